# Optimizing an MI355X kernel written in HIP

```python
import jax, jax.numpy as jnp
from jax import lax
import numpy as np

D_MODEL = 1024
BATCH = 8
SEQ = 4096
DEPTH = 1
DEC_BATCH = 32
DEC_SEQ = 8
PAST_LEN = 16384
PAGE_SIZE = 128

HEAD_DIM = 64
MIX_W = D_MODEL
RWKV_W = MIX_W // 2
ATT_W = MIX_W - RWKV_W
H_R = RWKV_W // HEAD_DIM
H_A = ATT_W // HEAD_DIM
D_DECAY = 64
D_ICLR = 64
D_GATE = 128
RWKV_COLS = 3 * RWKV_W + D_DECAY + D_ICLR + D_GATE
D_IN = RWKV_COLS + 3 * ATT_W
DIL_PATTERN = ((128, 1), (512, 4), (2048, 16))
WINDOW_MAX = max(w for w, _ in DIL_PATTERN)
ROPE_THETA = 10000.0
D_FF = 2816
CONV_W = 3
NORM_EPS = 1e-6
LNX_EPS = 64e-5
NEG_INF = -1e30

kernel_name = 'hymba_rwkv7_dilated_convffn_step'


def _rms(x, g):
    xf = x.astype(jnp.float32)
    y = xf * lax.rsqrt(jnp.mean(xf * xf, axis=-1, keepdims=True) + NORM_EPS)
    return (y * g.astype(jnp.float32)).astype(x.dtype)


def _rope(t, pos):
    half = t.shape[-1] // 2
    inv = ROPE_THETA ** (-jnp.arange(half, dtype=jnp.float32) / half)
    ang = pos.astype(jnp.float32)[:, None] * inv[None, :]
    cos = jnp.cos(ang)[None, :, None, :]
    sin = jnp.sin(ang)[None, :, None, :]
    tf = t.astype(jnp.float32)
    t1, t2 = tf[..., :half], tf[..., half:]
    return jnp.concatenate([t1 * cos - t2 * sin, t1 * sin + t2 * cos], axis=-1).astype(t.dtype)


def _dilated_branch_prompt(q, k, v, dilation, n_steps):
    B, L, H, Dh = q.shape
    qb = n_steps
    seg = dilation * qb
    Lp = -(-L // seg) * seg
    pad = Lp - L
    M = Lp // dilation
    nb = M // qb

    def to_sub(t):
        t = jnp.pad(t, ((0, 0), (pad, 0), (0, 0), (0, 0)))
        t = t.reshape(B, M, dilation, H, Dh).transpose(0, 2, 1, 3, 4)
        return t.reshape(B, dilation, nb, qb, H, Dh)

    def with_prev(t):
        prev = jnp.pad(t, ((0, 0), (0, 0), (1, 0), (0, 0), (0, 0), (0, 0)))[:, :, :-1]
        return jnp.concatenate([prev, t], axis=3)

    qs = to_sub(q)
    kb = with_prev(to_sub(k))
    vb = with_prev(to_sub(v))
    s = jnp.einsum('brnqhd,brnkhd->brnhqk', qs, kb).astype(jnp.float32) * (Dh ** -0.5)

    qi = jnp.arange(qb)[:, None]
    ki = jnp.arange(2 * qb)[None, :]
    dist = qi + qb - ki
    band = (dist >= 0) & (dist <= n_steps)
    key_sub = jnp.arange(nb)[:, None] * qb + jnp.arange(2 * qb)[None, :] - qb
    key_pos = key_sub[None] * dilation + jnp.arange(dilation)[:, None, None] - pad
    mask = band[None, None] & (key_pos >= 0)[:, :, None, :]
    mask = mask[None, :, :, None]

    s = jnp.where(mask, s, NEG_INF)
    m = jnp.max(s, axis=-1)
    p = jnp.where(mask, jnp.exp(s - m[..., None]), 0.0)
    l = jnp.sum(p, axis=-1)
    o = jnp.einsum('brnhqk,brnkhd->brnqhd', p, vb.astype(jnp.float32))

    def from_sub(t):
        rest = t.shape[4:]
        t = t.reshape((B, dilation, M) + rest).swapaxes(1, 2).reshape((B, Lp) + rest)
        return t[:, pad:]

    return from_sub(o), from_sub(m.swapaxes(3, 4)), from_sub(l.swapaxes(3, 4))


def _dilated_branch_sample(q, kc, vc, dilation, n_steps, offset):
    T = q.shape[1]
    j = jnp.arange(n_steps + 1)
    idx = offset + jnp.arange(T)[:, None] - j[None, :] * dilation
    valid = idx >= 0
    idx = jnp.maximum(idx, 0)
    kg = kc[:, idx]
    vg = vc[:, idx]
    s = jnp.einsum('bthd,btjhd->bthj', q, kg).astype(jnp.float32) * (q.shape[-1] ** -0.5)
    mask = valid[None, :, None, :]
    s = jnp.where(mask, s, NEG_INF)
    m = jnp.max(s, axis=-1)
    p = jnp.where(mask, jnp.exp(s - m[..., None]), 0.0)
    l = jnp.sum(p, axis=-1)
    o = jnp.einsum('bthj,btjhd->bthd', p, vg.astype(jnp.float32))
    return o, m, l


def _merge_branches(branches):
    o = jnp.stack([b[0] for b in branches])
    m = jnp.stack([b[1] for b in branches])
    l = jnp.stack([b[2] for b in branches])
    wt = jnp.exp(m - jnp.max(m, axis=0))
    num = jnp.sum(wt[..., None] * o, axis=0)
    den = jnp.sum(wt * l, axis=0)
    return num / den[..., None]


def _wkv_step(S, inp):
    r, w, k, v, a, b = inp
    sa = jnp.einsum('bhij,bhj->bhi', S, a)
    S = S * w[:, :, None, :] + sa[..., None] * b[:, :, None, :] + v[..., None] * k[:, :, None, :]
    return S, jnp.einsum('bhij,bhj->bhi', S, r)


def _rwkv7(r, k, v, wl, al, gl, S0, w0, w_decay_up, a0, w_iclr_up, w_gate_up,
           k_k, k_a, r_k, lnx_w, lnx_b):
    B, T, _ = r.shape
    f32 = jnp.float32
    r, k, v = r.astype(f32), k.astype(f32), v.astype(f32)
    w = -jax.nn.softplus(-(w0 + jnp.tanh(wl.astype(f32)) @ w_decay_up)) - 0.5
    decay = jnp.exp(-jnp.exp(w))
    a = jax.nn.sigmoid(a0 + al.astype(f32) @ w_iclr_up)
    g = jax.nn.sigmoid(gl.astype(f32)) @ w_gate_up
    heads = lambda t: t.reshape(B, T, H_R, HEAD_DIM)
    kk = heads(k * k_k)
    kk = kk / jnp.maximum(jnp.sqrt(jnp.sum(kk * kk, axis=-1, keepdims=True)), 1e-12)
    k = k * (1.0 + (a - 1.0) * k_a)
    rh, kh, vh, wh = heads(r), heads(k), heads(v), heads(decay)
    aa = -kk
    bb = kk * heads(a)
    tm = lambda t: jnp.swapaxes(t, 0, 1)
    S_fin, y = lax.scan(_wkv_step, S0.astype(f32),
                        (tm(rh), tm(wh), tm(kh), tm(vh), tm(aa), tm(bb)))
    y = tm(y)
    mu = jnp.mean(y, axis=-1, keepdims=True)
    var = jnp.mean(jnp.square(y - mu), axis=-1, keepdims=True)
    y = ((y - mu) * lax.rsqrt(var + LNX_EPS)).reshape(B, T, RWKV_W) * lnx_w + lnx_b
    bonus = jnp.sum(rh * kh * r_k, axis=-1, keepdims=True) * vh
    y = (y + bonus.reshape(B, T, RWKV_W)) * g
    return y, S_fin


def _layer(x, pos, h_prev, wkv0, k_buf, v_buf, conv_prev,
           norm_mix_pre, norm_mix_post, norm_ffn_pre, norm_ffn_post, w_in, mu_shift,
           w0, w_decay_up, a0, w_iclr_up, w_gate_up, k_k, k_a, r_k, lnx_w, lnx_b,
           w_out, w_ffn_up, ffn_conv_w, ffn_conv_b, w_ffn_down):
    B, T, _ = x.shape
    h = _rms(x, norm_mix_pre)
    proj = jnp.concatenate([h_prev[:, None].astype(h.dtype), h], axis=1) @ w_in
    cur = proj[:, 1:]
    prv = proj[:, :-1, :RWKV_COLS]
    rw = cur[..., :RWKV_COLS]
    mixed = rw + (prv - rw) * mu_shift
    r, k, v, wl, al, gl = jnp.split(mixed, [RWKV_W, 2 * RWKV_W, 3 * RWKV_W,
                                            3 * RWKV_W + D_DECAY,
                                            3 * RWKV_W + D_DECAY + D_ICLR], axis=-1)
    rwkv_out, wkv_new = _rwkv7(r, k, v, wl, al, gl, wkv0, w0, w_decay_up, a0, w_iclr_up,
                               w_gate_up, k_k, k_a, r_k, lnx_w, lnx_b)

    qa, ka, va = [t.reshape(B, T, H_A, HEAD_DIM)
                  for t in jnp.split(cur[..., RWKV_COLS:], 3, axis=-1)]
    qa = _rope(qa, pos)
    ka = _rope(ka, pos)
    if k_buf is None:
        branches = [_dilated_branch_prompt(qa, ka, va, d, w // d) for w, d in DIL_PATTERN]
        keep = min(WINDOW_MAX, T)
        k_new, v_new = ka[:, -keep:], va[:, -keep:]
    else:
        W = k_buf.shape[1]
        kc = jnp.concatenate([k_buf.astype(ka.dtype), ka], axis=1)
        vc = jnp.concatenate([v_buf.astype(va.dtype), va], axis=1)
        branches = [_dilated_branch_sample(qa, kc, vc, d, w // d, W) for w, d in DIL_PATTERN]
        k_new, v_new = kc[:, -W:], vc[:, -W:]
    att_out = _merge_branches(branches).reshape(B, T, ATT_W)

    mix = jnp.concatenate([rwkv_out.astype(x.dtype), att_out.astype(x.dtype)], axis=-1) @ w_out
    x = x + _rms(mix, norm_mix_post).astype(x.dtype)

    h2 = _rms(x, norm_ffn_pre)
    u = h2 @ w_ffn_up
    ue = jnp.concatenate([conv_prev.astype(u.dtype), u], axis=1)
    c = sum(ue[:, i:i + T] * ffn_conv_w[i] for i in range(CONV_W)) + ffn_conv_b
    gate, up = jnp.split(c, 2, axis=-1)
    f = (jax.nn.silu(gate) * up) @ w_ffn_down
    x = x + _rms(f, norm_ffn_post).astype(x.dtype)
    return x, h[:, -1], wkv_new, k_new, v_new, ue[:, -(CONV_W - 1):]


def setup_inputs(seed: int = 0) -> dict:
    key = jax.random.key(seed)
    ks = jax.random.split(key, 32)
    nrm = jax.random.normal
    W_BUF = min(WINDOW_MAX, PAST_LEN)
    L = DEPTH
    return {
        'x_prompt': nrm(ks[0], (BATCH, SEQ, D_MODEL), jnp.float32),
        'x_sample': nrm(ks[1], (DEC_BATCH, DEC_SEQ, D_MODEL), jnp.float32),
        'state_rwkv_shift': nrm(ks[2], (L, DEC_BATCH, D_MODEL), jnp.float32),
        'state_rwkv_wkv': nrm(ks[3], (L, DEC_BATCH, H_R, HEAD_DIM, HEAD_DIM), jnp.float32),
        'cache_att_k': nrm(ks[4], (L, DEC_BATCH, W_BUF, H_A, HEAD_DIM), jnp.float32),
        'cache_att_v': nrm(ks[5], (L, DEC_BATCH, W_BUF, H_A, HEAD_DIM), jnp.float32),
        'state_ffn_conv': nrm(ks[6], (L, DEC_BATCH, CONV_W - 1, 2 * D_FF), jnp.float32),
        'norm_mix_pre': 1.0 + 0.05 * nrm(ks[7], (L, D_MODEL), jnp.float32),
        'norm_mix_post': 1.0 + 0.05 * nrm(ks[8], (L, D_MODEL), jnp.float32),
        'norm_ffn_pre': 1.0 + 0.05 * nrm(ks[9], (L, D_MODEL), jnp.float32),
        'norm_ffn_post': 1.0 + 0.05 * nrm(ks[10], (L, D_MODEL), jnp.float32),
        'w_in': nrm(ks[11], (L, D_MODEL, D_IN), jnp.float32) * D_MODEL ** -0.5,
        'mu_shift': jax.random.uniform(ks[12], (L, RWKV_COLS), jnp.float32),
        'w0': -0.5 - 3.5 * jax.random.uniform(ks[13], (L, RWKV_W), jnp.float32),
        'w_decay_up': nrm(ks[14], (L, D_DECAY, RWKV_W), jnp.float32) * 0.1 * D_DECAY ** -0.5,
        'a0': 0.1 * nrm(ks[15], (L, RWKV_W), jnp.float32),
        'w_iclr_up': nrm(ks[16], (L, D_ICLR, RWKV_W), jnp.float32) * D_ICLR ** -0.5,
        'w_gate_up': nrm(ks[17], (L, D_GATE, RWKV_W), jnp.float32) * D_GATE ** -0.5,
        'k_k': 0.85 + 0.05 * nrm(ks[18], (L, RWKV_W), jnp.float32),
        'k_a': 1.0 + 0.05 * nrm(ks[19], (L, RWKV_W), jnp.float32),
        'r_k': 0.1 * nrm(ks[20], (L, H_R, HEAD_DIM), jnp.float32),
        'lnx_w': 1.0 + 0.05 * nrm(ks[21], (L, RWKV_W), jnp.float32),
        'lnx_b': 0.01 * nrm(ks[22], (L, RWKV_W), jnp.float32),
        'w_out': nrm(ks[23], (L, MIX_W, D_MODEL), jnp.float32) * MIX_W ** -0.5,
        'w_ffn_up': nrm(ks[24], (L, D_MODEL, 2 * D_FF), jnp.float32) * D_MODEL ** -0.5,
        'ffn_conv_w': nrm(ks[25], (L, CONV_W, 2 * D_FF), jnp.float32) * CONV_W ** -0.5,
        'ffn_conv_b': 0.01 * nrm(ks[26], (L, 2 * D_FF), jnp.float32),
        'w_ffn_down': nrm(ks[27], (L, D_FF, D_MODEL), jnp.float32) * D_FF ** -0.5,
    }


def reference(x_prompt, x_sample, state_rwkv_shift, state_rwkv_wkv, cache_att_k, cache_att_v,
              state_ffn_conv, norm_mix_pre, norm_mix_post, norm_ffn_pre, norm_ffn_post, w_in,
              mu_shift, w0, w_decay_up, a0, w_iclr_up, w_gate_up, k_k, k_a, r_k, lnx_w, lnx_b,
              w_out, w_ffn_up, ffn_conv_w, ffn_conv_b, w_ffn_down):
    Bp, Tp, _ = x_prompt.shape
    Ts = x_sample.shape[1]
    pos_p = jnp.arange(Tp, dtype=jnp.int32)
    pos_s = PAST_LEN + jnp.arange(Ts, dtype=jnp.int32)
    yp, ys = x_prompt, x_sample
    p_shift, p_wkv, p_k, p_v, p_conv = [], [], [], [], []
    s_shift, s_wkv, s_k, s_v, s_conv = [], [], [], [], []
    for l in range(DEPTH):
        wts = (norm_mix_pre[l], norm_mix_post[l], norm_ffn_pre[l], norm_ffn_post[l], w_in[l],
               mu_shift[l], w0[l], w_decay_up[l], a0[l], w_iclr_up[l], w_gate_up[l], k_k[l],
               k_a[l], r_k[l], lnx_w[l], lnx_b[l], w_out[l], w_ffn_up[l], ffn_conv_w[l],
               ffn_conv_b[l], w_ffn_down[l])
        yp, a1, a2, a3, a4, a5 = _layer(
            yp, pos_p, jnp.zeros((Bp, D_MODEL), x_prompt.dtype),
            jnp.zeros((Bp, H_R, HEAD_DIM, HEAD_DIM), jnp.float32), None, None,
            jnp.zeros((Bp, CONV_W - 1, 2 * D_FF), x_prompt.dtype), *wts)
        p_shift.append(a1); p_wkv.append(a2); p_k.append(a3); p_v.append(a4); p_conv.append(a5)
        ys, b1, b2, b3, b4, b5 = _layer(
            ys, pos_s, state_rwkv_shift[l], state_rwkv_wkv[l], cache_att_k[l], cache_att_v[l],
            state_ffn_conv[l], *wts)
        s_shift.append(b1); s_wkv.append(b2); s_k.append(b3); s_v.append(b4); s_conv.append(b5)
    return (yp, ys,
            jnp.stack(p_shift), jnp.stack(p_wkv), jnp.stack(p_k), jnp.stack(p_v), jnp.stack(p_conv),
            jnp.stack(s_shift), jnp.stack(s_wkv), jnp.stack(s_k), jnp.stack(s_v), jnp.stack(s_conv))
```

```cpp
#include <hip/hip_runtime.h>
#include <hip/hip_cooperative_groups.h>
#include <cstdio>
#include <cstdint>
namespace pg8 {
#define PG8_LAS __attribute__((address_space(3)))
typedef unsigned short bf16_t;
typedef short bf16x8 __attribute__((ext_vector_type(8)));
typedef float f32x4 __attribute__((ext_vector_type(4)));
typedef unsigned u32x4 __attribute__((ext_vector_type(4)));
constexpr int BM = 256, BK = 64, HALF = 128, HTB = HALF * BK * 2  , STAGE_BYTES = 8 * HTB, NXCD = 8, WGM = 8;

__host__ __device__ __forceinline__ int lds_byte(int r, int c) { const int st = (r >> 4) * 2 + (c >> 5), rr = r & 15, cc = c & 31, ob = rr * 64 + cc * 2; return st * 1024 + (ob ^ (((ob >> 9) & 1) << 5)); }
__host__ __device__ __forceinline__ void stage_rc(int b, int& R, int& C) { const int st = b / 1024, sb = b % 1024, swz = sb ^ (((sb >> 9) & 1) << 5); R = (st >> 1) * 16 + swz / 64; C = (st & 1) * 32 + (swz % 64) / 2; }
__host__ __device__ __forceinline__ int perm32(int rho) { const int n = rho >> 4, i = rho & 15; return 8 * (i >> 2) + 4 * n + (i & 3); }

struct Unit { int pm, pn; };
struct Gemm { const bf16_t* A; const bf16_t* Bt; int M, N, K, lda; };

struct StaticOrder {
    int nM, nN, nwg, G, c;
    __host__ __device__ void init(int M, int N, int G_, int c_) { nM = M / BM; nN = N / BM; nwg = nM * nN; G = G_; c = c_; }
    __host__ __device__ bool next(int i, Unit& u) const {
        const long L = (long)i * G + c; if (L >= nwg) return false;
        int wgid = (int)L; { const int q = nwg / NXCD, r = nwg % NXCD, xcd = wgid % NXCD, off = wgid / NXCD; wgid = (xcd < r ? xcd * (q + 1) : r * (q + 1) + (xcd - r) * q) + off; }
        const int nig = WGM * nN, gid = wgid / nig, fm = gid * WGM, gsz = (nM - fm) < WGM ? (nM - fm) : WGM;
        u.pm = fm + ((wgid % nig) % gsz); u.pn = (wgid % nig) / gsz; return true;
    }
    __device__ __forceinline__ void a_ready(const Unit&) const {}
    __device__ __forceinline__ void done(const Unit&) const {}
};
__device__ __forceinline__ unsigned cvt_pk_bf16(float lo, float hi) { unsigned r; asm volatile("v_cvt_pk_bf16_f32 %0, %1, %2" : "=v"(r) : "v"(lo), "v"(hi)); return r; }
typedef float f32x2 __attribute__((ext_vector_type(2)));
struct EpiF32 {
    static constexpr bool PERM = false, AFTER_DRAIN = false;
    float* C; int ldc; const float* bias;
    __device__ __forceinline__ void operator()(const f32x4 (&acc)[2][2][4][2], const Unit& u, int wr, int wc, int fr, int fq) const {
        const int row0 = u.pm * BM + wr * 64 + fr, col0 = u.pn * BM + wc * 32 + 4 * fq;
        f32x4 bv[2][2];
#pragma unroll
        for (int bj = 0; bj < 2; ++bj)
#pragma unroll
            for (int n = 0; n < 2; ++n) bv[bj][n] = bias ? *(const f32x4*)(bias + col0 + bj * HALF + n * 16) : (f32x4){0.f, 0.f, 0.f, 0.f};
#pragma unroll
        for (int ai = 0; ai < 2; ++ai)
#pragma unroll
            for (int m = 0; m < 4; ++m) { float* rowp = C + (size_t)(row0 + ai * HALF + m * 16) * ldc + col0;
#pragma unroll
                for (int bj = 0; bj < 2; ++bj)
#pragma unroll
                    for (int n = 0; n < 2; ++n) *(f32x4*)(rowp + bj * HALF + n * 16) = acc[ai][bj][m][n] + bv[bj][n]; }
    }
};
template <class Epi, class Sched, bool STAMP = false>
__device__ __forceinline__ void gemm_phase(PG8_LAS unsigned char* lds, const Gemm g, const Sched& S, const Epi& E, unsigned long long* stamps) {
    const int tid = threadIdx.x, wid = __builtin_amdgcn_readfirstlane(tid >> 6), lane = tid & 63, wr = wid >> 2, wc = wid & 3, fr = lane & 15, fq = lane >> 4;
    const int K = g.K, nt = K / BK;
    int ts_lo = 0, ts_hi = 0, nts = 0; const unsigned long long rt_entry = STAMP ? (unsigned long long)wall_clock64() : 0ull;
#define PG8_STAMP() do { if (STAMP && wid == 0 && nts < 64) { const unsigned long long _c = (unsigned long long)clock64(); \
        ts_lo = (lane == nts) ? (int)(unsigned)_c : ts_lo; ts_hi = (lane == nts) ? (int)(unsigned)(_c >> 32) : ts_hi; ++nts; } } while (0)
    PG8_STAMP();
    unsigned voffA[2], voffB[2];
#pragma unroll
    for (int i = 0; i < 2; ++i) { int R, C; stage_rc(tid * 16 + i * 8192, R, C); const int Rb = Epi::PERM ? ((R & ~31) + perm32(R & 31)) : R;
        voffA[i] = (unsigned)(R * g.lda + C) * 2u; voffB[i] = (unsigned)(Rb * K + C) * 2u; }
    const size_t kstep = (size_t)(BK * 2);
    const size_t hstep = (size_t)HALF * K * 2, hstepA = (size_t)HALF * g.lda * 2;
    const size_t tstep = 2 * hstep, tstepA = 2 * hstepA;
    const unsigned ldsw = (unsigned)wid * 1024u;
    const int aoff = lds_byte(wr * 64 + fr, fq * 8), boff = lds_byte(wc * 32 + fr, fq * 8);
#define PG8_SA(b, h) (((b) * 2 + (h)) * HTB)
#define PG8_SB(b, h) ((4 + (b) * 2 + (h)) * HTB)
#define PG8_STAGE(bufoff, gbase, voff) do { _Pragma("unroll") for (int _i = 0; _i < 2; ++_i) \
        __builtin_amdgcn_global_load_lds((const unsigned*)((const char*)(gbase) + (voff)[_i]), (PG8_LAS unsigned*)(lds + (bufoff) + ldsw + _i * 8192), 16, 0, 0); } while (0)
#define PG8_LDA(dst, b, h) do { _Pragma("unroll") for (int m = 0; m < 4; ++m) _Pragma("unroll") for (int k = 0; k < 2; ++k) dst[m][k] = *(const PG8_LAS bf16x8*)(lds + PG8_SA(b, h) + aoff + m * 2048 + k * 1024); } while (0)
#define PG8_LDB(dst, b, h) do { _Pragma("unroll") for (int n = 0; n < 2; ++n) _Pragma("unroll") for (int k = 0; k < 2; ++k) dst[n][k] = *(const PG8_LAS bf16x8*)(lds + PG8_SB(b, h) + boff + n * 2048 + k * 1024); } while (0)
#define PG8_MMA(ai, bj, At, Bt) do { __builtin_amdgcn_s_setprio(1); _Pragma("unroll") for (int m = 0; m < 4; ++m) _Pragma("unroll") for (int n = 0; n < 2; ++n) _Pragma("unroll") for (int k = 0; k < 2; ++k) \
        acc[ai][bj][m][n] = __builtin_amdgcn_mfma_f32_16x16x32_bf16(Bt[n][k], At[m][k], acc[ai][bj][m][n], 0, 0, 0); __builtin_amdgcn_s_setprio(0); } while (0)
#define PG8_WAIT_V(n) asm volatile("s_waitcnt vmcnt(" #n ")" ::: "memory")
#define PG8_WAIT_L(n) asm volatile("s_waitcnt lgkmcnt(" #n ")" ::: "memory")
#define PG8_BAR __builtin_amdgcn_s_barrier()
#define PG8_SCHED __builtin_amdgcn_sched_barrier(0)
    Unit cur, nxt; int ui = 0;
    if (!S.next(0, cur)) return;
    f32x4 acc[2][2][4][2];
#pragma unroll
    for (int a = 0; a < 2; ++a)
#pragma unroll
        for (int b = 0; b < 2; ++b)
#pragma unroll
            for (int m = 0; m < 4; ++m)
#pragma unroll
                for (int n = 0; n < 2; ++n) acc[a][b][m][n] = (f32x4){0.f, 0.f, 0.f, 0.f};
    bf16x8 At[4][2], B0[2][2], B1[2][2];
    const char* cA = (const char*)g.A + (size_t)cur.pm * tstepA; const char* cB = (const char*)g.Bt + (size_t)cur.pn * tstep;
    S.a_ready(cur);
    PG8_STAGE(PG8_SB(0, 0), cB, voffB); PG8_STAGE(PG8_SA(0, 0), cA, voffA); PG8_STAGE(PG8_SB(0, 1), cB + hstep, voffB); PG8_STAGE(PG8_SA(0, 1), cA + hstepA, voffA);
    if (wr == 1) PG8_BAR;
    PG8_WAIT_V(4); PG8_BAR;
    PG8_STAGE(PG8_SB(1, 0), cB + kstep, voffB); PG8_STAGE(PG8_SA(1, 0), cA + kstep, voffA); PG8_STAGE(PG8_SB(1, 1), cB + hstep + kstep, voffB);
    PG8_WAIT_V(6); PG8_BAR;
    PG8_STAMP();
    for (;;) {
        const bool has_next = S.next(ui + 1, nxt);
        const char* nA = has_next ? (const char*)g.A + (size_t)nxt.pm * tstepA : cA; const char* nB = has_next ? (const char*)g.Bt + (size_t)nxt.pn * tstep : cB;
        for (int t = 0; t < nt; t += 2) {
            const bool last = (t == nt - 2);
            const char* a1 = cA + (size_t)(t + 1) * kstep;
            const char* a2 = last ? nA : cA + (size_t)(t + 2) * kstep; const char* b2 = last ? nB : cB + (size_t)(t + 2) * kstep;
            const char* a3 = a2 + kstep; const char* b3 = b2 + kstep;
            if (last && has_next) S.a_ready(nxt);
            PG8_LDB(B0, 0, 0); PG8_SCHED; PG8_LDA(At, 0, 0); PG8_STAGE(PG8_SA(1, 1), a1 + hstepA, voffA);
            PG8_WAIT_L(8); PG8_BAR; PG8_WAIT_L(0); PG8_MMA(0, 0, At, B0); PG8_BAR; PG8_SCHED;
            PG8_LDB(B1, 0, 1); PG8_STAGE(PG8_SB(0, 0), b2, voffB);
            PG8_BAR; PG8_WAIT_L(0); PG8_MMA(0, 1, At, B1); PG8_BAR;
            PG8_LDA(At, 0, 1); PG8_STAGE(PG8_SA(0, 0), a2, voffA);
            PG8_BAR; PG8_WAIT_L(0); PG8_MMA(1, 0, At, B0); PG8_BAR; PG8_SCHED;
            PG8_STAGE(PG8_SB(0, 1), b2 + hstep, voffB);
            PG8_WAIT_V(6); PG8_BAR; PG8_MMA(1, 1, At, B1); PG8_BAR;
            PG8_LDB(B0, 1, 0); PG8_SCHED; PG8_LDA(At, 1, 0); PG8_STAGE(PG8_SA(0, 1), a2 + hstepA, voffA);
            PG8_WAIT_L(8); PG8_BAR; PG8_WAIT_L(0); PG8_MMA(0, 0, At, B0); PG8_BAR; PG8_SCHED;
            PG8_LDB(B1, 1, 1); PG8_STAGE(PG8_SB(1, 0), b3, voffB);
            PG8_BAR; PG8_WAIT_L(0); PG8_MMA(0, 1, At, B1); PG8_BAR;
            PG8_LDA(At, 1, 1); PG8_STAGE(PG8_SA(1, 0), a3, voffA);
            PG8_BAR; PG8_WAIT_L(0); PG8_MMA(1, 0, At, B0); PG8_BAR; PG8_SCHED;
            PG8_STAGE(PG8_SB(1, 1), b3 + hstep, voffB);
            PG8_WAIT_V(6); PG8_BAR; PG8_MMA(1, 1, At, B1); PG8_BAR;
        }
        PG8_STAMP();
        if constexpr (!Epi::AFTER_DRAIN) { E(acc, cur, wr, wc, fr, fq); S.done(cur); }
        PG8_STAMP();
        if (!has_next) break;
#pragma unroll
        for (int a = 0; a < 2; ++a)
#pragma unroll
            for (int b = 0; b < 2; ++b)
#pragma unroll
                for (int m = 0; m < 4; ++m)
#pragma unroll
                    for (int n = 0; n < 2; ++n) acc[a][b][m][n] = (f32x4){0.f, 0.f, 0.f, 0.f};
        cur = nxt; cA = nA; cB = nB; ++ui;
    }
    PG8_WAIT_V(0);
    if (wr == 0) PG8_BAR;
    PG8_BAR;
    if constexpr (Epi::AFTER_DRAIN) { E.fused(acc, cur, wr, wc, fr, fq, lds, wid, lane); S.done(cur); }
    PG8_STAMP();
    if (STAMP && wid == 0) { stamps[lane] = lane < nts ? (((unsigned long long)(unsigned)ts_hi << 32) | (unsigned)ts_lo) : 0ull;
        if (lane == 62) stamps[62] = rt_entry; if (lane == 63) stamps[63] = (unsigned long long)wall_clock64(); }
#undef PG8_STAMP
#undef PG8_SA
#undef PG8_SB
#undef PG8_STAGE
#undef PG8_LDA
#undef PG8_LDB
#undef PG8_MMA
#undef PG8_WAIT_V
#undef PG8_WAIT_L
#undef PG8_BAR
#undef PG8_SCHED
}
}

namespace cg = cooperative_groups;
#define LAS __attribute__((address_space(3)))
typedef unsigned short bf16_t;
typedef unsigned int u32;
typedef pg8::bf16x8 bf16x8;
typedef pg8::f32x4 f32x4;
typedef pg8::u32x4 u32x4;

constexpr int D = 1024, TP = 4096, BP = 8, MP = BP * TP, BS = 32, TS = 8, MS = BS * TS;
constexpr int MB = MP + MS;
constexpr int MA = 33280;
constexpr int MA_REAL = MP + BS * 9;
constexpr int DIN = 3328, RCOLS = 1792, FF = 2816, FF2 = 5632, NLORA = 1536, KLORA = 256;
constexpr int NTHREADS = 512;
constexpr int LDS_BYTES = 144 * 1024;

constexpr size_t O_YP = 0;
constexpr size_t O_YS = O_YP + (size_t)MP * D;
constexpr size_t O_PSH = O_YS + (size_t)MS * D;
constexpr size_t O_PWKV = O_PSH + (size_t)BP * D;
constexpr size_t O_PK = O_PWKV + (size_t)BP * 8 * 64 * 64;
constexpr size_t O_PV = O_PK + (size_t)BP * 2048 * 512;
constexpr size_t O_PCONV = O_PV + (size_t)BP * 2048 * 512;
constexpr size_t O_SSH = O_PCONV + (size_t)BP * 2 * FF2;
constexpr size_t O_SWKV = O_SSH + (size_t)BS * D;
constexpr size_t O_SK = O_SWKV + (size_t)BS * 8 * 64 * 64;
constexpr size_t O_SV = O_SK + (size_t)BS * 2048 * 512;
constexpr size_t O_SCONV = O_SV + (size_t)BS * 2048 * 512;
constexpr size_t O_END = O_SCONV + (size_t)BS * 2 * FF2;

constexpr size_t al256(size_t x) { return (x + 255) & ~(size_t)255; }
constexpr size_t WS_WIN = 0;
constexpr size_t WS_WOUT = WS_WIN + al256((size_t)DIN * D * 2);
constexpr size_t WS_WUP = WS_WOUT + al256((size_t)D * D * 2);
constexpr size_t WS_WDN = WS_WUP + al256((size_t)FF2 * D * 2);
constexpr size_t WS_WLORA = WS_WDN + al256((size_t)D * FF * 2);
constexpr size_t WS_ROPE = WS_WLORA + al256((size_t)NLORA * KLORA * 2);
constexpr int NPOS = 4104;
constexpr size_t WS_SNEWK = WS_ROPE + al256((size_t)NPOS * 32 * 2 * 4);
constexpr size_t WS_SNEWV = WS_SNEWK + al256((size_t)MS * 512 * 4);
constexpr size_t WS_HALO = WS_SNEWV + al256((size_t)MS * 512 * 4);
constexpr size_t WS_A = WS_HALO + al256((size_t)1025 * 2 * FF2 * 2);
constexpr size_t WS_PROJRW = WS_A;
constexpr size_t WS_Q = WS_PROJRW + al256((size_t)MA * RCOLS * 2);
constexpr size_t WS_K = WS_Q + al256((size_t)MB * 512 * 2);
constexpr size_t WS_VT1 = WS_K + al256((size_t)MB * 512 * 2);
constexpr size_t WS_VT4 = WS_VT1 + al256((size_t)BP * 8 * 64 * TP * 2);
constexpr size_t WS_VT16 = WS_VT4 + al256((size_t)BP * 8 * 64 * TP * 2);
constexpr size_t WS_ALORA = WS_VT16 + al256((size_t)BP * 8 * 64 * TP * 2);
constexpr size_t WS_A_EARLY_END = WS_ALORA + al256((size_t)MB * KLORA * 2);
constexpr size_t WS_U = WS_A;
constexpr size_t WS_END = WS_A + al256((size_t)MB * FF2 * 2);
static_assert(WS_A_EARLY_END <= WS_END, "region A overflow");
constexpr size_t SC_B = O_SK * 4;
constexpr size_t SC_C = SC_B + al256((size_t)MB * D * 4);
static_assert(SC_C + (size_t)MB * D * 2 <= O_SCONV * 4, "scratch overflow");
static_assert((size_t)MA * D * 2 <= (size_t)MB * D * 4 && (size_t)MB * NLORA * 2 <= (size_t)MB * D * 4, "region B");

struct Params {
    const float* in[28];
    float* out;
    unsigned char* ws;
    int ph_lo, ph_hi;
};

enum { I_XP = 0, I_XS, I_SSHIFT, I_SWKV, I_CK, I_CV, I_SCONV, I_NMPRE, I_NMPOST, I_NFPRE, I_NFPOST, I_WIN, I_MU, I_W0, I_WDEC, I_A0, I_WICLR, I_WGATE,
       I_KK, I_KA, I_RK, I_LNW, I_LNB, I_WOUT, I_WUP, I_CONVW, I_CONVB, I_WDN };

__device__ __forceinline__ float bflo(u32 p) { return __uint_as_float(p << 16); }
__device__ __forceinline__ float bfhi(u32 p) { return __uint_as_float(p & 0xffff0000u); }
__device__ __forceinline__ u32 pk2(float a, float b) { return pg8::cvt_pk_bf16(a, b); }
__device__ __forceinline__ float wave_sum(float v) {
#pragma unroll
    for (int o = 1; o < 64; o <<= 1) v += __shfl_xor(v, o);
    return v;
}
template <int N> __device__ __forceinline__ float dpp_ror(float x) {
    return __int_as_float(__builtin_amdgcn_update_dpp(0, __float_as_int(x), 0x120 + N, 0xF, 0xF, false));
}
__device__ __forceinline__ float row16_sum(float x) {
    x += dpp_ror<8>(x); x += dpp_ror<4>(x); x += dpp_ror<2>(x); x += dpp_ror<1>(x);
    return x;
}
__device__ __forceinline__ float sigmoidf_(float x) { return 1.f / (1.f + __expf(-x)); }

__device__ __forceinline__ int win_rowmap(int n) {
    if (n < RCOLS || n >= RCOLS + 1024) return n;
    const int base = (n < RCOLS + 512) ? RCOLS : RCOLS + 512, c = n - base, unit = c >> 8, cu = c & 255, hu = cu >> 6, d = cu & 63, e = d & 31, s = d >> 5;
    const int idx = hu * 32 + e, bj = idx >> 6, wc = (idx & 63) >> 4, fq = (idx & 15) >> 2, j = idx & 3;
    return base + unit * 256 + 128 * bj + 32 * wc + 16 * s + 4 * fq + j;
}
__device__ __forceinline__ void transpose_item(const float* W, int K, int N, bf16_t* WT, int mode, LAS float* scr, int item, int lane) {
    const int nblk = N / 32, kb = item / nblk, nb = item % nblk, k0 = 64 * kb, n0 = 32 * nb;
#pragma unroll 8
    for (int i = 0; i < 32; ++i) { const int kk = 2 * i + (lane >> 5); scr[kk * 33 + (lane & 31)] = W[(size_t)(k0 + kk) * N + n0 + (lane & 31)]; }
    asm volatile("s_waitcnt lgkmcnt(0)" ::: "memory");
    const int c = lane & 7;
#pragma unroll
    for (int j = 0; j < 4; ++j) { const int n = (lane >> 3) + 8 * j; const LAS float* s = scr + (8 * c) * 33 + n;
        uint4 o; o.x = pk2(s[0 * 33], s[1 * 33]); o.y = pk2(s[2 * 33], s[3 * 33]); o.z = pk2(s[4 * 33], s[5 * 33]); o.w = pk2(s[6 * 33], s[7 * 33]);
        const int row = mode ? win_rowmap(n0 + n) : (n0 + n);
        *(uint4*)(WT + (size_t)row * K + k0 + 8 * c) = o; }
    asm volatile("s_waitcnt lgkmcnt(0)" ::: "memory");
}
__device__ __forceinline__ void rms_row(const float* xrow, const float* g, bf16_t* orow, float* frow, int lane) {
    const float4* xr = (const float4*)xrow + lane; const float4* gr = (const float4*)g + lane;
    float4 v[4]; float s = 0.f;
#pragma unroll
    for (int j = 0; j < 4; ++j) { v[j] = xr[64 * j]; s += (v[j].x * v[j].x + v[j].y * v[j].y) + (v[j].z * v[j].z + v[j].w * v[j].w); }
    const float rs = rsqrtf(wave_sum(s) * (1.f / D) + 1e-6f);
#pragma unroll
    for (int j = 0; j < 4; ++j) { const float4 gg = gr[64 * j];
        float4 y; y.x = v[j].x * rs * gg.x; y.y = v[j].y * rs * gg.y; y.z = v[j].z * rs * gg.z; y.w = v[j].w * rs * gg.w;
        uint2 o; o.x = pk2(y.x, y.y); o.y = pk2(y.z, y.w);
        *((uint2*)orow + lane + 64 * j) = o;
        if (frow) *((float4*)frow + lane + 64 * j) = y; }
}
__device__ __forceinline__ void phase0(const Params& p, LAS unsigned char* lds, int tid, int G, int bid) {
    const int wave = tid >> 6, lane = tid & 63, gw = bid * 8 + wave, NGW = G * 8;
    LAS float* scr = (LAS float*)(lds + wave * 16384);
    bf16_t* WinT = (bf16_t*)(p.ws + WS_WIN); bf16_t* WoutT = (bf16_t*)(p.ws + WS_WOUT); bf16_t* WupT = (bf16_t*)(p.ws + WS_WUP); bf16_t* WdnT = (bf16_t*)(p.ws + WS_WDN);
    constexpr int I1 = (D / 64) * (DIN / 32), I2 = (D / 64) * (D / 32), I3 = (D / 64) * (FF2 / 32), I4 = (FF / 64) * (D / 32);
    for (int it = gw; it < I1 + I2 + I3 + I4; it += NGW) {
        int r = it;
        if (r < I1) { transpose_item(p.in[I_WIN], D, DIN, WinT, 1, scr, r, lane); continue; } r -= I1;
        if (r < I2) { transpose_item(p.in[I_WOUT], D, D, WoutT, 0, scr, r, lane); continue; } r -= I2;
        if (r < I3) { transpose_item(p.in[I_WUP], D, FF2, WupT, 0, scr, r, lane); continue; } r -= I3;
        transpose_item(p.in[I_WDN], FF, D, WdnT, 0, scr, r, lane);
    }
    const int gt = bid * NTHREADS + tid, NT = G * NTHREADS;
    bf16_t* WL = (bf16_t*)(p.ws + WS_WLORA);
    for (int i = gt; i < NLORA * KLORA; i += NT) {
        const int row = i >> 8, k = i & 255; float v = 0.f;
        if (row < 512) { if (k < 64) v = p.in[I_WDEC][k * 512 + row]; }
        else if (row < 1024) { if (k >= 64 && k < 128) v = p.in[I_WICLR][(k - 64) * 512 + (row - 512)]; }
        else { if (k >= 128) v = p.in[I_WGATE][(k - 128) * 512 + (row - 1024)]; }
        WL[i] = (bf16_t)(pk2(v, 0.f) & 0xffffu);
    }
    float* rope = (float*)(p.ws + WS_ROPE);
    for (int i = gt; i < NPOS * 32; i += NT) {
        const int pi = i >> 5, e = i & 31; const int pos = pi < TP ? pi : 16384 + (pi - TP);
        double inv = 1.0; for (int q = 0; q < e; ++q) inv *= 0.7498942093324558273;
        const float ang = (float)pos * (float)inv;
        const double a = (double)ang; const double kq = rint(a * 0.15915494309189535); double r = a - kq * 6.283185307179586; r -= kq * 2.4492935982947064e-16;
        const double r2 = r * r;
        double sn = 1.0 / 51090942171709440000.0;
        sn = sn * r2 * (-1.0) + 1.0 / 121645100408832000.0;
        sn = -sn * r2 + 1.0 / 355687428096000.0;
        sn = -sn * r2 + 1.0 / 1307674368000.0;
        sn = -sn * r2 + 1.0 / 6227020800.0;
        sn = -sn * r2 + 1.0 / 39916800.0;
        sn = -sn * r2 + 1.0 / 362880.0;
        sn = -sn * r2 + 1.0 / 5040.0;
        sn = -sn * r2 + 1.0 / 120.0;
        sn = -sn * r2 + 1.0 / 6.0;
        sn = -sn * r2 + 1.0;
        sn *= r;
        double cs = 1.0 / 1124000727777607680000.0;
        cs = -cs * r2 + 1.0 / 2432902008176640000.0;
        cs = -cs * r2 + 1.0 / 6402373705728000.0;
        cs = -cs * r2 + 1.0 / 20922789888000.0;
        cs = -cs * r2 + 1.0 / 87178291200.0;
        cs = -cs * r2 + 1.0 / 479001600.0;
        cs = -cs * r2 + 1.0 / 3628800.0;
        cs = -cs * r2 + 1.0 / 40320.0;
        cs = -cs * r2 + 1.0 / 720.0;
        cs = -cs * r2 + 1.0 / 24.0;
        cs = -cs * r2 + 0.5;
        cs = -cs * r2 + 1.0;
        rope[i] = (float)cs; rope[NPOS * 32 + i] = (float)sn;
    }
    bf16_t* H = (bf16_t*)((unsigned char*)p.out + SC_B);
    for (int row = gw; row < MA; row += NGW) {
        bf16_t* orow = H + (size_t)row * D;
        if (row < MP) {
            const bool last = (row & (TP - 1)) == TP - 1;
            rms_row(p.in[I_XP] + (size_t)row * D, p.in[I_NMPRE], orow, last ? p.out + O_PSH + (size_t)(row >> 12) * D : nullptr, lane);
        } else {
            const int s = row - MP;
            if (s < BS * 9) {
                const int b = s / 9, j = s - b * 9;
                if (j == 0) {
                    const float4* sr = (const float4*)(p.in[I_SSHIFT] + (size_t)b * D) + lane;
#pragma unroll
                    for (int q = 0; q < 4; ++q) { const float4 v = sr[64 * q]; uint2 o; o.x = pk2(v.x, v.y); o.y = pk2(v.z, v.w); *((uint2*)orow + lane + 64 * q) = o; }
                } else {
                    rms_row(p.in[I_XS] + (size_t)(b * TS + j - 1) * D, p.in[I_NMPRE], orow, j == TS ? p.out + O_SSH + (size_t)b * D : nullptr, lane);
                }
            } else {
#pragma unroll
                for (int q = 0; q < 4; ++q) *((uint2*)orow + lane + 64 * q) = make_uint2(0u, 0u);
            }
        }
    }
}

struct EpiProj {
    static constexpr bool PERM = false, AFTER_DRAIN = false;
    bf16_t* projrw; bf16_t* Q; bf16_t* K; bf16_t* VT1; bf16_t* VT4; bf16_t* VT16; const float* rope; float* out; float* snewk; float* snewv;
    __device__ __forceinline__ void operator()(const f32x4 (&acc)[2][2][4][2], const pg8::Unit& u, int wr, int wc, int fr, int fq) const {
        const int pn = u.pn;
        if (pn < 7) {
#pragma unroll
            for (int ai = 0; ai < 2; ++ai)
#pragma unroll
                for (int m = 0; m < 4; ++m) { const int row = u.pm * 256 + ai * 128 + wr * 64 + m * 16 + fr;
                    bf16_t* rp = projrw + (size_t)row * RCOLS + pn * 256 + wc * 32 + 4 * fq;
#pragma unroll
                    for (int bj = 0; bj < 2; ++bj)
#pragma unroll
                        for (int n = 0; n < 2; ++n) { const f32x4 v = acc[ai][bj][m][n]; uint2 o; o.x = pk2(v[0], v[1]); o.y = pk2(v[2], v[3]); *(uint2*)(rp + bj * 128 + n * 16) = o; } }
            return;
        }
#pragma unroll
        for (int ai = 0; ai < 2; ++ai)
#pragma unroll
            for (int m = 0; m < 4; ++m) {
                const int row = u.pm * 256 + ai * 128 + wr * 64 + m * 16 + fr;
                bool prompt = row < MP; int b, t, rowB, pi; bool valid = true;
                if (prompt) { b = row >> 12; t = row & (TP - 1); rowB = row; pi = t; }
                else { const int s = row - MP; b = s / 9; const int j = s - b * 9; valid = (s < BS * 9) && (j > 0); t = j - 1; rowB = MP + b * TS + t; pi = TP + t; }
                if (!valid) continue;
                if (pn < 11) {
                    const bool isq = pn < 9; const int unit = isq ? pn - 7 : pn - 9;
#pragma unroll
                    for (int bj = 0; bj < 2; ++bj) {
                        const int idx = bj * 64 + wc * 16 + fq * 4, hu = idx >> 5, e = idx & 31;
                        const float4 cs = *(const float4*)(rope + (size_t)pi * 32 + e), sn = *(const float4*)(rope + (size_t)NPOS * 32 + (size_t)pi * 32 + e);
                        const f32x4 x1 = acc[ai][bj][m][0], x2 = acc[ai][bj][m][1];
                        float o1[4], o2[4];
                        o1[0] = x1[0] * cs.x - x2[0] * sn.x; o2[0] = x1[0] * sn.x + x2[0] * cs.x;
                        o1[1] = x1[1] * cs.y - x2[1] * sn.y; o2[1] = x1[1] * sn.y + x2[1] * cs.y;
                        o1[2] = x1[2] * cs.z - x2[2] * sn.z; o2[2] = x1[2] * sn.z + x2[2] * cs.z;
                        o1[3] = x1[3] * cs.w - x2[3] * sn.w; o2[3] = x1[3] * sn.w + x2[3] * cs.w;
                        const int col = unit * 256 + hu * 64 + e;
                        if (isq) {
                            uint2 a, c2; a.x = pk2(o1[0] * 0.125f, o1[1] * 0.125f); a.y = pk2(o1[2] * 0.125f, o1[3] * 0.125f); c2.x = pk2(o2[0] * 0.125f, o2[1] * 0.125f); c2.y = pk2(o2[2] * 0.125f, o2[3] * 0.125f);
                            *(uint2*)(Q + (size_t)rowB * 512 + col) = a; *(uint2*)(Q + (size_t)rowB * 512 + col + 32) = c2;
                        } else {
                            uint2 a, c2; a.x = pk2(o1[0], o1[1]); a.y = pk2(o1[2], o1[3]); c2.x = pk2(o2[0], o2[1]); c2.y = pk2(o2[2], o2[3]);
                            *(uint2*)(K + (size_t)rowB * 512 + col) = a; *(uint2*)(K + (size_t)rowB * 512 + col + 32) = c2;
                            float* dst = nullptr;
                            if (prompt) { if (t >= 2048) dst = out + O_PK + ((size_t)b * 2048 + (t - 2048)) * 512 + col; }
                            else dst = snewk + (size_t)(b * TS + t) * 512 + col;
                            if (dst) { *(float4*)dst = make_float4(o1[0], o1[1], o1[2], o1[3]); *(float4*)(dst + 32) = make_float4(o2[0], o2[1], o2[2], o2[3]); }
                        }
                    }
                } else {
#pragma unroll
                    for (int bj = 0; bj < 2; ++bj)
#pragma unroll
                        for (int n = 0; n < 2; ++n) {
                            const int col = (pn - 11) * 256 + bj * 128 + wc * 32 + n * 16 + 4 * fq; const f32x4 v = acc[ai][bj][m][n];
                            if (prompt) {
                                if (t >= 2048) *(float4*)(out + O_PV + ((size_t)b * 2048 + (t - 2048)) * 512 + col) = make_float4(v[0], v[1], v[2], v[3]);
                                const int hd = col >> 6, d0 = col & 63; const size_t base = ((size_t)(b * 8 + hd) * 64 + d0) * TP;
                                const u32 p01 = pk2(v[0], v[1]), p23 = pk2(v[2], v[3]);
                                const bf16_t e0 = (bf16_t)(p01 & 0xffffu), e1 = (bf16_t)(p01 >> 16), e2 = (bf16_t)(p23 & 0xffffu), e3 = (bf16_t)(p23 >> 16);
                                const int i4 = (t & 3) * (TP / 4) + (t >> 2), i16 = (t & 15) * (TP / 16) + (t >> 4);
                                VT1[base + t] = e0; VT1[base + TP + t] = e1; VT1[base + 2 * TP + t] = e2; VT1[base + 3 * TP + t] = e3;
                                VT4[base + i4] = e0; VT4[base + TP + i4] = e1; VT4[base + 2 * TP + i4] = e2; VT4[base + 3 * TP + i4] = e3;
                                VT16[base + i16] = e0; VT16[base + TP + i16] = e1; VT16[base + 2 * TP + i16] = e2; VT16[base + 3 * TP + i16] = e3;
                            } else {
                                *(float4*)(snewv + (size_t)(b * TS + t) * 512 + col) = make_float4(v[0], v[1], v[2], v[3]);
                            }
                        }
                }
            }
    }
};
struct EpiDag {
    static constexpr bool PERM = false, AFTER_DRAIN = false;
    bf16_t* dag; const float* w0; const float* a0;
    __device__ __forceinline__ void operator()(const f32x4 (&acc)[2][2][4][2], const pg8::Unit& u, int wr, int wc, int fr, int fq) const {
        const int kind = u.pn >> 1;
#pragma unroll
        for (int bj = 0; bj < 2; ++bj)
#pragma unroll
            for (int n = 0; n < 2; ++n) {
                const int col = u.pn * 256 + bj * 128 + wc * 32 + n * 16 + 4 * fq;
                float4 bias = make_float4(0.f, 0.f, 0.f, 0.f);
                if (kind == 0) bias = *(const float4*)(w0 + col); else if (kind == 1) bias = *(const float4*)(a0 + col - 512);
                const float bb[4] = {bias.x, bias.y, bias.z, bias.w};
#pragma unroll
                for (int ai = 0; ai < 2; ++ai)
#pragma unroll
                    for (int m = 0; m < 4; ++m) { const int row = u.pm * 256 + ai * 128 + wr * 64 + m * 16 + fr; const f32x4 v = acc[ai][bj][m][n]; float o[4];
#pragma unroll
                        for (int j = 0; j < 4; ++j) { const float x = v[j] + bb[j];
                            if (kind == 0) { const float z = -x; const float sp = fmaxf(z, 0.f) + __logf(1.f + __expf(-fabsf(z))); o[j] = -__expf(-sp - 0.5f); }
                            else if (kind == 1) o[j] = sigmoidf_(x);
                            else o[j] = x; }
                        uint2 q; q.x = pk2(o[0], o[1]); q.y = pk2(o[2], o[3]); *(uint2*)(dag + (size_t)row * NLORA + col) = q; }
            }
    }
};
struct EpiUp {
    static constexpr bool PERM = false, AFTER_DRAIN = false;
    bf16_t* U; bf16_t* halo; float* out;
    __device__ __forceinline__ void operator()(const f32x4 (&acc)[2][2][4][2], const pg8::Unit& u, int wr, int wc, int fr, int fq) const {
#pragma unroll
        for (int ai = 0; ai < 2; ++ai)
#pragma unroll
            for (int m = 0; m < 4; ++m) {
                const int row = u.pm * 256 + ai * 128 + wr * 64 + m * 16 + fr; const int col0 = u.pn * 256 + wc * 32 + 4 * fq;
                bf16_t* hrow = nullptr; float* frow = nullptr;
                if (row < MP) { const int t = row & (TP - 1);
                    if ((t & 31) >= 30) hrow = halo + ((size_t)((row >> 5) + 1) * 2 + ((t & 31) - 30)) * FF2;
                    if (t >= TP - 2) frow = out + O_PCONV + ((size_t)(row >> 12) * 2 + (t - (TP - 2))) * FF2;
                } else { const int s = row - MP, b = s >> 3, tt = s & 7; if (tt >= 6) frow = out + O_SCONV + ((size_t)b * 2 + (tt - 6)) * FF2; }
#pragma unroll
                for (int bj = 0; bj < 2; ++bj)
#pragma unroll
                    for (int n = 0; n < 2; ++n) { const f32x4 v = acc[ai][bj][m][n]; const int col = col0 + bj * 128 + n * 16;
                        uint2 o; o.x = pk2(v[0], v[1]); o.y = pk2(v[2], v[3]);
                        *(uint2*)(U + (size_t)row * FF2 + col) = o;
                        if (hrow) *(uint2*)(hrow + col) = o;
                        if (frow) *(float4*)(frow + col) = make_float4(v[0], v[1], v[2], v[3]); }
            }
    }
};

__device__ __forceinline__ int rowA_of(int rowB) { return rowB < MP ? rowB : MP + ((rowB - MP) >> 3) * 9 + 1 + ((rowB - MP) & 7); }
__device__ __forceinline__ void phase_alora(const Params& p, int tid, int G, int bid) {
    const bf16_t* PR = (const bf16_t*)(p.ws + WS_PROJRW); bf16_t* AL = (bf16_t*)(p.ws + WS_ALORA); const float* mu = p.in[I_MU];
    const int gt = bid * NTHREADS + tid, NT = G * NTHREADS;
    for (int i = gt; i < MB * 64; i += NT) {
        const int rowB = i >> 6, c = (i & 63) * 4, rowA = rowA_of(rowB);
        const uint2 cur = *(const uint2*)(PR + (size_t)rowA * RCOLS + 1536 + c);
        uint2 prv = make_uint2(0u, 0u);
        if (!(rowB < MP && (rowB & (TP - 1)) == 0)) prv = *(const uint2*)(PR + (size_t)(rowA - 1) * RCOLS + 1536 + c);
        const float4 m4 = *(const float4*)(mu + 1536 + c);
        float x[4] = {bflo(cur.x), bfhi(cur.x), bflo(cur.y), bfhi(cur.y)}; const float pv[4] = {bflo(prv.x), bfhi(prv.x), bflo(prv.y), bfhi(prv.y)}; const float mm[4] = {m4.x, m4.y, m4.z, m4.w};
#pragma unroll
        for (int j = 0; j < 4; ++j) { float v = x[j] + (pv[j] - x[j]) * mm[j];
            if (c < 64) v = tanhf(v); else if (c >= 128) v = sigmoidf_(v);
            x[j] = v; }
        uint2 o; o.x = pk2(x[0], x[1]); o.y = pk2(x[2], x[3]);
        *(uint2*)(AL + (size_t)rowB * KLORA + c) = o;
    }
}

constexpr int CH = 32;
constexpr int SST = 452;
constexpr int SI_W = 0, SI_A = 64, SI_B = 128, SI_K = 192, SI_WR = 256, SI_V = 320, SI_G = 384, SI_SC = 448;
struct PrepRegs { uint2 cr, ck, cv, pr, pk, pv, dw, da, dg; };
__device__ __forceinline__ void scan_item(const Params& p, LAS unsigned char* lds, int tid, bool sample, int b, int h) {
    const bf16_t* PR = (const bf16_t*)(p.ws + WS_PROJRW); const bf16_t* DAG = (const bf16_t*)((const unsigned char*)p.out + SC_B);
    bf16_t* MIX = (bf16_t*)((unsigned char*)p.out + SC_C);
    LAS float* buf0 = (LAS float*)lds; LAS float* buf1 = buf0 + CH * SST; LAS float* ybuf = buf1 + CH * SST;
    const int T = sample ? TS : TP;
    const int rowB0 = sample ? MP + b * TS : b * TP;
    const int rowA0 = sample ? MP + b * 9 + 1 : b * TP;
    const int nch = (T + CH - 1) / CH;
    const int ptl = tid >> 4, pj = (tid & 15) * 4, pc = h * 64 + pj;
    const int lane = tid & 63, wv = tid >> 6, rg = wv * 4 + (lane >> 4), cgi = lane & 15;
    float s0[4], s1[4];
    if (sample) {
        const float* S0 = p.in[I_SWKV] + ((size_t)(b * 8 + h) * 64 + 2 * rg) * 64 + 4 * cgi;
        const float4 a = *(const float4*)S0, c = *(const float4*)(S0 + 64);
        s0[0] = a.x; s0[1] = a.y; s0[2] = a.z; s0[3] = a.w; s1[0] = c.x; s1[1] = c.y; s1[2] = c.z; s1[3] = c.w;
    } else {
#pragma unroll
        for (int j = 0; j < 4; ++j) { s0[j] = 0.f; s1[j] = 0.f; }
    }
    PrepRegs R;
#define SCAN_LOAD(chunk) do { const int t_ = (chunk) * CH + ptl; if (t_ < T) { const size_t ra = (size_t)(rowA0 + t_) * RCOLS + pc; const size_t rb = (size_t)(rowB0 + t_) * NLORA + pc; \
        R.cr = *(const uint2*)(PR + ra); R.ck = *(const uint2*)(PR + ra + 512); R.cv = *(const uint2*)(PR + ra + 1024); \
        if (!sample && t_ == 0) { R.pr = make_uint2(0u, 0u); R.pk = R.pr; R.pv = R.pr; } \
        else { R.pr = *(const uint2*)(PR + ra - RCOLS); R.pk = *(const uint2*)(PR + ra - RCOLS + 512); R.pv = *(const uint2*)(PR + ra - RCOLS + 1024); } \
        R.dw = *(const uint2*)(DAG + rb); R.da = *(const uint2*)(DAG + rb + 512); R.dg = *(const uint2*)(DAG + rb + 1024); } } while (0)
#define SCAN_PREP(chunk, dstbuf) do { const int t_ = (chunk) * CH + ptl; if (t_ < T) { \
        const float4 mur = *(const float4*)(p.in[I_MU] + pc), muk = *(const float4*)(p.in[I_MU] + 512 + pc), muv = *(const float4*)(p.in[I_MU] + 1024 + pc); \
        const float4 kk4 = *(const float4*)(p.in[I_KK] + pc), ka4 = *(const float4*)(p.in[I_KA] + pc), rk4 = *(const float4*)(p.in[I_RK] + pc); \
        const float mr[4] = {mur.x, mur.y, mur.z, mur.w}, mk[4] = {muk.x, muk.y, muk.z, muk.w}, mv[4] = {muv.x, muv.y, muv.z, muv.w}; \
        const float kkc[4] = {kk4.x, kk4.y, kk4.z, kk4.w}, kac[4] = {ka4.x, ka4.y, ka4.z, ka4.w}, rkc[4] = {rk4.x, rk4.y, rk4.z, rk4.w}; \
        const float crr[4] = {bflo(R.cr.x), bfhi(R.cr.x), bflo(R.cr.y), bfhi(R.cr.y)}, ckk[4] = {bflo(R.ck.x), bfhi(R.ck.x), bflo(R.ck.y), bfhi(R.ck.y)}, cvv[4] = {bflo(R.cv.x), bfhi(R.cv.x), bflo(R.cv.y), bfhi(R.cv.y)}; \
        const float prr[4] = {bflo(R.pr.x), bfhi(R.pr.x), bflo(R.pr.y), bfhi(R.pr.y)}, pkk[4] = {bflo(R.pk.x), bfhi(R.pk.x), bflo(R.pk.y), bfhi(R.pk.y)}, pvv[4] = {bflo(R.pv.x), bfhi(R.pv.x), bflo(R.pv.y), bfhi(R.pv.y)}; \
        const float lw[4] = {bflo(R.dw.x), bfhi(R.dw.x), bflo(R.dw.y), bfhi(R.dw.y)}, aa[4] = {bflo(R.da.x), bfhi(R.da.x), bflo(R.da.y), bfhi(R.da.y)}, gg[4] = {bflo(R.dg.x), bfhi(R.dg.x), bflo(R.dg.y), bfhi(R.dg.y)}; \
        float r_[4], k_[4], v_[4], w_[4], kn[4], k2[4]; float nrm = 0.f; \
        _Pragma("unroll") for (int j = 0; j < 4; ++j) { r_[j] = crr[j] + (prr[j] - crr[j]) * mr[j]; k_[j] = ckk[j] + (pkk[j] - ckk[j]) * mk[j]; v_[j] = cvv[j] + (pvv[j] - cvv[j]) * mv[j]; \
            w_[j] = __expf(lw[j]); kn[j] = k_[j] * kkc[j]; nrm += kn[j] * kn[j]; k2[j] = k_[j] * (1.f + (aa[j] - 1.f) * kac[j]); } \
        nrm = row16_sum(nrm); const float inv = 1.f / fmaxf(sqrtf(nrm), 1e-12f); \
        float br = 0.f, kr = 0.f, rk = 0.f; float an[4], bn[4], wrr[4]; \
        _Pragma("unroll") for (int j = 0; j < 4; ++j) { const float kkn = kn[j] * inv; an[j] = -kkn; bn[j] = kkn * aa[j]; wrr[j] = w_[j] * r_[j]; br += bn[j] * r_[j]; kr += k2[j] * r_[j]; rk += r_[j] * k2[j] * rkc[j]; } \
        br = row16_sum(br); kr = row16_sum(kr); rk = row16_sum(rk); \
        LAS float* rec = (dstbuf) + ptl * SST; \
        *(LAS f32x4*)(rec + SI_W + pj) = (f32x4){w_[0], w_[1], w_[2], w_[3]}; *(LAS f32x4*)(rec + SI_A + pj) = (f32x4){an[0], an[1], an[2], an[3]}; \
        *(LAS f32x4*)(rec + SI_B + pj) = (f32x4){bn[0], bn[1], bn[2], bn[3]}; *(LAS f32x4*)(rec + SI_K + pj) = (f32x4){k2[0], k2[1], k2[2], k2[3]}; \
        *(LAS f32x4*)(rec + SI_WR + pj) = (f32x4){wrr[0], wrr[1], wrr[2], wrr[3]}; *(LAS f32x4*)(rec + SI_V + pj) = (f32x4){v_[0], v_[1], v_[2], v_[3]}; \
        *(LAS f32x4*)(rec + SI_G + pj) = (f32x4){gg[0], gg[1], gg[2], gg[3]}; \
        if ((tid & 15) == 0) *(LAS f32x4*)(rec + SI_SC) = (f32x4){br, kr, rk, 0.f}; } } while (0)

    SCAN_LOAD(0);
    SCAN_PREP(0, buf0);
    __syncthreads();
    for (int c = 0; c < nch; ++c) {
        LAS float* cur = (c & 1) ? buf1 : buf0; LAS float* nxt = (c & 1) ? buf0 : buf1;
        if (c + 1 < nch) SCAN_LOAD(c + 1);
        const int ns = (T - c * CH) < CH ? (T - c * CH) : CH;
        for (int tl = 0; tl < ns; ++tl) {
            const LAS float* rec = cur + tl * SST;
            const f32x4 w4 = *(const LAS f32x4*)(rec + SI_W + 4 * cgi), a4 = *(const LAS f32x4*)(rec + SI_A + 4 * cgi), b4 = *(const LAS f32x4*)(rec + SI_B + 4 * cgi);
            const f32x4 k4 = *(const LAS f32x4*)(rec + SI_K + 4 * cgi), r4 = *(const LAS f32x4*)(rec + SI_WR + 4 * cgi);
            const pg8::f32x2 v2 = *(const LAS pg8::f32x2*)(rec + SI_V + 2 * rg); const pg8::f32x2 sc = *(const LAS pg8::f32x2*)(rec + SI_SC);
            float da0 = s0[0] * a4.x + s0[1] * a4.y + s0[2] * a4.z + s0[3] * a4.w;
            float da1 = s1[0] * a4.x + s1[1] * a4.y + s1[2] * a4.z + s1[3] * a4.w;
            float dw0 = s0[0] * r4.x + s0[1] * r4.y + s0[2] * r4.z + s0[3] * r4.w;
            float dw1 = s1[0] * r4.x + s1[1] * r4.y + s1[2] * r4.z + s1[3] * r4.w;
            da0 = row16_sum(da0); da1 = row16_sum(da1); dw0 = row16_sum(dw0); dw1 = row16_sum(dw1);
            const float y0 = dw0 + da0 * sc.x + v2.x * sc.y, y1 = dw1 + da1 * sc.x + v2.y * sc.y;
            s0[0] = s0[0] * w4.x + (da0 * b4.x + v2.x * k4.x); s0[1] = s0[1] * w4.y + (da0 * b4.y + v2.x * k4.y);
            s0[2] = s0[2] * w4.z + (da0 * b4.z + v2.x * k4.z); s0[3] = s0[3] * w4.w + (da0 * b4.w + v2.x * k4.w);
            s1[0] = s1[0] * w4.x + (da1 * b4.x + v2.y * k4.x); s1[1] = s1[1] * w4.y + (da1 * b4.y + v2.y * k4.y);
            s1[2] = s1[2] * w4.z + (da1 * b4.z + v2.y * k4.z); s1[3] = s1[3] * w4.w + (da1 * b4.w + v2.y * k4.w);
            if (cgi == 0) *(LAS pg8::f32x2*)(ybuf + tl * 64 + 2 * rg) = (pg8::f32x2){y0, y1};
        }
        __syncthreads();
        if (ptl < ns) {
            const LAS float* rec = cur + ptl * SST;
            const f32x4 y4 = *(const LAS f32x4*)(ybuf + ptl * 64 + pj), v4 = *(const LAS f32x4*)(rec + SI_V + pj), g4 = *(const LAS f32x4*)(rec + SI_G + pj);
            const float rk = rec[SI_SC + 2];
            const float4 lw4 = *(const float4*)(p.in[I_LNW] + pc), lb4 = *(const float4*)(p.in[I_LNB] + pc);
            const float mean = row16_sum((y4.x + y4.y) + (y4.z + y4.w)) * (1.f / 64.f);
            const float d0 = y4.x - mean, d1 = y4.y - mean, d2 = y4.z - mean, d3 = y4.w - mean;
            const float var = row16_sum((d0 * d0 + d1 * d1) + (d2 * d2 + d3 * d3)) * (1.f / 64.f);
            const float rs = rsqrtf(var + 64e-5f);
            const float o0 = (d0 * rs * lw4.x + lb4.x + rk * v4.x) * g4.x, o1 = (d1 * rs * lw4.y + lb4.y + rk * v4.y) * g4.y;
            const float o2 = (d2 * rs * lw4.z + lb4.z + rk * v4.z) * g4.z, o3 = (d3 * rs * lw4.w + lb4.w + rk * v4.w) * g4.w;
            uint2 o; o.x = pk2(o0, o1); o.y = pk2(o2, o3);
            *(uint2*)(MIX + (size_t)(rowB0 + c * CH + ptl) * D + pc) = o;
        }
        if (c + 1 < nch) SCAN_PREP(c + 1, nxt);
        __syncthreads();
    }
#undef SCAN_LOAD
#undef SCAN_PREP
    float* So = p.out + (sample ? O_SWKV : O_PWKV) + ((size_t)(b * 8 + h) * 64 + 2 * rg) * 64 + 4 * cgi;
    *(float4*)So = make_float4(s0[0], s0[1], s0[2], s0[3]); *(float4*)(So + 64) = make_float4(s1[0], s1[1], s1[2], s1[3]);
}

__device__ __forceinline__ void attn_task(const Params& p, int task, int lane) {
    const bf16_t* Q = (const bf16_t*)(p.ws + WS_Q); const bf16_t* K = (const bf16_t*)(p.ws + WS_K);
    bf16_t* MIX = (bf16_t*)((unsigned char*)p.out + SC_C);
    const int b = task >> 11, h = (task >> 8) & 7, r16 = (task >> 4) & 15, ig = task & 15;
    const int li = lane & 15, g = lane >> 4;
    const int tq = r16 + 16 * (16 * ig + li);
    const bf16_t* qp = Q + (size_t)(b * TP + tq) * 512 + h * 64 + 8 * g;
    const bf16x8 qf0 = *(const bf16x8*)qp, qf1 = *(const bf16x8*)(qp + 32);
    float m_run = -1e30f, l_run = 0.f;
    f32x4 o[4];
#pragma unroll
    for (int i = 0; i < 4; ++i) o[i] = (f32x4){0.f, 0.f, 0.f, 0.f};
#pragma unroll 1
    for (int br = 0; br < 3; ++br) {
        int dd, r, uq0, Tdd; const bf16_t* VT;
        if (br == 0) { dd = 16; r = r16; uq0 = 16 * ig; Tdd = TP / 16; VT = (const bf16_t*)(p.ws + WS_VT16); }
        else if (br == 1) { dd = 4; r = r16 & 3; uq0 = (r16 >> 2) + 64 * ig; Tdd = TP / 4; VT = (const bf16_t*)(p.ws + WS_VT4); }
        else { dd = 1; r = 0; uq0 = r16 + 256 * ig; Tdd = TP; VT = (const bf16_t*)(p.ws + WS_VT1); }
        const int s = 16 / dd, uq = uq0 + s * li;
        int ulo = uq0 - 128; if (ulo < 0) ulo = 0; ulo &= ~31;
        const int uhi = uq0 + 15 * s;
        const bf16_t* Kb = K + ((size_t)b * TP + r) * 512 + h * 64 + 8 * g;
        const bf16_t* Vb = VT + ((size_t)(b * 8 + h) * 64 + li) * TP + (size_t)r * Tdd + 4 * g;
#pragma unroll 1
        for (int kt = ulo; kt <= uhi; kt += 32) {
            const bf16_t* kx = Kb + (size_t)(kt + li) * dd * 512; const bf16_t* ky = kx + (size_t)16 * dd * 512;
            const bf16x8 kx0 = *(const bf16x8*)kx, kx1 = *(const bf16x8*)(kx + 32), ky0 = *(const bf16x8*)ky, ky1 = *(const bf16x8*)(ky + 32);
            uint2 va[4], vb[4];
#pragma unroll
            for (int dt = 0; dt < 4; ++dt) { va[dt] = *(const uint2*)(Vb + (size_t)16 * dt * TP + kt); vb[dt] = *(const uint2*)(Vb + (size_t)16 * dt * TP + kt + 16); }
            f32x4 sx = (f32x4){0.f, 0.f, 0.f, 0.f}, sy = (f32x4){0.f, 0.f, 0.f, 0.f};
            sx = __builtin_amdgcn_mfma_f32_16x16x32_bf16(kx0, qf0, sx, 0, 0, 0); sx = __builtin_amdgcn_mfma_f32_16x16x32_bf16(kx1, qf1, sx, 0, 0, 0);
            sy = __builtin_amdgcn_mfma_f32_16x16x32_bf16(ky0, qf0, sy, 0, 0, 0); sy = __builtin_amdgcn_mfma_f32_16x16x32_bf16(ky1, qf1, sy, 0, 0, 0);
            float sv[8]; bool ok[8]; float tmax = -1e30f;
#pragma unroll
            for (int j = 0; j < 4; ++j) { const int dx = uq - (kt + 4 * g + j), dy = dx - 16;
                ok[j] = (unsigned)dx <= 128u; ok[4 + j] = (unsigned)dy <= 128u; sv[j] = ok[j] ? sx[j] : -1e30f; sv[4 + j] = ok[4 + j] ? sy[j] : -1e30f;
                tmax = fmaxf(tmax, fmaxf(sv[j], sv[4 + j])); }
            tmax = fmaxf(tmax, __shfl_xor(tmax, 16)); tmax = fmaxf(tmax, __shfl_xor(tmax, 32));
            const float m_new = fmaxf(m_run, tmax), alpha = __expf(m_run - m_new);
            float pe[8]; float ps = 0.f;
#pragma unroll
            for (int j = 0; j < 8; ++j) { pe[j] = ok[j] ? __expf(sv[j] - m_new) : 0.f; ps += pe[j]; }
            l_run = l_run * alpha + ps; m_run = m_new;
            u32x4 pw; pw[0] = pk2(pe[0], pe[1]); pw[1] = pk2(pe[2], pe[3]); pw[2] = pk2(pe[4], pe[5]); pw[3] = pk2(pe[6], pe[7]);
            const bf16x8 pf = __builtin_bit_cast(bf16x8, pw);
#pragma unroll
            for (int dt = 0; dt < 4; ++dt) {
                u32x4 vw; vw[0] = va[dt].x; vw[1] = va[dt].y; vw[2] = vb[dt].x; vw[3] = vb[dt].y;
                o[dt] *= alpha;
                o[dt] = __builtin_amdgcn_mfma_f32_16x16x32_bf16(__builtin_bit_cast(bf16x8, vw), pf, o[dt], 0, 0, 0);
            }
        }
    }
    float lt = l_run; lt += __shfl_xor(lt, 16); lt += __shfl_xor(lt, 32);
    const float il = 1.f / lt;
    bf16_t* op = MIX + (size_t)(b * TP + tq) * D + 512 + h * 64 + 4 * g;
#pragma unroll
    for (int dt = 0; dt < 4; ++dt) { uint2 w; w.x = pk2(o[dt][0] * il, o[dt][1] * il); w.y = pk2(o[dt][2] * il, o[dt][3] * il); *(uint2*)(op + 16 * dt) = w; }
}
__device__ __forceinline__ void attn_sample_task(const Params& p, int task, int lane, LAS float* wl) {
    const bf16_t* Q = (const bf16_t*)(p.ws + WS_Q); const float* snewk = (const float*)(p.ws + WS_SNEWK); const float* snewv = (const float*)(p.ws + WS_SNEWV);
    const float* CK = p.in[I_CK]; const float* CV = p.in[I_CV];
    bf16_t* MIX = (bf16_t*)((unsigned char*)p.out + SC_C);
    const int b = task >> 6, h = (task >> 3) & 7, tt = task & 7;
    const int rowB = MP + b * TS + tt;
    asm volatile("s_waitcnt lgkmcnt(0)" ::: "memory");
    wl[lane] = bflo((u32)Q[(size_t)rowB * 512 + h * 64 + lane]);
    asm volatile("s_waitcnt lgkmcnt(0)" ::: "memory");
    float mx = -1e30f;
#pragma unroll 1
    for (int c = 0; c < 9; ++c) {
        const int br = c / 3, it = c - br * 3; const int dd = br == 0 ? 1 : (br == 1 ? 4 : 16); const int j = lane + 64 * it;
        const int jc = j <= 128 ? j : 128;
        const int idx = 2048 + tt - jc * dd;
        const float* kr = idx < 2048 ? CK + ((size_t)(b * 2048 + idx) * 8 + h) * 64 : snewk + (size_t)(b * TS + idx - 2048) * 512 + h * 64;
        float s = 0.f;
#pragma unroll
        for (int d4 = 0; d4 < 16; ++d4) { const float4 kv = *(const float4*)(kr + 4 * d4); const f32x4 qv = *(const LAS f32x4*)(wl + 4 * d4);
            s += kv.x * qv[0] + kv.y * qv[1] + kv.z * qv[2] + kv.w * qv[3]; }
        if (j > 128) s = -1e30f;
        wl[64 + c * 64 + lane] = s; mx = fmaxf(mx, s);
    }
#pragma unroll
    for (int o = 1; o < 64; o <<= 1) mx = fmaxf(mx, __shfl_xor(mx, o));
    asm volatile("s_waitcnt lgkmcnt(0)" ::: "memory");
    float ls = 0.f;
#pragma unroll 1
    for (int c = 0; c < 9; ++c) { const float s = wl[64 + c * 64 + lane]; const float e = s > -1e29f ? __expf(s - mx) : 0.f; wl[64 + c * 64 + lane] = e; ls += e; }
    ls = wave_sum(ls);
    asm volatile("s_waitcnt lgkmcnt(0)" ::: "memory");
    float acc = 0.f;
#pragma unroll 1
    for (int c = 0; c < 9; ++c) {
        const int br = c / 3, it = c - br * 3; const int dd = br == 0 ? 1 : (br == 1 ? 4 : 16); const int nj = it < 2 ? 64 : 1;
#pragma unroll 8
        for (int l2 = 0; l2 < nj; ++l2) {
            const int j = l2 + 64 * it; const int idx = 2048 + tt - j * dd;
            const float* vr = idx < 2048 ? CV + ((size_t)(b * 2048 + idx) * 8 + h) * 64 : snewv + (size_t)(b * TS + idx - 2048) * 512 + h * 64;
            acc += wl[64 + c * 64 + l2] * vr[lane];
        }
    }
    const float res = acc / ls;
    const float other = __shfl_xor(res, 1);
    if ((lane & 1) == 0) *(u32*)(MIX + (size_t)rowB * D + 512 + h * 64 + lane) = pk2(res, other);
}

__device__ __forceinline__ void phase_norm1(const Params& p, int tid, int G, int bid) {
    const int wave = tid >> 6, lane = tid & 63, gw = bid * 8 + wave, NGW = G * 8;
    const float* mix = (const float*)((const unsigned char*)p.out + SC_B); bf16_t* H2 = (bf16_t*)((unsigned char*)p.out + SC_C);
    for (int row = gw; row < MB; row += NGW) {
        const float* xrow = row < MP ? p.in[I_XP] + (size_t)row * D : p.in[I_XS] + (size_t)(row - MP) * D;
        const float4* mr = (const float4*)(mix + (size_t)row * D) + lane; const float4* xr = (const float4*)xrow + lane;
        float4 v[4], x[4]; float s = 0.f;
#pragma unroll
        for (int j = 0; j < 4; ++j) { v[j] = mr[64 * j]; x[j] = xr[64 * j]; s += (v[j].x * v[j].x + v[j].y * v[j].y) + (v[j].z * v[j].z + v[j].w * v[j].w); }
        const float rs = rsqrtf(wave_sum(s) * (1.f / D) + 1e-6f);
        float s2 = 0.f;
#pragma unroll
        for (int j = 0; j < 4; ++j) { const float4 gg = *((const float4*)p.in[I_NMPOST] + lane + 64 * j);
            x[j].x += v[j].x * rs * gg.x; x[j].y += v[j].y * rs * gg.y; x[j].z += v[j].z * rs * gg.z; x[j].w += v[j].w * rs * gg.w;
            s2 += (x[j].x * x[j].x + x[j].y * x[j].y) + (x[j].z * x[j].z + x[j].w * x[j].w);
            *((float4*)(p.out + (size_t)row * D) + lane + 64 * j) = x[j]; }
        const float rs2 = rsqrtf(wave_sum(s2) * (1.f / D) + 1e-6f);
#pragma unroll
        for (int j = 0; j < 4; ++j) { const float4 gg = *((const float4*)p.in[I_NFPRE] + lane + 64 * j);
            uint2 o; o.x = pk2(x[j].x * rs2 * gg.x, x[j].y * rs2 * gg.y); o.y = pk2(x[j].z * rs2 * gg.z, x[j].w * rs2 * gg.w);
            *((uint2*)(H2 + (size_t)row * D) + lane + 64 * j) = o; }
    }
}
__device__ __forceinline__ void phase_act(const Params& p, int tid, int G, int bid) {
    const int wave = tid >> 6, lane = tid & 63, gw = bid * 8 + wave, NGW = G * 8;
    bf16_t* U = (bf16_t*)(p.ws + WS_U); const bf16_t* halo = (const bf16_t*)(p.ws + WS_HALO);
    const float* cw = p.in[I_CONVW]; const float* cb = p.in[I_CONVB];
    constexpr int NPI = (MP / 32) * 11, NSI = BS * 11;
    for (int it = gw; it < NPI + NSI; it += NGW) {
        const bool sample = it >= NPI; const int q = sample ? it - NPI : it; const int chunk = q / 11, cgp = q - chunk * 11;
        const int col = cgp * 256 + 4 * lane;
        const float4 wg0 = *(const float4*)(cw + col), wg1 = *(const float4*)(cw + FF2 + col), wg2 = *(const float4*)(cw + 2 * FF2 + col), bg = *(const float4*)(cb + col);
        const float4 wu0 = *(const float4*)(cw + FF + col), wu1 = *(const float4*)(cw + FF2 + FF + col), wu2 = *(const float4*)(cw + 2 * FF2 + FF + col), bu = *(const float4*)(cb + FF + col);
        float g2[4], g1[4], u2[4], u1[4];
        int row0, nrows;
        if (!sample) {
            row0 = chunk * 32; nrows = 32;
            if ((row0 & (TP - 1)) == 0) {
#pragma unroll
                for (int j = 0; j < 4; ++j) { g2[j] = 0.f; g1[j] = 0.f; u2[j] = 0.f; u1[j] = 0.f; }
            } else {
                const bf16_t* hp = halo + (size_t)chunk * 2 * FF2;
                const uint2 a = *(const uint2*)(hp + col), c2 = *(const uint2*)(hp + FF2 + col), e = *(const uint2*)(hp + FF + col), f = *(const uint2*)(hp + FF2 + FF + col);
                g2[0] = bflo(a.x); g2[1] = bfhi(a.x); g2[2] = bflo(a.y); g2[3] = bfhi(a.y); g1[0] = bflo(c2.x); g1[1] = bfhi(c2.x); g1[2] = bflo(c2.y); g1[3] = bfhi(c2.y);
                u2[0] = bflo(e.x); u2[1] = bfhi(e.x); u2[2] = bflo(e.y); u2[3] = bfhi(e.y); u1[0] = bflo(f.x); u1[1] = bfhi(f.x); u1[2] = bflo(f.y); u1[3] = bfhi(f.y);
            }
        } else {
            row0 = MP + chunk * TS; nrows = TS;
            const float* sp = p.in[I_SCONV] + (size_t)chunk * 2 * FF2;
            const float4 a = *(const float4*)(sp + col), c2 = *(const float4*)(sp + FF2 + col), e = *(const float4*)(sp + FF + col), f = *(const float4*)(sp + FF2 + FF + col);
            g2[0] = a.x; g2[1] = a.y; g2[2] = a.z; g2[3] = a.w; g1[0] = c2.x; g1[1] = c2.y; g1[2] = c2.z; g1[3] = c2.w;
            u2[0] = e.x; u2[1] = e.y; u2[2] = e.z; u2[3] = e.w; u1[0] = f.x; u1[1] = f.y; u1[2] = f.z; u1[3] = f.w;
        }
        const float w0g[4] = {wg0.x, wg0.y, wg0.z, wg0.w}, w1g[4] = {wg1.x, wg1.y, wg1.z, wg1.w}, w2g[4] = {wg2.x, wg2.y, wg2.z, wg2.w}, bgg[4] = {bg.x, bg.y, bg.z, bg.w};
        const float w0u[4] = {wu0.x, wu0.y, wu0.z, wu0.w}, w1u[4] = {wu1.x, wu1.y, wu1.z, wu1.w}, w2u[4] = {wu2.x, wu2.y, wu2.z, wu2.w}, buu[4] = {bu.x, bu.y, bu.z, bu.w};
        for (int r0 = 0; r0 < nrows; r0 += 8) {
            uint2 gv[8], uv[8];
#pragma unroll
            for (int i = 0; i < 8; ++i) { const bf16_t* rp = U + (size_t)(row0 + r0 + i) * FF2 + col; gv[i] = *(const uint2*)rp; uv[i] = *(const uint2*)(rp + FF); }
#pragma unroll
            for (int i = 0; i < 8; ++i) {
                const float gc[4] = {bflo(gv[i].x), bfhi(gv[i].x), bflo(gv[i].y), bfhi(gv[i].y)}, uc[4] = {bflo(uv[i].x), bfhi(uv[i].x), bflo(uv[i].y), bfhi(uv[i].y)};
                float o[4];
#pragma unroll
                for (int j = 0; j < 4; ++j) {
                    const float cgv = w0g[j] * g2[j] + w1g[j] * g1[j] + w2g[j] * gc[j] + bgg[j];
                    const float cuv = w0u[j] * u2[j] + w1u[j] * u1[j] + w2u[j] * uc[j] + buu[j];
                    o[j] = cgv * sigmoidf_(cgv) * cuv;
                    g2[j] = g1[j]; g1[j] = gc[j]; u2[j] = u1[j]; u1[j] = uc[j];
                }
                uint2 w; w.x = pk2(o[0], o[1]); w.y = pk2(o[2], o[3]);
                *(uint2*)(U + (size_t)(row0 + r0 + i) * FF2 + col) = w;
            }
        }
    }
}
__device__ __forceinline__ void phase_final(const Params& p, int tid, int G, int bid) {
    const int wave = tid >> 6, lane = tid & 63, gw = bid * 8 + wave, NGW = G * 8;
    const float* F = (const float*)(p.ws + WS_U) + FF / 2;
    for (int row = gw; row < MB; row += NGW) {
        const float4* fr = (const float4*)(F + (size_t)row * (FF2 / 2)) + lane; float4* yr = (float4*)(p.out + (size_t)row * D) + lane;
        float4 v[4]; float s = 0.f;
#pragma unroll
        for (int j = 0; j < 4; ++j) { v[j] = fr[64 * j]; s += (v[j].x * v[j].x + v[j].y * v[j].y) + (v[j].z * v[j].z + v[j].w * v[j].w); }
        const float rs = rsqrtf(wave_sum(s) * (1.f / D) + 1e-6f);
#pragma unroll
        for (int j = 0; j < 4; ++j) { const float4 gg = *((const float4*)p.in[I_NFPOST] + lane + 64 * j); float4 x = yr[64 * j];
            x.x += v[j].x * rs * gg.x; x.y += v[j].y * rs * gg.y; x.z += v[j].z * rs * gg.z; x.w += v[j].w * rs * gg.w; yr[64 * j] = x; }
    }
}
__device__ __forceinline__ void phase_cachecopy(const Params& p, int tid, int G, int bid) {
    const int gt = bid * NTHREADS + tid, NT = G * NTHREADS;
    constexpr int PER_B = 2048 * 512 / 4;
    const float4* snk = (const float4*)(p.ws + WS_SNEWK); const float4* snv = (const float4*)(p.ws + WS_SNEWV);
    for (int i = gt; i < 2 * BS * PER_B; i += NT) {
        const int which = i >= BS * PER_B; const int q = which ? i - BS * PER_B : i; const int b = q / PER_B, r = q - b * PER_B;
        const float4* src = (const float4*)p.in[which ? I_CV : I_CK] + (size_t)b * PER_B;
        float4 v;
        if (r < 2040 * 128) v = src[r + 8 * 128]; else v = (which ? snv : snk)[(size_t)b * TS * 128 + (r - 2040 * 128)];
        ((float4*)(p.out + (which ? O_SV : O_SK)))[(size_t)b * PER_B + r] = v;
    }
}

__global__ void __launch_bounds__(NTHREADS, 2) hymba_fwd(Params p) {
    extern __shared__ __attribute__((aligned(16))) unsigned char lds_raw[];
    LAS unsigned char* lds = (LAS unsigned char*)lds_raw;
    cg::grid_group grid = cg::this_grid();
    const int tid = threadIdx.x, G = gridDim.x, bid = blockIdx.x;
    const int lo = p.ph_lo, hi = p.ph_hi;
#ifdef DBG_ONLY
#define IN(k) ((k) == DBG_ONLY && lo <= (k) && (k) < hi)
#else
#define IN(k) (lo <= (k) && (k) < hi)
#endif
#define SEAM(k) do { if (IN(k) && IN((k) + 1)) grid.sync(); } while (0)
    if (IN(0)) { phase0(p, lds, tid, G, bid); __syncthreads(); }
    SEAM(0);
    if (IN(1)) {
        pg8::Gemm g{(const bf16_t*)((const unsigned char*)p.out + SC_B), (const bf16_t*)(p.ws + WS_WIN), MA, DIN, D, D}; pg8::StaticOrder S; S.init(MA, DIN, G, bid);
        EpiProj E{(bf16_t*)(p.ws + WS_PROJRW), (bf16_t*)(p.ws + WS_Q), (bf16_t*)(p.ws + WS_K), (bf16_t*)(p.ws + WS_VT1), (bf16_t*)(p.ws + WS_VT4), (bf16_t*)(p.ws + WS_VT16),
                  (const float*)(p.ws + WS_ROPE), p.out, (float*)(p.ws + WS_SNEWK), (float*)(p.ws + WS_SNEWV)};
        pg8::gemm_phase<EpiProj, pg8::StaticOrder, false>(lds, g, S, E, nullptr);
    }
    SEAM(1);
    if (IN(2)) phase_alora(p, tid, G, bid);
    SEAM(2);
    if (IN(3)) {
        pg8::Gemm g{(const bf16_t*)(p.ws + WS_ALORA), (const bf16_t*)(p.ws + WS_WLORA), MB, NLORA, KLORA, KLORA}; pg8::StaticOrder S; S.init(MB, NLORA, G, bid);
        EpiDag E{(bf16_t*)((unsigned char*)p.out + SC_B), p.in[I_W0], p.in[I_A0]};
        pg8::gemm_phase<EpiDag, pg8::StaticOrder, false>(lds, g, S, E, nullptr);
    }
    SEAM(3);
    if (IN(4)) {
        const int NSCAN = G >= 128 ? 64 : (G / 2 > 0 ? G / 2 : 1);
        if (bid < NSCAN) {
            #ifndef DBG_NOSCAN
            for (int it = bid; it < 64 + 256; it += NSCAN) { const bool smp = it >= 64; const int q = smp ? it - 64 : it; scan_item(p, lds, tid, smp, q >> 3, q & 7); }
#endif
        } else {
            const int wave = tid >> 6, lane = tid & 63, aw = (bid - NSCAN) * 8 + wave, NAW = (G - NSCAN) * 8;
            for (int t = aw; t < 16384 + 2048; t += NAW) {
#ifndef DBG_NOATT
                if (t < 16384) attn_task(p, t, lane);
#endif
#ifndef DBG_NOSATT
                if (t >= 16384) attn_sample_task(p, t - 16384, lane, (LAS float*)(lds + wave * 4096));
#endif
            }
        }
    }
    SEAM(4);
    if (IN(5)) {
        pg8::Gemm g{(const bf16_t*)((const unsigned char*)p.out + SC_C), (const bf16_t*)(p.ws + WS_WOUT), MB, D, D, D}; pg8::StaticOrder S; S.init(MB, D, G, bid);
        pg8::EpiF32 E{(float*)((unsigned char*)p.out + SC_B), D, nullptr};
        pg8::gemm_phase<pg8::EpiF32, pg8::StaticOrder, false>(lds, g, S, E, nullptr);
    }
    SEAM(5);
    if (IN(6)) phase_norm1(p, tid, G, bid);
    SEAM(6);
    if (IN(7)) {
        pg8::Gemm g{(const bf16_t*)((const unsigned char*)p.out + SC_C), (const bf16_t*)(p.ws + WS_WUP), MB, FF2, D, D}; pg8::StaticOrder S; S.init(MB, FF2, G, bid);
        EpiUp E{(bf16_t*)(p.ws + WS_U), (bf16_t*)(p.ws + WS_HALO), p.out};
        pg8::gemm_phase<EpiUp, pg8::StaticOrder, false>(lds, g, S, E, nullptr);
    }
    SEAM(7);
    if (IN(8)) phase_act(p, tid, G, bid);
    SEAM(8);
    if (IN(9)) {
        pg8::Gemm g{(const bf16_t*)(p.ws + WS_U), (const bf16_t*)(p.ws + WS_WDN), MB, D, FF, FF2}; pg8::StaticOrder S; S.init(MB, D, G, bid);
        pg8::EpiF32 E{(float*)(p.ws + WS_U) + FF / 2, FF2 / 2, nullptr};
        pg8::gemm_phase<pg8::EpiF32, pg8::StaticOrder, false>(lds, g, S, E, nullptr);
    }
    SEAM(9);
    if (IN(10)) { phase_final(p, tid, G, bid); phase_cachecopy(p, tid, G, bid); }
#undef IN
#undef SEAM
}

constexpr int NPHASES = 11;
#ifndef MK_SPLIT
#define MK_SPLIT 0
#endif
extern "C" void kernel_launch(void* const* d_in, const int* in_sizes, int n_in, void* d_out, int out_size, void* d_ws, size_t ws_size, hipStream_t stream) {
    static int grid = 0;
    if (grid == 0) {
        if (n_in != 28 || (size_t)out_size != O_END || ws_size < WS_END) { fprintf(stderr, "kernel_launch: unexpected sizes n_in %d out %d ws %zu (need %zu)\n", n_in, out_size, ws_size, (size_t)WS_END); grid = -1; return; }
        int dev = 0, cus = 0, per_cu = 0;
        hipGetDevice(&dev); hipDeviceGetAttribute(&cus, hipDeviceAttributeMultiprocessorCount, dev);
        if (hipFuncSetAttribute((const void*)hymba_fwd, hipFuncAttributeMaxDynamicSharedMemorySize, LDS_BYTES) != hipSuccess) { fprintf(stderr, "kernel_launch: hipFuncSetAttribute failed\n"); grid = -1; return; }
        hipOccupancyMaxActiveBlocksPerMultiprocessor(&per_cu, (const void*)hymba_fwd, NTHREADS, LDS_BYTES);
        (void)hipGetLastError();
        if (per_cu < 1) per_cu = 1;
        grid = cus;
    }
    if (grid < 0) return;
    Params p{};
    for (int i = 0; i < 28; ++i) p.in[i] = (const float*)d_in[i];
    p.out = (float*)d_out; p.ws = (unsigned char*)d_ws;
#if MK_SPLIT
    for (int k = 0; k < NPHASES; ++k) { p.ph_lo = k; p.ph_hi = k + 1; hipLaunchKernelGGL(hymba_fwd, dim3(grid), dim3(NTHREADS), LDS_BYTES, stream, p); }
#else
    p.ph_lo = 0; p.ph_hi = NPHASES;
    void* args[] = {&p};
    hipError_t e = hipLaunchCooperativeKernel((const void*)hymba_fwd, dim3(grid), dim3(NTHREADS), args, LDS_BYTES, stream);
    if (e != hipSuccess) fprintf(stderr, "cooperative launch failed: %s (grid %d)\n", hipGetErrorString(e), grid);
#endif
}
```

```cpp
#include <hip/hip_runtime.h>
#include <hip/hip_cooperative_groups.h>
#include <cstdio>
#include <cstdint>
namespace pg8 {
#define PG8_LAS __attribute__((address_space(3)))
typedef unsigned short bf16_t;
typedef short bf16x8 __attribute__((ext_vector_type(8)));
typedef float f32x4 __attribute__((ext_vector_type(4)));
typedef unsigned u32x4 __attribute__((ext_vector_type(4)));
constexpr int BM = 256, BK = 64, HALF = 128, HTB = HALF * BK * 2  , STAGE_BYTES = 8 * HTB, NXCD = 8, WGM = 8;

__host__ __device__ __forceinline__ int lds_byte(int r, int c) { const int st = (r >> 4) * 2 + (c >> 5), rr = r & 15, cc = c & 31, ob = rr * 64 + cc * 2; return st * 1024 + (ob ^ (((ob >> 9) & 1) << 5)); }
__host__ __device__ __forceinline__ void stage_rc(int b, int& R, int& C) { const int st = b / 1024, sb = b % 1024, swz = sb ^ (((sb >> 9) & 1) << 5); R = (st >> 1) * 16 + swz / 64; C = (st & 1) * 32 + (swz % 64) / 2; }
__host__ __device__ __forceinline__ int perm32(int rho) { const int n = rho >> 4, i = rho & 15; return 8 * (i >> 2) + 4 * n + (i & 3); }

struct Unit { int pm, pn; };
struct Gemm { const bf16_t* A; const bf16_t* Bt; int M, N, K, lda; };

struct StaticOrder {
    int nM, nN, nwg, G, c;
    __host__ __device__ void init(int M, int N, int G_, int c_) { nM = M / BM; nN = N / BM; nwg = nM * nN; G = G_; c = c_; }
    __host__ __device__ bool next(int i, Unit& u) const {
        const long L = (long)i * G + c; if (L >= nwg) return false;
        int wgid = (int)L; { const int q = nwg / NXCD, r = nwg % NXCD, xcd = wgid % NXCD, off = wgid / NXCD; wgid = (xcd < r ? xcd * (q + 1) : r * (q + 1) + (xcd - r) * q) + off; }
        const int nig = WGM * nN, gid = wgid / nig, fm = gid * WGM, gsz = (nM - fm) < WGM ? (nM - fm) : WGM;
        u.pm = fm + ((wgid % nig) % gsz); u.pn = (wgid % nig) / gsz; return true;
    }
    __device__ __forceinline__ void a_ready(const Unit&) const {}
    __device__ __forceinline__ void done(const Unit&) const {}
};
__device__ __forceinline__ unsigned cvt_pk_bf16(float lo, float hi) { unsigned r; asm volatile("v_cvt_pk_bf16_f32 %0, %1, %2" : "=v"(r) : "v"(lo), "v"(hi)); return r; }
typedef float f32x2 __attribute__((ext_vector_type(2)));
struct EpiF32 {
    static constexpr bool PERM = false, AFTER_DRAIN = false;
    float* C; int ldc; const float* bias;
    __device__ __forceinline__ void operator()(const f32x4 (&acc)[2][2][4][2], const Unit& u, int wr, int wc, int fr, int fq) const {
        const int row0 = u.pm * BM + wr * 64 + fr, col0 = u.pn * BM + wc * 32 + 4 * fq;
        f32x4 bv[2][2];
#pragma unroll
        for (int bj = 0; bj < 2; ++bj)
#pragma unroll
            for (int n = 0; n < 2; ++n) bv[bj][n] = bias ? *(const f32x4*)(bias + col0 + bj * HALF + n * 16) : (f32x4){0.f, 0.f, 0.f, 0.f};
#pragma unroll
        for (int ai = 0; ai < 2; ++ai)
#pragma unroll
            for (int m = 0; m < 4; ++m) { float* rowp = C + (size_t)(row0 + ai * HALF + m * 16) * ldc + col0;
#pragma unroll
                for (int bj = 0; bj < 2; ++bj)
#pragma unroll
                    for (int n = 0; n < 2; ++n) *(f32x4*)(rowp + bj * HALF + n * 16) = acc[ai][bj][m][n] + bv[bj][n]; }
    }
};
template <class Epi, class Sched, bool STAMP = false>
__device__ __forceinline__ void gemm_phase(PG8_LAS unsigned char* lds, const Gemm g, const Sched& S, const Epi& E, unsigned long long* stamps) {
    const int tid = threadIdx.x, wid = __builtin_amdgcn_readfirstlane(tid >> 6), lane = tid & 63, wr = wid >> 2, wc = wid & 3, fr = lane & 15, fq = lane >> 4;
    const int K = g.K, nt = K / BK;
    int ts_lo = 0, ts_hi = 0, nts = 0; const unsigned long long rt_entry = STAMP ? (unsigned long long)wall_clock64() : 0ull;
#define PG8_STAMP() do { if (STAMP && wid == 0 && nts < 64) { const unsigned long long _c = (unsigned long long)clock64(); \
        ts_lo = (lane == nts) ? (int)(unsigned)_c : ts_lo; ts_hi = (lane == nts) ? (int)(unsigned)(_c >> 32) : ts_hi; ++nts; } } while (0)
    PG8_STAMP();
    unsigned voffA[2], voffB[2];
#pragma unroll
    for (int i = 0; i < 2; ++i) { int R, C; stage_rc(tid * 16 + i * 8192, R, C); const int Rb = Epi::PERM ? ((R & ~31) + perm32(R & 31)) : R;
        voffA[i] = (unsigned)(R * g.lda + C) * 2u; voffB[i] = (unsigned)(Rb * K + C) * 2u; }
    const size_t kstep = (size_t)(BK * 2);
    const size_t hstep = (size_t)HALF * K * 2, hstepA = (size_t)HALF * g.lda * 2;
    const size_t tstep = 2 * hstep, tstepA = 2 * hstepA;
    const unsigned ldsw = (unsigned)wid * 1024u;
    const int aoff = lds_byte(wr * 64 + fr, fq * 8), boff = lds_byte(wc * 32 + fr, fq * 8);
#define PG8_SA(b, h) (((b) * 2 + (h)) * HTB)
#define PG8_SB(b, h) ((4 + (b) * 2 + (h)) * HTB)
#define PG8_STAGE(bufoff, gbase, voff) do { _Pragma("unroll") for (int _i = 0; _i < 2; ++_i) \
        __builtin_amdgcn_global_load_lds((const unsigned*)((const char*)(gbase) + (voff)[_i]), (PG8_LAS unsigned*)(lds + (bufoff) + ldsw + _i * 8192), 16, 0, 0); } while (0)
#define PG8_LDA(dst, b, h) do { _Pragma("unroll") for (int m = 0; m < 4; ++m) _Pragma("unroll") for (int k = 0; k < 2; ++k) dst[m][k] = *(const PG8_LAS bf16x8*)(lds + PG8_SA(b, h) + aoff + m * 2048 + k * 1024); } while (0)
#define PG8_LDB(dst, b, h) do { _Pragma("unroll") for (int n = 0; n < 2; ++n) _Pragma("unroll") for (int k = 0; k < 2; ++k) dst[n][k] = *(const PG8_LAS bf16x8*)(lds + PG8_SB(b, h) + boff + n * 2048 + k * 1024); } while (0)
#define PG8_MMA(ai, bj, At, Bt) do { __builtin_amdgcn_s_setprio(1); _Pragma("unroll") for (int m = 0; m < 4; ++m) _Pragma("unroll") for (int n = 0; n < 2; ++n) _Pragma("unroll") for (int k = 0; k < 2; ++k) \
        acc[ai][bj][m][n] = __builtin_amdgcn_mfma_f32_16x16x32_bf16(Bt[n][k], At[m][k], acc[ai][bj][m][n], 0, 0, 0); __builtin_amdgcn_s_setprio(0); } while (0)
#define PG8_WAIT_V(n) asm volatile("s_waitcnt vmcnt(" #n ")" ::: "memory")
#define PG8_WAIT_L(n) asm volatile("s_waitcnt lgkmcnt(" #n ")" ::: "memory")
#define PG8_BAR __builtin_amdgcn_s_barrier()
#define PG8_SCHED __builtin_amdgcn_sched_barrier(0)
    Unit cur, nxt; int ui = 0;
    if (!S.next(0, cur)) return;
    f32x4 acc[2][2][4][2];
#pragma unroll
    for (int a = 0; a < 2; ++a)
#pragma unroll
        for (int b = 0; b < 2; ++b)
#pragma unroll
            for (int m = 0; m < 4; ++m)
#pragma unroll
                for (int n = 0; n < 2; ++n) acc[a][b][m][n] = (f32x4){0.f, 0.f, 0.f, 0.f};
    bf16x8 At[4][2], B0[2][2], B1[2][2];
    const char* cA = (const char*)g.A + (size_t)cur.pm * tstepA; const char* cB = (const char*)g.Bt + (size_t)cur.pn * tstep;
    S.a_ready(cur);
    PG8_STAGE(PG8_SB(0, 0), cB, voffB); PG8_STAGE(PG8_SA(0, 0), cA, voffA); PG8_STAGE(PG8_SB(0, 1), cB + hstep, voffB); PG8_STAGE(PG8_SA(0, 1), cA + hstepA, voffA);
    if (wr == 1) PG8_BAR;
    PG8_WAIT_V(4); PG8_BAR;
    PG8_STAGE(PG8_SB(1, 0), cB + kstep, voffB); PG8_STAGE(PG8_SA(1, 0), cA + kstep, voffA); PG8_STAGE(PG8_SB(1, 1), cB + hstep + kstep, voffB);
    PG8_WAIT_V(6); PG8_BAR;
    PG8_STAMP();
    for (;;) {
        const bool has_next = S.next(ui + 1, nxt);
        const char* nA = has_next ? (const char*)g.A + (size_t)nxt.pm * tstepA : cA; const char* nB = has_next ? (const char*)g.Bt + (size_t)nxt.pn * tstep : cB;
        for (int t = 0; t < nt; t += 2) {
            const bool last = (t == nt - 2);
            const char* a1 = cA + (size_t)(t + 1) * kstep;
            const char* a2 = last ? nA : cA + (size_t)(t + 2) * kstep; const char* b2 = last ? nB : cB + (size_t)(t + 2) * kstep;
            const char* a3 = a2 + kstep; const char* b3 = b2 + kstep;
            if (last && has_next) S.a_ready(nxt);
            PG8_LDB(B0, 0, 0); PG8_SCHED; PG8_LDA(At, 0, 0); PG8_STAGE(PG8_SA(1, 1), a1 + hstepA, voffA);
            PG8_WAIT_L(8); PG8_BAR; PG8_WAIT_L(0); PG8_MMA(0, 0, At, B0); PG8_BAR; PG8_SCHED;
            PG8_LDB(B1, 0, 1); PG8_STAGE(PG8_SB(0, 0), b2, voffB);
            PG8_BAR; PG8_WAIT_L(0); PG8_MMA(0, 1, At, B1); PG8_BAR;
            PG8_LDA(At, 0, 1); PG8_STAGE(PG8_SA(0, 0), a2, voffA);
            PG8_BAR; PG8_WAIT_L(0); PG8_MMA(1, 0, At, B0); PG8_BAR; PG8_SCHED;
            PG8_STAGE(PG8_SB(0, 1), b2 + hstep, voffB);
            PG8_WAIT_V(6); PG8_BAR; PG8_MMA(1, 1, At, B1); PG8_BAR;
            PG8_LDB(B0, 1, 0); PG8_SCHED; PG8_LDA(At, 1, 0); PG8_STAGE(PG8_SA(0, 1), a2 + hstepA, voffA);
            PG8_WAIT_L(8); PG8_BAR; PG8_WAIT_L(0); PG8_MMA(0, 0, At, B0); PG8_BAR; PG8_SCHED;
            PG8_LDB(B1, 1, 1); PG8_STAGE(PG8_SB(1, 0), b3, voffB);
            PG8_BAR; PG8_WAIT_L(0); PG8_MMA(0, 1, At, B1); PG8_BAR;
            PG8_LDA(At, 1, 1); PG8_STAGE(PG8_SA(1, 0), a3, voffA);
            PG8_BAR; PG8_WAIT_L(0); PG8_MMA(1, 0, At, B0); PG8_BAR; PG8_SCHED;
            PG8_STAGE(PG8_SB(1, 1), b3 + hstep, voffB);
            PG8_WAIT_V(6); PG8_BAR; PG8_MMA(1, 1, At, B1); PG8_BAR;
        }
        PG8_STAMP();
        if constexpr (!Epi::AFTER_DRAIN) { E(acc, cur, wr, wc, fr, fq); S.done(cur); }
        PG8_STAMP();
        if (!has_next) break;
#pragma unroll
        for (int a = 0; a < 2; ++a)
#pragma unroll
            for (int b = 0; b < 2; ++b)
#pragma unroll
                for (int m = 0; m < 4; ++m)
#pragma unroll
                    for (int n = 0; n < 2; ++n) acc[a][b][m][n] = (f32x4){0.f, 0.f, 0.f, 0.f};
        cur = nxt; cA = nA; cB = nB; ++ui;
    }
    PG8_WAIT_V(0);
    if (wr == 0) PG8_BAR;
    PG8_BAR;
    if constexpr (Epi::AFTER_DRAIN) { E.fused(acc, cur, wr, wc, fr, fq, lds, wid, lane); S.done(cur); }
    PG8_STAMP();
    if (STAMP && wid == 0) { stamps[lane] = lane < nts ? (((unsigned long long)(unsigned)ts_hi << 32) | (unsigned)ts_lo) : 0ull;
        if (lane == 62) stamps[62] = rt_entry; if (lane == 63) stamps[63] = (unsigned long long)wall_clock64(); }
#undef PG8_STAMP
#undef PG8_SA
#undef PG8_SB
#undef PG8_STAGE
#undef PG8_LDA
#undef PG8_LDB
#undef PG8_MMA
#undef PG8_WAIT_V
#undef PG8_WAIT_L
#undef PG8_BAR
#undef PG8_SCHED
}
}

namespace cg = cooperative_groups;
#define LAS __attribute__((address_space(3)))
typedef unsigned short bf16_t;
typedef unsigned int u32;
typedef pg8::bf16x8 bf16x8;
typedef pg8::f32x4 f32x4;
typedef pg8::u32x4 u32x4;

constexpr int D = 1024, TP = 4096, BP = 8, MP = BP * TP, BS = 32, TS = 8, MS = BS * TS;
constexpr int MB = MP + MS;
constexpr int MA = 33280;
constexpr int MA_REAL = MP + BS * 9;
constexpr int DIN = 3328, RCOLS = 1792, FF = 2816, FF2 = 5632, NLORA = 1536, KLORA = 256;
constexpr int NTHREADS = 512;
constexpr int LDS_BYTES = 144 * 1024;

constexpr size_t O_YP = 0;
constexpr size_t O_YS = O_YP + (size_t)MP * D;
constexpr size_t O_PSH = O_YS + (size_t)MS * D;
constexpr size_t O_PWKV = O_PSH + (size_t)BP * D;
constexpr size_t O_PK = O_PWKV + (size_t)BP * 8 * 64 * 64;
constexpr size_t O_PV = O_PK + (size_t)BP * 2048 * 512;
constexpr size_t O_PCONV = O_PV + (size_t)BP * 2048 * 512;
constexpr size_t O_SSH = O_PCONV + (size_t)BP * 2 * FF2;
constexpr size_t O_SWKV = O_SSH + (size_t)BS * D;
constexpr size_t O_SK = O_SWKV + (size_t)BS * 8 * 64 * 64;
constexpr size_t O_SV = O_SK + (size_t)BS * 2048 * 512;
constexpr size_t O_SCONV = O_SV + (size_t)BS * 2048 * 512;
constexpr size_t O_END = O_SCONV + (size_t)BS * 2 * FF2;

constexpr size_t al256(size_t x) { return (x + 255) & ~(size_t)255; }
constexpr size_t WS_WIN = 0;
constexpr size_t WS_WOUT = WS_WIN + al256((size_t)DIN * D * 2);
constexpr size_t WS_WUP = WS_WOUT + al256((size_t)D * D * 2);
constexpr size_t WS_WDN = WS_WUP + al256((size_t)FF2 * D * 2);
constexpr size_t WS_WLORA = WS_WDN + al256((size_t)D * FF * 2);
constexpr size_t WS_ROPE = WS_WLORA + al256((size_t)NLORA * KLORA * 2);
constexpr int NPOS = 4104;
constexpr size_t WS_SNEWK = WS_ROPE + al256((size_t)NPOS * 32 * 2 * 4);
constexpr size_t WS_SNEWV = WS_SNEWK + al256((size_t)MS * 512 * 4);
constexpr size_t WS_HALO = WS_SNEWV + al256((size_t)MS * 512 * 4);
constexpr size_t WS_A = WS_HALO + al256((size_t)1025 * 2 * FF2 * 2);
constexpr size_t WS_PROJRW = WS_A;
constexpr size_t WS_Q = WS_PROJRW + al256((size_t)MA * RCOLS * 2);
constexpr size_t WS_K = WS_Q + al256((size_t)MB * 512 * 2);
constexpr size_t WS_VT1 = WS_K + al256((size_t)MB * 512 * 2);
constexpr size_t WS_VT4 = WS_VT1 + al256((size_t)BP * 8 * 64 * TP * 2);
constexpr size_t WS_VT16 = WS_VT4 + al256((size_t)BP * 8 * 64 * TP * 2);
constexpr size_t WS_ALORA = WS_VT16 + al256((size_t)BP * 8 * 64 * TP * 2);
constexpr size_t WS_A_EARLY_END = WS_ALORA + al256((size_t)MB * KLORA * 2);
constexpr size_t WS_U = WS_A;
constexpr size_t WS_END = WS_A + al256((size_t)MB * FF2 * 2);
static_assert(WS_A_EARLY_END <= WS_END, "region A overflow");
constexpr size_t SC_B = O_SK * 4;
constexpr size_t SC_C = SC_B + al256((size_t)MB * D * 4);
static_assert(SC_C + (size_t)MB * D * 2 <= O_SCONV * 4, "scratch overflow");
static_assert((size_t)MA * D * 2 <= (size_t)MB * D * 4 && (size_t)MB * NLORA * 2 <= (size_t)MB * D * 4, "region B");

struct Params {
    const float* in[28];
    float* out;
    unsigned char* ws;
    int en, pad;
};

enum { I_XP = 0, I_XS, I_SSHIFT, I_SWKV, I_CK, I_CV, I_SCONV, I_NMPRE, I_NMPOST, I_NFPRE, I_NFPOST, I_WIN, I_MU, I_W0, I_WDEC, I_A0, I_WICLR, I_WGATE,
       I_KK, I_KA, I_RK, I_LNW, I_LNB, I_WOUT, I_WUP, I_CONVW, I_CONVB, I_WDN };

__device__ __forceinline__ float bflo(u32 p) { return __uint_as_float(p << 16); }
__device__ __forceinline__ float bfhi(u32 p) { return __uint_as_float(p & 0xffff0000u); }
__device__ __forceinline__ u32 pk2(float a, float b) { return pg8::cvt_pk_bf16(a, b); }
__device__ __forceinline__ float wave_sum(float v) {
#pragma unroll
    for (int o = 1; o < 64; o <<= 1) v += __shfl_xor(v, o);
    return v;
}
template <int N> __device__ __forceinline__ float dpp_ror(float x) {
    return __int_as_float(__builtin_amdgcn_update_dpp(0, __float_as_int(x), 0x120 + N, 0xF, 0xF, false));
}
__device__ __forceinline__ float row16_sum(float x) {
    x += dpp_ror<8>(x); x += dpp_ror<4>(x); x += dpp_ror<2>(x); x += dpp_ror<1>(x);
    return x;
}
__device__ __forceinline__ void row16_sum4(float& a, float& b, float& c, float& d) {
    asm volatile("s_nop 1\n\t"
                 "v_add_f32_dpp %0, %0, %0 row_ror:8 row_mask:0xf bank_mask:0xf\n\t" "v_add_f32_dpp %1, %1, %1 row_ror:8 row_mask:0xf bank_mask:0xf\n\t"
                 "v_add_f32_dpp %2, %2, %2 row_ror:8 row_mask:0xf bank_mask:0xf\n\t" "v_add_f32_dpp %3, %3, %3 row_ror:8 row_mask:0xf bank_mask:0xf\n\t"
                 "v_add_f32_dpp %0, %0, %0 row_ror:4 row_mask:0xf bank_mask:0xf\n\t" "v_add_f32_dpp %1, %1, %1 row_ror:4 row_mask:0xf bank_mask:0xf\n\t"
                 "v_add_f32_dpp %2, %2, %2 row_ror:4 row_mask:0xf bank_mask:0xf\n\t" "v_add_f32_dpp %3, %3, %3 row_ror:4 row_mask:0xf bank_mask:0xf\n\t"
                 "v_add_f32_dpp %0, %0, %0 row_ror:2 row_mask:0xf bank_mask:0xf\n\t" "v_add_f32_dpp %1, %1, %1 row_ror:2 row_mask:0xf bank_mask:0xf\n\t"
                 "v_add_f32_dpp %2, %2, %2 row_ror:2 row_mask:0xf bank_mask:0xf\n\t" "v_add_f32_dpp %3, %3, %3 row_ror:2 row_mask:0xf bank_mask:0xf\n\t"
                 "v_add_f32_dpp %0, %0, %0 row_ror:1 row_mask:0xf bank_mask:0xf\n\t" "v_add_f32_dpp %1, %1, %1 row_ror:1 row_mask:0xf bank_mask:0xf\n\t"
                 "v_add_f32_dpp %2, %2, %2 row_ror:1 row_mask:0xf bank_mask:0xf\n\t" "v_add_f32_dpp %3, %3, %3 row_ror:1 row_mask:0xf bank_mask:0xf\n\t"
                 "s_nop 1"
                 : "+v"(a), "+v"(b), "+v"(c), "+v"(d));
}
__device__ __forceinline__ float sigmoidf_(float x) { return 1.f / (1.f + __expf(-x)); }

__device__ __forceinline__ int win_rowmap(int n) {
    if (n < RCOLS || n >= RCOLS + 1024) return n;
    const int base = (n < RCOLS + 512) ? RCOLS : RCOLS + 512, c = n - base, unit = c >> 8, cu = c & 255, hu = cu >> 6, d = cu & 63, e = d & 31, s = d >> 5;
    const int idx = hu * 32 + e, bj = idx >> 6, wc = (idx & 63) >> 4, fq = (idx & 15) >> 2, j = idx & 3;
    return base + unit * 256 + 128 * bj + 32 * wc + 16 * s + 4 * fq + j;
}
__device__ __forceinline__ void transpose_item(const float* W, int K, int N, bf16_t* WT, int mode, LAS float* scr, int item, int lane) {
    const int nblk = N / 32, kb = item / nblk, nb = item % nblk, k0 = 64 * kb, n0 = 32 * nb;
#pragma unroll 8
    for (int i = 0; i < 32; ++i) { const int kk = 2 * i + (lane >> 5); scr[kk * 33 + (lane & 31)] = W[(size_t)(k0 + kk) * N + n0 + (lane & 31)]; }
    asm volatile("s_waitcnt lgkmcnt(0)" ::: "memory");
    const int c = lane & 7;
#pragma unroll
    for (int j = 0; j < 4; ++j) { const int n = (lane >> 3) + 8 * j; const LAS float* s = scr + (8 * c) * 33 + n;
        uint4 o; o.x = pk2(s[0 * 33], s[1 * 33]); o.y = pk2(s[2 * 33], s[3 * 33]); o.z = pk2(s[4 * 33], s[5 * 33]); o.w = pk2(s[6 * 33], s[7 * 33]);
        const int row = mode ? win_rowmap(n0 + n) : (n0 + n);
        *(uint4*)(WT + (size_t)row * K + k0 + 8 * c) = o; }
    asm volatile("s_waitcnt lgkmcnt(0)" ::: "memory");
}
__device__ __forceinline__ void rms_row(const float* xrow, const float* g, bf16_t* orow, float* frow, int lane) {
    const float4* xr = (const float4*)xrow + lane; const float4* gr = (const float4*)g + lane;
    float4 v[4]; float s = 0.f;
#pragma unroll
    for (int j = 0; j < 4; ++j) { v[j] = xr[64 * j]; s += (v[j].x * v[j].x + v[j].y * v[j].y) + (v[j].z * v[j].z + v[j].w * v[j].w); }
    const float rs = rsqrtf(wave_sum(s) * (1.f / D) + 1e-6f);
#pragma unroll
    for (int j = 0; j < 4; ++j) { const float4 gg = gr[64 * j];
        float4 y; y.x = v[j].x * rs * gg.x; y.y = v[j].y * rs * gg.y; y.z = v[j].z * rs * gg.z; y.w = v[j].w * rs * gg.w;
        uint2 o; o.x = pk2(y.x, y.y); o.y = pk2(y.z, y.w);
        *((uint2*)orow + lane + 64 * j) = o;
        if (frow) *((float4*)frow + lane + 64 * j) = y; }
}
__device__ __forceinline__ void phase0(const Params& p, LAS unsigned char* lds, int tid, int G, int bid) {
    const int wave = tid >> 6, lane = tid & 63, gw = bid * 8 + wave, NGW = G * 8;
    LAS float* scr = (LAS float*)(lds + wave * 16384);
    bf16_t* WinT = (bf16_t*)(p.ws + WS_WIN); bf16_t* WoutT = (bf16_t*)(p.ws + WS_WOUT); bf16_t* WupT = (bf16_t*)(p.ws + WS_WUP); bf16_t* WdnT = (bf16_t*)(p.ws + WS_WDN);
    constexpr int I1 = (D / 64) * (DIN / 32), I2 = (D / 64) * (D / 32), I3 = (D / 64) * (FF2 / 32), I4 = (FF / 64) * (D / 32);
    for (int it = gw; it < I1 + I2 + I3 + I4; it += NGW) {
        int r = it;
        if (r < I1) { transpose_item(p.in[I_WIN], D, DIN, WinT, 1, scr, r, lane); continue; } r -= I1;
        if (r < I2) { transpose_item(p.in[I_WOUT], D, D, WoutT, 0, scr, r, lane); continue; } r -= I2;
        if (r < I3) { transpose_item(p.in[I_WUP], D, FF2, WupT, 0, scr, r, lane); continue; } r -= I3;
        transpose_item(p.in[I_WDN], FF, D, WdnT, 0, scr, r, lane);
    }
    const int gt = bid * NTHREADS + tid, NT = G * NTHREADS;
    bf16_t* WL = (bf16_t*)(p.ws + WS_WLORA);
    for (int i = gt; i < NLORA * KLORA; i += NT) {
        const int row = i >> 8, k = i & 255; float v = 0.f;
        if (row < 512) { if (k < 64) v = p.in[I_WDEC][k * 512 + row]; }
        else if (row < 1024) { if (k >= 64 && k < 128) v = p.in[I_WICLR][(k - 64) * 512 + (row - 512)]; }
        else { if (k >= 128) v = p.in[I_WGATE][(k - 128) * 512 + (row - 1024)]; }
        WL[i] = (bf16_t)(pk2(v, 0.f) & 0xffffu);
    }
    float* rope = (float*)(p.ws + WS_ROPE);
    for (int i = gt; i < NPOS * 32; i += NT) {
        const int pi = i >> 5, e = i & 31; const int pos = pi < TP ? pi : 16384 + (pi - TP);
        double inv = 1.0; for (int q = 0; q < e; ++q) inv *= 0.7498942093324558273;
        const float ang = (float)pos * (float)inv;
        const double a = (double)ang; const double kq = rint(a * 0.15915494309189535); double r = a - kq * 6.283185307179586; r -= kq * 2.4492935982947064e-16;
        const double r2 = r * r;
        double sn = 1.0 / 51090942171709440000.0;
        sn = sn * r2 * (-1.0) + 1.0 / 121645100408832000.0;
        sn = -sn * r2 + 1.0 / 355687428096000.0;
        sn = -sn * r2 + 1.0 / 1307674368000.0;
        sn = -sn * r2 + 1.0 / 6227020800.0;
        sn = -sn * r2 + 1.0 / 39916800.0;
        sn = -sn * r2 + 1.0 / 362880.0;
        sn = -sn * r2 + 1.0 / 5040.0;
        sn = -sn * r2 + 1.0 / 120.0;
        sn = -sn * r2 + 1.0 / 6.0;
        sn = -sn * r2 + 1.0;
        sn *= r;
        double cs = 1.0 / 1124000727777607680000.0;
        cs = -cs * r2 + 1.0 / 2432902008176640000.0;
        cs = -cs * r2 + 1.0 / 6402373705728000.0;
        cs = -cs * r2 + 1.0 / 20922789888000.0;
        cs = -cs * r2 + 1.0 / 87178291200.0;
        cs = -cs * r2 + 1.0 / 479001600.0;
        cs = -cs * r2 + 1.0 / 3628800.0;
        cs = -cs * r2 + 1.0 / 40320.0;
        cs = -cs * r2 + 1.0 / 720.0;
        cs = -cs * r2 + 1.0 / 24.0;
        cs = -cs * r2 + 0.5;
        cs = -cs * r2 + 1.0;
        rope[i] = (float)cs; rope[NPOS * 32 + i] = (float)sn;
    }
    bf16_t* H = (bf16_t*)((unsigned char*)p.out + SC_B);
    for (int row = gw; row < MA; row += NGW) {
        bf16_t* orow = H + (size_t)row * D;
        if (row < MP) {
            const bool last = (row & (TP - 1)) == TP - 1;
            rms_row(p.in[I_XP] + (size_t)row * D, p.in[I_NMPRE], orow, last ? p.out + O_PSH + (size_t)(row >> 12) * D : nullptr, lane);
        } else {
            const int s = row - MP;
            if (s < BS * 9) {
                const int b = s / 9, j = s - b * 9;
                if (j == 0) {
                    const float4* sr = (const float4*)(p.in[I_SSHIFT] + (size_t)b * D) + lane;
#pragma unroll
                    for (int q = 0; q < 4; ++q) { const float4 v = sr[64 * q]; uint2 o; o.x = pk2(v.x, v.y); o.y = pk2(v.z, v.w); *((uint2*)orow + lane + 64 * q) = o; }
                } else {
                    rms_row(p.in[I_XS] + (size_t)(b * TS + j - 1) * D, p.in[I_NMPRE], orow, j == TS ? p.out + O_SSH + (size_t)b * D : nullptr, lane);
                }
            } else {
#pragma unroll
                for (int q = 0; q < 4; ++q) *((uint2*)orow + lane + 64 * q) = make_uint2(0u, 0u);
            }
        }
    }
}

struct EpiProj {
    static constexpr bool PERM = false, AFTER_DRAIN = false;
    bf16_t* projrw; bf16_t* Q; bf16_t* K; bf16_t* VT1; bf16_t* VT4; bf16_t* VT16; const float* rope; float* out; float* snewk; float* snewv;
    __device__ __forceinline__ void operator()(const f32x4 (&acc)[2][2][4][2], const pg8::Unit& u, int wr, int wc, int fr, int fq) const {
        const int pn = u.pn;
        if (pn < 7) {
#pragma unroll
            for (int ai = 0; ai < 2; ++ai)
#pragma unroll
                for (int m = 0; m < 4; ++m) { const int row = u.pm * 256 + ai * 128 + wr * 64 + m * 16 + fr;
                    bf16_t* rp = projrw + (size_t)row * RCOLS + pn * 256 + wc * 32 + 4 * fq;
#pragma unroll
                    for (int bj = 0; bj < 2; ++bj)
#pragma unroll
                        for (int n = 0; n < 2; ++n) { const f32x4 v = acc[ai][bj][m][n]; uint2 o; o.x = pk2(v[0], v[1]); o.y = pk2(v[2], v[3]); *(uint2*)(rp + bj * 128 + n * 16) = o; } }
            return;
        }
#pragma unroll
        for (int ai = 0; ai < 2; ++ai)
#pragma unroll
            for (int m = 0; m < 4; ++m) {
                const int row = u.pm * 256 + ai * 128 + wr * 64 + m * 16 + fr;
                bool prompt = row < MP; int b, t, rowB, pi; bool valid = true;
                if (prompt) { b = row >> 12; t = row & (TP - 1); rowB = row; pi = t; }
                else { const int s = row - MP; b = s / 9; const int j = s - b * 9; valid = (s < BS * 9) && (j > 0); t = j - 1; rowB = MP + b * TS + t; pi = TP + t; }
                if (!valid) continue;
                if (pn < 11) {
                    const bool isq = pn < 9; const int unit = isq ? pn - 7 : pn - 9;
#pragma unroll
                    for (int bj = 0; bj < 2; ++bj) {
                        const int idx = bj * 64 + wc * 16 + fq * 4, hu = idx >> 5, e = idx & 31;
                        const float4 cs = *(const float4*)(rope + (size_t)pi * 32 + e), sn = *(const float4*)(rope + (size_t)NPOS * 32 + (size_t)pi * 32 + e);
                        const f32x4 x1 = acc[ai][bj][m][0], x2 = acc[ai][bj][m][1];
                        float o1[4], o2[4];
                        o1[0] = x1[0] * cs.x - x2[0] * sn.x; o2[0] = x1[0] * sn.x + x2[0] * cs.x;
                        o1[1] = x1[1] * cs.y - x2[1] * sn.y; o2[1] = x1[1] * sn.y + x2[1] * cs.y;
                        o1[2] = x1[2] * cs.z - x2[2] * sn.z; o2[2] = x1[2] * sn.z + x2[2] * cs.z;
                        o1[3] = x1[3] * cs.w - x2[3] * sn.w; o2[3] = x1[3] * sn.w + x2[3] * cs.w;
                        const int col = unit * 256 + hu * 64 + e;
                        if (isq) {
                            uint2 a, c2; a.x = pk2(o1[0] * 0.125f, o1[1] * 0.125f); a.y = pk2(o1[2] * 0.125f, o1[3] * 0.125f); c2.x = pk2(o2[0] * 0.125f, o2[1] * 0.125f); c2.y = pk2(o2[2] * 0.125f, o2[3] * 0.125f);
                            *(uint2*)(Q + (size_t)rowB * 512 + col) = a; *(uint2*)(Q + (size_t)rowB * 512 + col + 32) = c2;
                        } else {
                            uint2 a, c2; a.x = pk2(o1[0], o1[1]); a.y = pk2(o1[2], o1[3]); c2.x = pk2(o2[0], o2[1]); c2.y = pk2(o2[2], o2[3]);
                            *(uint2*)(K + (size_t)rowB * 512 + col) = a; *(uint2*)(K + (size_t)rowB * 512 + col + 32) = c2;
                            float* dst = nullptr;
                            if (prompt) { if (t >= 2048) dst = out + O_PK + ((size_t)b * 2048 + (t - 2048)) * 512 + col; }
                            else dst = snewk + (size_t)(b * TS + t) * 512 + col;
                            if (dst) { *(float4*)dst = make_float4(o1[0], o1[1], o1[2], o1[3]); *(float4*)(dst + 32) = make_float4(o2[0], o2[1], o2[2], o2[3]); }
                        }
                    }
                } else {
#pragma unroll
                    for (int bj = 0; bj < 2; ++bj)
#pragma unroll
                        for (int n = 0; n < 2; ++n) {
                            const int col = (pn - 11) * 256 + bj * 128 + wc * 32 + n * 16 + 4 * fq; const f32x4 v = acc[ai][bj][m][n];
                            if (prompt) {
                                if (t >= 2048) *(float4*)(out + O_PV + ((size_t)b * 2048 + (t - 2048)) * 512 + col) = make_float4(v[0], v[1], v[2], v[3]);
                                const int hd = col >> 6, d0 = col & 63; const size_t base = ((size_t)(b * 8 + hd) * 64 + d0) * TP;
                                const u32 p01 = pk2(v[0], v[1]), p23 = pk2(v[2], v[3]);
                                const bf16_t e0 = (bf16_t)(p01 & 0xffffu), e1 = (bf16_t)(p01 >> 16), e2 = (bf16_t)(p23 & 0xffffu), e3 = (bf16_t)(p23 >> 16);
                                const int i4 = (t & 3) * (TP / 4) + (t >> 2), i16 = (t & 15) * (TP / 16) + (t >> 4);
                                VT1[base + t] = e0; VT1[base + TP + t] = e1; VT1[base + 2 * TP + t] = e2; VT1[base + 3 * TP + t] = e3;
                                VT4[base + i4] = e0; VT4[base + TP + i4] = e1; VT4[base + 2 * TP + i4] = e2; VT4[base + 3 * TP + i4] = e3;
                                VT16[base + i16] = e0; VT16[base + TP + i16] = e1; VT16[base + 2 * TP + i16] = e2; VT16[base + 3 * TP + i16] = e3;
                            } else {
                                *(float4*)(snewv + (size_t)(b * TS + t) * 512 + col) = make_float4(v[0], v[1], v[2], v[3]);
                            }
                        }
                }
            }
    }
};
struct EpiDag {
    static constexpr bool PERM = false, AFTER_DRAIN = false;
    bf16_t* dag; const float* w0; const float* a0;
    __device__ __forceinline__ void operator()(const f32x4 (&acc)[2][2][4][2], const pg8::Unit& u, int wr, int wc, int fr, int fq) const {
        const int kind = u.pn >> 1;
#pragma unroll
        for (int bj = 0; bj < 2; ++bj)
#pragma unroll
            for (int n = 0; n < 2; ++n) {
                const int col = u.pn * 256 + bj * 128 + wc * 32 + n * 16 + 4 * fq;
                float4 bias = make_float4(0.f, 0.f, 0.f, 0.f);
                if (kind == 0) bias = *(const float4*)(w0 + col); else if (kind == 1) bias = *(const float4*)(a0 + col - 512);
                const float bb[4] = {bias.x, bias.y, bias.z, bias.w};
#pragma unroll
                for (int ai = 0; ai < 2; ++ai)
#pragma unroll
                    for (int m = 0; m < 4; ++m) { const int row = u.pm * 256 + ai * 128 + wr * 64 + m * 16 + fr; const f32x4 v = acc[ai][bj][m][n]; float o[4];
#pragma unroll
                        for (int j = 0; j < 4; ++j) { const float x = v[j] + bb[j];
                            if (kind == 0) { const float z = -x; const float sp = fmaxf(z, 0.f) + __logf(1.f + __expf(-fabsf(z))); o[j] = -__expf(-sp - 0.5f); }
                            else if (kind == 1) o[j] = sigmoidf_(x);
                            else o[j] = x; }
                        uint2 q; q.x = pk2(o[0], o[1]); q.y = pk2(o[2], o[3]); *(uint2*)(dag + (size_t)row * NLORA + col) = q; }
            }
    }
};
struct EpiUp {
    static constexpr bool PERM = false, AFTER_DRAIN = false;
    bf16_t* U; bf16_t* halo; float* out;
    __device__ __forceinline__ void operator()(const f32x4 (&acc)[2][2][4][2], const pg8::Unit& u, int wr, int wc, int fr, int fq) const {
#pragma unroll
        for (int ai = 0; ai < 2; ++ai)
#pragma unroll
            for (int m = 0; m < 4; ++m) {
                const int row = u.pm * 256 + ai * 128 + wr * 64 + m * 16 + fr; const int col0 = u.pn * 256 + wc * 32 + 4 * fq;
                bf16_t* hrow = nullptr; float* frow = nullptr;
                if (row < MP) { const int t = row & (TP - 1);
                    if ((t & 31) >= 30) hrow = halo + ((size_t)((row >> 5) + 1) * 2 + ((t & 31) - 30)) * FF2;
                    if (t >= TP - 2) frow = out + O_PCONV + ((size_t)(row >> 12) * 2 + (t - (TP - 2))) * FF2;
                } else { const int s = row - MP, b = s >> 3, tt = s & 7; if (tt >= 6) frow = out + O_SCONV + ((size_t)b * 2 + (tt - 6)) * FF2; }
#pragma unroll
                for (int bj = 0; bj < 2; ++bj)
#pragma unroll
                    for (int n = 0; n < 2; ++n) { const f32x4 v = acc[ai][bj][m][n]; const int col = col0 + bj * 128 + n * 16;
                        uint2 o; o.x = pk2(v[0], v[1]); o.y = pk2(v[2], v[3]);
                        *(uint2*)(U + (size_t)row * FF2 + col) = o;
                        if (hrow) *(uint2*)(hrow + col) = o;
                        if (frow) *(float4*)(frow + col) = make_float4(v[0], v[1], v[2], v[3]); }
            }
    }
};

__device__ __forceinline__ int rowA_of(int rowB) { return rowB < MP ? rowB : MP + ((rowB - MP) >> 3) * 9 + 1 + ((rowB - MP) & 7); }
__device__ __forceinline__ void phase_alora(const Params& p, int tid, int G, int bid) {
    const bf16_t* PR = (const bf16_t*)(p.ws + WS_PROJRW); bf16_t* AL = (bf16_t*)(p.ws + WS_ALORA); const float* mu = p.in[I_MU];
    const int gt = bid * NTHREADS + tid, NT = G * NTHREADS;
    for (int i = gt; i < MB * 64; i += NT) {
        const int rowB = i >> 6, c = (i & 63) * 4, rowA = rowA_of(rowB);
        const uint2 cur = *(const uint2*)(PR + (size_t)rowA * RCOLS + 1536 + c);
        uint2 prv = make_uint2(0u, 0u);
        if (!(rowB < MP && (rowB & (TP - 1)) == 0)) prv = *(const uint2*)(PR + (size_t)(rowA - 1) * RCOLS + 1536 + c);
        const float4 m4 = *(const float4*)(mu + 1536 + c);
        float x[4] = {bflo(cur.x), bfhi(cur.x), bflo(cur.y), bfhi(cur.y)}; const float pv[4] = {bflo(prv.x), bfhi(prv.x), bflo(prv.y), bfhi(prv.y)}; const float mm[4] = {m4.x, m4.y, m4.z, m4.w};
#pragma unroll
        for (int j = 0; j < 4; ++j) { float v = x[j] + (pv[j] - x[j]) * mm[j];
            if (c < 64) v = tanhf(v); else if (c >= 128) v = sigmoidf_(v);
            x[j] = v; }
        uint2 o; o.x = pk2(x[0], x[1]); o.y = pk2(x[2], x[3]);
        *(uint2*)(AL + (size_t)rowB * KLORA + c) = o;
    }
}

constexpr int CH = 32;
constexpr int SST = 452;
constexpr int SI_W = 0, SI_A = 64, SI_B = 128, SI_K = 192, SI_WR = 256, SI_V = 320, SI_G = 384, SI_SC = 448;
struct PrepRegs { uint2 cr, ck, cv, pr, pk, pv, dw, da, dg; };
__device__ __forceinline__ void scan_item(const Params& p, LAS unsigned char* lds, int tid, bool sample, int b, int h) {
    const bf16_t* PR = (const bf16_t*)(p.ws + WS_PROJRW); const bf16_t* DAG = (const bf16_t*)((const unsigned char*)p.out + SC_B);
    bf16_t* MIX = (bf16_t*)((unsigned char*)p.out + SC_C);
    LAS float* buf0 = (LAS float*)lds; LAS float* buf1 = buf0 + CH * SST; LAS float* ybuf = buf1 + CH * SST;
    const int T = sample ? TS : TP;
    const int rowB0 = sample ? MP + b * TS : b * TP;
    const int rowA0 = sample ? MP + b * 9 + 1 : b * TP;
    const int nch = (T + CH - 1) / CH;
    const int ptl = tid >> 4, pj = (tid & 15) * 4, pc = h * 64 + pj;
    const int lane = tid & 63, wv = tid >> 6, rg = wv * 4 + (lane >> 4), cgi = lane & 15;
    float s0[4], s1[4];
    if (sample) {
        const float* S0 = p.in[I_SWKV] + ((size_t)(b * 8 + h) * 64 + 2 * rg) * 64 + 4 * cgi;
        const float4 a = *(const float4*)S0, c = *(const float4*)(S0 + 64);
        s0[0] = a.x; s0[1] = a.y; s0[2] = a.z; s0[3] = a.w; s1[0] = c.x; s1[1] = c.y; s1[2] = c.z; s1[3] = c.w;
    } else {
#pragma unroll
        for (int j = 0; j < 4; ++j) { s0[j] = 0.f; s1[j] = 0.f; }
    }
    __builtin_amdgcn_s_waitcnt(0x0F70);
    PrepRegs R;
#define SCAN_LOAD(chunk) do { const int t_ = (chunk) * CH + ptl; if (t_ < T) { const size_t ra = (size_t)(rowA0 + t_) * RCOLS + pc; const size_t rb = (size_t)(rowB0 + t_) * NLORA + pc; \
        R.cr = *(const uint2*)(PR + ra); R.ck = *(const uint2*)(PR + ra + 512); R.cv = *(const uint2*)(PR + ra + 1024); \
        if (!sample && t_ == 0) { R.pr = make_uint2(0u, 0u); R.pk = R.pr; R.pv = R.pr; } \
        else { R.pr = *(const uint2*)(PR + ra - RCOLS); R.pk = *(const uint2*)(PR + ra - RCOLS + 512); R.pv = *(const uint2*)(PR + ra - RCOLS + 1024); } \
        R.dw = *(const uint2*)(DAG + rb); R.da = *(const uint2*)(DAG + rb + 512); R.dg = *(const uint2*)(DAG + rb + 1024); } } while (0)
#define SCAN_PREP(chunk, dstbuf) do { const int t_ = (chunk) * CH + ptl; if (t_ < T) { \
        const float4 mur = *(const float4*)(p.in[I_MU] + pc), muk = *(const float4*)(p.in[I_MU] + 512 + pc), muv = *(const float4*)(p.in[I_MU] + 1024 + pc); \
        const float4 kk4 = *(const float4*)(p.in[I_KK] + pc), ka4 = *(const float4*)(p.in[I_KA] + pc), rk4 = *(const float4*)(p.in[I_RK] + pc); \
        const float mr[4] = {mur.x, mur.y, mur.z, mur.w}, mk[4] = {muk.x, muk.y, muk.z, muk.w}, mv[4] = {muv.x, muv.y, muv.z, muv.w}; \
        const float kkc[4] = {kk4.x, kk4.y, kk4.z, kk4.w}, kac[4] = {ka4.x, ka4.y, ka4.z, ka4.w}, rkc[4] = {rk4.x, rk4.y, rk4.z, rk4.w}; \
        const float crr[4] = {bflo(R.cr.x), bfhi(R.cr.x), bflo(R.cr.y), bfhi(R.cr.y)}, ckk[4] = {bflo(R.ck.x), bfhi(R.ck.x), bflo(R.ck.y), bfhi(R.ck.y)}, cvv[4] = {bflo(R.cv.x), bfhi(R.cv.x), bflo(R.cv.y), bfhi(R.cv.y)}; \
        const float prr[4] = {bflo(R.pr.x), bfhi(R.pr.x), bflo(R.pr.y), bfhi(R.pr.y)}, pkk[4] = {bflo(R.pk.x), bfhi(R.pk.x), bflo(R.pk.y), bfhi(R.pk.y)}, pvv[4] = {bflo(R.pv.x), bfhi(R.pv.x), bflo(R.pv.y), bfhi(R.pv.y)}; \
        const float lw[4] = {bflo(R.dw.x), bfhi(R.dw.x), bflo(R.dw.y), bfhi(R.dw.y)}, aa[4] = {bflo(R.da.x), bfhi(R.da.x), bflo(R.da.y), bfhi(R.da.y)}, gg[4] = {bflo(R.dg.x), bfhi(R.dg.x), bflo(R.dg.y), bfhi(R.dg.y)}; \
        float r_[4], k_[4], v_[4], w_[4], kn[4], k2[4]; float nrm = 0.f; \
        _Pragma("unroll") for (int j = 0; j < 4; ++j) { r_[j] = crr[j] + (prr[j] - crr[j]) * mr[j]; k_[j] = ckk[j] + (pkk[j] - ckk[j]) * mk[j]; v_[j] = cvv[j] + (pvv[j] - cvv[j]) * mv[j]; \
            w_[j] = __expf(lw[j]); kn[j] = k_[j] * kkc[j]; nrm += kn[j] * kn[j]; k2[j] = k_[j] * (1.f + (aa[j] - 1.f) * kac[j]); } \
        nrm = row16_sum(nrm); const float inv = 1.f / fmaxf(sqrtf(nrm), 1e-12f); \
        float br = 0.f, kr = 0.f, rk = 0.f; float an[4], bn[4], wrr[4]; \
        _Pragma("unroll") for (int j = 0; j < 4; ++j) { const float kkn = kn[j] * inv; an[j] = -kkn; bn[j] = kkn * aa[j]; wrr[j] = w_[j] * r_[j]; br += bn[j] * r_[j]; kr += k2[j] * r_[j]; rk += r_[j] * k2[j] * rkc[j]; } \
        br = row16_sum(br); kr = row16_sum(kr); rk = row16_sum(rk); \
        LAS float* rec = (dstbuf) + ptl * SST; \
        *(LAS f32x4*)(rec + SI_W + pj) = (f32x4){w_[0], w_[1], w_[2], w_[3]}; *(LAS f32x4*)(rec + SI_A + pj) = (f32x4){an[0], an[1], an[2], an[3]}; \
        *(LAS f32x4*)(rec + SI_B + pj) = (f32x4){bn[0], bn[1], bn[2], bn[3]}; *(LAS f32x4*)(rec + SI_K + pj) = (f32x4){k2[0], k2[1], k2[2], k2[3]}; \
        *(LAS f32x4*)(rec + SI_WR + pj) = (f32x4){wrr[0], wrr[1], wrr[2], wrr[3]}; *(LAS f32x4*)(rec + SI_V + pj) = (f32x4){v_[0], v_[1], v_[2], v_[3]}; \
        *(LAS f32x4*)(rec + SI_G + pj) = (f32x4){gg[0], gg[1], gg[2], gg[3]}; \
        if ((tid & 15) == 0) *(LAS f32x4*)(rec + SI_SC) = (f32x4){br, kr, rk, 0.f}; } } while (0)

    SCAN_LOAD(0);
    SCAN_PREP(0, buf0);
    __syncthreads();
    for (int c = 0; c < nch; ++c) {
        LAS float* cur = (c & 1) ? buf1 : buf0; LAS float* nxt = (c & 1) ? buf0 : buf1;
        if (c + 1 < nch) SCAN_LOAD(c + 1);
        const int ns = (T - c * CH) < CH ? (T - c * CH) : CH;
        {
            const LAS float* rec = cur;
            f32x4 wA = *(const LAS f32x4*)(rec + SI_W + 4 * cgi), aA = *(const LAS f32x4*)(rec + SI_A + 4 * cgi), bA = *(const LAS f32x4*)(rec + SI_B + 4 * cgi);
            f32x4 kA = *(const LAS f32x4*)(rec + SI_K + 4 * cgi), rA = *(const LAS f32x4*)(rec + SI_WR + 4 * cgi);
            pg8::f32x2 vA = *(const LAS pg8::f32x2*)(rec + SI_V + 2 * rg), cA = *(const LAS pg8::f32x2*)(rec + SI_SC);
            f32x4 wB, aB, bB, kB, rB; pg8::f32x2 vB, cB;
#define SCAN_FETCH(W, A, B, K, R, V, C) do { rec += SST; W = *(const LAS f32x4*)(rec + SI_W + 4 * cgi); A = *(const LAS f32x4*)(rec + SI_A + 4 * cgi); B = *(const LAS f32x4*)(rec + SI_B + 4 * cgi); \
            K = *(const LAS f32x4*)(rec + SI_K + 4 * cgi); R = *(const LAS f32x4*)(rec + SI_WR + 4 * cgi); V = *(const LAS pg8::f32x2*)(rec + SI_V + 2 * rg); C = *(const LAS pg8::f32x2*)(rec + SI_SC); } while (0)
#define SCAN_STEP(W, A, B, K, R, V, C, qq) do { \
            pg8::f32x2 da = S[0] * A[0]; da = S[1] * A[1] + da; da = S[2] * A[2] + da; da = S[3] * A[3] + da; \
            pg8::f32x2 dw = S[0] * R[0]; dw = S[1] * R[1] + dw; dw = S[2] * R[2] + dw; dw = S[3] * R[3] + dw; \
            { float d0_ = da[0], d1_ = da[1], d2_ = dw[0], d3_ = dw[1]; row16_sum4(d0_, d1_, d2_, d3_); da = (pg8::f32x2){d0_, d1_}; dw = (pg8::f32x2){d2_, d3_}; } \
            const pg8::f32x2 y = dw + da * C[0] + V * C[1]; \
            _Pragma("unroll") for (int j = 0; j < 4; ++j) S[j] = S[j] * W[j] + (da * B[j] + V * K[j]); \
            yk = ((qq) == cgi) ? y : yk; } while (0)
            pg8::f32x2 S[4];
#pragma unroll
            for (int j = 0; j < 4; ++j) S[j] = (pg8::f32x2){s0[j], s1[j]};
            for (int tb = 0; tb < ns; tb += 16) {
                const int nq = (ns - tb) < 16 ? (ns - tb) : 16;
                pg8::f32x2 yk = (pg8::f32x2){0.f, 0.f};
                for (int q = 0; q < nq; q += 2) {
                    SCAN_FETCH(wB, aB, bB, kB, rB, vB, cB);
                    SCAN_STEP(wA, aA, bA, kA, rA, vA, cA, q);
                    SCAN_FETCH(wA, aA, bA, kA, rA, vA, cA);
                    SCAN_STEP(wB, aB, bB, kB, rB, vB, cB, q + 1);
                }
                *(LAS pg8::f32x2*)(ybuf + (tb + cgi) * 64 + 2 * rg) = yk;
            }
#pragma unroll
            for (int j = 0; j < 4; ++j) { s0[j] = S[j][0]; s1[j] = S[j][1]; }
#undef SCAN_FETCH
#undef SCAN_STEP
        }
        __syncthreads();
        if (ptl < ns) {
            const LAS float* rec = cur + ptl * SST;
            const f32x4 y4 = *(const LAS f32x4*)(ybuf + ptl * 64 + pj), v4 = *(const LAS f32x4*)(rec + SI_V + pj), g4 = *(const LAS f32x4*)(rec + SI_G + pj);
            const float rk = rec[SI_SC + 2];
            const float4 lw4 = *(const float4*)(p.in[I_LNW] + pc), lb4 = *(const float4*)(p.in[I_LNB] + pc);
            const float mean = row16_sum((y4.x + y4.y) + (y4.z + y4.w)) * (1.f / 64.f);
            const float d0 = y4.x - mean, d1 = y4.y - mean, d2 = y4.z - mean, d3 = y4.w - mean;
            const float var = row16_sum((d0 * d0 + d1 * d1) + (d2 * d2 + d3 * d3)) * (1.f / 64.f);
            const float rs = rsqrtf(var + 64e-5f);
            const float o0 = (d0 * rs * lw4.x + lb4.x + rk * v4.x) * g4.x, o1 = (d1 * rs * lw4.y + lb4.y + rk * v4.y) * g4.y;
            const float o2 = (d2 * rs * lw4.z + lb4.z + rk * v4.z) * g4.z, o3 = (d3 * rs * lw4.w + lb4.w + rk * v4.w) * g4.w;
            uint2 o; o.x = pk2(o0, o1); o.y = pk2(o2, o3);
            *(uint2*)(MIX + (size_t)(rowB0 + c * CH + ptl) * D + pc) = o;
        }
        if (c + 1 < nch) SCAN_PREP(c + 1, nxt);
        __syncthreads();
    }
#undef SCAN_LOAD
#undef SCAN_PREP
    float* So = p.out + (sample ? O_SWKV : O_PWKV) + ((size_t)(b * 8 + h) * 64 + 2 * rg) * 64 + 4 * cgi;
    *(float4*)So = make_float4(s0[0], s0[1], s0[2], s0[3]); *(float4*)(So + 64) = make_float4(s1[0], s1[1], s1[2], s1[3]);
}

__device__ __forceinline__ void attn_task(const Params& p, int task, int lane) {
    const bf16_t* Q = (const bf16_t*)(p.ws + WS_Q); const bf16_t* K = (const bf16_t*)(p.ws + WS_K);
    bf16_t* MIX = (bf16_t*)((unsigned char*)p.out + SC_C);
    const int b = task >> 11, h = (task >> 8) & 7, r16 = (task >> 4) & 15, ig = task & 15;
    const int li = lane & 15, g = lane >> 4;
    const int tq = r16 + 16 * (16 * ig + li);
    const bf16_t* qp = Q + (size_t)(b * TP + tq) * 512 + h * 64 + 8 * g;
    const bf16x8 qf0 = *(const bf16x8*)qp, qf1 = *(const bf16x8*)(qp + 32);
    float m_run = -1e30f, l_run = 0.f;
    f32x4 o[4];
#pragma unroll
    for (int i = 0; i < 4; ++i) o[i] = (f32x4){0.f, 0.f, 0.f, 0.f};
#pragma unroll 1
    for (int br = 0; br < 3; ++br) {
        int dd, r, uq0, Tdd; const bf16_t* VT;
        if (br == 0) { dd = 16; r = r16; uq0 = 16 * ig; Tdd = TP / 16; VT = (const bf16_t*)(p.ws + WS_VT16); }
        else if (br == 1) { dd = 4; r = r16 & 3; uq0 = (r16 >> 2) + 64 * ig; Tdd = TP / 4; VT = (const bf16_t*)(p.ws + WS_VT4); }
        else { dd = 1; r = 0; uq0 = r16 + 256 * ig; Tdd = TP; VT = (const bf16_t*)(p.ws + WS_VT1); }
        const int s = 16 / dd, uq = uq0 + s * li;
        int ulo = uq0 - 128; if (ulo < 0) ulo = 0; ulo &= ~31;
        const int uhi = uq0 + 15 * s;
        const bf16_t* Kb = K + ((size_t)b * TP + r) * 512 + h * 64 + 8 * g;
        const bf16_t* Vb = VT + ((size_t)(b * 8 + h) * 64 + li) * TP + (size_t)r * Tdd + 4 * g;
#pragma unroll 1
        for (int kt = ulo; kt <= uhi; kt += 32) {
            const bf16_t* kx = Kb + (size_t)(kt + li) * dd * 512; const bf16_t* ky = kx + (size_t)16 * dd * 512;
            const bf16x8 kx0 = *(const bf16x8*)kx, kx1 = *(const bf16x8*)(kx + 32), ky0 = *(const bf16x8*)ky, ky1 = *(const bf16x8*)(ky + 32);
            uint2 va[4], vb[4];
#pragma unroll
            for (int dt = 0; dt < 4; ++dt) { va[dt] = *(const uint2*)(Vb + (size_t)16 * dt * TP + kt); vb[dt] = *(const uint2*)(Vb + (size_t)16 * dt * TP + kt + 16); }
            f32x4 sx = (f32x4){0.f, 0.f, 0.f, 0.f}, sy = (f32x4){0.f, 0.f, 0.f, 0.f};
            sx = __builtin_amdgcn_mfma_f32_16x16x32_bf16(kx0, qf0, sx, 0, 0, 0); sx = __builtin_amdgcn_mfma_f32_16x16x32_bf16(kx1, qf1, sx, 0, 0, 0);
            sy = __builtin_amdgcn_mfma_f32_16x16x32_bf16(ky0, qf0, sy, 0, 0, 0); sy = __builtin_amdgcn_mfma_f32_16x16x32_bf16(ky1, qf1, sy, 0, 0, 0);
            float sv[8]; bool ok[8]; float tmax = -1e30f;
#pragma unroll
            for (int j = 0; j < 4; ++j) { const int dx = uq - (kt + 4 * g + j), dy = dx - 16;
                ok[j] = (unsigned)dx <= 128u; ok[4 + j] = (unsigned)dy <= 128u; sv[j] = ok[j] ? sx[j] : -1e30f; sv[4 + j] = ok[4 + j] ? sy[j] : -1e30f;
                tmax = fmaxf(tmax, fmaxf(sv[j], sv[4 + j])); }
            tmax = fmaxf(tmax, __shfl_xor(tmax, 16)); tmax = fmaxf(tmax, __shfl_xor(tmax, 32));
            const float m_new = fmaxf(m_run, tmax), alpha = __expf(m_run - m_new);
            float pe[8]; float ps = 0.f;
#pragma unroll
            for (int j = 0; j < 8; ++j) { pe[j] = ok[j] ? __expf(sv[j] - m_new) : 0.f; ps += pe[j]; }
            l_run = l_run * alpha + ps; m_run = m_new;
            u32x4 pw; pw[0] = pk2(pe[0], pe[1]); pw[1] = pk2(pe[2], pe[3]); pw[2] = pk2(pe[4], pe[5]); pw[3] = pk2(pe[6], pe[7]);
            const bf16x8 pf = __builtin_bit_cast(bf16x8, pw);
#pragma unroll
            for (int dt = 0; dt < 4; ++dt) {
                u32x4 vw; vw[0] = va[dt].x; vw[1] = va[dt].y; vw[2] = vb[dt].x; vw[3] = vb[dt].y;
                o[dt] *= alpha;
                o[dt] = __builtin_amdgcn_mfma_f32_16x16x32_bf16(__builtin_bit_cast(bf16x8, vw), pf, o[dt], 0, 0, 0);
            }
        }
    }
    float lt = l_run; lt += __shfl_xor(lt, 16); lt += __shfl_xor(lt, 32);
    const float il = 1.f / lt;
    bf16_t* op = MIX + (size_t)(b * TP + tq) * D + 512 + h * 64 + 4 * g;
#pragma unroll
    for (int dt = 0; dt < 4; ++dt) { uint2 w; w.x = pk2(o[dt][0] * il, o[dt][1] * il); w.y = pk2(o[dt][2] * il, o[dt][3] * il); *(uint2*)(op + 16 * dt) = w; }
}
__device__ __forceinline__ void attn_sample_task(const Params& p, int task, int lane, LAS float* wl) {
    const bf16_t* Q = (const bf16_t*)(p.ws + WS_Q); const float* snewk = (const float*)(p.ws + WS_SNEWK); const float* snewv = (const float*)(p.ws + WS_SNEWV);
    const float* CK = p.in[I_CK]; const float* CV = p.in[I_CV];
    bf16_t* MIX = (bf16_t*)((unsigned char*)p.out + SC_C);
    const int b = task >> 6, h = (task >> 3) & 7, tt = task & 7;
    const int rowB = MP + b * TS + tt;
    asm volatile("s_waitcnt lgkmcnt(0)" ::: "memory");
    wl[lane] = bflo((u32)Q[(size_t)rowB * 512 + h * 64 + lane]);
    asm volatile("s_waitcnt lgkmcnt(0)" ::: "memory");
    float mx = -1e30f;
#pragma unroll 1
    for (int c = 0; c < 9; ++c) {
        const int br = c / 3, it = c - br * 3; const int dd = br == 0 ? 1 : (br == 1 ? 4 : 16); const int j = lane + 64 * it;
        const int jc = j <= 128 ? j : 128;
        const int idx = 2048 + tt - jc * dd;
        const float* kr = idx < 2048 ? CK + ((size_t)(b * 2048 + idx) * 8 + h) * 64 : snewk + (size_t)(b * TS + idx - 2048) * 512 + h * 64;
        float s = 0.f;
#pragma unroll
        for (int d4 = 0; d4 < 16; ++d4) { const float4 kv = *(const float4*)(kr + 4 * d4); const f32x4 qv = *(const LAS f32x4*)(wl + 4 * d4);
            s += kv.x * qv[0] + kv.y * qv[1] + kv.z * qv[2] + kv.w * qv[3]; }
        if (j > 128) s = -1e30f;
        wl[64 + c * 64 + lane] = s; mx = fmaxf(mx, s);
    }
#pragma unroll
    for (int o = 1; o < 64; o <<= 1) mx = fmaxf(mx, __shfl_xor(mx, o));
    asm volatile("s_waitcnt lgkmcnt(0)" ::: "memory");
    float ls = 0.f;
#pragma unroll 1
    for (int c = 0; c < 9; ++c) { const float s = wl[64 + c * 64 + lane]; const float e = s > -1e29f ? __expf(s - mx) : 0.f; wl[64 + c * 64 + lane] = e; ls += e; }
    ls = wave_sum(ls);
    asm volatile("s_waitcnt lgkmcnt(0)" ::: "memory");
    float acc = 0.f;
#pragma unroll 1
    for (int c = 0; c < 9; ++c) {
        const int br = c / 3, it = c - br * 3; const int dd = br == 0 ? 1 : (br == 1 ? 4 : 16); const int nj = it < 2 ? 64 : 1;
#pragma unroll 8
        for (int l2 = 0; l2 < nj; ++l2) {
            const int j = l2 + 64 * it; const int idx = 2048 + tt - j * dd;
            const float* vr = idx < 2048 ? CV + ((size_t)(b * 2048 + idx) * 8 + h) * 64 : snewv + (size_t)(b * TS + idx - 2048) * 512 + h * 64;
            acc += wl[64 + c * 64 + l2] * vr[lane];
        }
    }
    const float res = acc / ls;
    const float other = __shfl_xor(res, 1);
    if ((lane & 1) == 0) *(u32*)(MIX + (size_t)rowB * D + 512 + h * 64 + lane) = pk2(res, other);
}

__device__ __forceinline__ void phase_norm1(const Params& p, int tid, int G, int bid) {
    const int wave = tid >> 6, lane = tid & 63, gw = bid * 8 + wave, NGW = G * 8;
    const float* mix = (const float*)((const unsigned char*)p.out + SC_B); bf16_t* H2 = (bf16_t*)((unsigned char*)p.out + SC_C);
    for (int row = gw; row < MB; row += NGW) {
        const float* xrow = row < MP ? p.in[I_XP] + (size_t)row * D : p.in[I_XS] + (size_t)(row - MP) * D;
        const float4* mr = (const float4*)(mix + (size_t)row * D) + lane; const float4* xr = (const float4*)xrow + lane;
        float4 v[4], x[4]; float s = 0.f;
#pragma unroll
        for (int j = 0; j < 4; ++j) { v[j] = mr[64 * j]; x[j] = xr[64 * j]; s += (v[j].x * v[j].x + v[j].y * v[j].y) + (v[j].z * v[j].z + v[j].w * v[j].w); }
        const float rs = rsqrtf(wave_sum(s) * (1.f / D) + 1e-6f);
        float s2 = 0.f;
#pragma unroll
        for (int j = 0; j < 4; ++j) { const float4 gg = *((const float4*)p.in[I_NMPOST] + lane + 64 * j);
            x[j].x += v[j].x * rs * gg.x; x[j].y += v[j].y * rs * gg.y; x[j].z += v[j].z * rs * gg.z; x[j].w += v[j].w * rs * gg.w;
            s2 += (x[j].x * x[j].x + x[j].y * x[j].y) + (x[j].z * x[j].z + x[j].w * x[j].w);
            *((float4*)(p.out + (size_t)row * D) + lane + 64 * j) = x[j]; }
        const float rs2 = rsqrtf(wave_sum(s2) * (1.f / D) + 1e-6f);
#pragma unroll
        for (int j = 0; j < 4; ++j) { const float4 gg = *((const float4*)p.in[I_NFPRE] + lane + 64 * j);
            uint2 o; o.x = pk2(x[j].x * rs2 * gg.x, x[j].y * rs2 * gg.y); o.y = pk2(x[j].z * rs2 * gg.z, x[j].w * rs2 * gg.w);
            *((uint2*)(H2 + (size_t)row * D) + lane + 64 * j) = o; }
    }
}
__device__ __forceinline__ void phase_act(const Params& p, int tid, int G, int bid) {
    const int wave = tid >> 6, lane = tid & 63, gw = bid * 8 + wave, NGW = G * 8;
    bf16_t* U = (bf16_t*)(p.ws + WS_U); const bf16_t* halo = (const bf16_t*)(p.ws + WS_HALO);
    const float* cw = p.in[I_CONVW]; const float* cb = p.in[I_CONVB];
    constexpr int NPI = (MP / 32) * 11, NSI = BS * 11;
    for (int it = gw; it < NPI + NSI; it += NGW) {
        const bool sample = it >= NPI; const int q = sample ? it - NPI : it; const int chunk = q / 11, cgp = q - chunk * 11;
        const int col = cgp * 256 + 4 * lane;
        const float4 wg0 = *(const float4*)(cw + col), wg1 = *(const float4*)(cw + FF2 + col), wg2 = *(const float4*)(cw + 2 * FF2 + col), bg = *(const float4*)(cb + col);
        const float4 wu0 = *(const float4*)(cw + FF + col), wu1 = *(const float4*)(cw + FF2 + FF + col), wu2 = *(const float4*)(cw + 2 * FF2 + FF + col), bu = *(const float4*)(cb + FF + col);
        float g2[4], g1[4], u2[4], u1[4];
        int row0, nrows;
        if (!sample) {
            row0 = chunk * 32; nrows = 32;
            if ((row0 & (TP - 1)) == 0) {
#pragma unroll
                for (int j = 0; j < 4; ++j) { g2[j] = 0.f; g1[j] = 0.f; u2[j] = 0.f; u1[j] = 0.f; }
            } else {
                const bf16_t* hp = halo + (size_t)chunk * 2 * FF2;
                const uint2 a = *(const uint2*)(hp + col), c2 = *(const uint2*)(hp + FF2 + col), e = *(const uint2*)(hp + FF + col), f = *(const uint2*)(hp + FF2 + FF + col);
                g2[0] = bflo(a.x); g2[1] = bfhi(a.x); g2[2] = bflo(a.y); g2[3] = bfhi(a.y); g1[0] = bflo(c2.x); g1[1] = bfhi(c2.x); g1[2] = bflo(c2.y); g1[3] = bfhi(c2.y);
                u2[0] = bflo(e.x); u2[1] = bfhi(e.x); u2[2] = bflo(e.y); u2[3] = bfhi(e.y); u1[0] = bflo(f.x); u1[1] = bfhi(f.x); u1[2] = bflo(f.y); u1[3] = bfhi(f.y);
            }
        } else {
            row0 = MP + chunk * TS; nrows = TS;
            const float* sp = p.in[I_SCONV] + (size_t)chunk * 2 * FF2;
            const float4 a = *(const float4*)(sp + col), c2 = *(const float4*)(sp + FF2 + col), e = *(const float4*)(sp + FF + col), f = *(const float4*)(sp + FF2 + FF + col);
            g2[0] = a.x; g2[1] = a.y; g2[2] = a.z; g2[3] = a.w; g1[0] = c2.x; g1[1] = c2.y; g1[2] = c2.z; g1[3] = c2.w;
            u2[0] = e.x; u2[1] = e.y; u2[2] = e.z; u2[3] = e.w; u1[0] = f.x; u1[1] = f.y; u1[2] = f.z; u1[3] = f.w;
        }
        const float w0g[4] = {wg0.x, wg0.y, wg0.z, wg0.w}, w1g[4] = {wg1.x, wg1.y, wg1.z, wg1.w}, w2g[4] = {wg2.x, wg2.y, wg2.z, wg2.w}, bgg[4] = {bg.x, bg.y, bg.z, bg.w};
        const float w0u[4] = {wu0.x, wu0.y, wu0.z, wu0.w}, w1u[4] = {wu1.x, wu1.y, wu1.z, wu1.w}, w2u[4] = {wu2.x, wu2.y, wu2.z, wu2.w}, buu[4] = {bu.x, bu.y, bu.z, bu.w};
        for (int r0 = 0; r0 < nrows; r0 += 8) {
            uint2 gv[8], uv[8];
#pragma unroll
            for (int i = 0; i < 8; ++i) { const bf16_t* rp = U + (size_t)(row0 + r0 + i) * FF2 + col; gv[i] = *(const uint2*)rp; uv[i] = *(const uint2*)(rp + FF); }
#pragma unroll
            for (int i = 0; i < 8; ++i) {
                const float gc[4] = {bflo(gv[i].x), bfhi(gv[i].x), bflo(gv[i].y), bfhi(gv[i].y)}, uc[4] = {bflo(uv[i].x), bfhi(uv[i].x), bflo(uv[i].y), bfhi(uv[i].y)};
                float o[4];
#pragma unroll
                for (int j = 0; j < 4; ++j) {
                    const float cgv = w0g[j] * g2[j] + w1g[j] * g1[j] + w2g[j] * gc[j] + bgg[j];
                    const float cuv = w0u[j] * u2[j] + w1u[j] * u1[j] + w2u[j] * uc[j] + buu[j];
                    o[j] = cgv * sigmoidf_(cgv) * cuv;
                    g2[j] = g1[j]; g1[j] = gc[j]; u2[j] = u1[j]; u1[j] = uc[j];
                }
                uint2 w; w.x = pk2(o[0], o[1]); w.y = pk2(o[2], o[3]);
                *(uint2*)(U + (size_t)(row0 + r0 + i) * FF2 + col) = w;
            }
        }
    }
}
__device__ __forceinline__ void phase_final(const Params& p, int tid, int G, int bid) {
    const int wave = tid >> 6, lane = tid & 63, gw = bid * 8 + wave, NGW = G * 8;
    const float* F = (const float*)(p.ws + WS_U) + FF / 2;
    for (int row = gw; row < MB; row += NGW) {
        const float4* fr = (const float4*)(F + (size_t)row * (FF2 / 2)) + lane; float4* yr = (float4*)(p.out + (size_t)row * D) + lane;
        float4 v[4]; float s = 0.f;
#pragma unroll
        for (int j = 0; j < 4; ++j) { v[j] = fr[64 * j]; s += (v[j].x * v[j].x + v[j].y * v[j].y) + (v[j].z * v[j].z + v[j].w * v[j].w); }
        const float rs = rsqrtf(wave_sum(s) * (1.f / D) + 1e-6f);
#pragma unroll
        for (int j = 0; j < 4; ++j) { const float4 gg = *((const float4*)p.in[I_NFPOST] + lane + 64 * j); float4 x = yr[64 * j];
            x.x += v[j].x * rs * gg.x; x.y += v[j].y * rs * gg.y; x.z += v[j].z * rs * gg.z; x.w += v[j].w * rs * gg.w; yr[64 * j] = x; }
    }
}
__device__ __forceinline__ void phase_cachecopy(const Params& p, int tid, int G, int bid) {
    const int gt = bid * NTHREADS + tid, NT = G * NTHREADS;
    constexpr int PER_B = 2048 * 512 / 4;
    const float4* snk = (const float4*)(p.ws + WS_SNEWK); const float4* snv = (const float4*)(p.ws + WS_SNEWV);
    for (int i = gt; i < 2 * BS * PER_B; i += NT) {
        const int which = i >= BS * PER_B; const int q = which ? i - BS * PER_B : i; const int b = q / PER_B, r = q - b * PER_B;
        const float4* src = (const float4*)p.in[which ? I_CV : I_CK] + (size_t)b * PER_B;
        float4 v;
        if (r < 2040 * 128) v = src[r + 8 * 128]; else v = (which ? snv : snk)[(size_t)b * TS * 128 + (r - 2040 * 128)];
        ((float4*)(p.out + (which ? O_SV : O_SK)))[(size_t)b * PER_B + r] = v;
    }
}

template <int PH>
__device__ __forceinline__ void run_phase(const Params& p, LAS unsigned char* lds, int tid, int G, int bid) {
    if constexpr (PH == 0) { phase0(p, lds, tid, G, bid); __syncthreads(); }
    else if constexpr (PH == 1) {
        pg8::Gemm g{(const bf16_t*)((const unsigned char*)p.out + SC_B), (const bf16_t*)(p.ws + WS_WIN), MA, DIN, D, D}; pg8::StaticOrder S; S.init(MA, DIN, G, bid);
        EpiProj E{(bf16_t*)(p.ws + WS_PROJRW), (bf16_t*)(p.ws + WS_Q), (bf16_t*)(p.ws + WS_K), (bf16_t*)(p.ws + WS_VT1), (bf16_t*)(p.ws + WS_VT4), (bf16_t*)(p.ws + WS_VT16),
                  (const float*)(p.ws + WS_ROPE), p.out, (float*)(p.ws + WS_SNEWK), (float*)(p.ws + WS_SNEWV)};
        pg8::gemm_phase<EpiProj, pg8::StaticOrder, false>(lds, g, S, E, nullptr);
    } else if constexpr (PH == 2) phase_alora(p, tid, G, bid);
    else if constexpr (PH == 3) {
        pg8::Gemm g{(const bf16_t*)(p.ws + WS_ALORA), (const bf16_t*)(p.ws + WS_WLORA), MB, NLORA, KLORA, KLORA}; pg8::StaticOrder S; S.init(MB, NLORA, G, bid);
        EpiDag E{(bf16_t*)((unsigned char*)p.out + SC_B), p.in[I_W0], p.in[I_A0]};
        pg8::gemm_phase<EpiDag, pg8::StaticOrder, false>(lds, g, S, E, nullptr);
    } else if constexpr (PH == 4 || PH == 11 || PH == 12) {
        const int NSCAN = G >= 128 ? 64 : (G / 2 > 0 ? G / 2 : 1);
        if (bid < NSCAN) {
            if constexpr (PH != 12) for (int it = bid; it < 64 + 256; it += NSCAN) { const bool smp = it >= 64; const int q = smp ? it - 64 : it; scan_item(p, lds, tid, smp, q >> 3, q & 7); }
        } else {
            if constexpr (PH != 11) { const int wave = tid >> 6, lane = tid & 63, aw = (bid - NSCAN) * 8 + wave, NAW = (G - NSCAN) * 8;
                for (int t = aw; t < 16384 + 2048; t += NAW) { if (t < 16384) attn_task(p, t, lane); else attn_sample_task(p, t - 16384, lane, (LAS float*)(lds + wave * 4096)); } }
        }
    } else if constexpr (PH == 5) {
        pg8::Gemm g{(const bf16_t*)((const unsigned char*)p.out + SC_C), (const bf16_t*)(p.ws + WS_WOUT), MB, D, D, D}; pg8::StaticOrder S; S.init(MB, D, G, bid);
        pg8::EpiF32 E{(float*)((unsigned char*)p.out + SC_B), D, nullptr};
        pg8::gemm_phase<pg8::EpiF32, pg8::StaticOrder, false>(lds, g, S, E, nullptr);
    } else if constexpr (PH == 6) phase_norm1(p, tid, G, bid);
    else if constexpr (PH == 7) {
        pg8::Gemm g{(const bf16_t*)((const unsigned char*)p.out + SC_C), (const bf16_t*)(p.ws + WS_WUP), MB, FF2, D, D}; pg8::StaticOrder S; S.init(MB, FF2, G, bid);
        EpiUp E{(bf16_t*)(p.ws + WS_U), (bf16_t*)(p.ws + WS_HALO), p.out};
        pg8::gemm_phase<EpiUp, pg8::StaticOrder, false>(lds, g, S, E, nullptr);
    } else if constexpr (PH == 8) phase_act(p, tid, G, bid);
    else if constexpr (PH == 9) {
        pg8::Gemm g{(const bf16_t*)(p.ws + WS_U), (const bf16_t*)(p.ws + WS_WDN), MB, D, FF, FF2}; pg8::StaticOrder S; S.init(MB, D, G, bid);
        pg8::EpiF32 E{(float*)(p.ws + WS_U) + FF / 2, FF2 / 2, nullptr};
        pg8::gemm_phase<pg8::EpiF32, pg8::StaticOrder, false>(lds, g, S, E, nullptr);
    } else if constexpr (PH == 10) { phase_final(p, tid, G, bid); phase_cachecopy(p, tid, G, bid); }
}
template <int FIRST, int... REST>
__device__ __forceinline__ void run_program(const Params& p, LAS unsigned char* lds, cg::grid_group& grid, int tid, int G, int bid) {
    if (p.en > (int)sizeof...(REST) - 1000) run_phase<FIRST>(p, lds, tid, G, bid);
    if constexpr (sizeof...(REST) > 0) { grid.sync(); run_program<REST...>(p, lds, grid, tid, G, bid); }
}
#define PROGRAM 0, 1, 2, 3, 4, 5, 6, 7, 8, 9, 10
__global__ void __launch_bounds__(NTHREADS, 2) hymba_fwd(Params p) {
    extern __shared__ __attribute__((aligned(16))) unsigned char lds_raw[];
    LAS unsigned char* lds = (LAS unsigned char*)lds_raw;
    cg::grid_group grid = cg::this_grid();
    run_program<PROGRAM>(p, lds, grid, threadIdx.x, gridDim.x, blockIdx.x);
}

extern "C" void kernel_launch(void* const* d_in, const int* in_sizes, int n_in, void* d_out, int out_size, void* d_ws, size_t ws_size, hipStream_t stream) {
    static int grid = 0;
    if (grid == 0) {
        if (n_in != 28 || (size_t)out_size != O_END || ws_size < WS_END) { fprintf(stderr, "kernel_launch: unexpected sizes n_in %d out %d ws %zu (need %zu)\n", n_in, out_size, ws_size, (size_t)WS_END); grid = -1; return; }
        int dev = 0, cus = 0, per_cu = 0;
        hipGetDevice(&dev); hipDeviceGetAttribute(&cus, hipDeviceAttributeMultiprocessorCount, dev);
        if (hipFuncSetAttribute((const void*)hymba_fwd, hipFuncAttributeMaxDynamicSharedMemorySize, LDS_BYTES) != hipSuccess) { fprintf(stderr, "kernel_launch: hipFuncSetAttribute failed\n"); grid = -1; return; }
        hipOccupancyMaxActiveBlocksPerMultiprocessor(&per_cu, (const void*)hymba_fwd, NTHREADS, LDS_BYTES);
        (void)hipGetLastError();
        if (per_cu < 1) per_cu = 1;
        grid = cus;
    }
    if (grid < 0) return;
    Params p{};
    for (int i = 0; i < 28; ++i) p.in[i] = (const float*)d_in[i];
    p.out = (float*)d_out; p.ws = (unsigned char*)d_ws; p.en = 1;
    void* args[] = {&p};
    hipError_t e = hipLaunchCooperativeKernel((const void*)hymba_fwd, dim3(grid), dim3(NTHREADS), args, LDS_BYTES, stream);
    if (e != hipSuccess) fprintf(stderr, "cooperative launch failed: %s (grid %d)\n", hipGetErrorString(e), grid);
}
```

```cpp
#include <hip/hip_runtime.h>
#include <hip/hip_cooperative_groups.h>
#include <cstdio>
#include <cstdint>
namespace pg8 {
#define PG8_LAS __attribute__((address_space(3)))
typedef unsigned short bf16_t;
typedef short bf16x8 __attribute__((ext_vector_type(8)));
typedef float f32x4 __attribute__((ext_vector_type(4)));
typedef unsigned u32x4 __attribute__((ext_vector_type(4)));
constexpr int BM = 256, BK = 64, HALF = 128, HTB = HALF * BK * 2  , STAGE_BYTES = 8 * HTB, NXCD = 8, WGM = 8;

__host__ __device__ __forceinline__ int lds_byte(int r, int c) { const int st = (r >> 4) * 2 + (c >> 5), rr = r & 15, cc = c & 31, ob = rr * 64 + cc * 2; return st * 1024 + (ob ^ (((ob >> 9) & 1) << 5)); }
__host__ __device__ __forceinline__ void stage_rc(int b, int& R, int& C) { const int st = b / 1024, sb = b % 1024, swz = sb ^ (((sb >> 9) & 1) << 5); R = (st >> 1) * 16 + swz / 64; C = (st & 1) * 32 + (swz % 64) / 2; }
__host__ __device__ __forceinline__ int perm32(int rho) { const int n = rho >> 4, i = rho & 15; return 8 * (i >> 2) + 4 * n + (i & 3); }

struct Unit { int pm, pn; };
struct Gemm { const bf16_t* A; const bf16_t* Bt; int M, N, K, lda; };

struct StaticOrder {
    int nM, nN, nwg, G, c;
    __host__ __device__ void init(int M, int N, int G_, int c_) { nM = M / BM; nN = N / BM; nwg = nM * nN; G = G_; c = c_; }
    __host__ __device__ bool next(int i, Unit& u) const {
        const long L = (long)i * G + c; if (L >= nwg) return false;
        int wgid = (int)L; { const int q = nwg / NXCD, r = nwg % NXCD, xcd = wgid % NXCD, off = wgid / NXCD; wgid = (xcd < r ? xcd * (q + 1) : r * (q + 1) + (xcd - r) * q) + off; }
        const int nig = WGM * nN, gid = wgid / nig, fm = gid * WGM, gsz = (nM - fm) < WGM ? (nM - fm) : WGM;
        u.pm = fm + ((wgid % nig) % gsz); u.pn = (wgid % nig) / gsz; return true;
    }
    __device__ __forceinline__ void a_ready(const Unit&) const {}
    __device__ __forceinline__ void done(const Unit&) const {}
};
__device__ __forceinline__ unsigned cvt_pk_bf16(float lo, float hi) { unsigned r; asm volatile("v_cvt_pk_bf16_f32 %0, %1, %2" : "=v"(r) : "v"(lo), "v"(hi)); return r; }
typedef float f32x2 __attribute__((ext_vector_type(2)));
struct EpiF32 {
    static constexpr bool PERM = false, AFTER_DRAIN = false;
    float* C; int ldc; const float* bias;
    __device__ __forceinline__ void operator()(const f32x4 (&acc)[2][2][4][2], const Unit& u, int wr, int wc, int fr, int fq) const {
        const int row0 = u.pm * BM + wr * 64 + fr, col0 = u.pn * BM + wc * 32 + 4 * fq;
        f32x4 bv[2][2];
#pragma unroll
        for (int bj = 0; bj < 2; ++bj)
#pragma unroll
            for (int n = 0; n < 2; ++n) bv[bj][n] = bias ? *(const f32x4*)(bias + col0 + bj * HALF + n * 16) : (f32x4){0.f, 0.f, 0.f, 0.f};
#pragma unroll
        for (int ai = 0; ai < 2; ++ai)
#pragma unroll
            for (int m = 0; m < 4; ++m) { float* rowp = C + (size_t)(row0 + ai * HALF + m * 16) * ldc + col0;
#pragma unroll
                for (int bj = 0; bj < 2; ++bj)
#pragma unroll
                    for (int n = 0; n < 2; ++n) *(f32x4*)(rowp + bj * HALF + n * 16) = acc[ai][bj][m][n] + bv[bj][n]; }
    }
};
template <class Epi, class Sched, bool STAMP = false>
__device__ __forceinline__ void gemm_phase(PG8_LAS unsigned char* lds, const Gemm g, const Sched& S, const Epi& E, unsigned long long* stamps) {
    const int tid = threadIdx.x, wid = __builtin_amdgcn_readfirstlane(tid >> 6), lane = tid & 63, wr = wid >> 2, wc = wid & 3, fr = lane & 15, fq = lane >> 4;
    const int K = g.K, nt = K / BK;
    int ts_lo = 0, ts_hi = 0, nts = 0; const unsigned long long rt_entry = STAMP ? (unsigned long long)wall_clock64() : 0ull;
#define PG8_STAMP() do { if (STAMP && wid == 0 && nts < 64) { const unsigned long long _c = (unsigned long long)clock64(); \
        ts_lo = (lane == nts) ? (int)(unsigned)_c : ts_lo; ts_hi = (lane == nts) ? (int)(unsigned)(_c >> 32) : ts_hi; ++nts; } } while (0)
    PG8_STAMP();
    unsigned voffA[2], voffB[2];
#pragma unroll
    for (int i = 0; i < 2; ++i) { int R, C; stage_rc(tid * 16 + i * 8192, R, C); const int Rb = Epi::PERM ? ((R & ~31) + perm32(R & 31)) : R;
        voffA[i] = (unsigned)(R * g.lda + C) * 2u; voffB[i] = (unsigned)(Rb * K + C) * 2u; }
    const size_t kstep = (size_t)(BK * 2);
    const size_t hstep = (size_t)HALF * K * 2, hstepA = (size_t)HALF * g.lda * 2;
    const size_t tstep = 2 * hstep, tstepA = 2 * hstepA;
    const unsigned ldsw = (unsigned)wid * 1024u;
    const int aoff = lds_byte(wr * 64 + fr, fq * 8), boff = lds_byte(wc * 32 + fr, fq * 8);
#define PG8_SA(b, h) (((b) * 2 + (h)) * HTB)
#define PG8_SB(b, h) ((4 + (b) * 2 + (h)) * HTB)
#define PG8_STAGE(bufoff, gbase, voff) do { _Pragma("unroll") for (int _i = 0; _i < 2; ++_i) \
        __builtin_amdgcn_global_load_lds((const unsigned*)((const char*)(gbase) + (voff)[_i]), (PG8_LAS unsigned*)(lds + (bufoff) + ldsw + _i * 8192), 16, 0, 0); } while (0)
#define PG8_LDA(dst, b, h) do { _Pragma("unroll") for (int m = 0; m < 4; ++m) _Pragma("unroll") for (int k = 0; k < 2; ++k) dst[m][k] = *(const PG8_LAS bf16x8*)(lds + PG8_SA(b, h) + aoff + m * 2048 + k * 1024); } while (0)
#define PG8_LDB(dst, b, h) do { _Pragma("unroll") for (int n = 0; n < 2; ++n) _Pragma("unroll") for (int k = 0; k < 2; ++k) dst[n][k] = *(const PG8_LAS bf16x8*)(lds + PG8_SB(b, h) + boff + n * 2048 + k * 1024); } while (0)
#define PG8_MMA(ai, bj, At, Bt) do { __builtin_amdgcn_s_setprio(1); _Pragma("unroll") for (int m = 0; m < 4; ++m) _Pragma("unroll") for (int n = 0; n < 2; ++n) _Pragma("unroll") for (int k = 0; k < 2; ++k) \
        acc[ai][bj][m][n] = __builtin_amdgcn_mfma_f32_16x16x32_bf16(Bt[n][k], At[m][k], acc[ai][bj][m][n], 0, 0, 0); __builtin_amdgcn_s_setprio(0); } while (0)
#define PG8_WAIT_V(n) asm volatile("s_waitcnt vmcnt(" #n ")" ::: "memory")
#define PG8_WAIT_L(n) asm volatile("s_waitcnt lgkmcnt(" #n ")" ::: "memory")
#define PG8_BAR __builtin_amdgcn_s_barrier()
#define PG8_SCHED __builtin_amdgcn_sched_barrier(0)
    Unit cur, nxt; int ui = 0;
    if (!S.next(0, cur)) return;
    f32x4 acc[2][2][4][2];
#pragma unroll
    for (int a = 0; a < 2; ++a)
#pragma unroll
        for (int b = 0; b < 2; ++b)
#pragma unroll
            for (int m = 0; m < 4; ++m)
#pragma unroll
                for (int n = 0; n < 2; ++n) acc[a][b][m][n] = (f32x4){0.f, 0.f, 0.f, 0.f};
    bf16x8 At[4][2], B0[2][2], B1[2][2];
    const char* cA = (const char*)g.A + (size_t)cur.pm * tstepA; const char* cB = (const char*)g.Bt + (size_t)cur.pn * tstep;
    S.a_ready(cur);
    PG8_STAGE(PG8_SB(0, 0), cB, voffB); PG8_STAGE(PG8_SA(0, 0), cA, voffA); PG8_STAGE(PG8_SB(0, 1), cB + hstep, voffB); PG8_STAGE(PG8_SA(0, 1), cA + hstepA, voffA);
    if (wr == 1) PG8_BAR;
    PG8_WAIT_V(4); PG8_BAR;
    PG8_STAGE(PG8_SB(1, 0), cB + kstep, voffB); PG8_STAGE(PG8_SA(1, 0), cA + kstep, voffA); PG8_STAGE(PG8_SB(1, 1), cB + hstep + kstep, voffB);
    PG8_WAIT_V(6); PG8_BAR;
    PG8_STAMP();
    for (;;) {
        const bool has_next = S.next(ui + 1, nxt);
        const char* nA = has_next ? (const char*)g.A + (size_t)nxt.pm * tstepA : cA; const char* nB = has_next ? (const char*)g.Bt + (size_t)nxt.pn * tstep : cB;
        for (int t = 0; t < nt; t += 2) {
            const bool last = (t == nt - 2);
            const char* a1 = cA + (size_t)(t + 1) * kstep;
            const char* a2 = last ? nA : cA + (size_t)(t + 2) * kstep; const char* b2 = last ? nB : cB + (size_t)(t + 2) * kstep;
            const char* a3 = a2 + kstep; const char* b3 = b2 + kstep;
            if (last && has_next) S.a_ready(nxt);
            PG8_LDB(B0, 0, 0); PG8_SCHED; PG8_LDA(At, 0, 0); PG8_STAGE(PG8_SA(1, 1), a1 + hstepA, voffA);
            PG8_WAIT_L(8); PG8_BAR; PG8_WAIT_L(0); PG8_MMA(0, 0, At, B0); PG8_BAR; PG8_SCHED;
            PG8_LDB(B1, 0, 1); PG8_STAGE(PG8_SB(0, 0), b2, voffB);
            PG8_BAR; PG8_WAIT_L(0); PG8_MMA(0, 1, At, B1); PG8_BAR;
            PG8_LDA(At, 0, 1); PG8_STAGE(PG8_SA(0, 0), a2, voffA);
            PG8_BAR; PG8_WAIT_L(0); PG8_MMA(1, 0, At, B0); PG8_BAR; PG8_SCHED;
            PG8_STAGE(PG8_SB(0, 1), b2 + hstep, voffB);
            PG8_WAIT_V(6); PG8_BAR; PG8_MMA(1, 1, At, B1); PG8_BAR;
            PG8_LDB(B0, 1, 0); PG8_SCHED; PG8_LDA(At, 1, 0); PG8_STAGE(PG8_SA(0, 1), a2 + hstepA, voffA);
            PG8_WAIT_L(8); PG8_BAR; PG8_WAIT_L(0); PG8_MMA(0, 0, At, B0); PG8_BAR; PG8_SCHED;
            PG8_LDB(B1, 1, 1); PG8_STAGE(PG8_SB(1, 0), b3, voffB);
            PG8_BAR; PG8_WAIT_L(0); PG8_MMA(0, 1, At, B1); PG8_BAR;
            PG8_LDA(At, 1, 1); PG8_STAGE(PG8_SA(1, 0), a3, voffA);
            PG8_BAR; PG8_WAIT_L(0); PG8_MMA(1, 0, At, B0); PG8_BAR; PG8_SCHED;
            PG8_STAGE(PG8_SB(1, 1), b3 + hstep, voffB);
            PG8_WAIT_V(6); PG8_BAR; PG8_MMA(1, 1, At, B1); PG8_BAR;
        }
        PG8_STAMP();
        if constexpr (!Epi::AFTER_DRAIN) { E(acc, cur, wr, wc, fr, fq); S.done(cur); }
        PG8_STAMP();
        if (!has_next) break;
#pragma unroll
        for (int a = 0; a < 2; ++a)
#pragma unroll
            for (int b = 0; b < 2; ++b)
#pragma unroll
                for (int m = 0; m < 4; ++m)
#pragma unroll
                    for (int n = 0; n < 2; ++n) acc[a][b][m][n] = (f32x4){0.f, 0.f, 0.f, 0.f};
        cur = nxt; cA = nA; cB = nB; ++ui;
    }
    PG8_WAIT_V(0);
    if (wr == 0) PG8_BAR;
    PG8_BAR;
    if constexpr (Epi::AFTER_DRAIN) { E.fused(acc, cur, wr, wc, fr, fq, lds, wid, lane); S.done(cur); }
    PG8_STAMP();
    if (STAMP && wid == 0) { stamps[lane] = lane < nts ? (((unsigned long long)(unsigned)ts_hi << 32) | (unsigned)ts_lo) : 0ull;
        if (lane == 62) stamps[62] = rt_entry; if (lane == 63) stamps[63] = (unsigned long long)wall_clock64(); }
#undef PG8_STAMP
#undef PG8_SA
#undef PG8_SB
#undef PG8_STAGE
#undef PG8_LDA
#undef PG8_LDB
#undef PG8_MMA
#undef PG8_WAIT_V
#undef PG8_WAIT_L
#undef PG8_BAR
#undef PG8_SCHED
}
}

namespace cg = cooperative_groups;
#define LAS __attribute__((address_space(3)))
typedef unsigned short bf16_t;
typedef unsigned int u32;
typedef pg8::bf16x8 bf16x8;
typedef pg8::f32x4 f32x4;
typedef pg8::u32x4 u32x4;

constexpr int D = 1024, TP = 4096, BP = 8, MP = BP * TP, BS = 32, TS = 8, MS = BS * TS;
constexpr int MB = MP + MS;
constexpr int MA = 33280;
constexpr int MA_REAL = MP + BS * 9;
constexpr int DIN = 3328, RCOLS = 1792, FF = 2816, FF2 = 5632, NLORA = 1536, KLORA = 256;
constexpr int NTHREADS = 512;
constexpr int LDS_BYTES = 144 * 1024;

constexpr size_t O_YP = 0;
constexpr size_t O_YS = O_YP + (size_t)MP * D;
constexpr size_t O_PSH = O_YS + (size_t)MS * D;
constexpr size_t O_PWKV = O_PSH + (size_t)BP * D;
constexpr size_t O_PK = O_PWKV + (size_t)BP * 8 * 64 * 64;
constexpr size_t O_PV = O_PK + (size_t)BP * 2048 * 512;
constexpr size_t O_PCONV = O_PV + (size_t)BP * 2048 * 512;
constexpr size_t O_SSH = O_PCONV + (size_t)BP * 2 * FF2;
constexpr size_t O_SWKV = O_SSH + (size_t)BS * D;
constexpr size_t O_SK = O_SWKV + (size_t)BS * 8 * 64 * 64;
constexpr size_t O_SV = O_SK + (size_t)BS * 2048 * 512;
constexpr size_t O_SCONV = O_SV + (size_t)BS * 2048 * 512;
constexpr size_t O_END = O_SCONV + (size_t)BS * 2 * FF2;

constexpr size_t al256(size_t x) { return (x + 255) & ~(size_t)255; }
constexpr size_t WS_WIN = 0;
constexpr size_t WS_WOUT = WS_WIN + al256((size_t)DIN * D * 2);
constexpr size_t WS_WUP = WS_WOUT + al256((size_t)D * D * 2);
constexpr size_t WS_WDN = WS_WUP + al256((size_t)FF2 * D * 2);
constexpr size_t WS_WLORA = WS_WDN + al256((size_t)D * FF * 2);
constexpr size_t WS_ROPE = WS_WLORA + al256((size_t)NLORA * KLORA * 2);
constexpr int NPOS = 4104;
constexpr size_t WS_SNEWK = WS_ROPE + al256((size_t)NPOS * 32 * 2 * 4);
constexpr size_t WS_SNEWV = WS_SNEWK + al256((size_t)MS * 512 * 4);
constexpr size_t WS_HALO = WS_SNEWV + al256((size_t)MS * 512 * 4);
constexpr size_t WS_A = WS_HALO + al256((size_t)1025 * 2 * FF2 * 2);
constexpr size_t WS_PROJRW = WS_A;
constexpr size_t WS_Q = WS_PROJRW + al256((size_t)MA * RCOLS * 2);
constexpr size_t WS_K = WS_Q + al256((size_t)MB * 512 * 2);
constexpr size_t WS_VT1 = WS_K + al256((size_t)MB * 512 * 2);
constexpr size_t WS_VT4 = WS_VT1 + al256((size_t)BP * 8 * 64 * TP * 2);
constexpr size_t WS_VT16 = WS_VT4 + al256((size_t)BP * 8 * 64 * TP * 2);
constexpr size_t WS_ALORA = WS_VT16 + al256((size_t)BP * 8 * 64 * TP * 2);
constexpr size_t WS_VROW = WS_ALORA + al256((size_t)MB * KLORA * 2);
constexpr size_t WS_A_EARLY_END = WS_VROW + al256((size_t)MP * 512 * 2);
constexpr size_t WS_U = WS_A;
constexpr size_t WS_END = WS_A + al256((size_t)MB * FF2 * 2);
static_assert(WS_A_EARLY_END <= WS_END, "region A overflow");
constexpr size_t SC_B = O_SK * 4;
constexpr size_t SC_C = SC_B + al256((size_t)MB * D * 4);
static_assert(SC_C + (size_t)MB * D * 2 <= O_SCONV * 4, "scratch overflow");
static_assert((size_t)MA * D * 2 <= (size_t)MB * D * 4 && (size_t)MB * NLORA * 2 <= (size_t)MB * D * 4, "region B");

struct Params {
    const float* in[28];
    float* out;
    unsigned char* ws;
    int en, pad;
};

enum { I_XP = 0, I_XS, I_SSHIFT, I_SWKV, I_CK, I_CV, I_SCONV, I_NMPRE, I_NMPOST, I_NFPRE, I_NFPOST, I_WIN, I_MU, I_W0, I_WDEC, I_A0, I_WICLR, I_WGATE,
       I_KK, I_KA, I_RK, I_LNW, I_LNB, I_WOUT, I_WUP, I_CONVW, I_CONVB, I_WDN };

__device__ __forceinline__ float bflo(u32 p) { return __uint_as_float(p << 16); }
__device__ __forceinline__ float bfhi(u32 p) { return __uint_as_float(p & 0xffff0000u); }
__device__ __forceinline__ u32 pk2(float a, float b) { return pg8::cvt_pk_bf16(a, b); }
__device__ __forceinline__ float wave_sum(float v) {
#pragma unroll
    for (int o = 1; o < 64; o <<= 1) v += __shfl_xor(v, o);
    return v;
}
template <int N> __device__ __forceinline__ float dpp_ror(float x) {
    return __int_as_float(__builtin_amdgcn_update_dpp(0, __float_as_int(x), 0x120 + N, 0xF, 0xF, false));
}
__device__ __forceinline__ float row16_sum(float x) {
    x += dpp_ror<8>(x); x += dpp_ror<4>(x); x += dpp_ror<2>(x); x += dpp_ror<1>(x);
    return x;
}
__device__ __forceinline__ void row16_sum4(float& a, float& b, float& c, float& d) {
    asm volatile("s_nop 1\n\t"
                 "v_add_f32_dpp %0, %0, %0 row_ror:8 row_mask:0xf bank_mask:0xf\n\t" "v_add_f32_dpp %1, %1, %1 row_ror:8 row_mask:0xf bank_mask:0xf\n\t"
                 "v_add_f32_dpp %2, %2, %2 row_ror:8 row_mask:0xf bank_mask:0xf\n\t" "v_add_f32_dpp %3, %3, %3 row_ror:8 row_mask:0xf bank_mask:0xf\n\t"
                 "v_add_f32_dpp %0, %0, %0 row_ror:4 row_mask:0xf bank_mask:0xf\n\t" "v_add_f32_dpp %1, %1, %1 row_ror:4 row_mask:0xf bank_mask:0xf\n\t"
                 "v_add_f32_dpp %2, %2, %2 row_ror:4 row_mask:0xf bank_mask:0xf\n\t" "v_add_f32_dpp %3, %3, %3 row_ror:4 row_mask:0xf bank_mask:0xf\n\t"
                 "v_add_f32_dpp %0, %0, %0 row_ror:2 row_mask:0xf bank_mask:0xf\n\t" "v_add_f32_dpp %1, %1, %1 row_ror:2 row_mask:0xf bank_mask:0xf\n\t"
                 "v_add_f32_dpp %2, %2, %2 row_ror:2 row_mask:0xf bank_mask:0xf\n\t" "v_add_f32_dpp %3, %3, %3 row_ror:2 row_mask:0xf bank_mask:0xf\n\t"
                 "v_add_f32_dpp %0, %0, %0 row_ror:1 row_mask:0xf bank_mask:0xf\n\t" "v_add_f32_dpp %1, %1, %1 row_ror:1 row_mask:0xf bank_mask:0xf\n\t"
                 "v_add_f32_dpp %2, %2, %2 row_ror:1 row_mask:0xf bank_mask:0xf\n\t" "v_add_f32_dpp %3, %3, %3 row_ror:1 row_mask:0xf bank_mask:0xf\n\t"
                 "s_nop 1"
                 : "+v"(a), "+v"(b), "+v"(c), "+v"(d));
}
__device__ __forceinline__ float sigmoidf_(float x) { return 1.f / (1.f + __expf(-x)); }

__device__ __forceinline__ int win_rowmap(int n) {
    if (n < RCOLS || n >= RCOLS + 1024) return n;
    const int base = (n < RCOLS + 512) ? RCOLS : RCOLS + 512, c = n - base, unit = c >> 8, cu = c & 255, hu = cu >> 6, d = cu & 63, e = d & 31, s = d >> 5;
    const int idx = hu * 32 + e, bj = idx >> 6, wc = (idx & 63) >> 4, fq = (idx & 15) >> 2, j = idx & 3;
    return base + unit * 256 + 128 * bj + 32 * wc + 16 * s + 4 * fq + j;
}
__device__ __forceinline__ void transpose_item(const float* W, int K, int N, bf16_t* WT, int mode, LAS float* scr, int item, int lane) {
    const int nblk = N / 32, kb = item / nblk, nb = item % nblk, k0 = 64 * kb, n0 = 32 * nb;
#pragma unroll 8
    for (int i = 0; i < 32; ++i) { const int kk = 2 * i + (lane >> 5); scr[kk * 33 + (lane & 31)] = W[(size_t)(k0 + kk) * N + n0 + (lane & 31)]; }
    asm volatile("s_waitcnt lgkmcnt(0)" ::: "memory");
    const int c = lane & 7;
#pragma unroll
    for (int j = 0; j < 4; ++j) { const int n = (lane >> 3) + 8 * j; const LAS float* s = scr + (8 * c) * 33 + n;
        uint4 o; o.x = pk2(s[0 * 33], s[1 * 33]); o.y = pk2(s[2 * 33], s[3 * 33]); o.z = pk2(s[4 * 33], s[5 * 33]); o.w = pk2(s[6 * 33], s[7 * 33]);
        const int row = mode ? win_rowmap(n0 + n) : (n0 + n);
        *(uint4*)(WT + (size_t)row * K + k0 + 8 * c) = o; }
    asm volatile("s_waitcnt lgkmcnt(0)" ::: "memory");
}
__device__ __forceinline__ void rms_row(const float* xrow, const float* g, bf16_t* orow, float* frow, int lane) {
    const float4* xr = (const float4*)xrow + lane; const float4* gr = (const float4*)g + lane;
    float4 v[4]; float s = 0.f;
#pragma unroll
    for (int j = 0; j < 4; ++j) { v[j] = xr[64 * j]; s += (v[j].x * v[j].x + v[j].y * v[j].y) + (v[j].z * v[j].z + v[j].w * v[j].w); }
    const float rs = rsqrtf(wave_sum(s) * (1.f / D) + 1e-6f);
#pragma unroll
    for (int j = 0; j < 4; ++j) { const float4 gg = gr[64 * j];
        float4 y; y.x = v[j].x * rs * gg.x; y.y = v[j].y * rs * gg.y; y.z = v[j].z * rs * gg.z; y.w = v[j].w * rs * gg.w;
        uint2 o; o.x = pk2(y.x, y.y); o.y = pk2(y.z, y.w);
        *((uint2*)orow + lane + 64 * j) = o;
        if (frow) *((float4*)frow + lane + 64 * j) = y; }
}
__device__ __forceinline__ void phase0(const Params& p, LAS unsigned char* lds, int tid, int G, int bid) {
    const int wave = tid >> 6, lane = tid & 63, gw = bid * 8 + wave, NGW = G * 8;
    LAS float* scr = (LAS float*)(lds + wave * 16384);
    bf16_t* WinT = (bf16_t*)(p.ws + WS_WIN); bf16_t* WoutT = (bf16_t*)(p.ws + WS_WOUT); bf16_t* WupT = (bf16_t*)(p.ws + WS_WUP); bf16_t* WdnT = (bf16_t*)(p.ws + WS_WDN);
    constexpr int I1 = (D / 64) * (DIN / 32), I2 = (D / 64) * (D / 32), I3 = (D / 64) * (FF2 / 32), I4 = (FF / 64) * (D / 32);
    for (int it = gw; it < I1 + I2 + I3 + I4; it += NGW) {
        int r = it;
        if (r < I1) { transpose_item(p.in[I_WIN], D, DIN, WinT, 1, scr, r, lane); continue; } r -= I1;
        if (r < I2) { transpose_item(p.in[I_WOUT], D, D, WoutT, 0, scr, r, lane); continue; } r -= I2;
        if (r < I3) { transpose_item(p.in[I_WUP], D, FF2, WupT, 0, scr, r, lane); continue; } r -= I3;
        transpose_item(p.in[I_WDN], FF, D, WdnT, 0, scr, r, lane);
    }
    const int gt = bid * NTHREADS + tid, NT = G * NTHREADS;
    bf16_t* WL = (bf16_t*)(p.ws + WS_WLORA);
    for (int i = gt; i < NLORA * KLORA; i += NT) {
        const int row = i >> 8, k = i & 255; float v = 0.f;
        if (row < 512) { if (k < 64) v = p.in[I_WDEC][k * 512 + row]; }
        else if (row < 1024) { if (k >= 64 && k < 128) v = p.in[I_WICLR][(k - 64) * 512 + (row - 512)]; }
        else { if (k >= 128) v = p.in[I_WGATE][(k - 128) * 512 + (row - 1024)]; }
        WL[i] = (bf16_t)(pk2(v, 0.f) & 0xffffu);
    }
    float* rope = (float*)(p.ws + WS_ROPE);
    for (int i = gt; i < NPOS * 32; i += NT) {
        const int pi = i >> 5, e = i & 31; const int pos = pi < TP ? pi : 16384 + (pi - TP);
        double inv = 1.0; for (int q = 0; q < e; ++q) inv *= 0.7498942093324558273;
        const float ang = (float)pos * (float)inv;
        const double a = (double)ang; const double kq = rint(a * 0.15915494309189535); double r = a - kq * 6.283185307179586; r -= kq * 2.4492935982947064e-16;
        const double r2 = r * r;
        double sn = 1.0 / 51090942171709440000.0;
        sn = sn * r2 * (-1.0) + 1.0 / 121645100408832000.0;
        sn = -sn * r2 + 1.0 / 355687428096000.0;
        sn = -sn * r2 + 1.0 / 1307674368000.0;
        sn = -sn * r2 + 1.0 / 6227020800.0;
        sn = -sn * r2 + 1.0 / 39916800.0;
        sn = -sn * r2 + 1.0 / 362880.0;
        sn = -sn * r2 + 1.0 / 5040.0;
        sn = -sn * r2 + 1.0 / 120.0;
        sn = -sn * r2 + 1.0 / 6.0;
        sn = -sn * r2 + 1.0;
        sn *= r;
        double cs = 1.0 / 1124000727777607680000.0;
        cs = -cs * r2 + 1.0 / 2432902008176640000.0;
        cs = -cs * r2 + 1.0 / 6402373705728000.0;
        cs = -cs * r2 + 1.0 / 20922789888000.0;
        cs = -cs * r2 + 1.0 / 87178291200.0;
        cs = -cs * r2 + 1.0 / 479001600.0;
        cs = -cs * r2 + 1.0 / 3628800.0;
        cs = -cs * r2 + 1.0 / 40320.0;
        cs = -cs * r2 + 1.0 / 720.0;
        cs = -cs * r2 + 1.0 / 24.0;
        cs = -cs * r2 + 0.5;
        cs = -cs * r2 + 1.0;
        rope[i] = (float)cs; rope[NPOS * 32 + i] = (float)sn;
    }
    bf16_t* H = (bf16_t*)((unsigned char*)p.out + SC_B);
    for (int row = gw; row < MA; row += NGW) {
        bf16_t* orow = H + (size_t)row * D;
        if (row < MP) {
            const bool last = (row & (TP - 1)) == TP - 1;
            rms_row(p.in[I_XP] + (size_t)row * D, p.in[I_NMPRE], orow, last ? p.out + O_PSH + (size_t)(row >> 12) * D : nullptr, lane);
        } else {
            const int s = row - MP;
            if (s < BS * 9) {
                const int b = s / 9, j = s - b * 9;
                if (j == 0) {
                    const float4* sr = (const float4*)(p.in[I_SSHIFT] + (size_t)b * D) + lane;
#pragma unroll
                    for (int q = 0; q < 4; ++q) { const float4 v = sr[64 * q]; uint2 o; o.x = pk2(v.x, v.y); o.y = pk2(v.z, v.w); *((uint2*)orow + lane + 64 * q) = o; }
                } else {
                    rms_row(p.in[I_XS] + (size_t)(b * TS + j - 1) * D, p.in[I_NMPRE], orow, j == TS ? p.out + O_SSH + (size_t)b * D : nullptr, lane);
                }
            } else {
#pragma unroll
                for (int q = 0; q < 4; ++q) *((uint2*)orow + lane + 64 * q) = make_uint2(0u, 0u);
            }
        }
    }
}

struct EpiProj {
    static constexpr bool PERM = false, AFTER_DRAIN = false;
    bf16_t* projrw; bf16_t* Q; bf16_t* K; bf16_t* VT1; bf16_t* VT4; bf16_t* VT16; const float* rope; float* out; float* snewk; float* snewv;
    __device__ __forceinline__ void operator()(const f32x4 (&acc)[2][2][4][2], const pg8::Unit& u, int wr, int wc, int fr, int fq) const {
        const int pn = u.pn;
        if (pn < 7) {
#pragma unroll
            for (int ai = 0; ai < 2; ++ai)
#pragma unroll
                for (int m = 0; m < 4; ++m) { const int row = u.pm * 256 + ai * 128 + wr * 64 + m * 16 + fr;
                    bf16_t* rp = projrw + (size_t)row * RCOLS + pn * 256 + wc * 32 + 4 * fq;
#pragma unroll
                    for (int bj = 0; bj < 2; ++bj)
#pragma unroll
                        for (int n = 0; n < 2; ++n) { const f32x4 v = acc[ai][bj][m][n]; uint2 o; o.x = pk2(v[0], v[1]); o.y = pk2(v[2], v[3]); *(uint2*)(rp + bj * 128 + n * 16) = o; } }
            return;
        }
#pragma unroll
        for (int ai = 0; ai < 2; ++ai)
#pragma unroll
            for (int m = 0; m < 4; ++m) {
                const int row = u.pm * 256 + ai * 128 + wr * 64 + m * 16 + fr;
                bool prompt = row < MP; int b, t, rowB, pi; bool valid = true;
                if (prompt) { b = row >> 12; t = row & (TP - 1); rowB = row; pi = t; }
                else { const int s = row - MP; b = s / 9; const int j = s - b * 9; valid = (s < BS * 9) && (j > 0); t = j - 1; rowB = MP + b * TS + t; pi = TP + t; }
                if (!valid) continue;
                if (pn < 11) {
                    const bool isq = pn < 9; const int unit = isq ? pn - 7 : pn - 9;
#pragma unroll
                    for (int bj = 0; bj < 2; ++bj) {
                        const int idx = bj * 64 + wc * 16 + fq * 4, hu = idx >> 5, e = idx & 31;
                        const float4 cs = *(const float4*)(rope + (size_t)pi * 32 + e), sn = *(const float4*)(rope + (size_t)NPOS * 32 + (size_t)pi * 32 + e);
                        const f32x4 x1 = acc[ai][bj][m][0], x2 = acc[ai][bj][m][1];
                        float o1[4], o2[4];
                        o1[0] = x1[0] * cs.x - x2[0] * sn.x; o2[0] = x1[0] * sn.x + x2[0] * cs.x;
                        o1[1] = x1[1] * cs.y - x2[1] * sn.y; o2[1] = x1[1] * sn.y + x2[1] * cs.y;
                        o1[2] = x1[2] * cs.z - x2[2] * sn.z; o2[2] = x1[2] * sn.z + x2[2] * cs.z;
                        o1[3] = x1[3] * cs.w - x2[3] * sn.w; o2[3] = x1[3] * sn.w + x2[3] * cs.w;
                        const int col = unit * 256 + hu * 64 + e;
                        if (isq) {
                            uint2 a, c2; a.x = pk2(o1[0] * 0.125f, o1[1] * 0.125f); a.y = pk2(o1[2] * 0.125f, o1[3] * 0.125f); c2.x = pk2(o2[0] * 0.125f, o2[1] * 0.125f); c2.y = pk2(o2[2] * 0.125f, o2[3] * 0.125f);
                            *(uint2*)(Q + (size_t)rowB * 512 + col) = a; *(uint2*)(Q + (size_t)rowB * 512 + col + 32) = c2;
                        } else {
                            uint2 a, c2; a.x = pk2(o1[0], o1[1]); a.y = pk2(o1[2], o1[3]); c2.x = pk2(o2[0], o2[1]); c2.y = pk2(o2[2], o2[3]);
                            *(uint2*)(K + (size_t)rowB * 512 + col) = a; *(uint2*)(K + (size_t)rowB * 512 + col + 32) = c2;
                            float* dst = nullptr;
                            if (prompt) { if (t >= 2048) dst = out + O_PK + ((size_t)b * 2048 + (t - 2048)) * 512 + col; }
                            else dst = snewk + (size_t)(b * TS + t) * 512 + col;
                            if (dst) { *(float4*)dst = make_float4(o1[0], o1[1], o1[2], o1[3]); *(float4*)(dst + 32) = make_float4(o2[0], o2[1], o2[2], o2[3]); }
                        }
                    }
                } else {
#pragma unroll
                    for (int bj = 0; bj < 2; ++bj)
#pragma unroll
                        for (int n = 0; n < 2; ++n) {
                            const int col = (pn - 11) * 256 + bj * 128 + wc * 32 + n * 16 + 4 * fq; const f32x4 v = acc[ai][bj][m][n];
                            if (prompt) {
                                if (t >= 2048) *(float4*)(out + O_PV + ((size_t)b * 2048 + (t - 2048)) * 512 + col) = make_float4(v[0], v[1], v[2], v[3]);
                                uint2 o; o.x = pk2(v[0], v[1]); o.y = pk2(v[2], v[3]); *(uint2*)(VT1 + (size_t)rowB * 512 + col) = o;
                            } else {
                                *(float4*)(snewv + (size_t)(b * TS + t) * 512 + col) = make_float4(v[0], v[1], v[2], v[3]);
                            }
                        }
                }
            }
    }
};
struct EpiDag {
    static constexpr bool PERM = false, AFTER_DRAIN = false;
    bf16_t* dag; const float* w0; const float* a0;
    __device__ __forceinline__ void operator()(const f32x4 (&acc)[2][2][4][2], const pg8::Unit& u, int wr, int wc, int fr, int fq) const {
        const int kind = u.pn >> 1;
#pragma unroll
        for (int bj = 0; bj < 2; ++bj)
#pragma unroll
            for (int n = 0; n < 2; ++n) {
                const int col = u.pn * 256 + bj * 128 + wc * 32 + n * 16 + 4 * fq;
                float4 bias = make_float4(0.f, 0.f, 0.f, 0.f);
                if (kind == 0) bias = *(const float4*)(w0 + col); else if (kind == 1) bias = *(const float4*)(a0 + col - 512);
                const float bb[4] = {bias.x, bias.y, bias.z, bias.w};
#pragma unroll
                for (int ai = 0; ai < 2; ++ai)
#pragma unroll
                    for (int m = 0; m < 4; ++m) { const int row = u.pm * 256 + ai * 128 + wr * 64 + m * 16 + fr; const f32x4 v = acc[ai][bj][m][n]; float o[4];
#pragma unroll
                        for (int j = 0; j < 4; ++j) { const float x = v[j] + bb[j];
                            if (kind == 0) { const float z = -x; const float sp = fmaxf(z, 0.f) + __logf(1.f + __expf(-fabsf(z))); o[j] = -__expf(-sp - 0.5f); }
                            else if (kind == 1) o[j] = sigmoidf_(x);
                            else o[j] = x; }
                        uint2 q; q.x = pk2(o[0], o[1]); q.y = pk2(o[2], o[3]); *(uint2*)(dag + (size_t)row * NLORA + col) = q; }
            }
    }
};
struct EpiUp {
    static constexpr bool PERM = false, AFTER_DRAIN = false;
    bf16_t* U; bf16_t* halo; float* out;
    __device__ __forceinline__ void operator()(const f32x4 (&acc)[2][2][4][2], const pg8::Unit& u, int wr, int wc, int fr, int fq) const {
#pragma unroll
        for (int ai = 0; ai < 2; ++ai)
#pragma unroll
            for (int m = 0; m < 4; ++m) {
                const int row = u.pm * 256 + ai * 128 + wr * 64 + m * 16 + fr; const int col0 = u.pn * 256 + wc * 32 + 4 * fq;
                bf16_t* hrow = nullptr; float* frow = nullptr;
                if (row < MP) { const int t = row & (TP - 1);
                    if ((t & 31) >= 30) hrow = halo + ((size_t)((row >> 5) + 1) * 2 + ((t & 31) - 30)) * FF2;
                    if (t >= TP - 2) frow = out + O_PCONV + ((size_t)(row >> 12) * 2 + (t - (TP - 2))) * FF2;
                } else { const int s = row - MP, b = s >> 3, tt = s & 7; if (tt >= 6) frow = out + O_SCONV + ((size_t)b * 2 + (tt - 6)) * FF2; }
#pragma unroll
                for (int bj = 0; bj < 2; ++bj)
#pragma unroll
                    for (int n = 0; n < 2; ++n) { const f32x4 v = acc[ai][bj][m][n]; const int col = col0 + bj * 128 + n * 16;
                        uint2 o; o.x = pk2(v[0], v[1]); o.y = pk2(v[2], v[3]);
                        *(uint2*)(U + (size_t)row * FF2 + col) = o;
                        if (hrow) *(uint2*)(hrow + col) = o;
                        if (frow) *(float4*)(frow + col) = make_float4(v[0], v[1], v[2], v[3]); }
            }
    }
};

__device__ __forceinline__ int rowA_of(int rowB) { return rowB < MP ? rowB : MP + ((rowB - MP) >> 3) * 9 + 1 + ((rowB - MP) & 7); }
__device__ __forceinline__ void phase_alora(const Params& p, int tid, int G, int bid) {
    const bf16_t* PR = (const bf16_t*)(p.ws + WS_PROJRW); bf16_t* AL = (bf16_t*)(p.ws + WS_ALORA); const float* mu = p.in[I_MU];
    const int gt = bid * NTHREADS + tid, NT = G * NTHREADS;
    for (int i = gt; i < MB * 64; i += NT) {
        const int rowB = i >> 6, c = (i & 63) * 4, rowA = rowA_of(rowB);
        const uint2 cur = *(const uint2*)(PR + (size_t)rowA * RCOLS + 1536 + c);
        uint2 prv = make_uint2(0u, 0u);
        if (!(rowB < MP && (rowB & (TP - 1)) == 0)) prv = *(const uint2*)(PR + (size_t)(rowA - 1) * RCOLS + 1536 + c);
        const float4 m4 = *(const float4*)(mu + 1536 + c);
        float x[4] = {bflo(cur.x), bfhi(cur.x), bflo(cur.y), bfhi(cur.y)}; const float pv[4] = {bflo(prv.x), bfhi(prv.x), bflo(prv.y), bfhi(prv.y)}; const float mm[4] = {m4.x, m4.y, m4.z, m4.w};
#pragma unroll
        for (int j = 0; j < 4; ++j) { float v = x[j] + (pv[j] - x[j]) * mm[j];
            if (c < 64) v = tanhf(v); else if (c >= 128) v = sigmoidf_(v);
            x[j] = v; }
        uint2 o; o.x = pk2(x[0], x[1]); o.y = pk2(x[2], x[3]);
        *(uint2*)(AL + (size_t)rowB * KLORA + c) = o;
    }
}


__device__ __forceinline__ void phase_vtrans(const Params& p, LAS unsigned char* lds, int tid, int G, int bid) {
    const bf16_t* VR = (const bf16_t*)(p.ws + WS_VROW);
    constexpr int PITCH = 132;
    for (int item = bid; item < BP * 8 * 8; item += G) {
        const int b = item >> 6, h = (item >> 3) & 7, t0 = (item & 7) * 512;
        __syncthreads();
#pragma unroll
        for (int i = 0; i < 8; ++i) { const int piece = tid + 512 * i, row = piece >> 3, c8 = piece & 7;
            const uint4 v = *(const uint4*)(VR + (size_t)(b * TP + t0 + row) * 512 + h * 64 + c8 * 8);
            LAS u32* dst = (LAS u32*)(lds + row * PITCH + c8 * 16); dst[0] = v.x; dst[1] = v.y; dst[2] = v.z; dst[3] = v.w; }
        __syncthreads();
#pragma unroll 1
        for (int lay = 0; lay < 3; ++lay) {
            const int dd = lay == 0 ? 1 : (lay == 1 ? 4 : 16); const int Tdd = TP / dd;
            bf16_t* VT = (bf16_t*)(p.ws + (lay == 0 ? WS_VT1 : (lay == 1 ? WS_VT4 : WS_VT16))) + (size_t)(b * 8 + h) * 64 * TP;
            const int chunk0 = (t0 / dd) >> 5;
#pragma unroll
            for (int i = 0; i < 8; ++i) {
                const int sidx = tid + 512 * i, g = sidx & 3, d = (sidx >> 2) & 63, rc = sidx >> 8;
                int r, cl; if (lay == 0) { r = 0; cl = rc; } else if (lay == 1) { r = rc & 3; cl = rc >> 2; } else { r = rc; cl = 0; }
                u32 w[4];
#pragma unroll
                for (int hf = 0; hf < 2; ++hf)
#pragma unroll
                    for (int jp = 0; jp < 2; ++jp) {
                        const int u5a = 16 * hf + 4 * g + 2 * jp; const int ta = (32 * cl + u5a) * dd + r, tb = ta + dd;
                        const u32 lo = *(const LAS unsigned short*)(lds + ta * PITCH + d * 2), hi = *(const LAS unsigned short*)(lds + tb * PITCH + d * 2);
                        w[hf * 2 + jp] = lo | (hi << 16);
                    }
                *(uint4*)(VT + (size_t)r * Tdd * 64 + (size_t)(chunk0 + cl) * 2048 + d * 32 + 8 * g) = make_uint4(w[0], w[1], w[2], w[3]);
            }
        }
    }
    __syncthreads();
}

constexpr int CH = 32;
constexpr int SST = 452;
constexpr int SI_W = 0, SI_A = 64, SI_B = 128, SI_K = 192, SI_WR = 256, SI_V = 320, SI_G = 384, SI_SC = 448;
struct PrepRegs { uint2 cr, ck, cv, pr, pk, pv, dw, da, dg; };
__device__ __forceinline__ void scan_item(const Params& p, LAS unsigned char* lds, int tid, bool sample, int b, int h) {
    const bf16_t* PR = (const bf16_t*)(p.ws + WS_PROJRW); const bf16_t* DAG = (const bf16_t*)((const unsigned char*)p.out + SC_B);
    bf16_t* MIX = (bf16_t*)((unsigned char*)p.out + SC_C);
    LAS float* buf0 = (LAS float*)lds; LAS float* buf1 = buf0 + CH * SST; LAS float* ybuf = buf1 + CH * SST;
    const int T = sample ? TS : TP;
    const int rowB0 = sample ? MP + b * TS : b * TP;
    const int rowA0 = sample ? MP + b * 9 + 1 : b * TP;
    const int nch = (T + CH - 1) / CH;
    const int ptl = tid >> 4, pj = (tid & 15) * 4, pc = h * 64 + pj;
    const int lane = tid & 63, wv = tid >> 6, rg = wv * 4 + (lane >> 4), cgi = lane & 15;
    float s0[4], s1[4];
    if (sample) {
        const float* S0 = p.in[I_SWKV] + ((size_t)(b * 8 + h) * 64 + 2 * rg) * 64 + 4 * cgi;
        const float4 a = *(const float4*)S0, c = *(const float4*)(S0 + 64);
        s0[0] = a.x; s0[1] = a.y; s0[2] = a.z; s0[3] = a.w; s1[0] = c.x; s1[1] = c.y; s1[2] = c.z; s1[3] = c.w;
    } else {
#pragma unroll
        for (int j = 0; j < 4; ++j) { s0[j] = 0.f; s1[j] = 0.f; }
    }
    const float4 mur = *(const float4*)(p.in[I_MU] + pc), muk = *(const float4*)(p.in[I_MU] + 512 + pc), muv = *(const float4*)(p.in[I_MU] + 1024 + pc);
    const float4 kk4 = *(const float4*)(p.in[I_KK] + pc), ka4 = *(const float4*)(p.in[I_KA] + pc), rk4 = *(const float4*)(p.in[I_RK] + pc);
    const float4 lw4 = *(const float4*)(p.in[I_LNW] + pc), lb4 = *(const float4*)(p.in[I_LNB] + pc);
    __builtin_amdgcn_s_waitcnt(0x0F70);
    PrepRegs R;
#define SCAN_LOAD(chunk) do { const int t_ = (chunk) * CH + ptl; if (t_ < T) { const size_t ra = (size_t)(rowA0 + t_) * RCOLS + pc; const size_t rb = (size_t)(rowB0 + t_) * NLORA + pc; \
        R.cr = *(const uint2*)(PR + ra); R.ck = *(const uint2*)(PR + ra + 512); R.cv = *(const uint2*)(PR + ra + 1024); \
        if (!sample && t_ == 0) { R.pr = make_uint2(0u, 0u); R.pk = R.pr; R.pv = R.pr; } \
        else { R.pr = *(const uint2*)(PR + ra - RCOLS); R.pk = *(const uint2*)(PR + ra - RCOLS + 512); R.pv = *(const uint2*)(PR + ra - RCOLS + 1024); } \
        R.dw = *(const uint2*)(DAG + rb); R.da = *(const uint2*)(DAG + rb + 512); R.dg = *(const uint2*)(DAG + rb + 1024); } } while (0)
#define SCAN_PREP(chunk, dstbuf) do { const int t_ = (chunk) * CH + ptl; if (t_ < T) { \
        const float mr[4] = {mur.x, mur.y, mur.z, mur.w}, mk[4] = {muk.x, muk.y, muk.z, muk.w}, mv[4] = {muv.x, muv.y, muv.z, muv.w}; \
        const float kkc[4] = {kk4.x, kk4.y, kk4.z, kk4.w}, kac[4] = {ka4.x, ka4.y, ka4.z, ka4.w}, rkc[4] = {rk4.x, rk4.y, rk4.z, rk4.w}; \
        const float crr[4] = {bflo(R.cr.x), bfhi(R.cr.x), bflo(R.cr.y), bfhi(R.cr.y)}, ckk[4] = {bflo(R.ck.x), bfhi(R.ck.x), bflo(R.ck.y), bfhi(R.ck.y)}, cvv[4] = {bflo(R.cv.x), bfhi(R.cv.x), bflo(R.cv.y), bfhi(R.cv.y)}; \
        const float prr[4] = {bflo(R.pr.x), bfhi(R.pr.x), bflo(R.pr.y), bfhi(R.pr.y)}, pkk[4] = {bflo(R.pk.x), bfhi(R.pk.x), bflo(R.pk.y), bfhi(R.pk.y)}, pvv[4] = {bflo(R.pv.x), bfhi(R.pv.x), bflo(R.pv.y), bfhi(R.pv.y)}; \
        const float lw[4] = {bflo(R.dw.x), bfhi(R.dw.x), bflo(R.dw.y), bfhi(R.dw.y)}, aa[4] = {bflo(R.da.x), bfhi(R.da.x), bflo(R.da.y), bfhi(R.da.y)}, gg[4] = {bflo(R.dg.x), bfhi(R.dg.x), bflo(R.dg.y), bfhi(R.dg.y)}; \
        float r_[4], k_[4], v_[4], w_[4], kn[4], k2[4]; float nrm = 0.f; \
        _Pragma("unroll") for (int j = 0; j < 4; ++j) { r_[j] = crr[j] + (prr[j] - crr[j]) * mr[j]; k_[j] = ckk[j] + (pkk[j] - ckk[j]) * mk[j]; v_[j] = cvv[j] + (pvv[j] - cvv[j]) * mv[j]; \
            w_[j] = __expf(lw[j]); kn[j] = k_[j] * kkc[j]; nrm += kn[j] * kn[j]; k2[j] = k_[j] * (1.f + (aa[j] - 1.f) * kac[j]); } \
        nrm = row16_sum(nrm); const float inv = 1.f / fmaxf(sqrtf(nrm), 1e-12f); \
        float br = 0.f, kr = 0.f, rk = 0.f; float an[4], bn[4], wrr[4]; \
        _Pragma("unroll") for (int j = 0; j < 4; ++j) { const float kkn = kn[j] * inv; an[j] = -kkn; bn[j] = kkn * aa[j]; wrr[j] = w_[j] * r_[j]; br += bn[j] * r_[j]; kr += k2[j] * r_[j]; rk += r_[j] * k2[j] * rkc[j]; } \
        br = row16_sum(br); kr = row16_sum(kr); rk = row16_sum(rk); \
        LAS float* rec = (dstbuf) + ptl * SST; \
        *(LAS f32x4*)(rec + SI_W + pj) = (f32x4){w_[0], w_[1], w_[2], w_[3]}; *(LAS f32x4*)(rec + SI_A + pj) = (f32x4){an[0], an[1], an[2], an[3]}; \
        *(LAS f32x4*)(rec + SI_B + pj) = (f32x4){bn[0], bn[1], bn[2], bn[3]}; *(LAS f32x4*)(rec + SI_K + pj) = (f32x4){k2[0], k2[1], k2[2], k2[3]}; \
        *(LAS f32x4*)(rec + SI_WR + pj) = (f32x4){wrr[0], wrr[1], wrr[2], wrr[3]}; *(LAS f32x4*)(rec + SI_V + pj) = (f32x4){v_[0], v_[1], v_[2], v_[3]}; \
        *(LAS f32x4*)(rec + SI_G + pj) = (f32x4){gg[0], gg[1], gg[2], gg[3]}; \
        if ((tid & 15) == 0) *(LAS f32x4*)(rec + SI_SC) = (f32x4){br, kr, rk, 0.f}; } } while (0)

    SCAN_LOAD(0);
    SCAN_PREP(0, buf0);
    __syncthreads();
    for (int c = 0; c < nch; ++c) {
        LAS float* cur = (c & 1) ? buf1 : buf0; LAS float* nxt = (c & 1) ? buf0 : buf1;
        if (c + 1 < nch) SCAN_LOAD(c + 1);
        const int ns = (T - c * CH) < CH ? (T - c * CH) : CH;
        {
            const LAS float* rec = cur;
            f32x4 wA = *(const LAS f32x4*)(rec + SI_W + 4 * cgi), aA = *(const LAS f32x4*)(rec + SI_A + 4 * cgi), bA = *(const LAS f32x4*)(rec + SI_B + 4 * cgi);
            f32x4 kA = *(const LAS f32x4*)(rec + SI_K + 4 * cgi), rA = *(const LAS f32x4*)(rec + SI_WR + 4 * cgi);
            pg8::f32x2 vA = *(const LAS pg8::f32x2*)(rec + SI_V + 2 * rg), cA = *(const LAS pg8::f32x2*)(rec + SI_SC);
            f32x4 wB, aB, bB, kB, rB; pg8::f32x2 vB, cB;
#define SCAN_FETCH(W, A, B, K, R, V, C) do { rec += SST; W = *(const LAS f32x4*)(rec + SI_W + 4 * cgi); A = *(const LAS f32x4*)(rec + SI_A + 4 * cgi); B = *(const LAS f32x4*)(rec + SI_B + 4 * cgi); \
            K = *(const LAS f32x4*)(rec + SI_K + 4 * cgi); R = *(const LAS f32x4*)(rec + SI_WR + 4 * cgi); V = *(const LAS pg8::f32x2*)(rec + SI_V + 2 * rg); C = *(const LAS pg8::f32x2*)(rec + SI_SC); } while (0)
#define SCAN_STEP(W, A, B, K, R, V, C, qq) do { \
            pg8::f32x2 da = S[0] * A[0]; da = S[1] * A[1] + da; da = S[2] * A[2] + da; da = S[3] * A[3] + da; \
            pg8::f32x2 dw = S[0] * R[0]; dw = S[1] * R[1] + dw; dw = S[2] * R[2] + dw; dw = S[3] * R[3] + dw; \
            { float d0_ = da[0], d1_ = da[1], d2_ = dw[0], d3_ = dw[1]; row16_sum4(d0_, d1_, d2_, d3_); da = (pg8::f32x2){d0_, d1_}; dw = (pg8::f32x2){d2_, d3_}; } \
            const pg8::f32x2 y = dw + da * C[0] + V * C[1]; \
            _Pragma("unroll") for (int j = 0; j < 4; ++j) S[j] = S[j] * W[j] + (da * B[j] + V * K[j]); \
            yk = ((qq) == cgi) ? y : yk; } while (0)
            pg8::f32x2 S[4];
#pragma unroll
            for (int j = 0; j < 4; ++j) S[j] = (pg8::f32x2){s0[j], s1[j]};
            for (int tb = 0; tb < ns; tb += 16) {
                const int nq = (ns - tb) < 16 ? (ns - tb) : 16;
                pg8::f32x2 yk = (pg8::f32x2){0.f, 0.f};
                for (int q = 0; q < nq; q += 2) {
                    SCAN_FETCH(wB, aB, bB, kB, rB, vB, cB);
                    SCAN_STEP(wA, aA, bA, kA, rA, vA, cA, q);
                    SCAN_FETCH(wA, aA, bA, kA, rA, vA, cA);
                    SCAN_STEP(wB, aB, bB, kB, rB, vB, cB, q + 1);
                }
                *(LAS pg8::f32x2*)(ybuf + (tb + cgi) * 64 + 2 * rg) = yk;
            }
#pragma unroll
            for (int j = 0; j < 4; ++j) { s0[j] = S[j][0]; s1[j] = S[j][1]; }
#undef SCAN_FETCH
#undef SCAN_STEP
        }
        __syncthreads();
        if (ptl < ns) {
            const LAS float* rec = cur + ptl * SST;
            const f32x4 y4 = *(const LAS f32x4*)(ybuf + ptl * 64 + pj), v4 = *(const LAS f32x4*)(rec + SI_V + pj), g4 = *(const LAS f32x4*)(rec + SI_G + pj);
            const float rk = rec[SI_SC + 2];
            const float mean = row16_sum((y4.x + y4.y) + (y4.z + y4.w)) * (1.f / 64.f);
            const float d0 = y4.x - mean, d1 = y4.y - mean, d2 = y4.z - mean, d3 = y4.w - mean;
            const float var = row16_sum((d0 * d0 + d1 * d1) + (d2 * d2 + d3 * d3)) * (1.f / 64.f);
            const float rs = rsqrtf(var + 64e-5f);
            const float o0 = (d0 * rs * lw4.x + lb4.x + rk * v4.x) * g4.x, o1 = (d1 * rs * lw4.y + lb4.y + rk * v4.y) * g4.y;
            const float o2 = (d2 * rs * lw4.z + lb4.z + rk * v4.z) * g4.z, o3 = (d3 * rs * lw4.w + lb4.w + rk * v4.w) * g4.w;
            uint2 o; o.x = pk2(o0, o1); o.y = pk2(o2, o3);
            *(uint2*)(MIX + (size_t)(rowB0 + c * CH + ptl) * D + pc) = o;
        }
        if (c + 1 < nch) SCAN_PREP(c + 1, nxt);
        __syncthreads();
    }
#undef SCAN_LOAD
#undef SCAN_PREP
    float* So = p.out + (sample ? O_SWKV : O_PWKV) + ((size_t)(b * 8 + h) * 64 + 2 * rg) * 64 + 4 * cgi;
    *(float4*)So = make_float4(s0[0], s0[1], s0[2], s0[3]); *(float4*)(So + 64) = make_float4(s1[0], s1[1], s1[2], s1[3]);
}

__device__ __forceinline__ void attn_task(const Params& p, int task, int lane) {
    const bf16_t* Q = (const bf16_t*)(p.ws + WS_Q); const bf16_t* K = (const bf16_t*)(p.ws + WS_K);
    bf16_t* MIX = (bf16_t*)((unsigned char*)p.out + SC_C);
    const int b = task >> 11, h = (task >> 8) & 7, r16 = (task >> 4) & 15, ig = task & 15;
    const int li = lane & 15, g = lane >> 4;
    const int tq = r16 + 16 * (16 * ig + li);
    const bf16_t* qp = Q + (size_t)(b * TP + tq) * 512 + h * 64 + 8 * g;
    const bf16x8 qf0 = *(const bf16x8*)qp, qf1 = *(const bf16x8*)(qp + 32);
    float m_run = -1e30f, l_run = 0.f;
    f32x4 o[4];
#pragma unroll
    for (int i = 0; i < 4; ++i) o[i] = (f32x4){0.f, 0.f, 0.f, 0.f};
#pragma unroll 1
    for (int br = 0; br < 3; ++br) {
        int dd, r, uq0, Tdd; const bf16_t* VT;
        if (br == 0) { dd = 16; r = r16; uq0 = 16 * ig; Tdd = TP / 16; VT = (const bf16_t*)(p.ws + WS_VT16); }
        else if (br == 1) { dd = 4; r = r16 & 3; uq0 = (r16 >> 2) + 64 * ig; Tdd = TP / 4; VT = (const bf16_t*)(p.ws + WS_VT4); }
        else { dd = 1; r = 0; uq0 = r16 + 256 * ig; Tdd = TP; VT = (const bf16_t*)(p.ws + WS_VT1); }
        const int s = 16 / dd, uq = uq0 + s * li;
        int ulo = uq0 - 128; if (ulo < 0) ulo = 0; ulo &= ~31;
        const int uhi = uq0 + 15 * s;
        const bf16_t* Kb = K + ((size_t)b * TP + r) * 512 + h * 64 + 8 * g;
        const bf16_t* Vb = VT + (size_t)(b * 8 + h) * 64 * TP + (size_t)r * Tdd * 64 + li * 32 + 8 * g;
        bf16x8 kx0, kx1, ky0, ky1, vf[4];
        { const bf16_t* kx = Kb + (size_t)(ulo + li) * dd * 512; const bf16_t* ky = kx + (size_t)16 * dd * 512;
          kx0 = *(const bf16x8*)kx; kx1 = *(const bf16x8*)(kx + 32); ky0 = *(const bf16x8*)ky; ky1 = *(const bf16x8*)(ky + 32);
#pragma unroll
          for (int dt = 0; dt < 4; ++dt) vf[dt] = *(const bf16x8*)(Vb + (size_t)(ulo >> 5) * 2048 + dt * 512); }
#pragma unroll 1
        for (int kt = ulo; kt <= uhi; kt += 32) {
            const int ktn = (kt + 32 <= uhi) ? kt + 32 : kt;
            const bf16_t* nkx = Kb + (size_t)(ktn + li) * dd * 512; const bf16_t* nky = nkx + (size_t)16 * dd * 512;
            const bf16x8 nkx0 = *(const bf16x8*)nkx, nkx1 = *(const bf16x8*)(nkx + 32), nky0 = *(const bf16x8*)nky, nky1 = *(const bf16x8*)(nky + 32);
            bf16x8 nvf[4];
#pragma unroll
            for (int dt = 0; dt < 4; ++dt) nvf[dt] = *(const bf16x8*)(Vb + (size_t)(ktn >> 5) * 2048 + dt * 512);
            f32x4 sx = (f32x4){0.f, 0.f, 0.f, 0.f}, sy = (f32x4){0.f, 0.f, 0.f, 0.f};
            sx = __builtin_amdgcn_mfma_f32_16x16x32_bf16(kx0, qf0, sx, 0, 0, 0); sx = __builtin_amdgcn_mfma_f32_16x16x32_bf16(kx1, qf1, sx, 0, 0, 0);
            sy = __builtin_amdgcn_mfma_f32_16x16x32_bf16(ky0, qf0, sy, 0, 0, 0); sy = __builtin_amdgcn_mfma_f32_16x16x32_bf16(ky1, qf1, sy, 0, 0, 0);
            float sv[8]; bool ok[8]; float tmax = -1e30f;
#pragma unroll
            for (int j = 0; j < 4; ++j) { const int dx = uq - (kt + 4 * g + j), dy = dx - 16;
                ok[j] = (unsigned)dx <= 128u; ok[4 + j] = (unsigned)dy <= 128u; sv[j] = ok[j] ? sx[j] : -1e30f; sv[4 + j] = ok[4 + j] ? sy[j] : -1e30f;
                tmax = fmaxf(tmax, fmaxf(sv[j], sv[4 + j])); }
            tmax = fmaxf(tmax, __shfl_xor(tmax, 16)); tmax = fmaxf(tmax, __shfl_xor(tmax, 32));
            const float m_new = fmaxf(m_run, tmax), alpha = __expf(m_run - m_new);
            float pe[8]; float ps = 0.f;
#pragma unroll
            for (int j = 0; j < 8; ++j) { pe[j] = ok[j] ? __expf(sv[j] - m_new) : 0.f; ps += pe[j]; }
            l_run = l_run * alpha + ps; m_run = m_new;
            u32x4 pw; pw[0] = pk2(pe[0], pe[1]); pw[1] = pk2(pe[2], pe[3]); pw[2] = pk2(pe[4], pe[5]); pw[3] = pk2(pe[6], pe[7]);
            const bf16x8 pf = __builtin_bit_cast(bf16x8, pw);
#pragma unroll
            for (int dt = 0; dt < 4; ++dt) { o[dt] *= alpha; o[dt] = __builtin_amdgcn_mfma_f32_16x16x32_bf16(vf[dt], pf, o[dt], 0, 0, 0); }
            kx0 = nkx0; kx1 = nkx1; ky0 = nky0; ky1 = nky1;
#pragma unroll
            for (int dt = 0; dt < 4; ++dt) vf[dt] = nvf[dt];
        }
    }
    float lt = l_run; lt += __shfl_xor(lt, 16); lt += __shfl_xor(lt, 32);
    const float il = 1.f / lt;
    bf16_t* op = MIX + (size_t)(b * TP + tq) * D + 512 + h * 64 + 4 * g;
#pragma unroll
    for (int dt = 0; dt < 4; ++dt) { uint2 w; w.x = pk2(o[dt][0] * il, o[dt][1] * il); w.y = pk2(o[dt][2] * il, o[dt][3] * il); *(uint2*)(op + 16 * dt) = w; }
}
__device__ __forceinline__ void attn_sample_task(const Params& p, int task, int lane, LAS float* wl) {
    const bf16_t* Q = (const bf16_t*)(p.ws + WS_Q); const float* snewk = (const float*)(p.ws + WS_SNEWK); const float* snewv = (const float*)(p.ws + WS_SNEWV);
    const float* CK = p.in[I_CK]; const float* CV = p.in[I_CV];
    bf16_t* MIX = (bf16_t*)((unsigned char*)p.out + SC_C);
    const int b = task >> 6, h = (task >> 3) & 7, tt = task & 7;
    const int rowB = MP + b * TS + tt;
    asm volatile("s_waitcnt lgkmcnt(0)" ::: "memory");
    wl[lane] = bflo((u32)Q[(size_t)rowB * 512 + h * 64 + lane]);
    asm volatile("s_waitcnt lgkmcnt(0)" ::: "memory");
    float mx = -1e30f;
#pragma unroll 1
    for (int c = 0; c < 9; ++c) {
        const int br = c / 3, it = c - br * 3; const int dd = br == 0 ? 1 : (br == 1 ? 4 : 16); const int j = lane + 64 * it;
        const int jc = j <= 128 ? j : 128;
        const int idx = 2048 + tt - jc * dd;
        const float* kr = idx < 2048 ? CK + ((size_t)(b * 2048 + idx) * 8 + h) * 64 : snewk + (size_t)(b * TS + idx - 2048) * 512 + h * 64;
        float s = 0.f;
#pragma unroll
        for (int d4 = 0; d4 < 16; ++d4) { const float4 kv = *(const float4*)(kr + 4 * d4); const f32x4 qv = *(const LAS f32x4*)(wl + 4 * d4);
            s += kv.x * qv[0] + kv.y * qv[1] + kv.z * qv[2] + kv.w * qv[3]; }
        if (j > 128) s = -1e30f;
        wl[64 + c * 64 + lane] = s; mx = fmaxf(mx, s);
    }
#pragma unroll
    for (int o = 1; o < 64; o <<= 1) mx = fmaxf(mx, __shfl_xor(mx, o));
    asm volatile("s_waitcnt lgkmcnt(0)" ::: "memory");
    float ls = 0.f;
#pragma unroll 1
    for (int c = 0; c < 9; ++c) { const float s = wl[64 + c * 64 + lane]; const float e = s > -1e29f ? __expf(s - mx) : 0.f; wl[64 + c * 64 + lane] = e; ls += e; }
    ls = wave_sum(ls);
    asm volatile("s_waitcnt lgkmcnt(0)" ::: "memory");
    float acc = 0.f;
#pragma unroll 1
    for (int c = 0; c < 9; ++c) {
        const int br = c / 3, it = c - br * 3; const int dd = br == 0 ? 1 : (br == 1 ? 4 : 16); const int nj = it < 2 ? 64 : 1;
#pragma unroll 8
        for (int l2 = 0; l2 < nj; ++l2) {
            const int j = l2 + 64 * it; const int idx = 2048 + tt - j * dd;
            const float* vr = idx < 2048 ? CV + ((size_t)(b * 2048 + idx) * 8 + h) * 64 : snewv + (size_t)(b * TS + idx - 2048) * 512 + h * 64;
            acc += wl[64 + c * 64 + l2] * vr[lane];
        }
    }
    const float res = acc / ls;
    const float other = __shfl_xor(res, 1);
    if ((lane & 1) == 0) *(u32*)(MIX + (size_t)rowB * D + 512 + h * 64 + lane) = pk2(res, other);
}

__device__ __forceinline__ void phase_norm1(const Params& p, int tid, int G, int bid) {
    const int wave = tid >> 6, lane = tid & 63, gw = bid * 8 + wave, NGW = G * 8;
    const float* mix = (const float*)((const unsigned char*)p.out + SC_B); bf16_t* H2 = (bf16_t*)((unsigned char*)p.out + SC_C);
    for (int row = gw; row < MB; row += NGW) {
        const float* xrow = row < MP ? p.in[I_XP] + (size_t)row * D : p.in[I_XS] + (size_t)(row - MP) * D;
        const float4* mr = (const float4*)(mix + (size_t)row * D) + lane; const float4* xr = (const float4*)xrow + lane;
        float4 v[4], x[4]; float s = 0.f;
#pragma unroll
        for (int j = 0; j < 4; ++j) { v[j] = mr[64 * j]; x[j] = xr[64 * j]; s += (v[j].x * v[j].x + v[j].y * v[j].y) + (v[j].z * v[j].z + v[j].w * v[j].w); }
        const float rs = rsqrtf(wave_sum(s) * (1.f / D) + 1e-6f);
        float s2 = 0.f;
#pragma unroll
        for (int j = 0; j < 4; ++j) { const float4 gg = *((const float4*)p.in[I_NMPOST] + lane + 64 * j);
            x[j].x += v[j].x * rs * gg.x; x[j].y += v[j].y * rs * gg.y; x[j].z += v[j].z * rs * gg.z; x[j].w += v[j].w * rs * gg.w;
            s2 += (x[j].x * x[j].x + x[j].y * x[j].y) + (x[j].z * x[j].z + x[j].w * x[j].w);
            *((float4*)(p.out + (size_t)row * D) + lane + 64 * j) = x[j]; }
        const float rs2 = rsqrtf(wave_sum(s2) * (1.f / D) + 1e-6f);
#pragma unroll
        for (int j = 0; j < 4; ++j) { const float4 gg = *((const float4*)p.in[I_NFPRE] + lane + 64 * j);
            uint2 o; o.x = pk2(x[j].x * rs2 * gg.x, x[j].y * rs2 * gg.y); o.y = pk2(x[j].z * rs2 * gg.z, x[j].w * rs2 * gg.w);
            *((uint2*)(H2 + (size_t)row * D) + lane + 64 * j) = o; }
    }
}
__device__ __forceinline__ void phase_act(const Params& p, int tid, int G, int bid) {
    const int wave = tid >> 6, lane = tid & 63, gw = bid * 8 + wave, NGW = G * 8;
    bf16_t* U = (bf16_t*)(p.ws + WS_U); const bf16_t* halo = (const bf16_t*)(p.ws + WS_HALO);
    const float* cw = p.in[I_CONVW]; const float* cb = p.in[I_CONVB];
    constexpr int NPI = (MP / 32) * 11, NSI = BS * 11;
    for (int it = gw; it < NPI + NSI; it += NGW) {
        const bool sample = it >= NPI; const int q = sample ? it - NPI : it; const int chunk = q / 11, cgp = q - chunk * 11;
        const int col = cgp * 256 + 4 * lane;
        const float4 wg0 = *(const float4*)(cw + col), wg1 = *(const float4*)(cw + FF2 + col), wg2 = *(const float4*)(cw + 2 * FF2 + col), bg = *(const float4*)(cb + col);
        const float4 wu0 = *(const float4*)(cw + FF + col), wu1 = *(const float4*)(cw + FF2 + FF + col), wu2 = *(const float4*)(cw + 2 * FF2 + FF + col), bu = *(const float4*)(cb + FF + col);
        float g2[4], g1[4], u2[4], u1[4];
        int row0, nrows;
        if (!sample) {
            row0 = chunk * 32; nrows = 32;
            if ((row0 & (TP - 1)) == 0) {
#pragma unroll
                for (int j = 0; j < 4; ++j) { g2[j] = 0.f; g1[j] = 0.f; u2[j] = 0.f; u1[j] = 0.f; }
            } else {
                const bf16_t* hp = halo + (size_t)chunk * 2 * FF2;
                const uint2 a = *(const uint2*)(hp + col), c2 = *(const uint2*)(hp + FF2 + col), e = *(const uint2*)(hp + FF + col), f = *(const uint2*)(hp + FF2 + FF + col);
                g2[0] = bflo(a.x); g2[1] = bfhi(a.x); g2[2] = bflo(a.y); g2[3] = bfhi(a.y); g1[0] = bflo(c2.x); g1[1] = bfhi(c2.x); g1[2] = bflo(c2.y); g1[3] = bfhi(c2.y);
                u2[0] = bflo(e.x); u2[1] = bfhi(e.x); u2[2] = bflo(e.y); u2[3] = bfhi(e.y); u1[0] = bflo(f.x); u1[1] = bfhi(f.x); u1[2] = bflo(f.y); u1[3] = bfhi(f.y);
            }
        } else {
            row0 = MP + chunk * TS; nrows = TS;
            const float* sp = p.in[I_SCONV] + (size_t)chunk * 2 * FF2;
            const float4 a = *(const float4*)(sp + col), c2 = *(const float4*)(sp + FF2 + col), e = *(const float4*)(sp + FF + col), f = *(const float4*)(sp + FF2 + FF + col);
            g2[0] = a.x; g2[1] = a.y; g2[2] = a.z; g2[3] = a.w; g1[0] = c2.x; g1[1] = c2.y; g1[2] = c2.z; g1[3] = c2.w;
            u2[0] = e.x; u2[1] = e.y; u2[2] = e.z; u2[3] = e.w; u1[0] = f.x; u1[1] = f.y; u1[2] = f.z; u1[3] = f.w;
        }
        const float w0g[4] = {wg0.x, wg0.y, wg0.z, wg0.w}, w1g[4] = {wg1.x, wg1.y, wg1.z, wg1.w}, w2g[4] = {wg2.x, wg2.y, wg2.z, wg2.w}, bgg[4] = {bg.x, bg.y, bg.z, bg.w};
        const float w0u[4] = {wu0.x, wu0.y, wu0.z, wu0.w}, w1u[4] = {wu1.x, wu1.y, wu1.z, wu1.w}, w2u[4] = {wu2.x, wu2.y, wu2.z, wu2.w}, buu[4] = {bu.x, bu.y, bu.z, bu.w};
        for (int r0 = 0; r0 < nrows; r0 += 8) {
            uint2 gv[8], uv[8];
#pragma unroll
            for (int i = 0; i < 8; ++i) { const bf16_t* rp = U + (size_t)(row0 + r0 + i) * FF2 + col; gv[i] = *(const uint2*)rp; uv[i] = *(const uint2*)(rp + FF); }
#pragma unroll
            for (int i = 0; i < 8; ++i) {
                const float gc[4] = {bflo(gv[i].x), bfhi(gv[i].x), bflo(gv[i].y), bfhi(gv[i].y)}, uc[4] = {bflo(uv[i].x), bfhi(uv[i].x), bflo(uv[i].y), bfhi(uv[i].y)};
                float o[4];
#pragma unroll
                for (int j = 0; j < 4; ++j) {
                    const float cgv = w0g[j] * g2[j] + w1g[j] * g1[j] + w2g[j] * gc[j] + bgg[j];
                    const float cuv = w0u[j] * u2[j] + w1u[j] * u1[j] + w2u[j] * uc[j] + buu[j];
                    o[j] = cgv * sigmoidf_(cgv) * cuv;
                    g2[j] = g1[j]; g1[j] = gc[j]; u2[j] = u1[j]; u1[j] = uc[j];
                }
                uint2 w; w.x = pk2(o[0], o[1]); w.y = pk2(o[2], o[3]);
                *(uint2*)(U + (size_t)(row0 + r0 + i) * FF2 + col) = w;
            }
        }
    }
}
__device__ __forceinline__ void phase_final(const Params& p, int tid, int G, int bid) {
    const int wave = tid >> 6, lane = tid & 63, gw = bid * 8 + wave, NGW = G * 8;
    const float* F = (const float*)(p.ws + WS_U) + FF / 2;
    for (int row = gw; row < MB; row += NGW) {
        const float4* fr = (const float4*)(F + (size_t)row * (FF2 / 2)) + lane; float4* yr = (float4*)(p.out + (size_t)row * D) + lane;
        float4 v[4]; float s = 0.f;
#pragma unroll
        for (int j = 0; j < 4; ++j) { v[j] = fr[64 * j]; s += (v[j].x * v[j].x + v[j].y * v[j].y) + (v[j].z * v[j].z + v[j].w * v[j].w); }
        const float rs = rsqrtf(wave_sum(s) * (1.f / D) + 1e-6f);
#pragma unroll
        for (int j = 0; j < 4; ++j) { const float4 gg = *((const float4*)p.in[I_NFPOST] + lane + 64 * j); float4 x = yr[64 * j];
            x.x += v[j].x * rs * gg.x; x.y += v[j].y * rs * gg.y; x.z += v[j].z * rs * gg.z; x.w += v[j].w * rs * gg.w; yr[64 * j] = x; }
    }
}
__device__ __forceinline__ void phase_cachecopy(const Params& p, int tid, int G, int bid) {
    const int gt = bid * NTHREADS + tid, NT = G * NTHREADS;
    constexpr int PER_B = 2048 * 512 / 4;
    const float4* snk = (const float4*)(p.ws + WS_SNEWK); const float4* snv = (const float4*)(p.ws + WS_SNEWV);
    for (int i = gt; i < 2 * BS * PER_B; i += NT) {
        const int which = i >= BS * PER_B; const int q = which ? i - BS * PER_B : i; const int b = q / PER_B, r = q - b * PER_B;
        const float4* src = (const float4*)p.in[which ? I_CV : I_CK] + (size_t)b * PER_B;
        float4 v;
        if (r < 2040 * 128) v = src[r + 8 * 128]; else v = (which ? snv : snk)[(size_t)b * TS * 128 + (r - 2040 * 128)];
        ((float4*)(p.out + (which ? O_SV : O_SK)))[(size_t)b * PER_B + r] = v;
    }
}

template <int PH>
__device__ __forceinline__ void run_phase(const Params& p, LAS unsigned char* lds, int tid, int G, int bid) {
    if constexpr (PH == 0) { phase0(p, lds, tid, G, bid); __syncthreads(); }
    else if constexpr (PH == 1) {
        pg8::Gemm g{(const bf16_t*)((const unsigned char*)p.out + SC_B), (const bf16_t*)(p.ws + WS_WIN), MA, DIN, D, D}; pg8::StaticOrder S; S.init(MA, DIN, G, bid);
        EpiProj E{(bf16_t*)(p.ws + WS_PROJRW), (bf16_t*)(p.ws + WS_Q), (bf16_t*)(p.ws + WS_K), (bf16_t*)(p.ws + WS_VROW), (bf16_t*)(p.ws + WS_VT4), (bf16_t*)(p.ws + WS_VT16),
                  (const float*)(p.ws + WS_ROPE), p.out, (float*)(p.ws + WS_SNEWK), (float*)(p.ws + WS_SNEWV)};
        pg8::gemm_phase<EpiProj, pg8::StaticOrder, false>(lds, g, S, E, nullptr);
    } else if constexpr (PH == 2) { phase_alora(p, tid, G, bid); phase_vtrans(p, lds, tid, G, bid); }
    else if constexpr (PH == 3) {
        pg8::Gemm g{(const bf16_t*)(p.ws + WS_ALORA), (const bf16_t*)(p.ws + WS_WLORA), MB, NLORA, KLORA, KLORA}; pg8::StaticOrder S; S.init(MB, NLORA, G, bid);
        EpiDag E{(bf16_t*)((unsigned char*)p.out + SC_B), p.in[I_W0], p.in[I_A0]};
        pg8::gemm_phase<EpiDag, pg8::StaticOrder, false>(lds, g, S, E, nullptr);
    } else if constexpr (PH == 4 || PH == 11 || PH == 12) {
        const int NSCAN = G >= 128 ? 64 : (G / 2 > 0 ? G / 2 : 1);
        if (bid < NSCAN) {
            if constexpr (PH != 12) for (int it = bid; it < 64 + 256; it += NSCAN) { const bool smp = it >= 64; const int q = smp ? it - 64 : it; scan_item(p, lds, tid, smp, q >> 3, q & 7); }
        } else {
            if constexpr (PH != 11) { const int wave = tid >> 6, lane = tid & 63, aw = (bid - NSCAN) * 8 + wave, NAW = (G - NSCAN) * 8;
                for (int t = aw; t < 16384 + 2048; t += NAW) { if (t < 16384) attn_task(p, t, lane); else attn_sample_task(p, t - 16384, lane, (LAS float*)(lds + wave * 4096)); } }
        }
    } else if constexpr (PH == 5) {
        pg8::Gemm g{(const bf16_t*)((const unsigned char*)p.out + SC_C), (const bf16_t*)(p.ws + WS_WOUT), MB, D, D, D}; pg8::StaticOrder S; S.init(MB, D, G, bid);
        pg8::EpiF32 E{(float*)((unsigned char*)p.out + SC_B), D, nullptr};
        pg8::gemm_phase<pg8::EpiF32, pg8::StaticOrder, false>(lds, g, S, E, nullptr);
    } else if constexpr (PH == 6) phase_norm1(p, tid, G, bid);
    else if constexpr (PH == 7) {
        pg8::Gemm g{(const bf16_t*)((const unsigned char*)p.out + SC_C), (const bf16_t*)(p.ws + WS_WUP), MB, FF2, D, D}; pg8::StaticOrder S; S.init(MB, FF2, G, bid);
        EpiUp E{(bf16_t*)(p.ws + WS_U), (bf16_t*)(p.ws + WS_HALO), p.out};
        pg8::gemm_phase<EpiUp, pg8::StaticOrder, false>(lds, g, S, E, nullptr);
    } else if constexpr (PH == 8) phase_act(p, tid, G, bid);
    else if constexpr (PH == 9) {
        pg8::Gemm g{(const bf16_t*)(p.ws + WS_U), (const bf16_t*)(p.ws + WS_WDN), MB, D, FF, FF2}; pg8::StaticOrder S; S.init(MB, D, G, bid);
        pg8::EpiF32 E{(float*)(p.ws + WS_U) + FF / 2, FF2 / 2, nullptr};
        pg8::gemm_phase<pg8::EpiF32, pg8::StaticOrder, false>(lds, g, S, E, nullptr);
    } else if constexpr (PH == 10) { phase_final(p, tid, G, bid); phase_cachecopy(p, tid, G, bid); }
}
template <int FIRST, int... REST>
__device__ __forceinline__ void run_program(const Params& p, LAS unsigned char* lds, cg::grid_group& grid, int tid, int G, int bid) {
    if (p.en > (int)sizeof...(REST) - 1000) run_phase<FIRST>(p, lds, tid, G, bid);
    if constexpr (sizeof...(REST) > 0) { grid.sync(); run_program<REST...>(p, lds, grid, tid, G, bid); }
}
#define PROGRAM 0, 1, 2, 3, 4, 5, 6, 7, 8, 9, 10
__global__ void __launch_bounds__(NTHREADS, 2) hymba_fwd(Params p) {
    extern __shared__ __attribute__((aligned(16))) unsigned char lds_raw[];
    LAS unsigned char* lds = (LAS unsigned char*)lds_raw;
    cg::grid_group grid = cg::this_grid();
    run_program<PROGRAM>(p, lds, grid, threadIdx.x, gridDim.x, blockIdx.x);
}

extern "C" void kernel_launch(void* const* d_in, const int* in_sizes, int n_in, void* d_out, int out_size, void* d_ws, size_t ws_size, hipStream_t stream) {
    static int grid = 0;
    if (grid == 0) {
        if (n_in != 28 || (size_t)out_size != O_END || ws_size < WS_END) { fprintf(stderr, "kernel_launch: unexpected sizes n_in %d out %d ws %zu (need %zu)\n", n_in, out_size, ws_size, (size_t)WS_END); grid = -1; return; }
        int dev = 0, cus = 0, per_cu = 0;
        hipGetDevice(&dev); hipDeviceGetAttribute(&cus, hipDeviceAttributeMultiprocessorCount, dev);
        if (hipFuncSetAttribute((const void*)hymba_fwd, hipFuncAttributeMaxDynamicSharedMemorySize, LDS_BYTES) != hipSuccess) { fprintf(stderr, "kernel_launch: hipFuncSetAttribute failed\n"); grid = -1; return; }
        hipOccupancyMaxActiveBlocksPerMultiprocessor(&per_cu, (const void*)hymba_fwd, NTHREADS, LDS_BYTES);
        (void)hipGetLastError();
        if (per_cu < 1) per_cu = 1;
        grid = cus;
    }
    if (grid < 0) return;
    Params p{};
    for (int i = 0; i < 28; ++i) p.in[i] = (const float*)d_in[i];
    p.out = (float*)d_out; p.ws = (unsigned char*)d_ws; p.en = 1;
    void* args[] = {&p};
    hipError_t e = hipLaunchCooperativeKernel((const void*)hymba_fwd, dim3(grid), dim3(NTHREADS), args, LDS_BYTES, stream);
    if (e != hipSuccess) fprintf(stderr, "cooperative launch failed: %s (grid %d)\n", hipGetErrorString(e), grid);
}
```

```cpp
#include <hip/hip_runtime.h>
#include <hip/hip_cooperative_groups.h>
#include <cstdio>
#include <cstdint>
namespace pg8 {
#define PG8_LAS __attribute__((address_space(3)))
typedef unsigned short bf16_t;
typedef short bf16x8 __attribute__((ext_vector_type(8)));
typedef float f32x4 __attribute__((ext_vector_type(4)));
typedef unsigned u32x4 __attribute__((ext_vector_type(4)));
constexpr int BM = 256, BK = 64, HALF = 128, HTB = HALF * BK * 2  , STAGE_BYTES = 8 * HTB, NXCD = 8, WGM = 8;

__host__ __device__ __forceinline__ int lds_byte(int r, int c) { const int st = (r >> 4) * 2 + (c >> 5), rr = r & 15, cc = c & 31, ob = rr * 64 + cc * 2; return st * 1024 + (ob ^ (((ob >> 9) & 1) << 5)); }
__host__ __device__ __forceinline__ void stage_rc(int b, int& R, int& C) { const int st = b / 1024, sb = b % 1024, swz = sb ^ (((sb >> 9) & 1) << 5); R = (st >> 1) * 16 + swz / 64; C = (st & 1) * 32 + (swz % 64) / 2; }
__host__ __device__ __forceinline__ int perm32(int rho) { const int n = rho >> 4, i = rho & 15; return 8 * (i >> 2) + 4 * n + (i & 3); }

struct Unit { int pm, pn; };
struct Gemm { const bf16_t* A; const bf16_t* Bt; int M, N, K, lda; };

struct StaticOrder {
    int nM, nN, nwg, G, c;
    __host__ __device__ void init(int M, int N, int G_, int c_) { nM = M / BM; nN = N / BM; nwg = nM * nN; G = G_; c = c_; }
    __host__ __device__ bool next(int i, Unit& u) const {
        const long L = (long)i * G + c; if (L >= nwg) return false;
        int wgid = (int)L; { const int q = nwg / NXCD, r = nwg % NXCD, xcd = wgid % NXCD, off = wgid / NXCD; wgid = (xcd < r ? xcd * (q + 1) : r * (q + 1) + (xcd - r) * q) + off; }
        const int nig = WGM * nN, gid = wgid / nig, fm = gid * WGM, gsz = (nM - fm) < WGM ? (nM - fm) : WGM;
        u.pm = fm + ((wgid % nig) % gsz); u.pn = (wgid % nig) / gsz; return true;
    }
    __device__ __forceinline__ void a_ready(const Unit&) const {}
    __device__ __forceinline__ void done(const Unit&) const {}
};
__device__ __forceinline__ unsigned cvt_pk_bf16(float lo, float hi) { unsigned r; asm volatile("v_cvt_pk_bf16_f32 %0, %1, %2" : "=v"(r) : "v"(lo), "v"(hi)); return r; }
typedef float f32x2 __attribute__((ext_vector_type(2)));
struct EpiF32 {
    static constexpr bool PERM = false, AFTER_DRAIN = false;
    float* C; int ldc; const float* bias;
    __device__ __forceinline__ void operator()(const f32x4 (&acc)[2][2][4][2], const Unit& u, int wr, int wc, int fr, int fq) const {
        const int row0 = u.pm * BM + wr * 64 + fr, col0 = u.pn * BM + wc * 32 + 4 * fq;
        f32x4 bv[2][2];
#pragma unroll
        for (int bj = 0; bj < 2; ++bj)
#pragma unroll
            for (int n = 0; n < 2; ++n) bv[bj][n] = bias ? *(const f32x4*)(bias + col0 + bj * HALF + n * 16) : (f32x4){0.f, 0.f, 0.f, 0.f};
#pragma unroll
        for (int ai = 0; ai < 2; ++ai)
#pragma unroll
            for (int m = 0; m < 4; ++m) { float* rowp = C + (size_t)(row0 + ai * HALF + m * 16) * ldc + col0;
#pragma unroll
                for (int bj = 0; bj < 2; ++bj)
#pragma unroll
                    for (int n = 0; n < 2; ++n) *(f32x4*)(rowp + bj * HALF + n * 16) = acc[ai][bj][m][n] + bv[bj][n]; }
    }
};
template <class Epi, class Sched, bool STAMP = false>
__device__ __forceinline__ void gemm_phase(PG8_LAS unsigned char* lds, const Gemm g, const Sched& S, const Epi& E, unsigned long long* stamps) {
    const int tid = threadIdx.x, wid = __builtin_amdgcn_readfirstlane(tid >> 6), lane = tid & 63, wr = wid >> 2, wc = wid & 3, fr = lane & 15, fq = lane >> 4;
    const int K = g.K, nt = K / BK;
    int ts_lo = 0, ts_hi = 0, nts = 0; const unsigned long long rt_entry = STAMP ? (unsigned long long)wall_clock64() : 0ull;
#define PG8_STAMP() do { if (STAMP && wid == 0 && nts < 64) { const unsigned long long _c = (unsigned long long)clock64(); \
        ts_lo = (lane == nts) ? (int)(unsigned)_c : ts_lo; ts_hi = (lane == nts) ? (int)(unsigned)(_c >> 32) : ts_hi; ++nts; } } while (0)
    PG8_STAMP();
    unsigned voffA[2], voffB[2];
#pragma unroll
    for (int i = 0; i < 2; ++i) { int R, C; stage_rc(tid * 16 + i * 8192, R, C); const int Rb = Epi::PERM ? ((R & ~31) + perm32(R & 31)) : R;
        voffA[i] = (unsigned)(R * g.lda + C) * 2u; voffB[i] = (unsigned)(Rb * K + C) * 2u; }
    const size_t kstep = (size_t)(BK * 2);
    const size_t hstep = (size_t)HALF * K * 2, hstepA = (size_t)HALF * g.lda * 2;
    const size_t tstep = 2 * hstep, tstepA = 2 * hstepA;
    const unsigned ldsw = (unsigned)wid * 1024u;
    const int aoff = lds_byte(wr * 64 + fr, fq * 8), boff = lds_byte(wc * 32 + fr, fq * 8);
#define PG8_SA(b, h) (((b) * 2 + (h)) * HTB)
#define PG8_SB(b, h) ((4 + (b) * 2 + (h)) * HTB)
#define PG8_STAGE(bufoff, gbase, voff) do { _Pragma("unroll") for (int _i = 0; _i < 2; ++_i) \
        __builtin_amdgcn_global_load_lds((const unsigned*)((const char*)(gbase) + (voff)[_i]), (PG8_LAS unsigned*)(lds + (bufoff) + ldsw + _i * 8192), 16, 0, 0); } while (0)
#define PG8_LDA(dst, b, h) do { _Pragma("unroll") for (int m = 0; m < 4; ++m) _Pragma("unroll") for (int k = 0; k < 2; ++k) dst[m][k] = *(const PG8_LAS bf16x8*)(lds + PG8_SA(b, h) + aoff + m * 2048 + k * 1024); } while (0)
#define PG8_LDB(dst, b, h) do { _Pragma("unroll") for (int n = 0; n < 2; ++n) _Pragma("unroll") for (int k = 0; k < 2; ++k) dst[n][k] = *(const PG8_LAS bf16x8*)(lds + PG8_SB(b, h) + boff + n * 2048 + k * 1024); } while (0)
#define PG8_MMA(ai, bj, At, Bt) do { __builtin_amdgcn_s_setprio(1); _Pragma("unroll") for (int m = 0; m < 4; ++m) _Pragma("unroll") for (int n = 0; n < 2; ++n) _Pragma("unroll") for (int k = 0; k < 2; ++k) \
        acc[ai][bj][m][n] = __builtin_amdgcn_mfma_f32_16x16x32_bf16(Bt[n][k], At[m][k], acc[ai][bj][m][n], 0, 0, 0); __builtin_amdgcn_s_setprio(0); } while (0)
#define PG8_WAIT_V(n) asm volatile("s_waitcnt vmcnt(" #n ")" ::: "memory")
#define PG8_WAIT_L(n) asm volatile("s_waitcnt lgkmcnt(" #n ")" ::: "memory")
#define PG8_BAR __builtin_amdgcn_s_barrier()
#define PG8_SCHED __builtin_amdgcn_sched_barrier(0)
    Unit cur, nxt; int ui = 0;
    if (!S.next(0, cur)) return;
    f32x4 acc[2][2][4][2];
#pragma unroll
    for (int a = 0; a < 2; ++a)
#pragma unroll
        for (int b = 0; b < 2; ++b)
#pragma unroll
            for (int m = 0; m < 4; ++m)
#pragma unroll
                for (int n = 0; n < 2; ++n) acc[a][b][m][n] = (f32x4){0.f, 0.f, 0.f, 0.f};
    bf16x8 At[4][2], B0[2][2], B1[2][2];
    const char* cA = (const char*)g.A + (size_t)cur.pm * tstepA; const char* cB = (const char*)g.Bt + (size_t)cur.pn * tstep;
    S.a_ready(cur);
    PG8_STAGE(PG8_SB(0, 0), cB, voffB); PG8_STAGE(PG8_SA(0, 0), cA, voffA); PG8_STAGE(PG8_SB(0, 1), cB + hstep, voffB); PG8_STAGE(PG8_SA(0, 1), cA + hstepA, voffA);
    if (wr == 1) PG8_BAR;
    PG8_WAIT_V(4); PG8_BAR;
    PG8_STAGE(PG8_SB(1, 0), cB + kstep, voffB); PG8_STAGE(PG8_SA(1, 0), cA + kstep, voffA); PG8_STAGE(PG8_SB(1, 1), cB + hstep + kstep, voffB);
    PG8_WAIT_V(6); PG8_BAR;
    PG8_STAMP();
    for (;;) {
        const bool has_next = S.next(ui + 1, nxt);
        const char* nA = has_next ? (const char*)g.A + (size_t)nxt.pm * tstepA : cA; const char* nB = has_next ? (const char*)g.Bt + (size_t)nxt.pn * tstep : cB;
        for (int t = 0; t < nt; t += 2) {
            const bool last = (t == nt - 2);
            const char* a1 = cA + (size_t)(t + 1) * kstep;
            const char* a2 = last ? nA : cA + (size_t)(t + 2) * kstep; const char* b2 = last ? nB : cB + (size_t)(t + 2) * kstep;
            const char* a3 = a2 + kstep; const char* b3 = b2 + kstep;
            if (last && has_next) S.a_ready(nxt);
            PG8_LDB(B0, 0, 0); PG8_SCHED; PG8_LDA(At, 0, 0); PG8_STAGE(PG8_SA(1, 1), a1 + hstepA, voffA);
            PG8_WAIT_L(8); PG8_BAR; PG8_WAIT_L(0); PG8_MMA(0, 0, At, B0); PG8_BAR; PG8_SCHED;
            PG8_LDB(B1, 0, 1); PG8_STAGE(PG8_SB(0, 0), b2, voffB);
            PG8_BAR; PG8_WAIT_L(0); PG8_MMA(0, 1, At, B1); PG8_BAR;
            PG8_LDA(At, 0, 1); PG8_STAGE(PG8_SA(0, 0), a2, voffA);
            PG8_BAR; PG8_WAIT_L(0); PG8_MMA(1, 0, At, B0); PG8_BAR; PG8_SCHED;
            PG8_STAGE(PG8_SB(0, 1), b2 + hstep, voffB);
            PG8_WAIT_V(6); PG8_BAR; PG8_MMA(1, 1, At, B1); PG8_BAR;
            PG8_LDB(B0, 1, 0); PG8_SCHED; PG8_LDA(At, 1, 0); PG8_STAGE(PG8_SA(0, 1), a2 + hstepA, voffA);
            PG8_WAIT_L(8); PG8_BAR; PG8_WAIT_L(0); PG8_MMA(0, 0, At, B0); PG8_BAR; PG8_SCHED;
            PG8_LDB(B1, 1, 1); PG8_STAGE(PG8_SB(1, 0), b3, voffB);
            PG8_BAR; PG8_WAIT_L(0); PG8_MMA(0, 1, At, B1); PG8_BAR;
            PG8_LDA(At, 1, 1); PG8_STAGE(PG8_SA(1, 0), a3, voffA);
            PG8_BAR; PG8_WAIT_L(0); PG8_MMA(1, 0, At, B0); PG8_BAR; PG8_SCHED;
            PG8_STAGE(PG8_SB(1, 1), b3 + hstep, voffB);
            PG8_WAIT_V(6); PG8_BAR; PG8_MMA(1, 1, At, B1); PG8_BAR;
        }
        PG8_STAMP();
        if constexpr (!Epi::AFTER_DRAIN) { E(acc, cur, wr, wc, fr, fq); S.done(cur); }
        PG8_STAMP();
        if (!has_next) break;
#pragma unroll
        for (int a = 0; a < 2; ++a)
#pragma unroll
            for (int b = 0; b < 2; ++b)
#pragma unroll
                for (int m = 0; m < 4; ++m)
#pragma unroll
                    for (int n = 0; n < 2; ++n) acc[a][b][m][n] = (f32x4){0.f, 0.f, 0.f, 0.f};
        cur = nxt; cA = nA; cB = nB; ++ui;
    }
    PG8_WAIT_V(0);
    if (wr == 0) PG8_BAR;
    PG8_BAR;
    if constexpr (Epi::AFTER_DRAIN) { E.fused(acc, cur, wr, wc, fr, fq, lds, wid, lane); S.done(cur); }
    PG8_STAMP();
    if (STAMP && wid == 0) { stamps[lane] = lane < nts ? (((unsigned long long)(unsigned)ts_hi << 32) | (unsigned)ts_lo) : 0ull;
        if (lane == 62) stamps[62] = rt_entry; if (lane == 63) stamps[63] = (unsigned long long)wall_clock64(); }
#undef PG8_STAMP
#undef PG8_SA
#undef PG8_SB
#undef PG8_STAGE
#undef PG8_LDA
#undef PG8_LDB
#undef PG8_MMA
#undef PG8_WAIT_V
#undef PG8_WAIT_L
#undef PG8_BAR
#undef PG8_SCHED
}
}

namespace cg = cooperative_groups;
#define LAS __attribute__((address_space(3)))
typedef unsigned short bf16_t;
typedef unsigned int u32;
typedef pg8::bf16x8 bf16x8;
typedef pg8::f32x4 f32x4;
typedef pg8::u32x4 u32x4;

constexpr int D = 1024, TP = 4096, BP = 8, MP = BP * TP, BS = 32, TS = 8, MS = BS * TS;
constexpr int MB = MP + MS;
constexpr int MA = 33280;
constexpr int MA_REAL = MP + BS * 9;
constexpr int DIN = 3328, RCOLS = 1792, FF = 2816, FF2 = 5632, NLORA = 1536, KLORA = 256;
constexpr int NTHREADS = 512;
constexpr int LDS_BYTES = 144 * 1024;

constexpr size_t O_YP = 0;
constexpr size_t O_YS = O_YP + (size_t)MP * D;
constexpr size_t O_PSH = O_YS + (size_t)MS * D;
constexpr size_t O_PWKV = O_PSH + (size_t)BP * D;
constexpr size_t O_PK = O_PWKV + (size_t)BP * 8 * 64 * 64;
constexpr size_t O_PV = O_PK + (size_t)BP * 2048 * 512;
constexpr size_t O_PCONV = O_PV + (size_t)BP * 2048 * 512;
constexpr size_t O_SSH = O_PCONV + (size_t)BP * 2 * FF2;
constexpr size_t O_SWKV = O_SSH + (size_t)BS * D;
constexpr size_t O_SK = O_SWKV + (size_t)BS * 8 * 64 * 64;
constexpr size_t O_SV = O_SK + (size_t)BS * 2048 * 512;
constexpr size_t O_SCONV = O_SV + (size_t)BS * 2048 * 512;
constexpr size_t O_END = O_SCONV + (size_t)BS * 2 * FF2;

constexpr size_t al256(size_t x) { return (x + 255) & ~(size_t)255; }
constexpr size_t WS_WIN = 0;
constexpr size_t WS_WOUT = WS_WIN + al256((size_t)DIN * D * 2);
constexpr size_t WS_WUP = WS_WOUT + al256((size_t)D * D * 2);
constexpr size_t WS_WDN = WS_WUP + al256((size_t)FF2 * D * 2);
constexpr size_t WS_WLORA = WS_WDN + al256((size_t)D * FF * 2);
constexpr size_t WS_ROPE = WS_WLORA + al256((size_t)NLORA * KLORA * 2);
constexpr int NPOS = 4104;
constexpr size_t WS_SNEWK = WS_ROPE + al256((size_t)NPOS * 32 * 2 * 4);
constexpr size_t WS_SNEWV = WS_SNEWK + al256((size_t)MS * 512 * 4);
constexpr size_t WS_HALO = WS_SNEWV + al256((size_t)MS * 512 * 4);
constexpr size_t WS_A = WS_HALO + al256((size_t)1025 * 2 * FF2 * 2);
constexpr size_t WS_PROJRW = WS_A;
constexpr size_t WS_Q = WS_PROJRW + al256((size_t)MA * RCOLS * 2);
constexpr size_t WS_K = WS_Q + al256((size_t)MB * 512 * 2);
constexpr size_t WS_VT1 = WS_K + al256((size_t)MB * 512 * 2);
constexpr size_t WS_VT4 = WS_VT1 + al256((size_t)BP * 8 * 64 * TP * 2);
constexpr size_t WS_VT16 = WS_VT4 + al256((size_t)BP * 8 * 64 * TP * 2);
constexpr size_t WS_ALORA = WS_VT16 + al256((size_t)BP * 8 * 64 * TP * 2);
constexpr size_t WS_VROW = WS_ALORA + al256((size_t)MB * KLORA * 2);
constexpr size_t WS_A_EARLY_END = WS_VROW + al256((size_t)MP * 512 * 2);
constexpr size_t WS_U = WS_A;
constexpr size_t WS_END = WS_A + al256((size_t)MB * FF2 * 2);
static_assert(WS_A_EARLY_END <= WS_END, "region A overflow");
constexpr size_t WS_BAR = WS_END;
constexpr size_t WS_TOTAL = WS_END + 256;
constexpr size_t WS_Y = WS_ALORA;
static_assert(WS_Y + (size_t)MB * 512 * 4 <= WS_END, "Y overflow");
constexpr size_t SC_B = O_SK * 4;
constexpr size_t SC_C = SC_B + al256((size_t)MB * D * 4);
static_assert(SC_C + (size_t)MB * D * 2 <= O_SCONV * 4, "scratch overflow");
static_assert((size_t)MA * D * 2 <= (size_t)MB * D * 4 && (size_t)MB * NLORA * 2 <= (size_t)MB * D * 4, "region B");

struct Params {
    const float* in[28];
    float* out;
    unsigned char* ws;
    int en, pad;
};

enum { I_XP = 0, I_XS, I_SSHIFT, I_SWKV, I_CK, I_CV, I_SCONV, I_NMPRE, I_NMPOST, I_NFPRE, I_NFPOST, I_WIN, I_MU, I_W0, I_WDEC, I_A0, I_WICLR, I_WGATE,
       I_KK, I_KA, I_RK, I_LNW, I_LNB, I_WOUT, I_WUP, I_CONVW, I_CONVB, I_WDN };

__device__ __forceinline__ float bflo(u32 p) { return __uint_as_float(p << 16); }
__device__ __forceinline__ float bfhi(u32 p) { return __uint_as_float(p & 0xffff0000u); }
__device__ __forceinline__ u32 pk2(float a, float b) { return pg8::cvt_pk_bf16(a, b); }
__device__ __forceinline__ float wave_sum(float v) {
#pragma unroll
    for (int o = 1; o < 64; o <<= 1) v += __shfl_xor(v, o);
    return v;
}
template <int N> __device__ __forceinline__ float dpp_ror(float x) {
    return __int_as_float(__builtin_amdgcn_update_dpp(0, __float_as_int(x), 0x120 + N, 0xF, 0xF, false));
}
__device__ __forceinline__ float row16_sum(float x) {
    x += dpp_ror<8>(x); x += dpp_ror<4>(x); x += dpp_ror<2>(x); x += dpp_ror<1>(x);
    return x;
}
__device__ __forceinline__ void row16_sum4(float& a, float& b, float& c, float& d) {
    asm volatile("s_nop 1\n\t"
                 "v_add_f32_dpp %0, %0, %0 row_ror:8 row_mask:0xf bank_mask:0xf\n\t" "v_add_f32_dpp %1, %1, %1 row_ror:8 row_mask:0xf bank_mask:0xf\n\t"
                 "v_add_f32_dpp %2, %2, %2 row_ror:8 row_mask:0xf bank_mask:0xf\n\t" "v_add_f32_dpp %3, %3, %3 row_ror:8 row_mask:0xf bank_mask:0xf\n\t"
                 "v_add_f32_dpp %0, %0, %0 row_ror:4 row_mask:0xf bank_mask:0xf\n\t" "v_add_f32_dpp %1, %1, %1 row_ror:4 row_mask:0xf bank_mask:0xf\n\t"
                 "v_add_f32_dpp %2, %2, %2 row_ror:4 row_mask:0xf bank_mask:0xf\n\t" "v_add_f32_dpp %3, %3, %3 row_ror:4 row_mask:0xf bank_mask:0xf\n\t"
                 "v_add_f32_dpp %0, %0, %0 row_ror:2 row_mask:0xf bank_mask:0xf\n\t" "v_add_f32_dpp %1, %1, %1 row_ror:2 row_mask:0xf bank_mask:0xf\n\t"
                 "v_add_f32_dpp %2, %2, %2 row_ror:2 row_mask:0xf bank_mask:0xf\n\t" "v_add_f32_dpp %3, %3, %3 row_ror:2 row_mask:0xf bank_mask:0xf\n\t"
                 "v_add_f32_dpp %0, %0, %0 row_ror:1 row_mask:0xf bank_mask:0xf\n\t" "v_add_f32_dpp %1, %1, %1 row_ror:1 row_mask:0xf bank_mask:0xf\n\t"
                 "v_add_f32_dpp %2, %2, %2 row_ror:1 row_mask:0xf bank_mask:0xf\n\t" "v_add_f32_dpp %3, %3, %3 row_ror:1 row_mask:0xf bank_mask:0xf\n\t"
                 "s_nop 1"
                 : "+v"(a), "+v"(b), "+v"(c), "+v"(d));
}
__device__ __forceinline__ void row16_sum2(float& a, float& b) {
    asm volatile("s_nop 1\n\t"
                 "v_add_f32_dpp %0, %0, %0 row_ror:8 row_mask:0xf bank_mask:0xf\n\t" "v_add_f32_dpp %1, %1, %1 row_ror:8 row_mask:0xf bank_mask:0xf\n\t" "s_nop 0\n\t"
                 "v_add_f32_dpp %0, %0, %0 row_ror:4 row_mask:0xf bank_mask:0xf\n\t" "v_add_f32_dpp %1, %1, %1 row_ror:4 row_mask:0xf bank_mask:0xf\n\t" "s_nop 0\n\t"
                 "v_add_f32_dpp %0, %0, %0 row_ror:2 row_mask:0xf bank_mask:0xf\n\t" "v_add_f32_dpp %1, %1, %1 row_ror:2 row_mask:0xf bank_mask:0xf\n\t" "s_nop 0\n\t"
                 "v_add_f32_dpp %0, %0, %0 row_ror:1 row_mask:0xf bank_mask:0xf\n\t" "v_add_f32_dpp %1, %1, %1 row_ror:1 row_mask:0xf bank_mask:0xf\n\t"
                 "s_nop 1"
                 : "+v"(a), "+v"(b));
}
__device__ __forceinline__ float sigmoidf_(float x) { return 1.f / (1.f + __expf(-x)); }

__device__ __forceinline__ int win_rowmap(int n) {
    if (n < RCOLS || n >= RCOLS + 1024) return n;
    const int base = (n < RCOLS + 512) ? RCOLS : RCOLS + 512, c = n - base, unit = c >> 8, cu = c & 255, hu = cu >> 6, d = cu & 63, e = d & 31, s = d >> 5;
    const int idx = hu * 32 + e, bj = idx >> 6, wc = (idx & 63) >> 4, fq = (idx & 15) >> 2, j = idx & 3;
    return base + unit * 256 + 128 * bj + 32 * wc + 16 * s + 4 * fq + j;
}
__device__ __forceinline__ void transpose_item(const float* W, int K, int N, bf16_t* WT, int mode, LAS float* scr, int item, int lane) {
    const int nblk = N / 32, kb = item / nblk, nb = item % nblk, k0 = 64 * kb, n0 = 32 * nb;
#pragma unroll 8
    for (int i = 0; i < 32; ++i) { const int kk = 2 * i + (lane >> 5); scr[kk * 33 + (lane & 31)] = W[(size_t)(k0 + kk) * N + n0 + (lane & 31)]; }
    asm volatile("s_waitcnt lgkmcnt(0)" ::: "memory");
    const int c = lane & 7;
#pragma unroll
    for (int j = 0; j < 4; ++j) { const int n = (lane >> 3) + 8 * j; const LAS float* s = scr + (8 * c) * 33 + n;
        uint4 o; o.x = pk2(s[0 * 33], s[1 * 33]); o.y = pk2(s[2 * 33], s[3 * 33]); o.z = pk2(s[4 * 33], s[5 * 33]); o.w = pk2(s[6 * 33], s[7 * 33]);
        const int row = mode ? win_rowmap(n0 + n) : (n0 + n);
        *(uint4*)(WT + (size_t)row * K + k0 + 8 * c) = o; }
    asm volatile("s_waitcnt lgkmcnt(0)" ::: "memory");
}
__device__ __forceinline__ void rms_row(const float* xrow, const float* g, bf16_t* orow, float* frow, int lane) {
    const float4* xr = (const float4*)xrow + lane; const float4* gr = (const float4*)g + lane;
    float4 v[4]; float s = 0.f;
#pragma unroll
    for (int j = 0; j < 4; ++j) { v[j] = xr[64 * j]; s += (v[j].x * v[j].x + v[j].y * v[j].y) + (v[j].z * v[j].z + v[j].w * v[j].w); }
    const float rs = rsqrtf(wave_sum(s) * (1.f / D) + 1e-6f);
#pragma unroll
    for (int j = 0; j < 4; ++j) { const float4 gg = gr[64 * j];
        float4 y; y.x = v[j].x * rs * gg.x; y.y = v[j].y * rs * gg.y; y.z = v[j].z * rs * gg.z; y.w = v[j].w * rs * gg.w;
        uint2 o; o.x = pk2(y.x, y.y); o.y = pk2(y.z, y.w);
        *((uint2*)orow + lane + 64 * j) = o;
        if (frow) *((float4*)frow + lane + 64 * j) = y; }
}
__device__ __forceinline__ void phase0(const Params& p, LAS unsigned char* lds, int tid, int G, int bid) {
    const int wave = tid >> 6, lane = tid & 63, gw = bid * 8 + wave, NGW = G * 8;
    LAS float* scr = (LAS float*)(lds + wave * 16384);
    bf16_t* WinT = (bf16_t*)(p.ws + WS_WIN); bf16_t* WoutT = (bf16_t*)(p.ws + WS_WOUT); bf16_t* WupT = (bf16_t*)(p.ws + WS_WUP); bf16_t* WdnT = (bf16_t*)(p.ws + WS_WDN);
    constexpr int I1 = (D / 64) * (DIN / 32), I2 = (D / 64) * (D / 32), I3 = (D / 64) * (FF2 / 32), I4 = (FF / 64) * (D / 32);
    for (int it = gw; it < I1 + I2 + I3 + I4; it += NGW) {
        int r = it;
        if (r < I1) { transpose_item(p.in[I_WIN], D, DIN, WinT, 1, scr, r, lane); continue; } r -= I1;
        if (r < I2) { transpose_item(p.in[I_WOUT], D, D, WoutT, 0, scr, r, lane); continue; } r -= I2;
        if (r < I3) { transpose_item(p.in[I_WUP], D, FF2, WupT, 0, scr, r, lane); continue; } r -= I3;
        transpose_item(p.in[I_WDN], FF, D, WdnT, 0, scr, r, lane);
    }
    const int gt = bid * NTHREADS + tid, NT = G * NTHREADS;
    bf16_t* WL = (bf16_t*)(p.ws + WS_WLORA);
    for (int i = gt; i < NLORA * KLORA; i += NT) {
        const int row = i >> 8, k = i & 255; float v = 0.f;
        if (row < 512) { if (k < 64) v = p.in[I_WDEC][k * 512 + row]; }
        else if (row < 1024) { if (k >= 64 && k < 128) v = p.in[I_WICLR][(k - 64) * 512 + (row - 512)]; }
        else { if (k >= 128) v = p.in[I_WGATE][(k - 128) * 512 + (row - 1024)]; }
        WL[i] = (bf16_t)(pk2(v, 0.f) & 0xffffu);
    }
    float* rope = (float*)(p.ws + WS_ROPE);
    for (int i = gt; i < NPOS * 32; i += NT) {
        const int pi = i >> 5, e = i & 31; const int pos = pi < TP ? pi : 16384 + (pi - TP);
        double inv = 1.0; for (int q = 0; q < e; ++q) inv *= 0.7498942093324558273;
        const float ang = (float)pos * (float)inv;
        const double a = (double)ang; const double kq = rint(a * 0.15915494309189535); double r = a - kq * 6.283185307179586; r -= kq * 2.4492935982947064e-16;
        const double r2 = r * r;
        double sn = 1.0 / 51090942171709440000.0;
        sn = sn * r2 * (-1.0) + 1.0 / 121645100408832000.0;
        sn = -sn * r2 + 1.0 / 355687428096000.0;
        sn = -sn * r2 + 1.0 / 1307674368000.0;
        sn = -sn * r2 + 1.0 / 6227020800.0;
        sn = -sn * r2 + 1.0 / 39916800.0;
        sn = -sn * r2 + 1.0 / 362880.0;
        sn = -sn * r2 + 1.0 / 5040.0;
        sn = -sn * r2 + 1.0 / 120.0;
        sn = -sn * r2 + 1.0 / 6.0;
        sn = -sn * r2 + 1.0;
        sn *= r;
        double cs = 1.0 / 1124000727777607680000.0;
        cs = -cs * r2 + 1.0 / 2432902008176640000.0;
        cs = -cs * r2 + 1.0 / 6402373705728000.0;
        cs = -cs * r2 + 1.0 / 20922789888000.0;
        cs = -cs * r2 + 1.0 / 87178291200.0;
        cs = -cs * r2 + 1.0 / 479001600.0;
        cs = -cs * r2 + 1.0 / 3628800.0;
        cs = -cs * r2 + 1.0 / 40320.0;
        cs = -cs * r2 + 1.0 / 720.0;
        cs = -cs * r2 + 1.0 / 24.0;
        cs = -cs * r2 + 0.5;
        cs = -cs * r2 + 1.0;
        rope[i] = (float)cs; rope[NPOS * 32 + i] = (float)sn;
    }
    bf16_t* H = (bf16_t*)((unsigned char*)p.out + SC_B);
    for (int row = gw; row < MA; row += NGW) {
        bf16_t* orow = H + (size_t)row * D;
        if (row < MP) {
            const bool last = (row & (TP - 1)) == TP - 1;
            rms_row(p.in[I_XP] + (size_t)row * D, p.in[I_NMPRE], orow, last ? p.out + O_PSH + (size_t)(row >> 12) * D : nullptr, lane);
        } else {
            const int s = row - MP;
            if (s < BS * 9) {
                const int b = s / 9, j = s - b * 9;
                if (j == 0) {
                    const float4* sr = (const float4*)(p.in[I_SSHIFT] + (size_t)b * D) + lane;
#pragma unroll
                    for (int q = 0; q < 4; ++q) { const float4 v = sr[64 * q]; uint2 o; o.x = pk2(v.x, v.y); o.y = pk2(v.z, v.w); *((uint2*)orow + lane + 64 * q) = o; }
                } else {
                    rms_row(p.in[I_XS] + (size_t)(b * TS + j - 1) * D, p.in[I_NMPRE], orow, j == TS ? p.out + O_SSH + (size_t)b * D : nullptr, lane);
                }
            } else {
#pragma unroll
                for (int q = 0; q < 4; ++q) *((uint2*)orow + lane + 64 * q) = make_uint2(0u, 0u);
            }
        }
    }
}

struct EpiProj {
    static constexpr bool PERM = false, AFTER_DRAIN = false;
    bf16_t* projrw; bf16_t* Q; bf16_t* K; bf16_t* VT1; bf16_t* VT4; bf16_t* VT16; const float* rope; float* out; float* snewk; float* snewv;
    __device__ __forceinline__ void operator()(const f32x4 (&acc)[2][2][4][2], const pg8::Unit& u, int wr, int wc, int fr, int fq) const {
        const int pn = u.pn;
        if (pn < 7) {
#pragma unroll
            for (int ai = 0; ai < 2; ++ai)
#pragma unroll
                for (int m = 0; m < 4; ++m) { const int row = u.pm * 256 + ai * 128 + wr * 64 + m * 16 + fr;
                    bf16_t* rp = projrw + (size_t)row * RCOLS + pn * 256 + wc * 32 + 4 * fq;
#pragma unroll
                    for (int bj = 0; bj < 2; ++bj)
#pragma unroll
                        for (int n = 0; n < 2; ++n) { const f32x4 v = acc[ai][bj][m][n]; uint2 o; o.x = pk2(v[0], v[1]); o.y = pk2(v[2], v[3]); *(uint2*)(rp + bj * 128 + n * 16) = o; } }
            return;
        }
#pragma unroll
        for (int ai = 0; ai < 2; ++ai)
#pragma unroll
            for (int m = 0; m < 4; ++m) {
                const int row = u.pm * 256 + ai * 128 + wr * 64 + m * 16 + fr;
                bool prompt = row < MP; int b, t, rowB, pi; bool valid = true;
                if (prompt) { b = row >> 12; t = row & (TP - 1); rowB = row; pi = t; }
                else { const int s = row - MP; b = s / 9; const int j = s - b * 9; valid = (s < BS * 9) && (j > 0); t = j - 1; rowB = MP + b * TS + t; pi = TP + t; }
                if (!valid) continue;
                if (pn < 11) {
                    const bool isq = pn < 9; const int unit = isq ? pn - 7 : pn - 9;
#pragma unroll
                    for (int bj = 0; bj < 2; ++bj) {
                        const int idx = bj * 64 + wc * 16 + fq * 4, hu = idx >> 5, e = idx & 31;
                        const float4 cs = *(const float4*)(rope + (size_t)pi * 32 + e), sn = *(const float4*)(rope + (size_t)NPOS * 32 + (size_t)pi * 32 + e);
                        const f32x4 x1 = acc[ai][bj][m][0], x2 = acc[ai][bj][m][1];
                        float o1[4], o2[4];
                        o1[0] = x1[0] * cs.x - x2[0] * sn.x; o2[0] = x1[0] * sn.x + x2[0] * cs.x;
                        o1[1] = x1[1] * cs.y - x2[1] * sn.y; o2[1] = x1[1] * sn.y + x2[1] * cs.y;
                        o1[2] = x1[2] * cs.z - x2[2] * sn.z; o2[2] = x1[2] * sn.z + x2[2] * cs.z;
                        o1[3] = x1[3] * cs.w - x2[3] * sn.w; o2[3] = x1[3] * sn.w + x2[3] * cs.w;
                        const int col = unit * 256 + hu * 64 + e;
                        if (isq) {
                            uint2 a, c2; a.x = pk2(o1[0] * 0.125f, o1[1] * 0.125f); a.y = pk2(o1[2] * 0.125f, o1[3] * 0.125f); c2.x = pk2(o2[0] * 0.125f, o2[1] * 0.125f); c2.y = pk2(o2[2] * 0.125f, o2[3] * 0.125f);
                            *(uint2*)(Q + (size_t)rowB * 512 + col) = a; *(uint2*)(Q + (size_t)rowB * 512 + col + 32) = c2;
                        } else {
                            uint2 a, c2; a.x = pk2(o1[0], o1[1]); a.y = pk2(o1[2], o1[3]); c2.x = pk2(o2[0], o2[1]); c2.y = pk2(o2[2], o2[3]);
                            *(uint2*)(K + (size_t)rowB * 512 + col) = a; *(uint2*)(K + (size_t)rowB * 512 + col + 32) = c2;
                            float* dst = nullptr;
                            if (prompt) { if (t >= 2048) dst = out + O_PK + ((size_t)b * 2048 + (t - 2048)) * 512 + col; }
                            else dst = snewk + (size_t)(b * TS + t) * 512 + col;
                            if (dst) { *(float4*)dst = make_float4(o1[0], o1[1], o1[2], o1[3]); *(float4*)(dst + 32) = make_float4(o2[0], o2[1], o2[2], o2[3]); }
                        }
                    }
                } else {
#pragma unroll
                    for (int bj = 0; bj < 2; ++bj)
#pragma unroll
                        for (int n = 0; n < 2; ++n) {
                            const int col = (pn - 11) * 256 + bj * 128 + wc * 32 + n * 16 + 4 * fq; const f32x4 v = acc[ai][bj][m][n];
                            if (prompt) {
                                if (t >= 2048) *(float4*)(out + O_PV + ((size_t)b * 2048 + (t - 2048)) * 512 + col) = make_float4(v[0], v[1], v[2], v[3]);
                                uint2 o; o.x = pk2(v[0], v[1]); o.y = pk2(v[2], v[3]); *(uint2*)(VT1 + (size_t)rowB * 512 + col) = o;
                            } else {
                                *(float4*)(snewv + (size_t)(b * TS + t) * 512 + col) = make_float4(v[0], v[1], v[2], v[3]);
                            }
                        }
                }
            }
    }
};
struct EpiDag {
    static constexpr bool PERM = false, AFTER_DRAIN = false;
    bf16_t* dag; const float* w0; const float* a0;
    __device__ __forceinline__ void operator()(const f32x4 (&acc)[2][2][4][2], const pg8::Unit& u, int wr, int wc, int fr, int fq) const {
        const int kind = u.pn >> 1;
#pragma unroll
        for (int bj = 0; bj < 2; ++bj)
#pragma unroll
            for (int n = 0; n < 2; ++n) {
                const int col = u.pn * 256 + bj * 128 + wc * 32 + n * 16 + 4 * fq;
                float4 bias = make_float4(0.f, 0.f, 0.f, 0.f);
                if (kind == 0) bias = *(const float4*)(w0 + col); else if (kind == 1) bias = *(const float4*)(a0 + col - 512);
                const float bb[4] = {bias.x, bias.y, bias.z, bias.w};
#pragma unroll
                for (int ai = 0; ai < 2; ++ai)
#pragma unroll
                    for (int m = 0; m < 4; ++m) { const int row = u.pm * 256 + ai * 128 + wr * 64 + m * 16 + fr; const f32x4 v = acc[ai][bj][m][n]; float o[4];
#pragma unroll
                        for (int j = 0; j < 4; ++j) { const float x = v[j] + bb[j];
                            if (kind == 0) { const float z = -x; const float sp = fmaxf(z, 0.f) + __logf(1.f + __expf(-fabsf(z))); o[j] = -__expf(-sp - 0.5f); }
                            else if (kind == 1) o[j] = sigmoidf_(x);
                            else o[j] = x; }
                        uint2 q; q.x = pk2(o[0], o[1]); q.y = pk2(o[2], o[3]); *(uint2*)(dag + (size_t)row * NLORA + col) = q; }
            }
    }
};
struct EpiUp {
    static constexpr bool PERM = false, AFTER_DRAIN = false;
    bf16_t* U; bf16_t* halo; float* out;
    __device__ __forceinline__ void operator()(const f32x4 (&acc)[2][2][4][2], const pg8::Unit& u, int wr, int wc, int fr, int fq) const {
#pragma unroll
        for (int ai = 0; ai < 2; ++ai)
#pragma unroll
            for (int m = 0; m < 4; ++m) {
                const int row = u.pm * 256 + ai * 128 + wr * 64 + m * 16 + fr; const int col0 = u.pn * 256 + wc * 32 + 4 * fq;
                bf16_t* hrow = nullptr; float* frow = nullptr;
                if (row < MP) { const int t = row & (TP - 1);
                    if ((t & 31) >= 30) hrow = halo + ((size_t)((row >> 5) + 1) * 2 + ((t & 31) - 30)) * FF2;
                    if (t >= TP - 2) frow = out + O_PCONV + ((size_t)(row >> 12) * 2 + (t - (TP - 2))) * FF2;
                } else { const int s = row - MP, b = s >> 3, tt = s & 7; if (tt >= 6) frow = out + O_SCONV + ((size_t)b * 2 + (tt - 6)) * FF2; }
#pragma unroll
                for (int bj = 0; bj < 2; ++bj)
#pragma unroll
                    for (int n = 0; n < 2; ++n) { const f32x4 v = acc[ai][bj][m][n]; const int col = col0 + bj * 128 + n * 16;
                        uint2 o; o.x = pk2(v[0], v[1]); o.y = pk2(v[2], v[3]);
                        *(uint2*)(U + (size_t)row * FF2 + col) = o;
                        if (hrow) *(uint2*)(hrow + col) = o;
                        if (frow) *(float4*)(frow + col) = make_float4(v[0], v[1], v[2], v[3]); }
            }
    }
};

__device__ __forceinline__ int rowA_of(int rowB) { return rowB < MP ? rowB : MP + ((rowB - MP) >> 3) * 9 + 1 + ((rowB - MP) & 7); }
__device__ __forceinline__ void phase_alora(const Params& p, int tid, int G, int bid) {
    const bf16_t* PR = (const bf16_t*)(p.ws + WS_PROJRW); bf16_t* AL = (bf16_t*)(p.ws + WS_ALORA); const float* mu = p.in[I_MU];
    const int gt = bid * NTHREADS + tid, NT = G * NTHREADS;
    for (int i = gt; i < MB * 64; i += NT) {
        const int rowB = i >> 6, c = (i & 63) * 4, rowA = rowA_of(rowB);
        const uint2 cur = *(const uint2*)(PR + (size_t)rowA * RCOLS + 1536 + c);
        uint2 prv = make_uint2(0u, 0u);
        if (!(rowB < MP && (rowB & (TP - 1)) == 0)) prv = *(const uint2*)(PR + (size_t)(rowA - 1) * RCOLS + 1536 + c);
        const float4 m4 = *(const float4*)(mu + 1536 + c);
        float x[4] = {bflo(cur.x), bfhi(cur.x), bflo(cur.y), bfhi(cur.y)}; const float pv[4] = {bflo(prv.x), bfhi(prv.x), bflo(prv.y), bfhi(prv.y)}; const float mm[4] = {m4.x, m4.y, m4.z, m4.w};
#pragma unroll
        for (int j = 0; j < 4; ++j) { float v = x[j] + (pv[j] - x[j]) * mm[j];
            if (c < 64) v = tanhf(v); else if (c >= 128) v = sigmoidf_(v);
            x[j] = v; }
        uint2 o; o.x = pk2(x[0], x[1]); o.y = pk2(x[2], x[3]);
        *(uint2*)(AL + (size_t)rowB * KLORA + c) = o;
    }
}


__device__ __forceinline__ void phase_vtrans(const Params& p, LAS unsigned char* lds, int tid, int G, int bid) {
    const bf16_t* VR = (const bf16_t*)(p.ws + WS_VROW);
    constexpr int PITCH = 132;
    for (int item = bid; item < BP * 8 * 8; item += G) {
        const int b = item >> 6, h = (item >> 3) & 7, t0 = (item & 7) * 512;
        __syncthreads();
#pragma unroll
        for (int i = 0; i < 8; ++i) { const int piece = tid + 512 * i, row = piece >> 3, c8 = piece & 7;
            const uint4 v = *(const uint4*)(VR + (size_t)(b * TP + t0 + row) * 512 + h * 64 + c8 * 8);
            LAS u32* dst = (LAS u32*)(lds + row * PITCH + c8 * 16); dst[0] = v.x; dst[1] = v.y; dst[2] = v.z; dst[3] = v.w; }
        __syncthreads();
#pragma unroll 1
        for (int lay = 0; lay < 3; ++lay) {
            const int dd = lay == 0 ? 1 : (lay == 1 ? 4 : 16); const int Tdd = TP / dd;
            bf16_t* VT = (bf16_t*)(p.ws + (lay == 0 ? WS_VT1 : (lay == 1 ? WS_VT4 : WS_VT16))) + (size_t)(b * 8 + h) * 64 * TP;
            const int chunk0 = (t0 / dd) >> 5;
#pragma unroll
            for (int i = 0; i < 8; ++i) {
                const int sidx = tid + 512 * i, g = sidx & 3, d = (sidx >> 2) & 63, rc = sidx >> 8;
                int r, cl; if (lay == 0) { r = 0; cl = rc; } else if (lay == 1) { r = rc & 3; cl = rc >> 2; } else { r = rc; cl = 0; }
                u32 w[4];
#pragma unroll
                for (int hf = 0; hf < 2; ++hf)
#pragma unroll
                    for (int jp = 0; jp < 2; ++jp) {
                        const int u5a = 16 * hf + 4 * g + 2 * jp; const int ta = (32 * cl + u5a) * dd + r, tb = ta + dd;
                        const u32 lo = *(const LAS unsigned short*)(lds + ta * PITCH + d * 2), hi = *(const LAS unsigned short*)(lds + tb * PITCH + d * 2);
                        w[hf * 2 + jp] = lo | (hi << 16);
                    }
                *(uint4*)(VT + (size_t)r * Tdd * 64 + (size_t)(chunk0 + cl) * 2048 + d * 32 + 8 * g) = make_uint4(w[0], w[1], w[2], w[3]);
            }
        }
    }
    __syncthreads();
}

constexpr int CH = 32;
constexpr int SST = 452;
constexpr int SI_W = 0, SI_A = 64, SI_B = 128, SI_K = 192, SI_WR = 256, SI_V = 320, SI_G = 384, SI_SC = 448;
struct PrepRegs { uint2 cr, ck, cv, pr, pk, pv, dw, da, dg; };
__device__ __forceinline__ void scan_item(const Params& p, LAS unsigned char* lds, int tid, bool sample, int b, int h, int half) {
    const bf16_t* PR = (const bf16_t*)(p.ws + WS_PROJRW); const bf16_t* DAG = (const bf16_t*)((const unsigned char*)p.out + SC_B);
    float* YG = (float*)(p.ws + WS_Y);
    LAS float* buf0 = (LAS float*)lds; LAS float* buf1 = buf0 + CH * SST; LAS float* ybuf = buf1 + CH * SST;
    const int T = sample ? TS : TP;
    const int rowB0 = sample ? MP + b * TS : b * TP;
    const int rowA0 = sample ? MP + b * 9 + 1 : b * TP;
    const int nch = (T + CH - 1) / CH;
    const int ptl = tid >> 4, pj = (tid & 15) * 4, pc = h * 64 + pj;
    const int lane = tid & 63, wv = tid >> 6, rg = wv * 4 + (lane >> 4), cgi = lane & 15;
    const int row = 32 * half + rg;
    float st[4];
    if (sample) {
        const float4 a = *(const float4*)(p.in[I_SWKV] + ((size_t)(b * 8 + h) * 64 + row) * 64 + 4 * cgi);
        st[0] = a.x; st[1] = a.y; st[2] = a.z; st[3] = a.w;
    } else {
#pragma unroll
        for (int j = 0; j < 4; ++j) st[j] = 0.f;
    }
    const float4 mur = *(const float4*)(p.in[I_MU] + pc), muk = *(const float4*)(p.in[I_MU] + 512 + pc), muv = *(const float4*)(p.in[I_MU] + 1024 + pc);
    const float4 kk4 = *(const float4*)(p.in[I_KK] + pc), ka4 = *(const float4*)(p.in[I_KA] + pc), rk4 = *(const float4*)(p.in[I_RK] + pc);
    __builtin_amdgcn_s_waitcnt(0x0F70);
    PrepRegs R;
#define SCAN_LOAD(chunk) do { const int t_ = (chunk) * CH + ptl; if (t_ < T) { const size_t ra = (size_t)(rowA0 + t_) * RCOLS + pc; const size_t rb = (size_t)(rowB0 + t_) * NLORA + pc; \
        R.cr = *(const uint2*)(PR + ra); R.ck = *(const uint2*)(PR + ra + 512); R.cv = *(const uint2*)(PR + ra + 1024); \
        if (!sample && t_ == 0) { R.pr = make_uint2(0u, 0u); R.pk = R.pr; R.pv = R.pr; } \
        else { R.pr = *(const uint2*)(PR + ra - RCOLS); R.pk = *(const uint2*)(PR + ra - RCOLS + 512); R.pv = *(const uint2*)(PR + ra - RCOLS + 1024); } \
        R.dw = *(const uint2*)(DAG + rb); R.da = *(const uint2*)(DAG + rb + 512); R.dg = *(const uint2*)(DAG + rb + 1024); } } while (0)
#define SCAN_PREP(chunk, dstbuf) do { const int t_ = (chunk) * CH + ptl; if (t_ < T) { \
        const float mr[4] = {mur.x, mur.y, mur.z, mur.w}, mk[4] = {muk.x, muk.y, muk.z, muk.w}, mv[4] = {muv.x, muv.y, muv.z, muv.w}; \
        const float kkc[4] = {kk4.x, kk4.y, kk4.z, kk4.w}, kac[4] = {ka4.x, ka4.y, ka4.z, ka4.w}, rkc[4] = {rk4.x, rk4.y, rk4.z, rk4.w}; \
        const float crr[4] = {bflo(R.cr.x), bfhi(R.cr.x), bflo(R.cr.y), bfhi(R.cr.y)}, ckk[4] = {bflo(R.ck.x), bfhi(R.ck.x), bflo(R.ck.y), bfhi(R.ck.y)}, cvv[4] = {bflo(R.cv.x), bfhi(R.cv.x), bflo(R.cv.y), bfhi(R.cv.y)}; \
        const float prr[4] = {bflo(R.pr.x), bfhi(R.pr.x), bflo(R.pr.y), bfhi(R.pr.y)}, pkk[4] = {bflo(R.pk.x), bfhi(R.pk.x), bflo(R.pk.y), bfhi(R.pk.y)}, pvv[4] = {bflo(R.pv.x), bfhi(R.pv.x), bflo(R.pv.y), bfhi(R.pv.y)}; \
        const float lw[4] = {bflo(R.dw.x), bfhi(R.dw.x), bflo(R.dw.y), bfhi(R.dw.y)}, aa[4] = {bflo(R.da.x), bfhi(R.da.x), bflo(R.da.y), bfhi(R.da.y)}, gg[4] = {bflo(R.dg.x), bfhi(R.dg.x), bflo(R.dg.y), bfhi(R.dg.y)}; \
        float r_[4], k_[4], v_[4], w_[4], kn[4], k2[4]; float nrm = 0.f; \
        _Pragma("unroll") for (int j = 0; j < 4; ++j) { r_[j] = crr[j] + (prr[j] - crr[j]) * mr[j]; k_[j] = ckk[j] + (pkk[j] - ckk[j]) * mk[j]; v_[j] = cvv[j] + (pvv[j] - cvv[j]) * mv[j]; \
            w_[j] = __expf(lw[j]); kn[j] = k_[j] * kkc[j]; nrm += kn[j] * kn[j]; k2[j] = k_[j] * (1.f + (aa[j] - 1.f) * kac[j]); } \
        nrm = row16_sum(nrm); const float inv = 1.f / fmaxf(sqrtf(nrm), 1e-12f); \
        float br = 0.f, kr = 0.f, rk = 0.f; float an[4], bn[4], wrr[4]; \
        _Pragma("unroll") for (int j = 0; j < 4; ++j) { const float kkn = kn[j] * inv; an[j] = -kkn; bn[j] = kkn * aa[j]; wrr[j] = w_[j] * r_[j]; br += bn[j] * r_[j]; kr += k2[j] * r_[j]; rk += r_[j] * k2[j] * rkc[j]; } \
        br = row16_sum(br); kr = row16_sum(kr); rk = row16_sum(rk); \
        LAS float* rec = (dstbuf) + ptl * SST; \
        *(LAS f32x4*)(rec + SI_W + pj) = (f32x4){w_[0], w_[1], w_[2], w_[3]}; *(LAS f32x4*)(rec + SI_A + pj) = (f32x4){an[0], an[1], an[2], an[3]}; \
        *(LAS f32x4*)(rec + SI_B + pj) = (f32x4){bn[0], bn[1], bn[2], bn[3]}; *(LAS f32x4*)(rec + SI_K + pj) = (f32x4){k2[0], k2[1], k2[2], k2[3]}; \
        *(LAS f32x4*)(rec + SI_WR + pj) = (f32x4){wrr[0], wrr[1], wrr[2], wrr[3]}; *(LAS f32x4*)(rec + SI_V + pj) = (f32x4){v_[0], v_[1], v_[2], v_[3]}; \
        *(LAS f32x4*)(rec + SI_G + pj) = (f32x4){gg[0], gg[1], gg[2], gg[3]}; \
        if ((tid & 15) == 0) *(LAS f32x4*)(rec + SI_SC) = (f32x4){br, kr, rk, 0.f}; } } while (0)

    SCAN_LOAD(0);
    SCAN_PREP(0, buf0);
    __syncthreads();
    for (int c = 0; c < nch; ++c) {
        LAS float* cur = (c & 1) ? buf1 : buf0; LAS float* nxt = (c & 1) ? buf0 : buf1;
        if (c + 1 < nch) SCAN_LOAD(c + 1);
        const int ns = (T - c * CH) < CH ? (T - c * CH) : CH;
        {
            const LAS float* rec = cur;
            f32x4 wA = *(const LAS f32x4*)(rec + SI_W + 4 * cgi), aA = *(const LAS f32x4*)(rec + SI_A + 4 * cgi), bA = *(const LAS f32x4*)(rec + SI_B + 4 * cgi);
            f32x4 kA = *(const LAS f32x4*)(rec + SI_K + 4 * cgi), rA = *(const LAS f32x4*)(rec + SI_WR + 4 * cgi);
            float vA = rec[SI_V + row]; pg8::f32x2 cA = *(const LAS pg8::f32x2*)(rec + SI_SC);
            f32x4 wB, aB, bB, kB, rB; float vB; pg8::f32x2 cB;
#define SCAN_FETCH(W, A, B, K, R, V, C) do { rec += SST; W = *(const LAS f32x4*)(rec + SI_W + 4 * cgi); A = *(const LAS f32x4*)(rec + SI_A + 4 * cgi); B = *(const LAS f32x4*)(rec + SI_B + 4 * cgi); \
            K = *(const LAS f32x4*)(rec + SI_K + 4 * cgi); R = *(const LAS f32x4*)(rec + SI_WR + 4 * cgi); V = rec[SI_V + row]; C = *(const LAS pg8::f32x2*)(rec + SI_SC); } while (0)
#define SCAN_STEP(W, A, B, K, R, V, C, qq) do { \
            float da = st[0] * A[0]; da = st[1] * A[1] + da; da = st[2] * A[2] + da; da = st[3] * A[3] + da; \
            float dw = st[0] * R[0]; dw = st[1] * R[1] + dw; dw = st[2] * R[2] + dw; dw = st[3] * R[3] + dw; \
            row16_sum2(da, dw); \
            const float y = dw + da * C[0] + V * C[1]; \
            _Pragma("unroll") for (int j = 0; j < 4; ++j) st[j] = st[j] * W[j] + (da * B[j] + V * K[j]); \
            yk = ((qq) == cgi) ? y : yk; } while (0)
            for (int tb = 0; tb < ns; tb += 16) {
                const int nq = (ns - tb) < 16 ? (ns - tb) : 16;
                float yk = 0.f;
                for (int q = 0; q < nq; q += 2) {
                    SCAN_FETCH(wB, aB, bB, kB, rB, vB, cB);
                    SCAN_STEP(wA, aA, bA, kA, rA, vA, cA, q);
                    SCAN_FETCH(wA, aA, bA, kA, rA, vA, cA);
                    SCAN_STEP(wB, aB, bB, kB, rB, vB, cB, q + 1);
                }
                ybuf[(tb + cgi) * 32 + rg] = yk;
            }
#undef SCAN_FETCH
#undef SCAN_STEP
        }
        __syncthreads();
        if (ptl < ns) {
            const pg8::f32x2 y2 = *(const LAS pg8::f32x2*)(ybuf + ptl * 32 + 2 * (tid & 15));
            *(float2*)(YG + (size_t)(rowB0 + c * CH + ptl) * 512 + h * 64 + 32 * half + 2 * (tid & 15)) = make_float2(y2[0], y2[1]);
        }
        if (c + 1 < nch) SCAN_PREP(c + 1, nxt);
        __syncthreads();
    }
#undef SCAN_LOAD
#undef SCAN_PREP
    float* So = p.out + (sample ? O_SWKV : O_PWKV) + ((size_t)(b * 8 + h) * 64 + row) * 64 + 4 * cgi;
    *(float4*)So = make_float4(st[0], st[1], st[2], st[3]);
}

__device__ __forceinline__ void phase_wkvfin(const Params& p, int tid, int G, int bid) {
    const bf16_t* PR = (const bf16_t*)(p.ws + WS_PROJRW); const bf16_t* DAG = (const bf16_t*)((const unsigned char*)p.out + SC_B);
    const float* YG = (const float*)(p.ws + WS_Y); bf16_t* MIX = (bf16_t*)((unsigned char*)p.out + SC_C);
    const int gt = bid * NTHREADS + tid, NT = G * NTHREADS;
    for (int i = gt; i < MB * 128; i += NT) {
        const int jq = i & 15, h = (i >> 4) & 7, rowB = i >> 7, pc = h * 64 + jq * 4, rowA = rowA_of(rowB);
        const size_t ra = (size_t)rowA * RCOLS + pc;
        const uint2 cr = *(const uint2*)(PR + ra), ck = *(const uint2*)(PR + ra + 512), cv = *(const uint2*)(PR + ra + 1024);
        uint2 pr = make_uint2(0u, 0u), pk = pr, pv = pr;
        if (!(rowB < MP && (rowB & (TP - 1)) == 0)) { pr = *(const uint2*)(PR + ra - RCOLS); pk = *(const uint2*)(PR + ra - RCOLS + 512); pv = *(const uint2*)(PR + ra - RCOLS + 1024); }
        const uint2 da = *(const uint2*)(DAG + (size_t)rowB * NLORA + 512 + pc), dg = *(const uint2*)(DAG + (size_t)rowB * NLORA + 1024 + pc);
        const float4 y4 = *(const float4*)(YG + (size_t)rowB * 512 + pc);
        const float4 mur = *(const float4*)(p.in[I_MU] + pc), muk = *(const float4*)(p.in[I_MU] + 512 + pc), muv = *(const float4*)(p.in[I_MU] + 1024 + pc);
        const float4 ka4 = *(const float4*)(p.in[I_KA] + pc), rk4 = *(const float4*)(p.in[I_RK] + pc), lw4 = *(const float4*)(p.in[I_LNW] + pc), lb4 = *(const float4*)(p.in[I_LNB] + pc);
        const float mr[4] = {mur.x, mur.y, mur.z, mur.w}, mk[4] = {muk.x, muk.y, muk.z, muk.w}, mv[4] = {muv.x, muv.y, muv.z, muv.w};
        const float kac[4] = {ka4.x, ka4.y, ka4.z, ka4.w}, rkc[4] = {rk4.x, rk4.y, rk4.z, rk4.w}, lw[4] = {lw4.x, lw4.y, lw4.z, lw4.w}, lb[4] = {lb4.x, lb4.y, lb4.z, lb4.w};
        const float crr[4] = {bflo(cr.x), bfhi(cr.x), bflo(cr.y), bfhi(cr.y)}, ckk[4] = {bflo(ck.x), bfhi(ck.x), bflo(ck.y), bfhi(ck.y)}, cvv[4] = {bflo(cv.x), bfhi(cv.x), bflo(cv.y), bfhi(cv.y)};
        const float prr[4] = {bflo(pr.x), bfhi(pr.x), bflo(pr.y), bfhi(pr.y)}, pkk[4] = {bflo(pk.x), bfhi(pk.x), bflo(pk.y), bfhi(pk.y)}, pvv[4] = {bflo(pv.x), bfhi(pv.x), bflo(pv.y), bfhi(pv.y)};
        const float aa[4] = {bflo(da.x), bfhi(da.x), bflo(da.y), bfhi(da.y)}, gg[4] = {bflo(dg.x), bfhi(dg.x), bflo(dg.y), bfhi(dg.y)};
        const float yy[4] = {y4.x, y4.y, y4.z, y4.w};
        float v_[4]; float rk = 0.f;
#pragma unroll
        for (int j = 0; j < 4; ++j) { const float r_ = crr[j] + (prr[j] - crr[j]) * mr[j], k_ = ckk[j] + (pkk[j] - ckk[j]) * mk[j]; v_[j] = cvv[j] + (pvv[j] - cvv[j]) * mv[j];
            const float k2 = k_ * (1.f + (aa[j] - 1.f) * kac[j]); rk += r_ * k2 * rkc[j]; }
        rk = row16_sum(rk);
        const float mean = row16_sum((yy[0] + yy[1]) + (yy[2] + yy[3])) * (1.f / 64.f);
        float d[4]; float vs = 0.f;
#pragma unroll
        for (int j = 0; j < 4; ++j) { d[j] = yy[j] - mean; vs += d[j] * d[j]; }
        const float rs = rsqrtf(row16_sum(vs) * (1.f / 64.f) + 64e-5f);
        float o[4];
#pragma unroll
        for (int j = 0; j < 4; ++j) o[j] = (d[j] * rs * lw[j] + lb[j] + rk * v_[j]) * gg[j];
        uint2 w; w.x = pk2(o[0], o[1]); w.y = pk2(o[2], o[3]);
        *(uint2*)(MIX + (size_t)rowB * D + pc) = w;
    }
}

__device__ __forceinline__ void attn_task(const Params& p, int task, int lane) {
    const bf16_t* Q = (const bf16_t*)(p.ws + WS_Q); const bf16_t* K = (const bf16_t*)(p.ws + WS_K);
    bf16_t* MIX = (bf16_t*)((unsigned char*)p.out + SC_C);
    const int b = task >> 11, h = (task >> 8) & 7, r16 = (task >> 4) & 15, ig = task & 15;
    const int li = lane & 15, g = lane >> 4;
    const int tq = r16 + 16 * (16 * ig + li);
    const bf16_t* qp = Q + (size_t)(b * TP + tq) * 512 + h * 64 + 8 * g;
    const bf16x8 qf0 = *(const bf16x8*)qp, qf1 = *(const bf16x8*)(qp + 32);
    float m_run = -1e30f, l_run = 0.f;
    f32x4 o[4];
#pragma unroll
    for (int i = 0; i < 4; ++i) o[i] = (f32x4){0.f, 0.f, 0.f, 0.f};
#pragma unroll 1
    for (int br = 0; br < 3; ++br) {
        int dd, r, uq0, Tdd; const bf16_t* VT;
        if (br == 0) { dd = 16; r = r16; uq0 = 16 * ig; Tdd = TP / 16; VT = (const bf16_t*)(p.ws + WS_VT16); }
        else if (br == 1) { dd = 4; r = r16 & 3; uq0 = (r16 >> 2) + 64 * ig; Tdd = TP / 4; VT = (const bf16_t*)(p.ws + WS_VT4); }
        else { dd = 1; r = 0; uq0 = r16 + 256 * ig; Tdd = TP; VT = (const bf16_t*)(p.ws + WS_VT1); }
        const int s = 16 / dd, uq = uq0 + s * li;
        int ulo = uq0 - 128; if (ulo < 0) ulo = 0; ulo &= ~31;
        const int uhi = uq0 + 15 * s;
        const bf16_t* Kb = K + ((size_t)b * TP + r) * 512 + h * 64 + 8 * g;
        const bf16_t* Vb = VT + (size_t)(b * 8 + h) * 64 * TP + (size_t)r * Tdd * 64 + li * 32 + 8 * g;
        bf16x8 kx0, kx1, ky0, ky1, vf[4];
        { const bf16_t* kx = Kb + (size_t)(ulo + li) * dd * 512; const bf16_t* ky = kx + (size_t)16 * dd * 512;
          kx0 = *(const bf16x8*)kx; kx1 = *(const bf16x8*)(kx + 32); ky0 = *(const bf16x8*)ky; ky1 = *(const bf16x8*)(ky + 32);
#pragma unroll
          for (int dt = 0; dt < 4; ++dt) vf[dt] = *(const bf16x8*)(Vb + (size_t)(ulo >> 5) * 2048 + dt * 512); }
#pragma unroll 1
        for (int kt = ulo; kt <= uhi; kt += 32) {
            const int ktn = (kt + 32 <= uhi) ? kt + 32 : kt;
            const bf16_t* nkx = Kb + (size_t)(ktn + li) * dd * 512; const bf16_t* nky = nkx + (size_t)16 * dd * 512;
            const bf16x8 nkx0 = *(const bf16x8*)nkx, nkx1 = *(const bf16x8*)(nkx + 32), nky0 = *(const bf16x8*)nky, nky1 = *(const bf16x8*)(nky + 32);
            bf16x8 nvf[4];
#pragma unroll
            for (int dt = 0; dt < 4; ++dt) nvf[dt] = *(const bf16x8*)(Vb + (size_t)(ktn >> 5) * 2048 + dt * 512);
            f32x4 sx = (f32x4){0.f, 0.f, 0.f, 0.f}, sy = (f32x4){0.f, 0.f, 0.f, 0.f};
            sx = __builtin_amdgcn_mfma_f32_16x16x32_bf16(kx0, qf0, sx, 0, 0, 0); sx = __builtin_amdgcn_mfma_f32_16x16x32_bf16(kx1, qf1, sx, 0, 0, 0);
            sy = __builtin_amdgcn_mfma_f32_16x16x32_bf16(ky0, qf0, sy, 0, 0, 0); sy = __builtin_amdgcn_mfma_f32_16x16x32_bf16(ky1, qf1, sy, 0, 0, 0);
            float sv[8]; bool ok[8]; float tmax = -1e30f;
#pragma unroll
            for (int j = 0; j < 4; ++j) { const int dx = uq - (kt + 4 * g + j), dy = dx - 16;
                ok[j] = (unsigned)dx <= 128u; ok[4 + j] = (unsigned)dy <= 128u; sv[j] = ok[j] ? sx[j] : -1e30f; sv[4 + j] = ok[4 + j] ? sy[j] : -1e30f;
                tmax = fmaxf(tmax, fmaxf(sv[j], sv[4 + j])); }
            tmax = fmaxf(tmax, __shfl_xor(tmax, 16)); tmax = fmaxf(tmax, __shfl_xor(tmax, 32));
            const float m_new = fmaxf(m_run, tmax), alpha = __expf(m_run - m_new);
            float pe[8]; float ps = 0.f;
#pragma unroll
            for (int j = 0; j < 8; ++j) { pe[j] = ok[j] ? __expf(sv[j] - m_new) : 0.f; ps += pe[j]; }
            l_run = l_run * alpha + ps; m_run = m_new;
            u32x4 pw; pw[0] = pk2(pe[0], pe[1]); pw[1] = pk2(pe[2], pe[3]); pw[2] = pk2(pe[4], pe[5]); pw[3] = pk2(pe[6], pe[7]);
            const bf16x8 pf = __builtin_bit_cast(bf16x8, pw);
#pragma unroll
            for (int dt = 0; dt < 4; ++dt) { o[dt] *= alpha; o[dt] = __builtin_amdgcn_mfma_f32_16x16x32_bf16(vf[dt], pf, o[dt], 0, 0, 0); }
            kx0 = nkx0; kx1 = nkx1; ky0 = nky0; ky1 = nky1;
#pragma unroll
            for (int dt = 0; dt < 4; ++dt) vf[dt] = nvf[dt];
        }
    }
    float lt = l_run; lt += __shfl_xor(lt, 16); lt += __shfl_xor(lt, 32);
    const float il = 1.f / lt;
    bf16_t* op = MIX + (size_t)(b * TP + tq) * D + 512 + h * 64 + 4 * g;
#pragma unroll
    for (int dt = 0; dt < 4; ++dt) { uint2 w; w.x = pk2(o[dt][0] * il, o[dt][1] * il); w.y = pk2(o[dt][2] * il, o[dt][3] * il); *(uint2*)(op + 16 * dt) = w; }
}
__device__ __forceinline__ void attn_sample_task(const Params& p, int task, int lane, LAS float* wl) {
    const bf16_t* Q = (const bf16_t*)(p.ws + WS_Q); const float* snewk = (const float*)(p.ws + WS_SNEWK); const float* snewv = (const float*)(p.ws + WS_SNEWV);
    const float* CK = p.in[I_CK]; const float* CV = p.in[I_CV];
    bf16_t* MIX = (bf16_t*)((unsigned char*)p.out + SC_C);
    const int b = task >> 6, h = (task >> 3) & 7, tt = task & 7;
    const int rowB = MP + b * TS + tt;
    asm volatile("s_waitcnt lgkmcnt(0)" ::: "memory");
    wl[lane] = bflo((u32)Q[(size_t)rowB * 512 + h * 64 + lane]);
    asm volatile("s_waitcnt lgkmcnt(0)" ::: "memory");
    float mx = -1e30f;
#pragma unroll 1
    for (int c = 0; c < 9; ++c) {
        const int br = c / 3, it = c - br * 3; const int dd = br == 0 ? 1 : (br == 1 ? 4 : 16); const int j = lane + 64 * it;
        const int jc = j <= 128 ? j : 128;
        const int idx = 2048 + tt - jc * dd;
        const float* kr = idx < 2048 ? CK + ((size_t)(b * 2048 + idx) * 8 + h) * 64 : snewk + (size_t)(b * TS + idx - 2048) * 512 + h * 64;
        float s = 0.f;
#pragma unroll
        for (int d4 = 0; d4 < 16; ++d4) { const float4 kv = *(const float4*)(kr + 4 * d4); const f32x4 qv = *(const LAS f32x4*)(wl + 4 * d4);
            s += kv.x * qv[0] + kv.y * qv[1] + kv.z * qv[2] + kv.w * qv[3]; }
        if (j > 128) s = -1e30f;
        wl[64 + c * 64 + lane] = s; mx = fmaxf(mx, s);
    }
#pragma unroll
    for (int o = 1; o < 64; o <<= 1) mx = fmaxf(mx, __shfl_xor(mx, o));
    asm volatile("s_waitcnt lgkmcnt(0)" ::: "memory");
    float ls = 0.f;
#pragma unroll 1
    for (int c = 0; c < 9; ++c) { const float s = wl[64 + c * 64 + lane]; const float e = s > -1e29f ? __expf(s - mx) : 0.f; wl[64 + c * 64 + lane] = e; ls += e; }
    ls = wave_sum(ls);
    asm volatile("s_waitcnt lgkmcnt(0)" ::: "memory");
    float acc = 0.f;
#pragma unroll 1
    for (int c = 0; c < 9; ++c) {
        const int br = c / 3, it = c - br * 3; const int dd = br == 0 ? 1 : (br == 1 ? 4 : 16); const int nj = it < 2 ? 64 : 1;
#pragma unroll 8
        for (int l2 = 0; l2 < nj; ++l2) {
            const int j = l2 + 64 * it; const int idx = 2048 + tt - j * dd;
            const float* vr = idx < 2048 ? CV + ((size_t)(b * 2048 + idx) * 8 + h) * 64 : snewv + (size_t)(b * TS + idx - 2048) * 512 + h * 64;
            acc += wl[64 + c * 64 + l2] * vr[lane];
        }
    }
    const float res = acc / ls;
    const float other = __shfl_xor(res, 1);
    if ((lane & 1) == 0) *(u32*)(MIX + (size_t)rowB * D + 512 + h * 64 + lane) = pk2(res, other);
}

__device__ __forceinline__ void phase_norm1(const Params& p, int tid, int G, int bid) {
    const int wave = tid >> 6, lane = tid & 63, gw = bid * 8 + wave, NGW = G * 8;
    const float* mix = (const float*)((const unsigned char*)p.out + SC_B); bf16_t* H2 = (bf16_t*)((unsigned char*)p.out + SC_C);
    for (int row = gw; row < MB; row += NGW) {
        const float* xrow = row < MP ? p.in[I_XP] + (size_t)row * D : p.in[I_XS] + (size_t)(row - MP) * D;
        const float4* mr = (const float4*)(mix + (size_t)row * D) + lane; const float4* xr = (const float4*)xrow + lane;
        float4 v[4], x[4]; float s = 0.f;
#pragma unroll
        for (int j = 0; j < 4; ++j) { v[j] = mr[64 * j]; x[j] = xr[64 * j]; s += (v[j].x * v[j].x + v[j].y * v[j].y) + (v[j].z * v[j].z + v[j].w * v[j].w); }
        const float rs = rsqrtf(wave_sum(s) * (1.f / D) + 1e-6f);
        float s2 = 0.f;
#pragma unroll
        for (int j = 0; j < 4; ++j) { const float4 gg = *((const float4*)p.in[I_NMPOST] + lane + 64 * j);
            x[j].x += v[j].x * rs * gg.x; x[j].y += v[j].y * rs * gg.y; x[j].z += v[j].z * rs * gg.z; x[j].w += v[j].w * rs * gg.w;
            s2 += (x[j].x * x[j].x + x[j].y * x[j].y) + (x[j].z * x[j].z + x[j].w * x[j].w);
            *((float4*)(p.out + (size_t)row * D) + lane + 64 * j) = x[j]; }
        const float rs2 = rsqrtf(wave_sum(s2) * (1.f / D) + 1e-6f);
#pragma unroll
        for (int j = 0; j < 4; ++j) { const float4 gg = *((const float4*)p.in[I_NFPRE] + lane + 64 * j);
            uint2 o; o.x = pk2(x[j].x * rs2 * gg.x, x[j].y * rs2 * gg.y); o.y = pk2(x[j].z * rs2 * gg.z, x[j].w * rs2 * gg.w);
            *((uint2*)(H2 + (size_t)row * D) + lane + 64 * j) = o; }
    }
}
__device__ __forceinline__ void phase_act(const Params& p, int tid, int G, int bid) {
    const int wave = tid >> 6, lane = tid & 63, gw = bid * 8 + wave, NGW = G * 8;
    bf16_t* U = (bf16_t*)(p.ws + WS_U); const bf16_t* halo = (const bf16_t*)(p.ws + WS_HALO);
    const float* cw = p.in[I_CONVW]; const float* cb = p.in[I_CONVB];
    constexpr int NPI = (MP / 32) * 11, NSI = BS * 11;
    for (int it = gw; it < NPI + NSI; it += NGW) {
        const bool sample = it >= NPI; const int q = sample ? it - NPI : it; const int chunk = q / 11, cgp = q - chunk * 11;
        const int col = cgp * 256 + 4 * lane;
        const float4 wg0 = *(const float4*)(cw + col), wg1 = *(const float4*)(cw + FF2 + col), wg2 = *(const float4*)(cw + 2 * FF2 + col), bg = *(const float4*)(cb + col);
        const float4 wu0 = *(const float4*)(cw + FF + col), wu1 = *(const float4*)(cw + FF2 + FF + col), wu2 = *(const float4*)(cw + 2 * FF2 + FF + col), bu = *(const float4*)(cb + FF + col);
        float g2[4], g1[4], u2[4], u1[4];
        int row0, nrows;
        if (!sample) {
            row0 = chunk * 32; nrows = 32;
            if ((row0 & (TP - 1)) == 0) {
#pragma unroll
                for (int j = 0; j < 4; ++j) { g2[j] = 0.f; g1[j] = 0.f; u2[j] = 0.f; u1[j] = 0.f; }
            } else {
                const bf16_t* hp = halo + (size_t)chunk * 2 * FF2;
                const uint2 a = *(const uint2*)(hp + col), c2 = *(const uint2*)(hp + FF2 + col), e = *(const uint2*)(hp + FF + col), f = *(const uint2*)(hp + FF2 + FF + col);
                g2[0] = bflo(a.x); g2[1] = bfhi(a.x); g2[2] = bflo(a.y); g2[3] = bfhi(a.y); g1[0] = bflo(c2.x); g1[1] = bfhi(c2.x); g1[2] = bflo(c2.y); g1[3] = bfhi(c2.y);
                u2[0] = bflo(e.x); u2[1] = bfhi(e.x); u2[2] = bflo(e.y); u2[3] = bfhi(e.y); u1[0] = bflo(f.x); u1[1] = bfhi(f.x); u1[2] = bflo(f.y); u1[3] = bfhi(f.y);
            }
        } else {
            row0 = MP + chunk * TS; nrows = TS;
            const float* sp = p.in[I_SCONV] + (size_t)chunk * 2 * FF2;
            const float4 a = *(const float4*)(sp + col), c2 = *(const float4*)(sp + FF2 + col), e = *(const float4*)(sp + FF + col), f = *(const float4*)(sp + FF2 + FF + col);
            g2[0] = a.x; g2[1] = a.y; g2[2] = a.z; g2[3] = a.w; g1[0] = c2.x; g1[1] = c2.y; g1[2] = c2.z; g1[3] = c2.w;
            u2[0] = e.x; u2[1] = e.y; u2[2] = e.z; u2[3] = e.w; u1[0] = f.x; u1[1] = f.y; u1[2] = f.z; u1[3] = f.w;
        }
        const float w0g[4] = {wg0.x, wg0.y, wg0.z, wg0.w}, w1g[4] = {wg1.x, wg1.y, wg1.z, wg1.w}, w2g[4] = {wg2.x, wg2.y, wg2.z, wg2.w}, bgg[4] = {bg.x, bg.y, bg.z, bg.w};
        const float w0u[4] = {wu0.x, wu0.y, wu0.z, wu0.w}, w1u[4] = {wu1.x, wu1.y, wu1.z, wu1.w}, w2u[4] = {wu2.x, wu2.y, wu2.z, wu2.w}, buu[4] = {bu.x, bu.y, bu.z, bu.w};
        for (int r0 = 0; r0 < nrows; r0 += 8) {
            uint2 gv[8], uv[8];
#pragma unroll
            for (int i = 0; i < 8; ++i) { const bf16_t* rp = U + (size_t)(row0 + r0 + i) * FF2 + col; gv[i] = *(const uint2*)rp; uv[i] = *(const uint2*)(rp + FF); }
#pragma unroll
            for (int i = 0; i < 8; ++i) {
                const float gc[4] = {bflo(gv[i].x), bfhi(gv[i].x), bflo(gv[i].y), bfhi(gv[i].y)}, uc[4] = {bflo(uv[i].x), bfhi(uv[i].x), bflo(uv[i].y), bfhi(uv[i].y)};
                float o[4];
#pragma unroll
                for (int j = 0; j < 4; ++j) {
                    const float cgv = w0g[j] * g2[j] + w1g[j] * g1[j] + w2g[j] * gc[j] + bgg[j];
                    const float cuv = w0u[j] * u2[j] + w1u[j] * u1[j] + w2u[j] * uc[j] + buu[j];
                    o[j] = cgv * sigmoidf_(cgv) * cuv;
                    g2[j] = g1[j]; g1[j] = gc[j]; u2[j] = u1[j]; u1[j] = uc[j];
                }
                uint2 w; w.x = pk2(o[0], o[1]); w.y = pk2(o[2], o[3]);
                *(uint2*)(U + (size_t)(row0 + r0 + i) * FF2 + col) = w;
            }
        }
    }
}
__device__ __forceinline__ void phase_final(const Params& p, int tid, int G, int bid) {
    const int wave = tid >> 6, lane = tid & 63, gw = bid * 8 + wave, NGW = G * 8;
    const float* F = (const float*)(p.ws + WS_U) + FF / 2;
    for (int row = gw; row < MB; row += NGW) {
        const float4* fr = (const float4*)(F + (size_t)row * (FF2 / 2)) + lane; float4* yr = (float4*)(p.out + (size_t)row * D) + lane;
        float4 v[4]; float s = 0.f;
#pragma unroll
        for (int j = 0; j < 4; ++j) { v[j] = fr[64 * j]; s += (v[j].x * v[j].x + v[j].y * v[j].y) + (v[j].z * v[j].z + v[j].w * v[j].w); }
        const float rs = rsqrtf(wave_sum(s) * (1.f / D) + 1e-6f);
#pragma unroll
        for (int j = 0; j < 4; ++j) { const float4 gg = *((const float4*)p.in[I_NFPOST] + lane + 64 * j); float4 x = yr[64 * j];
            x.x += v[j].x * rs * gg.x; x.y += v[j].y * rs * gg.y; x.z += v[j].z * rs * gg.z; x.w += v[j].w * rs * gg.w; yr[64 * j] = x; }
    }
}
__device__ __forceinline__ void phase_cachecopy(const Params& p, int tid, int G, int bid) {
    const int gt = bid * NTHREADS + tid, NT = G * NTHREADS;
    constexpr int PER_B = 2048 * 512 / 4;
    const float4* snk = (const float4*)(p.ws + WS_SNEWK); const float4* snv = (const float4*)(p.ws + WS_SNEWV);
    for (int i = gt; i < 2 * BS * PER_B; i += NT) {
        const int which = i >= BS * PER_B; const int q = which ? i - BS * PER_B : i; const int b = q / PER_B, r = q - b * PER_B;
        const float4* src = (const float4*)p.in[which ? I_CV : I_CK] + (size_t)b * PER_B;
        float4 v;
        if (r < 2040 * 128) v = src[r + 8 * 128]; else v = (which ? snv : snk)[(size_t)b * TS * 128 + (r - 2040 * 128)];
        ((float4*)(p.out + (which ? O_SV : O_SK)))[(size_t)b * PER_B + r] = v;
    }
}

template <int PH>
__device__ __forceinline__ void run_phase(const Params& p, LAS unsigned char* lds, int tid, int G, int bid) {
    if constexpr (PH == 0) { phase0(p, lds, tid, G, bid); __syncthreads(); }
    else if constexpr (PH == 1) {
        pg8::Gemm g{(const bf16_t*)((const unsigned char*)p.out + SC_B), (const bf16_t*)(p.ws + WS_WIN), MA, DIN, D, D}; pg8::StaticOrder S; S.init(MA, DIN, G, bid);
        EpiProj E{(bf16_t*)(p.ws + WS_PROJRW), (bf16_t*)(p.ws + WS_Q), (bf16_t*)(p.ws + WS_K), (bf16_t*)(p.ws + WS_VROW), (bf16_t*)(p.ws + WS_VT4), (bf16_t*)(p.ws + WS_VT16),
                  (const float*)(p.ws + WS_ROPE), p.out, (float*)(p.ws + WS_SNEWK), (float*)(p.ws + WS_SNEWV)};
        pg8::gemm_phase<EpiProj, pg8::StaticOrder, false>(lds, g, S, E, nullptr);
    } else if constexpr (PH == 2) { phase_alora(p, tid, G, bid); phase_vtrans(p, lds, tid, G, bid); }
    else if constexpr (PH == 3) {
        pg8::Gemm g{(const bf16_t*)(p.ws + WS_ALORA), (const bf16_t*)(p.ws + WS_WLORA), MB, NLORA, KLORA, KLORA}; pg8::StaticOrder S; S.init(MB, NLORA, G, bid);
        EpiDag E{(bf16_t*)((unsigned char*)p.out + SC_B), p.in[I_W0], p.in[I_A0]};
        pg8::gemm_phase<EpiDag, pg8::StaticOrder, false>(lds, g, S, E, nullptr);
    } else if constexpr (PH == 4 || PH == 11 || PH == 12) {
        const int NSCAN = 128;
        if (bid < NSCAN) {
            if constexpr (PH != 12) {
                scan_item(p, lds, tid, false, bid >> 4, (bid >> 1) & 7, bid & 1);
                for (int it = bid; it < 512; it += NSCAN) scan_item(p, lds, tid, true, it >> 4, (it >> 1) & 7, it & 1);
            }
        } else {
            if constexpr (PH != 11) { const int wave = tid >> 6, lane = tid & 63, ab = bid - NSCAN, NAB = G - NSCAN;
                for (int t = ab * 8 + wave; t < 16384; t += NAB * 8) attn_task(p, t, lane);
                for (int t = ab * 8 + wave; t < 2048; t += NAB * 8) attn_sample_task(p, t, lane, (LAS float*)(lds + wave * 4096)); }
        }
    } else if constexpr (PH == 5) {
        pg8::Gemm g{(const bf16_t*)((const unsigned char*)p.out + SC_C), (const bf16_t*)(p.ws + WS_WOUT), MB, D, D, D}; pg8::StaticOrder S; S.init(MB, D, G, bid);
        pg8::EpiF32 E{(float*)((unsigned char*)p.out + SC_B), D, nullptr};
        pg8::gemm_phase<pg8::EpiF32, pg8::StaticOrder, false>(lds, g, S, E, nullptr);
    } else if constexpr (PH == 6) phase_norm1(p, tid, G, bid);
    else if constexpr (PH == 7) {
        pg8::Gemm g{(const bf16_t*)((const unsigned char*)p.out + SC_C), (const bf16_t*)(p.ws + WS_WUP), MB, FF2, D, D}; pg8::StaticOrder S; S.init(MB, FF2, G, bid);
        EpiUp E{(bf16_t*)(p.ws + WS_U), (bf16_t*)(p.ws + WS_HALO), p.out};
        pg8::gemm_phase<EpiUp, pg8::StaticOrder, false>(lds, g, S, E, nullptr);
    } else if constexpr (PH == 8) phase_act(p, tid, G, bid);
    else if constexpr (PH == 9) {
        pg8::Gemm g{(const bf16_t*)(p.ws + WS_U), (const bf16_t*)(p.ws + WS_WDN), MB, D, FF, FF2}; pg8::StaticOrder S; S.init(MB, D, G, bid);
        pg8::EpiF32 E{(float*)(p.ws + WS_U) + FF / 2, FF2 / 2, nullptr};
        pg8::gemm_phase<pg8::EpiF32, pg8::StaticOrder, false>(lds, g, S, E, nullptr);
    } else if constexpr (PH == 10) { phase_final(p, tid, G, bid); phase_cachecopy(p, tid, G, bid); }
    else if constexpr (PH == 13) phase_wkvfin(p, tid, G, bid);
}
__device__ __forceinline__ void grid_bar(unsigned* ctr, unsigned target) {
    asm volatile("s_waitcnt vmcnt(0)" ::: "memory");
    __syncthreads();
    if (threadIdx.x == 0) {
        __builtin_amdgcn_fence(__ATOMIC_RELEASE, "agent");
        asm volatile("s_waitcnt vmcnt(0)" ::: "memory");
        __hip_atomic_fetch_add(ctr, 1u, __ATOMIC_RELAXED, __HIP_MEMORY_SCOPE_AGENT);
        while (__hip_atomic_load(ctr, __ATOMIC_RELAXED, __HIP_MEMORY_SCOPE_AGENT) < target) __builtin_amdgcn_s_sleep(2);
        __builtin_amdgcn_fence(__ATOMIC_ACQUIRE, "agent");
        asm volatile("s_waitcnt vmcnt(0)" ::: "memory");
    }
    __syncthreads();
}
template <int SEAM, int FIRST, int... REST>
__device__ __forceinline__ void run_program(const Params& p, LAS unsigned char* lds, cg::grid_group& grid, int tid, int G, int bid) {
    if (p.en > (int)sizeof...(REST) - 1000) run_phase<FIRST>(p, lds, tid, G, bid);
    if constexpr (sizeof...(REST) > 0) {
        if constexpr (SEAM == 0) grid.sync(); else grid_bar((unsigned*)(p.ws + WS_BAR), (unsigned)(SEAM * G));
        run_program<SEAM + 1, REST...>(p, lds, grid, tid, G, bid);
    }
}
#define PROGRAM 0, 1, 2, 3, 4, 13, 5, 6, 7, 8, 9, 10
__global__ void __launch_bounds__(NTHREADS, 2) hymba_fwd(Params p) {
    extern __shared__ __attribute__((aligned(16))) unsigned char lds_raw[];
    LAS unsigned char* lds = (LAS unsigned char*)lds_raw;
    cg::grid_group grid = cg::this_grid();
    run_program<0, PROGRAM>(p, lds, grid, threadIdx.x, gridDim.x, blockIdx.x);
}

extern "C" void kernel_launch(void* const* d_in, const int* in_sizes, int n_in, void* d_out, int out_size, void* d_ws, size_t ws_size, hipStream_t stream) {
    static int grid = 0;
    if (grid == 0) {
        if (n_in != 28 || (size_t)out_size != O_END || ws_size < WS_TOTAL) { fprintf(stderr, "kernel_launch: unexpected sizes n_in %d out %d ws %zu (need %zu)\n", n_in, out_size, ws_size, (size_t)WS_TOTAL); grid = -1; return; }
        int dev = 0, cus = 0, per_cu = 0;
        hipGetDevice(&dev); hipDeviceGetAttribute(&cus, hipDeviceAttributeMultiprocessorCount, dev);
        if (hipFuncSetAttribute((const void*)hymba_fwd, hipFuncAttributeMaxDynamicSharedMemorySize, LDS_BYTES) != hipSuccess) { fprintf(stderr, "kernel_launch: hipFuncSetAttribute failed\n"); grid = -1; return; }
        hipOccupancyMaxActiveBlocksPerMultiprocessor(&per_cu, (const void*)hymba_fwd, NTHREADS, LDS_BYTES);
        (void)hipGetLastError();
        if (per_cu < 1) per_cu = 1;
        grid = cus;
    }
    if (grid < 0) return;
    Params p{};
    for (int i = 0; i < 28; ++i) p.in[i] = (const float*)d_in[i];
    p.out = (float*)d_out; p.ws = (unsigned char*)d_ws; p.en = 1;
    if (hipMemsetAsync((unsigned char*)d_ws + WS_BAR, 0, 256, stream) != hipSuccess) { fprintf(stderr, "kernel_launch: memset of the barrier word failed\n"); return; }
    void* args[] = {&p};
    hipError_t e = hipLaunchCooperativeKernel((const void*)hymba_fwd, dim3(grid), dim3(NTHREADS), args, LDS_BYTES, stream);
    if (e != hipSuccess) fprintf(stderr, "cooperative launch failed: %s (grid %d)\n", hipGetErrorString(e), grid);
}
```

```cpp
#include <hip/hip_runtime.h>
#include <hip/hip_cooperative_groups.h>
#include <cstdio>
#include <cstdint>
namespace pg8 {
#define PG8_LAS __attribute__((address_space(3)))
typedef unsigned short bf16_t;
typedef short bf16x8 __attribute__((ext_vector_type(8)));
typedef float f32x4 __attribute__((ext_vector_type(4)));
typedef unsigned u32x4 __attribute__((ext_vector_type(4)));
constexpr int BM = 256, BK = 64, HALF = 128, HTB = HALF * BK * 2  , STAGE_BYTES = 8 * HTB, NXCD = 8, WGM = 8;

__host__ __device__ __forceinline__ int lds_byte(int r, int c) { const int st = (r >> 4) * 2 + (c >> 5), rr = r & 15, cc = c & 31, ob = rr * 64 + cc * 2; return st * 1024 + (ob ^ (((ob >> 9) & 1) << 5)); }
__host__ __device__ __forceinline__ void stage_rc(int b, int& R, int& C) { const int st = b / 1024, sb = b % 1024, swz = sb ^ (((sb >> 9) & 1) << 5); R = (st >> 1) * 16 + swz / 64; C = (st & 1) * 32 + (swz % 64) / 2; }
__host__ __device__ __forceinline__ int perm32(int rho) { const int n = rho >> 4, i = rho & 15; return 8 * (i >> 2) + 4 * n + (i & 3); }

struct Unit { int pm, pn; };
struct Gemm { const bf16_t* A; const bf16_t* Bt; int M, N, K, lda; };

struct StaticOrder {
    int nM, nN, nwg, G, c;
    __host__ __device__ void init(int M, int N, int G_, int c_) { nM = M / BM; nN = N / BM; nwg = nM * nN; G = G_; c = c_; }
    __host__ __device__ bool next(int i, Unit& u) const {
        const long L = (long)i * G + c; if (L >= nwg) return false;
        int wgid = (int)L; { const int q = nwg / NXCD, r = nwg % NXCD, xcd = wgid % NXCD, off = wgid / NXCD; wgid = (xcd < r ? xcd * (q + 1) : r * (q + 1) + (xcd - r) * q) + off; }
        const int nig = WGM * nN, gid = wgid / nig, fm = gid * WGM, gsz = (nM - fm) < WGM ? (nM - fm) : WGM;
        u.pm = fm + ((wgid % nig) % gsz); u.pn = (wgid % nig) / gsz; return true;
    }
    __device__ __forceinline__ void a_ready(const Unit&) const {}
    __device__ __forceinline__ void done(const Unit&) const {}
};
__device__ __forceinline__ unsigned cvt_pk_bf16(float lo, float hi) { unsigned r; asm volatile("v_cvt_pk_bf16_f32 %0, %1, %2" : "=v"(r) : "v"(lo), "v"(hi)); return r; }
typedef float f32x2 __attribute__((ext_vector_type(2)));
struct EpiF32 {
    static constexpr bool PERM = false, AFTER_DRAIN = false;
    float* C; int ldc; const float* bias;
    __device__ __forceinline__ void operator()(const f32x4 (&acc)[2][2][4][2], const Unit& u, int wr, int wc, int fr, int fq) const {
        const int row0 = u.pm * BM + wr * 64 + fr, col0 = u.pn * BM + wc * 32 + 4 * fq;
        f32x4 bv[2][2];
#pragma unroll
        for (int bj = 0; bj < 2; ++bj)
#pragma unroll
            for (int n = 0; n < 2; ++n) bv[bj][n] = bias ? *(const f32x4*)(bias + col0 + bj * HALF + n * 16) : (f32x4){0.f, 0.f, 0.f, 0.f};
#pragma unroll
        for (int ai = 0; ai < 2; ++ai)
#pragma unroll
            for (int m = 0; m < 4; ++m) { float* rowp = C + (size_t)(row0 + ai * HALF + m * 16) * ldc + col0;
#pragma unroll
                for (int bj = 0; bj < 2; ++bj)
#pragma unroll
                    for (int n = 0; n < 2; ++n) *(f32x4*)(rowp + bj * HALF + n * 16) = acc[ai][bj][m][n] + bv[bj][n]; }
    }
};
template <class Epi, class Sched, bool STAMP = false>
__device__ __forceinline__ void gemm_phase(PG8_LAS unsigned char* lds, const Gemm g, const Sched& S, const Epi& E, unsigned long long* stamps) {
    const int tid = threadIdx.x, wid = __builtin_amdgcn_readfirstlane(tid >> 6), lane = tid & 63, wr = wid >> 2, wc = wid & 3, fr = lane & 15, fq = lane >> 4;
    const int K = g.K, nt = K / BK;
    int ts_lo = 0, ts_hi = 0, nts = 0; const unsigned long long rt_entry = STAMP ? (unsigned long long)wall_clock64() : 0ull;
#define PG8_STAMP() do { if (STAMP && wid == 0 && nts < 64) { const unsigned long long _c = (unsigned long long)clock64(); \
        ts_lo = (lane == nts) ? (int)(unsigned)_c : ts_lo; ts_hi = (lane == nts) ? (int)(unsigned)(_c >> 32) : ts_hi; ++nts; } } while (0)
    PG8_STAMP();
    unsigned voffA[2], voffB[2];
#pragma unroll
    for (int i = 0; i < 2; ++i) { int R, C; stage_rc(tid * 16 + i * 8192, R, C); const int Rb = Epi::PERM ? ((R & ~31) + perm32(R & 31)) : R;
        voffA[i] = (unsigned)(R * g.lda + C) * 2u; voffB[i] = (unsigned)(Rb * K + C) * 2u; }
    const size_t kstep = (size_t)(BK * 2);
    const size_t hstep = (size_t)HALF * K * 2, hstepA = (size_t)HALF * g.lda * 2;
    const size_t tstep = 2 * hstep, tstepA = 2 * hstepA;
    const unsigned ldsw = (unsigned)wid * 1024u;
    const int aoff = lds_byte(wr * 64 + fr, fq * 8), boff = lds_byte(wc * 32 + fr, fq * 8);
#define PG8_SA(b, h) (((b) * 2 + (h)) * HTB)
#define PG8_SB(b, h) ((4 + (b) * 2 + (h)) * HTB)
#define PG8_STAGE(bufoff, gbase, voff) do { _Pragma("unroll") for (int _i = 0; _i < 2; ++_i) \
        __builtin_amdgcn_global_load_lds((const unsigned*)((const char*)(gbase) + (voff)[_i]), (PG8_LAS unsigned*)(lds + (bufoff) + ldsw + _i * 8192), 16, 0, 0); } while (0)
#define PG8_LDA(dst, b, h) do { _Pragma("unroll") for (int m = 0; m < 4; ++m) _Pragma("unroll") for (int k = 0; k < 2; ++k) dst[m][k] = *(const PG8_LAS bf16x8*)(lds + PG8_SA(b, h) + aoff + m * 2048 + k * 1024); } while (0)
#define PG8_LDB(dst, b, h) do { _Pragma("unroll") for (int n = 0; n < 2; ++n) _Pragma("unroll") for (int k = 0; k < 2; ++k) dst[n][k] = *(const PG8_LAS bf16x8*)(lds + PG8_SB(b, h) + boff + n * 2048 + k * 1024); } while (0)
#define PG8_MMA(ai, bj, At, Bt) do { __builtin_amdgcn_s_setprio(1); _Pragma("unroll") for (int m = 0; m < 4; ++m) _Pragma("unroll") for (int n = 0; n < 2; ++n) _Pragma("unroll") for (int k = 0; k < 2; ++k) \
        acc[ai][bj][m][n] = __builtin_amdgcn_mfma_f32_16x16x32_bf16(Bt[n][k], At[m][k], acc[ai][bj][m][n], 0, 0, 0); __builtin_amdgcn_s_setprio(0); } while (0)
#define PG8_WAIT_V(n) asm volatile("s_waitcnt vmcnt(" #n ")" ::: "memory")
#define PG8_WAIT_L(n) asm volatile("s_waitcnt lgkmcnt(" #n ")" ::: "memory")
#define PG8_BAR __builtin_amdgcn_s_barrier()
#define PG8_SCHED __builtin_amdgcn_sched_barrier(0)
    Unit cur, nxt; int ui = 0;
    if (!S.next(0, cur)) return;
    f32x4 acc[2][2][4][2];
#pragma unroll
    for (int a = 0; a < 2; ++a)
#pragma unroll
        for (int b = 0; b < 2; ++b)
#pragma unroll
            for (int m = 0; m < 4; ++m)
#pragma unroll
                for (int n = 0; n < 2; ++n) acc[a][b][m][n] = (f32x4){0.f, 0.f, 0.f, 0.f};
    bf16x8 At[4][2], B0[2][2], B1[2][2];
    const char* cA = (const char*)g.A + (size_t)cur.pm * tstepA; const char* cB = (const char*)g.Bt + (size_t)cur.pn * tstep;
    S.a_ready(cur);
    PG8_STAGE(PG8_SB(0, 0), cB, voffB); PG8_STAGE(PG8_SA(0, 0), cA, voffA); PG8_STAGE(PG8_SB(0, 1), cB + hstep, voffB); PG8_STAGE(PG8_SA(0, 1), cA + hstepA, voffA);
    if (wr == 1) PG8_BAR;
    PG8_WAIT_V(4); PG8_BAR;
    PG8_STAGE(PG8_SB(1, 0), cB + kstep, voffB); PG8_STAGE(PG8_SA(1, 0), cA + kstep, voffA); PG8_STAGE(PG8_SB(1, 1), cB + hstep + kstep, voffB);
    PG8_WAIT_V(6); PG8_BAR;
    PG8_STAMP();
    for (;;) {
        const bool has_next = S.next(ui + 1, nxt);
        const char* nA = has_next ? (const char*)g.A + (size_t)nxt.pm * tstepA : cA; const char* nB = has_next ? (const char*)g.Bt + (size_t)nxt.pn * tstep : cB;
        for (int t = 0; t < nt; t += 2) {
            const bool last = (t == nt - 2);
            const char* a1 = cA + (size_t)(t + 1) * kstep;
            const char* a2 = last ? nA : cA + (size_t)(t + 2) * kstep; const char* b2 = last ? nB : cB + (size_t)(t + 2) * kstep;
            const char* a3 = a2 + kstep; const char* b3 = b2 + kstep;
            if (last && has_next) S.a_ready(nxt);
            PG8_LDB(B0, 0, 0); PG8_SCHED; PG8_LDA(At, 0, 0); PG8_STAGE(PG8_SA(1, 1), a1 + hstepA, voffA);
            PG8_WAIT_L(8); PG8_BAR; PG8_WAIT_L(0); PG8_MMA(0, 0, At, B0); PG8_BAR; PG8_SCHED;
            PG8_LDB(B1, 0, 1); PG8_STAGE(PG8_SB(0, 0), b2, voffB);
            PG8_BAR; PG8_WAIT_L(0); PG8_MMA(0, 1, At, B1); PG8_BAR;
            PG8_LDA(At, 0, 1); PG8_STAGE(PG8_SA(0, 0), a2, voffA);
            PG8_BAR; PG8_WAIT_L(0); PG8_MMA(1, 0, At, B0); PG8_BAR; PG8_SCHED;
            PG8_STAGE(PG8_SB(0, 1), b2 + hstep, voffB);
            PG8_WAIT_V(6); PG8_BAR; PG8_MMA(1, 1, At, B1); PG8_BAR;
            PG8_LDB(B0, 1, 0); PG8_SCHED; PG8_LDA(At, 1, 0); PG8_STAGE(PG8_SA(0, 1), a2 + hstepA, voffA);
            PG8_WAIT_L(8); PG8_BAR; PG8_WAIT_L(0); PG8_MMA(0, 0, At, B0); PG8_BAR; PG8_SCHED;
            PG8_LDB(B1, 1, 1); PG8_STAGE(PG8_SB(1, 0), b3, voffB);
            PG8_BAR; PG8_WAIT_L(0); PG8_MMA(0, 1, At, B1); PG8_BAR;
            PG8_LDA(At, 1, 1); PG8_STAGE(PG8_SA(1, 0), a3, voffA);
            PG8_BAR; PG8_WAIT_L(0); PG8_MMA(1, 0, At, B0); PG8_BAR; PG8_SCHED;
            PG8_STAGE(PG8_SB(1, 1), b3 + hstep, voffB);
            PG8_WAIT_V(6); PG8_BAR; PG8_MMA(1, 1, At, B1); PG8_BAR;
        }
        PG8_STAMP();
        if constexpr (!Epi::AFTER_DRAIN) { E(acc, cur, wr, wc, fr, fq); S.done(cur); }
        PG8_STAMP();
        if (!has_next) break;
#pragma unroll
        for (int a = 0; a < 2; ++a)
#pragma unroll
            for (int b = 0; b < 2; ++b)
#pragma unroll
                for (int m = 0; m < 4; ++m)
#pragma unroll
                    for (int n = 0; n < 2; ++n) acc[a][b][m][n] = (f32x4){0.f, 0.f, 0.f, 0.f};
        cur = nxt; cA = nA; cB = nB; ++ui;
    }
    PG8_WAIT_V(0);
    if (wr == 0) PG8_BAR;
    PG8_BAR;
    if constexpr (Epi::AFTER_DRAIN) { E.fused(acc, cur, wr, wc, fr, fq, lds, wid, lane); S.done(cur); }
    PG8_STAMP();
    if (STAMP && wid == 0) { stamps[lane] = lane < nts ? (((unsigned long long)(unsigned)ts_hi << 32) | (unsigned)ts_lo) : 0ull;
        if (lane == 62) stamps[62] = rt_entry; if (lane == 63) stamps[63] = (unsigned long long)wall_clock64(); }
#undef PG8_STAMP
#undef PG8_SA
#undef PG8_SB
#undef PG8_STAGE
#undef PG8_LDA
#undef PG8_LDB
#undef PG8_MMA
#undef PG8_WAIT_V
#undef PG8_WAIT_L
#undef PG8_BAR
#undef PG8_SCHED
}
}

namespace cg = cooperative_groups;
#define LAS __attribute__((address_space(3)))
typedef unsigned short bf16_t;
typedef unsigned int u32;
typedef pg8::bf16x8 bf16x8;
typedef pg8::f32x4 f32x4;
typedef pg8::u32x4 u32x4;

constexpr int D = 1024, TP = 4096, BP = 8, MP = BP * TP, BS = 32, TS = 8, MS = BS * TS;
constexpr int MB = MP + MS;
constexpr int MA = 33280;
constexpr int MA_REAL = MP + BS * 9;
constexpr int DIN = 3328, RCOLS = 1792, FF = 2816, FF2 = 5632, NLORA = 1536, KLORA = 256;
constexpr int NTHREADS = 512;
constexpr int LDS_BYTES = 144 * 1024;

constexpr size_t O_YP = 0;
constexpr size_t O_YS = O_YP + (size_t)MP * D;
constexpr size_t O_PSH = O_YS + (size_t)MS * D;
constexpr size_t O_PWKV = O_PSH + (size_t)BP * D;
constexpr size_t O_PK = O_PWKV + (size_t)BP * 8 * 64 * 64;
constexpr size_t O_PV = O_PK + (size_t)BP * 2048 * 512;
constexpr size_t O_PCONV = O_PV + (size_t)BP * 2048 * 512;
constexpr size_t O_SSH = O_PCONV + (size_t)BP * 2 * FF2;
constexpr size_t O_SWKV = O_SSH + (size_t)BS * D;
constexpr size_t O_SK = O_SWKV + (size_t)BS * 8 * 64 * 64;
constexpr size_t O_SV = O_SK + (size_t)BS * 2048 * 512;
constexpr size_t O_SCONV = O_SV + (size_t)BS * 2048 * 512;
constexpr size_t O_END = O_SCONV + (size_t)BS * 2 * FF2;

constexpr size_t al256(size_t x) { return (x + 255) & ~(size_t)255; }
constexpr size_t WS_WIN = 0;
constexpr size_t WS_WOUT = WS_WIN + al256((size_t)DIN * D * 2);
constexpr size_t WS_WUP = WS_WOUT + al256((size_t)D * D * 2);
constexpr size_t WS_WDN = WS_WUP + al256((size_t)FF2 * D * 2);
constexpr size_t WS_WLORA = WS_WDN + al256((size_t)D * FF * 2);
constexpr size_t WS_ROPE = WS_WLORA + al256((size_t)NLORA * KLORA * 2);
constexpr int NPOS = 4104;
constexpr size_t WS_SNEWK = WS_ROPE + al256((size_t)NPOS * 32 * 2 * 4);
constexpr size_t WS_SNEWV = WS_SNEWK + al256((size_t)MS * 512 * 4);
constexpr size_t WS_HALO = WS_SNEWV + al256((size_t)MS * 512 * 4);
constexpr size_t WS_A = WS_HALO + al256((size_t)1025 * 2 * FF2 * 2);
constexpr size_t WS_PROJRW = WS_A;
constexpr size_t WS_Q = WS_PROJRW + al256((size_t)MA * RCOLS * 2);
constexpr size_t WS_K = WS_Q + al256((size_t)MB * 512 * 2);
constexpr size_t WS_VT1 = WS_K + al256((size_t)MB * 512 * 2);
constexpr size_t WS_VT4 = WS_VT1 + al256((size_t)BP * 8 * 64 * TP * 2);
constexpr size_t WS_VT16 = WS_VT4 + al256((size_t)BP * 8 * 64 * TP * 2);
constexpr size_t WS_ALORA = WS_VT16 + al256((size_t)BP * 8 * 64 * TP * 2);
constexpr size_t WS_VROW = WS_ALORA + al256((size_t)MB * KLORA * 2);
constexpr size_t WS_A_EARLY_END = WS_VROW + al256((size_t)MP * 512 * 2);
constexpr size_t WS_U = WS_A;
constexpr size_t WS_END = WS_A + al256((size_t)MB * FF2 * 2);
static_assert(WS_A_EARLY_END <= WS_END, "region A overflow");
constexpr size_t WS_BAR = WS_END;
constexpr size_t WS_TOTAL = WS_END + 256;
constexpr size_t WS_Y = WS_ALORA;
static_assert(WS_Y + (size_t)MB * 512 * 4 <= WS_END, "Y overflow");
constexpr size_t SC_B = O_SK * 4;
constexpr size_t SC_C = SC_B + al256((size_t)MB * D * 4);
static_assert(SC_C + (size_t)MB * D * 2 <= O_SCONV * 4, "scratch overflow");
static_assert((size_t)MA * D * 2 <= (size_t)MB * D * 4 && (size_t)MB * NLORA * 2 <= (size_t)MB * D * 4, "region B");

struct Params {
    const float* in[28];
    float* out;
    unsigned char* ws;
    int en, pad;
};

enum { I_XP = 0, I_XS, I_SSHIFT, I_SWKV, I_CK, I_CV, I_SCONV, I_NMPRE, I_NMPOST, I_NFPRE, I_NFPOST, I_WIN, I_MU, I_W0, I_WDEC, I_A0, I_WICLR, I_WGATE,
       I_KK, I_KA, I_RK, I_LNW, I_LNB, I_WOUT, I_WUP, I_CONVW, I_CONVB, I_WDN };

__device__ __forceinline__ float bflo(u32 p) { return __uint_as_float(p << 16); }
__device__ __forceinline__ float bfhi(u32 p) { return __uint_as_float(p & 0xffff0000u); }
__device__ __forceinline__ u32 pk2(float a, float b) { return pg8::cvt_pk_bf16(a, b); }
__device__ __forceinline__ float wave_sum(float v) {
#pragma unroll
    for (int o = 1; o < 64; o <<= 1) v += __shfl_xor(v, o);
    return v;
}
template <int N> __device__ __forceinline__ float dpp_ror(float x) {
    return __int_as_float(__builtin_amdgcn_update_dpp(0, __float_as_int(x), 0x120 + N, 0xF, 0xF, false));
}
__device__ __forceinline__ float row16_sum(float x) {
    x += dpp_ror<8>(x); x += dpp_ror<4>(x); x += dpp_ror<2>(x); x += dpp_ror<1>(x);
    return x;
}
__device__ __forceinline__ void row16_sum4(float& a, float& b, float& c, float& d) {
    asm volatile("s_nop 1\n\t"
                 "v_add_f32_dpp %0, %0, %0 row_ror:8 row_mask:0xf bank_mask:0xf\n\t" "v_add_f32_dpp %1, %1, %1 row_ror:8 row_mask:0xf bank_mask:0xf\n\t"
                 "v_add_f32_dpp %2, %2, %2 row_ror:8 row_mask:0xf bank_mask:0xf\n\t" "v_add_f32_dpp %3, %3, %3 row_ror:8 row_mask:0xf bank_mask:0xf\n\t"
                 "v_add_f32_dpp %0, %0, %0 row_ror:4 row_mask:0xf bank_mask:0xf\n\t" "v_add_f32_dpp %1, %1, %1 row_ror:4 row_mask:0xf bank_mask:0xf\n\t"
                 "v_add_f32_dpp %2, %2, %2 row_ror:4 row_mask:0xf bank_mask:0xf\n\t" "v_add_f32_dpp %3, %3, %3 row_ror:4 row_mask:0xf bank_mask:0xf\n\t"
                 "v_add_f32_dpp %0, %0, %0 row_ror:2 row_mask:0xf bank_mask:0xf\n\t" "v_add_f32_dpp %1, %1, %1 row_ror:2 row_mask:0xf bank_mask:0xf\n\t"
                 "v_add_f32_dpp %2, %2, %2 row_ror:2 row_mask:0xf bank_mask:0xf\n\t" "v_add_f32_dpp %3, %3, %3 row_ror:2 row_mask:0xf bank_mask:0xf\n\t"
                 "v_add_f32_dpp %0, %0, %0 row_ror:1 row_mask:0xf bank_mask:0xf\n\t" "v_add_f32_dpp %1, %1, %1 row_ror:1 row_mask:0xf bank_mask:0xf\n\t"
                 "v_add_f32_dpp %2, %2, %2 row_ror:1 row_mask:0xf bank_mask:0xf\n\t" "v_add_f32_dpp %3, %3, %3 row_ror:1 row_mask:0xf bank_mask:0xf\n\t"
                 "s_nop 1"
                 : "+v"(a), "+v"(b), "+v"(c), "+v"(d));
}
__device__ __forceinline__ float fma_(float a, float b, float c) { float d; asm("v_fma_f32 %0, %1, %2, %3" : "=v"(d) : "v"(a), "v"(b), "v"(c)); return d; }
__device__ __forceinline__ float mul_(float a, float b) { float d; asm("v_mul_f32 %0, %1, %2" : "=v"(d) : "v"(a), "v"(b)); return d; }
__device__ __forceinline__ void row16_sum2_mul4(float& a, float& b, float (&t)[4], float v, float k0, float k1, float k2, float k3) {
    asm volatile("v_mul_f32 %2, %6, %7\n\t" "v_mul_f32 %3, %6, %8\n\t"
                 "v_add_f32_dpp %0, %0, %0 row_ror:8 row_mask:0xf bank_mask:0xf\n\t" "v_add_f32_dpp %1, %1, %1 row_ror:8 row_mask:0xf bank_mask:0xf\n\t"
                 "v_mul_f32 %4, %6, %9\n\t"
                 "v_add_f32_dpp %0, %0, %0 row_ror:4 row_mask:0xf bank_mask:0xf\n\t" "v_add_f32_dpp %1, %1, %1 row_ror:4 row_mask:0xf bank_mask:0xf\n\t"
                 "v_mul_f32 %5, %6, %10\n\t"
                 "v_add_f32_dpp %0, %0, %0 row_ror:2 row_mask:0xf bank_mask:0xf\n\t" "v_add_f32_dpp %1, %1, %1 row_ror:2 row_mask:0xf bank_mask:0xf\n\t"
                 "s_nop 0\n\t"
                 "v_add_f32_dpp %0, %0, %0 row_ror:1 row_mask:0xf bank_mask:0xf\n\t" "v_add_f32_dpp %1, %1, %1 row_ror:1 row_mask:0xf bank_mask:0xf"
                 : "+v"(a), "+v"(b), "=&v"(t[0]), "=&v"(t[1]), "=&v"(t[2]), "=&v"(t[3])
                 : "v"(v), "v"(k0), "v"(k1), "v"(k2), "v"(k3));
}
__device__ __forceinline__ void row16_sum2(float& a, float& b) {
    asm volatile("s_nop 1\n\t"
                 "v_add_f32_dpp %0, %0, %0 row_ror:8 row_mask:0xf bank_mask:0xf\n\t" "v_add_f32_dpp %1, %1, %1 row_ror:8 row_mask:0xf bank_mask:0xf\n\t" "s_nop 0\n\t"
                 "v_add_f32_dpp %0, %0, %0 row_ror:4 row_mask:0xf bank_mask:0xf\n\t" "v_add_f32_dpp %1, %1, %1 row_ror:4 row_mask:0xf bank_mask:0xf\n\t" "s_nop 0\n\t"
                 "v_add_f32_dpp %0, %0, %0 row_ror:2 row_mask:0xf bank_mask:0xf\n\t" "v_add_f32_dpp %1, %1, %1 row_ror:2 row_mask:0xf bank_mask:0xf\n\t" "s_nop 0\n\t"
                 "v_add_f32_dpp %0, %0, %0 row_ror:1 row_mask:0xf bank_mask:0xf\n\t" "v_add_f32_dpp %1, %1, %1 row_ror:1 row_mask:0xf bank_mask:0xf\n\t"
                 "s_nop 1"
                 : "+v"(a), "+v"(b));
}
__device__ __forceinline__ float sigmoidf_(float x) { return 1.f / (1.f + __expf(-x)); }

__device__ __forceinline__ int win_rowmap(int n) {
    if (n < RCOLS || n >= RCOLS + 1024) return n;
    const int base = (n < RCOLS + 512) ? RCOLS : RCOLS + 512, c = n - base, unit = c >> 8, cu = c & 255, hu = cu >> 6, d = cu & 63, e = d & 31, s = d >> 5;
    const int idx = hu * 32 + e, bj = idx >> 6, wc = (idx & 63) >> 4, fq = (idx & 15) >> 2, j = idx & 3;
    return base + unit * 256 + 128 * bj + 32 * wc + 16 * s + 4 * fq + j;
}
__device__ __forceinline__ void transpose_item(const float* W, int K, int N, bf16_t* WT, int mode, LAS float* scr, int item, int lane) {
    const int nblk = N / 32, kb = item / nblk, nb = item % nblk, k0 = 64 * kb, n0 = 32 * nb;
#pragma unroll 8
    for (int i = 0; i < 32; ++i) { const int kk = 2 * i + (lane >> 5); scr[kk * 33 + (lane & 31)] = W[(size_t)(k0 + kk) * N + n0 + (lane & 31)]; }
    asm volatile("s_waitcnt lgkmcnt(0)" ::: "memory");
    const int c = lane & 7;
#pragma unroll
    for (int j = 0; j < 4; ++j) { const int n = (lane >> 3) + 8 * j; const LAS float* s = scr + (8 * c) * 33 + n;
        uint4 o; o.x = pk2(s[0 * 33], s[1 * 33]); o.y = pk2(s[2 * 33], s[3 * 33]); o.z = pk2(s[4 * 33], s[5 * 33]); o.w = pk2(s[6 * 33], s[7 * 33]);
        const int row = mode ? win_rowmap(n0 + n) : (n0 + n);
        *(uint4*)(WT + (size_t)row * K + k0 + 8 * c) = o; }
    asm volatile("s_waitcnt lgkmcnt(0)" ::: "memory");
}
__device__ __forceinline__ void rms_row(const float* xrow, const float* g, bf16_t* orow, float* frow, int lane) {
    const float4* xr = (const float4*)xrow + lane; const float4* gr = (const float4*)g + lane;
    float4 v[4]; float s = 0.f;
#pragma unroll
    for (int j = 0; j < 4; ++j) { v[j] = xr[64 * j]; s += (v[j].x * v[j].x + v[j].y * v[j].y) + (v[j].z * v[j].z + v[j].w * v[j].w); }
    const float rs = rsqrtf(wave_sum(s) * (1.f / D) + 1e-6f);
#pragma unroll
    for (int j = 0; j < 4; ++j) { const float4 gg = gr[64 * j];
        float4 y; y.x = v[j].x * rs * gg.x; y.y = v[j].y * rs * gg.y; y.z = v[j].z * rs * gg.z; y.w = v[j].w * rs * gg.w;
        uint2 o; o.x = pk2(y.x, y.y); o.y = pk2(y.z, y.w);
        *((uint2*)orow + lane + 64 * j) = o;
        if (frow) *((float4*)frow + lane + 64 * j) = y; }
}
__device__ __forceinline__ void phase0(const Params& p, LAS unsigned char* lds, int tid, int G, int bid) {
    const int wave = tid >> 6, lane = tid & 63, gw = bid * 8 + wave, NGW = G * 8;
    LAS float* scr = (LAS float*)(lds + wave * 16384);
    bf16_t* WinT = (bf16_t*)(p.ws + WS_WIN); bf16_t* WoutT = (bf16_t*)(p.ws + WS_WOUT); bf16_t* WupT = (bf16_t*)(p.ws + WS_WUP); bf16_t* WdnT = (bf16_t*)(p.ws + WS_WDN);
    constexpr int I1 = (D / 64) * (DIN / 32), I2 = (D / 64) * (D / 32), I3 = (D / 64) * (FF2 / 32), I4 = (FF / 64) * (D / 32);
    for (int it = gw; it < I1 + I2 + I3 + I4; it += NGW) {
        int r = it;
        if (r < I1) { transpose_item(p.in[I_WIN], D, DIN, WinT, 1, scr, r, lane); continue; } r -= I1;
        if (r < I2) { transpose_item(p.in[I_WOUT], D, D, WoutT, 0, scr, r, lane); continue; } r -= I2;
        if (r < I3) { transpose_item(p.in[I_WUP], D, FF2, WupT, 0, scr, r, lane); continue; } r -= I3;
        transpose_item(p.in[I_WDN], FF, D, WdnT, 0, scr, r, lane);
    }
    const int gt = bid * NTHREADS + tid, NT = G * NTHREADS;
    bf16_t* WL = (bf16_t*)(p.ws + WS_WLORA);
    for (int i = gt; i < NLORA * KLORA; i += NT) {
        const int row = i >> 8, k = i & 255; float v = 0.f;
        if (row < 512) { if (k < 64) v = p.in[I_WDEC][k * 512 + row]; }
        else if (row < 1024) { if (k >= 64 && k < 128) v = p.in[I_WICLR][(k - 64) * 512 + (row - 512)]; }
        else { if (k >= 128) v = p.in[I_WGATE][(k - 128) * 512 + (row - 1024)]; }
        WL[i] = (bf16_t)(pk2(v, 0.f) & 0xffffu);
    }
    float* rope = (float*)(p.ws + WS_ROPE);
    for (int i = gt; i < NPOS * 32; i += NT) {
        const int pi = i >> 5, e = i & 31; const int pos = pi < TP ? pi : 16384 + (pi - TP);
        double inv = 1.0; for (int q = 0; q < e; ++q) inv *= 0.7498942093324558273;
        const float ang = (float)pos * (float)inv;
        const double a = (double)ang; const double kq = rint(a * 0.15915494309189535); double r = a - kq * 6.283185307179586; r -= kq * 2.4492935982947064e-16;
        const double r2 = r * r;
        double sn = 1.0 / 51090942171709440000.0;
        sn = sn * r2 * (-1.0) + 1.0 / 121645100408832000.0;
        sn = -sn * r2 + 1.0 / 355687428096000.0;
        sn = -sn * r2 + 1.0 / 1307674368000.0;
        sn = -sn * r2 + 1.0 / 6227020800.0;
        sn = -sn * r2 + 1.0 / 39916800.0;
        sn = -sn * r2 + 1.0 / 362880.0;
        sn = -sn * r2 + 1.0 / 5040.0;
        sn = -sn * r2 + 1.0 / 120.0;
        sn = -sn * r2 + 1.0 / 6.0;
        sn = -sn * r2 + 1.0;
        sn *= r;
        double cs = 1.0 / 1124000727777607680000.0;
        cs = -cs * r2 + 1.0 / 2432902008176640000.0;
        cs = -cs * r2 + 1.0 / 6402373705728000.0;
        cs = -cs * r2 + 1.0 / 20922789888000.0;
        cs = -cs * r2 + 1.0 / 87178291200.0;
        cs = -cs * r2 + 1.0 / 479001600.0;
        cs = -cs * r2 + 1.0 / 3628800.0;
        cs = -cs * r2 + 1.0 / 40320.0;
        cs = -cs * r2 + 1.0 / 720.0;
        cs = -cs * r2 + 1.0 / 24.0;
        cs = -cs * r2 + 0.5;
        cs = -cs * r2 + 1.0;
        rope[i] = (float)cs; rope[NPOS * 32 + i] = (float)sn;
    }
    bf16_t* H = (bf16_t*)((unsigned char*)p.out + SC_B);
    for (int row = gw; row < MA; row += NGW) {
        bf16_t* orow = H + (size_t)row * D;
        if (row < MP) {
            const bool last = (row & (TP - 1)) == TP - 1;
            rms_row(p.in[I_XP] + (size_t)row * D, p.in[I_NMPRE], orow, last ? p.out + O_PSH + (size_t)(row >> 12) * D : nullptr, lane);
        } else {
            const int s = row - MP;
            if (s < BS * 9) {
                const int b = s / 9, j = s - b * 9;
                if (j == 0) {
                    const float4* sr = (const float4*)(p.in[I_SSHIFT] + (size_t)b * D) + lane;
#pragma unroll
                    for (int q = 0; q < 4; ++q) { const float4 v = sr[64 * q]; uint2 o; o.x = pk2(v.x, v.y); o.y = pk2(v.z, v.w); *((uint2*)orow + lane + 64 * q) = o; }
                } else {
                    rms_row(p.in[I_XS] + (size_t)(b * TS + j - 1) * D, p.in[I_NMPRE], orow, j == TS ? p.out + O_SSH + (size_t)b * D : nullptr, lane);
                }
            } else {
#pragma unroll
                for (int q = 0; q < 4; ++q) *((uint2*)orow + lane + 64 * q) = make_uint2(0u, 0u);
            }
        }
    }
}

struct EpiProj {
    static constexpr bool PERM = false, AFTER_DRAIN = false;
    bf16_t* projrw; bf16_t* Q; bf16_t* K; bf16_t* VT1; bf16_t* VT4; bf16_t* VT16; const float* rope; float* out; float* snewk; float* snewv;
    __device__ __forceinline__ void operator()(const f32x4 (&acc)[2][2][4][2], const pg8::Unit& u, int wr, int wc, int fr, int fq) const {
        const int pn = u.pn;
        if (pn < 7) {
#pragma unroll
            for (int ai = 0; ai < 2; ++ai)
#pragma unroll
                for (int m = 0; m < 4; ++m) { const int row = u.pm * 256 + ai * 128 + wr * 64 + m * 16 + fr;
                    bf16_t* rp = projrw + (size_t)row * RCOLS + pn * 256 + wc * 32 + 4 * fq;
#pragma unroll
                    for (int bj = 0; bj < 2; ++bj)
#pragma unroll
                        for (int n = 0; n < 2; ++n) { const f32x4 v = acc[ai][bj][m][n]; uint2 o; o.x = pk2(v[0], v[1]); o.y = pk2(v[2], v[3]); *(uint2*)(rp + bj * 128 + n * 16) = o; } }
            return;
        }
#pragma unroll
        for (int ai = 0; ai < 2; ++ai)
#pragma unroll
            for (int m = 0; m < 4; ++m) {
                const int row = u.pm * 256 + ai * 128 + wr * 64 + m * 16 + fr;
                bool prompt = row < MP; int b, t, rowB, pi; bool valid = true;
                if (prompt) { b = row >> 12; t = row & (TP - 1); rowB = row; pi = t; }
                else { const int s = row - MP; b = s / 9; const int j = s - b * 9; valid = (s < BS * 9) && (j > 0); t = j - 1; rowB = MP + b * TS + t; pi = TP + t; }
                if (!valid) continue;
                if (pn < 11) {
                    const bool isq = pn < 9; const int unit = isq ? pn - 7 : pn - 9;
#pragma unroll
                    for (int bj = 0; bj < 2; ++bj) {
                        const int idx = bj * 64 + wc * 16 + fq * 4, hu = idx >> 5, e = idx & 31;
                        const float4 cs = *(const float4*)(rope + (size_t)pi * 32 + e), sn = *(const float4*)(rope + (size_t)NPOS * 32 + (size_t)pi * 32 + e);
                        const f32x4 x1 = acc[ai][bj][m][0], x2 = acc[ai][bj][m][1];
                        float o1[4], o2[4];
                        o1[0] = x1[0] * cs.x - x2[0] * sn.x; o2[0] = x1[0] * sn.x + x2[0] * cs.x;
                        o1[1] = x1[1] * cs.y - x2[1] * sn.y; o2[1] = x1[1] * sn.y + x2[1] * cs.y;
                        o1[2] = x1[2] * cs.z - x2[2] * sn.z; o2[2] = x1[2] * sn.z + x2[2] * cs.z;
                        o1[3] = x1[3] * cs.w - x2[3] * sn.w; o2[3] = x1[3] * sn.w + x2[3] * cs.w;
                        const int col = unit * 256 + hu * 64 + e;
                        if (isq) {
                            uint2 a, c2; a.x = pk2(o1[0] * 0.125f, o1[1] * 0.125f); a.y = pk2(o1[2] * 0.125f, o1[3] * 0.125f); c2.x = pk2(o2[0] * 0.125f, o2[1] * 0.125f); c2.y = pk2(o2[2] * 0.125f, o2[3] * 0.125f);
                            *(uint2*)(Q + (size_t)rowB * 512 + col) = a; *(uint2*)(Q + (size_t)rowB * 512 + col + 32) = c2;
                        } else {
                            uint2 a, c2; a.x = pk2(o1[0], o1[1]); a.y = pk2(o1[2], o1[3]); c2.x = pk2(o2[0], o2[1]); c2.y = pk2(o2[2], o2[3]);
                            *(uint2*)(K + (size_t)rowB * 512 + col) = a; *(uint2*)(K + (size_t)rowB * 512 + col + 32) = c2;
                            float* dst = nullptr;
                            if (prompt) { if (t >= 2048) dst = out + O_PK + ((size_t)b * 2048 + (t - 2048)) * 512 + col; }
                            else dst = snewk + (size_t)(b * TS + t) * 512 + col;
                            if (dst) { *(float4*)dst = make_float4(o1[0], o1[1], o1[2], o1[3]); *(float4*)(dst + 32) = make_float4(o2[0], o2[1], o2[2], o2[3]); }
                        }
                    }
                } else {
#pragma unroll
                    for (int bj = 0; bj < 2; ++bj)
#pragma unroll
                        for (int n = 0; n < 2; ++n) {
                            const int col = (pn - 11) * 256 + bj * 128 + wc * 32 + n * 16 + 4 * fq; const f32x4 v = acc[ai][bj][m][n];
                            if (prompt) {
                                if (t >= 2048) *(float4*)(out + O_PV + ((size_t)b * 2048 + (t - 2048)) * 512 + col) = make_float4(v[0], v[1], v[2], v[3]);
                                uint2 o; o.x = pk2(v[0], v[1]); o.y = pk2(v[2], v[3]); *(uint2*)(VT1 + (size_t)rowB * 512 + col) = o;
                            } else {
                                *(float4*)(snewv + (size_t)(b * TS + t) * 512 + col) = make_float4(v[0], v[1], v[2], v[3]);
                            }
                        }
                }
            }
    }
};
struct EpiDag {
    static constexpr bool PERM = false, AFTER_DRAIN = false;
    bf16_t* dag; const float* w0; const float* a0;
    __device__ __forceinline__ void operator()(const f32x4 (&acc)[2][2][4][2], const pg8::Unit& u, int wr, int wc, int fr, int fq) const {
        const int kind = u.pn >> 1;
#pragma unroll
        for (int bj = 0; bj < 2; ++bj)
#pragma unroll
            for (int n = 0; n < 2; ++n) {
                const int col = u.pn * 256 + bj * 128 + wc * 32 + n * 16 + 4 * fq;
                float4 bias = make_float4(0.f, 0.f, 0.f, 0.f);
                if (kind == 0) bias = *(const float4*)(w0 + col); else if (kind == 1) bias = *(const float4*)(a0 + col - 512);
                const float bb[4] = {bias.x, bias.y, bias.z, bias.w};
#pragma unroll
                for (int ai = 0; ai < 2; ++ai)
#pragma unroll
                    for (int m = 0; m < 4; ++m) { const int row = u.pm * 256 + ai * 128 + wr * 64 + m * 16 + fr; const f32x4 v = acc[ai][bj][m][n]; float o[4];
#pragma unroll
                        for (int j = 0; j < 4; ++j) { const float x = v[j] + bb[j];
                            if (kind == 0) { const float z = -x; const float sp = fmaxf(z, 0.f) + __logf(1.f + __expf(-fabsf(z))); o[j] = -__expf(-sp - 0.5f); }
                            else if (kind == 1) o[j] = sigmoidf_(x);
                            else o[j] = x; }
                        uint2 q; q.x = pk2(o[0], o[1]); q.y = pk2(o[2], o[3]); *(uint2*)(dag + (size_t)row * NLORA + col) = q; }
            }
    }
};
struct EpiUp {
    static constexpr bool PERM = false, AFTER_DRAIN = false;
    bf16_t* U; bf16_t* halo; float* out;
    __device__ __forceinline__ void operator()(const f32x4 (&acc)[2][2][4][2], const pg8::Unit& u, int wr, int wc, int fr, int fq) const {
#pragma unroll
        for (int ai = 0; ai < 2; ++ai)
#pragma unroll
            for (int m = 0; m < 4; ++m) {
                const int row = u.pm * 256 + ai * 128 + wr * 64 + m * 16 + fr; const int col0 = u.pn * 256 + wc * 32 + 4 * fq;
                bf16_t* hrow = nullptr; float* frow = nullptr;
                if (row < MP) { const int t = row & (TP - 1);
                    if ((t & 31) >= 30) hrow = halo + ((size_t)((row >> 5) + 1) * 2 + ((t & 31) - 30)) * FF2;
                    if (t >= TP - 2) frow = out + O_PCONV + ((size_t)(row >> 12) * 2 + (t - (TP - 2))) * FF2;
                } else { const int s = row - MP, b = s >> 3, tt = s & 7; if (tt >= 6) frow = out + O_SCONV + ((size_t)b * 2 + (tt - 6)) * FF2; }
#pragma unroll
                for (int bj = 0; bj < 2; ++bj)
#pragma unroll
                    for (int n = 0; n < 2; ++n) { const f32x4 v = acc[ai][bj][m][n]; const int col = col0 + bj * 128 + n * 16;
                        uint2 o; o.x = pk2(v[0], v[1]); o.y = pk2(v[2], v[3]);
                        *(uint2*)(U + (size_t)row * FF2 + col) = o;
                        if (hrow) *(uint2*)(hrow + col) = o;
                        if (frow) *(float4*)(frow + col) = make_float4(v[0], v[1], v[2], v[3]); }
            }
    }
};

__device__ __forceinline__ int rowA_of(int rowB) { return rowB < MP ? rowB : MP + ((rowB - MP) >> 3) * 9 + 1 + ((rowB - MP) & 7); }
__device__ __forceinline__ void phase_alora(const Params& p, int tid, int G, int bid) {
    const bf16_t* PR = (const bf16_t*)(p.ws + WS_PROJRW); bf16_t* AL = (bf16_t*)(p.ws + WS_ALORA); const float* mu = p.in[I_MU];
    const int gt = bid * NTHREADS + tid, NT = G * NTHREADS;
    for (int i = gt; i < MB * 64; i += NT) {
        const int rowB = i >> 6, c = (i & 63) * 4, rowA = rowA_of(rowB);
        const uint2 cur = *(const uint2*)(PR + (size_t)rowA * RCOLS + 1536 + c);
        uint2 prv = make_uint2(0u, 0u);
        if (!(rowB < MP && (rowB & (TP - 1)) == 0)) prv = *(const uint2*)(PR + (size_t)(rowA - 1) * RCOLS + 1536 + c);
        const float4 m4 = *(const float4*)(mu + 1536 + c);
        float x[4] = {bflo(cur.x), bfhi(cur.x), bflo(cur.y), bfhi(cur.y)}; const float pv[4] = {bflo(prv.x), bfhi(prv.x), bflo(prv.y), bfhi(prv.y)}; const float mm[4] = {m4.x, m4.y, m4.z, m4.w};
#pragma unroll
        for (int j = 0; j < 4; ++j) { float v = x[j] + (pv[j] - x[j]) * mm[j];
            if (c < 64) v = tanhf(v); else if (c >= 128) v = sigmoidf_(v);
            x[j] = v; }
        uint2 o; o.x = pk2(x[0], x[1]); o.y = pk2(x[2], x[3]);
        *(uint2*)(AL + (size_t)rowB * KLORA + c) = o;
    }
}


__device__ __forceinline__ void phase_vtrans(const Params& p, LAS unsigned char* lds, int tid, int G, int bid) {
    const bf16_t* VR = (const bf16_t*)(p.ws + WS_VROW);
    constexpr int PITCH = 132;
    for (int item = bid; item < BP * 8 * 8; item += G) {
        const int b = item >> 6, h = (item >> 3) & 7, t0 = (item & 7) * 512;
        __syncthreads();
#pragma unroll
        for (int i = 0; i < 8; ++i) { const int piece = tid + 512 * i, row = piece >> 3, c8 = piece & 7;
            const uint4 v = *(const uint4*)(VR + (size_t)(b * TP + t0 + row) * 512 + h * 64 + c8 * 8);
            LAS u32* dst = (LAS u32*)(lds + row * PITCH + c8 * 16); dst[0] = v.x; dst[1] = v.y; dst[2] = v.z; dst[3] = v.w; }
        __syncthreads();
#pragma unroll 1
        for (int lay = 0; lay < 3; ++lay) {
            const int dd = lay == 0 ? 1 : (lay == 1 ? 4 : 16); const int Tdd = TP / dd;
            bf16_t* VT = (bf16_t*)(p.ws + (lay == 0 ? WS_VT1 : (lay == 1 ? WS_VT4 : WS_VT16))) + (size_t)(b * 8 + h) * 64 * TP;
            const int chunk0 = (t0 / dd) >> 5;
#pragma unroll
            for (int i = 0; i < 8; ++i) {
                const int sidx = tid + 512 * i, g = sidx & 3, d = (sidx >> 2) & 63, rc = sidx >> 8;
                int r, cl; if (lay == 0) { r = 0; cl = rc; } else if (lay == 1) { r = rc & 3; cl = rc >> 2; } else { r = rc; cl = 0; }
                u32 w[4];
#pragma unroll
                for (int hf = 0; hf < 2; ++hf)
#pragma unroll
                    for (int jp = 0; jp < 2; ++jp) {
                        const int u5a = 16 * hf + 4 * g + 2 * jp; const int ta = (32 * cl + u5a) * dd + r, tb = ta + dd;
                        const u32 lo = *(const LAS unsigned short*)(lds + ta * PITCH + d * 2), hi = *(const LAS unsigned short*)(lds + tb * PITCH + d * 2);
                        w[hf * 2 + jp] = lo | (hi << 16);
                    }
                *(uint4*)(VT + (size_t)r * Tdd * 64 + (size_t)(chunk0 + cl) * 2048 + d * 32 + 8 * g) = make_uint4(w[0], w[1], w[2], w[3]);
            }
        }
    }
    __syncthreads();
}

constexpr int CH = 32;
constexpr int SST = 452;
constexpr int SI_W = 0, SI_A = 64, SI_B = 128, SI_K = 192, SI_WR = 256, SI_V = 320, SI_G = 384, SI_SC = 448;
struct PrepRegs { uint2 cr, ck, cv, pr, pk, pv, dw, da, dg; };
__device__ __forceinline__ void scan_item(const Params& p, LAS unsigned char* lds, int tid, bool sample, int b, int h, int half) {
    const bf16_t* PR = (const bf16_t*)(p.ws + WS_PROJRW); const bf16_t* DAG = (const bf16_t*)((const unsigned char*)p.out + SC_B);
    float* YG = (float*)(p.ws + WS_Y);
    LAS float* buf0 = (LAS float*)lds; LAS float* buf1 = buf0 + CH * SST; LAS float* ybuf = buf1 + CH * SST;
    const int T = sample ? TS : TP;
    const int rowB0 = sample ? MP + b * TS : b * TP;
    const int rowA0 = sample ? MP + b * 9 + 1 : b * TP;
    const int nch = (T + CH - 1) / CH;
    const int ptl = tid >> 4, pj = (tid & 15) * 4, pc = h * 64 + pj;
    const int lane = tid & 63, wv = tid >> 6, rg = wv * 4 + (lane >> 4), cgi = lane & 15;
    const int row = 32 * half + rg;
    float st[4];
    if (sample) {
        const float4 a = *(const float4*)(p.in[I_SWKV] + ((size_t)(b * 8 + h) * 64 + row) * 64 + 4 * cgi);
        st[0] = a.x; st[1] = a.y; st[2] = a.z; st[3] = a.w;
    } else {
#pragma unroll
        for (int j = 0; j < 4; ++j) st[j] = 0.f;
    }
    const float4 mur = *(const float4*)(p.in[I_MU] + pc), muk = *(const float4*)(p.in[I_MU] + 512 + pc), muv = *(const float4*)(p.in[I_MU] + 1024 + pc);
    const float4 kk4 = *(const float4*)(p.in[I_KK] + pc), ka4 = *(const float4*)(p.in[I_KA] + pc), rk4 = *(const float4*)(p.in[I_RK] + pc);
    __builtin_amdgcn_s_waitcnt(0x0F70);
    PrepRegs R;
#define SCAN_LOAD(chunk) do { const int t_ = (chunk) * CH + ptl; if (t_ < T) { const size_t ra = (size_t)(rowA0 + t_) * RCOLS + pc; const size_t rb = (size_t)(rowB0 + t_) * NLORA + pc; \
        R.cr = *(const uint2*)(PR + ra); R.ck = *(const uint2*)(PR + ra + 512); R.cv = *(const uint2*)(PR + ra + 1024); \
        if (!sample && t_ == 0) { R.pr = make_uint2(0u, 0u); R.pk = R.pr; R.pv = R.pr; } \
        else { R.pr = *(const uint2*)(PR + ra - RCOLS); R.pk = *(const uint2*)(PR + ra - RCOLS + 512); R.pv = *(const uint2*)(PR + ra - RCOLS + 1024); } \
        R.dw = *(const uint2*)(DAG + rb); R.da = *(const uint2*)(DAG + rb + 512); R.dg = *(const uint2*)(DAG + rb + 1024); } } while (0)
#define SCAN_PREP(chunk, dstbuf) do { const int t_ = (chunk) * CH + ptl; if (t_ < T) { \
        const float mr[4] = {mur.x, mur.y, mur.z, mur.w}, mk[4] = {muk.x, muk.y, muk.z, muk.w}, mv[4] = {muv.x, muv.y, muv.z, muv.w}; \
        const float kkc[4] = {kk4.x, kk4.y, kk4.z, kk4.w}, kac[4] = {ka4.x, ka4.y, ka4.z, ka4.w}, rkc[4] = {rk4.x, rk4.y, rk4.z, rk4.w}; \
        const float crr[4] = {bflo(R.cr.x), bfhi(R.cr.x), bflo(R.cr.y), bfhi(R.cr.y)}, ckk[4] = {bflo(R.ck.x), bfhi(R.ck.x), bflo(R.ck.y), bfhi(R.ck.y)}, cvv[4] = {bflo(R.cv.x), bfhi(R.cv.x), bflo(R.cv.y), bfhi(R.cv.y)}; \
        const float prr[4] = {bflo(R.pr.x), bfhi(R.pr.x), bflo(R.pr.y), bfhi(R.pr.y)}, pkk[4] = {bflo(R.pk.x), bfhi(R.pk.x), bflo(R.pk.y), bfhi(R.pk.y)}, pvv[4] = {bflo(R.pv.x), bfhi(R.pv.x), bflo(R.pv.y), bfhi(R.pv.y)}; \
        const float lw[4] = {bflo(R.dw.x), bfhi(R.dw.x), bflo(R.dw.y), bfhi(R.dw.y)}, aa[4] = {bflo(R.da.x), bfhi(R.da.x), bflo(R.da.y), bfhi(R.da.y)}, gg[4] = {bflo(R.dg.x), bfhi(R.dg.x), bflo(R.dg.y), bfhi(R.dg.y)}; \
        float r_[4], k_[4], v_[4], w_[4], kn[4], k2[4]; float nrm = 0.f; \
        _Pragma("unroll") for (int j = 0; j < 4; ++j) { r_[j] = crr[j] + (prr[j] - crr[j]) * mr[j]; k_[j] = ckk[j] + (pkk[j] - ckk[j]) * mk[j]; v_[j] = cvv[j] + (pvv[j] - cvv[j]) * mv[j]; \
            w_[j] = __expf(lw[j]); kn[j] = k_[j] * kkc[j]; nrm += kn[j] * kn[j]; k2[j] = k_[j] * (1.f + (aa[j] - 1.f) * kac[j]); } \
        nrm = row16_sum(nrm); const float inv = 1.f / fmaxf(sqrtf(nrm), 1e-12f); \
        float br = 0.f, kr = 0.f, rk = 0.f; float an[4], bn[4], wrr[4]; \
        _Pragma("unroll") for (int j = 0; j < 4; ++j) { const float kkn = kn[j] * inv; an[j] = -kkn; bn[j] = kkn * aa[j]; wrr[j] = w_[j] * r_[j]; br += bn[j] * r_[j]; kr += k2[j] * r_[j]; rk += r_[j] * k2[j] * rkc[j]; } \
        br = row16_sum(br); kr = row16_sum(kr); rk = row16_sum(rk); \
        LAS float* rec = (dstbuf) + ptl * SST; \
        *(LAS f32x4*)(rec + SI_W + pj) = (f32x4){w_[0], w_[1], w_[2], w_[3]}; *(LAS f32x4*)(rec + SI_A + pj) = (f32x4){an[0], an[1], an[2], an[3]}; \
        *(LAS f32x4*)(rec + SI_B + pj) = (f32x4){bn[0], bn[1], bn[2], bn[3]}; *(LAS f32x4*)(rec + SI_K + pj) = (f32x4){k2[0], k2[1], k2[2], k2[3]}; \
        *(LAS f32x4*)(rec + SI_WR + pj) = (f32x4){wrr[0], wrr[1], wrr[2], wrr[3]}; *(LAS f32x4*)(rec + SI_V + pj) = (f32x4){v_[0], v_[1], v_[2], v_[3]}; \
        *(LAS f32x4*)(rec + SI_G + pj) = (f32x4){gg[0], gg[1], gg[2], gg[3]}; \
        if ((tid & 15) == 0) *(LAS f32x4*)(rec + SI_SC) = (f32x4){br, kr, rk, 0.f}; } } while (0)

    SCAN_LOAD(0);
    SCAN_PREP(0, buf0);
    __syncthreads();
    for (int c = 0; c < nch; ++c) {
        LAS float* cur = (c & 1) ? buf1 : buf0; LAS float* nxt = (c & 1) ? buf0 : buf1;
        if (c + 1 < nch) SCAN_LOAD(c + 1);
        const int ns = (T - c * CH) < CH ? (T - c * CH) : CH;
        {
            const LAS float* rec = cur;
            f32x4 wA = *(const LAS f32x4*)(rec + SI_W + 4 * cgi), aA = *(const LAS f32x4*)(rec + SI_A + 4 * cgi), bA = *(const LAS f32x4*)(rec + SI_B + 4 * cgi);
            f32x4 kA = *(const LAS f32x4*)(rec + SI_K + 4 * cgi), rA = *(const LAS f32x4*)(rec + SI_WR + 4 * cgi);
            float vA = rec[SI_V + row]; pg8::f32x2 cA = *(const LAS pg8::f32x2*)(rec + SI_SC);
            f32x4 wB, aB, bB, kB, rB; float vB; pg8::f32x2 cB;
#define SCAN_FETCH(W, A, B, K, R, V, C) do { rec += SST; W = *(const LAS f32x4*)(rec + SI_W + 4 * cgi); A = *(const LAS f32x4*)(rec + SI_A + 4 * cgi); B = *(const LAS f32x4*)(rec + SI_B + 4 * cgi); \
            K = *(const LAS f32x4*)(rec + SI_K + 4 * cgi); R = *(const LAS f32x4*)(rec + SI_WR + 4 * cgi); V = rec[SI_V + row]; C = *(const LAS pg8::f32x2*)(rec + SI_SC); } while (0)
#define SCAN_STEP(W, A, B, K, R, V, C, qq) do { \
            float da = mul_(st[0], A[0]); float dw = mul_(st[0], R[0]); \
            da = fma_(st[1], A[1], da); dw = fma_(st[1], R[1], dw); da = fma_(st[2], A[2], da); dw = fma_(st[2], R[2], dw); da = fma_(st[3], A[3], da); dw = fma_(st[3], R[3], dw); \
            float tt_[4]; row16_sum2_mul4(da, dw, tt_, V, K[0], K[1], K[2], K[3]); \
            const float y = fma_(V, C[1], fma_(da, C[0], dw)); \
            _Pragma("unroll") for (int j = 0; j < 4; ++j) st[j] = fma_(st[j], W[j], fma_(da, B[j], tt_[j])); \
            yk = ((qq) == cgi) ? y : yk; } while (0)
            for (int tb = 0; tb < ns; tb += 16) {
                const int nq = (ns - tb) < 16 ? (ns - tb) : 16;
                float yk = 0.f;
                for (int q = 0; q < nq; q += 2) {
                    SCAN_FETCH(wB, aB, bB, kB, rB, vB, cB);
                    SCAN_STEP(wA, aA, bA, kA, rA, vA, cA, q);
                    SCAN_FETCH(wA, aA, bA, kA, rA, vA, cA);
                    SCAN_STEP(wB, aB, bB, kB, rB, vB, cB, q + 1);
                }
                ybuf[(tb + cgi) * 32 + rg] = yk;
            }
#undef SCAN_FETCH
#undef SCAN_STEP
        }
        __syncthreads();
        if (ptl < ns) {
            const pg8::f32x2 y2 = *(const LAS pg8::f32x2*)(ybuf + ptl * 32 + 2 * (tid & 15));
            *(float2*)(YG + (size_t)(rowB0 + c * CH + ptl) * 512 + h * 64 + 32 * half + 2 * (tid & 15)) = make_float2(y2[0], y2[1]);
        }
        if (c + 1 < nch) SCAN_PREP(c + 1, nxt);
        __syncthreads();
    }
#undef SCAN_LOAD
#undef SCAN_PREP
    float* So = p.out + (sample ? O_SWKV : O_PWKV) + ((size_t)(b * 8 + h) * 64 + row) * 64 + 4 * cgi;
    *(float4*)So = make_float4(st[0], st[1], st[2], st[3]);
}

__device__ __forceinline__ void phase_wkvfin(const Params& p, int tid, int G, int bid) {
    const bf16_t* PR = (const bf16_t*)(p.ws + WS_PROJRW); const bf16_t* DAG = (const bf16_t*)((const unsigned char*)p.out + SC_B);
    const float* YG = (const float*)(p.ws + WS_Y); bf16_t* MIX = (bf16_t*)((unsigned char*)p.out + SC_C);
    const int gt = bid * NTHREADS + tid, NT = G * NTHREADS;
    for (int i = gt; i < MB * 128; i += NT) {
        const int jq = i & 15, h = (i >> 4) & 7, rowB = i >> 7, pc = h * 64 + jq * 4, rowA = rowA_of(rowB);
        const size_t ra = (size_t)rowA * RCOLS + pc;
        const uint2 cr = *(const uint2*)(PR + ra), ck = *(const uint2*)(PR + ra + 512), cv = *(const uint2*)(PR + ra + 1024);
        uint2 pr = make_uint2(0u, 0u), pk = pr, pv = pr;
        if (!(rowB < MP && (rowB & (TP - 1)) == 0)) { pr = *(const uint2*)(PR + ra - RCOLS); pk = *(const uint2*)(PR + ra - RCOLS + 512); pv = *(const uint2*)(PR + ra - RCOLS + 1024); }
        const uint2 da = *(const uint2*)(DAG + (size_t)rowB * NLORA + 512 + pc), dg = *(const uint2*)(DAG + (size_t)rowB * NLORA + 1024 + pc);
        const float4 y4 = *(const float4*)(YG + (size_t)rowB * 512 + pc);
        const float4 mur = *(const float4*)(p.in[I_MU] + pc), muk = *(const float4*)(p.in[I_MU] + 512 + pc), muv = *(const float4*)(p.in[I_MU] + 1024 + pc);
        const float4 ka4 = *(const float4*)(p.in[I_KA] + pc), rk4 = *(const float4*)(p.in[I_RK] + pc), lw4 = *(const float4*)(p.in[I_LNW] + pc), lb4 = *(const float4*)(p.in[I_LNB] + pc);
        const float mr[4] = {mur.x, mur.y, mur.z, mur.w}, mk[4] = {muk.x, muk.y, muk.z, muk.w}, mv[4] = {muv.x, muv.y, muv.z, muv.w};
        const float kac[4] = {ka4.x, ka4.y, ka4.z, ka4.w}, rkc[4] = {rk4.x, rk4.y, rk4.z, rk4.w}, lw[4] = {lw4.x, lw4.y, lw4.z, lw4.w}, lb[4] = {lb4.x, lb4.y, lb4.z, lb4.w};
        const float crr[4] = {bflo(cr.x), bfhi(cr.x), bflo(cr.y), bfhi(cr.y)}, ckk[4] = {bflo(ck.x), bfhi(ck.x), bflo(ck.y), bfhi(ck.y)}, cvv[4] = {bflo(cv.x), bfhi(cv.x), bflo(cv.y), bfhi(cv.y)};
        const float prr[4] = {bflo(pr.x), bfhi(pr.x), bflo(pr.y), bfhi(pr.y)}, pkk[4] = {bflo(pk.x), bfhi(pk.x), bflo(pk.y), bfhi(pk.y)}, pvv[4] = {bflo(pv.x), bfhi(pv.x), bflo(pv.y), bfhi(pv.y)};
        const float aa[4] = {bflo(da.x), bfhi(da.x), bflo(da.y), bfhi(da.y)}, gg[4] = {bflo(dg.x), bfhi(dg.x), bflo(dg.y), bfhi(dg.y)};
        const float yy[4] = {y4.x, y4.y, y4.z, y4.w};
        float v_[4]; float rk = 0.f;
#pragma unroll
        for (int j = 0; j < 4; ++j) { const float r_ = crr[j] + (prr[j] - crr[j]) * mr[j], k_ = ckk[j] + (pkk[j] - ckk[j]) * mk[j]; v_[j] = cvv[j] + (pvv[j] - cvv[j]) * mv[j];
            const float k2 = k_ * (1.f + (aa[j] - 1.f) * kac[j]); rk += r_ * k2 * rkc[j]; }
        rk = row16_sum(rk);
        const float mean = row16_sum((yy[0] + yy[1]) + (yy[2] + yy[3])) * (1.f / 64.f);
        float d[4]; float vs = 0.f;
#pragma unroll
        for (int j = 0; j < 4; ++j) { d[j] = yy[j] - mean; vs += d[j] * d[j]; }
        const float rs = rsqrtf(row16_sum(vs) * (1.f / 64.f) + 64e-5f);
        float o[4];
#pragma unroll
        for (int j = 0; j < 4; ++j) o[j] = (d[j] * rs * lw[j] + lb[j] + rk * v_[j]) * gg[j];
        uint2 w; w.x = pk2(o[0], o[1]); w.y = pk2(o[2], o[3]);
        *(uint2*)(MIX + (size_t)rowB * D + pc) = w;
    }
}

__device__ __forceinline__ void attn_task(const Params& p, int task, int lane) {
    const bf16_t* Q = (const bf16_t*)(p.ws + WS_Q); const bf16_t* K = (const bf16_t*)(p.ws + WS_K);
    bf16_t* MIX = (bf16_t*)((unsigned char*)p.out + SC_C);
    const int b = task >> 11, h = (task >> 8) & 7, r16 = (task >> 4) & 15, ig = task & 15;
    const int li = lane & 15, g = lane >> 4;
    const int tq = r16 + 16 * (16 * ig + li);
    const bf16_t* qp = Q + (size_t)(b * TP + tq) * 512 + h * 64 + 8 * g;
    const bf16x8 qf0 = *(const bf16x8*)qp, qf1 = *(const bf16x8*)(qp + 32);
    float m_run = -1e30f, l_run = 0.f;
    f32x4 o[4];
#pragma unroll
    for (int i = 0; i < 4; ++i) o[i] = (f32x4){0.f, 0.f, 0.f, 0.f};
#pragma unroll 1
    for (int br = 0; br < 3; ++br) {
        int dd, r, uq0, Tdd; const bf16_t* VT;
        if (br == 0) { dd = 16; r = r16; uq0 = 16 * ig; Tdd = TP / 16; VT = (const bf16_t*)(p.ws + WS_VT16); }
        else if (br == 1) { dd = 4; r = r16 & 3; uq0 = (r16 >> 2) + 64 * ig; Tdd = TP / 4; VT = (const bf16_t*)(p.ws + WS_VT4); }
        else { dd = 1; r = 0; uq0 = r16 + 256 * ig; Tdd = TP; VT = (const bf16_t*)(p.ws + WS_VT1); }
        const int s = 16 / dd, uq = uq0 + s * li;
        int ulo = uq0 - 128; if (ulo < 0) ulo = 0; ulo &= ~31;
        const int uhi = uq0 + 15 * s;
        const bf16_t* Kb = K + ((size_t)b * TP + r) * 512 + h * 64 + 8 * g;
        const bf16_t* Vb = VT + (size_t)(b * 8 + h) * 64 * TP + (size_t)r * Tdd * 64 + li * 32 + 8 * g;
        bf16x8 kx0, kx1, ky0, ky1, vf[4];
        { const bf16_t* kx = Kb + (size_t)(ulo + li) * dd * 512; const bf16_t* ky = kx + (size_t)16 * dd * 512;
          kx0 = *(const bf16x8*)kx; kx1 = *(const bf16x8*)(kx + 32); ky0 = *(const bf16x8*)ky; ky1 = *(const bf16x8*)(ky + 32);
#pragma unroll
          for (int dt = 0; dt < 4; ++dt) vf[dt] = *(const bf16x8*)(Vb + (size_t)(ulo >> 5) * 2048 + dt * 512); }
#pragma unroll 1
        for (int kt = ulo; kt <= uhi; kt += 32) {
            const int ktn = (kt + 32 <= uhi) ? kt + 32 : kt;
            const bf16_t* nkx = Kb + (size_t)(ktn + li) * dd * 512; const bf16_t* nky = nkx + (size_t)16 * dd * 512;
            const bf16x8 nkx0 = *(const bf16x8*)nkx, nkx1 = *(const bf16x8*)(nkx + 32), nky0 = *(const bf16x8*)nky, nky1 = *(const bf16x8*)(nky + 32);
            bf16x8 nvf[4];
#pragma unroll
            for (int dt = 0; dt < 4; ++dt) nvf[dt] = *(const bf16x8*)(Vb + (size_t)(ktn >> 5) * 2048 + dt * 512);
            f32x4 sx = (f32x4){0.f, 0.f, 0.f, 0.f}, sy = (f32x4){0.f, 0.f, 0.f, 0.f};
            sx = __builtin_amdgcn_mfma_f32_16x16x32_bf16(kx0, qf0, sx, 0, 0, 0); sx = __builtin_amdgcn_mfma_f32_16x16x32_bf16(kx1, qf1, sx, 0, 0, 0);
            sy = __builtin_amdgcn_mfma_f32_16x16x32_bf16(ky0, qf0, sy, 0, 0, 0); sy = __builtin_amdgcn_mfma_f32_16x16x32_bf16(ky1, qf1, sy, 0, 0, 0);
            float sv[8]; bool ok[8]; float tmax = -1e30f;
#pragma unroll
            for (int j = 0; j < 4; ++j) { const int dx = uq - (kt + 4 * g + j), dy = dx - 16;
                ok[j] = (unsigned)dx <= 128u; ok[4 + j] = (unsigned)dy <= 128u; sv[j] = ok[j] ? sx[j] : -1e30f; sv[4 + j] = ok[4 + j] ? sy[j] : -1e30f;
                tmax = fmaxf(tmax, fmaxf(sv[j], sv[4 + j])); }
            tmax = fmaxf(tmax, __shfl_xor(tmax, 16)); tmax = fmaxf(tmax, __shfl_xor(tmax, 32));
            const float m_new = fmaxf(m_run, tmax), alpha = __expf(m_run - m_new);
            float pe[8]; float ps = 0.f;
#pragma unroll
            for (int j = 0; j < 8; ++j) { pe[j] = ok[j] ? __expf(sv[j] - m_new) : 0.f; ps += pe[j]; }
            l_run = l_run * alpha + ps; m_run = m_new;
            u32x4 pw; pw[0] = pk2(pe[0], pe[1]); pw[1] = pk2(pe[2], pe[3]); pw[2] = pk2(pe[4], pe[5]); pw[3] = pk2(pe[6], pe[7]);
            const bf16x8 pf = __builtin_bit_cast(bf16x8, pw);
#pragma unroll
            for (int dt = 0; dt < 4; ++dt) { o[dt] *= alpha; o[dt] = __builtin_amdgcn_mfma_f32_16x16x32_bf16(vf[dt], pf, o[dt], 0, 0, 0); }
            kx0 = nkx0; kx1 = nkx1; ky0 = nky0; ky1 = nky1;
#pragma unroll
            for (int dt = 0; dt < 4; ++dt) vf[dt] = nvf[dt];
        }
    }
    float lt = l_run; lt += __shfl_xor(lt, 16); lt += __shfl_xor(lt, 32);
    const float il = 1.f / lt;
    bf16_t* op = MIX + (size_t)(b * TP + tq) * D + 512 + h * 64 + 4 * g;
#pragma unroll
    for (int dt = 0; dt < 4; ++dt) { uint2 w; w.x = pk2(o[dt][0] * il, o[dt][1] * il); w.y = pk2(o[dt][2] * il, o[dt][3] * il); *(uint2*)(op + 16 * dt) = w; }
}
__device__ __forceinline__ void attn_sample_task(const Params& p, int task, int lane, LAS float* wl) {
    const bf16_t* Q = (const bf16_t*)(p.ws + WS_Q); const float* snewk = (const float*)(p.ws + WS_SNEWK); const float* snewv = (const float*)(p.ws + WS_SNEWV);
    const float* CK = p.in[I_CK]; const float* CV = p.in[I_CV];
    bf16_t* MIX = (bf16_t*)((unsigned char*)p.out + SC_C);
    const int b = task >> 6, h = (task >> 3) & 7, tt = task & 7;
    const int rowB = MP + b * TS + tt;
    asm volatile("s_waitcnt lgkmcnt(0)" ::: "memory");
    wl[lane] = bflo((u32)Q[(size_t)rowB * 512 + h * 64 + lane]);
    asm volatile("s_waitcnt lgkmcnt(0)" ::: "memory");
    float mx = -1e30f;
#pragma unroll 1
    for (int c = 0; c < 9; ++c) {
        const int br = c / 3, it = c - br * 3; const int dd = br == 0 ? 1 : (br == 1 ? 4 : 16); const int j = lane + 64 * it;
        const int jc = j <= 128 ? j : 128;
        const int idx = 2048 + tt - jc * dd;
        const float* kr = idx < 2048 ? CK + ((size_t)(b * 2048 + idx) * 8 + h) * 64 : snewk + (size_t)(b * TS + idx - 2048) * 512 + h * 64;
        float s = 0.f;
#pragma unroll
        for (int d4 = 0; d4 < 16; ++d4) { const float4 kv = *(const float4*)(kr + 4 * d4); const f32x4 qv = *(const LAS f32x4*)(wl + 4 * d4);
            s += kv.x * qv[0] + kv.y * qv[1] + kv.z * qv[2] + kv.w * qv[3]; }
        if (j > 128) s = -1e30f;
        wl[64 + c * 64 + lane] = s; mx = fmaxf(mx, s);
    }
#pragma unroll
    for (int o = 1; o < 64; o <<= 1) mx = fmaxf(mx, __shfl_xor(mx, o));
    asm volatile("s_waitcnt lgkmcnt(0)" ::: "memory");
    float ls = 0.f;
#pragma unroll 1
    for (int c = 0; c < 9; ++c) { const float s = wl[64 + c * 64 + lane]; const float e = s > -1e29f ? __expf(s - mx) : 0.f; wl[64 + c * 64 + lane] = e; ls += e; }
    ls = wave_sum(ls);
    asm volatile("s_waitcnt lgkmcnt(0)" ::: "memory");
    float acc = 0.f;
#pragma unroll 1
    for (int c = 0; c < 9; ++c) {
        const int br = c / 3, it = c - br * 3; const int dd = br == 0 ? 1 : (br == 1 ? 4 : 16); const int nj = it < 2 ? 64 : 1;
#pragma unroll 8
        for (int l2 = 0; l2 < nj; ++l2) {
            const int j = l2 + 64 * it; const int idx = 2048 + tt - j * dd;
            const float* vr = idx < 2048 ? CV + ((size_t)(b * 2048 + idx) * 8 + h) * 64 : snewv + (size_t)(b * TS + idx - 2048) * 512 + h * 64;
            acc += wl[64 + c * 64 + l2] * vr[lane];
        }
    }
    const float res = acc / ls;
    const float other = __shfl_xor(res, 1);
    if ((lane & 1) == 0) *(u32*)(MIX + (size_t)rowB * D + 512 + h * 64 + lane) = pk2(res, other);
}

__device__ __forceinline__ void phase_norm1(const Params& p, int tid, int G, int bid) {
    const int wave = tid >> 6, lane = tid & 63, gw = bid * 8 + wave, NGW = G * 8;
    const float* mix = (const float*)((const unsigned char*)p.out + SC_B); bf16_t* H2 = (bf16_t*)((unsigned char*)p.out + SC_C);
    for (int row = gw; row < MB; row += NGW) {
        const float* xrow = row < MP ? p.in[I_XP] + (size_t)row * D : p.in[I_XS] + (size_t)(row - MP) * D;
        const float4* mr = (const float4*)(mix + (size_t)row * D) + lane; const float4* xr = (const float4*)xrow + lane;
        float4 v[4], x[4]; float s = 0.f;
#pragma unroll
        for (int j = 0; j < 4; ++j) { v[j] = mr[64 * j]; x[j] = xr[64 * j]; s += (v[j].x * v[j].x + v[j].y * v[j].y) + (v[j].z * v[j].z + v[j].w * v[j].w); }
        const float rs = rsqrtf(wave_sum(s) * (1.f / D) + 1e-6f);
        float s2 = 0.f;
#pragma unroll
        for (int j = 0; j < 4; ++j) { const float4 gg = *((const float4*)p.in[I_NMPOST] + lane + 64 * j);
            x[j].x += v[j].x * rs * gg.x; x[j].y += v[j].y * rs * gg.y; x[j].z += v[j].z * rs * gg.z; x[j].w += v[j].w * rs * gg.w;
            s2 += (x[j].x * x[j].x + x[j].y * x[j].y) + (x[j].z * x[j].z + x[j].w * x[j].w);
            *((float4*)(p.out + (size_t)row * D) + lane + 64 * j) = x[j]; }
        const float rs2 = rsqrtf(wave_sum(s2) * (1.f / D) + 1e-6f);
#pragma unroll
        for (int j = 0; j < 4; ++j) { const float4 gg = *((const float4*)p.in[I_NFPRE] + lane + 64 * j);
            uint2 o; o.x = pk2(x[j].x * rs2 * gg.x, x[j].y * rs2 * gg.y); o.y = pk2(x[j].z * rs2 * gg.z, x[j].w * rs2 * gg.w);
            *((uint2*)(H2 + (size_t)row * D) + lane + 64 * j) = o; }
    }
}
__device__ __forceinline__ void phase_act(const Params& p, int tid, int G, int bid) {
    const int wave = tid >> 6, lane = tid & 63, gw = bid * 8 + wave, NGW = G * 8;
    bf16_t* U = (bf16_t*)(p.ws + WS_U); const bf16_t* halo = (const bf16_t*)(p.ws + WS_HALO);
    const float* cw = p.in[I_CONVW]; const float* cb = p.in[I_CONVB];
    constexpr int NPI = (MP / 32) * 11, NSI = BS * 11;
    for (int it = gw; it < NPI + NSI; it += NGW) {
        const bool sample = it >= NPI; const int q = sample ? it - NPI : it; const int chunk = q / 11, cgp = q - chunk * 11;
        const int col = cgp * 256 + 4 * lane;
        const float4 wg0 = *(const float4*)(cw + col), wg1 = *(const float4*)(cw + FF2 + col), wg2 = *(const float4*)(cw + 2 * FF2 + col), bg = *(const float4*)(cb + col);
        const float4 wu0 = *(const float4*)(cw + FF + col), wu1 = *(const float4*)(cw + FF2 + FF + col), wu2 = *(const float4*)(cw + 2 * FF2 + FF + col), bu = *(const float4*)(cb + FF + col);
        float g2[4], g1[4], u2[4], u1[4];
        int row0, nrows;
        if (!sample) {
            row0 = chunk * 32; nrows = 32;
            if ((row0 & (TP - 1)) == 0) {
#pragma unroll
                for (int j = 0; j < 4; ++j) { g2[j] = 0.f; g1[j] = 0.f; u2[j] = 0.f; u1[j] = 0.f; }
            } else {
                const bf16_t* hp = halo + (size_t)chunk * 2 * FF2;
                const uint2 a = *(const uint2*)(hp + col), c2 = *(const uint2*)(hp + FF2 + col), e = *(const uint2*)(hp + FF + col), f = *(const uint2*)(hp + FF2 + FF + col);
                g2[0] = bflo(a.x); g2[1] = bfhi(a.x); g2[2] = bflo(a.y); g2[3] = bfhi(a.y); g1[0] = bflo(c2.x); g1[1] = bfhi(c2.x); g1[2] = bflo(c2.y); g1[3] = bfhi(c2.y);
                u2[0] = bflo(e.x); u2[1] = bfhi(e.x); u2[2] = bflo(e.y); u2[3] = bfhi(e.y); u1[0] = bflo(f.x); u1[1] = bfhi(f.x); u1[2] = bflo(f.y); u1[3] = bfhi(f.y);
            }
        } else {
            row0 = MP + chunk * TS; nrows = TS;
            const float* sp = p.in[I_SCONV] + (size_t)chunk * 2 * FF2;
            const float4 a = *(const float4*)(sp + col), c2 = *(const float4*)(sp + FF2 + col), e = *(const float4*)(sp + FF + col), f = *(const float4*)(sp + FF2 + FF + col);
            g2[0] = a.x; g2[1] = a.y; g2[2] = a.z; g2[3] = a.w; g1[0] = c2.x; g1[1] = c2.y; g1[2] = c2.z; g1[3] = c2.w;
            u2[0] = e.x; u2[1] = e.y; u2[2] = e.z; u2[3] = e.w; u1[0] = f.x; u1[1] = f.y; u1[2] = f.z; u1[3] = f.w;
        }
        const float w0g[4] = {wg0.x, wg0.y, wg0.z, wg0.w}, w1g[4] = {wg1.x, wg1.y, wg1.z, wg1.w}, w2g[4] = {wg2.x, wg2.y, wg2.z, wg2.w}, bgg[4] = {bg.x, bg.y, bg.z, bg.w};
        const float w0u[4] = {wu0.x, wu0.y, wu0.z, wu0.w}, w1u[4] = {wu1.x, wu1.y, wu1.z, wu1.w}, w2u[4] = {wu2.x, wu2.y, wu2.z, wu2.w}, buu[4] = {bu.x, bu.y, bu.z, bu.w};
        for (int r0 = 0; r0 < nrows; r0 += 8) {
            uint2 gv[8], uv[8];
#pragma unroll
            for (int i = 0; i < 8; ++i) { const bf16_t* rp = U + (size_t)(row0 + r0 + i) * FF2 + col; gv[i] = *(const uint2*)rp; uv[i] = *(const uint2*)(rp + FF); }
#pragma unroll
            for (int i = 0; i < 8; ++i) {
                const float gc[4] = {bflo(gv[i].x), bfhi(gv[i].x), bflo(gv[i].y), bfhi(gv[i].y)}, uc[4] = {bflo(uv[i].x), bfhi(uv[i].x), bflo(uv[i].y), bfhi(uv[i].y)};
                float o[4];
#pragma unroll
                for (int j = 0; j < 4; ++j) {
                    const float cgv = w0g[j] * g2[j] + w1g[j] * g1[j] + w2g[j] * gc[j] + bgg[j];
                    const float cuv = w0u[j] * u2[j] + w1u[j] * u1[j] + w2u[j] * uc[j] + buu[j];
                    o[j] = cgv * sigmoidf_(cgv) * cuv;
                    g2[j] = g1[j]; g1[j] = gc[j]; u2[j] = u1[j]; u1[j] = uc[j];
                }
                uint2 w; w.x = pk2(o[0], o[1]); w.y = pk2(o[2], o[3]);
                *(uint2*)(U + (size_t)(row0 + r0 + i) * FF2 + col) = w;
            }
        }
    }
}
__device__ __forceinline__ void phase_final(const Params& p, int tid, int G, int bid) {
    const int wave = tid >> 6, lane = tid & 63, gw = bid * 8 + wave, NGW = G * 8;
    const float* F = (const float*)(p.ws + WS_U) + FF / 2;
    for (int row = gw; row < MB; row += NGW) {
        const float4* fr = (const float4*)(F + (size_t)row * (FF2 / 2)) + lane; float4* yr = (float4*)(p.out + (size_t)row * D) + lane;
        float4 v[4]; float s = 0.f;
#pragma unroll
        for (int j = 0; j < 4; ++j) { v[j] = fr[64 * j]; s += (v[j].x * v[j].x + v[j].y * v[j].y) + (v[j].z * v[j].z + v[j].w * v[j].w); }
        const float rs = rsqrtf(wave_sum(s) * (1.f / D) + 1e-6f);
#pragma unroll
        for (int j = 0; j < 4; ++j) { const float4 gg = *((const float4*)p.in[I_NFPOST] + lane + 64 * j); float4 x = yr[64 * j];
            x.x += v[j].x * rs * gg.x; x.y += v[j].y * rs * gg.y; x.z += v[j].z * rs * gg.z; x.w += v[j].w * rs * gg.w; yr[64 * j] = x; }
    }
}
__device__ __forceinline__ void phase_cachecopy(const Params& p, int tid, int G, int bid) {
    const int gt = bid * NTHREADS + tid, NT = G * NTHREADS;
    constexpr int PER_B = 2048 * 512 / 4;
    const float4* snk = (const float4*)(p.ws + WS_SNEWK); const float4* snv = (const float4*)(p.ws + WS_SNEWV);
    for (int i = gt; i < 2 * BS * PER_B; i += NT) {
        const int which = i >= BS * PER_B; const int q = which ? i - BS * PER_B : i; const int b = q / PER_B, r = q - b * PER_B;
        const float4* src = (const float4*)p.in[which ? I_CV : I_CK] + (size_t)b * PER_B;
        float4 v;
        if (r < 2040 * 128) v = src[r + 8 * 128]; else v = (which ? snv : snk)[(size_t)b * TS * 128 + (r - 2040 * 128)];
        ((float4*)(p.out + (which ? O_SV : O_SK)))[(size_t)b * PER_B + r] = v;
    }
}

template <int PH>
__device__ __forceinline__ void run_phase(const Params& p, LAS unsigned char* lds, int tid, int G, int bid) {
    if constexpr (PH == 0) { phase0(p, lds, tid, G, bid); __syncthreads(); }
    else if constexpr (PH == 1) {
        pg8::Gemm g{(const bf16_t*)((const unsigned char*)p.out + SC_B), (const bf16_t*)(p.ws + WS_WIN), MA, DIN, D, D}; pg8::StaticOrder S; S.init(MA, DIN, G, bid);
        EpiProj E{(bf16_t*)(p.ws + WS_PROJRW), (bf16_t*)(p.ws + WS_Q), (bf16_t*)(p.ws + WS_K), (bf16_t*)(p.ws + WS_VROW), (bf16_t*)(p.ws + WS_VT4), (bf16_t*)(p.ws + WS_VT16),
                  (const float*)(p.ws + WS_ROPE), p.out, (float*)(p.ws + WS_SNEWK), (float*)(p.ws + WS_SNEWV)};
        pg8::gemm_phase<EpiProj, pg8::StaticOrder, false>(lds, g, S, E, nullptr);
    } else if constexpr (PH == 2) { phase_alora(p, tid, G, bid); phase_vtrans(p, lds, tid, G, bid); }
    else if constexpr (PH == 3) {
        pg8::Gemm g{(const bf16_t*)(p.ws + WS_ALORA), (const bf16_t*)(p.ws + WS_WLORA), MB, NLORA, KLORA, KLORA}; pg8::StaticOrder S; S.init(MB, NLORA, G, bid);
        EpiDag E{(bf16_t*)((unsigned char*)p.out + SC_B), p.in[I_W0], p.in[I_A0]};
        pg8::gemm_phase<EpiDag, pg8::StaticOrder, false>(lds, g, S, E, nullptr);
    } else if constexpr (PH == 4 || PH == 11 || PH == 12) {
        const int NSCAN = 128;
        if (bid < NSCAN) {
            if constexpr (PH != 12) {
                scan_item(p, lds, tid, false, bid >> 4, (bid >> 1) & 7, bid & 1);
                for (int it = bid; it < 512; it += NSCAN) scan_item(p, lds, tid, true, it >> 4, (it >> 1) & 7, it & 1);
            }
        }
        if (PH == 4 || (PH == 12 && bid >= NSCAN)) {
            const int wave = tid >> 6, lane = tid & 63, x = bid & 7;
            unsigned* ctr = (unsigned*)(p.ws + WS_BAR) + (PH == 4 ? 16 : 32) + x;
            for (;;) {
                unsigned id = 0; if (lane == 0) id = __hip_atomic_fetch_add(ctr, 1u, __ATOMIC_RELAXED, __HIP_MEMORY_SCOPE_AGENT);
                id = (unsigned)__builtin_amdgcn_readfirstlane((int)id);
                if (id >= 2048u + 256u) break;
                if (id < 2048u) { const int ig = id >> 7, hh = (id >> 4) & 7, r16 = id & 15; attn_task(p, (x << 11) | (hh << 8) | (r16 << 4) | ig, lane); }
                else { const int s = id - 2048; attn_sample_task(p, ((4 * x + (s >> 6)) << 6) | (s & 63), lane, (LAS float*)(lds + wave * 4096)); }
            }
        }
    } else if constexpr (PH == 5) {
        pg8::Gemm g{(const bf16_t*)((const unsigned char*)p.out + SC_C), (const bf16_t*)(p.ws + WS_WOUT), MB, D, D, D}; pg8::StaticOrder S; S.init(MB, D, G, bid);
        pg8::EpiF32 E{(float*)((unsigned char*)p.out + SC_B), D, nullptr};
        pg8::gemm_phase<pg8::EpiF32, pg8::StaticOrder, false>(lds, g, S, E, nullptr);
    } else if constexpr (PH == 6) phase_norm1(p, tid, G, bid);
    else if constexpr (PH == 7) {
        pg8::Gemm g{(const bf16_t*)((const unsigned char*)p.out + SC_C), (const bf16_t*)(p.ws + WS_WUP), MB, FF2, D, D}; pg8::StaticOrder S; S.init(MB, FF2, G, bid);
        EpiUp E{(bf16_t*)(p.ws + WS_U), (bf16_t*)(p.ws + WS_HALO), p.out};
        pg8::gemm_phase<EpiUp, pg8::StaticOrder, false>(lds, g, S, E, nullptr);
    } else if constexpr (PH == 8) phase_act(p, tid, G, bid);
    else if constexpr (PH == 9) {
        pg8::Gemm g{(const bf16_t*)(p.ws + WS_U), (const bf16_t*)(p.ws + WS_WDN), MB, D, FF, FF2}; pg8::StaticOrder S; S.init(MB, D, G, bid);
        pg8::EpiF32 E{(float*)(p.ws + WS_U) + FF / 2, FF2 / 2, nullptr};
        pg8::gemm_phase<pg8::EpiF32, pg8::StaticOrder, false>(lds, g, S, E, nullptr);
    } else if constexpr (PH == 10) { phase_final(p, tid, G, bid); phase_cachecopy(p, tid, G, bid); }
    else if constexpr (PH == 13) phase_wkvfin(p, tid, G, bid);
}
__device__ __forceinline__ void grid_bar(unsigned* ctr, unsigned target) {
    asm volatile("s_waitcnt vmcnt(0)" ::: "memory");
    __syncthreads();
    if (threadIdx.x == 0) {
        __builtin_amdgcn_fence(__ATOMIC_RELEASE, "agent");
        asm volatile("s_waitcnt vmcnt(0)" ::: "memory");
        __hip_atomic_fetch_add(ctr, 1u, __ATOMIC_RELAXED, __HIP_MEMORY_SCOPE_AGENT);
        while (__hip_atomic_load(ctr, __ATOMIC_RELAXED, __HIP_MEMORY_SCOPE_AGENT) < target) __builtin_amdgcn_s_sleep(2);
        __builtin_amdgcn_fence(__ATOMIC_ACQUIRE, "agent");
        asm volatile("s_waitcnt vmcnt(0)" ::: "memory");
    }
    __syncthreads();
}
template <int SEAM, int FIRST, int... REST>
__device__ __forceinline__ void run_program(const Params& p, LAS unsigned char* lds, cg::grid_group& grid, int tid, int G, int bid) {
    if (p.en > (int)sizeof...(REST) - 1000) run_phase<FIRST>(p, lds, tid, G, bid);
    if constexpr (sizeof...(REST) > 0) {
        if constexpr (SEAM == 0) grid.sync(); else grid_bar((unsigned*)(p.ws + WS_BAR), (unsigned)(SEAM * G));
        run_program<SEAM + 1, REST...>(p, lds, grid, tid, G, bid);
    }
}
#define PROGRAM 0, 1, 2, 3, 4, 13, 5, 6, 7, 8, 9, 10
__global__ void __launch_bounds__(NTHREADS, 2) hymba_fwd(Params p) {
    extern __shared__ __attribute__((aligned(16))) unsigned char lds_raw[];
    LAS unsigned char* lds = (LAS unsigned char*)lds_raw;
    cg::grid_group grid = cg::this_grid();
    run_program<0, PROGRAM>(p, lds, grid, threadIdx.x, gridDim.x, blockIdx.x);
}

extern "C" void kernel_launch(void* const* d_in, const int* in_sizes, int n_in, void* d_out, int out_size, void* d_ws, size_t ws_size, hipStream_t stream) {
    static int grid = 0;
    if (grid == 0) {
        if (n_in != 28 || (size_t)out_size != O_END || ws_size < WS_TOTAL) { fprintf(stderr, "kernel_launch: unexpected sizes n_in %d out %d ws %zu (need %zu)\n", n_in, out_size, ws_size, (size_t)WS_TOTAL); grid = -1; return; }
        int dev = 0, cus = 0, per_cu = 0;
        hipGetDevice(&dev); hipDeviceGetAttribute(&cus, hipDeviceAttributeMultiprocessorCount, dev);
        if (hipFuncSetAttribute((const void*)hymba_fwd, hipFuncAttributeMaxDynamicSharedMemorySize, LDS_BYTES) != hipSuccess) { fprintf(stderr, "kernel_launch: hipFuncSetAttribute failed\n"); grid = -1; return; }
        hipOccupancyMaxActiveBlocksPerMultiprocessor(&per_cu, (const void*)hymba_fwd, NTHREADS, LDS_BYTES);
        (void)hipGetLastError();
        if (per_cu < 1) per_cu = 1;
        grid = cus;
    }
    if (grid < 0) return;
    Params p{};
    for (int i = 0; i < 28; ++i) p.in[i] = (const float*)d_in[i];
    p.out = (float*)d_out; p.ws = (unsigned char*)d_ws; p.en = 1;
    if (hipMemsetAsync((unsigned char*)d_ws + WS_BAR, 0, 256, stream) != hipSuccess) { fprintf(stderr, "kernel_launch: memset of the barrier word failed\n"); return; }
    void* args[] = {&p};
    hipError_t e = hipLaunchCooperativeKernel((const void*)hymba_fwd, dim3(grid), dim3(NTHREADS), args, LDS_BYTES, stream);
    if (e != hipSuccess) fprintf(stderr, "cooperative launch failed: %s (grid %d)\n", hipGetErrorString(e), grid);
}
```

```cpp
#include <hip/hip_runtime.h>
#include <hip/hip_cooperative_groups.h>
#include <cstdio>
#include <cstdint>
namespace pg8 {
#define PG8_LAS __attribute__((address_space(3)))
typedef unsigned short bf16_t;
typedef short bf16x8 __attribute__((ext_vector_type(8)));
typedef float f32x4 __attribute__((ext_vector_type(4)));
typedef unsigned u32x4 __attribute__((ext_vector_type(4)));
constexpr int BM = 256, BK = 64, HALF = 128, HTB = HALF * BK * 2  , STAGE_BYTES = 8 * HTB, NXCD = 8, WGM = 8;

__host__ __device__ __forceinline__ int lds_byte(int r, int c) { const int st = (r >> 4) * 2 + (c >> 5), rr = r & 15, cc = c & 31, ob = rr * 64 + cc * 2; return st * 1024 + (ob ^ (((ob >> 9) & 1) << 5)); }
__host__ __device__ __forceinline__ void stage_rc(int b, int& R, int& C) { const int st = b / 1024, sb = b % 1024, swz = sb ^ (((sb >> 9) & 1) << 5); R = (st >> 1) * 16 + swz / 64; C = (st & 1) * 32 + (swz % 64) / 2; }
__host__ __device__ __forceinline__ int perm32(int rho) { const int n = rho >> 4, i = rho & 15; return 8 * (i >> 2) + 4 * n + (i & 3); }

struct Unit { int pm, pn; };
struct Gemm { const bf16_t* A; const bf16_t* Bt; int M, N, K, lda; };

struct StaticOrder {
    int nM, nN, nwg, G, c;
    __host__ __device__ void init(int M, int N, int G_, int c_) { nM = M / BM; nN = N / BM; nwg = nM * nN; G = G_; c = c_; }
    __host__ __device__ bool next(int i, Unit& u) const {
        const long L = (long)i * G + c; if (L >= nwg) return false;
        int wgid = (int)L; { const int q = nwg / NXCD, r = nwg % NXCD, xcd = wgid % NXCD, off = wgid / NXCD; wgid = (xcd < r ? xcd * (q + 1) : r * (q + 1) + (xcd - r) * q) + off; }
        const int nig = WGM * nN, gid = wgid / nig, fm = gid * WGM, gsz = (nM - fm) < WGM ? (nM - fm) : WGM;
        u.pm = fm + ((wgid % nig) % gsz); u.pn = (wgid % nig) / gsz; return true;
    }
    __device__ __forceinline__ void a_ready(const Unit&) const {}
    __device__ __forceinline__ void done(const Unit&) const {}
};
__device__ __forceinline__ unsigned cvt_pk_bf16(float lo, float hi) { unsigned r; asm volatile("v_cvt_pk_bf16_f32 %0, %1, %2" : "=v"(r) : "v"(lo), "v"(hi)); return r; }
typedef float f32x2 __attribute__((ext_vector_type(2)));
struct EpiF32 {
    static constexpr bool PERM = false, AFTER_DRAIN = false;
    float* C; int ldc; const float* bias;
    __device__ __forceinline__ void operator()(const f32x4 (&acc)[2][2][4][2], const Unit& u, int wr, int wc, int fr, int fq) const {
        const int row0 = u.pm * BM + wr * 64 + fr, col0 = u.pn * BM + wc * 32 + 4 * fq;
        f32x4 bv[2][2];
#pragma unroll
        for (int bj = 0; bj < 2; ++bj)
#pragma unroll
            for (int n = 0; n < 2; ++n) bv[bj][n] = bias ? *(const f32x4*)(bias + col0 + bj * HALF + n * 16) : (f32x4){0.f, 0.f, 0.f, 0.f};
#pragma unroll
        for (int ai = 0; ai < 2; ++ai)
#pragma unroll
            for (int m = 0; m < 4; ++m) { float* rowp = C + (size_t)(row0 + ai * HALF + m * 16) * ldc + col0;
#pragma unroll
                for (int bj = 0; bj < 2; ++bj)
#pragma unroll
                    for (int n = 0; n < 2; ++n) *(f32x4*)(rowp + bj * HALF + n * 16) = acc[ai][bj][m][n] + bv[bj][n]; }
    }
};
template <class Epi, class Sched, bool STAMP = false>
__device__ __forceinline__ void gemm_phase(PG8_LAS unsigned char* lds, const Gemm g, const Sched& S, const Epi& E, unsigned long long* stamps) {
    const int tid = threadIdx.x, wid = __builtin_amdgcn_readfirstlane(tid >> 6), lane = tid & 63, wr = wid >> 2, wc = wid & 3, fr = lane & 15, fq = lane >> 4;
    const int K = g.K, nt = K / BK;
    int ts_lo = 0, ts_hi = 0, nts = 0; const unsigned long long rt_entry = STAMP ? (unsigned long long)wall_clock64() : 0ull;
#define PG8_STAMP() do { if (STAMP && wid == 0 && nts < 64) { const unsigned long long _c = (unsigned long long)clock64(); \
        ts_lo = (lane == nts) ? (int)(unsigned)_c : ts_lo; ts_hi = (lane == nts) ? (int)(unsigned)(_c >> 32) : ts_hi; ++nts; } } while (0)
    PG8_STAMP();
    unsigned voffA[2], voffB[2];
#pragma unroll
    for (int i = 0; i < 2; ++i) { int R, C; stage_rc(tid * 16 + i * 8192, R, C); const int Rb = Epi::PERM ? ((R & ~31) + perm32(R & 31)) : R;
        voffA[i] = (unsigned)(R * g.lda + C) * 2u; voffB[i] = (unsigned)(Rb * K + C) * 2u; }
    const size_t kstep = (size_t)(BK * 2);
    const size_t hstep = (size_t)HALF * K * 2, hstepA = (size_t)HALF * g.lda * 2;
    const size_t tstep = 2 * hstep, tstepA = 2 * hstepA;
    const unsigned ldsw = (unsigned)wid * 1024u;
    const int aoff = lds_byte(wr * 64 + fr, fq * 8), boff = lds_byte(wc * 32 + fr, fq * 8);
#define PG8_SA(b, h) (((b) * 2 + (h)) * HTB)
#define PG8_SB(b, h) ((4 + (b) * 2 + (h)) * HTB)
#define PG8_STAGE(bufoff, gbase, voff) do { _Pragma("unroll") for (int _i = 0; _i < 2; ++_i) \
        __builtin_amdgcn_global_load_lds((const unsigned*)((const char*)(gbase) + (voff)[_i]), (PG8_LAS unsigned*)(lds + (bufoff) + ldsw + _i * 8192), 16, 0, 0); } while (0)
#define PG8_LDA(dst, b, h) do { _Pragma("unroll") for (int m = 0; m < 4; ++m) _Pragma("unroll") for (int k = 0; k < 2; ++k) dst[m][k] = *(const PG8_LAS bf16x8*)(lds + PG8_SA(b, h) + aoff + m * 2048 + k * 1024); } while (0)
#define PG8_LDB(dst, b, h) do { _Pragma("unroll") for (int n = 0; n < 2; ++n) _Pragma("unroll") for (int k = 0; k < 2; ++k) dst[n][k] = *(const PG8_LAS bf16x8*)(lds + PG8_SB(b, h) + boff + n * 2048 + k * 1024); } while (0)
#define PG8_MMA(ai, bj, At, Bt) do { __builtin_amdgcn_s_setprio(1); _Pragma("unroll") for (int m = 0; m < 4; ++m) _Pragma("unroll") for (int n = 0; n < 2; ++n) _Pragma("unroll") for (int k = 0; k < 2; ++k) \
        acc[ai][bj][m][n] = __builtin_amdgcn_mfma_f32_16x16x32_bf16(Bt[n][k], At[m][k], acc[ai][bj][m][n], 0, 0, 0); __builtin_amdgcn_s_setprio(0); } while (0)
#define PG8_WAIT_V(n) asm volatile("s_waitcnt vmcnt(" #n ")" ::: "memory")
#define PG8_WAIT_L(n) asm volatile("s_waitcnt lgkmcnt(" #n ")" ::: "memory")
#define PG8_BAR __builtin_amdgcn_s_barrier()
#define PG8_SCHED __builtin_amdgcn_sched_barrier(0)
    Unit cur, nxt; int ui = 0;
    if (!S.next(0, cur)) return;
    f32x4 acc[2][2][4][2];
#pragma unroll
    for (int a = 0; a < 2; ++a)
#pragma unroll
        for (int b = 0; b < 2; ++b)
#pragma unroll
            for (int m = 0; m < 4; ++m)
#pragma unroll
                for (int n = 0; n < 2; ++n) acc[a][b][m][n] = (f32x4){0.f, 0.f, 0.f, 0.f};
    bf16x8 At[4][2], B0[2][2], B1[2][2];
    const char* cA = (const char*)g.A + (size_t)cur.pm * tstepA; const char* cB = (const char*)g.Bt + (size_t)cur.pn * tstep;
    S.a_ready(cur);
    PG8_STAGE(PG8_SB(0, 0), cB, voffB); PG8_STAGE(PG8_SA(0, 0), cA, voffA); PG8_STAGE(PG8_SB(0, 1), cB + hstep, voffB); PG8_STAGE(PG8_SA(0, 1), cA + hstepA, voffA);
    if (wr == 1) PG8_BAR;
    PG8_WAIT_V(4); PG8_BAR;
    PG8_STAGE(PG8_SB(1, 0), cB + kstep, voffB); PG8_STAGE(PG8_SA(1, 0), cA + kstep, voffA); PG8_STAGE(PG8_SB(1, 1), cB + hstep + kstep, voffB);
    PG8_WAIT_V(6); PG8_BAR;
    PG8_STAMP();
    for (;;) {
        const bool has_next = S.next(ui + 1, nxt);
        const char* nA = has_next ? (const char*)g.A + (size_t)nxt.pm * tstepA : cA; const char* nB = has_next ? (const char*)g.Bt + (size_t)nxt.pn * tstep : cB;
        for (int t = 0; t < nt; t += 2) {
            const bool last = (t == nt - 2);
            const char* a1 = cA + (size_t)(t + 1) * kstep;
            const char* a2 = last ? nA : cA + (size_t)(t + 2) * kstep; const char* b2 = last ? nB : cB + (size_t)(t + 2) * kstep;
            const char* a3 = a2 + kstep; const char* b3 = b2 + kstep;
            if (last && has_next) S.a_ready(nxt);
            PG8_LDB(B0, 0, 0); PG8_SCHED; PG8_LDA(At, 0, 0); PG8_STAGE(PG8_SA(1, 1), a1 + hstepA, voffA);
            PG8_WAIT_L(8); PG8_BAR; PG8_WAIT_L(0); PG8_MMA(0, 0, At, B0); PG8_BAR; PG8_SCHED;
            PG8_LDB(B1, 0, 1); PG8_STAGE(PG8_SB(0, 0), b2, voffB);
            PG8_BAR; PG8_WAIT_L(0); PG8_MMA(0, 1, At, B1); PG8_BAR;
            PG8_LDA(At, 0, 1); PG8_STAGE(PG8_SA(0, 0), a2, voffA);
            PG8_BAR; PG8_WAIT_L(0); PG8_MMA(1, 0, At, B0); PG8_BAR; PG8_SCHED;
            PG8_STAGE(PG8_SB(0, 1), b2 + hstep, voffB);
            PG8_WAIT_V(6); PG8_BAR; PG8_MMA(1, 1, At, B1); PG8_BAR;
            PG8_LDB(B0, 1, 0); PG8_SCHED; PG8_LDA(At, 1, 0); PG8_STAGE(PG8_SA(0, 1), a2 + hstepA, voffA);
            PG8_WAIT_L(8); PG8_BAR; PG8_WAIT_L(0); PG8_MMA(0, 0, At, B0); PG8_BAR; PG8_SCHED;
            PG8_LDB(B1, 1, 1); PG8_STAGE(PG8_SB(1, 0), b3, voffB);
            PG8_BAR; PG8_WAIT_L(0); PG8_MMA(0, 1, At, B1); PG8_BAR;
            PG8_LDA(At, 1, 1); PG8_STAGE(PG8_SA(1, 0), a3, voffA);
            PG8_BAR; PG8_WAIT_L(0); PG8_MMA(1, 0, At, B0); PG8_BAR; PG8_SCHED;
            PG8_STAGE(PG8_SB(1, 1), b3 + hstep, voffB);
            PG8_WAIT_V(6); PG8_BAR; PG8_MMA(1, 1, At, B1); PG8_BAR;
        }
        PG8_STAMP();
        if constexpr (!Epi::AFTER_DRAIN) { E(acc, cur, wr, wc, fr, fq); S.done(cur); }
        PG8_STAMP();
        if (!has_next) break;
#pragma unroll
        for (int a = 0; a < 2; ++a)
#pragma unroll
            for (int b = 0; b < 2; ++b)
#pragma unroll
                for (int m = 0; m < 4; ++m)
#pragma unroll
                    for (int n = 0; n < 2; ++n) acc[a][b][m][n] = (f32x4){0.f, 0.f, 0.f, 0.f};
        cur = nxt; cA = nA; cB = nB; ++ui;
    }
    PG8_WAIT_V(0);
    if (wr == 0) PG8_BAR;
    PG8_BAR;
    if constexpr (Epi::AFTER_DRAIN) { E.fused(acc, cur, wr, wc, fr, fq, lds, wid, lane); S.done(cur); }
    PG8_STAMP();
    if (STAMP && wid == 0) { stamps[lane] = lane < nts ? (((unsigned long long)(unsigned)ts_hi << 32) | (unsigned)ts_lo) : 0ull;
        if (lane == 62) stamps[62] = rt_entry; if (lane == 63) stamps[63] = (unsigned long long)wall_clock64(); }
#undef PG8_STAMP
#undef PG8_SA
#undef PG8_SB
#undef PG8_STAGE
#undef PG8_LDA
#undef PG8_LDB
#undef PG8_MMA
#undef PG8_WAIT_V
#undef PG8_WAIT_L
#undef PG8_BAR
#undef PG8_SCHED
}
}

namespace cg = cooperative_groups;
#define LAS __attribute__((address_space(3)))
typedef unsigned short bf16_t;
typedef unsigned int u32;
typedef pg8::bf16x8 bf16x8;
typedef pg8::f32x4 f32x4;
typedef pg8::u32x4 u32x4;

constexpr int D = 1024, TP = 4096, BP = 8, MP = BP * TP, BS = 32, TS = 8, MS = BS * TS;
constexpr int MB = MP + MS;
constexpr int MA = 33280;
constexpr int MA_REAL = MP + BS * 9;
constexpr int DIN = 3328, RCOLS = 1792, FF = 2816, FF2 = 5632, NLORA = 1536, KLORA = 256;
constexpr int NTHREADS = 512;
constexpr int LDS_BYTES = 144 * 1024;

constexpr size_t O_YP = 0;
constexpr size_t O_YS = O_YP + (size_t)MP * D;
constexpr size_t O_PSH = O_YS + (size_t)MS * D;
constexpr size_t O_PWKV = O_PSH + (size_t)BP * D;
constexpr size_t O_PK = O_PWKV + (size_t)BP * 8 * 64 * 64;
constexpr size_t O_PV = O_PK + (size_t)BP * 2048 * 512;
constexpr size_t O_PCONV = O_PV + (size_t)BP * 2048 * 512;
constexpr size_t O_SSH = O_PCONV + (size_t)BP * 2 * FF2;
constexpr size_t O_SWKV = O_SSH + (size_t)BS * D;
constexpr size_t O_SK = O_SWKV + (size_t)BS * 8 * 64 * 64;
constexpr size_t O_SV = O_SK + (size_t)BS * 2048 * 512;
constexpr size_t O_SCONV = O_SV + (size_t)BS * 2048 * 512;
constexpr size_t O_END = O_SCONV + (size_t)BS * 2 * FF2;

constexpr size_t al256(size_t x) { return (x + 255) & ~(size_t)255; }
constexpr size_t WS_WIN = 0;
constexpr size_t WS_WOUT = WS_WIN + al256((size_t)DIN * D * 2);
constexpr size_t WS_WUP = WS_WOUT + al256((size_t)D * D * 2);
constexpr size_t WS_WDN = WS_WUP + al256((size_t)FF2 * D * 2);
constexpr size_t WS_WLORA = WS_WDN + al256((size_t)D * FF * 2);
constexpr size_t WS_ROPE = WS_WLORA + al256((size_t)NLORA * KLORA * 2);
constexpr int NPOS = 4104;
constexpr size_t WS_SNEWK = WS_ROPE + al256((size_t)NPOS * 32 * 2 * 4);
constexpr size_t WS_SNEWV = WS_SNEWK + al256((size_t)MS * 512 * 4);
constexpr size_t WS_HALO = WS_SNEWV + al256((size_t)MS * 512 * 4);
constexpr size_t WS_A = WS_HALO + al256((size_t)1025 * 2 * FF2 * 2);
constexpr size_t WS_PROJRW = WS_A;
constexpr size_t WS_Q = WS_PROJRW + al256((size_t)MA * RCOLS * 2);
constexpr size_t WS_K = WS_Q + al256((size_t)MB * 512 * 2);
constexpr size_t WS_VT1 = WS_K + al256((size_t)MB * 512 * 2);
constexpr size_t WS_VT4 = WS_VT1 + al256((size_t)BP * 8 * 64 * TP * 2);
constexpr size_t WS_VT16 = WS_VT4 + al256((size_t)BP * 8 * 64 * TP * 2);
constexpr size_t WS_ALORA = WS_VT16 + al256((size_t)BP * 8 * 64 * TP * 2);
constexpr size_t WS_VROW = WS_ALORA + al256((size_t)MB * KLORA * 2);
constexpr size_t WS_A_EARLY_END = WS_VROW + al256((size_t)MP * 512 * 2);
constexpr size_t WS_U = WS_A;
constexpr size_t WS_END = WS_A + al256((size_t)MB * FF2 * 2);
static_assert(WS_A_EARLY_END <= WS_END, "region A overflow");
constexpr size_t WS_BAR = WS_END;
constexpr size_t WS_TOTAL = WS_END + 256;
constexpr size_t WS_Y = WS_ALORA;
static_assert(WS_Y + (size_t)MB * 512 * 4 <= WS_END, "Y overflow");
constexpr size_t SC_B = O_SK * 4;
constexpr size_t SC_C = SC_B + al256((size_t)MB * D * 4);
static_assert(SC_C + (size_t)MB * D * 2 <= O_SCONV * 4, "scratch overflow");
static_assert((size_t)MA * D * 2 <= (size_t)MB * D * 4 && (size_t)MB * NLORA * 2 <= (size_t)MB * D * 4, "region B");

struct Params {
    const float* in[28];
    float* out;
    unsigned char* ws;
    int en, pad;
};

enum { I_XP = 0, I_XS, I_SSHIFT, I_SWKV, I_CK, I_CV, I_SCONV, I_NMPRE, I_NMPOST, I_NFPRE, I_NFPOST, I_WIN, I_MU, I_W0, I_WDEC, I_A0, I_WICLR, I_WGATE,
       I_KK, I_KA, I_RK, I_LNW, I_LNB, I_WOUT, I_WUP, I_CONVW, I_CONVB, I_WDN };

__device__ __forceinline__ float bflo(u32 p) { return __uint_as_float(p << 16); }
__device__ __forceinline__ float bfhi(u32 p) { return __uint_as_float(p & 0xffff0000u); }
__device__ __forceinline__ u32 pk2(float a, float b) { return pg8::cvt_pk_bf16(a, b); }
__device__ __forceinline__ float wave_sum(float v) {
#pragma unroll
    for (int o = 1; o < 64; o <<= 1) v += __shfl_xor(v, o);
    return v;
}
template <int N> __device__ __forceinline__ float dpp_ror(float x) {
    return __int_as_float(__builtin_amdgcn_update_dpp(0, __float_as_int(x), 0x120 + N, 0xF, 0xF, false));
}
__device__ __forceinline__ float row16_sum(float x) {
    x += dpp_ror<8>(x); x += dpp_ror<4>(x); x += dpp_ror<2>(x); x += dpp_ror<1>(x);
    return x;
}
__device__ __forceinline__ void row16_sum4(float& a, float& b, float& c, float& d) {
    asm volatile("s_nop 1\n\t"
                 "v_add_f32_dpp %0, %0, %0 row_ror:8 row_mask:0xf bank_mask:0xf\n\t" "v_add_f32_dpp %1, %1, %1 row_ror:8 row_mask:0xf bank_mask:0xf\n\t"
                 "v_add_f32_dpp %2, %2, %2 row_ror:8 row_mask:0xf bank_mask:0xf\n\t" "v_add_f32_dpp %3, %3, %3 row_ror:8 row_mask:0xf bank_mask:0xf\n\t"
                 "v_add_f32_dpp %0, %0, %0 row_ror:4 row_mask:0xf bank_mask:0xf\n\t" "v_add_f32_dpp %1, %1, %1 row_ror:4 row_mask:0xf bank_mask:0xf\n\t"
                 "v_add_f32_dpp %2, %2, %2 row_ror:4 row_mask:0xf bank_mask:0xf\n\t" "v_add_f32_dpp %3, %3, %3 row_ror:4 row_mask:0xf bank_mask:0xf\n\t"
                 "v_add_f32_dpp %0, %0, %0 row_ror:2 row_mask:0xf bank_mask:0xf\n\t" "v_add_f32_dpp %1, %1, %1 row_ror:2 row_mask:0xf bank_mask:0xf\n\t"
                 "v_add_f32_dpp %2, %2, %2 row_ror:2 row_mask:0xf bank_mask:0xf\n\t" "v_add_f32_dpp %3, %3, %3 row_ror:2 row_mask:0xf bank_mask:0xf\n\t"
                 "v_add_f32_dpp %0, %0, %0 row_ror:1 row_mask:0xf bank_mask:0xf\n\t" "v_add_f32_dpp %1, %1, %1 row_ror:1 row_mask:0xf bank_mask:0xf\n\t"
                 "v_add_f32_dpp %2, %2, %2 row_ror:1 row_mask:0xf bank_mask:0xf\n\t" "v_add_f32_dpp %3, %3, %3 row_ror:1 row_mask:0xf bank_mask:0xf\n\t"
                 "s_nop 1"
                 : "+v"(a), "+v"(b), "+v"(c), "+v"(d));
}
__device__ __forceinline__ float fma_(float a, float b, float c) { float d; asm("v_fma_f32 %0, %1, %2, %3" : "=v"(d) : "v"(a), "v"(b), "v"(c)); return d; }
__device__ __forceinline__ float mul_(float a, float b) { float d; asm("v_mul_f32 %0, %1, %2" : "=v"(d) : "v"(a), "v"(b)); return d; }
__device__ __forceinline__ void row16_sum2_mul4(float& a, float& b, float (&t)[4], float v, float k0, float k1, float k2, float k3) {
    asm volatile("v_mul_f32 %2, %6, %7\n\t" "v_mul_f32 %3, %6, %8\n\t"
                 "v_add_f32_dpp %0, %0, %0 row_ror:8 row_mask:0xf bank_mask:0xf\n\t" "v_add_f32_dpp %1, %1, %1 row_ror:8 row_mask:0xf bank_mask:0xf\n\t"
                 "v_mul_f32 %4, %6, %9\n\t"
                 "v_add_f32_dpp %0, %0, %0 row_ror:4 row_mask:0xf bank_mask:0xf\n\t" "v_add_f32_dpp %1, %1, %1 row_ror:4 row_mask:0xf bank_mask:0xf\n\t"
                 "v_mul_f32 %5, %6, %10\n\t"
                 "v_add_f32_dpp %0, %0, %0 row_ror:2 row_mask:0xf bank_mask:0xf\n\t" "v_add_f32_dpp %1, %1, %1 row_ror:2 row_mask:0xf bank_mask:0xf\n\t"
                 "s_nop 0\n\t"
                 "v_add_f32_dpp %0, %0, %0 row_ror:1 row_mask:0xf bank_mask:0xf\n\t" "v_add_f32_dpp %1, %1, %1 row_ror:1 row_mask:0xf bank_mask:0xf"
                 : "+v"(a), "+v"(b), "=&v"(t[0]), "=&v"(t[1]), "=&v"(t[2]), "=&v"(t[3])
                 : "v"(v), "v"(k0), "v"(k1), "v"(k2), "v"(k3));
}
__device__ __forceinline__ void row16_sum2(float& a, float& b) {
    asm volatile("s_nop 1\n\t"
                 "v_add_f32_dpp %0, %0, %0 row_ror:8 row_mask:0xf bank_mask:0xf\n\t" "v_add_f32_dpp %1, %1, %1 row_ror:8 row_mask:0xf bank_mask:0xf\n\t" "s_nop 0\n\t"
                 "v_add_f32_dpp %0, %0, %0 row_ror:4 row_mask:0xf bank_mask:0xf\n\t" "v_add_f32_dpp %1, %1, %1 row_ror:4 row_mask:0xf bank_mask:0xf\n\t" "s_nop 0\n\t"
                 "v_add_f32_dpp %0, %0, %0 row_ror:2 row_mask:0xf bank_mask:0xf\n\t" "v_add_f32_dpp %1, %1, %1 row_ror:2 row_mask:0xf bank_mask:0xf\n\t" "s_nop 0\n\t"
                 "v_add_f32_dpp %0, %0, %0 row_ror:1 row_mask:0xf bank_mask:0xf\n\t" "v_add_f32_dpp %1, %1, %1 row_ror:1 row_mask:0xf bank_mask:0xf\n\t"
                 "s_nop 1"
                 : "+v"(a), "+v"(b));
}
__device__ __forceinline__ float sigmoidf_(float x) { return 1.f / (1.f + __expf(-x)); }

__device__ __forceinline__ int win_rowmap(int n) {
    if (n < RCOLS || n >= RCOLS + 1024) return n;
    const int base = (n < RCOLS + 512) ? RCOLS : RCOLS + 512, c = n - base, unit = c >> 8, cu = c & 255, hu = cu >> 6, d = cu & 63, e = d & 31, s = d >> 5;
    const int idx = hu * 32 + e, bj = idx >> 6, wc = (idx & 63) >> 4, fq = (idx & 15) >> 2, j = idx & 3;
    return base + unit * 256 + 128 * bj + 32 * wc + 16 * s + 4 * fq + j;
}
__device__ __forceinline__ void transpose_item(const float* W, int K, int N, bf16_t* WT, int mode, LAS float* scr, int item, int lane) {
    const int nblk = N / 32, kb = item / nblk, nb = item % nblk, k0 = 64 * kb, n0 = 32 * nb;
#pragma unroll 8
    for (int i = 0; i < 32; ++i) { const int kk = 2 * i + (lane >> 5); scr[kk * 33 + (lane & 31)] = W[(size_t)(k0 + kk) * N + n0 + (lane & 31)]; }
    asm volatile("s_waitcnt lgkmcnt(0)" ::: "memory");
    const int c = lane & 7;
#pragma unroll
    for (int j = 0; j < 4; ++j) { const int n = (lane >> 3) + 8 * j; const LAS float* s = scr + (8 * c) * 33 + n;
        uint4 o; o.x = pk2(s[0 * 33], s[1 * 33]); o.y = pk2(s[2 * 33], s[3 * 33]); o.z = pk2(s[4 * 33], s[5 * 33]); o.w = pk2(s[6 * 33], s[7 * 33]);
        const int row = mode ? win_rowmap(n0 + n) : (n0 + n);
        *(uint4*)(WT + (size_t)row * K + k0 + 8 * c) = o; }
    asm volatile("s_waitcnt lgkmcnt(0)" ::: "memory");
}
__device__ __forceinline__ void rms_row(const float* xrow, const float* g, bf16_t* orow, float* frow, int lane) {
    const float4* xr = (const float4*)xrow + lane; const float4* gr = (const float4*)g + lane;
    float4 v[4]; float s = 0.f;
#pragma unroll
    for (int j = 0; j < 4; ++j) { v[j] = xr[64 * j]; s += (v[j].x * v[j].x + v[j].y * v[j].y) + (v[j].z * v[j].z + v[j].w * v[j].w); }
    const float rs = rsqrtf(wave_sum(s) * (1.f / D) + 1e-6f);
#pragma unroll
    for (int j = 0; j < 4; ++j) { const float4 gg = gr[64 * j];
        float4 y; y.x = v[j].x * rs * gg.x; y.y = v[j].y * rs * gg.y; y.z = v[j].z * rs * gg.z; y.w = v[j].w * rs * gg.w;
        uint2 o; o.x = pk2(y.x, y.y); o.y = pk2(y.z, y.w);
        *((uint2*)orow + lane + 64 * j) = o;
        if (frow) *((float4*)frow + lane + 64 * j) = y; }
}
__device__ __forceinline__ void phase0(const Params& p, LAS unsigned char* lds, int tid, int G, int bid) {
    const int wave = tid >> 6, lane = tid & 63, gw = bid * 8 + wave, NGW = G * 8;
    LAS float* scr = (LAS float*)(lds + wave * 16384);
    bf16_t* WinT = (bf16_t*)(p.ws + WS_WIN); bf16_t* WoutT = (bf16_t*)(p.ws + WS_WOUT); bf16_t* WupT = (bf16_t*)(p.ws + WS_WUP); bf16_t* WdnT = (bf16_t*)(p.ws + WS_WDN);
    constexpr int I1 = (D / 64) * (DIN / 32), I2 = (D / 64) * (D / 32), I3 = (D / 64) * (FF2 / 32), I4 = (FF / 64) * (D / 32);
    for (int it = gw; it < I1 + I2 + I3 + I4; it += NGW) {
        int r = it;
        if (r < I1) { transpose_item(p.in[I_WIN], D, DIN, WinT, 1, scr, r, lane); continue; } r -= I1;
        if (r < I2) { transpose_item(p.in[I_WOUT], D, D, WoutT, 0, scr, r, lane); continue; } r -= I2;
        if (r < I3) { transpose_item(p.in[I_WUP], D, FF2, WupT, 0, scr, r, lane); continue; } r -= I3;
        transpose_item(p.in[I_WDN], FF, D, WdnT, 0, scr, r, lane);
    }
    const int gt = bid * NTHREADS + tid, NT = G * NTHREADS;
    bf16_t* WL = (bf16_t*)(p.ws + WS_WLORA);
    for (int i = gt; i < NLORA * KLORA; i += NT) {
        const int row = i >> 8, k = i & 255; float v = 0.f;
        if (row < 512) { if (k < 64) v = p.in[I_WDEC][k * 512 + row]; }
        else if (row < 1024) { if (k >= 64 && k < 128) v = p.in[I_WICLR][(k - 64) * 512 + (row - 512)]; }
        else { if (k >= 128) v = p.in[I_WGATE][(k - 128) * 512 + (row - 1024)]; }
        WL[i] = (bf16_t)(pk2(v, 0.f) & 0xffffu);
    }
    float* rope = (float*)(p.ws + WS_ROPE);
    for (int i = gt; i < NPOS * 32; i += NT) {
        const int pi = i >> 5, e = i & 31; const int pos = pi < TP ? pi : 16384 + (pi - TP);
        double inv = 1.0; for (int q = 0; q < e; ++q) inv *= 0.7498942093324558273;
        const float ang = (float)pos * (float)inv;
        const double a = (double)ang; const double kq = rint(a * 0.15915494309189535); double r = a - kq * 6.283185307179586; r -= kq * 2.4492935982947064e-16;
        const double r2 = r * r;
        double sn = 1.0 / 51090942171709440000.0;
        sn = sn * r2 * (-1.0) + 1.0 / 121645100408832000.0;
        sn = -sn * r2 + 1.0 / 355687428096000.0;
        sn = -sn * r2 + 1.0 / 1307674368000.0;
        sn = -sn * r2 + 1.0 / 6227020800.0;
        sn = -sn * r2 + 1.0 / 39916800.0;
        sn = -sn * r2 + 1.0 / 362880.0;
        sn = -sn * r2 + 1.0 / 5040.0;
        sn = -sn * r2 + 1.0 / 120.0;
        sn = -sn * r2 + 1.0 / 6.0;
        sn = -sn * r2 + 1.0;
        sn *= r;
        double cs = 1.0 / 1124000727777607680000.0;
        cs = -cs * r2 + 1.0 / 2432902008176640000.0;
        cs = -cs * r2 + 1.0 / 6402373705728000.0;
        cs = -cs * r2 + 1.0 / 20922789888000.0;
        cs = -cs * r2 + 1.0 / 87178291200.0;
        cs = -cs * r2 + 1.0 / 479001600.0;
        cs = -cs * r2 + 1.0 / 3628800.0;
        cs = -cs * r2 + 1.0 / 40320.0;
        cs = -cs * r2 + 1.0 / 720.0;
        cs = -cs * r2 + 1.0 / 24.0;
        cs = -cs * r2 + 0.5;
        cs = -cs * r2 + 1.0;
        rope[i] = (float)cs; rope[NPOS * 32 + i] = (float)sn;
    }
    bf16_t* H = (bf16_t*)((unsigned char*)p.out + SC_B);
    for (int row = gw; row < MA; row += NGW) {
        bf16_t* orow = H + (size_t)row * D;
        if (row < MP) {
            const bool last = (row & (TP - 1)) == TP - 1;
            rms_row(p.in[I_XP] + (size_t)row * D, p.in[I_NMPRE], orow, last ? p.out + O_PSH + (size_t)(row >> 12) * D : nullptr, lane);
        } else {
            const int s = row - MP;
            if (s < BS * 9) {
                const int b = s / 9, j = s - b * 9;
                if (j == 0) {
                    const float4* sr = (const float4*)(p.in[I_SSHIFT] + (size_t)b * D) + lane;
#pragma unroll
                    for (int q = 0; q < 4; ++q) { const float4 v = sr[64 * q]; uint2 o; o.x = pk2(v.x, v.y); o.y = pk2(v.z, v.w); *((uint2*)orow + lane + 64 * q) = o; }
                } else {
                    rms_row(p.in[I_XS] + (size_t)(b * TS + j - 1) * D, p.in[I_NMPRE], orow, j == TS ? p.out + O_SSH + (size_t)b * D : nullptr, lane);
                }
            } else {
#pragma unroll
                for (int q = 0; q < 4; ++q) *((uint2*)orow + lane + 64 * q) = make_uint2(0u, 0u);
            }
        }
    }
}

struct EpiProj {
    static constexpr bool PERM = false, AFTER_DRAIN = false;
    bf16_t* projrw; bf16_t* Q; bf16_t* K; bf16_t* VT1; bf16_t* VT4; bf16_t* VT16; const float* rope; float* out; float* snewk; float* snewv;
    __device__ __forceinline__ void operator()(const f32x4 (&acc)[2][2][4][2], const pg8::Unit& u, int wr, int wc, int fr, int fq) const {
        const int pn = u.pn;
        if (pn < 7) {
#pragma unroll
            for (int ai = 0; ai < 2; ++ai)
#pragma unroll
                for (int m = 0; m < 4; ++m) { const int row = u.pm * 256 + ai * 128 + wr * 64 + m * 16 + fr;
                    bf16_t* rp = projrw + (size_t)row * RCOLS + pn * 256 + wc * 32 + 4 * fq;
#pragma unroll
                    for (int bj = 0; bj < 2; ++bj)
#pragma unroll
                        for (int n = 0; n < 2; ++n) { const f32x4 v = acc[ai][bj][m][n]; uint2 o; o.x = pk2(v[0], v[1]); o.y = pk2(v[2], v[3]); *(uint2*)(rp + bj * 128 + n * 16) = o; } }
            return;
        }
#pragma unroll
        for (int ai = 0; ai < 2; ++ai)
#pragma unroll
            for (int m = 0; m < 4; ++m) {
                const int row = u.pm * 256 + ai * 128 + wr * 64 + m * 16 + fr;
                bool prompt = row < MP; int b, t, rowB, pi; bool valid = true;
                if (prompt) { b = row >> 12; t = row & (TP - 1); rowB = row; pi = t; }
                else { const int s = row - MP; b = s / 9; const int j = s - b * 9; valid = (s < BS * 9) && (j > 0); t = j - 1; rowB = MP + b * TS + t; pi = TP + t; }
                if (!valid) continue;
                if (pn < 11) {
                    const bool isq = pn < 9; const int unit = isq ? pn - 7 : pn - 9;
#pragma unroll
                    for (int bj = 0; bj < 2; ++bj) {
                        const int idx = bj * 64 + wc * 16 + fq * 4, hu = idx >> 5, e = idx & 31;
                        const float4 cs = *(const float4*)(rope + (size_t)pi * 32 + e), sn = *(const float4*)(rope + (size_t)NPOS * 32 + (size_t)pi * 32 + e);
                        const f32x4 x1 = acc[ai][bj][m][0], x2 = acc[ai][bj][m][1];
                        float o1[4], o2[4];
                        o1[0] = x1[0] * cs.x - x2[0] * sn.x; o2[0] = x1[0] * sn.x + x2[0] * cs.x;
                        o1[1] = x1[1] * cs.y - x2[1] * sn.y; o2[1] = x1[1] * sn.y + x2[1] * cs.y;
                        o1[2] = x1[2] * cs.z - x2[2] * sn.z; o2[2] = x1[2] * sn.z + x2[2] * cs.z;
                        o1[3] = x1[3] * cs.w - x2[3] * sn.w; o2[3] = x1[3] * sn.w + x2[3] * cs.w;
                        const int col = unit * 256 + hu * 64 + e;
                        if (isq) {
                            uint2 a, c2; a.x = pk2(o1[0] * 0.125f, o1[1] * 0.125f); a.y = pk2(o1[2] * 0.125f, o1[3] * 0.125f); c2.x = pk2(o2[0] * 0.125f, o2[1] * 0.125f); c2.y = pk2(o2[2] * 0.125f, o2[3] * 0.125f);
                            *(uint2*)(Q + (size_t)rowB * 512 + col) = a; *(uint2*)(Q + (size_t)rowB * 512 + col + 32) = c2;
                        } else {
                            uint2 a, c2; a.x = pk2(o1[0], o1[1]); a.y = pk2(o1[2], o1[3]); c2.x = pk2(o2[0], o2[1]); c2.y = pk2(o2[2], o2[3]);
                            *(uint2*)(K + (size_t)rowB * 512 + col) = a; *(uint2*)(K + (size_t)rowB * 512 + col + 32) = c2;
                            float* dst = nullptr;
                            if (prompt) { if (t >= 2048) dst = out + O_PK + ((size_t)b * 2048 + (t - 2048)) * 512 + col; }
                            else dst = snewk + (size_t)(b * TS + t) * 512 + col;
                            if (dst) { *(float4*)dst = make_float4(o1[0], o1[1], o1[2], o1[3]); *(float4*)(dst + 32) = make_float4(o2[0], o2[1], o2[2], o2[3]); }
                        }
                    }
                } else {
#pragma unroll
                    for (int bj = 0; bj < 2; ++bj)
#pragma unroll
                        for (int n = 0; n < 2; ++n) {
                            const int col = (pn - 11) * 256 + bj * 128 + wc * 32 + n * 16 + 4 * fq; const f32x4 v = acc[ai][bj][m][n];
                            if (prompt) {
                                if (t >= 2048) *(float4*)(out + O_PV + ((size_t)b * 2048 + (t - 2048)) * 512 + col) = make_float4(v[0], v[1], v[2], v[3]);
                                uint2 o; o.x = pk2(v[0], v[1]); o.y = pk2(v[2], v[3]); *(uint2*)(VT1 + (size_t)rowB * 512 + col) = o;
                            } else {
                                *(float4*)(snewv + (size_t)(b * TS + t) * 512 + col) = make_float4(v[0], v[1], v[2], v[3]);
                            }
                        }
                }
            }
    }
};
struct EpiDag {
    static constexpr bool PERM = false, AFTER_DRAIN = false;
    bf16_t* dag; const float* w0; const float* a0;
    __device__ __forceinline__ void operator()(const f32x4 (&acc)[2][2][4][2], const pg8::Unit& u, int wr, int wc, int fr, int fq) const {
        const int kind = u.pn >> 1;
#pragma unroll
        for (int bj = 0; bj < 2; ++bj)
#pragma unroll
            for (int n = 0; n < 2; ++n) {
                const int col = u.pn * 256 + bj * 128 + wc * 32 + n * 16 + 4 * fq;
                float4 bias = make_float4(0.f, 0.f, 0.f, 0.f);
                if (kind == 0) bias = *(const float4*)(w0 + col); else if (kind == 1) bias = *(const float4*)(a0 + col - 512);
                const float bb[4] = {bias.x, bias.y, bias.z, bias.w};
#pragma unroll
                for (int ai = 0; ai < 2; ++ai)
#pragma unroll
                    for (int m = 0; m < 4; ++m) { const int row = u.pm * 256 + ai * 128 + wr * 64 + m * 16 + fr; const f32x4 v = acc[ai][bj][m][n]; float o[4];
#pragma unroll
                        for (int j = 0; j < 4; ++j) { const float x = v[j] + bb[j];
                            if (kind == 0) { const float z = -x; const float sp = fmaxf(z, 0.f) + __logf(1.f + __expf(-fabsf(z))); o[j] = -__expf(-sp - 0.5f); }
                            else if (kind == 1) o[j] = sigmoidf_(x);
                            else o[j] = x; }
                        uint2 q; q.x = pk2(o[0], o[1]); q.y = pk2(o[2], o[3]); *(uint2*)(dag + (size_t)row * NLORA + col) = q; }
            }
    }
};
struct EpiUp {
    static constexpr bool PERM = false, AFTER_DRAIN = false;
    bf16_t* U; bf16_t* halo; float* out;
    __device__ __forceinline__ void operator()(const f32x4 (&acc)[2][2][4][2], const pg8::Unit& u, int wr, int wc, int fr, int fq) const {
#pragma unroll
        for (int ai = 0; ai < 2; ++ai)
#pragma unroll
            for (int m = 0; m < 4; ++m) {
                const int row = u.pm * 256 + ai * 128 + wr * 64 + m * 16 + fr; const int col0 = u.pn * 256 + wc * 32 + 4 * fq;
                bf16_t* hrow = nullptr; float* frow = nullptr;
                if (row < MP) { const int t = row & (TP - 1);
                    if ((t & 31) >= 30) hrow = halo + ((size_t)((row >> 5) + 1) * 2 + ((t & 31) - 30)) * FF2;
                    if (t >= TP - 2) frow = out + O_PCONV + ((size_t)(row >> 12) * 2 + (t - (TP - 2))) * FF2;
                } else { const int s = row - MP, b = s >> 3, tt = s & 7; if (tt >= 6) frow = out + O_SCONV + ((size_t)b * 2 + (tt - 6)) * FF2; }
#pragma unroll
                for (int bj = 0; bj < 2; ++bj)
#pragma unroll
                    for (int n = 0; n < 2; ++n) { const f32x4 v = acc[ai][bj][m][n]; const int col = col0 + bj * 128 + n * 16;
                        uint2 o; o.x = pk2(v[0], v[1]); o.y = pk2(v[2], v[3]);
                        *(uint2*)(U + (size_t)row * FF2 + col) = o;
                        if (hrow) *(uint2*)(hrow + col) = o;
                        if (frow) *(float4*)(frow + col) = make_float4(v[0], v[1], v[2], v[3]); }
            }
    }
};

__device__ __forceinline__ int rowA_of(int rowB) { return rowB < MP ? rowB : MP + ((rowB - MP) >> 3) * 9 + 1 + ((rowB - MP) & 7); }
__device__ __forceinline__ void phase_alora(const Params& p, int tid, int G, int bid) {
    const bf16_t* PR = (const bf16_t*)(p.ws + WS_PROJRW); bf16_t* AL = (bf16_t*)(p.ws + WS_ALORA); const float* mu = p.in[I_MU];
    const int gt = bid * NTHREADS + tid, NT = G * NTHREADS;
    for (int i = gt; i < MB * 64; i += NT) {
        const int rowB = i >> 6, c = (i & 63) * 4, rowA = rowA_of(rowB);
        const uint2 cur = *(const uint2*)(PR + (size_t)rowA * RCOLS + 1536 + c);
        uint2 prv = make_uint2(0u, 0u);
        if (!(rowB < MP && (rowB & (TP - 1)) == 0)) prv = *(const uint2*)(PR + (size_t)(rowA - 1) * RCOLS + 1536 + c);
        const float4 m4 = *(const float4*)(mu + 1536 + c);
        float x[4] = {bflo(cur.x), bfhi(cur.x), bflo(cur.y), bfhi(cur.y)}; const float pv[4] = {bflo(prv.x), bfhi(prv.x), bflo(prv.y), bfhi(prv.y)}; const float mm[4] = {m4.x, m4.y, m4.z, m4.w};
#pragma unroll
        for (int j = 0; j < 4; ++j) { float v = x[j] + (pv[j] - x[j]) * mm[j];
            if (c < 64) v = tanhf(v); else if (c >= 128) v = sigmoidf_(v);
            x[j] = v; }
        uint2 o; o.x = pk2(x[0], x[1]); o.y = pk2(x[2], x[3]);
        *(uint2*)(AL + (size_t)rowB * KLORA + c) = o;
    }
}


__device__ __forceinline__ void phase_vtrans(const Params& p, LAS unsigned char* lds, int tid, int G, int bid) {
    const bf16_t* VR = (const bf16_t*)(p.ws + WS_VROW);
    constexpr int PITCH = 132;
    for (int item = bid; item < BP * 8 * 8; item += G) {
        const int b = item >> 6, h = (item >> 3) & 7, t0 = (item & 7) * 512;
        __syncthreads();
#pragma unroll
        for (int i = 0; i < 8; ++i) { const int piece = tid + 512 * i, row = piece >> 3, c8 = piece & 7;
            const uint4 v = *(const uint4*)(VR + (size_t)(b * TP + t0 + row) * 512 + h * 64 + c8 * 8);
            LAS u32* dst = (LAS u32*)(lds + row * PITCH + c8 * 16); dst[0] = v.x; dst[1] = v.y; dst[2] = v.z; dst[3] = v.w; }
        __syncthreads();
#pragma unroll 1
        for (int lay = 0; lay < 3; ++lay) {
            const int dd = lay == 0 ? 1 : (lay == 1 ? 4 : 16); const int Tdd = TP / dd;
            bf16_t* VT = (bf16_t*)(p.ws + (lay == 0 ? WS_VT1 : (lay == 1 ? WS_VT4 : WS_VT16))) + (size_t)(b * 8 + h) * 64 * TP;
            const int chunk0 = (t0 / dd) >> 5;
#pragma unroll
            for (int i = 0; i < 8; ++i) {
                const int sidx = tid + 512 * i, g = sidx & 3, d = (sidx >> 2) & 63, rc = sidx >> 8;
                int r, cl; if (lay == 0) { r = 0; cl = rc; } else if (lay == 1) { r = rc & 3; cl = rc >> 2; } else { r = rc; cl = 0; }
                u32 w[4];
#pragma unroll
                for (int hf = 0; hf < 2; ++hf)
#pragma unroll
                    for (int jp = 0; jp < 2; ++jp) {
                        const int u5a = 16 * hf + 4 * g + 2 * jp; const int ta = (32 * cl + u5a) * dd + r, tb = ta + dd;
                        const u32 lo = *(const LAS unsigned short*)(lds + ta * PITCH + d * 2), hi = *(const LAS unsigned short*)(lds + tb * PITCH + d * 2);
                        w[hf * 2 + jp] = lo | (hi << 16);
                    }
                *(uint4*)(VT + (size_t)r * Tdd * 64 + (size_t)(chunk0 + cl) * 2048 + d * 32 + 8 * g) = make_uint4(w[0], w[1], w[2], w[3]);
            }
        }
    }
    __syncthreads();
}

constexpr int CH = 32;
constexpr int SST = 452;
constexpr int SI_W = 0, SI_A = 64, SI_B = 128, SI_K = 192, SI_WR = 256, SI_V = 320, SI_G = 384, SI_SC = 448;
struct PrepRegs { uint2 cr, ck, cv, pr, pk, pv, dw, da, dg; };
__device__ __forceinline__ void scan_item(const Params& p, LAS unsigned char* lds, int tid, bool sample, int b, int h, int half) {
    const bf16_t* PR = (const bf16_t*)(p.ws + WS_PROJRW); const bf16_t* DAG = (const bf16_t*)((const unsigned char*)p.out + SC_B);
    float* YG = (float*)(p.ws + WS_Y);
    LAS float* buf0 = (LAS float*)lds; LAS float* buf1 = buf0 + CH * SST; LAS float* ybuf = buf1 + CH * SST;
    const int T = sample ? TS : TP;
    const int rowB0 = sample ? MP + b * TS : b * TP;
    const int rowA0 = sample ? MP + b * 9 + 1 : b * TP;
    const int nch = (T + CH - 1) / CH;
    const int ptl = tid >> 4, pj = (tid & 15) * 4, pc = h * 64 + pj;
    const int lane = tid & 63, wv = tid >> 6, rg = wv * 4 + (lane >> 4), cgi = lane & 15;
    const int row = 32 * half + rg;
    float st[4];
    if (sample) {
        const float4 a = *(const float4*)(p.in[I_SWKV] + ((size_t)(b * 8 + h) * 64 + row) * 64 + 4 * cgi);
        st[0] = a.x; st[1] = a.y; st[2] = a.z; st[3] = a.w;
    } else {
#pragma unroll
        for (int j = 0; j < 4; ++j) st[j] = 0.f;
    }
    const float4 mur = *(const float4*)(p.in[I_MU] + pc), muk = *(const float4*)(p.in[I_MU] + 512 + pc), muv = *(const float4*)(p.in[I_MU] + 1024 + pc);
    const float4 kk4 = *(const float4*)(p.in[I_KK] + pc), ka4 = *(const float4*)(p.in[I_KA] + pc), rk4 = *(const float4*)(p.in[I_RK] + pc);
    __builtin_amdgcn_s_waitcnt(0x0F70);
    PrepRegs R;
#define SCAN_LOAD(chunk) do { const int t_ = (chunk) * CH + ptl; if (t_ < T) { const size_t ra = (size_t)(rowA0 + t_) * RCOLS + pc; const size_t rb = (size_t)(rowB0 + t_) * NLORA + pc; \
        R.cr = *(const uint2*)(PR + ra); R.ck = *(const uint2*)(PR + ra + 512); R.cv = *(const uint2*)(PR + ra + 1024); \
        if (!sample && t_ == 0) { R.pr = make_uint2(0u, 0u); R.pk = R.pr; R.pv = R.pr; } \
        else { R.pr = *(const uint2*)(PR + ra - RCOLS); R.pk = *(const uint2*)(PR + ra - RCOLS + 512); R.pv = *(const uint2*)(PR + ra - RCOLS + 1024); } \
        R.dw = *(const uint2*)(DAG + rb); R.da = *(const uint2*)(DAG + rb + 512); R.dg = *(const uint2*)(DAG + rb + 1024); } } while (0)
#define SCAN_PREP(chunk, dstbuf) do { const int t_ = (chunk) * CH + ptl; if (t_ < T) { \
        const float mr[4] = {mur.x, mur.y, mur.z, mur.w}, mk[4] = {muk.x, muk.y, muk.z, muk.w}, mv[4] = {muv.x, muv.y, muv.z, muv.w}; \
        const float kkc[4] = {kk4.x, kk4.y, kk4.z, kk4.w}, kac[4] = {ka4.x, ka4.y, ka4.z, ka4.w}, rkc[4] = {rk4.x, rk4.y, rk4.z, rk4.w}; \
        const float crr[4] = {bflo(R.cr.x), bfhi(R.cr.x), bflo(R.cr.y), bfhi(R.cr.y)}, ckk[4] = {bflo(R.ck.x), bfhi(R.ck.x), bflo(R.ck.y), bfhi(R.ck.y)}, cvv[4] = {bflo(R.cv.x), bfhi(R.cv.x), bflo(R.cv.y), bfhi(R.cv.y)}; \
        const float prr[4] = {bflo(R.pr.x), bfhi(R.pr.x), bflo(R.pr.y), bfhi(R.pr.y)}, pkk[4] = {bflo(R.pk.x), bfhi(R.pk.x), bflo(R.pk.y), bfhi(R.pk.y)}, pvv[4] = {bflo(R.pv.x), bfhi(R.pv.x), bflo(R.pv.y), bfhi(R.pv.y)}; \
        const float lw[4] = {bflo(R.dw.x), bfhi(R.dw.x), bflo(R.dw.y), bfhi(R.dw.y)}, aa[4] = {bflo(R.da.x), bfhi(R.da.x), bflo(R.da.y), bfhi(R.da.y)}, gg[4] = {bflo(R.dg.x), bfhi(R.dg.x), bflo(R.dg.y), bfhi(R.dg.y)}; \
        float r_[4], k_[4], v_[4], w_[4], kn[4], k2[4]; float nrm = 0.f; \
        _Pragma("unroll") for (int j = 0; j < 4; ++j) { r_[j] = crr[j] + (prr[j] - crr[j]) * mr[j]; k_[j] = ckk[j] + (pkk[j] - ckk[j]) * mk[j]; v_[j] = cvv[j] + (pvv[j] - cvv[j]) * mv[j]; \
            w_[j] = __expf(lw[j]); kn[j] = k_[j] * kkc[j]; nrm += kn[j] * kn[j]; k2[j] = k_[j] * (1.f + (aa[j] - 1.f) * kac[j]); } \
        nrm = row16_sum(nrm); const float inv = 1.f / fmaxf(sqrtf(nrm), 1e-12f); \
        float br = 0.f, kr = 0.f, rk = 0.f; float an[4], bn[4], wrr[4]; \
        _Pragma("unroll") for (int j = 0; j < 4; ++j) { const float kkn = kn[j] * inv; an[j] = -kkn; bn[j] = kkn * aa[j]; wrr[j] = w_[j] * r_[j]; br += bn[j] * r_[j]; kr += k2[j] * r_[j]; rk += r_[j] * k2[j] * rkc[j]; } \
        br = row16_sum(br); kr = row16_sum(kr); rk = row16_sum(rk); \
        LAS float* rec = (dstbuf) + ptl * SST; \
        *(LAS f32x4*)(rec + SI_W + pj) = (f32x4){w_[0], w_[1], w_[2], w_[3]}; *(LAS f32x4*)(rec + SI_A + pj) = (f32x4){an[0], an[1], an[2], an[3]}; \
        *(LAS f32x4*)(rec + SI_B + pj) = (f32x4){bn[0], bn[1], bn[2], bn[3]}; *(LAS f32x4*)(rec + SI_K + pj) = (f32x4){k2[0], k2[1], k2[2], k2[3]}; \
        *(LAS f32x4*)(rec + SI_WR + pj) = (f32x4){wrr[0], wrr[1], wrr[2], wrr[3]}; *(LAS f32x4*)(rec + SI_V + pj) = (f32x4){v_[0], v_[1], v_[2], v_[3]}; \
        *(LAS f32x4*)(rec + SI_G + pj) = (f32x4){gg[0], gg[1], gg[2], gg[3]}; \
        if ((tid & 15) == 0) *(LAS f32x4*)(rec + SI_SC) = (f32x4){br, kr, rk, 0.f}; } } while (0)

    SCAN_LOAD(0);
    SCAN_PREP(0, buf0);
    __syncthreads();
    for (int c = 0; c < nch; ++c) {
        LAS float* cur = (c & 1) ? buf1 : buf0; LAS float* nxt = (c & 1) ? buf0 : buf1;
        if (c + 1 < nch) SCAN_LOAD(c + 1);
        const int ns = (T - c * CH) < CH ? (T - c * CH) : CH;
        {
            const LAS float* rec = cur;
            f32x4 wA = *(const LAS f32x4*)(rec + SI_W + 4 * cgi), aA = *(const LAS f32x4*)(rec + SI_A + 4 * cgi), bA = *(const LAS f32x4*)(rec + SI_B + 4 * cgi);
            f32x4 kA = *(const LAS f32x4*)(rec + SI_K + 4 * cgi), rA = *(const LAS f32x4*)(rec + SI_WR + 4 * cgi);
            float vA = rec[SI_V + row]; pg8::f32x2 cA = *(const LAS pg8::f32x2*)(rec + SI_SC);
            f32x4 wB, aB, bB, kB, rB; float vB; pg8::f32x2 cB;
#define SCAN_FETCH(W, A, B, K, R, V, C) do { rec += SST; W = *(const LAS f32x4*)(rec + SI_W + 4 * cgi); A = *(const LAS f32x4*)(rec + SI_A + 4 * cgi); B = *(const LAS f32x4*)(rec + SI_B + 4 * cgi); \
            K = *(const LAS f32x4*)(rec + SI_K + 4 * cgi); R = *(const LAS f32x4*)(rec + SI_WR + 4 * cgi); V = rec[SI_V + row]; C = *(const LAS pg8::f32x2*)(rec + SI_SC); } while (0)
#define SCAN_STEP(W, A, B, K, R, V, C, qq) do { \
            float da = mul_(st[0], A[0]); float dw = mul_(st[0], R[0]); \
            da = fma_(st[1], A[1], da); dw = fma_(st[1], R[1], dw); da = fma_(st[2], A[2], da); dw = fma_(st[2], R[2], dw); da = fma_(st[3], A[3], da); dw = fma_(st[3], R[3], dw); \
            float tt_[4]; row16_sum2_mul4(da, dw, tt_, V, K[0], K[1], K[2], K[3]); \
            const float y = fma_(V, C[1], fma_(da, C[0], dw)); \
            _Pragma("unroll") for (int j = 0; j < 4; ++j) st[j] = fma_(st[j], W[j], fma_(da, B[j], tt_[j])); \
            yk = ((qq) == cgi) ? y : yk; } while (0)
            for (int tb = 0; tb < ns; tb += 16) {
                const int nq = (ns - tb) < 16 ? (ns - tb) : 16;
                float yk = 0.f;
                for (int q = 0; q < nq; q += 2) {
                    SCAN_FETCH(wB, aB, bB, kB, rB, vB, cB);
                    SCAN_STEP(wA, aA, bA, kA, rA, vA, cA, q);
                    SCAN_FETCH(wA, aA, bA, kA, rA, vA, cA);
                    SCAN_STEP(wB, aB, bB, kB, rB, vB, cB, q + 1);
                }
                ybuf[(tb + cgi) * 32 + rg] = yk;
            }
#undef SCAN_FETCH
#undef SCAN_STEP
        }
        __syncthreads();
        if (ptl < ns) {
            const pg8::f32x2 y2 = *(const LAS pg8::f32x2*)(ybuf + ptl * 32 + 2 * (tid & 15));
            *(float2*)(YG + (size_t)(rowB0 + c * CH + ptl) * 512 + h * 64 + 32 * half + 2 * (tid & 15)) = make_float2(y2[0], y2[1]);
        }
        if (c + 1 < nch) SCAN_PREP(c + 1, nxt);
        __syncthreads();
    }
#undef SCAN_LOAD
#undef SCAN_PREP
    float* So = p.out + (sample ? O_SWKV : O_PWKV) + ((size_t)(b * 8 + h) * 64 + row) * 64 + 4 * cgi;
    *(float4*)So = make_float4(st[0], st[1], st[2], st[3]);
}

__device__ __forceinline__ void phase_wkvfin(const Params& p, int tid, int G, int bid) {
    const bf16_t* PR = (const bf16_t*)(p.ws + WS_PROJRW); const bf16_t* DAG = (const bf16_t*)((const unsigned char*)p.out + SC_B);
    const float* YG = (const float*)(p.ws + WS_Y); bf16_t* MIX = (bf16_t*)((unsigned char*)p.out + SC_C);
    const int gt = bid * NTHREADS + tid, NT = G * NTHREADS;
    for (int i = gt; i < MB * 128; i += NT) {
        const int jq = i & 15, h = (i >> 4) & 7, rowB = i >> 7, pc = h * 64 + jq * 4, rowA = rowA_of(rowB);
        const size_t ra = (size_t)rowA * RCOLS + pc;
        const uint2 cr = *(const uint2*)(PR + ra), ck = *(const uint2*)(PR + ra + 512), cv = *(const uint2*)(PR + ra + 1024);
        uint2 pr = make_uint2(0u, 0u), pk = pr, pv = pr;
        if (!(rowB < MP && (rowB & (TP - 1)) == 0)) { pr = *(const uint2*)(PR + ra - RCOLS); pk = *(const uint2*)(PR + ra - RCOLS + 512); pv = *(const uint2*)(PR + ra - RCOLS + 1024); }
        const uint2 da = *(const uint2*)(DAG + (size_t)rowB * NLORA + 512 + pc), dg = *(const uint2*)(DAG + (size_t)rowB * NLORA + 1024 + pc);
        const float4 y4 = *(const float4*)(YG + (size_t)rowB * 512 + pc);
        const float4 mur = *(const float4*)(p.in[I_MU] + pc), muk = *(const float4*)(p.in[I_MU] + 512 + pc), muv = *(const float4*)(p.in[I_MU] + 1024 + pc);
        const float4 ka4 = *(const float4*)(p.in[I_KA] + pc), rk4 = *(const float4*)(p.in[I_RK] + pc), lw4 = *(const float4*)(p.in[I_LNW] + pc), lb4 = *(const float4*)(p.in[I_LNB] + pc);
        const float mr[4] = {mur.x, mur.y, mur.z, mur.w}, mk[4] = {muk.x, muk.y, muk.z, muk.w}, mv[4] = {muv.x, muv.y, muv.z, muv.w};
        const float kac[4] = {ka4.x, ka4.y, ka4.z, ka4.w}, rkc[4] = {rk4.x, rk4.y, rk4.z, rk4.w}, lw[4] = {lw4.x, lw4.y, lw4.z, lw4.w}, lb[4] = {lb4.x, lb4.y, lb4.z, lb4.w};
        const float crr[4] = {bflo(cr.x), bfhi(cr.x), bflo(cr.y), bfhi(cr.y)}, ckk[4] = {bflo(ck.x), bfhi(ck.x), bflo(ck.y), bfhi(ck.y)}, cvv[4] = {bflo(cv.x), bfhi(cv.x), bflo(cv.y), bfhi(cv.y)};
        const float prr[4] = {bflo(pr.x), bfhi(pr.x), bflo(pr.y), bfhi(pr.y)}, pkk[4] = {bflo(pk.x), bfhi(pk.x), bflo(pk.y), bfhi(pk.y)}, pvv[4] = {bflo(pv.x), bfhi(pv.x), bflo(pv.y), bfhi(pv.y)};
        const float aa[4] = {bflo(da.x), bfhi(da.x), bflo(da.y), bfhi(da.y)}, gg[4] = {bflo(dg.x), bfhi(dg.x), bflo(dg.y), bfhi(dg.y)};
        const float yy[4] = {y4.x, y4.y, y4.z, y4.w};
        float v_[4]; float rk = 0.f;
#pragma unroll
        for (int j = 0; j < 4; ++j) { const float r_ = crr[j] + (prr[j] - crr[j]) * mr[j], k_ = ckk[j] + (pkk[j] - ckk[j]) * mk[j]; v_[j] = cvv[j] + (pvv[j] - cvv[j]) * mv[j];
            const float k2 = k_ * (1.f + (aa[j] - 1.f) * kac[j]); rk += r_ * k2 * rkc[j]; }
        rk = row16_sum(rk);
        const float mean = row16_sum((yy[0] + yy[1]) + (yy[2] + yy[3])) * (1.f / 64.f);
        float d[4]; float vs = 0.f;
#pragma unroll
        for (int j = 0; j < 4; ++j) { d[j] = yy[j] - mean; vs += d[j] * d[j]; }
        const float rs = rsqrtf(row16_sum(vs) * (1.f / 64.f) + 64e-5f);
        float o[4];
#pragma unroll
        for (int j = 0; j < 4; ++j) o[j] = (d[j] * rs * lw[j] + lb[j] + rk * v_[j]) * gg[j];
        uint2 w; w.x = pk2(o[0], o[1]); w.y = pk2(o[2], o[3]);
        *(uint2*)(MIX + (size_t)rowB * D + pc) = w;
    }
}

__device__ __forceinline__ void attn_task(const Params& p, int task, int lane) {
    const bf16_t* Q = (const bf16_t*)(p.ws + WS_Q); const bf16_t* K = (const bf16_t*)(p.ws + WS_K);
    bf16_t* MIX = (bf16_t*)((unsigned char*)p.out + SC_C);
    const int b = task >> 11, h = (task >> 8) & 7, r16 = (task >> 4) & 15, ig = task & 15;
    const int li = lane & 15, g = lane >> 4;
    const int tq = r16 + 16 * (16 * ig + li);
    const bf16_t* qp = Q + (size_t)(b * TP + tq) * 512 + h * 64 + 8 * g;
    const bf16x8 qf0 = *(const bf16x8*)qp, qf1 = *(const bf16x8*)(qp + 32);
    float m_run = -1e30f, l_run = 0.f;
    f32x4 o[4];
#pragma unroll
    for (int i = 0; i < 4; ++i) o[i] = (f32x4){0.f, 0.f, 0.f, 0.f};
#pragma unroll 1
    for (int br = 0; br < 3; ++br) {
        int dd, r, uq0, Tdd; const bf16_t* VT;
        if (br == 0) { dd = 16; r = r16; uq0 = 16 * ig; Tdd = TP / 16; VT = (const bf16_t*)(p.ws + WS_VT16); }
        else if (br == 1) { dd = 4; r = r16 & 3; uq0 = (r16 >> 2) + 64 * ig; Tdd = TP / 4; VT = (const bf16_t*)(p.ws + WS_VT4); }
        else { dd = 1; r = 0; uq0 = r16 + 256 * ig; Tdd = TP; VT = (const bf16_t*)(p.ws + WS_VT1); }
        const int s = 16 / dd, uq = uq0 + s * li;
        int ulo = uq0 - 128; if (ulo < 0) ulo = 0; ulo &= ~31;
        const int uhi = uq0 + 15 * s;
        const bf16_t* Kb = K + ((size_t)b * TP + r) * 512 + h * 64 + 8 * g;
        const bf16_t* Vb = VT + (size_t)(b * 8 + h) * 64 * TP + (size_t)r * Tdd * 64 + li * 32 + 8 * g;
        bf16x8 kx0, kx1, ky0, ky1, vf[4];
        { const bf16_t* kx = Kb + (size_t)(ulo + li) * dd * 512; const bf16_t* ky = kx + (size_t)16 * dd * 512;
          kx0 = *(const bf16x8*)kx; kx1 = *(const bf16x8*)(kx + 32); ky0 = *(const bf16x8*)ky; ky1 = *(const bf16x8*)(ky + 32);
#pragma unroll
          for (int dt = 0; dt < 4; ++dt) vf[dt] = *(const bf16x8*)(Vb + (size_t)(ulo >> 5) * 2048 + dt * 512); }
#pragma unroll 1
        for (int kt = ulo; kt <= uhi; kt += 32) {
            const int ktn = (kt + 32 <= uhi) ? kt + 32 : kt;
            const bf16_t* nkx = Kb + (size_t)(ktn + li) * dd * 512; const bf16_t* nky = nkx + (size_t)16 * dd * 512;
            const bf16x8 nkx0 = *(const bf16x8*)nkx, nkx1 = *(const bf16x8*)(nkx + 32), nky0 = *(const bf16x8*)nky, nky1 = *(const bf16x8*)(nky + 32);
            bf16x8 nvf[4];
#pragma unroll
            for (int dt = 0; dt < 4; ++dt) nvf[dt] = *(const bf16x8*)(Vb + (size_t)(ktn >> 5) * 2048 + dt * 512);
            f32x4 sx = (f32x4){0.f, 0.f, 0.f, 0.f}, sy = (f32x4){0.f, 0.f, 0.f, 0.f};
            sx = __builtin_amdgcn_mfma_f32_16x16x32_bf16(kx0, qf0, sx, 0, 0, 0); sx = __builtin_amdgcn_mfma_f32_16x16x32_bf16(kx1, qf1, sx, 0, 0, 0);
            sy = __builtin_amdgcn_mfma_f32_16x16x32_bf16(ky0, qf0, sy, 0, 0, 0); sy = __builtin_amdgcn_mfma_f32_16x16x32_bf16(ky1, qf1, sy, 0, 0, 0);
            float sv[8]; bool ok[8]; float tmax = -1e30f;
#pragma unroll
            for (int j = 0; j < 4; ++j) { const int dx = uq - (kt + 4 * g + j), dy = dx - 16;
                ok[j] = (unsigned)dx <= 128u; ok[4 + j] = (unsigned)dy <= 128u; sv[j] = ok[j] ? sx[j] : -1e30f; sv[4 + j] = ok[4 + j] ? sy[j] : -1e30f;
                tmax = fmaxf(tmax, fmaxf(sv[j], sv[4 + j])); }
            tmax = fmaxf(tmax, __shfl_xor(tmax, 16)); tmax = fmaxf(tmax, __shfl_xor(tmax, 32));
            const float m_new = fmaxf(m_run, tmax), alpha = __expf(m_run - m_new);
            float pe[8]; float ps = 0.f;
#pragma unroll
            for (int j = 0; j < 8; ++j) { pe[j] = ok[j] ? __expf(sv[j] - m_new) : 0.f; ps += pe[j]; }
            l_run = l_run * alpha + ps; m_run = m_new;
            u32x4 pw; pw[0] = pk2(pe[0], pe[1]); pw[1] = pk2(pe[2], pe[3]); pw[2] = pk2(pe[4], pe[5]); pw[3] = pk2(pe[6], pe[7]);
            const bf16x8 pf = __builtin_bit_cast(bf16x8, pw);
#pragma unroll
            for (int dt = 0; dt < 4; ++dt) { o[dt] *= alpha; o[dt] = __builtin_amdgcn_mfma_f32_16x16x32_bf16(vf[dt], pf, o[dt], 0, 0, 0); }
            kx0 = nkx0; kx1 = nkx1; ky0 = nky0; ky1 = nky1;
#pragma unroll
            for (int dt = 0; dt < 4; ++dt) vf[dt] = nvf[dt];
        }
    }
    float lt = l_run; lt += __shfl_xor(lt, 16); lt += __shfl_xor(lt, 32);
    const float il = 1.f / lt;
    bf16_t* op = MIX + (size_t)(b * TP + tq) * D + 512 + h * 64 + 4 * g;
#pragma unroll
    for (int dt = 0; dt < 4; ++dt) { uint2 w; w.x = pk2(o[dt][0] * il, o[dt][1] * il); w.y = pk2(o[dt][2] * il, o[dt][3] * il); *(uint2*)(op + 16 * dt) = w; }
}
__device__ __forceinline__ void attn_sample_task(const Params& p, int task, int lane, LAS float* wl) {
    const bf16_t* Q = (const bf16_t*)(p.ws + WS_Q); const float* snewk = (const float*)(p.ws + WS_SNEWK); const float* snewv = (const float*)(p.ws + WS_SNEWV);
    const float* CK = p.in[I_CK]; const float* CV = p.in[I_CV];
    bf16_t* MIX = (bf16_t*)((unsigned char*)p.out + SC_C);
    const int b = task >> 6, h = (task >> 3) & 7, tt = task & 7;
    const int rowB = MP + b * TS + tt;
    asm volatile("s_waitcnt lgkmcnt(0)" ::: "memory");
    wl[lane] = bflo((u32)Q[(size_t)rowB * 512 + h * 64 + lane]);
    asm volatile("s_waitcnt lgkmcnt(0)" ::: "memory");
    float mx = -1e30f;
#pragma unroll 1
    for (int c = 0; c < 9; ++c) {
        const int br = c / 3, it = c - br * 3; const int dd = br == 0 ? 1 : (br == 1 ? 4 : 16); const int j = lane + 64 * it;
        const int jc = j <= 128 ? j : 128;
        const int idx = 2048 + tt - jc * dd;
        const float* kr = idx < 2048 ? CK + ((size_t)(b * 2048 + idx) * 8 + h) * 64 : snewk + (size_t)(b * TS + idx - 2048) * 512 + h * 64;
        float s = 0.f;
#pragma unroll
        for (int d4 = 0; d4 < 16; ++d4) { const float4 kv = *(const float4*)(kr + 4 * d4); const f32x4 qv = *(const LAS f32x4*)(wl + 4 * d4);
            s += kv.x * qv[0] + kv.y * qv[1] + kv.z * qv[2] + kv.w * qv[3]; }
        if (j > 128) s = -1e30f;
        wl[64 + c * 64 + lane] = s; mx = fmaxf(mx, s);
    }
#pragma unroll
    for (int o = 1; o < 64; o <<= 1) mx = fmaxf(mx, __shfl_xor(mx, o));
    asm volatile("s_waitcnt lgkmcnt(0)" ::: "memory");
    float ls = 0.f;
#pragma unroll 1
    for (int c = 0; c < 9; ++c) { const float s = wl[64 + c * 64 + lane]; const float e = s > -1e29f ? __expf(s - mx) : 0.f; wl[64 + c * 64 + lane] = e; ls += e; }
    ls = wave_sum(ls);
    asm volatile("s_waitcnt lgkmcnt(0)" ::: "memory");
    float acc = 0.f;
#pragma unroll 1
    for (int c = 0; c < 9; ++c) {
        const int br = c / 3, it = c - br * 3; const int dd = br == 0 ? 1 : (br == 1 ? 4 : 16); const int nj = it < 2 ? 64 : 1;
#pragma unroll 8
        for (int l2 = 0; l2 < nj; ++l2) {
            const int j = l2 + 64 * it; const int idx = 2048 + tt - j * dd;
            const float* vr = idx < 2048 ? CV + ((size_t)(b * 2048 + idx) * 8 + h) * 64 : snewv + (size_t)(b * TS + idx - 2048) * 512 + h * 64;
            acc += wl[64 + c * 64 + l2] * vr[lane];
        }
    }
    const float res = acc / ls;
    const float other = __shfl_xor(res, 1);
    if ((lane & 1) == 0) *(u32*)(MIX + (size_t)rowB * D + 512 + h * 64 + lane) = pk2(res, other);
}

__device__ __forceinline__ void phase_norm1(const Params& p, int tid, int G, int bid) {
    const int wave = tid >> 6, lane = tid & 63, gw = bid * 8 + wave, NGW = G * 8;
    const float* mix = (const float*)((const unsigned char*)p.out + SC_B); bf16_t* H2 = (bf16_t*)((unsigned char*)p.out + SC_C);
    for (int row = gw; row < MB; row += NGW) {
        const float* xrow = row < MP ? p.in[I_XP] + (size_t)row * D : p.in[I_XS] + (size_t)(row - MP) * D;
        const float4* mr = (const float4*)(mix + (size_t)row * D) + lane; const float4* xr = (const float4*)xrow + lane;
        float4 v[4], x[4]; float s = 0.f;
#pragma unroll
        for (int j = 0; j < 4; ++j) { v[j] = mr[64 * j]; x[j] = xr[64 * j]; s += (v[j].x * v[j].x + v[j].y * v[j].y) + (v[j].z * v[j].z + v[j].w * v[j].w); }
        const float rs = rsqrtf(wave_sum(s) * (1.f / D) + 1e-6f);
        float s2 = 0.f;
#pragma unroll
        for (int j = 0; j < 4; ++j) { const float4 gg = *((const float4*)p.in[I_NMPOST] + lane + 64 * j);
            x[j].x += v[j].x * rs * gg.x; x[j].y += v[j].y * rs * gg.y; x[j].z += v[j].z * rs * gg.z; x[j].w += v[j].w * rs * gg.w;
            s2 += (x[j].x * x[j].x + x[j].y * x[j].y) + (x[j].z * x[j].z + x[j].w * x[j].w);
            *((float4*)(p.out + (size_t)row * D) + lane + 64 * j) = x[j]; }
        const float rs2 = rsqrtf(wave_sum(s2) * (1.f / D) + 1e-6f);
#pragma unroll
        for (int j = 0; j < 4; ++j) { const float4 gg = *((const float4*)p.in[I_NFPRE] + lane + 64 * j);
            uint2 o; o.x = pk2(x[j].x * rs2 * gg.x, x[j].y * rs2 * gg.y); o.y = pk2(x[j].z * rs2 * gg.z, x[j].w * rs2 * gg.w);
            *((uint2*)(H2 + (size_t)row * D) + lane + 64 * j) = o; }
    }
}
__device__ __forceinline__ void phase_act(const Params& p, int tid, int G, int bid) {
    const int wave = tid >> 6, lane = tid & 63, gw = bid * 8 + wave, NGW = G * 8;
    bf16_t* U = (bf16_t*)(p.ws + WS_U); const bf16_t* halo = (const bf16_t*)(p.ws + WS_HALO);
    const float* cw = p.in[I_CONVW]; const float* cb = p.in[I_CONVB];
    constexpr int NPI = (MP / 32) * 11, NSI = BS * 11;
    for (int it = gw; it < NPI + NSI; it += NGW) {
        const bool sample = it >= NPI; const int q = sample ? it - NPI : it; const int chunk = q / 11, cgp = q - chunk * 11;
        const int col = cgp * 256 + 4 * lane;
        const float4 wg0 = *(const float4*)(cw + col), wg1 = *(const float4*)(cw + FF2 + col), wg2 = *(const float4*)(cw + 2 * FF2 + col), bg = *(const float4*)(cb + col);
        const float4 wu0 = *(const float4*)(cw + FF + col), wu1 = *(const float4*)(cw + FF2 + FF + col), wu2 = *(const float4*)(cw + 2 * FF2 + FF + col), bu = *(const float4*)(cb + FF + col);
        float g2[4], g1[4], u2[4], u1[4];
        int row0, nrows;
        if (!sample) {
            row0 = chunk * 32; nrows = 32;
            if ((row0 & (TP - 1)) == 0) {
#pragma unroll
                for (int j = 0; j < 4; ++j) { g2[j] = 0.f; g1[j] = 0.f; u2[j] = 0.f; u1[j] = 0.f; }
            } else {
                const bf16_t* hp = halo + (size_t)chunk * 2 * FF2;
                const uint2 a = *(const uint2*)(hp + col), c2 = *(const uint2*)(hp + FF2 + col), e = *(const uint2*)(hp + FF + col), f = *(const uint2*)(hp + FF2 + FF + col);
                g2[0] = bflo(a.x); g2[1] = bfhi(a.x); g2[2] = bflo(a.y); g2[3] = bfhi(a.y); g1[0] = bflo(c2.x); g1[1] = bfhi(c2.x); g1[2] = bflo(c2.y); g1[3] = bfhi(c2.y);
                u2[0] = bflo(e.x); u2[1] = bfhi(e.x); u2[2] = bflo(e.y); u2[3] = bfhi(e.y); u1[0] = bflo(f.x); u1[1] = bfhi(f.x); u1[2] = bflo(f.y); u1[3] = bfhi(f.y);
            }
        } else {
            row0 = MP + chunk * TS; nrows = TS;
            const float* sp = p.in[I_SCONV] + (size_t)chunk * 2 * FF2;
            const float4 a = *(const float4*)(sp + col), c2 = *(const float4*)(sp + FF2 + col), e = *(const float4*)(sp + FF + col), f = *(const float4*)(sp + FF2 + FF + col);
            g2[0] = a.x; g2[1] = a.y; g2[2] = a.z; g2[3] = a.w; g1[0] = c2.x; g1[1] = c2.y; g1[2] = c2.z; g1[3] = c2.w;
            u2[0] = e.x; u2[1] = e.y; u2[2] = e.z; u2[3] = e.w; u1[0] = f.x; u1[1] = f.y; u1[2] = f.z; u1[3] = f.w;
        }
        const float w0g[4] = {wg0.x, wg0.y, wg0.z, wg0.w}, w1g[4] = {wg1.x, wg1.y, wg1.z, wg1.w}, w2g[4] = {wg2.x, wg2.y, wg2.z, wg2.w}, bgg[4] = {bg.x, bg.y, bg.z, bg.w};
        const float w0u[4] = {wu0.x, wu0.y, wu0.z, wu0.w}, w1u[4] = {wu1.x, wu1.y, wu1.z, wu1.w}, w2u[4] = {wu2.x, wu2.y, wu2.z, wu2.w}, buu[4] = {bu.x, bu.y, bu.z, bu.w};
        for (int r0 = 0; r0 < nrows; r0 += 8) {
            uint2 gv[8], uv[8];
#pragma unroll
            for (int i = 0; i < 8; ++i) { const bf16_t* rp = U + (size_t)(row0 + r0 + i) * FF2 + col; gv[i] = *(const uint2*)rp; uv[i] = *(const uint2*)(rp + FF); }
#pragma unroll
            for (int i = 0; i < 8; ++i) {
                const float gc[4] = {bflo(gv[i].x), bfhi(gv[i].x), bflo(gv[i].y), bfhi(gv[i].y)}, uc[4] = {bflo(uv[i].x), bfhi(uv[i].x), bflo(uv[i].y), bfhi(uv[i].y)};
                float o[4];
#pragma unroll
                for (int j = 0; j < 4; ++j) {
                    const float cgv = w0g[j] * g2[j] + w1g[j] * g1[j] + w2g[j] * gc[j] + bgg[j];
                    const float cuv = w0u[j] * u2[j] + w1u[j] * u1[j] + w2u[j] * uc[j] + buu[j];
                    o[j] = cgv * sigmoidf_(cgv) * cuv;
                    g2[j] = g1[j]; g1[j] = gc[j]; u2[j] = u1[j]; u1[j] = uc[j];
                }
                uint2 w; w.x = pk2(o[0], o[1]); w.y = pk2(o[2], o[3]);
                *(uint2*)(U + (size_t)(row0 + r0 + i) * FF2 + col) = w;
            }
        }
    }
}
__device__ __forceinline__ void phase_final(const Params& p, int tid, int G, int bid) {
    const int wave = tid >> 6, lane = tid & 63, gw = bid * 8 + wave, NGW = G * 8;
    const float* F = (const float*)(p.ws + WS_U) + FF / 2;
    for (int row = gw; row < MB; row += NGW) {
        const float4* fr = (const float4*)(F + (size_t)row * (FF2 / 2)) + lane; float4* yr = (float4*)(p.out + (size_t)row * D) + lane;
        float4 v[4]; float s = 0.f;
#pragma unroll
        for (int j = 0; j < 4; ++j) { v[j] = fr[64 * j]; s += (v[j].x * v[j].x + v[j].y * v[j].y) + (v[j].z * v[j].z + v[j].w * v[j].w); }
        const float rs = rsqrtf(wave_sum(s) * (1.f / D) + 1e-6f);
#pragma unroll
        for (int j = 0; j < 4; ++j) { const float4 gg = *((const float4*)p.in[I_NFPOST] + lane + 64 * j); float4 x = yr[64 * j];
            x.x += v[j].x * rs * gg.x; x.y += v[j].y * rs * gg.y; x.z += v[j].z * rs * gg.z; x.w += v[j].w * rs * gg.w; yr[64 * j] = x; }
    }
}
__device__ __forceinline__ void phase_cachecopy(const Params& p, int tid, int G, int bid) {
    if (bid < 4) return;
    const int gt = (bid - 4) * NTHREADS + tid, NT = (G - 4) * NTHREADS;
    constexpr int PER_B = 2048 * 512 / 4;
    const float4* snk = (const float4*)(p.ws + WS_SNEWK); const float4* snv = (const float4*)(p.ws + WS_SNEWV);
    for (int i = gt; i < 2 * BS * PER_B; i += NT) {
        const int which = i >= BS * PER_B; const int q = which ? i - BS * PER_B : i; const int b = q / PER_B, r = q - b * PER_B;
        const float4* src = (const float4*)p.in[which ? I_CV : I_CK] + (size_t)b * PER_B;
        float4 v;
        if (r < 2040 * 128) v = src[r + 8 * 128]; else v = (which ? snv : snk)[(size_t)b * TS * 128 + (r - 2040 * 128)];
        ((float4*)(p.out + (which ? O_SV : O_SK)))[(size_t)b * PER_B + r] = v;
    }
}

template <int PH>
__device__ __forceinline__ void run_phase(const Params& p, LAS unsigned char* lds, int tid, int G, int bid) {
    if constexpr (PH == 0) { phase0(p, lds, tid, G, bid); __syncthreads(); }
    else if constexpr (PH == 1) {
        pg8::Gemm g{(const bf16_t*)((const unsigned char*)p.out + SC_B), (const bf16_t*)(p.ws + WS_WIN), MA, DIN, D, D}; pg8::StaticOrder S; S.init(MA, DIN, G, bid);
        EpiProj E{(bf16_t*)(p.ws + WS_PROJRW), (bf16_t*)(p.ws + WS_Q), (bf16_t*)(p.ws + WS_K), (bf16_t*)(p.ws + WS_VROW), (bf16_t*)(p.ws + WS_VT4), (bf16_t*)(p.ws + WS_VT16),
                  (const float*)(p.ws + WS_ROPE), p.out, (float*)(p.ws + WS_SNEWK), (float*)(p.ws + WS_SNEWV)};
        pg8::gemm_phase<EpiProj, pg8::StaticOrder, false>(lds, g, S, E, nullptr);
    } else if constexpr (PH == 2) { phase_alora(p, tid, G, bid); phase_vtrans(p, lds, tid, G, bid); }
    else if constexpr (PH == 3) {
        pg8::Gemm g{(const bf16_t*)(p.ws + WS_ALORA), (const bf16_t*)(p.ws + WS_WLORA), MB, NLORA, KLORA, KLORA}; pg8::StaticOrder S; S.init(MB, NLORA, G, bid);
        EpiDag E{(bf16_t*)((unsigned char*)p.out + SC_B), p.in[I_W0], p.in[I_A0]};
        pg8::gemm_phase<EpiDag, pg8::StaticOrder, false>(lds, g, S, E, nullptr);
    } else if constexpr (PH == 4 || PH == 11 || PH == 12) {
        const int NSCAN = 128;
        if (bid < NSCAN) {
            if constexpr (PH != 12) {
                scan_item(p, lds, tid, false, bid >> 4, (bid >> 1) & 7, bid & 1);
                for (int it = bid; it < 512; it += NSCAN) scan_item(p, lds, tid, true, it >> 4, (it >> 1) & 7, it & 1);
            }
        }
        if (PH == 4 || (PH == 12 && bid >= NSCAN)) {
            const int wave = tid >> 6, lane = tid & 63, x = bid & 7;
            unsigned* ctr = (unsigned*)(p.ws + WS_BAR) + (PH == 4 ? 16 : 32) + x;
            for (;;) {
                unsigned id = 0; if (lane == 0) id = __hip_atomic_fetch_add(ctr, 1u, __ATOMIC_RELAXED, __HIP_MEMORY_SCOPE_AGENT);
                id = (unsigned)__builtin_amdgcn_readfirstlane((int)id);
                if (id >= 2048u + 256u) break;
                if (id < 2048u) { const int ig = id >> 7, hh = (id >> 4) & 7, r16 = id & 15; attn_task(p, (x << 11) | (hh << 8) | (r16 << 4) | ig, lane); }
                else { const int s = id - 2048; attn_sample_task(p, ((4 * x + (s >> 6)) << 6) | (s & 63), lane, (LAS float*)(lds + wave * 4096)); }
            }
        }
    } else if constexpr (PH == 5) {
        pg8::Gemm g{(const bf16_t*)((const unsigned char*)p.out + SC_C), (const bf16_t*)(p.ws + WS_WOUT), MB, D, D, D}; pg8::StaticOrder S; S.init(MB, D, G, bid);
        pg8::EpiF32 E{(float*)((unsigned char*)p.out + SC_B), D, nullptr};
        pg8::gemm_phase<pg8::EpiF32, pg8::StaticOrder, false>(lds, g, S, E, nullptr);
    } else if constexpr (PH == 6) phase_norm1(p, tid, G, bid);
    else if constexpr (PH == 7) {
        pg8::Gemm g{(const bf16_t*)((const unsigned char*)p.out + SC_C), (const bf16_t*)(p.ws + WS_WUP), MB, FF2, D, D}; pg8::StaticOrder S; S.init(MB, FF2, G, bid);
        EpiUp E{(bf16_t*)(p.ws + WS_U), (bf16_t*)(p.ws + WS_HALO), p.out};
        pg8::gemm_phase<EpiUp, pg8::StaticOrder, false>(lds, g, S, E, nullptr);
    } else if constexpr (PH == 8) phase_act(p, tid, G, bid);
    else if constexpr (PH == 9) {
        pg8::Gemm g{(const bf16_t*)(p.ws + WS_U), (const bf16_t*)(p.ws + WS_WDN), MB, D, FF, FF2}; pg8::StaticOrder S; S.init(MB, D, G, bid);
        pg8::EpiF32 E{(float*)(p.ws + WS_U) + FF / 2, FF2 / 2, nullptr};
        pg8::gemm_phase<pg8::EpiF32, pg8::StaticOrder, false>(lds, g, S, E, nullptr);
        phase_cachecopy(p, tid, G, bid);
    } else if constexpr (PH == 10) { phase_final(p, tid, G, bid); }
    else if constexpr (PH == 13) phase_wkvfin(p, tid, G, bid);
}
__device__ __forceinline__ void grid_bar(unsigned* ctr, unsigned target) {
    asm volatile("s_waitcnt vmcnt(0)" ::: "memory");
    __syncthreads();
    if (threadIdx.x == 0) {
        __builtin_amdgcn_fence(__ATOMIC_RELEASE, "agent");
        asm volatile("s_waitcnt vmcnt(0)" ::: "memory");
        __hip_atomic_fetch_add(ctr, 1u, __ATOMIC_RELAXED, __HIP_MEMORY_SCOPE_AGENT);
        while (__hip_atomic_load(ctr, __ATOMIC_RELAXED, __HIP_MEMORY_SCOPE_AGENT) < target) __builtin_amdgcn_s_sleep(2);
        __builtin_amdgcn_fence(__ATOMIC_ACQUIRE, "agent");
        asm volatile("s_waitcnt vmcnt(0)" ::: "memory");
    }
    __syncthreads();
}
template <int SEAM, int FIRST, int... REST>
__device__ __forceinline__ void run_program(const Params& p, LAS unsigned char* lds, cg::grid_group& grid, int tid, int G, int bid) {
    if (p.en > (int)sizeof...(REST) - 1000) run_phase<FIRST>(p, lds, tid, G, bid);
    if constexpr (sizeof...(REST) > 0) {
        if constexpr (SEAM == 0) grid.sync(); else grid_bar((unsigned*)(p.ws + WS_BAR), (unsigned)(SEAM * G));
        run_program<SEAM + 1, REST...>(p, lds, grid, tid, G, bid);
    }
}
#define PROGRAM 0, 1, 2, 3, 4, 13, 5, 6, 7, 8, 9, 10
__global__ void __launch_bounds__(NTHREADS, 2) hymba_fwd(Params p) {
    extern __shared__ __attribute__((aligned(16))) unsigned char lds_raw[];
    LAS unsigned char* lds = (LAS unsigned char*)lds_raw;
    cg::grid_group grid = cg::this_grid();
    run_program<0, PROGRAM>(p, lds, grid, threadIdx.x, gridDim.x, blockIdx.x);
}

extern "C" void kernel_launch(void* const* d_in, const int* in_sizes, int n_in, void* d_out, int out_size, void* d_ws, size_t ws_size, hipStream_t stream) {
    static int grid = 0;
    if (grid == 0) {
        if (n_in != 28 || (size_t)out_size != O_END || ws_size < WS_TOTAL) { fprintf(stderr, "kernel_launch: unexpected sizes n_in %d out %d ws %zu (need %zu)\n", n_in, out_size, ws_size, (size_t)WS_TOTAL); grid = -1; return; }
        int dev = 0, cus = 0, per_cu = 0;
        hipGetDevice(&dev); hipDeviceGetAttribute(&cus, hipDeviceAttributeMultiprocessorCount, dev);
        if (hipFuncSetAttribute((const void*)hymba_fwd, hipFuncAttributeMaxDynamicSharedMemorySize, LDS_BYTES) != hipSuccess) { fprintf(stderr, "kernel_launch: hipFuncSetAttribute failed\n"); grid = -1; return; }
        hipOccupancyMaxActiveBlocksPerMultiprocessor(&per_cu, (const void*)hymba_fwd, NTHREADS, LDS_BYTES);
        (void)hipGetLastError();
        if (per_cu < 1) per_cu = 1;
        grid = cus;
    }
    if (grid < 0) return;
    Params p{};
    for (int i = 0; i < 28; ++i) p.in[i] = (const float*)d_in[i];
    p.out = (float*)d_out; p.ws = (unsigned char*)d_ws; p.en = 1;
    if (hipMemsetAsync((unsigned char*)d_ws + WS_BAR, 0, 256, stream) != hipSuccess) { fprintf(stderr, "kernel_launch: memset of the barrier word failed\n"); return; }
    void* args[] = {&p};
    hipError_t e = hipLaunchCooperativeKernel((const void*)hymba_fwd, dim3(grid), dim3(NTHREADS), args, LDS_BYTES, stream);
    if (e != hipSuccess) fprintf(stderr, "cooperative launch failed: %s (grid %d)\n", hipGetErrorString(e), grid);
}
```

```cpp
#include <hip/hip_runtime.h>
#include <hip/hip_cooperative_groups.h>
#include <cstdio>
#include <cstdint>
namespace pg8 {
#define PG8_LAS __attribute__((address_space(3)))
typedef unsigned short bf16_t;
typedef short bf16x8 __attribute__((ext_vector_type(8)));
typedef float f32x4 __attribute__((ext_vector_type(4)));
typedef unsigned u32x4 __attribute__((ext_vector_type(4)));
constexpr int BM = 256, BK = 64, HALF = 128, HTB = HALF * BK * 2  , STAGE_BYTES = 8 * HTB, NXCD = 8, WGM = 8;

__host__ __device__ __forceinline__ int lds_byte(int r, int c) { const int st = (r >> 4) * 2 + (c >> 5), rr = r & 15, cc = c & 31, ob = rr * 64 + cc * 2; return st * 1024 + (ob ^ (((ob >> 9) & 1) << 5)); }
__host__ __device__ __forceinline__ void stage_rc(int b, int& R, int& C) { const int st = b / 1024, sb = b % 1024, swz = sb ^ (((sb >> 9) & 1) << 5); R = (st >> 1) * 16 + swz / 64; C = (st & 1) * 32 + (swz % 64) / 2; }
__host__ __device__ __forceinline__ int perm32(int rho) { const int n = rho >> 4, i = rho & 15; return 8 * (i >> 2) + 4 * n + (i & 3); }

struct Unit { int pm, pn; };
struct Gemm { const bf16_t* A; const bf16_t* Bt; int M, N, K, lda, tile_rows; };

struct StaticOrder {
    int nM, nN, nwg, G, c;
    __host__ __device__ void init(int M, int N, int G_, int c_) { nM = M / BM; nN = N / BM; nwg = nM * nN; G = G_; c = c_; }
    __host__ __device__ bool next(int i, Unit& u) const {
        const long L = (long)i * G + c; if (L >= nwg) return false;
        int wgid = (int)L; { const int q = nwg / NXCD, r = nwg % NXCD, xcd = wgid % NXCD, off = wgid / NXCD; wgid = (xcd < r ? xcd * (q + 1) : r * (q + 1) + (xcd - r) * q) + off; }
        const int nig = WGM * nN, gid = wgid / nig, fm = gid * WGM, gsz = (nM - fm) < WGM ? (nM - fm) : WGM;
        u.pm = fm + ((wgid % nig) % gsz); u.pn = (wgid % nig) / gsz; return true;
    }
    __device__ __forceinline__ void a_ready(const Unit&) const {}
    __device__ __forceinline__ void done(const Unit&) const {}
};
__device__ __forceinline__ unsigned cvt_pk_bf16(float lo, float hi) { unsigned r; asm volatile("v_cvt_pk_bf16_f32 %0, %1, %2" : "=v"(r) : "v"(lo), "v"(hi)); return r; }
typedef float f32x2 __attribute__((ext_vector_type(2)));
struct EpiF32 {
    static constexpr bool PERM = false, AFTER_DRAIN = false;
    float* C; int ldc; const float* bias;
    __device__ __forceinline__ void operator()(const f32x4 (&acc)[2][2][4][2], const Unit& u, int wr, int wc, int fr, int fq) const {
        const int row0 = u.pm * BM + wr * 64 + fr, col0 = u.pn * BM + wc * 32 + 4 * fq;
        f32x4 bv[2][2];
#pragma unroll
        for (int bj = 0; bj < 2; ++bj)
#pragma unroll
            for (int n = 0; n < 2; ++n) bv[bj][n] = bias ? *(const f32x4*)(bias + col0 + bj * HALF + n * 16) : (f32x4){0.f, 0.f, 0.f, 0.f};
#pragma unroll
        for (int ai = 0; ai < 2; ++ai)
#pragma unroll
            for (int m = 0; m < 4; ++m) { float* rowp = C + (size_t)(row0 + ai * HALF + m * 16) * ldc + col0;
#pragma unroll
                for (int bj = 0; bj < 2; ++bj)
#pragma unroll
                    for (int n = 0; n < 2; ++n) *(f32x4*)(rowp + bj * HALF + n * 16) = acc[ai][bj][m][n] + bv[bj][n]; }
    }
};
template <class Epi, class Sched, bool STAMP = false>
__device__ __forceinline__ void gemm_phase(PG8_LAS unsigned char* lds, const Gemm g, const Sched& S, const Epi& E, unsigned long long* stamps) {
    const int tid = threadIdx.x, wid = __builtin_amdgcn_readfirstlane(tid >> 6), lane = tid & 63, wr = wid >> 2, wc = wid & 3, fr = lane & 15, fq = lane >> 4;
    const int K = g.K, nt = K / BK;
    int ts_lo = 0, ts_hi = 0, nts = 0; const unsigned long long rt_entry = STAMP ? (unsigned long long)wall_clock64() : 0ull;
#define PG8_STAMP() do { if (STAMP && wid == 0 && nts < 64) { const unsigned long long _c = (unsigned long long)clock64(); \
        ts_lo = (lane == nts) ? (int)(unsigned)_c : ts_lo; ts_hi = (lane == nts) ? (int)(unsigned)(_c >> 32) : ts_hi; ++nts; } } while (0)
    PG8_STAMP();
    unsigned voffA[2], voffB[2];
#pragma unroll
    for (int i = 0; i < 2; ++i) { int R, C; stage_rc(tid * 16 + i * 8192, R, C); const int Rb = Epi::PERM ? ((R & ~31) + perm32(R & 31)) : R;
        voffA[i] = (unsigned)(R * g.lda + C) * 2u; voffB[i] = (unsigned)(Rb * K + C) * 2u; }
    const size_t kstep = (size_t)(BK * 2);
    const size_t hstep = (size_t)HALF * K * 2, hstepA = (size_t)HALF * g.lda * 2;
    const size_t tstep = 2 * hstep, tstepA = (size_t)g.tile_rows * g.lda * 2;
    const unsigned ldsw = (unsigned)wid * 1024u;
    const int aoff = lds_byte(wr * 64 + fr, fq * 8), boff = lds_byte(wc * 32 + fr, fq * 8);
#define PG8_SA(b, h) (((b) * 2 + (h)) * HTB)
#define PG8_SB(b, h) ((4 + (b) * 2 + (h)) * HTB)
#define PG8_STAGE(bufoff, gbase, voff) do { _Pragma("unroll") for (int _i = 0; _i < 2; ++_i) \
        __builtin_amdgcn_global_load_lds((const unsigned*)((const char*)(gbase) + (voff)[_i]), (PG8_LAS unsigned*)(lds + (bufoff) + ldsw + _i * 8192), 16, 0, 0); } while (0)
#define PG8_LDA(dst, b, h) do { _Pragma("unroll") for (int m = 0; m < 4; ++m) _Pragma("unroll") for (int k = 0; k < 2; ++k) dst[m][k] = *(const PG8_LAS bf16x8*)(lds + PG8_SA(b, h) + aoff + m * 2048 + k * 1024); } while (0)
#define PG8_LDB(dst, b, h) do { _Pragma("unroll") for (int n = 0; n < 2; ++n) _Pragma("unroll") for (int k = 0; k < 2; ++k) dst[n][k] = *(const PG8_LAS bf16x8*)(lds + PG8_SB(b, h) + boff + n * 2048 + k * 1024); } while (0)
#define PG8_MMA(ai, bj, At, Bt) do { __builtin_amdgcn_s_setprio(1); _Pragma("unroll") for (int m = 0; m < 4; ++m) _Pragma("unroll") for (int n = 0; n < 2; ++n) _Pragma("unroll") for (int k = 0; k < 2; ++k) \
        acc[ai][bj][m][n] = __builtin_amdgcn_mfma_f32_16x16x32_bf16(Bt[n][k], At[m][k], acc[ai][bj][m][n], 0, 0, 0); __builtin_amdgcn_s_setprio(0); } while (0)
#define PG8_WAIT_V(n) asm volatile("s_waitcnt vmcnt(" #n ")" ::: "memory")
#define PG8_WAIT_L(n) asm volatile("s_waitcnt lgkmcnt(" #n ")" ::: "memory")
#define PG8_BAR __builtin_amdgcn_s_barrier()
#define PG8_SCHED __builtin_amdgcn_sched_barrier(0)
    Unit cur, nxt; int ui = 0;
    if (!S.next(0, cur)) return;
    f32x4 acc[2][2][4][2];
#pragma unroll
    for (int a = 0; a < 2; ++a)
#pragma unroll
        for (int b = 0; b < 2; ++b)
#pragma unroll
            for (int m = 0; m < 4; ++m)
#pragma unroll
                for (int n = 0; n < 2; ++n) acc[a][b][m][n] = (f32x4){0.f, 0.f, 0.f, 0.f};
    bf16x8 At[4][2], B0[2][2], B1[2][2];
    const char* cA = (const char*)g.A + (size_t)cur.pm * tstepA; const char* cB = (const char*)g.Bt + (size_t)cur.pn * tstep;
    S.a_ready(cur);
    PG8_STAGE(PG8_SB(0, 0), cB, voffB); PG8_STAGE(PG8_SA(0, 0), cA, voffA); PG8_STAGE(PG8_SB(0, 1), cB + hstep, voffB); PG8_STAGE(PG8_SA(0, 1), cA + hstepA, voffA);
    if (wr == 1) PG8_BAR;
    PG8_WAIT_V(4); PG8_BAR;
    PG8_STAGE(PG8_SB(1, 0), cB + kstep, voffB); PG8_STAGE(PG8_SA(1, 0), cA + kstep, voffA); PG8_STAGE(PG8_SB(1, 1), cB + hstep + kstep, voffB);
    PG8_WAIT_V(6); PG8_BAR;
    PG8_STAMP();
    for (;;) {
        const bool has_next = S.next(ui + 1, nxt);
        const char* nA = has_next ? (const char*)g.A + (size_t)nxt.pm * tstepA : cA; const char* nB = has_next ? (const char*)g.Bt + (size_t)nxt.pn * tstep : cB;
        for (int t = 0; t < nt; t += 2) {
            const bool last = (t == nt - 2);
            const char* a1 = cA + (size_t)(t + 1) * kstep;
            const char* a2 = last ? nA : cA + (size_t)(t + 2) * kstep; const char* b2 = last ? nB : cB + (size_t)(t + 2) * kstep;
            const char* a3 = a2 + kstep; const char* b3 = b2 + kstep;
            if (last && has_next) S.a_ready(nxt);
            PG8_LDB(B0, 0, 0); PG8_SCHED; PG8_LDA(At, 0, 0); PG8_STAGE(PG8_SA(1, 1), a1 + hstepA, voffA);
            PG8_WAIT_L(8); PG8_BAR; PG8_WAIT_L(0); PG8_MMA(0, 0, At, B0); PG8_BAR; PG8_SCHED;
            PG8_LDB(B1, 0, 1); PG8_STAGE(PG8_SB(0, 0), b2, voffB);
            PG8_BAR; PG8_WAIT_L(0); PG8_MMA(0, 1, At, B1); PG8_BAR;
            PG8_LDA(At, 0, 1); PG8_STAGE(PG8_SA(0, 0), a2, voffA);
            PG8_BAR; PG8_WAIT_L(0); PG8_MMA(1, 0, At, B0); PG8_BAR; PG8_SCHED;
            PG8_STAGE(PG8_SB(0, 1), b2 + hstep, voffB);
            PG8_WAIT_V(6); PG8_BAR; PG8_MMA(1, 1, At, B1); PG8_BAR;
            PG8_LDB(B0, 1, 0); PG8_SCHED; PG8_LDA(At, 1, 0); PG8_STAGE(PG8_SA(0, 1), a2 + hstepA, voffA);
            PG8_WAIT_L(8); PG8_BAR; PG8_WAIT_L(0); PG8_MMA(0, 0, At, B0); PG8_BAR; PG8_SCHED;
            PG8_LDB(B1, 1, 1); PG8_STAGE(PG8_SB(1, 0), b3, voffB);
            PG8_BAR; PG8_WAIT_L(0); PG8_MMA(0, 1, At, B1); PG8_BAR;
            PG8_LDA(At, 1, 1); PG8_STAGE(PG8_SA(1, 0), a3, voffA);
            PG8_BAR; PG8_WAIT_L(0); PG8_MMA(1, 0, At, B0); PG8_BAR; PG8_SCHED;
            PG8_STAGE(PG8_SB(1, 1), b3 + hstep, voffB);
            PG8_WAIT_V(6); PG8_BAR; PG8_MMA(1, 1, At, B1); PG8_BAR;
        }
        PG8_STAMP();
        if constexpr (!Epi::AFTER_DRAIN) { E(acc, cur, wr, wc, fr, fq); S.done(cur); }
        PG8_STAMP();
        if (!has_next) break;
#pragma unroll
        for (int a = 0; a < 2; ++a)
#pragma unroll
            for (int b = 0; b < 2; ++b)
#pragma unroll
                for (int m = 0; m < 4; ++m)
#pragma unroll
                    for (int n = 0; n < 2; ++n) acc[a][b][m][n] = (f32x4){0.f, 0.f, 0.f, 0.f};
        cur = nxt; cA = nA; cB = nB; ++ui;
    }
    PG8_WAIT_V(0);
    if (wr == 0) PG8_BAR;
    PG8_BAR;
    if constexpr (Epi::AFTER_DRAIN) { E.fused(acc, cur, wr, wc, fr, fq, lds, wid, lane); S.done(cur); }
    PG8_STAMP();
    if (STAMP && wid == 0) { stamps[lane] = lane < nts ? (((unsigned long long)(unsigned)ts_hi << 32) | (unsigned)ts_lo) : 0ull;
        if (lane == 62) stamps[62] = rt_entry; if (lane == 63) stamps[63] = (unsigned long long)wall_clock64(); }
#undef PG8_STAMP
#undef PG8_SA
#undef PG8_SB
#undef PG8_STAGE
#undef PG8_LDA
#undef PG8_LDB
#undef PG8_MMA
#undef PG8_WAIT_V
#undef PG8_WAIT_L
#undef PG8_BAR
#undef PG8_SCHED
}
}

namespace cg = cooperative_groups;
#define LAS __attribute__((address_space(3)))
typedef unsigned short bf16_t;
typedef unsigned int u32;
typedef pg8::bf16x8 bf16x8;
typedef pg8::f32x4 f32x4;
typedef pg8::u32x4 u32x4;

constexpr int D = 1024, TP = 4096, BP = 8, MP = BP * TP, BS = 32, TS = 8, MS = BS * TS;
constexpr int MB = MP + MS;
constexpr int MA = 33280;
constexpr int MA_REAL = MP + BS * 9;
constexpr int DIN = 3328, RCOLS = 1792, FF = 2816, FF2 = 5632, NLORA = 1536, KLORA = 256;
constexpr int NTHREADS = 512;
constexpr int UP_TILES = 131, UP_STEP = 254, H2P_ROWS = (UP_TILES - 1) * UP_STEP + 256;
constexpr int LDS_BYTES = 144 * 1024;

constexpr size_t O_YP = 0;
constexpr size_t O_YS = O_YP + (size_t)MP * D;
constexpr size_t O_PSH = O_YS + (size_t)MS * D;
constexpr size_t O_PWKV = O_PSH + (size_t)BP * D;
constexpr size_t O_PK = O_PWKV + (size_t)BP * 8 * 64 * 64;
constexpr size_t O_PV = O_PK + (size_t)BP * 2048 * 512;
constexpr size_t O_PCONV = O_PV + (size_t)BP * 2048 * 512;
constexpr size_t O_SSH = O_PCONV + (size_t)BP * 2 * FF2;
constexpr size_t O_SWKV = O_SSH + (size_t)BS * D;
constexpr size_t O_SK = O_SWKV + (size_t)BS * 8 * 64 * 64;
constexpr size_t O_SV = O_SK + (size_t)BS * 2048 * 512;
constexpr size_t O_SCONV = O_SV + (size_t)BS * 2048 * 512;
constexpr size_t O_END = O_SCONV + (size_t)BS * 2 * FF2;

constexpr size_t al256(size_t x) { return (x + 255) & ~(size_t)255; }
constexpr size_t WS_WIN = 0;
constexpr size_t WS_WOUT = WS_WIN + al256((size_t)DIN * D * 2);
constexpr size_t WS_WUP = WS_WOUT + al256((size_t)D * D * 2);
constexpr size_t WS_WDN = WS_WUP + al256((size_t)FF2 * D * 2);
constexpr size_t WS_WLORA = WS_WDN + al256((size_t)D * FF * 2);
constexpr size_t WS_ROPE = WS_WLORA + al256((size_t)NLORA * KLORA * 2);
constexpr int NPOS = 4104;
constexpr size_t WS_SNEWK = WS_ROPE + al256((size_t)NPOS * 32 * 2 * 4);
constexpr size_t WS_SNEWV = WS_SNEWK + al256((size_t)MS * 512 * 4);
constexpr size_t WS_HALO = WS_SNEWV + al256((size_t)MS * 512 * 4);
constexpr size_t WS_A = WS_HALO + al256((size_t)1025 * 2 * FF2 * 2);
constexpr size_t WS_PROJRW = WS_A;
constexpr size_t WS_Q = WS_PROJRW + al256((size_t)MA * RCOLS * 2);
constexpr size_t WS_K = WS_Q + al256((size_t)MB * 512 * 2);
constexpr size_t WS_VT1 = WS_K + al256((size_t)MB * 512 * 2);
constexpr size_t WS_VT4 = WS_VT1 + al256((size_t)BP * 8 * 64 * TP * 2);
constexpr size_t WS_VT16 = WS_VT4 + al256((size_t)BP * 8 * 64 * TP * 2);
constexpr size_t WS_ALORA = WS_VT16 + al256((size_t)BP * 8 * 64 * TP * 2);
constexpr size_t WS_VROW = WS_ALORA + al256((size_t)MB * KLORA * 2);
constexpr size_t WS_A_EARLY_END = WS_VROW + al256((size_t)MP * 512 * 2);
constexpr size_t WS_U = WS_A;
constexpr size_t WS_F = WS_A + al256((size_t)MB * FF * 2);
static_assert(WS_F + (size_t)MB * D * 4 <= WS_A + al256((size_t)MB * FF2 * 2), "region A late overflow");
constexpr size_t WS_END = WS_A + al256((size_t)MB * FF2 * 2);
static_assert(WS_A_EARLY_END <= WS_END, "region A overflow");
constexpr size_t WS_BAR = WS_END;
constexpr size_t WS_TOTAL = WS_END + 256;
constexpr size_t WS_Y = WS_ALORA;
static_assert(WS_Y + (size_t)MB * 512 * 4 <= WS_END, "Y overflow");
constexpr size_t SC_B = O_SK * 4;
constexpr size_t SC_C = SC_B + al256((size_t)MB * D * 4);
static_assert(SC_C + (size_t)H2P_ROWS * D * 2 <= O_SCONV * 4, "scratch overflow");
static_assert((size_t)MA * D * 2 <= (size_t)MB * D * 4 && (size_t)MB * NLORA * 2 <= (size_t)MB * D * 4, "region B");

struct Params {
    const float* in[28];
    float* out;
    unsigned char* ws;
    int en, pad;
};

enum { I_XP = 0, I_XS, I_SSHIFT, I_SWKV, I_CK, I_CV, I_SCONV, I_NMPRE, I_NMPOST, I_NFPRE, I_NFPOST, I_WIN, I_MU, I_W0, I_WDEC, I_A0, I_WICLR, I_WGATE,
       I_KK, I_KA, I_RK, I_LNW, I_LNB, I_WOUT, I_WUP, I_CONVW, I_CONVB, I_WDN };

__device__ __forceinline__ float bflo(u32 p) { return __uint_as_float(p << 16); }
__device__ __forceinline__ float bfhi(u32 p) { return __uint_as_float(p & 0xffff0000u); }
__device__ __forceinline__ u32 pk2(float a, float b) { return pg8::cvt_pk_bf16(a, b); }
__device__ __forceinline__ float wave_sum(float v) {
#pragma unroll
    for (int o = 1; o < 64; o <<= 1) v += __shfl_xor(v, o);
    return v;
}
template <int N> __device__ __forceinline__ float dpp_ror(float x) {
    return __int_as_float(__builtin_amdgcn_update_dpp(0, __float_as_int(x), 0x120 + N, 0xF, 0xF, false));
}
__device__ __forceinline__ float row16_sum(float x) {
    x += dpp_ror<8>(x); x += dpp_ror<4>(x); x += dpp_ror<2>(x); x += dpp_ror<1>(x);
    return x;
}
__device__ __forceinline__ void row16_sum4(float& a, float& b, float& c, float& d) {
    asm volatile("s_nop 1\n\t"
                 "v_add_f32_dpp %0, %0, %0 row_ror:8 row_mask:0xf bank_mask:0xf\n\t" "v_add_f32_dpp %1, %1, %1 row_ror:8 row_mask:0xf bank_mask:0xf\n\t"
                 "v_add_f32_dpp %2, %2, %2 row_ror:8 row_mask:0xf bank_mask:0xf\n\t" "v_add_f32_dpp %3, %3, %3 row_ror:8 row_mask:0xf bank_mask:0xf\n\t"
                 "v_add_f32_dpp %0, %0, %0 row_ror:4 row_mask:0xf bank_mask:0xf\n\t" "v_add_f32_dpp %1, %1, %1 row_ror:4 row_mask:0xf bank_mask:0xf\n\t"
                 "v_add_f32_dpp %2, %2, %2 row_ror:4 row_mask:0xf bank_mask:0xf\n\t" "v_add_f32_dpp %3, %3, %3 row_ror:4 row_mask:0xf bank_mask:0xf\n\t"
                 "v_add_f32_dpp %0, %0, %0 row_ror:2 row_mask:0xf bank_mask:0xf\n\t" "v_add_f32_dpp %1, %1, %1 row_ror:2 row_mask:0xf bank_mask:0xf\n\t"
                 "v_add_f32_dpp %2, %2, %2 row_ror:2 row_mask:0xf bank_mask:0xf\n\t" "v_add_f32_dpp %3, %3, %3 row_ror:2 row_mask:0xf bank_mask:0xf\n\t"
                 "v_add_f32_dpp %0, %0, %0 row_ror:1 row_mask:0xf bank_mask:0xf\n\t" "v_add_f32_dpp %1, %1, %1 row_ror:1 row_mask:0xf bank_mask:0xf\n\t"
                 "v_add_f32_dpp %2, %2, %2 row_ror:1 row_mask:0xf bank_mask:0xf\n\t" "v_add_f32_dpp %3, %3, %3 row_ror:1 row_mask:0xf bank_mask:0xf\n\t"
                 "s_nop 1"
                 : "+v"(a), "+v"(b), "+v"(c), "+v"(d));
}
__device__ __forceinline__ float fma_(float a, float b, float c) { float d; asm("v_fma_f32 %0, %1, %2, %3" : "=v"(d) : "v"(a), "v"(b), "v"(c)); return d; }
__device__ __forceinline__ float mul_(float a, float b) { float d; asm("v_mul_f32 %0, %1, %2" : "=v"(d) : "v"(a), "v"(b)); return d; }
__device__ __forceinline__ void row16_sum2_mul4(float& a, float& b, float (&t)[4], float v, float k0, float k1, float k2, float k3) {
    asm volatile("v_mul_f32 %2, %6, %7\n\t" "v_mul_f32 %3, %6, %8\n\t"
                 "v_add_f32_dpp %0, %0, %0 row_ror:8 row_mask:0xf bank_mask:0xf\n\t" "v_add_f32_dpp %1, %1, %1 row_ror:8 row_mask:0xf bank_mask:0xf\n\t"
                 "v_mul_f32 %4, %6, %9\n\t"
                 "v_add_f32_dpp %0, %0, %0 row_ror:4 row_mask:0xf bank_mask:0xf\n\t" "v_add_f32_dpp %1, %1, %1 row_ror:4 row_mask:0xf bank_mask:0xf\n\t"
                 "v_mul_f32 %5, %6, %10\n\t"
                 "v_add_f32_dpp %0, %0, %0 row_ror:2 row_mask:0xf bank_mask:0xf\n\t" "v_add_f32_dpp %1, %1, %1 row_ror:2 row_mask:0xf bank_mask:0xf\n\t"
                 "s_nop 0\n\t"
                 "v_add_f32_dpp %0, %0, %0 row_ror:1 row_mask:0xf bank_mask:0xf\n\t" "v_add_f32_dpp %1, %1, %1 row_ror:1 row_mask:0xf bank_mask:0xf"
                 : "+v"(a), "+v"(b), "=&v"(t[0]), "=&v"(t[1]), "=&v"(t[2]), "=&v"(t[3])
                 : "v"(v), "v"(k0), "v"(k1), "v"(k2), "v"(k3));
}
__device__ __forceinline__ void row16_sum2(float& a, float& b) {
    asm volatile("s_nop 1\n\t"
                 "v_add_f32_dpp %0, %0, %0 row_ror:8 row_mask:0xf bank_mask:0xf\n\t" "v_add_f32_dpp %1, %1, %1 row_ror:8 row_mask:0xf bank_mask:0xf\n\t" "s_nop 0\n\t"
                 "v_add_f32_dpp %0, %0, %0 row_ror:4 row_mask:0xf bank_mask:0xf\n\t" "v_add_f32_dpp %1, %1, %1 row_ror:4 row_mask:0xf bank_mask:0xf\n\t" "s_nop 0\n\t"
                 "v_add_f32_dpp %0, %0, %0 row_ror:2 row_mask:0xf bank_mask:0xf\n\t" "v_add_f32_dpp %1, %1, %1 row_ror:2 row_mask:0xf bank_mask:0xf\n\t" "s_nop 0\n\t"
                 "v_add_f32_dpp %0, %0, %0 row_ror:1 row_mask:0xf bank_mask:0xf\n\t" "v_add_f32_dpp %1, %1, %1 row_ror:1 row_mask:0xf bank_mask:0xf\n\t"
                 "s_nop 1"
                 : "+v"(a), "+v"(b));
}
__device__ __forceinline__ float sigmoidf_(float x) { return 1.f / (1.f + __expf(-x)); }

__device__ __forceinline__ int win_rowmap(int n) {
    if (n < RCOLS || n >= RCOLS + 1024) return n;
    const int base = (n < RCOLS + 512) ? RCOLS : RCOLS + 512, c = n - base, unit = c >> 8, cu = c & 255, hu = cu >> 6, d = cu & 63, e = d & 31, s = d >> 5;
    const int idx = hu * 32 + e, bj = idx >> 6, wc = (idx & 63) >> 4, fq = (idx & 15) >> 2, j = idx & 3;
    return base + unit * 256 + 128 * bj + 32 * wc + 16 * s + 4 * fq + j;
}
__device__ __forceinline__ int wup_rowmap(int c) {
    const int isup = c >= FF ? 1 : 0, cc = c - FF * isup, pn = cc >> 7, e = cc & 127;
    return pn * 256 + 128 * (e >> 6) + 32 * ((e >> 4) & 3) + 16 * isup + 4 * ((e >> 2) & 3) + (e & 3);
}
__device__ __forceinline__ void transpose_item(const float* W, int K, int N, bf16_t* WT, int mode, LAS float* scr, int item, int lane) {
    const int nblk = N / 32, kb = item / nblk, nb = item % nblk, k0 = 64 * kb, n0 = 32 * nb;
#pragma unroll 8
    for (int i = 0; i < 32; ++i) { const int kk = 2 * i + (lane >> 5); scr[kk * 33 + (lane & 31)] = W[(size_t)(k0 + kk) * N + n0 + (lane & 31)]; }
    asm volatile("s_waitcnt lgkmcnt(0)" ::: "memory");
    const int c = lane & 7;
#pragma unroll
    for (int j = 0; j < 4; ++j) { const int n = (lane >> 3) + 8 * j; const LAS float* s = scr + (8 * c) * 33 + n;
        uint4 o; o.x = pk2(s[0 * 33], s[1 * 33]); o.y = pk2(s[2 * 33], s[3 * 33]); o.z = pk2(s[4 * 33], s[5 * 33]); o.w = pk2(s[6 * 33], s[7 * 33]);
        const int row = mode == 1 ? win_rowmap(n0 + n) : (mode == 2 ? wup_rowmap(n0 + n) : (n0 + n));
        *(uint4*)(WT + (size_t)row * K + k0 + 8 * c) = o; }
    asm volatile("s_waitcnt lgkmcnt(0)" ::: "memory");
}
__device__ __forceinline__ void rms_row(const float* xrow, const float* g, bf16_t* orow, float* frow, int lane) {
    const float4* xr = (const float4*)xrow + lane; const float4* gr = (const float4*)g + lane;
    float4 v[4]; float s = 0.f;
#pragma unroll
    for (int j = 0; j < 4; ++j) { v[j] = xr[64 * j]; s += (v[j].x * v[j].x + v[j].y * v[j].y) + (v[j].z * v[j].z + v[j].w * v[j].w); }
    const float rs = rsqrtf(wave_sum(s) * (1.f / D) + 1e-6f);
#pragma unroll
    for (int j = 0; j < 4; ++j) { const float4 gg = gr[64 * j];
        float4 y; y.x = v[j].x * rs * gg.x; y.y = v[j].y * rs * gg.y; y.z = v[j].z * rs * gg.z; y.w = v[j].w * rs * gg.w;
        uint2 o; o.x = pk2(y.x, y.y); o.y = pk2(y.z, y.w);
        *((uint2*)orow + lane + 64 * j) = o;
        if (frow) *((float4*)frow + lane + 64 * j) = y; }
}
__device__ __forceinline__ void phase0(const Params& p, LAS unsigned char* lds, int tid, int G, int bid) {
    const int wave = tid >> 6, lane = tid & 63, gw = bid * 8 + wave, NGW = G * 8;
    LAS float* scr = (LAS float*)(lds + wave * 16384);
    bf16_t* WinT = (bf16_t*)(p.ws + WS_WIN); bf16_t* WoutT = (bf16_t*)(p.ws + WS_WOUT); bf16_t* WupT = (bf16_t*)(p.ws + WS_WUP); bf16_t* WdnT = (bf16_t*)(p.ws + WS_WDN);
    constexpr int I1 = (D / 64) * (DIN / 32), I2 = (D / 64) * (D / 32), I3 = (D / 64) * (FF2 / 32), I4 = (FF / 64) * (D / 32);
    for (int it = gw; it < I1 + I2 + I3 + I4; it += NGW) {
        int r = it;
        if (r < I1) { transpose_item(p.in[I_WIN], D, DIN, WinT, 1, scr, r, lane); continue; } r -= I1;
        if (r < I2) { transpose_item(p.in[I_WOUT], D, D, WoutT, 0, scr, r, lane); continue; } r -= I2;
        if (r < I3) { transpose_item(p.in[I_WUP], D, FF2, WupT, 2, scr, r, lane); continue; } r -= I3;
        transpose_item(p.in[I_WDN], FF, D, WdnT, 0, scr, r, lane);
    }
    const int gt = bid * NTHREADS + tid, NT = G * NTHREADS;
    bf16_t* WL = (bf16_t*)(p.ws + WS_WLORA);
    for (int i = gt; i < NLORA * KLORA; i += NT) {
        const int row = i >> 8, k = i & 255; float v = 0.f;
        if (row < 512) { if (k < 64) v = p.in[I_WDEC][k * 512 + row]; }
        else if (row < 1024) { if (k >= 64 && k < 128) v = p.in[I_WICLR][(k - 64) * 512 + (row - 512)]; }
        else { if (k >= 128) v = p.in[I_WGATE][(k - 128) * 512 + (row - 1024)]; }
        WL[i] = (bf16_t)(pk2(v, 0.f) & 0xffffu);
    }
    float* rope = (float*)(p.ws + WS_ROPE);
    for (int i = gt; i < NPOS * 32; i += NT) {
        const int pi = i >> 5, e = i & 31; const int pos = pi < TP ? pi : 16384 + (pi - TP);
        double inv = 1.0; for (int q = 0; q < e; ++q) inv *= 0.7498942093324558273;
        const float ang = (float)pos * (float)inv;
        const double a = (double)ang; const double kq = rint(a * 0.15915494309189535); double r = a - kq * 6.283185307179586; r -= kq * 2.4492935982947064e-16;
        const double r2 = r * r;
        double sn = 1.0 / 51090942171709440000.0;
        sn = sn * r2 * (-1.0) + 1.0 / 121645100408832000.0;
        sn = -sn * r2 + 1.0 / 355687428096000.0;
        sn = -sn * r2 + 1.0 / 1307674368000.0;
        sn = -sn * r2 + 1.0 / 6227020800.0;
        sn = -sn * r2 + 1.0 / 39916800.0;
        sn = -sn * r2 + 1.0 / 362880.0;
        sn = -sn * r2 + 1.0 / 5040.0;
        sn = -sn * r2 + 1.0 / 120.0;
        sn = -sn * r2 + 1.0 / 6.0;
        sn = -sn * r2 + 1.0;
        sn *= r;
        double cs = 1.0 / 1124000727777607680000.0;
        cs = -cs * r2 + 1.0 / 2432902008176640000.0;
        cs = -cs * r2 + 1.0 / 6402373705728000.0;
        cs = -cs * r2 + 1.0 / 20922789888000.0;
        cs = -cs * r2 + 1.0 / 87178291200.0;
        cs = -cs * r2 + 1.0 / 479001600.0;
        cs = -cs * r2 + 1.0 / 3628800.0;
        cs = -cs * r2 + 1.0 / 40320.0;
        cs = -cs * r2 + 1.0 / 720.0;
        cs = -cs * r2 + 1.0 / 24.0;
        cs = -cs * r2 + 0.5;
        cs = -cs * r2 + 1.0;
        rope[i] = (float)cs; rope[NPOS * 32 + i] = (float)sn;
    }
    bf16_t* H = (bf16_t*)((unsigned char*)p.out + SC_B);
    for (int row = gw; row < MA; row += NGW) {
        bf16_t* orow = H + (size_t)row * D;
        if (row < MP) {
            const bool last = (row & (TP - 1)) == TP - 1;
            rms_row(p.in[I_XP] + (size_t)row * D, p.in[I_NMPRE], orow, last ? p.out + O_PSH + (size_t)(row >> 12) * D : nullptr, lane);
        } else {
            const int s = row - MP;
            if (s < BS * 9) {
                const int b = s / 9, j = s - b * 9;
                if (j == 0) {
                    const float4* sr = (const float4*)(p.in[I_SSHIFT] + (size_t)b * D) + lane;
#pragma unroll
                    for (int q = 0; q < 4; ++q) { const float4 v = sr[64 * q]; uint2 o; o.x = pk2(v.x, v.y); o.y = pk2(v.z, v.w); *((uint2*)orow + lane + 64 * q) = o; }
                } else {
                    rms_row(p.in[I_XS] + (size_t)(b * TS + j - 1) * D, p.in[I_NMPRE], orow, j == TS ? p.out + O_SSH + (size_t)b * D : nullptr, lane);
                }
            } else {
#pragma unroll
                for (int q = 0; q < 4; ++q) *((uint2*)orow + lane + 64 * q) = make_uint2(0u, 0u);
            }
        }
    }
}

struct EpiProj {
    static constexpr bool PERM = false, AFTER_DRAIN = false;
    bf16_t* projrw; bf16_t* Q; bf16_t* K; bf16_t* VT1; bf16_t* VT4; bf16_t* VT16; const float* rope; float* out; float* snewk; float* snewv;
    __device__ __forceinline__ void operator()(const f32x4 (&acc)[2][2][4][2], const pg8::Unit& u, int wr, int wc, int fr, int fq) const {
        const int pn = u.pn;
        if (pn < 7) {
#pragma unroll
            for (int ai = 0; ai < 2; ++ai)
#pragma unroll
                for (int m = 0; m < 4; ++m) { const int row = u.pm * 256 + ai * 128 + wr * 64 + m * 16 + fr;
                    bf16_t* rp = projrw + (size_t)row * RCOLS + pn * 256 + wc * 32 + 4 * fq;
#pragma unroll
                    for (int bj = 0; bj < 2; ++bj)
#pragma unroll
                        for (int n = 0; n < 2; ++n) { const f32x4 v = acc[ai][bj][m][n]; uint2 o; o.x = pk2(v[0], v[1]); o.y = pk2(v[2], v[3]); *(uint2*)(rp + bj * 128 + n * 16) = o; } }
            return;
        }
#pragma unroll
        for (int ai = 0; ai < 2; ++ai)
#pragma unroll
            for (int m = 0; m < 4; ++m) {
                const int row = u.pm * 256 + ai * 128 + wr * 64 + m * 16 + fr;
                bool prompt = row < MP; int b, t, rowB, pi; bool valid = true;
                if (prompt) { b = row >> 12; t = row & (TP - 1); rowB = row; pi = t; }
                else { const int s = row - MP; b = s / 9; const int j = s - b * 9; valid = (s < BS * 9) && (j > 0); t = j - 1; rowB = MP + b * TS + t; pi = TP + t; }
                if (!valid) continue;
                if (pn < 11) {
                    const bool isq = pn < 9; const int unit = isq ? pn - 7 : pn - 9;
#pragma unroll
                    for (int bj = 0; bj < 2; ++bj) {
                        const int idx = bj * 64 + wc * 16 + fq * 4, hu = idx >> 5, e = idx & 31;
                        const float4 cs = *(const float4*)(rope + (size_t)pi * 32 + e), sn = *(const float4*)(rope + (size_t)NPOS * 32 + (size_t)pi * 32 + e);
                        const f32x4 x1 = acc[ai][bj][m][0], x2 = acc[ai][bj][m][1];
                        float o1[4], o2[4];
                        o1[0] = x1[0] * cs.x - x2[0] * sn.x; o2[0] = x1[0] * sn.x + x2[0] * cs.x;
                        o1[1] = x1[1] * cs.y - x2[1] * sn.y; o2[1] = x1[1] * sn.y + x2[1] * cs.y;
                        o1[2] = x1[2] * cs.z - x2[2] * sn.z; o2[2] = x1[2] * sn.z + x2[2] * cs.z;
                        o1[3] = x1[3] * cs.w - x2[3] * sn.w; o2[3] = x1[3] * sn.w + x2[3] * cs.w;
                        const int col = unit * 256 + hu * 64 + e;
                        if (isq) {
                            uint2 a, c2; a.x = pk2(o1[0] * 0.125f, o1[1] * 0.125f); a.y = pk2(o1[2] * 0.125f, o1[3] * 0.125f); c2.x = pk2(o2[0] * 0.125f, o2[1] * 0.125f); c2.y = pk2(o2[2] * 0.125f, o2[3] * 0.125f);
                            *(uint2*)(Q + (size_t)rowB * 512 + col) = a; *(uint2*)(Q + (size_t)rowB * 512 + col + 32) = c2;
                        } else {
                            uint2 a, c2; a.x = pk2(o1[0], o1[1]); a.y = pk2(o1[2], o1[3]); c2.x = pk2(o2[0], o2[1]); c2.y = pk2(o2[2], o2[3]);
                            *(uint2*)(K + (size_t)rowB * 512 + col) = a; *(uint2*)(K + (size_t)rowB * 512 + col + 32) = c2;
                            float* dst = nullptr;
                            if (prompt) { if (t >= 2048) dst = out + O_PK + ((size_t)b * 2048 + (t - 2048)) * 512 + col; }
                            else dst = snewk + (size_t)(b * TS + t) * 512 + col;
                            if (dst) { *(float4*)dst = make_float4(o1[0], o1[1], o1[2], o1[3]); *(float4*)(dst + 32) = make_float4(o2[0], o2[1], o2[2], o2[3]); }
                        }
                    }
                } else {
#pragma unroll
                    for (int bj = 0; bj < 2; ++bj)
#pragma unroll
                        for (int n = 0; n < 2; ++n) {
                            const int col = (pn - 11) * 256 + bj * 128 + wc * 32 + n * 16 + 4 * fq; const f32x4 v = acc[ai][bj][m][n];
                            if (prompt) {
                                if (t >= 2048) *(float4*)(out + O_PV + ((size_t)b * 2048 + (t - 2048)) * 512 + col) = make_float4(v[0], v[1], v[2], v[3]);
                                uint2 o; o.x = pk2(v[0], v[1]); o.y = pk2(v[2], v[3]); *(uint2*)(VT1 + (size_t)rowB * 512 + col) = o;
                            } else {
                                *(float4*)(snewv + (size_t)(b * TS + t) * 512 + col) = make_float4(v[0], v[1], v[2], v[3]);
                            }
                        }
                }
            }
    }
};
struct EpiDag {
    static constexpr bool PERM = false, AFTER_DRAIN = false;
    bf16_t* dag; const float* w0; const float* a0;
    __device__ __forceinline__ void operator()(const f32x4 (&acc)[2][2][4][2], const pg8::Unit& u, int wr, int wc, int fr, int fq) const {
        const int kind = u.pn >> 1;
#pragma unroll
        for (int bj = 0; bj < 2; ++bj)
#pragma unroll
            for (int n = 0; n < 2; ++n) {
                const int col = u.pn * 256 + bj * 128 + wc * 32 + n * 16 + 4 * fq;
                float4 bias = make_float4(0.f, 0.f, 0.f, 0.f);
                if (kind == 0) bias = *(const float4*)(w0 + col); else if (kind == 1) bias = *(const float4*)(a0 + col - 512);
                const float bb[4] = {bias.x, bias.y, bias.z, bias.w};
#pragma unroll
                for (int ai = 0; ai < 2; ++ai)
#pragma unroll
                    for (int m = 0; m < 4; ++m) { const int row = u.pm * 256 + ai * 128 + wr * 64 + m * 16 + fr; const f32x4 v = acc[ai][bj][m][n]; float o[4];
#pragma unroll
                        for (int j = 0; j < 4; ++j) { const float x = v[j] + bb[j];
                            if (kind == 0) { const float z = -x; const float sp = fmaxf(z, 0.f) + __logf(1.f + __expf(-fabsf(z))); o[j] = -__expf(-sp - 0.5f); }
                            else if (kind == 1) o[j] = sigmoidf_(x);
                            else o[j] = x; }
                        uint2 q; q.x = pk2(o[0], o[1]); q.y = pk2(o[2], o[3]); *(uint2*)(dag + (size_t)row * NLORA + col) = q; }
            }
    }
};
struct EpiUp {
    static constexpr bool PERM = false, AFTER_DRAIN = false;
    bf16_t* U; bf16_t* halo; float* out;
    __device__ __forceinline__ void operator()(const f32x4 (&acc)[2][2][4][2], const pg8::Unit& u, int wr, int wc, int fr, int fq) const {
#pragma unroll
        for (int ai = 0; ai < 2; ++ai)
#pragma unroll
            for (int m = 0; m < 4; ++m) {
                const int row = u.pm * 256 + ai * 128 + wr * 64 + m * 16 + fr; const int col0 = u.pn * 256 + wc * 32 + 4 * fq;
                bf16_t* hrow = nullptr; float* frow = nullptr;
                if (row < MP) { const int t = row & (TP - 1);
                    if ((t & 31) >= 30) hrow = halo + ((size_t)((row >> 5) + 1) * 2 + ((t & 31) - 30)) * FF2;
                    if (t >= TP - 2) frow = out + O_PCONV + ((size_t)(row >> 12) * 2 + (t - (TP - 2))) * FF2;
                } else { const int s = row - MP, b = s >> 3, tt = s & 7; if (tt >= 6) frow = out + O_SCONV + ((size_t)b * 2 + (tt - 6)) * FF2; }
#pragma unroll
                for (int bj = 0; bj < 2; ++bj)
#pragma unroll
                    for (int n = 0; n < 2; ++n) { const f32x4 v = acc[ai][bj][m][n]; const int col = col0 + bj * 128 + n * 16;
                        uint2 o; o.x = pk2(v[0], v[1]); o.y = pk2(v[2], v[3]);
                        *(uint2*)(U + (size_t)row * FF2 + col) = o;
                        if (hrow) *(uint2*)(hrow + col) = o;
                        if (frow) *(float4*)(frow + col) = make_float4(v[0], v[1], v[2], v[3]); }
            }
    }
};

struct EpiUpAct {
    static constexpr bool PERM = false, AFTER_DRAIN = false;
    bf16_t* ACT; float* out; const float* cw; const float* cb; const float* sconv; LAS float* xch;
    __device__ __forceinline__ void operator()(const f32x4 (&acc)[2][2][4][2], const pg8::Unit& u, int wr, int wc, int fr, int fq) const {
        const int lane = fq * 16 + fr, wid = wr * 4 + wc;
        if (fr >= 14) {
#pragma unroll
            for (int ai = 0; ai < 2; ++ai)
#pragma unroll
                for (int bj = 0; bj < 2; ++bj)
#pragma unroll
                    for (int n = 0; n < 2; ++n) *(LAS f32x4*)(xch + ((wid * 2 + ai) * 2 + (fr - 14)) * 64 + (bj * 2 + n) * 16 + 4 * fq) = acc[ai][bj][3][n];
        }
        asm volatile("s_waitcnt lgkmcnt(0)" ::: "memory");
        __builtin_amdgcn_s_barrier(); __builtin_amdgcn_s_barrier();
        asm volatile("" ::: "memory");
        const int src1 = (lane & 48) | ((lane - 1) & 15), src2 = (lane & 48) | ((lane - 2) & 15);
#pragma unroll
        for (int bj = 0; bj < 2; ++bj) {
            const int e = 64 * bj + 16 * wc + 4 * fq, gcol = 128 * u.pn + e, ucol = FF + gcol;
            const float4 wg0 = *(const float4*)(cw + gcol), wg1 = *(const float4*)(cw + FF2 + gcol), wg2 = *(const float4*)(cw + 2 * FF2 + gcol), bg = *(const float4*)(cb + gcol);
            const float4 wu0 = *(const float4*)(cw + ucol), wu1 = *(const float4*)(cw + FF2 + ucol), wu2 = *(const float4*)(cw + 2 * FF2 + ucol), bu = *(const float4*)(cb + ucol);
            const float w0g[4] = {wg0.x, wg0.y, wg0.z, wg0.w}, w1g[4] = {wg1.x, wg1.y, wg1.z, wg1.w}, w2g[4] = {wg2.x, wg2.y, wg2.z, wg2.w}, bgg[4] = {bg.x, bg.y, bg.z, bg.w};
            const float w0u[4] = {wu0.x, wu0.y, wu0.z, wu0.w}, w1u[4] = {wu1.x, wu1.y, wu1.z, wu1.w}, w2u[4] = {wu2.x, wu2.y, wu2.z, wu2.w}, buu[4] = {bu.x, bu.y, bu.z, bu.w};
#pragma unroll
            for (int ai = 0; ai < 2; ++ai) {
                const int swr = wr ^ 1, sai = (wr == 1) ? ai : 0;
                const LAS float* xs = xch + (((swr * 4 + wc) * 2 + sai) * 2) * 64 + (bj * 2) * 16 + 4 * fq;
                f32x4 pg1 = *(const LAS f32x4*)(xs + 64), pg2 = *(const LAS f32x4*)(xs), pu1 = *(const LAS f32x4*)(xs + 64 + 16), pu2 = *(const LAS f32x4*)(xs + 16);
                f32x4 g1p = pg1, g2p = (fr == 1) ? pg1 : pg2, u1p = pu1, u2p = (fr == 1) ? pu1 : pu2;
#pragma unroll
                for (int m = 0; m < 4; ++m) {
                    const int r = 128 * ai + 64 * wr + 16 * m + fr; const int R = UP_STEP * u.pm - 2 + r;
                    const f32x4 gc = acc[ai][bj][m][0], uc = acc[ai][bj][m][1];
                    f32x4 g1r, g2r, u1r, u2r;
#pragma unroll
                    for (int j = 0; j < 4; ++j) { g1r[j] = __shfl(gc[j], src1); g2r[j] = __shfl(gc[j], src2); u1r[j] = __shfl(uc[j], src1); u2r[j] = __shfl(uc[j], src2); }
                    f32x4 g1 = (fr >= 1) ? g1r : g1p, g2 = (fr >= 2) ? g2r : g2p, u1 = (fr >= 1) ? u1r : u1p, u2 = (fr >= 2) ? u2r : u2p;
                    g1p = g1r; g2p = g2r; u1p = u1r; u2p = u2r;
                    const bool emit = (r >= 2) && (R < MB);
                    if (emit) {
                        float* frow = nullptr;
                        if (R < MP) { const int t = R & (TP - 1);
                            if (t == 0) { g1 = (f32x4){0.f, 0.f, 0.f, 0.f}; u1 = g1; }
                            if (t <= 1) { g2 = (f32x4){0.f, 0.f, 0.f, 0.f}; u2 = g2; }
                            if (t >= TP - 2) frow = out + O_PCONV + ((size_t)(R >> 12) * 2 + (t - (TP - 2))) * FF2;
                        } else { const int s = R - MP, b = s >> 3, tt = s & 7; const float* sp = sconv + (size_t)b * 2 * FF2;
                            if (tt == 0) { const float4 a = *(const float4*)(sp + FF2 + gcol), c = *(const float4*)(sp + FF2 + ucol); g1 = (f32x4){a.x, a.y, a.z, a.w}; u1 = (f32x4){c.x, c.y, c.z, c.w}; }
                            if (tt <= 1) { const float4 a = *(const float4*)(sp + (tt == 0 ? 0 : FF2) + gcol), c = *(const float4*)(sp + (tt == 0 ? 0 : FF2) + ucol); g2 = (f32x4){a.x, a.y, a.z, a.w}; u2 = (f32x4){c.x, c.y, c.z, c.w}; }
                            if (tt >= 6) frow = out + O_SCONV + ((size_t)b * 2 + (tt - 6)) * FF2;
                        }
                        float o[4];
#pragma unroll
                        for (int j = 0; j < 4; ++j) { const float cgv = w0g[j] * g2[j] + w1g[j] * g1[j] + w2g[j] * gc[j] + bgg[j], cuv = w0u[j] * u2[j] + w1u[j] * u1[j] + w2u[j] * uc[j] + buu[j];
                            o[j] = cgv * sigmoidf_(cgv) * cuv; }
                        uint2 w; w.x = pk2(o[0], o[1]); w.y = pk2(o[2], o[3]);
                        *(uint2*)(ACT + (size_t)R * FF + gcol) = w;
                        if (frow) { *(float4*)(frow + gcol) = make_float4(gc[0], gc[1], gc[2], gc[3]); *(float4*)(frow + ucol) = make_float4(uc[0], uc[1], uc[2], uc[3]); }
                    }
                }
            }
        }
    }
};

__device__ __forceinline__ int rowA_of(int rowB) { return rowB < MP ? rowB : MP + ((rowB - MP) >> 3) * 9 + 1 + ((rowB - MP) & 7); }
__device__ __forceinline__ void phase_alora(const Params& p, int tid, int G, int bid) {
    const bf16_t* PR = (const bf16_t*)(p.ws + WS_PROJRW); bf16_t* AL = (bf16_t*)(p.ws + WS_ALORA); const float* mu = p.in[I_MU];
    const int gt = bid * NTHREADS + tid, NT = G * NTHREADS;
    for (int i = gt; i < MB * 64; i += NT) {
        const int rowB = i >> 6, c = (i & 63) * 4, rowA = rowA_of(rowB);
        const uint2 cur = *(const uint2*)(PR + (size_t)rowA * RCOLS + 1536 + c);
        uint2 prv = make_uint2(0u, 0u);
        if (!(rowB < MP && (rowB & (TP - 1)) == 0)) prv = *(const uint2*)(PR + (size_t)(rowA - 1) * RCOLS + 1536 + c);
        const float4 m4 = *(const float4*)(mu + 1536 + c);
        float x[4] = {bflo(cur.x), bfhi(cur.x), bflo(cur.y), bfhi(cur.y)}; const float pv[4] = {bflo(prv.x), bfhi(prv.x), bflo(prv.y), bfhi(prv.y)}; const float mm[4] = {m4.x, m4.y, m4.z, m4.w};
#pragma unroll
        for (int j = 0; j < 4; ++j) { float v = x[j] + (pv[j] - x[j]) * mm[j];
            if (c < 64) v = tanhf(v); else if (c >= 128) v = sigmoidf_(v);
            x[j] = v; }
        uint2 o; o.x = pk2(x[0], x[1]); o.y = pk2(x[2], x[3]);
        *(uint2*)(AL + (size_t)rowB * KLORA + c) = o;
    }
}


__device__ __forceinline__ void phase_vtrans(const Params& p, LAS unsigned char* lds, int tid, int G, int bid) {
    const bf16_t* VR = (const bf16_t*)(p.ws + WS_VROW);
    constexpr int PITCH = 132;
    for (int item = bid; item < BP * 8 * 8; item += G) {
        const int b = item >> 6, h = (item >> 3) & 7, t0 = (item & 7) * 512;
        __syncthreads();
#pragma unroll
        for (int i = 0; i < 8; ++i) { const int piece = tid + 512 * i, row = piece >> 3, c8 = piece & 7;
            const uint4 v = *(const uint4*)(VR + (size_t)(b * TP + t0 + row) * 512 + h * 64 + c8 * 8);
            LAS u32* dst = (LAS u32*)(lds + row * PITCH + c8 * 16); dst[0] = v.x; dst[1] = v.y; dst[2] = v.z; dst[3] = v.w; }
        __syncthreads();
#pragma unroll 1
        for (int lay = 0; lay < 3; ++lay) {
            const int dd = lay == 0 ? 1 : (lay == 1 ? 4 : 16); const int Tdd = TP / dd;
            bf16_t* VT = (bf16_t*)(p.ws + (lay == 0 ? WS_VT1 : (lay == 1 ? WS_VT4 : WS_VT16))) + (size_t)(b * 8 + h) * 64 * TP;
            const int chunk0 = (t0 / dd) >> 5;
#pragma unroll
            for (int i = 0; i < 8; ++i) {
                const int sidx = tid + 512 * i, g = sidx & 3, d = (sidx >> 2) & 63, rc = sidx >> 8;
                int r, cl; if (lay == 0) { r = 0; cl = rc; } else if (lay == 1) { r = rc & 3; cl = rc >> 2; } else { r = rc; cl = 0; }
                u32 w[4];
#pragma unroll
                for (int hf = 0; hf < 2; ++hf)
#pragma unroll
                    for (int jp = 0; jp < 2; ++jp) {
                        const int u5a = 16 * hf + 4 * g + 2 * jp; const int ta = (32 * cl + u5a) * dd + r, tb = ta + dd;
                        const u32 lo = *(const LAS unsigned short*)(lds + ta * PITCH + d * 2), hi = *(const LAS unsigned short*)(lds + tb * PITCH + d * 2);
                        w[hf * 2 + jp] = lo | (hi << 16);
                    }
                *(uint4*)(VT + (size_t)r * Tdd * 64 + (size_t)(chunk0 + cl) * 2048 + d * 32 + 8 * g) = make_uint4(w[0], w[1], w[2], w[3]);
            }
        }
    }
    __syncthreads();
}

constexpr int CH = 32;
constexpr int SST = 452;
constexpr int SI_W = 0, SI_A = 64, SI_B = 128, SI_K = 192, SI_WR = 256, SI_V = 320, SI_G = 384, SI_SC = 448;
struct PrepRegs { uint2 cr, ck, cv, pr, pk, pv, dw, da, dg; };
__device__ __forceinline__ void scan_item(const Params& p, LAS unsigned char* lds, int tid, bool sample, int b, int h, int half) {
    const bf16_t* PR = (const bf16_t*)(p.ws + WS_PROJRW); const bf16_t* DAG = (const bf16_t*)((const unsigned char*)p.out + SC_B);
    float* YG = (float*)(p.ws + WS_Y);
    LAS float* buf0 = (LAS float*)lds; LAS float* buf1 = buf0 + CH * SST; LAS float* ybuf = buf1 + CH * SST;
    const int T = sample ? TS : TP;
    const int rowB0 = sample ? MP + b * TS : b * TP;
    const int rowA0 = sample ? MP + b * 9 + 1 : b * TP;
    const int nch = (T + CH - 1) / CH;
    const int ptl = tid >> 4, pj = (tid & 15) * 4, pc = h * 64 + pj;
    const int lane = tid & 63, wv = tid >> 6, rg = wv * 4 + (lane >> 4), cgi = lane & 15;
    const int row = 32 * half + rg;
    float st[4];
    if (sample) {
        const float4 a = *(const float4*)(p.in[I_SWKV] + ((size_t)(b * 8 + h) * 64 + row) * 64 + 4 * cgi);
        st[0] = a.x; st[1] = a.y; st[2] = a.z; st[3] = a.w;
    } else {
#pragma unroll
        for (int j = 0; j < 4; ++j) st[j] = 0.f;
    }
    const float4 mur = *(const float4*)(p.in[I_MU] + pc), muk = *(const float4*)(p.in[I_MU] + 512 + pc), muv = *(const float4*)(p.in[I_MU] + 1024 + pc);
    const float4 kk4 = *(const float4*)(p.in[I_KK] + pc), ka4 = *(const float4*)(p.in[I_KA] + pc), rk4 = *(const float4*)(p.in[I_RK] + pc);
    __builtin_amdgcn_s_waitcnt(0x0F70);
    PrepRegs R;
#define SCAN_LOAD(chunk) do { const int t_ = (chunk) * CH + ptl; if (t_ < T) { const size_t ra = (size_t)(rowA0 + t_) * RCOLS + pc; const size_t rb = (size_t)(rowB0 + t_) * NLORA + pc; \
        R.cr = *(const uint2*)(PR + ra); R.ck = *(const uint2*)(PR + ra + 512); R.cv = *(const uint2*)(PR + ra + 1024); \
        if (!sample && t_ == 0) { R.pr = make_uint2(0u, 0u); R.pk = R.pr; R.pv = R.pr; } \
        else { R.pr = *(const uint2*)(PR + ra - RCOLS); R.pk = *(const uint2*)(PR + ra - RCOLS + 512); R.pv = *(const uint2*)(PR + ra - RCOLS + 1024); } \
        R.dw = *(const uint2*)(DAG + rb); R.da = *(const uint2*)(DAG + rb + 512); R.dg = *(const uint2*)(DAG + rb + 1024); } } while (0)
#define SCAN_PREP(chunk, dstbuf) do { const int t_ = (chunk) * CH + ptl; if (t_ < T) { \
        const float mr[4] = {mur.x, mur.y, mur.z, mur.w}, mk[4] = {muk.x, muk.y, muk.z, muk.w}, mv[4] = {muv.x, muv.y, muv.z, muv.w}; \
        const float kkc[4] = {kk4.x, kk4.y, kk4.z, kk4.w}, kac[4] = {ka4.x, ka4.y, ka4.z, ka4.w}, rkc[4] = {rk4.x, rk4.y, rk4.z, rk4.w}; \
        const float crr[4] = {bflo(R.cr.x), bfhi(R.cr.x), bflo(R.cr.y), bfhi(R.cr.y)}, ckk[4] = {bflo(R.ck.x), bfhi(R.ck.x), bflo(R.ck.y), bfhi(R.ck.y)}, cvv[4] = {bflo(R.cv.x), bfhi(R.cv.x), bflo(R.cv.y), bfhi(R.cv.y)}; \
        const float prr[4] = {bflo(R.pr.x), bfhi(R.pr.x), bflo(R.pr.y), bfhi(R.pr.y)}, pkk[4] = {bflo(R.pk.x), bfhi(R.pk.x), bflo(R.pk.y), bfhi(R.pk.y)}, pvv[4] = {bflo(R.pv.x), bfhi(R.pv.x), bflo(R.pv.y), bfhi(R.pv.y)}; \
        const float lw[4] = {bflo(R.dw.x), bfhi(R.dw.x), bflo(R.dw.y), bfhi(R.dw.y)}, aa[4] = {bflo(R.da.x), bfhi(R.da.x), bflo(R.da.y), bfhi(R.da.y)}, gg[4] = {bflo(R.dg.x), bfhi(R.dg.x), bflo(R.dg.y), bfhi(R.dg.y)}; \
        float r_[4], k_[4], v_[4], w_[4], kn[4], k2[4]; float nrm = 0.f; \
        _Pragma("unroll") for (int j = 0; j < 4; ++j) { r_[j] = crr[j] + (prr[j] - crr[j]) * mr[j]; k_[j] = ckk[j] + (pkk[j] - ckk[j]) * mk[j]; v_[j] = cvv[j] + (pvv[j] - cvv[j]) * mv[j]; \
            w_[j] = __expf(lw[j]); kn[j] = k_[j] * kkc[j]; nrm += kn[j] * kn[j]; k2[j] = k_[j] * (1.f + (aa[j] - 1.f) * kac[j]); } \
        nrm = row16_sum(nrm); const float inv = 1.f / fmaxf(sqrtf(nrm), 1e-12f); \
        float br = 0.f, kr = 0.f, rk = 0.f; float an[4], bn[4], wrr[4]; \
        _Pragma("unroll") for (int j = 0; j < 4; ++j) { const float kkn = kn[j] * inv; an[j] = -kkn; bn[j] = kkn * aa[j]; wrr[j] = w_[j] * r_[j]; br += bn[j] * r_[j]; kr += k2[j] * r_[j]; rk += r_[j] * k2[j] * rkc[j]; } \
        br = row16_sum(br); kr = row16_sum(kr); rk = row16_sum(rk); \
        LAS float* rec = (dstbuf) + ptl * SST; \
        *(LAS f32x4*)(rec + SI_W + pj) = (f32x4){w_[0], w_[1], w_[2], w_[3]}; *(LAS f32x4*)(rec + SI_A + pj) = (f32x4){an[0], an[1], an[2], an[3]}; \
        *(LAS f32x4*)(rec + SI_B + pj) = (f32x4){bn[0], bn[1], bn[2], bn[3]}; *(LAS f32x4*)(rec + SI_K + pj) = (f32x4){k2[0], k2[1], k2[2], k2[3]}; \
        *(LAS f32x4*)(rec + SI_WR + pj) = (f32x4){wrr[0], wrr[1], wrr[2], wrr[3]}; *(LAS f32x4*)(rec + SI_V + pj) = (f32x4){v_[0], v_[1], v_[2], v_[3]}; \
        *(LAS f32x4*)(rec + SI_G + pj) = (f32x4){gg[0], gg[1], gg[2], gg[3]}; \
        if ((tid & 15) == 0) *(LAS f32x4*)(rec + SI_SC) = (f32x4){br, kr, rk, 0.f}; } } while (0)

    SCAN_LOAD(0);
    SCAN_PREP(0, buf0);
    __syncthreads();
    for (int c = 0; c < nch; ++c) {
        LAS float* cur = (c & 1) ? buf1 : buf0; LAS float* nxt = (c & 1) ? buf0 : buf1;
        if (c + 1 < nch) SCAN_LOAD(c + 1);
        const int ns = (T - c * CH) < CH ? (T - c * CH) : CH;
        {
            const LAS float* rec = cur;
            f32x4 wA = *(const LAS f32x4*)(rec + SI_W + 4 * cgi), aA = *(const LAS f32x4*)(rec + SI_A + 4 * cgi), bA = *(const LAS f32x4*)(rec + SI_B + 4 * cgi);
            f32x4 kA = *(const LAS f32x4*)(rec + SI_K + 4 * cgi), rA = *(const LAS f32x4*)(rec + SI_WR + 4 * cgi);
            float vA = rec[SI_V + row]; pg8::f32x2 cA = *(const LAS pg8::f32x2*)(rec + SI_SC);
            f32x4 wB, aB, bB, kB, rB; float vB; pg8::f32x2 cB;
#define SCAN_FETCH(W, A, B, K, R, V, C) do { rec += SST; W = *(const LAS f32x4*)(rec + SI_W + 4 * cgi); A = *(const LAS f32x4*)(rec + SI_A + 4 * cgi); B = *(const LAS f32x4*)(rec + SI_B + 4 * cgi); \
            K = *(const LAS f32x4*)(rec + SI_K + 4 * cgi); R = *(const LAS f32x4*)(rec + SI_WR + 4 * cgi); V = rec[SI_V + row]; C = *(const LAS pg8::f32x2*)(rec + SI_SC); } while (0)
#define SCAN_STEP(W, A, B, K, R, V, C, qq) do { \
            float da = mul_(st[0], A[0]); float dw = mul_(st[0], R[0]); \
            da = fma_(st[1], A[1], da); dw = fma_(st[1], R[1], dw); da = fma_(st[2], A[2], da); dw = fma_(st[2], R[2], dw); da = fma_(st[3], A[3], da); dw = fma_(st[3], R[3], dw); \
            float tt_[4]; row16_sum2_mul4(da, dw, tt_, V, K[0], K[1], K[2], K[3]); \
            const float y = fma_(V, C[1], fma_(da, C[0], dw)); \
            _Pragma("unroll") for (int j = 0; j < 4; ++j) st[j] = fma_(st[j], W[j], fma_(da, B[j], tt_[j])); \
            yk = ((qq) == cgi) ? y : yk; } while (0)
            for (int tb = 0; tb < ns; tb += 16) {
                const int nq = (ns - tb) < 16 ? (ns - tb) : 16;
                float yk = 0.f;
                for (int q = 0; q < nq; q += 2) {
                    SCAN_FETCH(wB, aB, bB, kB, rB, vB, cB);
                    SCAN_STEP(wA, aA, bA, kA, rA, vA, cA, q);
                    SCAN_FETCH(wA, aA, bA, kA, rA, vA, cA);
                    SCAN_STEP(wB, aB, bB, kB, rB, vB, cB, q + 1);
                }
                ybuf[(tb + cgi) * 32 + rg] = yk;
            }
#undef SCAN_FETCH
#undef SCAN_STEP
        }
        __syncthreads();
        if (ptl < ns) {
            const pg8::f32x2 y2 = *(const LAS pg8::f32x2*)(ybuf + ptl * 32 + 2 * (tid & 15));
            *(float2*)(YG + (size_t)(rowB0 + c * CH + ptl) * 512 + h * 64 + 32 * half + 2 * (tid & 15)) = make_float2(y2[0], y2[1]);
        }
        if (c + 1 < nch) SCAN_PREP(c + 1, nxt);
        __syncthreads();
    }
#undef SCAN_LOAD
#undef SCAN_PREP
    float* So = p.out + (sample ? O_SWKV : O_PWKV) + ((size_t)(b * 8 + h) * 64 + row) * 64 + 4 * cgi;
    *(float4*)So = make_float4(st[0], st[1], st[2], st[3]);
}

__device__ __forceinline__ void phase_wkvfin(const Params& p, int tid, int G, int bid) {
    const bf16_t* PR = (const bf16_t*)(p.ws + WS_PROJRW); const bf16_t* DAG = (const bf16_t*)((const unsigned char*)p.out + SC_B);
    const float* YG = (const float*)(p.ws + WS_Y); bf16_t* MIX = (bf16_t*)((unsigned char*)p.out + SC_C);
    const int gt = bid * NTHREADS + tid, NT = G * NTHREADS;
    for (int i = gt; i < MB * 128; i += NT) {
        const int jq = i & 15, h = (i >> 4) & 7, rowB = i >> 7, pc = h * 64 + jq * 4, rowA = rowA_of(rowB);
        const size_t ra = (size_t)rowA * RCOLS + pc;
        const uint2 cr = *(const uint2*)(PR + ra), ck = *(const uint2*)(PR + ra + 512), cv = *(const uint2*)(PR + ra + 1024);
        uint2 pr = make_uint2(0u, 0u), pk = pr, pv = pr;
        if (!(rowB < MP && (rowB & (TP - 1)) == 0)) { pr = *(const uint2*)(PR + ra - RCOLS); pk = *(const uint2*)(PR + ra - RCOLS + 512); pv = *(const uint2*)(PR + ra - RCOLS + 1024); }
        const uint2 da = *(const uint2*)(DAG + (size_t)rowB * NLORA + 512 + pc), dg = *(const uint2*)(DAG + (size_t)rowB * NLORA + 1024 + pc);
        const float4 y4 = *(const float4*)(YG + (size_t)rowB * 512 + pc);
        const float4 mur = *(const float4*)(p.in[I_MU] + pc), muk = *(const float4*)(p.in[I_MU] + 512 + pc), muv = *(const float4*)(p.in[I_MU] + 1024 + pc);
        const float4 ka4 = *(const float4*)(p.in[I_KA] + pc), rk4 = *(const float4*)(p.in[I_RK] + pc), lw4 = *(const float4*)(p.in[I_LNW] + pc), lb4 = *(const float4*)(p.in[I_LNB] + pc);
        const float mr[4] = {mur.x, mur.y, mur.z, mur.w}, mk[4] = {muk.x, muk.y, muk.z, muk.w}, mv[4] = {muv.x, muv.y, muv.z, muv.w};
        const float kac[4] = {ka4.x, ka4.y, ka4.z, ka4.w}, rkc[4] = {rk4.x, rk4.y, rk4.z, rk4.w}, lw[4] = {lw4.x, lw4.y, lw4.z, lw4.w}, lb[4] = {lb4.x, lb4.y, lb4.z, lb4.w};
        const float crr[4] = {bflo(cr.x), bfhi(cr.x), bflo(cr.y), bfhi(cr.y)}, ckk[4] = {bflo(ck.x), bfhi(ck.x), bflo(ck.y), bfhi(ck.y)}, cvv[4] = {bflo(cv.x), bfhi(cv.x), bflo(cv.y), bfhi(cv.y)};
        const float prr[4] = {bflo(pr.x), bfhi(pr.x), bflo(pr.y), bfhi(pr.y)}, pkk[4] = {bflo(pk.x), bfhi(pk.x), bflo(pk.y), bfhi(pk.y)}, pvv[4] = {bflo(pv.x), bfhi(pv.x), bflo(pv.y), bfhi(pv.y)};
        const float aa[4] = {bflo(da.x), bfhi(da.x), bflo(da.y), bfhi(da.y)}, gg[4] = {bflo(dg.x), bfhi(dg.x), bflo(dg.y), bfhi(dg.y)};
        const float yy[4] = {y4.x, y4.y, y4.z, y4.w};
        float v_[4]; float rk = 0.f;
#pragma unroll
        for (int j = 0; j < 4; ++j) { const float r_ = crr[j] + (prr[j] - crr[j]) * mr[j], k_ = ckk[j] + (pkk[j] - ckk[j]) * mk[j]; v_[j] = cvv[j] + (pvv[j] - cvv[j]) * mv[j];
            const float k2 = k_ * (1.f + (aa[j] - 1.f) * kac[j]); rk += r_ * k2 * rkc[j]; }
        rk = row16_sum(rk);
        const float mean = row16_sum((yy[0] + yy[1]) + (yy[2] + yy[3])) * (1.f / 64.f);
        float d[4]; float vs = 0.f;
#pragma unroll
        for (int j = 0; j < 4; ++j) { d[j] = yy[j] - mean; vs += d[j] * d[j]; }
        const float rs = rsqrtf(row16_sum(vs) * (1.f / 64.f) + 64e-5f);
        float o[4];
#pragma unroll
        for (int j = 0; j < 4; ++j) o[j] = (d[j] * rs * lw[j] + lb[j] + rk * v_[j]) * gg[j];
        uint2 w; w.x = pk2(o[0], o[1]); w.y = pk2(o[2], o[3]);
        *(uint2*)(MIX + (size_t)rowB * D + pc) = w;
    }
}

__device__ __forceinline__ void attn_task(const Params& p, int task, int lane) {
    const bf16_t* Q = (const bf16_t*)(p.ws + WS_Q); const bf16_t* K = (const bf16_t*)(p.ws + WS_K);
    bf16_t* MIX = (bf16_t*)((unsigned char*)p.out + SC_C);
    const int b = task >> 11, h = (task >> 8) & 7, r16 = (task >> 4) & 15, ig = task & 15;
    const int li = lane & 15, g = lane >> 4;
    const int tq = r16 + 16 * (16 * ig + li);
    const bf16_t* qp = Q + (size_t)(b * TP + tq) * 512 + h * 64 + 8 * g;
    const bf16x8 qf0 = *(const bf16x8*)qp, qf1 = *(const bf16x8*)(qp + 32);
    float m_run = -1e30f, l_run = 0.f;
    f32x4 o[4];
#pragma unroll
    for (int i = 0; i < 4; ++i) o[i] = (f32x4){0.f, 0.f, 0.f, 0.f};
#pragma unroll 1
    for (int br = 0; br < 3; ++br) {
        int dd, r, uq0, Tdd; const bf16_t* VT;
        if (br == 0) { dd = 16; r = r16; uq0 = 16 * ig; Tdd = TP / 16; VT = (const bf16_t*)(p.ws + WS_VT16); }
        else if (br == 1) { dd = 4; r = r16 & 3; uq0 = (r16 >> 2) + 64 * ig; Tdd = TP / 4; VT = (const bf16_t*)(p.ws + WS_VT4); }
        else { dd = 1; r = 0; uq0 = r16 + 256 * ig; Tdd = TP; VT = (const bf16_t*)(p.ws + WS_VT1); }
        const int s = 16 / dd, uq = uq0 + s * li;
        int ulo = uq0 - 128; if (ulo < 0) ulo = 0; ulo &= ~31;
        const int uhi = uq0 + 15 * s;
        const bf16_t* Kb = K + ((size_t)b * TP + r) * 512 + h * 64 + 8 * g;
        const bf16_t* Vb = VT + (size_t)(b * 8 + h) * 64 * TP + (size_t)r * Tdd * 64 + li * 32 + 8 * g;
        bf16x8 kx0, kx1, ky0, ky1, vf[4];
        { const bf16_t* kx = Kb + (size_t)(ulo + li) * dd * 512; const bf16_t* ky = kx + (size_t)16 * dd * 512;
          kx0 = *(const bf16x8*)kx; kx1 = *(const bf16x8*)(kx + 32); ky0 = *(const bf16x8*)ky; ky1 = *(const bf16x8*)(ky + 32);
#pragma unroll
          for (int dt = 0; dt < 4; ++dt) vf[dt] = *(const bf16x8*)(Vb + (size_t)(ulo >> 5) * 2048 + dt * 512); }
#pragma unroll 1
        for (int kt = ulo; kt <= uhi; kt += 32) {
            const int ktn = (kt + 32 <= uhi) ? kt + 32 : kt;
            const bf16_t* nkx = Kb + (size_t)(ktn + li) * dd * 512; const bf16_t* nky = nkx + (size_t)16 * dd * 512;
            const bf16x8 nkx0 = *(const bf16x8*)nkx, nkx1 = *(const bf16x8*)(nkx + 32), nky0 = *(const bf16x8*)nky, nky1 = *(const bf16x8*)(nky + 32);
            bf16x8 nvf[4];
#pragma unroll
            for (int dt = 0; dt < 4; ++dt) nvf[dt] = *(const bf16x8*)(Vb + (size_t)(ktn >> 5) * 2048 + dt * 512);
            f32x4 sx = (f32x4){0.f, 0.f, 0.f, 0.f}, sy = (f32x4){0.f, 0.f, 0.f, 0.f};
            sx = __builtin_amdgcn_mfma_f32_16x16x32_bf16(kx0, qf0, sx, 0, 0, 0); sx = __builtin_amdgcn_mfma_f32_16x16x32_bf16(kx1, qf1, sx, 0, 0, 0);
            sy = __builtin_amdgcn_mfma_f32_16x16x32_bf16(ky0, qf0, sy, 0, 0, 0); sy = __builtin_amdgcn_mfma_f32_16x16x32_bf16(ky1, qf1, sy, 0, 0, 0);
            float sv[8]; bool ok[8]; float tmax = -1e30f;
#pragma unroll
            for (int j = 0; j < 4; ++j) { const int dx = uq - (kt + 4 * g + j), dy = dx - 16;
                ok[j] = (unsigned)dx <= 128u; ok[4 + j] = (unsigned)dy <= 128u; sv[j] = ok[j] ? sx[j] : -1e30f; sv[4 + j] = ok[4 + j] ? sy[j] : -1e30f;
                tmax = fmaxf(tmax, fmaxf(sv[j], sv[4 + j])); }
            tmax = fmaxf(tmax, __shfl_xor(tmax, 16)); tmax = fmaxf(tmax, __shfl_xor(tmax, 32));
            const float m_new = fmaxf(m_run, tmax), alpha = __expf(m_run - m_new);
            float pe[8]; float ps = 0.f;
#pragma unroll
            for (int j = 0; j < 8; ++j) { pe[j] = ok[j] ? __expf(sv[j] - m_new) : 0.f; ps += pe[j]; }
            l_run = l_run * alpha + ps; m_run = m_new;
            u32x4 pw; pw[0] = pk2(pe[0], pe[1]); pw[1] = pk2(pe[2], pe[3]); pw[2] = pk2(pe[4], pe[5]); pw[3] = pk2(pe[6], pe[7]);
            const bf16x8 pf = __builtin_bit_cast(bf16x8, pw);
#pragma unroll
            for (int dt = 0; dt < 4; ++dt) { o[dt] *= alpha; o[dt] = __builtin_amdgcn_mfma_f32_16x16x32_bf16(vf[dt], pf, o[dt], 0, 0, 0); }
            kx0 = nkx0; kx1 = nkx1; ky0 = nky0; ky1 = nky1;
#pragma unroll
            for (int dt = 0; dt < 4; ++dt) vf[dt] = nvf[dt];
        }
    }
    float lt = l_run; lt += __shfl_xor(lt, 16); lt += __shfl_xor(lt, 32);
    const float il = 1.f / lt;
    bf16_t* op = MIX + (size_t)(b * TP + tq) * D + 512 + h * 64 + 4 * g;
#pragma unroll
    for (int dt = 0; dt < 4; ++dt) { uint2 w; w.x = pk2(o[dt][0] * il, o[dt][1] * il); w.y = pk2(o[dt][2] * il, o[dt][3] * il); *(uint2*)(op + 16 * dt) = w; }
}
__device__ __forceinline__ void attn_sample_task(const Params& p, int task, int lane, LAS float* wl) {
    const bf16_t* Q = (const bf16_t*)(p.ws + WS_Q); const float* snewk = (const float*)(p.ws + WS_SNEWK); const float* snewv = (const float*)(p.ws + WS_SNEWV);
    const float* CK = p.in[I_CK]; const float* CV = p.in[I_CV];
    bf16_t* MIX = (bf16_t*)((unsigned char*)p.out + SC_C);
    const int b = task >> 6, h = (task >> 3) & 7, tt = task & 7;
    const int rowB = MP + b * TS + tt;
    asm volatile("s_waitcnt lgkmcnt(0)" ::: "memory");
    wl[lane] = bflo((u32)Q[(size_t)rowB * 512 + h * 64 + lane]);
    asm volatile("s_waitcnt lgkmcnt(0)" ::: "memory");
    float mx = -1e30f;
#pragma unroll 1
    for (int c = 0; c < 9; ++c) {
        const int br = c / 3, it = c - br * 3; const int dd = br == 0 ? 1 : (br == 1 ? 4 : 16); const int j = lane + 64 * it;
        const int jc = j <= 128 ? j : 128;
        const int idx = 2048 + tt - jc * dd;
        const float* kr = idx < 2048 ? CK + ((size_t)(b * 2048 + idx) * 8 + h) * 64 : snewk + (size_t)(b * TS + idx - 2048) * 512 + h * 64;
        float s = 0.f;
#pragma unroll
        for (int d4 = 0; d4 < 16; ++d4) { const float4 kv = *(const float4*)(kr + 4 * d4); const f32x4 qv = *(const LAS f32x4*)(wl + 4 * d4);
            s += kv.x * qv[0] + kv.y * qv[1] + kv.z * qv[2] + kv.w * qv[3]; }
        if (j > 128) s = -1e30f;
        wl[64 + c * 64 + lane] = s; mx = fmaxf(mx, s);
    }
#pragma unroll
    for (int o = 1; o < 64; o <<= 1) mx = fmaxf(mx, __shfl_xor(mx, o));
    asm volatile("s_waitcnt lgkmcnt(0)" ::: "memory");
    float ls = 0.f;
#pragma unroll 1
    for (int c = 0; c < 9; ++c) { const float s = wl[64 + c * 64 + lane]; const float e = s > -1e29f ? __expf(s - mx) : 0.f; wl[64 + c * 64 + lane] = e; ls += e; }
    ls = wave_sum(ls);
    asm volatile("s_waitcnt lgkmcnt(0)" ::: "memory");
    float acc = 0.f;
#pragma unroll 1
    for (int c = 0; c < 9; ++c) {
        const int br = c / 3, it = c - br * 3; const int dd = br == 0 ? 1 : (br == 1 ? 4 : 16); const int nj = it < 2 ? 64 : 1;
#pragma unroll 8
        for (int l2 = 0; l2 < nj; ++l2) {
            const int j = l2 + 64 * it; const int idx = 2048 + tt - j * dd;
            const float* vr = idx < 2048 ? CV + ((size_t)(b * 2048 + idx) * 8 + h) * 64 : snewv + (size_t)(b * TS + idx - 2048) * 512 + h * 64;
            acc += wl[64 + c * 64 + l2] * vr[lane];
        }
    }
    const float res = acc / ls;
    const float other = __shfl_xor(res, 1);
    if ((lane & 1) == 0) *(u32*)(MIX + (size_t)rowB * D + 512 + h * 64 + lane) = pk2(res, other);
}

__device__ __forceinline__ void phase_norm1(const Params& p, int tid, int G, int bid) {
    const int wave = tid >> 6, lane = tid & 63, gw = bid * 8 + wave, NGW = G * 8;
    const float* mix = (const float*)((const unsigned char*)p.out + SC_B); bf16_t* H2 = (bf16_t*)((unsigned char*)p.out + SC_C);
    for (int row = gw; row < MB; row += NGW) {
        const float* xrow = row < MP ? p.in[I_XP] + (size_t)row * D : p.in[I_XS] + (size_t)(row - MP) * D;
        const float4* mr = (const float4*)(mix + (size_t)row * D) + lane; const float4* xr = (const float4*)xrow + lane;
        float4 v[4], x[4]; float s = 0.f;
#pragma unroll
        for (int j = 0; j < 4; ++j) { v[j] = mr[64 * j]; x[j] = xr[64 * j]; s += (v[j].x * v[j].x + v[j].y * v[j].y) + (v[j].z * v[j].z + v[j].w * v[j].w); }
        const float rs = rsqrtf(wave_sum(s) * (1.f / D) + 1e-6f);
        float s2 = 0.f;
#pragma unroll
        for (int j = 0; j < 4; ++j) { const float4 gg = *((const float4*)p.in[I_NMPOST] + lane + 64 * j);
            x[j].x += v[j].x * rs * gg.x; x[j].y += v[j].y * rs * gg.y; x[j].z += v[j].z * rs * gg.z; x[j].w += v[j].w * rs * gg.w;
            s2 += (x[j].x * x[j].x + x[j].y * x[j].y) + (x[j].z * x[j].z + x[j].w * x[j].w);
            *((float4*)(p.out + (size_t)row * D) + lane + 64 * j) = x[j]; }
        const float rs2 = rsqrtf(wave_sum(s2) * (1.f / D) + 1e-6f);
#pragma unroll
        for (int j = 0; j < 4; ++j) { const float4 gg = *((const float4*)p.in[I_NFPRE] + lane + 64 * j);
            uint2 o; o.x = pk2(x[j].x * rs2 * gg.x, x[j].y * rs2 * gg.y); o.y = pk2(x[j].z * rs2 * gg.z, x[j].w * rs2 * gg.w);
            *((uint2*)(H2 + (size_t)(row + 2) * D) + lane + 64 * j) = o; }
    }
    for (int row = gw; row < 2 + (H2P_ROWS - MB - 2); row += NGW) {
        const int rr = row < 2 ? row : MB + row;
#pragma unroll
        for (int j = 0; j < 4; ++j) *((uint2*)(H2 + (size_t)rr * D) + lane + 64 * j) = make_uint2(0u, 0u);
    }
}
__device__ __forceinline__ void phase_act(const Params& p, int tid, int G, int bid) {
    const int wave = tid >> 6, lane = tid & 63, gw = bid * 8 + wave, NGW = G * 8;
    bf16_t* U = (bf16_t*)(p.ws + WS_U); const bf16_t* halo = (const bf16_t*)(p.ws + WS_HALO);
    const float* cw = p.in[I_CONVW]; const float* cb = p.in[I_CONVB];
    constexpr int NPI = (MP / 32) * 11, NSI = BS * 11;
    for (int it = gw; it < NPI + NSI; it += NGW) {
        const bool sample = it >= NPI; const int q = sample ? it - NPI : it; const int chunk = q / 11, cgp = q - chunk * 11;
        const int col = cgp * 256 + 4 * lane;
        const float4 wg0 = *(const float4*)(cw + col), wg1 = *(const float4*)(cw + FF2 + col), wg2 = *(const float4*)(cw + 2 * FF2 + col), bg = *(const float4*)(cb + col);
        const float4 wu0 = *(const float4*)(cw + FF + col), wu1 = *(const float4*)(cw + FF2 + FF + col), wu2 = *(const float4*)(cw + 2 * FF2 + FF + col), bu = *(const float4*)(cb + FF + col);
        float g2[4], g1[4], u2[4], u1[4];
        int row0, nrows;
        if (!sample) {
            row0 = chunk * 32; nrows = 32;
            if ((row0 & (TP - 1)) == 0) {
#pragma unroll
                for (int j = 0; j < 4; ++j) { g2[j] = 0.f; g1[j] = 0.f; u2[j] = 0.f; u1[j] = 0.f; }
            } else {
                const bf16_t* hp = halo + (size_t)chunk * 2 * FF2;
                const uint2 a = *(const uint2*)(hp + col), c2 = *(const uint2*)(hp + FF2 + col), e = *(const uint2*)(hp + FF + col), f = *(const uint2*)(hp + FF2 + FF + col);
                g2[0] = bflo(a.x); g2[1] = bfhi(a.x); g2[2] = bflo(a.y); g2[3] = bfhi(a.y); g1[0] = bflo(c2.x); g1[1] = bfhi(c2.x); g1[2] = bflo(c2.y); g1[3] = bfhi(c2.y);
                u2[0] = bflo(e.x); u2[1] = bfhi(e.x); u2[2] = bflo(e.y); u2[3] = bfhi(e.y); u1[0] = bflo(f.x); u1[1] = bfhi(f.x); u1[2] = bflo(f.y); u1[3] = bfhi(f.y);
            }
        } else {
            row0 = MP + chunk * TS; nrows = TS;
            const float* sp = p.in[I_SCONV] + (size_t)chunk * 2 * FF2;
            const float4 a = *(const float4*)(sp + col), c2 = *(const float4*)(sp + FF2 + col), e = *(const float4*)(sp + FF + col), f = *(const float4*)(sp + FF2 + FF + col);
            g2[0] = a.x; g2[1] = a.y; g2[2] = a.z; g2[3] = a.w; g1[0] = c2.x; g1[1] = c2.y; g1[2] = c2.z; g1[3] = c2.w;
            u2[0] = e.x; u2[1] = e.y; u2[2] = e.z; u2[3] = e.w; u1[0] = f.x; u1[1] = f.y; u1[2] = f.z; u1[3] = f.w;
        }
        const float w0g[4] = {wg0.x, wg0.y, wg0.z, wg0.w}, w1g[4] = {wg1.x, wg1.y, wg1.z, wg1.w}, w2g[4] = {wg2.x, wg2.y, wg2.z, wg2.w}, bgg[4] = {bg.x, bg.y, bg.z, bg.w};
        const float w0u[4] = {wu0.x, wu0.y, wu0.z, wu0.w}, w1u[4] = {wu1.x, wu1.y, wu1.z, wu1.w}, w2u[4] = {wu2.x, wu2.y, wu2.z, wu2.w}, buu[4] = {bu.x, bu.y, bu.z, bu.w};
        for (int r0 = 0; r0 < nrows; r0 += 8) {
            uint2 gv[8], uv[8];
#pragma unroll
            for (int i = 0; i < 8; ++i) { const bf16_t* rp = U + (size_t)(row0 + r0 + i) * FF2 + col; gv[i] = *(const uint2*)rp; uv[i] = *(const uint2*)(rp + FF); }
#pragma unroll
            for (int i = 0; i < 8; ++i) {
                const float gc[4] = {bflo(gv[i].x), bfhi(gv[i].x), bflo(gv[i].y), bfhi(gv[i].y)}, uc[4] = {bflo(uv[i].x), bfhi(uv[i].x), bflo(uv[i].y), bfhi(uv[i].y)};
                float o[4];
#pragma unroll
                for (int j = 0; j < 4; ++j) {
                    const float cgv = w0g[j] * g2[j] + w1g[j] * g1[j] + w2g[j] * gc[j] + bgg[j];
                    const float cuv = w0u[j] * u2[j] + w1u[j] * u1[j] + w2u[j] * uc[j] + buu[j];
                    o[j] = cgv * sigmoidf_(cgv) * cuv;
                    g2[j] = g1[j]; g1[j] = gc[j]; u2[j] = u1[j]; u1[j] = uc[j];
                }
                uint2 w; w.x = pk2(o[0], o[1]); w.y = pk2(o[2], o[3]);
                *(uint2*)(U + (size_t)(row0 + r0 + i) * FF2 + col) = w;
            }
        }
    }
}
__device__ __forceinline__ void phase_final(const Params& p, int tid, int G, int bid) {
    const int wave = tid >> 6, lane = tid & 63, gw = bid * 8 + wave, NGW = G * 8;
    const float* F = (const float*)(p.ws + WS_F);
    for (int row = gw; row < MB; row += NGW) {
        const float4* fr = (const float4*)(F + (size_t)row * D) + lane; float4* yr = (float4*)(p.out + (size_t)row * D) + lane;
        float4 v[4]; float s = 0.f;
#pragma unroll
        for (int j = 0; j < 4; ++j) { v[j] = fr[64 * j]; s += (v[j].x * v[j].x + v[j].y * v[j].y) + (v[j].z * v[j].z + v[j].w * v[j].w); }
        const float rs = rsqrtf(wave_sum(s) * (1.f / D) + 1e-6f);
#pragma unroll
        for (int j = 0; j < 4; ++j) { const float4 gg = *((const float4*)p.in[I_NFPOST] + lane + 64 * j); float4 x = yr[64 * j];
            x.x += v[j].x * rs * gg.x; x.y += v[j].y * rs * gg.y; x.z += v[j].z * rs * gg.z; x.w += v[j].w * rs * gg.w; yr[64 * j] = x; }
    }
}
__device__ __forceinline__ void phase_cachecopy(const Params& p, int tid, int G, int bid) {
    if (bid < 4) return;
    const int gt = (bid - 4) * NTHREADS + tid, NT = (G - 4) * NTHREADS;
    constexpr int PER_B = 2048 * 512 / 4;
    const float4* snk = (const float4*)(p.ws + WS_SNEWK); const float4* snv = (const float4*)(p.ws + WS_SNEWV);
    for (int i = gt; i < 2 * BS * PER_B; i += NT) {
        const int which = i >= BS * PER_B; const int q = which ? i - BS * PER_B : i; const int b = q / PER_B, r = q - b * PER_B;
        const float4* src = (const float4*)p.in[which ? I_CV : I_CK] + (size_t)b * PER_B;
        float4 v;
        if (r < 2040 * 128) v = src[r + 8 * 128]; else v = (which ? snv : snk)[(size_t)b * TS * 128 + (r - 2040 * 128)];
        ((float4*)(p.out + (which ? O_SV : O_SK)))[(size_t)b * PER_B + r] = v;
    }
}

template <int PH>
__device__ __forceinline__ void run_phase(const Params& p, LAS unsigned char* lds, int tid, int G, int bid) {
    if constexpr (PH == 0) { phase0(p, lds, tid, G, bid); __syncthreads(); }
    else if constexpr (PH == 1) {
        pg8::Gemm g{(const bf16_t*)((const unsigned char*)p.out + SC_B), (const bf16_t*)(p.ws + WS_WIN), MA, DIN, D, D, 256}; pg8::StaticOrder S; S.init(MA, DIN, G, bid);
        EpiProj E{(bf16_t*)(p.ws + WS_PROJRW), (bf16_t*)(p.ws + WS_Q), (bf16_t*)(p.ws + WS_K), (bf16_t*)(p.ws + WS_VROW), (bf16_t*)(p.ws + WS_VT4), (bf16_t*)(p.ws + WS_VT16),
                  (const float*)(p.ws + WS_ROPE), p.out, (float*)(p.ws + WS_SNEWK), (float*)(p.ws + WS_SNEWV)};
        pg8::gemm_phase<EpiProj, pg8::StaticOrder, false>(lds, g, S, E, nullptr);
    } else if constexpr (PH == 2) { phase_alora(p, tid, G, bid); phase_vtrans(p, lds, tid, G, bid); }
    else if constexpr (PH == 3) {
        pg8::Gemm g{(const bf16_t*)(p.ws + WS_ALORA), (const bf16_t*)(p.ws + WS_WLORA), MB, NLORA, KLORA, KLORA, 256}; pg8::StaticOrder S; S.init(MB, NLORA, G, bid);
        EpiDag E{(bf16_t*)((unsigned char*)p.out + SC_B), p.in[I_W0], p.in[I_A0]};
        pg8::gemm_phase<EpiDag, pg8::StaticOrder, false>(lds, g, S, E, nullptr);
    } else if constexpr (PH == 4 || PH == 11 || PH == 12) {
        const int NSCAN = 128;
        if (bid < NSCAN) {
            if constexpr (PH != 12) {
                scan_item(p, lds, tid, false, bid >> 4, (bid >> 1) & 7, bid & 1);
                for (int it = bid; it < 512; it += NSCAN) scan_item(p, lds, tid, true, it >> 4, (it >> 1) & 7, it & 1);
            }
        }
        if (PH == 4 || (PH == 12 && bid >= NSCAN)) {
            const int wave = tid >> 6, lane = tid & 63, x = bid & 7;
            unsigned* ctr = (unsigned*)(p.ws + WS_BAR) + (PH == 4 ? 16 : 32) + x;
            for (;;) {
                unsigned id = 0; if (lane == 0) id = __hip_atomic_fetch_add(ctr, 1u, __ATOMIC_RELAXED, __HIP_MEMORY_SCOPE_AGENT);
                id = (unsigned)__builtin_amdgcn_readfirstlane((int)id);
                if (id >= 2048u + 256u) break;
                if (id < 2048u) { const int ig = id >> 7, hh = (id >> 4) & 7, r16 = id & 15; attn_task(p, (x << 11) | (hh << 8) | (r16 << 4) | ig, lane); }
                else { const int s = id - 2048; attn_sample_task(p, ((4 * x + (s >> 6)) << 6) | (s & 63), lane, (LAS float*)(lds + wave * 4096)); }
            }
        }
    } else if constexpr (PH == 5) {
        pg8::Gemm g{(const bf16_t*)((const unsigned char*)p.out + SC_C), (const bf16_t*)(p.ws + WS_WOUT), MB, D, D, D, 256}; pg8::StaticOrder S; S.init(MB, D, G, bid);
        pg8::EpiF32 E{(float*)((unsigned char*)p.out + SC_B), D, nullptr};
        pg8::gemm_phase<pg8::EpiF32, pg8::StaticOrder, false>(lds, g, S, E, nullptr);
    } else if constexpr (PH == 6) phase_norm1(p, tid, G, bid);
    else if constexpr (PH == 7) {
        pg8::Gemm g{(const bf16_t*)((const unsigned char*)p.out + SC_C), (const bf16_t*)(p.ws + WS_WUP), UP_TILES * 256, FF2, D, D, UP_STEP}; pg8::StaticOrder S; S.init(UP_TILES * 256, FF2, G, bid);
        EpiUpAct E{(bf16_t*)(p.ws + WS_U), p.out, p.in[I_CONVW], p.in[I_CONVB], p.in[I_SCONV], (LAS float*)(lds + 131072)};
        pg8::gemm_phase<EpiUpAct, pg8::StaticOrder, false>(lds, g, S, E, nullptr);
    } else if constexpr (PH == 8) phase_act(p, tid, G, bid);
    else if constexpr (PH == 9) {
        pg8::Gemm g{(const bf16_t*)(p.ws + WS_U), (const bf16_t*)(p.ws + WS_WDN), MB, D, FF, FF, 256}; pg8::StaticOrder S; S.init(MB, D, G, bid);
        pg8::EpiF32 E{(float*)(p.ws + WS_F), D, nullptr};
        pg8::gemm_phase<pg8::EpiF32, pg8::StaticOrder, false>(lds, g, S, E, nullptr);
        phase_cachecopy(p, tid, G, bid);
    } else if constexpr (PH == 10) { phase_final(p, tid, G, bid); }
    else if constexpr (PH == 13) phase_wkvfin(p, tid, G, bid);
}
__device__ __forceinline__ void grid_bar(unsigned* ctr, unsigned target) {
    asm volatile("s_waitcnt vmcnt(0)" ::: "memory");
    __syncthreads();
    if (threadIdx.x == 0) {
        __builtin_amdgcn_fence(__ATOMIC_RELEASE, "agent");
        asm volatile("s_waitcnt vmcnt(0)" ::: "memory");
        __hip_atomic_fetch_add(ctr, 1u, __ATOMIC_RELAXED, __HIP_MEMORY_SCOPE_AGENT);
        while (__hip_atomic_load(ctr, __ATOMIC_RELAXED, __HIP_MEMORY_SCOPE_AGENT) < target) __builtin_amdgcn_s_sleep(2);
        __builtin_amdgcn_fence(__ATOMIC_ACQUIRE, "agent");
        asm volatile("s_waitcnt vmcnt(0)" ::: "memory");
    }
    __syncthreads();
}
template <int SEAM, int FIRST, int... REST>
__device__ __forceinline__ void run_program(const Params& p, LAS unsigned char* lds, cg::grid_group& grid, int tid, int G, int bid) {
    if (p.en > (int)sizeof...(REST) - 1000) run_phase<FIRST>(p, lds, tid, G, bid);
    if constexpr (sizeof...(REST) > 0) {
        if constexpr (SEAM == 0) grid.sync(); else grid_bar((unsigned*)(p.ws + WS_BAR), (unsigned)(SEAM * G));
        run_program<SEAM + 1, REST...>(p, lds, grid, tid, G, bid);
    }
}
#define PROGRAM 0, 1, 2, 3, 4, 13, 5, 6, 7, 9, 10
__global__ void __launch_bounds__(NTHREADS, 2) hymba_fwd(Params p) {
    extern __shared__ __attribute__((aligned(16))) unsigned char lds_raw[];
    LAS unsigned char* lds = (LAS unsigned char*)lds_raw;
    cg::grid_group grid = cg::this_grid();
    run_program<0, PROGRAM>(p, lds, grid, threadIdx.x, gridDim.x, blockIdx.x);
}

extern "C" void kernel_launch(void* const* d_in, const int* in_sizes, int n_in, void* d_out, int out_size, void* d_ws, size_t ws_size, hipStream_t stream) {
    static int grid = 0;
    if (grid == 0) {
        if (n_in != 28 || (size_t)out_size != O_END || ws_size < WS_TOTAL) { fprintf(stderr, "kernel_launch: unexpected sizes n_in %d out %d ws %zu (need %zu)\n", n_in, out_size, ws_size, (size_t)WS_TOTAL); grid = -1; return; }
        int dev = 0, cus = 0, per_cu = 0;
        hipGetDevice(&dev); hipDeviceGetAttribute(&cus, hipDeviceAttributeMultiprocessorCount, dev);
        if (hipFuncSetAttribute((const void*)hymba_fwd, hipFuncAttributeMaxDynamicSharedMemorySize, LDS_BYTES) != hipSuccess) { fprintf(stderr, "kernel_launch: hipFuncSetAttribute failed\n"); grid = -1; return; }
        hipOccupancyMaxActiveBlocksPerMultiprocessor(&per_cu, (const void*)hymba_fwd, NTHREADS, LDS_BYTES);
        (void)hipGetLastError();
        if (per_cu < 1) per_cu = 1;
        grid = cus;
    }
    if (grid < 0) return;
    Params p{};
    for (int i = 0; i < 28; ++i) p.in[i] = (const float*)d_in[i];
    p.out = (float*)d_out; p.ws = (unsigned char*)d_ws; p.en = 1;
    if (hipMemsetAsync((unsigned char*)d_ws + WS_BAR, 0, 256, stream) != hipSuccess) { fprintf(stderr, "kernel_launch: memset of the barrier word failed\n"); return; }
    void* args[] = {&p};
    hipError_t e = hipLaunchCooperativeKernel((const void*)hymba_fwd, dim3(grid), dim3(NTHREADS), args, LDS_BYTES, stream);
    if (e != hipSuccess) fprintf(stderr, "cooperative launch failed: %s (grid %d)\n", hipGetErrorString(e), grid);
}
```

```cpp
#include <hip/hip_runtime.h>
#include <hip/hip_cooperative_groups.h>
#include <cstdio>
#include <cstdint>
namespace pg8 {
#define PG8_LAS __attribute__((address_space(3)))
typedef unsigned short bf16_t;
typedef short bf16x8 __attribute__((ext_vector_type(8)));
typedef float f32x4 __attribute__((ext_vector_type(4)));
typedef unsigned u32x4 __attribute__((ext_vector_type(4)));
constexpr int BM = 256, BK = 64, HALF = 128, HTB = HALF * BK * 2  , STAGE_BYTES = 8 * HTB, NXCD = 8, WGM = 8;

__host__ __device__ __forceinline__ int lds_byte(int r, int c) { const int st = (r >> 4) * 2 + (c >> 5), rr = r & 15, cc = c & 31, ob = rr * 64 + cc * 2; return st * 1024 + (ob ^ (((ob >> 9) & 1) << 5)); }
__host__ __device__ __forceinline__ void stage_rc(int b, int& R, int& C) { const int st = b / 1024, sb = b % 1024, swz = sb ^ (((sb >> 9) & 1) << 5); R = (st >> 1) * 16 + swz / 64; C = (st & 1) * 32 + (swz % 64) / 2; }
__host__ __device__ __forceinline__ int perm32(int rho) { const int n = rho >> 4, i = rho & 15; return 8 * (i >> 2) + 4 * n + (i & 3); }

struct Unit { int pm, pn; };
struct Gemm { const bf16_t* A; const bf16_t* Bt; int M, N, K, lda, tile_rows; };

struct StaticOrder {
    int nM, nN, nwg, G, c;
    __host__ __device__ void init(int M, int N, int G_, int c_) { nM = M / BM; nN = N / BM; nwg = nM * nN; G = G_; c = c_; }
    __host__ __device__ bool next(int i, Unit& u) const {
        const long L = (long)i * G + c; if (L >= nwg) return false;
        int wgid = (int)L; { const int q = nwg / NXCD, r = nwg % NXCD, xcd = wgid % NXCD, off = wgid / NXCD; wgid = (xcd < r ? xcd * (q + 1) : r * (q + 1) + (xcd - r) * q) + off; }
        const int nig = WGM * nN, gid = wgid / nig, fm = gid * WGM, gsz = (nM - fm) < WGM ? (nM - fm) : WGM;
        u.pm = fm + ((wgid % nig) % gsz); u.pn = (wgid % nig) / gsz; return true;
    }
    __device__ __forceinline__ void a_ready(const Unit&) const {}
    __device__ __forceinline__ void done(const Unit&) const {}
};
__device__ __forceinline__ unsigned cvt_pk_bf16(float lo, float hi) { unsigned r; asm volatile("v_cvt_pk_bf16_f32 %0, %1, %2" : "=v"(r) : "v"(lo), "v"(hi)); return r; }
typedef float f32x2 __attribute__((ext_vector_type(2)));
struct EpiF32 {
    static constexpr bool PERM = false, AFTER_DRAIN = false;
    float* C; int ldc; const float* bias;
    __device__ __forceinline__ void operator()(const f32x4 (&acc)[2][2][4][2], const Unit& u, int wr, int wc, int fr, int fq) const {
        const int row0 = u.pm * BM + wr * 64 + fr, col0 = u.pn * BM + wc * 32 + 4 * fq;
        f32x4 bv[2][2];
#pragma unroll
        for (int bj = 0; bj < 2; ++bj)
#pragma unroll
            for (int n = 0; n < 2; ++n) bv[bj][n] = bias ? *(const f32x4*)(bias + col0 + bj * HALF + n * 16) : (f32x4){0.f, 0.f, 0.f, 0.f};
#pragma unroll
        for (int ai = 0; ai < 2; ++ai)
#pragma unroll
            for (int m = 0; m < 4; ++m) { float* rowp = C + (size_t)(row0 + ai * HALF + m * 16) * ldc + col0;
#pragma unroll
                for (int bj = 0; bj < 2; ++bj)
#pragma unroll
                    for (int n = 0; n < 2; ++n) *(f32x4*)(rowp + bj * HALF + n * 16) = acc[ai][bj][m][n] + bv[bj][n]; }
    }
};
template <class Epi, class Sched, bool STAMP = false>
__device__ __forceinline__ void gemm_phase(PG8_LAS unsigned char* lds, const Gemm g, const Sched& S, const Epi& E, unsigned long long* stamps) {
    const int tid = threadIdx.x, wid = __builtin_amdgcn_readfirstlane(tid >> 6), lane = tid & 63, wr = wid >> 2, wc = wid & 3, fr = lane & 15, fq = lane >> 4;
    const int K = g.K, nt = K / BK;
    int ts_lo = 0, ts_hi = 0, nts = 0; const unsigned long long rt_entry = STAMP ? (unsigned long long)wall_clock64() : 0ull;
#define PG8_STAMP() do { if (STAMP && wid == 0 && nts < 64) { const unsigned long long _c = (unsigned long long)clock64(); \
        ts_lo = (lane == nts) ? (int)(unsigned)_c : ts_lo; ts_hi = (lane == nts) ? (int)(unsigned)(_c >> 32) : ts_hi; ++nts; } } while (0)
    PG8_STAMP();
    unsigned voffA[2], voffB[2];
#pragma unroll
    for (int i = 0; i < 2; ++i) { int R, C; stage_rc(tid * 16 + i * 8192, R, C); const int Rb = Epi::PERM ? ((R & ~31) + perm32(R & 31)) : R;
        voffA[i] = (unsigned)(R * g.lda + C) * 2u; voffB[i] = (unsigned)(Rb * K + C) * 2u; }
    const size_t kstep = (size_t)(BK * 2);
    const size_t hstep = (size_t)HALF * K * 2, hstepA = (size_t)HALF * g.lda * 2;
    const size_t tstep = 2 * hstep, tstepA = (size_t)g.tile_rows * g.lda * 2;
    const unsigned ldsw = (unsigned)wid * 1024u;
    const int aoff = lds_byte(wr * 64 + fr, fq * 8), boff = lds_byte(wc * 32 + fr, fq * 8);
#define PG8_SA(b, h) (((b) * 2 + (h)) * HTB)
#define PG8_SB(b, h) ((4 + (b) * 2 + (h)) * HTB)
#define PG8_STAGE(bufoff, gbase, voff) do { _Pragma("unroll") for (int _i = 0; _i < 2; ++_i) \
        __builtin_amdgcn_global_load_lds((const unsigned*)((const char*)(gbase) + (voff)[_i]), (PG8_LAS unsigned*)(lds + (bufoff) + ldsw + _i * 8192), 16, 0, 0); } while (0)
#define PG8_LDA(dst, b, h) do { _Pragma("unroll") for (int m = 0; m < 4; ++m) _Pragma("unroll") for (int k = 0; k < 2; ++k) dst[m][k] = *(const PG8_LAS bf16x8*)(lds + PG8_SA(b, h) + aoff + m * 2048 + k * 1024); } while (0)
#define PG8_LDB(dst, b, h) do { _Pragma("unroll") for (int n = 0; n < 2; ++n) _Pragma("unroll") for (int k = 0; k < 2; ++k) dst[n][k] = *(const PG8_LAS bf16x8*)(lds + PG8_SB(b, h) + boff + n * 2048 + k * 1024); } while (0)
#define PG8_MMA(ai, bj, At, Bt) do { __builtin_amdgcn_s_setprio(1); _Pragma("unroll") for (int m = 0; m < 4; ++m) _Pragma("unroll") for (int n = 0; n < 2; ++n) _Pragma("unroll") for (int k = 0; k < 2; ++k) \
        acc[ai][bj][m][n] = __builtin_amdgcn_mfma_f32_16x16x32_bf16(Bt[n][k], At[m][k], acc[ai][bj][m][n], 0, 0, 0); __builtin_amdgcn_s_setprio(0); } while (0)
#define PG8_WAIT_V(n) asm volatile("s_waitcnt vmcnt(" #n ")" ::: "memory")
#define PG8_WAIT_L(n) asm volatile("s_waitcnt lgkmcnt(" #n ")" ::: "memory")
#define PG8_BAR __builtin_amdgcn_s_barrier()
#define PG8_SCHED __builtin_amdgcn_sched_barrier(0)
    Unit cur, nxt; int ui = 0;
    if (!S.next(0, cur)) return;
    f32x4 acc[2][2][4][2];
#pragma unroll
    for (int a = 0; a < 2; ++a)
#pragma unroll
        for (int b = 0; b < 2; ++b)
#pragma unroll
            for (int m = 0; m < 4; ++m)
#pragma unroll
                for (int n = 0; n < 2; ++n) acc[a][b][m][n] = (f32x4){0.f, 0.f, 0.f, 0.f};
    bf16x8 At[4][2], B0[2][2], B1[2][2];
    const char* cA = (const char*)g.A + (size_t)cur.pm * tstepA; const char* cB = (const char*)g.Bt + (size_t)cur.pn * tstep;
    S.a_ready(cur);
    PG8_STAGE(PG8_SB(0, 0), cB, voffB); PG8_STAGE(PG8_SA(0, 0), cA, voffA); PG8_STAGE(PG8_SB(0, 1), cB + hstep, voffB); PG8_STAGE(PG8_SA(0, 1), cA + hstepA, voffA);
    if (wr == 1) PG8_BAR;
    PG8_WAIT_V(4); PG8_BAR;
    PG8_STAGE(PG8_SB(1, 0), cB + kstep, voffB); PG8_STAGE(PG8_SA(1, 0), cA + kstep, voffA); PG8_STAGE(PG8_SB(1, 1), cB + hstep + kstep, voffB);
    PG8_WAIT_V(6); PG8_BAR;
    PG8_STAMP();
    for (;;) {
        const bool has_next = S.next(ui + 1, nxt);
        const char* nA = has_next ? (const char*)g.A + (size_t)nxt.pm * tstepA : cA; const char* nB = has_next ? (const char*)g.Bt + (size_t)nxt.pn * tstep : cB;
        for (int t = 0; t < nt; t += 2) {
            const bool last = (t == nt - 2);
            const char* a1 = cA + (size_t)(t + 1) * kstep;
            const char* a2 = last ? nA : cA + (size_t)(t + 2) * kstep; const char* b2 = last ? nB : cB + (size_t)(t + 2) * kstep;
            const char* a3 = a2 + kstep; const char* b3 = b2 + kstep;
            if (last && has_next) S.a_ready(nxt);
            PG8_LDB(B0, 0, 0); PG8_SCHED; PG8_LDA(At, 0, 0); PG8_STAGE(PG8_SA(1, 1), a1 + hstepA, voffA);
            PG8_WAIT_L(8); PG8_BAR; PG8_WAIT_L(0); PG8_MMA(0, 0, At, B0); PG8_BAR; PG8_SCHED;
            PG8_LDB(B1, 0, 1); PG8_STAGE(PG8_SB(0, 0), b2, voffB);
            PG8_BAR; PG8_WAIT_L(0); PG8_MMA(0, 1, At, B1); PG8_BAR;
            PG8_LDA(At, 0, 1); PG8_STAGE(PG8_SA(0, 0), a2, voffA);
            PG8_BAR; PG8_WAIT_L(0); PG8_MMA(1, 0, At, B0); PG8_BAR; PG8_SCHED;
            PG8_STAGE(PG8_SB(0, 1), b2 + hstep, voffB);
            PG8_WAIT_V(6); PG8_BAR; PG8_MMA(1, 1, At, B1); PG8_BAR;
            PG8_LDB(B0, 1, 0); PG8_SCHED; PG8_LDA(At, 1, 0); PG8_STAGE(PG8_SA(0, 1), a2 + hstepA, voffA);
            PG8_WAIT_L(8); PG8_BAR; PG8_WAIT_L(0); PG8_MMA(0, 0, At, B0); PG8_BAR; PG8_SCHED;
            PG8_LDB(B1, 1, 1); PG8_STAGE(PG8_SB(1, 0), b3, voffB);
            PG8_BAR; PG8_WAIT_L(0); PG8_MMA(0, 1, At, B1); PG8_BAR;
            PG8_LDA(At, 1, 1); PG8_STAGE(PG8_SA(1, 0), a3, voffA);
            PG8_BAR; PG8_WAIT_L(0); PG8_MMA(1, 0, At, B0); PG8_BAR; PG8_SCHED;
            PG8_STAGE(PG8_SB(1, 1), b3 + hstep, voffB);
            PG8_WAIT_V(6); PG8_BAR; PG8_MMA(1, 1, At, B1); PG8_BAR;
        }
        PG8_STAMP();
        if constexpr (!Epi::AFTER_DRAIN) { E(acc, cur, wr, wc, fr, fq); S.done(cur); }
        PG8_STAMP();
        if (!has_next) break;
#pragma unroll
        for (int a = 0; a < 2; ++a)
#pragma unroll
            for (int b = 0; b < 2; ++b)
#pragma unroll
                for (int m = 0; m < 4; ++m)
#pragma unroll
                    for (int n = 0; n < 2; ++n) acc[a][b][m][n] = (f32x4){0.f, 0.f, 0.f, 0.f};
        cur = nxt; cA = nA; cB = nB; ++ui;
    }
    PG8_WAIT_V(0);
    if (wr == 0) PG8_BAR;
    PG8_BAR;
    if constexpr (Epi::AFTER_DRAIN) { E.fused(acc, cur, wr, wc, fr, fq, lds, wid, lane); S.done(cur); }
    PG8_STAMP();
    if (STAMP && wid == 0) { stamps[lane] = lane < nts ? (((unsigned long long)(unsigned)ts_hi << 32) | (unsigned)ts_lo) : 0ull;
        if (lane == 62) stamps[62] = rt_entry; if (lane == 63) stamps[63] = (unsigned long long)wall_clock64(); }
#undef PG8_STAMP
#undef PG8_SA
#undef PG8_SB
#undef PG8_STAGE
#undef PG8_LDA
#undef PG8_LDB
#undef PG8_MMA
#undef PG8_WAIT_V
#undef PG8_WAIT_L
#undef PG8_BAR
#undef PG8_SCHED
}
}

namespace cg = cooperative_groups;
#define LAS __attribute__((address_space(3)))
typedef unsigned short bf16_t;
typedef unsigned int u32;
typedef pg8::bf16x8 bf16x8;
typedef pg8::f32x4 f32x4;
typedef pg8::u32x4 u32x4;

constexpr int D = 1024, TP = 4096, BP = 8, MP = BP * TP, BS = 32, TS = 8, MS = BS * TS;
constexpr int MB = MP + MS;
constexpr int MA = 33280;
constexpr int MA_REAL = MP + BS * 9;
constexpr int DIN = 3328, RCOLS = 1792, FF = 2816, FF2 = 5632, NLORA = 1536, KLORA = 256;
constexpr int NTHREADS = 512;
constexpr int UP_TILES = 131, UP_STEP = 254, H2P_ROWS = (UP_TILES - 1) * UP_STEP + 256;
constexpr int LDS_BYTES = 144 * 1024;

constexpr size_t O_YP = 0;
constexpr size_t O_YS = O_YP + (size_t)MP * D;
constexpr size_t O_PSH = O_YS + (size_t)MS * D;
constexpr size_t O_PWKV = O_PSH + (size_t)BP * D;
constexpr size_t O_PK = O_PWKV + (size_t)BP * 8 * 64 * 64;
constexpr size_t O_PV = O_PK + (size_t)BP * 2048 * 512;
constexpr size_t O_PCONV = O_PV + (size_t)BP * 2048 * 512;
constexpr size_t O_SSH = O_PCONV + (size_t)BP * 2 * FF2;
constexpr size_t O_SWKV = O_SSH + (size_t)BS * D;
constexpr size_t O_SK = O_SWKV + (size_t)BS * 8 * 64 * 64;
constexpr size_t O_SV = O_SK + (size_t)BS * 2048 * 512;
constexpr size_t O_SCONV = O_SV + (size_t)BS * 2048 * 512;
constexpr size_t O_END = O_SCONV + (size_t)BS * 2 * FF2;

constexpr size_t al256(size_t x) { return (x + 255) & ~(size_t)255; }
constexpr size_t WS_WIN = 0;
constexpr size_t WS_WOUT = WS_WIN + al256((size_t)DIN * D * 2);
constexpr size_t WS_WUP = WS_WOUT + al256((size_t)D * D * 2);
constexpr size_t WS_WDN = WS_WUP + al256((size_t)FF2 * D * 2);
constexpr size_t WS_WLORA = WS_WDN + al256((size_t)D * FF * 2);
constexpr size_t WS_ROPE = WS_WLORA + al256((size_t)NLORA * KLORA * 2);
constexpr int NPOS = 4104;
constexpr size_t WS_SNEWK = WS_ROPE + al256((size_t)NPOS * 32 * 2 * 4);
constexpr size_t WS_SNEWV = WS_SNEWK + al256((size_t)MS * 512 * 4);
constexpr size_t WS_HALO = WS_SNEWV + al256((size_t)MS * 512 * 4);
constexpr size_t WS_A = WS_HALO + al256((size_t)1025 * 2 * FF2 * 2);
constexpr size_t WS_PROJRW = WS_A;
constexpr size_t WS_Q = WS_PROJRW + al256((size_t)MA * RCOLS * 2);
constexpr size_t WS_K = WS_Q + al256((size_t)MB * 512 * 2);
constexpr size_t WS_VT1 = WS_K + al256((size_t)MB * 512 * 2);
constexpr size_t WS_VT4 = WS_VT1 + al256((size_t)BP * 8 * 64 * TP * 2);
constexpr size_t WS_VT16 = WS_VT4 + al256((size_t)BP * 8 * 64 * TP * 2);
constexpr size_t WS_ALORA = WS_VT16 + al256((size_t)BP * 8 * 64 * TP * 2);
constexpr size_t WS_VROW = WS_ALORA + al256((size_t)MB * KLORA * 2);
constexpr size_t WS_A_EARLY_END = WS_VROW + al256((size_t)MP * 512 * 2);
constexpr size_t WS_U = WS_A;
constexpr size_t WS_F = WS_A + al256((size_t)MB * FF * 2);
static_assert(WS_F + (size_t)MB * D * 4 <= WS_A + al256((size_t)MB * FF2 * 2), "region A late overflow");
constexpr size_t WS_END = WS_A + al256((size_t)MB * FF2 * 2);
static_assert(WS_A_EARLY_END <= WS_END, "region A overflow");
constexpr size_t WS_BAR = WS_END;
constexpr size_t WS_TOTAL = WS_END + 256;
constexpr size_t WS_Y = WS_ALORA;
static_assert(WS_Y + (size_t)MB * 512 * 4 <= WS_END, "Y overflow");
constexpr size_t SC_B = O_SK * 4;
constexpr size_t SC_C = SC_B + al256((size_t)MB * D * 4);
static_assert(SC_C + (size_t)H2P_ROWS * D * 2 <= O_SCONV * 4, "scratch overflow");
static_assert((size_t)MA * D * 2 <= (size_t)MB * D * 4 && (size_t)MB * NLORA * 2 <= (size_t)MB * D * 4, "region B");

struct Params {
    const float* in[28];
    float* out;
    unsigned char* ws;
    int en, pad;
};

enum { I_XP = 0, I_XS, I_SSHIFT, I_SWKV, I_CK, I_CV, I_SCONV, I_NMPRE, I_NMPOST, I_NFPRE, I_NFPOST, I_WIN, I_MU, I_W0, I_WDEC, I_A0, I_WICLR, I_WGATE,
       I_KK, I_KA, I_RK, I_LNW, I_LNB, I_WOUT, I_WUP, I_CONVW, I_CONVB, I_WDN };

__device__ __forceinline__ float bflo(u32 p) { return __uint_as_float(p << 16); }
__device__ __forceinline__ float bfhi(u32 p) { return __uint_as_float(p & 0xffff0000u); }
__device__ __forceinline__ u32 pk2(float a, float b) { return pg8::cvt_pk_bf16(a, b); }
__device__ __forceinline__ float wave_sum(float v) {
#pragma unroll
    for (int o = 1; o < 64; o <<= 1) v += __shfl_xor(v, o);
    return v;
}
template <int N> __device__ __forceinline__ float dpp_ror(float x) {
    return __int_as_float(__builtin_amdgcn_update_dpp(0, __float_as_int(x), 0x120 + N, 0xF, 0xF, false));
}
__device__ __forceinline__ float row16_sum(float x) {
    x += dpp_ror<8>(x); x += dpp_ror<4>(x); x += dpp_ror<2>(x); x += dpp_ror<1>(x);
    return x;
}
__device__ __forceinline__ void row16_sum4(float& a, float& b, float& c, float& d) {
    asm volatile("s_nop 1\n\t"
                 "v_add_f32_dpp %0, %0, %0 row_ror:8 row_mask:0xf bank_mask:0xf\n\t" "v_add_f32_dpp %1, %1, %1 row_ror:8 row_mask:0xf bank_mask:0xf\n\t"
                 "v_add_f32_dpp %2, %2, %2 row_ror:8 row_mask:0xf bank_mask:0xf\n\t" "v_add_f32_dpp %3, %3, %3 row_ror:8 row_mask:0xf bank_mask:0xf\n\t"
                 "v_add_f32_dpp %0, %0, %0 row_ror:4 row_mask:0xf bank_mask:0xf\n\t" "v_add_f32_dpp %1, %1, %1 row_ror:4 row_mask:0xf bank_mask:0xf\n\t"
                 "v_add_f32_dpp %2, %2, %2 row_ror:4 row_mask:0xf bank_mask:0xf\n\t" "v_add_f32_dpp %3, %3, %3 row_ror:4 row_mask:0xf bank_mask:0xf\n\t"
                 "v_add_f32_dpp %0, %0, %0 row_ror:2 row_mask:0xf bank_mask:0xf\n\t" "v_add_f32_dpp %1, %1, %1 row_ror:2 row_mask:0xf bank_mask:0xf\n\t"
                 "v_add_f32_dpp %2, %2, %2 row_ror:2 row_mask:0xf bank_mask:0xf\n\t" "v_add_f32_dpp %3, %3, %3 row_ror:2 row_mask:0xf bank_mask:0xf\n\t"
                 "v_add_f32_dpp %0, %0, %0 row_ror:1 row_mask:0xf bank_mask:0xf\n\t" "v_add_f32_dpp %1, %1, %1 row_ror:1 row_mask:0xf bank_mask:0xf\n\t"
                 "v_add_f32_dpp %2, %2, %2 row_ror:1 row_mask:0xf bank_mask:0xf\n\t" "v_add_f32_dpp %3, %3, %3 row_ror:1 row_mask:0xf bank_mask:0xf\n\t"
                 "s_nop 1"
                 : "+v"(a), "+v"(b), "+v"(c), "+v"(d));
}
__device__ __forceinline__ float fma_(float a, float b, float c) { float d; asm("v_fma_f32 %0, %1, %2, %3" : "=v"(d) : "v"(a), "v"(b), "v"(c)); return d; }
__device__ __forceinline__ float mul_(float a, float b) { float d; asm("v_mul_f32 %0, %1, %2" : "=v"(d) : "v"(a), "v"(b)); return d; }
__device__ __forceinline__ void row16_sum2_mul4(float& a, float& b, float (&t)[4], float v, float k0, float k1, float k2, float k3) {
    asm volatile("v_mul_f32 %2, %6, %7\n\t" "v_mul_f32 %3, %6, %8\n\t"
                 "v_add_f32_dpp %0, %0, %0 row_ror:8 row_mask:0xf bank_mask:0xf\n\t" "v_add_f32_dpp %1, %1, %1 row_ror:8 row_mask:0xf bank_mask:0xf\n\t"
                 "v_mul_f32 %4, %6, %9\n\t"
                 "v_add_f32_dpp %0, %0, %0 row_ror:4 row_mask:0xf bank_mask:0xf\n\t" "v_add_f32_dpp %1, %1, %1 row_ror:4 row_mask:0xf bank_mask:0xf\n\t"
                 "v_mul_f32 %5, %6, %10\n\t"
                 "v_add_f32_dpp %0, %0, %0 row_ror:2 row_mask:0xf bank_mask:0xf\n\t" "v_add_f32_dpp %1, %1, %1 row_ror:2 row_mask:0xf bank_mask:0xf\n\t"
                 "s_nop 0\n\t"
                 "v_add_f32_dpp %0, %0, %0 row_ror:1 row_mask:0xf bank_mask:0xf\n\t" "v_add_f32_dpp %1, %1, %1 row_ror:1 row_mask:0xf bank_mask:0xf"
                 : "+v"(a), "+v"(b), "=&v"(t[0]), "=&v"(t[1]), "=&v"(t[2]), "=&v"(t[3])
                 : "v"(v), "v"(k0), "v"(k1), "v"(k2), "v"(k3));
}
__device__ __forceinline__ void row16_sum2(float& a, float& b) {
    asm volatile("s_nop 1\n\t"
                 "v_add_f32_dpp %0, %0, %0 row_ror:8 row_mask:0xf bank_mask:0xf\n\t" "v_add_f32_dpp %1, %1, %1 row_ror:8 row_mask:0xf bank_mask:0xf\n\t" "s_nop 0\n\t"
                 "v_add_f32_dpp %0, %0, %0 row_ror:4 row_mask:0xf bank_mask:0xf\n\t" "v_add_f32_dpp %1, %1, %1 row_ror:4 row_mask:0xf bank_mask:0xf\n\t" "s_nop 0\n\t"
                 "v_add_f32_dpp %0, %0, %0 row_ror:2 row_mask:0xf bank_mask:0xf\n\t" "v_add_f32_dpp %1, %1, %1 row_ror:2 row_mask:0xf bank_mask:0xf\n\t" "s_nop 0\n\t"
                 "v_add_f32_dpp %0, %0, %0 row_ror:1 row_mask:0xf bank_mask:0xf\n\t" "v_add_f32_dpp %1, %1, %1 row_ror:1 row_mask:0xf bank_mask:0xf\n\t"
                 "s_nop 1"
                 : "+v"(a), "+v"(b));
}
__device__ __forceinline__ float sigmoidf_(float x) { return __builtin_amdgcn_rcpf(1.f + __expf(-x)); }

__device__ __forceinline__ int win_rowmap(int n) {
    if (n < RCOLS || n >= RCOLS + 1024) return n;
    const int base = (n < RCOLS + 512) ? RCOLS : RCOLS + 512, c = n - base, unit = c >> 8, cu = c & 255, hu = cu >> 6, d = cu & 63, e = d & 31, s = d >> 5;
    const int idx = hu * 32 + e, bj = idx >> 6, wc = (idx & 63) >> 4, fq = (idx & 15) >> 2, j = idx & 3;
    return base + unit * 256 + 128 * bj + 32 * wc + 16 * s + 4 * fq + j;
}
__device__ __forceinline__ int wup_rowmap(int c) {
    const int isup = c >= FF ? 1 : 0, cc = c - FF * isup, pn = cc >> 7, e = cc & 127;
    return pn * 256 + 128 * (e >> 6) + 32 * ((e >> 4) & 3) + 16 * isup + 4 * ((e >> 2) & 3) + (e & 3);
}
__device__ __forceinline__ void transpose_item(const float* W, int K, int N, bf16_t* WT, int mode, LAS float* scr, int item, int lane) {
    const int nblk = N / 32, kb = item / nblk, nb = item % nblk, k0 = 64 * kb, n0 = 32 * nb;
#pragma unroll 8
    for (int i = 0; i < 32; ++i) { const int kk = 2 * i + (lane >> 5); scr[kk * 33 + (lane & 31)] = W[(size_t)(k0 + kk) * N + n0 + (lane & 31)]; }
    asm volatile("s_waitcnt lgkmcnt(0)" ::: "memory");
    const int c = lane & 7;
#pragma unroll
    for (int j = 0; j < 4; ++j) { const int n = (lane >> 3) + 8 * j; const LAS float* s = scr + (8 * c) * 33 + n;
        uint4 o; o.x = pk2(s[0 * 33], s[1 * 33]); o.y = pk2(s[2 * 33], s[3 * 33]); o.z = pk2(s[4 * 33], s[5 * 33]); o.w = pk2(s[6 * 33], s[7 * 33]);
        const int row = mode == 1 ? win_rowmap(n0 + n) : (mode == 2 ? wup_rowmap(n0 + n) : (n0 + n));
        *(uint4*)(WT + (size_t)row * K + k0 + 8 * c) = o; }
    asm volatile("s_waitcnt lgkmcnt(0)" ::: "memory");
}
__device__ __forceinline__ void rms_row(const float* xrow, const float* g, bf16_t* orow, float* frow, int lane) {
    const float4* xr = (const float4*)xrow + lane; const float4* gr = (const float4*)g + lane;
    float4 v[4]; float s = 0.f;
#pragma unroll
    for (int j = 0; j < 4; ++j) { v[j] = xr[64 * j]; s += (v[j].x * v[j].x + v[j].y * v[j].y) + (v[j].z * v[j].z + v[j].w * v[j].w); }
    const float rs = rsqrtf(wave_sum(s) * (1.f / D) + 1e-6f);
#pragma unroll
    for (int j = 0; j < 4; ++j) { const float4 gg = gr[64 * j];
        float4 y; y.x = v[j].x * rs * gg.x; y.y = v[j].y * rs * gg.y; y.z = v[j].z * rs * gg.z; y.w = v[j].w * rs * gg.w;
        uint2 o; o.x = pk2(y.x, y.y); o.y = pk2(y.z, y.w);
        *((uint2*)orow + lane + 64 * j) = o;
        if (frow) *((float4*)frow + lane + 64 * j) = y; }
}
__device__ __forceinline__ void phase0(const Params& p, LAS unsigned char* lds, int tid, int G, int bid) {
    const int wave = tid >> 6, lane = tid & 63, gw = bid * 8 + wave, NGW = G * 8;
    LAS float* scr = (LAS float*)(lds + wave * 16384);
    bf16_t* WinT = (bf16_t*)(p.ws + WS_WIN); bf16_t* WoutT = (bf16_t*)(p.ws + WS_WOUT); bf16_t* WupT = (bf16_t*)(p.ws + WS_WUP); bf16_t* WdnT = (bf16_t*)(p.ws + WS_WDN);
    constexpr int I1 = (D / 64) * (DIN / 32), I2 = (D / 64) * (D / 32), I3 = (D / 64) * (FF2 / 32), I4 = (FF / 64) * (D / 32);
    for (int it = gw; it < I1 + I2 + I3 + I4; it += NGW) {
        int r = it;
        if (r < I1) { transpose_item(p.in[I_WIN], D, DIN, WinT, 1, scr, r, lane); continue; } r -= I1;
        if (r < I2) { transpose_item(p.in[I_WOUT], D, D, WoutT, 0, scr, r, lane); continue; } r -= I2;
        if (r < I3) { transpose_item(p.in[I_WUP], D, FF2, WupT, 2, scr, r, lane); continue; } r -= I3;
        transpose_item(p.in[I_WDN], FF, D, WdnT, 0, scr, r, lane);
    }
    const int gt = bid * NTHREADS + tid, NT = G * NTHREADS;
    bf16_t* WL = (bf16_t*)(p.ws + WS_WLORA);
    for (int i = gt; i < NLORA * KLORA; i += NT) {
        const int row = i >> 8, k = i & 255; float v = 0.f;
        if (row < 512) { if (k < 64) v = p.in[I_WDEC][k * 512 + row]; }
        else if (row < 1024) { if (k >= 64 && k < 128) v = p.in[I_WICLR][(k - 64) * 512 + (row - 512)]; }
        else { if (k >= 128) v = p.in[I_WGATE][(k - 128) * 512 + (row - 1024)]; }
        WL[i] = (bf16_t)(pk2(v, 0.f) & 0xffffu);
    }
    float* rope = (float*)(p.ws + WS_ROPE);
    for (int i = gt; i < NPOS * 32; i += NT) {
        const int pi = i >> 5, e = i & 31; const int pos = pi < TP ? pi : 16384 + (pi - TP);
        double inv = 1.0; for (int q = 0; q < e; ++q) inv *= 0.7498942093324558273;
        const float ang = (float)pos * (float)inv;
        const double a = (double)ang; const double kq = rint(a * 0.15915494309189535); double r = a - kq * 6.283185307179586; r -= kq * 2.4492935982947064e-16;
        const double r2 = r * r;
        double sn = 1.0 / 51090942171709440000.0;
        sn = sn * r2 * (-1.0) + 1.0 / 121645100408832000.0;
        sn = -sn * r2 + 1.0 / 355687428096000.0;
        sn = -sn * r2 + 1.0 / 1307674368000.0;
        sn = -sn * r2 + 1.0 / 6227020800.0;
        sn = -sn * r2 + 1.0 / 39916800.0;
        sn = -sn * r2 + 1.0 / 362880.0;
        sn = -sn * r2 + 1.0 / 5040.0;
        sn = -sn * r2 + 1.0 / 120.0;
        sn = -sn * r2 + 1.0 / 6.0;
        sn = -sn * r2 + 1.0;
        sn *= r;
        double cs = 1.0 / 1124000727777607680000.0;
        cs = -cs * r2 + 1.0 / 2432902008176640000.0;
        cs = -cs * r2 + 1.0 / 6402373705728000.0;
        cs = -cs * r2 + 1.0 / 20922789888000.0;
        cs = -cs * r2 + 1.0 / 87178291200.0;
        cs = -cs * r2 + 1.0 / 479001600.0;
        cs = -cs * r2 + 1.0 / 3628800.0;
        cs = -cs * r2 + 1.0 / 40320.0;
        cs = -cs * r2 + 1.0 / 720.0;
        cs = -cs * r2 + 1.0 / 24.0;
        cs = -cs * r2 + 0.5;
        cs = -cs * r2 + 1.0;
        rope[i] = (float)cs; rope[NPOS * 32 + i] = (float)sn;
    }
    bf16_t* H = (bf16_t*)((unsigned char*)p.out + SC_B);
    for (int row = gw; row < MA; row += NGW) {
        bf16_t* orow = H + (size_t)row * D;
        if (row < MP) {
            const bool last = (row & (TP - 1)) == TP - 1;
            rms_row(p.in[I_XP] + (size_t)row * D, p.in[I_NMPRE], orow, last ? p.out + O_PSH + (size_t)(row >> 12) * D : nullptr, lane);
        } else {
            const int s = row - MP;
            if (s < BS * 9) {
                const int b = s / 9, j = s - b * 9;
                if (j == 0) {
                    const float4* sr = (const float4*)(p.in[I_SSHIFT] + (size_t)b * D) + lane;
#pragma unroll
                    for (int q = 0; q < 4; ++q) { const float4 v = sr[64 * q]; uint2 o; o.x = pk2(v.x, v.y); o.y = pk2(v.z, v.w); *((uint2*)orow + lane + 64 * q) = o; }
                } else {
                    rms_row(p.in[I_XS] + (size_t)(b * TS + j - 1) * D, p.in[I_NMPRE], orow, j == TS ? p.out + O_SSH + (size_t)b * D : nullptr, lane);
                }
            } else {
#pragma unroll
                for (int q = 0; q < 4; ++q) *((uint2*)orow + lane + 64 * q) = make_uint2(0u, 0u);
            }
        }
    }
}

struct EpiProj {
    static constexpr bool PERM = false, AFTER_DRAIN = false;
    bf16_t* projrw; bf16_t* Q; bf16_t* K; bf16_t* VT1; bf16_t* VT4; bf16_t* VT16; const float* rope; float* out; float* snewk; float* snewv;
    __device__ __forceinline__ void operator()(const f32x4 (&acc)[2][2][4][2], const pg8::Unit& u, int wr, int wc, int fr, int fq) const {
        const int pn = u.pn;
        if (pn < 7) {
#pragma unroll
            for (int ai = 0; ai < 2; ++ai)
#pragma unroll
                for (int m = 0; m < 4; ++m) { const int row = u.pm * 256 + ai * 128 + wr * 64 + m * 16 + fr;
                    bf16_t* rp = projrw + (size_t)row * RCOLS + pn * 256 + wc * 32 + 4 * fq;
#pragma unroll
                    for (int bj = 0; bj < 2; ++bj)
#pragma unroll
                        for (int n = 0; n < 2; ++n) { const f32x4 v = acc[ai][bj][m][n]; uint2 o; o.x = pk2(v[0], v[1]); o.y = pk2(v[2], v[3]); *(uint2*)(rp + bj * 128 + n * 16) = o; } }
            return;
        }
#pragma unroll
        for (int ai = 0; ai < 2; ++ai)
#pragma unroll
            for (int m = 0; m < 4; ++m) {
                const int row = u.pm * 256 + ai * 128 + wr * 64 + m * 16 + fr;
                bool prompt = row < MP; int b, t, rowB, pi; bool valid = true;
                if (prompt) { b = row >> 12; t = row & (TP - 1); rowB = row; pi = t; }
                else { const int s = row - MP; b = s / 9; const int j = s - b * 9; valid = (s < BS * 9) && (j > 0); t = j - 1; rowB = MP + b * TS + t; pi = TP + t; }
                if (!valid) continue;
                if (pn < 11) {
                    const bool isq = pn < 9; const int unit = isq ? pn - 7 : pn - 9;
#pragma unroll
                    for (int bj = 0; bj < 2; ++bj) {
                        const int idx = bj * 64 + wc * 16 + fq * 4, hu = idx >> 5, e = idx & 31;
                        const float4 cs = *(const float4*)(rope + (size_t)pi * 32 + e), sn = *(const float4*)(rope + (size_t)NPOS * 32 + (size_t)pi * 32 + e);
                        const f32x4 x1 = acc[ai][bj][m][0], x2 = acc[ai][bj][m][1];
                        float o1[4], o2[4];
                        o1[0] = x1[0] * cs.x - x2[0] * sn.x; o2[0] = x1[0] * sn.x + x2[0] * cs.x;
                        o1[1] = x1[1] * cs.y - x2[1] * sn.y; o2[1] = x1[1] * sn.y + x2[1] * cs.y;
                        o1[2] = x1[2] * cs.z - x2[2] * sn.z; o2[2] = x1[2] * sn.z + x2[2] * cs.z;
                        o1[3] = x1[3] * cs.w - x2[3] * sn.w; o2[3] = x1[3] * sn.w + x2[3] * cs.w;
                        const int col = unit * 256 + hu * 64 + e;
                        if (isq) {
                            uint2 a, c2; a.x = pk2(o1[0] * 0.125f, o1[1] * 0.125f); a.y = pk2(o1[2] * 0.125f, o1[3] * 0.125f); c2.x = pk2(o2[0] * 0.125f, o2[1] * 0.125f); c2.y = pk2(o2[2] * 0.125f, o2[3] * 0.125f);
                            *(uint2*)(Q + (size_t)rowB * 512 + col) = a; *(uint2*)(Q + (size_t)rowB * 512 + col + 32) = c2;
                        } else {
                            uint2 a, c2; a.x = pk2(o1[0], o1[1]); a.y = pk2(o1[2], o1[3]); c2.x = pk2(o2[0], o2[1]); c2.y = pk2(o2[2], o2[3]);
                            *(uint2*)(K + (size_t)rowB * 512 + col) = a; *(uint2*)(K + (size_t)rowB * 512 + col + 32) = c2;
                            float* dst = nullptr;
                            if (prompt) { if (t >= 2048) dst = out + O_PK + ((size_t)b * 2048 + (t - 2048)) * 512 + col; }
                            else dst = snewk + (size_t)(b * TS + t) * 512 + col;
                            if (dst) { *(float4*)dst = make_float4(o1[0], o1[1], o1[2], o1[3]); *(float4*)(dst + 32) = make_float4(o2[0], o2[1], o2[2], o2[3]); }
                        }
                    }
                } else {
#pragma unroll
                    for (int bj = 0; bj < 2; ++bj)
#pragma unroll
                        for (int n = 0; n < 2; ++n) {
                            const int col = (pn - 11) * 256 + bj * 128 + wc * 32 + n * 16 + 4 * fq; const f32x4 v = acc[ai][bj][m][n];
                            if (prompt) {
                                if (t >= 2048) *(float4*)(out + O_PV + ((size_t)b * 2048 + (t - 2048)) * 512 + col) = make_float4(v[0], v[1], v[2], v[3]);
                                uint2 o; o.x = pk2(v[0], v[1]); o.y = pk2(v[2], v[3]); *(uint2*)(VT1 + (size_t)rowB * 512 + col) = o;
                            } else {
                                *(float4*)(snewv + (size_t)(b * TS + t) * 512 + col) = make_float4(v[0], v[1], v[2], v[3]);
                            }
                        }
                }
            }
    }
};
struct EpiDag {
    static constexpr bool PERM = false, AFTER_DRAIN = false;
    bf16_t* dag; const float* w0; const float* a0;
    __device__ __forceinline__ void operator()(const f32x4 (&acc)[2][2][4][2], const pg8::Unit& u, int wr, int wc, int fr, int fq) const {
        const int kind = u.pn >> 1;
#pragma unroll
        for (int bj = 0; bj < 2; ++bj)
#pragma unroll
            for (int n = 0; n < 2; ++n) {
                const int col = u.pn * 256 + bj * 128 + wc * 32 + n * 16 + 4 * fq;
                float4 bias = make_float4(0.f, 0.f, 0.f, 0.f);
                if (kind == 0) bias = *(const float4*)(w0 + col); else if (kind == 1) bias = *(const float4*)(a0 + col - 512);
                const float bb[4] = {bias.x, bias.y, bias.z, bias.w};
#pragma unroll
                for (int ai = 0; ai < 2; ++ai)
#pragma unroll
                    for (int m = 0; m < 4; ++m) { const int row = u.pm * 256 + ai * 128 + wr * 64 + m * 16 + fr; const f32x4 v = acc[ai][bj][m][n]; float o[4];
#pragma unroll
                        for (int j = 0; j < 4; ++j) { const float x = v[j] + bb[j];
                            if (kind == 0) { const float z = -x; const float sp = fmaxf(z, 0.f) + __logf(1.f + __expf(-fabsf(z))); o[j] = -__expf(-sp - 0.5f); }
                            else if (kind == 1) o[j] = sigmoidf_(x);
                            else o[j] = x; }
                        uint2 q; q.x = pk2(o[0], o[1]); q.y = pk2(o[2], o[3]); *(uint2*)(dag + (size_t)row * NLORA + col) = q; }
            }
    }
};
struct EpiUp {
    static constexpr bool PERM = false, AFTER_DRAIN = false;
    bf16_t* U; bf16_t* halo; float* out;
    __device__ __forceinline__ void operator()(const f32x4 (&acc)[2][2][4][2], const pg8::Unit& u, int wr, int wc, int fr, int fq) const {
#pragma unroll
        for (int ai = 0; ai < 2; ++ai)
#pragma unroll
            for (int m = 0; m < 4; ++m) {
                const int row = u.pm * 256 + ai * 128 + wr * 64 + m * 16 + fr; const int col0 = u.pn * 256 + wc * 32 + 4 * fq;
                bf16_t* hrow = nullptr; float* frow = nullptr;
                if (row < MP) { const int t = row & (TP - 1);
                    if ((t & 31) >= 30) hrow = halo + ((size_t)((row >> 5) + 1) * 2 + ((t & 31) - 30)) * FF2;
                    if (t >= TP - 2) frow = out + O_PCONV + ((size_t)(row >> 12) * 2 + (t - (TP - 2))) * FF2;
                } else { const int s = row - MP, b = s >> 3, tt = s & 7; if (tt >= 6) frow = out + O_SCONV + ((size_t)b * 2 + (tt - 6)) * FF2; }
#pragma unroll
                for (int bj = 0; bj < 2; ++bj)
#pragma unroll
                    for (int n = 0; n < 2; ++n) { const f32x4 v = acc[ai][bj][m][n]; const int col = col0 + bj * 128 + n * 16;
                        uint2 o; o.x = pk2(v[0], v[1]); o.y = pk2(v[2], v[3]);
                        *(uint2*)(U + (size_t)row * FF2 + col) = o;
                        if (hrow) *(uint2*)(hrow + col) = o;
                        if (frow) *(float4*)(frow + col) = make_float4(v[0], v[1], v[2], v[3]); }
            }
    }
};

struct EpiUpAct {
    static constexpr bool PERM = false, AFTER_DRAIN = false;
    bf16_t* ACT; float* out; const float* cw; const float* cb; const float* sconv; LAS float* xch;
    __device__ __forceinline__ void operator()(const f32x4 (&acc)[2][2][4][2], const pg8::Unit& u, int wr, int wc, int fr, int fq) const {
        const int lane = fq * 16 + fr, wid = wr * 4 + wc;
        if (fr >= 14) {
#pragma unroll
            for (int ai = 0; ai < 2; ++ai)
#pragma unroll
                for (int bj = 0; bj < 2; ++bj)
#pragma unroll
                    for (int n = 0; n < 2; ++n) *(LAS f32x4*)(xch + ((wid * 2 + ai) * 2 + (fr - 14)) * 64 + (bj * 2 + n) * 16 + 4 * fq) = acc[ai][bj][3][n];
        }
        asm volatile("s_waitcnt lgkmcnt(0)" ::: "memory");
        __builtin_amdgcn_s_barrier(); __builtin_amdgcn_s_barrier();
        asm volatile("" ::: "memory");
#pragma unroll
        for (int bj = 0; bj < 2; ++bj) {
            const int e = 64 * bj + 16 * wc + 4 * fq, gcol = 128 * u.pn + e, ucol = FF + gcol;
            const float4 wg0 = *(const float4*)(cw + gcol), wg1 = *(const float4*)(cw + FF2 + gcol), wg2 = *(const float4*)(cw + 2 * FF2 + gcol), bg = *(const float4*)(cb + gcol);
            const float4 wu0 = *(const float4*)(cw + ucol), wu1 = *(const float4*)(cw + FF2 + ucol), wu2 = *(const float4*)(cw + 2 * FF2 + ucol), bu = *(const float4*)(cb + ucol);
            const float w0g[4] = {wg0.x, wg0.y, wg0.z, wg0.w}, w1g[4] = {wg1.x, wg1.y, wg1.z, wg1.w}, w2g[4] = {wg2.x, wg2.y, wg2.z, wg2.w}, bgg[4] = {bg.x, bg.y, bg.z, bg.w};
            const float w0u[4] = {wu0.x, wu0.y, wu0.z, wu0.w}, w1u[4] = {wu1.x, wu1.y, wu1.z, wu1.w}, w2u[4] = {wu2.x, wu2.y, wu2.z, wu2.w}, buu[4] = {bu.x, bu.y, bu.z, bu.w};
#pragma unroll
            for (int ai = 0; ai < 2; ++ai) {
                const int swr = wr ^ 1, sai = (wr == 1) ? ai : 0;
                const LAS float* xs = xch + (((swr * 4 + wc) * 2 + sai) * 2) * 64 + (bj * 2) * 16 + 4 * fq;
                f32x4 pg1 = *(const LAS f32x4*)(xs + 64), pg2 = *(const LAS f32x4*)(xs), pu1 = *(const LAS f32x4*)(xs + 64 + 16), pu2 = *(const LAS f32x4*)(xs + 16);
                f32x4 g1p = pg1, g2p = (fr == 1) ? pg1 : pg2, u1p = pu1, u2p = (fr == 1) ? pu1 : pu2;
#pragma unroll
                for (int m = 0; m < 4; ++m) {
                    const int r = 128 * ai + 64 * wr + 16 * m + fr; const int R = UP_STEP * u.pm - 2 + r;
                    const f32x4 gc = acc[ai][bj][m][0], uc = acc[ai][bj][m][1];
                    f32x4 g1r, g2r, u1r, u2r;
#pragma unroll
                    for (int j = 0; j < 4; ++j) { g1r[j] = dpp_ror<1>(gc[j]); g2r[j] = dpp_ror<2>(gc[j]); u1r[j] = dpp_ror<1>(uc[j]); u2r[j] = dpp_ror<2>(uc[j]); }
                    f32x4 g1 = (fr >= 1) ? g1r : g1p, g2 = (fr >= 2) ? g2r : g2p, u1 = (fr >= 1) ? u1r : u1p, u2 = (fr >= 2) ? u2r : u2p;
                    g1p = g1r; g2p = g2r; u1p = u1r; u2p = u2r;
                    const bool emit = (r >= 2) && (R < MB);
                    if (emit) {
                        float* frow = nullptr;
                        if (R < MP) { const int t = R & (TP - 1);
                            if (t == 0) { g1 = (f32x4){0.f, 0.f, 0.f, 0.f}; u1 = g1; }
                            if (t <= 1) { g2 = (f32x4){0.f, 0.f, 0.f, 0.f}; u2 = g2; }
                            if (t >= TP - 2) frow = out + O_PCONV + ((size_t)(R >> 12) * 2 + (t - (TP - 2))) * FF2;
                        } else { const int s = R - MP, b = s >> 3, tt = s & 7; const float* sp = sconv + (size_t)b * 2 * FF2;
                            if (tt == 0) { const float4 a = *(const float4*)(sp + FF2 + gcol), c = *(const float4*)(sp + FF2 + ucol); g1 = (f32x4){a.x, a.y, a.z, a.w}; u1 = (f32x4){c.x, c.y, c.z, c.w}; }
                            if (tt <= 1) { const float4 a = *(const float4*)(sp + (tt == 0 ? 0 : FF2) + gcol), c = *(const float4*)(sp + (tt == 0 ? 0 : FF2) + ucol); g2 = (f32x4){a.x, a.y, a.z, a.w}; u2 = (f32x4){c.x, c.y, c.z, c.w}; }
                            if (tt >= 6) frow = out + O_SCONV + ((size_t)b * 2 + (tt - 6)) * FF2;
                        }
                        float o[4];
#pragma unroll
                        for (int j = 0; j < 4; ++j) { const float cgv = w0g[j] * g2[j] + w1g[j] * g1[j] + w2g[j] * gc[j] + bgg[j], cuv = w0u[j] * u2[j] + w1u[j] * u1[j] + w2u[j] * uc[j] + buu[j];
                            o[j] = cgv * sigmoidf_(cgv) * cuv; }
                        uint2 w; w.x = pk2(o[0], o[1]); w.y = pk2(o[2], o[3]);
                        *(uint2*)(ACT + (size_t)R * FF + gcol) = w;
                        if (frow) { *(float4*)(frow + gcol) = make_float4(gc[0], gc[1], gc[2], gc[3]); *(float4*)(frow + ucol) = make_float4(uc[0], uc[1], uc[2], uc[3]); }
                    }
                }
            }
        }
    }
};

__device__ __forceinline__ int rowA_of(int rowB) { return rowB < MP ? rowB : MP + ((rowB - MP) >> 3) * 9 + 1 + ((rowB - MP) & 7); }
__device__ __forceinline__ void phase_alora(const Params& p, int tid, int G, int bid) {
    const bf16_t* PR = (const bf16_t*)(p.ws + WS_PROJRW); bf16_t* AL = (bf16_t*)(p.ws + WS_ALORA); const float* mu = p.in[I_MU];
    const int gt = bid * NTHREADS + tid, NT = G * NTHREADS;
    for (int i = gt; i < MB * 64; i += NT) {
        const int rowB = i >> 6, c = (i & 63) * 4, rowA = rowA_of(rowB);
        const uint2 cur = *(const uint2*)(PR + (size_t)rowA * RCOLS + 1536 + c);
        uint2 prv = make_uint2(0u, 0u);
        if (!(rowB < MP && (rowB & (TP - 1)) == 0)) prv = *(const uint2*)(PR + (size_t)(rowA - 1) * RCOLS + 1536 + c);
        const float4 m4 = *(const float4*)(mu + 1536 + c);
        float x[4] = {bflo(cur.x), bfhi(cur.x), bflo(cur.y), bfhi(cur.y)}; const float pv[4] = {bflo(prv.x), bfhi(prv.x), bflo(prv.y), bfhi(prv.y)}; const float mm[4] = {m4.x, m4.y, m4.z, m4.w};
#pragma unroll
        for (int j = 0; j < 4; ++j) { float v = x[j] + (pv[j] - x[j]) * mm[j];
            if (c < 64) v = tanhf(v); else if (c >= 128) v = sigmoidf_(v);
            x[j] = v; }
        uint2 o; o.x = pk2(x[0], x[1]); o.y = pk2(x[2], x[3]);
        *(uint2*)(AL + (size_t)rowB * KLORA + c) = o;
    }
}


__device__ __forceinline__ void phase_vtrans(const Params& p, LAS unsigned char* lds, int tid, int G, int bid) {
    const bf16_t* VR = (const bf16_t*)(p.ws + WS_VROW);
    constexpr int PITCH = 132;
    for (int item = bid; item < BP * 8 * 8; item += G) {
        const int b = item >> 6, h = (item >> 3) & 7, t0 = (item & 7) * 512;
        __syncthreads();
#pragma unroll
        for (int i = 0; i < 8; ++i) { const int piece = tid + 512 * i, row = piece >> 3, c8 = piece & 7;
            const uint4 v = *(const uint4*)(VR + (size_t)(b * TP + t0 + row) * 512 + h * 64 + c8 * 8);
            LAS u32* dst = (LAS u32*)(lds + row * PITCH + c8 * 16); dst[0] = v.x; dst[1] = v.y; dst[2] = v.z; dst[3] = v.w; }
        __syncthreads();
#pragma unroll 1
        for (int lay = 0; lay < 3; ++lay) {
            const int dd = lay == 0 ? 1 : (lay == 1 ? 4 : 16); const int Tdd = TP / dd;
            bf16_t* VT = (bf16_t*)(p.ws + (lay == 0 ? WS_VT1 : (lay == 1 ? WS_VT4 : WS_VT16))) + (size_t)(b * 8 + h) * 64 * TP;
            const int chunk0 = (t0 / dd) >> 5;
#pragma unroll
            for (int i = 0; i < 8; ++i) {
                const int sidx = tid + 512 * i, g = sidx & 3, d = (sidx >> 2) & 63, rc = sidx >> 8;
                int r, cl; if (lay == 0) { r = 0; cl = rc; } else if (lay == 1) { r = rc & 3; cl = rc >> 2; } else { r = rc; cl = 0; }
                u32 w[4];
#pragma unroll
                for (int hf = 0; hf < 2; ++hf)
#pragma unroll
                    for (int jp = 0; jp < 2; ++jp) {
                        const int u5a = 16 * hf + 4 * g + 2 * jp; const int ta = (32 * cl + u5a) * dd + r, tb = ta + dd;
                        const u32 lo = *(const LAS unsigned short*)(lds + ta * PITCH + d * 2), hi = *(const LAS unsigned short*)(lds + tb * PITCH + d * 2);
                        w[hf * 2 + jp] = lo | (hi << 16);
                    }
                *(uint4*)(VT + (size_t)r * Tdd * 64 + (size_t)(chunk0 + cl) * 2048 + d * 32 + 8 * g) = make_uint4(w[0], w[1], w[2], w[3]);
            }
        }
    }
    __syncthreads();
}

constexpr int CH = 32;
constexpr int SST = 452;
constexpr int SI_W = 0, SI_A = 64, SI_B = 128, SI_K = 192, SI_WR = 256, SI_V = 320, SI_G = 384, SI_SC = 448;
struct PrepRegs { uint2 cr, ck, cv, pr, pk, pv, dw, da, dg; };
__device__ __forceinline__ void scan_item(const Params& p, LAS unsigned char* lds, int tid, bool sample, int b, int h, int half) {
    const bf16_t* PR = (const bf16_t*)(p.ws + WS_PROJRW); const bf16_t* DAG = (const bf16_t*)((const unsigned char*)p.out + SC_B);
    float* YG = (float*)(p.ws + WS_Y);
    LAS float* buf0 = (LAS float*)lds; LAS float* buf1 = buf0 + CH * SST; LAS float* ybuf = buf1 + CH * SST;
    const int T = sample ? TS : TP;
    const int rowB0 = sample ? MP + b * TS : b * TP;
    const int rowA0 = sample ? MP + b * 9 + 1 : b * TP;
    const int nch = (T + CH - 1) / CH;
    const int ptl = tid >> 4, pj = (tid & 15) * 4, pc = h * 64 + pj;
    const int lane = tid & 63, wv = tid >> 6, rg = wv * 4 + (lane >> 4), cgi = lane & 15;
    const int row = 32 * half + rg;
    float st[4];
    if (sample) {
        const float4 a = *(const float4*)(p.in[I_SWKV] + ((size_t)(b * 8 + h) * 64 + row) * 64 + 4 * cgi);
        st[0] = a.x; st[1] = a.y; st[2] = a.z; st[3] = a.w;
    } else {
#pragma unroll
        for (int j = 0; j < 4; ++j) st[j] = 0.f;
    }
    const float4 mur = *(const float4*)(p.in[I_MU] + pc), muk = *(const float4*)(p.in[I_MU] + 512 + pc), muv = *(const float4*)(p.in[I_MU] + 1024 + pc);
    const float4 kk4 = *(const float4*)(p.in[I_KK] + pc), ka4 = *(const float4*)(p.in[I_KA] + pc), rk4 = *(const float4*)(p.in[I_RK] + pc);
    __builtin_amdgcn_s_waitcnt(0x0F70);
    PrepRegs R;
#define SCAN_LOAD(chunk) do { const int t_ = (chunk) * CH + ptl; if (t_ < T) { const size_t ra = (size_t)(rowA0 + t_) * RCOLS + pc; const size_t rb = (size_t)(rowB0 + t_) * NLORA + pc; \
        R.cr = *(const uint2*)(PR + ra); R.ck = *(const uint2*)(PR + ra + 512); R.cv = *(const uint2*)(PR + ra + 1024); \
        if (!sample && t_ == 0) { R.pr = make_uint2(0u, 0u); R.pk = R.pr; R.pv = R.pr; } \
        else { R.pr = *(const uint2*)(PR + ra - RCOLS); R.pk = *(const uint2*)(PR + ra - RCOLS + 512); R.pv = *(const uint2*)(PR + ra - RCOLS + 1024); } \
        R.dw = *(const uint2*)(DAG + rb); R.da = *(const uint2*)(DAG + rb + 512); R.dg = *(const uint2*)(DAG + rb + 1024); } } while (0)
#define SCAN_PREP(chunk, dstbuf) do { const int t_ = (chunk) * CH + ptl; if (t_ < T) { \
        const float mr[4] = {mur.x, mur.y, mur.z, mur.w}, mk[4] = {muk.x, muk.y, muk.z, muk.w}, mv[4] = {muv.x, muv.y, muv.z, muv.w}; \
        const float kkc[4] = {kk4.x, kk4.y, kk4.z, kk4.w}, kac[4] = {ka4.x, ka4.y, ka4.z, ka4.w}, rkc[4] = {rk4.x, rk4.y, rk4.z, rk4.w}; \
        const float crr[4] = {bflo(R.cr.x), bfhi(R.cr.x), bflo(R.cr.y), bfhi(R.cr.y)}, ckk[4] = {bflo(R.ck.x), bfhi(R.ck.x), bflo(R.ck.y), bfhi(R.ck.y)}, cvv[4] = {bflo(R.cv.x), bfhi(R.cv.x), bflo(R.cv.y), bfhi(R.cv.y)}; \
        const float prr[4] = {bflo(R.pr.x), bfhi(R.pr.x), bflo(R.pr.y), bfhi(R.pr.y)}, pkk[4] = {bflo(R.pk.x), bfhi(R.pk.x), bflo(R.pk.y), bfhi(R.pk.y)}, pvv[4] = {bflo(R.pv.x), bfhi(R.pv.x), bflo(R.pv.y), bfhi(R.pv.y)}; \
        const float lw[4] = {bflo(R.dw.x), bfhi(R.dw.x), bflo(R.dw.y), bfhi(R.dw.y)}, aa[4] = {bflo(R.da.x), bfhi(R.da.x), bflo(R.da.y), bfhi(R.da.y)}, gg[4] = {bflo(R.dg.x), bfhi(R.dg.x), bflo(R.dg.y), bfhi(R.dg.y)}; \
        float r_[4], k_[4], v_[4], w_[4], kn[4], k2[4]; float nrm = 0.f; \
        _Pragma("unroll") for (int j = 0; j < 4; ++j) { r_[j] = crr[j] + (prr[j] - crr[j]) * mr[j]; k_[j] = ckk[j] + (pkk[j] - ckk[j]) * mk[j]; v_[j] = cvv[j] + (pvv[j] - cvv[j]) * mv[j]; \
            w_[j] = __expf(lw[j]); kn[j] = k_[j] * kkc[j]; nrm += kn[j] * kn[j]; k2[j] = k_[j] * (1.f + (aa[j] - 1.f) * kac[j]); } \
        nrm = row16_sum(nrm); const float inv = 1.f / fmaxf(sqrtf(nrm), 1e-12f); \
        float br = 0.f, kr = 0.f, rk = 0.f; float an[4], bn[4], wrr[4]; \
        _Pragma("unroll") for (int j = 0; j < 4; ++j) { const float kkn = kn[j] * inv; an[j] = -kkn; bn[j] = kkn * aa[j]; wrr[j] = w_[j] * r_[j]; br += bn[j] * r_[j]; kr += k2[j] * r_[j]; rk += r_[j] * k2[j] * rkc[j]; } \
        br = row16_sum(br); kr = row16_sum(kr); rk = row16_sum(rk); \
        LAS float* rec = (dstbuf) + ptl * SST; \
        *(LAS f32x4*)(rec + SI_W + pj) = (f32x4){w_[0], w_[1], w_[2], w_[3]}; *(LAS f32x4*)(rec + SI_A + pj) = (f32x4){an[0], an[1], an[2], an[3]}; \
        *(LAS f32x4*)(rec + SI_B + pj) = (f32x4){bn[0], bn[1], bn[2], bn[3]}; *(LAS f32x4*)(rec + SI_K + pj) = (f32x4){k2[0], k2[1], k2[2], k2[3]}; \
        *(LAS f32x4*)(rec + SI_WR + pj) = (f32x4){wrr[0], wrr[1], wrr[2], wrr[3]}; *(LAS f32x4*)(rec + SI_V + pj) = (f32x4){v_[0], v_[1], v_[2], v_[3]}; \
        *(LAS f32x4*)(rec + SI_G + pj) = (f32x4){gg[0], gg[1], gg[2], gg[3]}; \
        if ((tid & 15) == 0) *(LAS f32x4*)(rec + SI_SC) = (f32x4){br, kr, rk, 0.f}; } } while (0)

    SCAN_LOAD(0);
    SCAN_PREP(0, buf0);
    __syncthreads();
    for (int c = 0; c < nch; ++c) {
        LAS float* cur = (c & 1) ? buf1 : buf0; LAS float* nxt = (c & 1) ? buf0 : buf1;
        if (c + 1 < nch) SCAN_LOAD(c + 1);
        const int ns = (T - c * CH) < CH ? (T - c * CH) : CH;
        {
            const LAS float* rec = cur;
            f32x4 wA = *(const LAS f32x4*)(rec + SI_W + 4 * cgi), aA = *(const LAS f32x4*)(rec + SI_A + 4 * cgi), bA = *(const LAS f32x4*)(rec + SI_B + 4 * cgi);
            f32x4 kA = *(const LAS f32x4*)(rec + SI_K + 4 * cgi), rA = *(const LAS f32x4*)(rec + SI_WR + 4 * cgi);
            float vA = rec[SI_V + row]; pg8::f32x2 cA = *(const LAS pg8::f32x2*)(rec + SI_SC);
            f32x4 wB, aB, bB, kB, rB; float vB; pg8::f32x2 cB;
#define SCAN_FETCH(W, A, B, K, R, V, C) do { rec += SST; W = *(const LAS f32x4*)(rec + SI_W + 4 * cgi); A = *(const LAS f32x4*)(rec + SI_A + 4 * cgi); B = *(const LAS f32x4*)(rec + SI_B + 4 * cgi); \
            K = *(const LAS f32x4*)(rec + SI_K + 4 * cgi); R = *(const LAS f32x4*)(rec + SI_WR + 4 * cgi); V = rec[SI_V + row]; C = *(const LAS pg8::f32x2*)(rec + SI_SC); } while (0)
#define SCAN_STEP(W, A, B, K, R, V, C, qq) do { \
            float da = mul_(st[0], A[0]); float dw = mul_(st[0], R[0]); \
            da = fma_(st[1], A[1], da); dw = fma_(st[1], R[1], dw); da = fma_(st[2], A[2], da); dw = fma_(st[2], R[2], dw); da = fma_(st[3], A[3], da); dw = fma_(st[3], R[3], dw); \
            float tt_[4]; row16_sum2_mul4(da, dw, tt_, V, K[0], K[1], K[2], K[3]); \
            const float y = fma_(V, C[1], fma_(da, C[0], dw)); \
            _Pragma("unroll") for (int j = 0; j < 4; ++j) st[j] = fma_(st[j], W[j], fma_(da, B[j], tt_[j])); \
            yk = ((qq) == cgi) ? y : yk; } while (0)
            for (int tb = 0; tb < ns; tb += 16) {
                const int nq = (ns - tb) < 16 ? (ns - tb) : 16;
                float yk = 0.f;
                for (int q = 0; q < nq; q += 2) {
                    SCAN_FETCH(wB, aB, bB, kB, rB, vB, cB);
                    SCAN_STEP(wA, aA, bA, kA, rA, vA, cA, q);
                    SCAN_FETCH(wA, aA, bA, kA, rA, vA, cA);
                    SCAN_STEP(wB, aB, bB, kB, rB, vB, cB, q + 1);
                }
                ybuf[(tb + cgi) * 32 + rg] = yk;
            }
#undef SCAN_FETCH
#undef SCAN_STEP
        }
        __syncthreads();
        if (ptl < ns) {
            const pg8::f32x2 y2 = *(const LAS pg8::f32x2*)(ybuf + ptl * 32 + 2 * (tid & 15));
            *(float2*)(YG + (size_t)(rowB0 + c * CH + ptl) * 512 + h * 64 + 32 * half + 2 * (tid & 15)) = make_float2(y2[0], y2[1]);
        }
        if (c + 1 < nch) SCAN_PREP(c + 1, nxt);
        __syncthreads();
    }
#undef SCAN_LOAD
#undef SCAN_PREP
    float* So = p.out + (sample ? O_SWKV : O_PWKV) + ((size_t)(b * 8 + h) * 64 + row) * 64 + 4 * cgi;
    *(float4*)So = make_float4(st[0], st[1], st[2], st[3]);
}

__device__ __forceinline__ void phase_wkvfin(const Params& p, int tid, int G, int bid) {
    const bf16_t* PR = (const bf16_t*)(p.ws + WS_PROJRW); const bf16_t* DAG = (const bf16_t*)((const unsigned char*)p.out + SC_B);
    const float* YG = (const float*)(p.ws + WS_Y); bf16_t* MIX = (bf16_t*)((unsigned char*)p.out + SC_C);
    const int gt = bid * NTHREADS + tid, NT = G * NTHREADS;
    for (int i = gt; i < MB * 128; i += NT) {
        const int jq = i & 15, h = (i >> 4) & 7, rowB = i >> 7, pc = h * 64 + jq * 4, rowA = rowA_of(rowB);
        const size_t ra = (size_t)rowA * RCOLS + pc;
        const uint2 cr = *(const uint2*)(PR + ra), ck = *(const uint2*)(PR + ra + 512), cv = *(const uint2*)(PR + ra + 1024);
        uint2 pr = make_uint2(0u, 0u), pk = pr, pv = pr;
        if (!(rowB < MP && (rowB & (TP - 1)) == 0)) { pr = *(const uint2*)(PR + ra - RCOLS); pk = *(const uint2*)(PR + ra - RCOLS + 512); pv = *(const uint2*)(PR + ra - RCOLS + 1024); }
        const uint2 da = *(const uint2*)(DAG + (size_t)rowB * NLORA + 512 + pc), dg = *(const uint2*)(DAG + (size_t)rowB * NLORA + 1024 + pc);
        const float4 y4 = *(const float4*)(YG + (size_t)rowB * 512 + pc);
        const float4 mur = *(const float4*)(p.in[I_MU] + pc), muk = *(const float4*)(p.in[I_MU] + 512 + pc), muv = *(const float4*)(p.in[I_MU] + 1024 + pc);
        const float4 ka4 = *(const float4*)(p.in[I_KA] + pc), rk4 = *(const float4*)(p.in[I_RK] + pc), lw4 = *(const float4*)(p.in[I_LNW] + pc), lb4 = *(const float4*)(p.in[I_LNB] + pc);
        const float mr[4] = {mur.x, mur.y, mur.z, mur.w}, mk[4] = {muk.x, muk.y, muk.z, muk.w}, mv[4] = {muv.x, muv.y, muv.z, muv.w};
        const float kac[4] = {ka4.x, ka4.y, ka4.z, ka4.w}, rkc[4] = {rk4.x, rk4.y, rk4.z, rk4.w}, lw[4] = {lw4.x, lw4.y, lw4.z, lw4.w}, lb[4] = {lb4.x, lb4.y, lb4.z, lb4.w};
        const float crr[4] = {bflo(cr.x), bfhi(cr.x), bflo(cr.y), bfhi(cr.y)}, ckk[4] = {bflo(ck.x), bfhi(ck.x), bflo(ck.y), bfhi(ck.y)}, cvv[4] = {bflo(cv.x), bfhi(cv.x), bflo(cv.y), bfhi(cv.y)};
        const float prr[4] = {bflo(pr.x), bfhi(pr.x), bflo(pr.y), bfhi(pr.y)}, pkk[4] = {bflo(pk.x), bfhi(pk.x), bflo(pk.y), bfhi(pk.y)}, pvv[4] = {bflo(pv.x), bfhi(pv.x), bflo(pv.y), bfhi(pv.y)};
        const float aa[4] = {bflo(da.x), bfhi(da.x), bflo(da.y), bfhi(da.y)}, gg[4] = {bflo(dg.x), bfhi(dg.x), bflo(dg.y), bfhi(dg.y)};
        const float yy[4] = {y4.x, y4.y, y4.z, y4.w};
        float v_[4]; float rk = 0.f;
#pragma unroll
        for (int j = 0; j < 4; ++j) { const float r_ = crr[j] + (prr[j] - crr[j]) * mr[j], k_ = ckk[j] + (pkk[j] - ckk[j]) * mk[j]; v_[j] = cvv[j] + (pvv[j] - cvv[j]) * mv[j];
            const float k2 = k_ * (1.f + (aa[j] - 1.f) * kac[j]); rk += r_ * k2 * rkc[j]; }
        rk = row16_sum(rk);
        const float mean = row16_sum((yy[0] + yy[1]) + (yy[2] + yy[3])) * (1.f / 64.f);
        float d[4]; float vs = 0.f;
#pragma unroll
        for (int j = 0; j < 4; ++j) { d[j] = yy[j] - mean; vs += d[j] * d[j]; }
        const float rs = rsqrtf(row16_sum(vs) * (1.f / 64.f) + 64e-5f);
        float o[4];
#pragma unroll
        for (int j = 0; j < 4; ++j) o[j] = (d[j] * rs * lw[j] + lb[j] + rk * v_[j]) * gg[j];
        uint2 w; w.x = pk2(o[0], o[1]); w.y = pk2(o[2], o[3]);
        *(uint2*)(MIX + (size_t)rowB * D + pc) = w;
    }
}

__device__ __forceinline__ void attn_task(const Params& p, int task, int lane) {
    const bf16_t* Q = (const bf16_t*)(p.ws + WS_Q); const bf16_t* K = (const bf16_t*)(p.ws + WS_K);
    bf16_t* MIX = (bf16_t*)((unsigned char*)p.out + SC_C);
    const int b = task >> 11, h = (task >> 8) & 7, r16 = (task >> 4) & 15, ig = task & 15;
    const int li = lane & 15, g = lane >> 4;
    const int tq = r16 + 16 * (16 * ig + li);
    const bf16_t* qp = Q + (size_t)(b * TP + tq) * 512 + h * 64 + 8 * g;
    const bf16x8 qf0 = *(const bf16x8*)qp, qf1 = *(const bf16x8*)(qp + 32);
    float m_run = -1e30f, l_run = 0.f;
    f32x4 o[4];
#pragma unroll
    for (int i = 0; i < 4; ++i) o[i] = (f32x4){0.f, 0.f, 0.f, 0.f};
#pragma unroll 1
    for (int br = 0; br < 3; ++br) {
        int dd, r, uq0, Tdd; const bf16_t* VT;
        if (br == 0) { dd = 16; r = r16; uq0 = 16 * ig; Tdd = TP / 16; VT = (const bf16_t*)(p.ws + WS_VT16); }
        else if (br == 1) { dd = 4; r = r16 & 3; uq0 = (r16 >> 2) + 64 * ig; Tdd = TP / 4; VT = (const bf16_t*)(p.ws + WS_VT4); }
        else { dd = 1; r = 0; uq0 = r16 + 256 * ig; Tdd = TP; VT = (const bf16_t*)(p.ws + WS_VT1); }
        const int s = 16 / dd, uq = uq0 + s * li;
        int ulo = uq0 - 128; if (ulo < 0) ulo = 0; ulo &= ~31;
        const int uhi = uq0 + 15 * s;
        const bf16_t* Kb = K + ((size_t)b * TP + r) * 512 + h * 64 + 8 * g;
        const bf16_t* Vb = VT + (size_t)(b * 8 + h) * 64 * TP + (size_t)r * Tdd * 64 + li * 32 + 8 * g;
        bf16x8 kx0, kx1, ky0, ky1, vf[4];
        { const bf16_t* kx = Kb + (size_t)(ulo + li) * dd * 512; const bf16_t* ky = kx + (size_t)16 * dd * 512;
          kx0 = *(const bf16x8*)kx; kx1 = *(const bf16x8*)(kx + 32); ky0 = *(const bf16x8*)ky; ky1 = *(const bf16x8*)(ky + 32);
#pragma unroll
          for (int dt = 0; dt < 4; ++dt) vf[dt] = *(const bf16x8*)(Vb + (size_t)(ulo >> 5) * 2048 + dt * 512); }
#pragma unroll 1
        for (int kt = ulo; kt <= uhi; kt += 32) {
            const int ktn = (kt + 32 <= uhi) ? kt + 32 : kt;
            const bf16_t* nkx = Kb + (size_t)(ktn + li) * dd * 512; const bf16_t* nky = nkx + (size_t)16 * dd * 512;
            const bf16x8 nkx0 = *(const bf16x8*)nkx, nkx1 = *(const bf16x8*)(nkx + 32), nky0 = *(const bf16x8*)nky, nky1 = *(const bf16x8*)(nky + 32);
            bf16x8 nvf[4];
#pragma unroll
            for (int dt = 0; dt < 4; ++dt) nvf[dt] = *(const bf16x8*)(Vb + (size_t)(ktn >> 5) * 2048 + dt * 512);
            f32x4 sx = (f32x4){0.f, 0.f, 0.f, 0.f}, sy = (f32x4){0.f, 0.f, 0.f, 0.f};
            sx = __builtin_amdgcn_mfma_f32_16x16x32_bf16(kx0, qf0, sx, 0, 0, 0); sx = __builtin_amdgcn_mfma_f32_16x16x32_bf16(kx1, qf1, sx, 0, 0, 0);
            sy = __builtin_amdgcn_mfma_f32_16x16x32_bf16(ky0, qf0, sy, 0, 0, 0); sy = __builtin_amdgcn_mfma_f32_16x16x32_bf16(ky1, qf1, sy, 0, 0, 0);
            float sv[8]; bool ok[8]; float tmax = -1e30f;
#pragma unroll
            for (int j = 0; j < 4; ++j) { const int dx = uq - (kt + 4 * g + j), dy = dx - 16;
                ok[j] = (unsigned)dx <= 128u; ok[4 + j] = (unsigned)dy <= 128u; sv[j] = ok[j] ? sx[j] : -1e30f; sv[4 + j] = ok[4 + j] ? sy[j] : -1e30f;
                tmax = fmaxf(tmax, fmaxf(sv[j], sv[4 + j])); }
            tmax = fmaxf(tmax, __shfl_xor(tmax, 16)); tmax = fmaxf(tmax, __shfl_xor(tmax, 32));
            const float m_new = fmaxf(m_run, tmax), alpha = __expf(m_run - m_new);
            float pe[8]; float ps = 0.f;
#pragma unroll
            for (int j = 0; j < 8; ++j) { pe[j] = ok[j] ? __expf(sv[j] - m_new) : 0.f; ps += pe[j]; }
            l_run = l_run * alpha + ps; m_run = m_new;
            u32x4 pw; pw[0] = pk2(pe[0], pe[1]); pw[1] = pk2(pe[2], pe[3]); pw[2] = pk2(pe[4], pe[5]); pw[3] = pk2(pe[6], pe[7]);
            const bf16x8 pf = __builtin_bit_cast(bf16x8, pw);
#pragma unroll
            for (int dt = 0; dt < 4; ++dt) { o[dt] *= alpha; o[dt] = __builtin_amdgcn_mfma_f32_16x16x32_bf16(vf[dt], pf, o[dt], 0, 0, 0); }
            kx0 = nkx0; kx1 = nkx1; ky0 = nky0; ky1 = nky1;
#pragma unroll
            for (int dt = 0; dt < 4; ++dt) vf[dt] = nvf[dt];
        }
    }
    float lt = l_run; lt += __shfl_xor(lt, 16); lt += __shfl_xor(lt, 32);
    const float il = 1.f / lt;
    bf16_t* op = MIX + (size_t)(b * TP + tq) * D + 512 + h * 64 + 4 * g;
#pragma unroll
    for (int dt = 0; dt < 4; ++dt) { uint2 w; w.x = pk2(o[dt][0] * il, o[dt][1] * il); w.y = pk2(o[dt][2] * il, o[dt][3] * il); *(uint2*)(op + 16 * dt) = w; }
}
__device__ __forceinline__ void attn_sample_task(const Params& p, int task, int lane, LAS float* wl) {
    const bf16_t* Q = (const bf16_t*)(p.ws + WS_Q); const float* snewk = (const float*)(p.ws + WS_SNEWK); const float* snewv = (const float*)(p.ws + WS_SNEWV);
    const float* CK = p.in[I_CK]; const float* CV = p.in[I_CV];
    bf16_t* MIX = (bf16_t*)((unsigned char*)p.out + SC_C);
    const int b = task >> 6, h = (task >> 3) & 7, tt = task & 7;
    const int rowB = MP + b * TS + tt;
    asm volatile("s_waitcnt lgkmcnt(0)" ::: "memory");
    wl[lane] = bflo((u32)Q[(size_t)rowB * 512 + h * 64 + lane]);
    asm volatile("s_waitcnt lgkmcnt(0)" ::: "memory");
    float mx = -1e30f;
#pragma unroll 1
    for (int c = 0; c < 9; ++c) {
        const int br = c / 3, it = c - br * 3; const int dd = br == 0 ? 1 : (br == 1 ? 4 : 16); const int j = lane + 64 * it;
        const int jc = j <= 128 ? j : 128;
        const int idx = 2048 + tt - jc * dd;
        const float* kr = idx < 2048 ? CK + ((size_t)(b * 2048 + idx) * 8 + h) * 64 : snewk + (size_t)(b * TS + idx - 2048) * 512 + h * 64;
        float s = 0.f;
#pragma unroll
        for (int d4 = 0; d4 < 16; ++d4) { const float4 kv = *(const float4*)(kr + 4 * d4); const f32x4 qv = *(const LAS f32x4*)(wl + 4 * d4);
            s += kv.x * qv[0] + kv.y * qv[1] + kv.z * qv[2] + kv.w * qv[3]; }
        if (j > 128) s = -1e30f;
        wl[64 + c * 64 + lane] = s; mx = fmaxf(mx, s);
    }
#pragma unroll
    for (int o = 1; o < 64; o <<= 1) mx = fmaxf(mx, __shfl_xor(mx, o));
    asm volatile("s_waitcnt lgkmcnt(0)" ::: "memory");
    float ls = 0.f;
#pragma unroll 1
    for (int c = 0; c < 9; ++c) { const float s = wl[64 + c * 64 + lane]; const float e = s > -1e29f ? __expf(s - mx) : 0.f; wl[64 + c * 64 + lane] = e; ls += e; }
    ls = wave_sum(ls);
    asm volatile("s_waitcnt lgkmcnt(0)" ::: "memory");
    float acc = 0.f;
#pragma unroll 1
    for (int c = 0; c < 9; ++c) {
        const int br = c / 3, it = c - br * 3; const int dd = br == 0 ? 1 : (br == 1 ? 4 : 16); const int nj = it < 2 ? 64 : 1;
#pragma unroll 8
        for (int l2 = 0; l2 < nj; ++l2) {
            const int j = l2 + 64 * it; const int idx = 2048 + tt - j * dd;
            const float* vr = idx < 2048 ? CV + ((size_t)(b * 2048 + idx) * 8 + h) * 64 : snewv + (size_t)(b * TS + idx - 2048) * 512 + h * 64;
            acc += wl[64 + c * 64 + l2] * vr[lane];
        }
    }
    const float res = acc / ls;
    const float other = __shfl_xor(res, 1);
    if ((lane & 1) == 0) *(u32*)(MIX + (size_t)rowB * D + 512 + h * 64 + lane) = pk2(res, other);
}

__device__ __forceinline__ void phase_norm1(const Params& p, int tid, int G, int bid) {
    const int wave = tid >> 6, lane = tid & 63, gw = bid * 8 + wave, NGW = G * 8;
    const float* mix = (const float*)((const unsigned char*)p.out + SC_B); bf16_t* H2 = (bf16_t*)((unsigned char*)p.out + SC_C);
    for (int row = gw; row < MB; row += NGW) {
        const float* xrow = row < MP ? p.in[I_XP] + (size_t)row * D : p.in[I_XS] + (size_t)(row - MP) * D;
        const float4* mr = (const float4*)(mix + (size_t)row * D) + lane; const float4* xr = (const float4*)xrow + lane;
        float4 v[4], x[4]; float s = 0.f;
#pragma unroll
        for (int j = 0; j < 4; ++j) { v[j] = mr[64 * j]; x[j] = xr[64 * j]; s += (v[j].x * v[j].x + v[j].y * v[j].y) + (v[j].z * v[j].z + v[j].w * v[j].w); }
        const float rs = rsqrtf(wave_sum(s) * (1.f / D) + 1e-6f);
        float s2 = 0.f;
#pragma unroll
        for (int j = 0; j < 4; ++j) { const float4 gg = *((const float4*)p.in[I_NMPOST] + lane + 64 * j);
            x[j].x += v[j].x * rs * gg.x; x[j].y += v[j].y * rs * gg.y; x[j].z += v[j].z * rs * gg.z; x[j].w += v[j].w * rs * gg.w;
            s2 += (x[j].x * x[j].x + x[j].y * x[j].y) + (x[j].z * x[j].z + x[j].w * x[j].w);
            *((float4*)(p.out + (size_t)row * D) + lane + 64 * j) = x[j]; }
        const float rs2 = rsqrtf(wave_sum(s2) * (1.f / D) + 1e-6f);
#pragma unroll
        for (int j = 0; j < 4; ++j) { const float4 gg = *((const float4*)p.in[I_NFPRE] + lane + 64 * j);
            uint2 o; o.x = pk2(x[j].x * rs2 * gg.x, x[j].y * rs2 * gg.y); o.y = pk2(x[j].z * rs2 * gg.z, x[j].w * rs2 * gg.w);
            *((uint2*)(H2 + (size_t)(row + 2) * D) + lane + 64 * j) = o; }
    }
    for (int row = gw; row < 2 + (H2P_ROWS - MB - 2); row += NGW) {
        const int rr = row < 2 ? row : MB + row;
#pragma unroll
        for (int j = 0; j < 4; ++j) *((uint2*)(H2 + (size_t)rr * D) + lane + 64 * j) = make_uint2(0u, 0u);
    }
}
__device__ __forceinline__ void phase_act(const Params& p, int tid, int G, int bid) {
    const int wave = tid >> 6, lane = tid & 63, gw = bid * 8 + wave, NGW = G * 8;
    bf16_t* U = (bf16_t*)(p.ws + WS_U); const bf16_t* halo = (const bf16_t*)(p.ws + WS_HALO);
    const float* cw = p.in[I_CONVW]; const float* cb = p.in[I_CONVB];
    constexpr int NPI = (MP / 32) * 11, NSI = BS * 11;
    for (int it = gw; it < NPI + NSI; it += NGW) {
        const bool sample = it >= NPI; const int q = sample ? it - NPI : it; const int chunk = q / 11, cgp = q - chunk * 11;
        const int col = cgp * 256 + 4 * lane;
        const float4 wg0 = *(const float4*)(cw + col), wg1 = *(const float4*)(cw + FF2 + col), wg2 = *(const float4*)(cw + 2 * FF2 + col), bg = *(const float4*)(cb + col);
        const float4 wu0 = *(const float4*)(cw + FF + col), wu1 = *(const float4*)(cw + FF2 + FF + col), wu2 = *(const float4*)(cw + 2 * FF2 + FF + col), bu = *(const float4*)(cb + FF + col);
        float g2[4], g1[4], u2[4], u1[4];
        int row0, nrows;
        if (!sample) {
            row0 = chunk * 32; nrows = 32;
            if ((row0 & (TP - 1)) == 0) {
#pragma unroll
                for (int j = 0; j < 4; ++j) { g2[j] = 0.f; g1[j] = 0.f; u2[j] = 0.f; u1[j] = 0.f; }
            } else {
                const bf16_t* hp = halo + (size_t)chunk * 2 * FF2;
                const uint2 a = *(const uint2*)(hp + col), c2 = *(const uint2*)(hp + FF2 + col), e = *(const uint2*)(hp + FF + col), f = *(const uint2*)(hp + FF2 + FF + col);
                g2[0] = bflo(a.x); g2[1] = bfhi(a.x); g2[2] = bflo(a.y); g2[3] = bfhi(a.y); g1[0] = bflo(c2.x); g1[1] = bfhi(c2.x); g1[2] = bflo(c2.y); g1[3] = bfhi(c2.y);
                u2[0] = bflo(e.x); u2[1] = bfhi(e.x); u2[2] = bflo(e.y); u2[3] = bfhi(e.y); u1[0] = bflo(f.x); u1[1] = bfhi(f.x); u1[2] = bflo(f.y); u1[3] = bfhi(f.y);
            }
        } else {
            row0 = MP + chunk * TS; nrows = TS;
            const float* sp = p.in[I_SCONV] + (size_t)chunk * 2 * FF2;
            const float4 a = *(const float4*)(sp + col), c2 = *(const float4*)(sp + FF2 + col), e = *(const float4*)(sp + FF + col), f = *(const float4*)(sp + FF2 + FF + col);
            g2[0] = a.x; g2[1] = a.y; g2[2] = a.z; g2[3] = a.w; g1[0] = c2.x; g1[1] = c2.y; g1[2] = c2.z; g1[3] = c2.w;
            u2[0] = e.x; u2[1] = e.y; u2[2] = e.z; u2[3] = e.w; u1[0] = f.x; u1[1] = f.y; u1[2] = f.z; u1[3] = f.w;
        }
        const float w0g[4] = {wg0.x, wg0.y, wg0.z, wg0.w}, w1g[4] = {wg1.x, wg1.y, wg1.z, wg1.w}, w2g[4] = {wg2.x, wg2.y, wg2.z, wg2.w}, bgg[4] = {bg.x, bg.y, bg.z, bg.w};
        const float w0u[4] = {wu0.x, wu0.y, wu0.z, wu0.w}, w1u[4] = {wu1.x, wu1.y, wu1.z, wu1.w}, w2u[4] = {wu2.x, wu2.y, wu2.z, wu2.w}, buu[4] = {bu.x, bu.y, bu.z, bu.w};
        for (int r0 = 0; r0 < nrows; r0 += 8) {
            uint2 gv[8], uv[8];
#pragma unroll
            for (int i = 0; i < 8; ++i) { const bf16_t* rp = U + (size_t)(row0 + r0 + i) * FF2 + col; gv[i] = *(const uint2*)rp; uv[i] = *(const uint2*)(rp + FF); }
#pragma unroll
            for (int i = 0; i < 8; ++i) {
                const float gc[4] = {bflo(gv[i].x), bfhi(gv[i].x), bflo(gv[i].y), bfhi(gv[i].y)}, uc[4] = {bflo(uv[i].x), bfhi(uv[i].x), bflo(uv[i].y), bfhi(uv[i].y)};
                float o[4];
#pragma unroll
                for (int j = 0; j < 4; ++j) {
                    const float cgv = w0g[j] * g2[j] + w1g[j] * g1[j] + w2g[j] * gc[j] + bgg[j];
                    const float cuv = w0u[j] * u2[j] + w1u[j] * u1[j] + w2u[j] * uc[j] + buu[j];
                    o[j] = cgv * sigmoidf_(cgv) * cuv;
                    g2[j] = g1[j]; g1[j] = gc[j]; u2[j] = u1[j]; u1[j] = uc[j];
                }
                uint2 w; w.x = pk2(o[0], o[1]); w.y = pk2(o[2], o[3]);
                *(uint2*)(U + (size_t)(row0 + r0 + i) * FF2 + col) = w;
            }
        }
    }
}
__device__ __forceinline__ void phase_final(const Params& p, int tid, int G, int bid) {
    const int wave = tid >> 6, lane = tid & 63, gw = bid * 8 + wave, NGW = G * 8;
    const float* F = (const float*)(p.ws + WS_F);
    for (int row = gw; row < MB; row += NGW) {
        const float4* fr = (const float4*)(F + (size_t)row * D) + lane; float4* yr = (float4*)(p.out + (size_t)row * D) + lane;
        float4 v[4]; float s = 0.f;
#pragma unroll
        for (int j = 0; j < 4; ++j) { v[j] = fr[64 * j]; s += (v[j].x * v[j].x + v[j].y * v[j].y) + (v[j].z * v[j].z + v[j].w * v[j].w); }
        const float rs = rsqrtf(wave_sum(s) * (1.f / D) + 1e-6f);
#pragma unroll
        for (int j = 0; j < 4; ++j) { const float4 gg = *((const float4*)p.in[I_NFPOST] + lane + 64 * j); float4 x = yr[64 * j];
            x.x += v[j].x * rs * gg.x; x.y += v[j].y * rs * gg.y; x.z += v[j].z * rs * gg.z; x.w += v[j].w * rs * gg.w; yr[64 * j] = x; }
    }
}
__device__ __forceinline__ void phase_cachecopy(const Params& p, int tid, int G, int bid) {
    if (bid < 4) return;
    const int gt = (bid - 4) * NTHREADS + tid, NT = (G - 4) * NTHREADS;
    constexpr int PER_B = 2048 * 512 / 4;
    const float4* snk = (const float4*)(p.ws + WS_SNEWK); const float4* snv = (const float4*)(p.ws + WS_SNEWV);
    for (int i = gt; i < 2 * BS * PER_B; i += NT) {
        const int which = i >= BS * PER_B; const int q = which ? i - BS * PER_B : i; const int b = q / PER_B, r = q - b * PER_B;
        const float4* src = (const float4*)p.in[which ? I_CV : I_CK] + (size_t)b * PER_B;
        float4 v;
        if (r < 2040 * 128) v = src[r + 8 * 128]; else v = (which ? snv : snk)[(size_t)b * TS * 128 + (r - 2040 * 128)];
        ((float4*)(p.out + (which ? O_SV : O_SK)))[(size_t)b * PER_B + r] = v;
    }
}

template <int PH>
__device__ __forceinline__ void run_phase(const Params& p, LAS unsigned char* lds, int tid, int G, int bid) {
    if constexpr (PH == 0) { phase0(p, lds, tid, G, bid); __syncthreads(); }
    else if constexpr (PH == 1) {
        pg8::Gemm g{(const bf16_t*)((const unsigned char*)p.out + SC_B), (const bf16_t*)(p.ws + WS_WIN), MA, DIN, D, D, 256}; pg8::StaticOrder S; S.init(MA, DIN, G, bid);
        EpiProj E{(bf16_t*)(p.ws + WS_PROJRW), (bf16_t*)(p.ws + WS_Q), (bf16_t*)(p.ws + WS_K), (bf16_t*)(p.ws + WS_VROW), (bf16_t*)(p.ws + WS_VT4), (bf16_t*)(p.ws + WS_VT16),
                  (const float*)(p.ws + WS_ROPE), p.out, (float*)(p.ws + WS_SNEWK), (float*)(p.ws + WS_SNEWV)};
        pg8::gemm_phase<EpiProj, pg8::StaticOrder, false>(lds, g, S, E, nullptr);
    } else if constexpr (PH == 2) { phase_alora(p, tid, G, bid); phase_vtrans(p, lds, tid, G, bid); }
    else if constexpr (PH == 3) {
        pg8::Gemm g{(const bf16_t*)(p.ws + WS_ALORA), (const bf16_t*)(p.ws + WS_WLORA), MB, NLORA, KLORA, KLORA, 256}; pg8::StaticOrder S; S.init(MB, NLORA, G, bid);
        EpiDag E{(bf16_t*)((unsigned char*)p.out + SC_B), p.in[I_W0], p.in[I_A0]};
        pg8::gemm_phase<EpiDag, pg8::StaticOrder, false>(lds, g, S, E, nullptr);
    } else if constexpr (PH == 4 || PH == 11 || PH == 12) {
        const int NSCAN = 128;
        if (bid < NSCAN) {
            if constexpr (PH != 12) {
                scan_item(p, lds, tid, false, bid >> 4, (bid >> 1) & 7, bid & 1);
                for (int it = bid; it < 512; it += NSCAN) scan_item(p, lds, tid, true, it >> 4, (it >> 1) & 7, it & 1);
            }
        }
        if (PH == 4 || (PH == 12 && bid >= NSCAN)) {
            const int wave = tid >> 6, lane = tid & 63, x = bid & 7;
            unsigned* ctr = (unsigned*)(p.ws + WS_BAR) + (PH == 4 ? 16 : 32) + x;
            for (;;) {
                unsigned id = 0; if (lane == 0) id = __hip_atomic_fetch_add(ctr, 1u, __ATOMIC_RELAXED, __HIP_MEMORY_SCOPE_AGENT);
                id = (unsigned)__builtin_amdgcn_readfirstlane((int)id);
                if (id >= 2048u + 256u) break;
                if (id < 2048u) { const int ig = id >> 7, hh = (id >> 4) & 7, r16 = id & 15; attn_task(p, (x << 11) | (hh << 8) | (r16 << 4) | ig, lane); }
                else { const int s = id - 2048; attn_sample_task(p, ((4 * x + (s >> 6)) << 6) | (s & 63), lane, (LAS float*)(lds + wave * 4096)); }
            }
        }
    } else if constexpr (PH == 5) {
        pg8::Gemm g{(const bf16_t*)((const unsigned char*)p.out + SC_C), (const bf16_t*)(p.ws + WS_WOUT), MB, D, D, D, 256}; pg8::StaticOrder S; S.init(MB, D, G, bid);
        pg8::EpiF32 E{(float*)((unsigned char*)p.out + SC_B), D, nullptr};
        pg8::gemm_phase<pg8::EpiF32, pg8::StaticOrder, false>(lds, g, S, E, nullptr);
    } else if constexpr (PH == 6) phase_norm1(p, tid, G, bid);
    else if constexpr (PH == 7) {
        pg8::Gemm g{(const bf16_t*)((const unsigned char*)p.out + SC_C), (const bf16_t*)(p.ws + WS_WUP), UP_TILES * 256, FF2, D, D, UP_STEP}; pg8::StaticOrder S; S.init(UP_TILES * 256, FF2, G, bid);
        EpiUpAct E{(bf16_t*)(p.ws + WS_U), p.out, p.in[I_CONVW], p.in[I_CONVB], p.in[I_SCONV], (LAS float*)(lds + 131072)};
        pg8::gemm_phase<EpiUpAct, pg8::StaticOrder, false>(lds, g, S, E, nullptr);
    } else if constexpr (PH == 8) phase_act(p, tid, G, bid);
    else if constexpr (PH == 9) {
        pg8::Gemm g{(const bf16_t*)(p.ws + WS_U), (const bf16_t*)(p.ws + WS_WDN), MB, D, FF, FF, 256}; pg8::StaticOrder S; S.init(MB, D, G, bid);
        pg8::EpiF32 E{(float*)(p.ws + WS_F), D, nullptr};
        pg8::gemm_phase<pg8::EpiF32, pg8::StaticOrder, false>(lds, g, S, E, nullptr);
        phase_cachecopy(p, tid, G, bid);
    } else if constexpr (PH == 10) { phase_final(p, tid, G, bid); }
    else if constexpr (PH == 13) phase_wkvfin(p, tid, G, bid);
}
__device__ __forceinline__ void grid_bar(unsigned* ctr, unsigned target) {
    asm volatile("s_waitcnt vmcnt(0)" ::: "memory");
    __syncthreads();
    if (threadIdx.x == 0) {
        __builtin_amdgcn_fence(__ATOMIC_RELEASE, "agent");
        asm volatile("s_waitcnt vmcnt(0)" ::: "memory");
        __hip_atomic_fetch_add(ctr, 1u, __ATOMIC_RELAXED, __HIP_MEMORY_SCOPE_AGENT);
        while (__hip_atomic_load(ctr, __ATOMIC_RELAXED, __HIP_MEMORY_SCOPE_AGENT) < target) __builtin_amdgcn_s_sleep(2);
        __builtin_amdgcn_fence(__ATOMIC_ACQUIRE, "agent");
        asm volatile("s_waitcnt vmcnt(0)" ::: "memory");
    }
    __syncthreads();
}
template <int SEAM, int FIRST, int... REST>
__device__ __forceinline__ void run_program(const Params& p, LAS unsigned char* lds, cg::grid_group& grid, int tid, int G, int bid) {
    if (p.en > (int)sizeof...(REST) - 1000) run_phase<FIRST>(p, lds, tid, G, bid);
    if constexpr (sizeof...(REST) > 0) {
        if constexpr (SEAM == 0) grid.sync(); else grid_bar((unsigned*)(p.ws + WS_BAR), (unsigned)(SEAM * G));
        run_program<SEAM + 1, REST...>(p, lds, grid, tid, G, bid);
    }
}
#define PROGRAM 0, 1, 2, 3, 4, 13, 5, 6, 7, 9, 10
__global__ void __launch_bounds__(NTHREADS, 2) hymba_fwd(Params p) {
    extern __shared__ __attribute__((aligned(16))) unsigned char lds_raw[];
    LAS unsigned char* lds = (LAS unsigned char*)lds_raw;
    cg::grid_group grid = cg::this_grid();
    run_program<0, PROGRAM>(p, lds, grid, threadIdx.x, gridDim.x, blockIdx.x);
}

extern "C" void kernel_launch(void* const* d_in, const int* in_sizes, int n_in, void* d_out, int out_size, void* d_ws, size_t ws_size, hipStream_t stream) {
    static int grid = 0;
    if (grid == 0) {
        if (n_in != 28 || (size_t)out_size != O_END || ws_size < WS_TOTAL) { fprintf(stderr, "kernel_launch: unexpected sizes n_in %d out %d ws %zu (need %zu)\n", n_in, out_size, ws_size, (size_t)WS_TOTAL); grid = -1; return; }
        int dev = 0, cus = 0, per_cu = 0;
        hipGetDevice(&dev); hipDeviceGetAttribute(&cus, hipDeviceAttributeMultiprocessorCount, dev);
        if (hipFuncSetAttribute((const void*)hymba_fwd, hipFuncAttributeMaxDynamicSharedMemorySize, LDS_BYTES) != hipSuccess) { fprintf(stderr, "kernel_launch: hipFuncSetAttribute failed\n"); grid = -1; return; }
        hipOccupancyMaxActiveBlocksPerMultiprocessor(&per_cu, (const void*)hymba_fwd, NTHREADS, LDS_BYTES);
        (void)hipGetLastError();
        if (per_cu < 1) per_cu = 1;
        grid = cus;
    }
    if (grid < 0) return;
    Params p{};
    for (int i = 0; i < 28; ++i) p.in[i] = (const float*)d_in[i];
    p.out = (float*)d_out; p.ws = (unsigned char*)d_ws; p.en = 1;
    if (hipMemsetAsync((unsigned char*)d_ws + WS_BAR, 0, 256, stream) != hipSuccess) { fprintf(stderr, "kernel_launch: memset of the barrier word failed\n"); return; }
    void* args[] = {&p};
    hipError_t e = hipLaunchCooperativeKernel((const void*)hymba_fwd, dim3(grid), dim3(NTHREADS), args, LDS_BYTES, stream);
    if (e != hipSuccess) fprintf(stderr, "cooperative launch failed: %s (grid %d)\n", hipGetErrorString(e), grid);
}
```

```cpp
#include <hip/hip_runtime.h>
#include <hip/hip_cooperative_groups.h>
#include <cstdio>
#include <cstdint>
namespace pg8 {
#define PG8_LAS __attribute__((address_space(3)))
typedef unsigned short bf16_t;
typedef short bf16x8 __attribute__((ext_vector_type(8)));
typedef float f32x4 __attribute__((ext_vector_type(4)));
typedef unsigned u32x4 __attribute__((ext_vector_type(4)));
constexpr int BM = 256, BK = 64, HALF = 128, HTB = HALF * BK * 2  , STAGE_BYTES = 8 * HTB, NXCD = 8, WGM = 8;

__host__ __device__ __forceinline__ int lds_byte(int r, int c) { const int st = (r >> 4) * 2 + (c >> 5), rr = r & 15, cc = c & 31, ob = rr * 64 + cc * 2; return st * 1024 + (ob ^ (((ob >> 9) & 1) << 5)); }
__host__ __device__ __forceinline__ void stage_rc(int b, int& R, int& C) { const int st = b / 1024, sb = b % 1024, swz = sb ^ (((sb >> 9) & 1) << 5); R = (st >> 1) * 16 + swz / 64; C = (st & 1) * 32 + (swz % 64) / 2; }
__host__ __device__ __forceinline__ int perm32(int rho) { const int n = rho >> 4, i = rho & 15; return 8 * (i >> 2) + 4 * n + (i & 3); }

struct Unit { int pm, pn; };
struct Gemm { const bf16_t* A; const bf16_t* Bt; int M, N, K, lda, tile_rows; };

struct StaticOrder {
    int nM, nN, nwg, G, c;
    __host__ __device__ void init(int M, int N, int G_, int c_) { nM = M / BM; nN = N / BM; nwg = nM * nN; G = G_; c = c_; }
    __host__ __device__ bool next(int i, Unit& u) const {
        const long L = (long)i * G + c; if (L >= nwg) return false;
        int wgid = (int)L; { const int q = nwg / NXCD, r = nwg % NXCD, xcd = wgid % NXCD, off = wgid / NXCD; wgid = (xcd < r ? xcd * (q + 1) : r * (q + 1) + (xcd - r) * q) + off; }
        const int nig = WGM * nN, gid = wgid / nig, fm = gid * WGM, gsz = (nM - fm) < WGM ? (nM - fm) : WGM;
        u.pm = fm + ((wgid % nig) % gsz); u.pn = (wgid % nig) / gsz; return true;
    }
    __device__ __forceinline__ void a_ready(const Unit&) const {}
    __device__ __forceinline__ void done(const Unit&) const {}
};
__device__ __forceinline__ unsigned cvt_pk_bf16(float lo, float hi) { unsigned r; asm volatile("v_cvt_pk_bf16_f32 %0, %1, %2" : "=v"(r) : "v"(lo), "v"(hi)); return r; }
typedef float f32x2 __attribute__((ext_vector_type(2)));
struct EpiF32 {
    static constexpr bool PERM = false, AFTER_DRAIN = false;
    float* C; int ldc; const float* bias;
    __device__ __forceinline__ void operator()(const f32x4 (&acc)[2][2][4][2], const Unit& u, int wr, int wc, int fr, int fq) const {
        const int row0 = u.pm * BM + wr * 64 + fr, col0 = u.pn * BM + wc * 32 + 4 * fq;
        f32x4 bv[2][2];
#pragma unroll
        for (int bj = 0; bj < 2; ++bj)
#pragma unroll
            for (int n = 0; n < 2; ++n) bv[bj][n] = bias ? *(const f32x4*)(bias + col0 + bj * HALF + n * 16) : (f32x4){0.f, 0.f, 0.f, 0.f};
#pragma unroll
        for (int ai = 0; ai < 2; ++ai)
#pragma unroll
            for (int m = 0; m < 4; ++m) { float* rowp = C + (size_t)(row0 + ai * HALF + m * 16) * ldc + col0;
#pragma unroll
                for (int bj = 0; bj < 2; ++bj)
#pragma unroll
                    for (int n = 0; n < 2; ++n) *(f32x4*)(rowp + bj * HALF + n * 16) = acc[ai][bj][m][n] + bv[bj][n]; }
    }
};
template <class Epi, class Sched, bool STAMP = false>
__device__ __forceinline__ void gemm_phase(PG8_LAS unsigned char* lds, const Gemm g, const Sched& S, const Epi& E, unsigned long long* stamps) {
    const int tid = threadIdx.x, wid = __builtin_amdgcn_readfirstlane(tid >> 6), lane = tid & 63, wr = wid >> 2, wc = wid & 3, fr = lane & 15, fq = lane >> 4;
    const int K = g.K, nt = K / BK;
    int ts_lo = 0, ts_hi = 0, nts = 0; const unsigned long long rt_entry = STAMP ? (unsigned long long)wall_clock64() : 0ull;
#define PG8_STAMP() do { if (STAMP && wid == 0 && nts < 64) { const unsigned long long _c = (unsigned long long)clock64(); \
        ts_lo = (lane == nts) ? (int)(unsigned)_c : ts_lo; ts_hi = (lane == nts) ? (int)(unsigned)(_c >> 32) : ts_hi; ++nts; } } while (0)
    PG8_STAMP();
    unsigned voffA[2], voffB[2];
#pragma unroll
    for (int i = 0; i < 2; ++i) { int R, C; stage_rc(tid * 16 + i * 8192, R, C); const int Rb = Epi::PERM ? ((R & ~31) + perm32(R & 31)) : R;
        voffA[i] = (unsigned)(R * g.lda + C) * 2u; voffB[i] = (unsigned)(Rb * K + C) * 2u; }
    const size_t kstep = (size_t)(BK * 2);
    const size_t hstep = (size_t)HALF * K * 2, hstepA = (size_t)HALF * g.lda * 2;
    const size_t tstep = 2 * hstep, tstepA = (size_t)g.tile_rows * g.lda * 2;
    const unsigned ldsw = (unsigned)wid * 1024u;
    const int aoff = lds_byte(wr * 64 + fr, fq * 8), boff = lds_byte(wc * 32 + fr, fq * 8);
#define PG8_SA(b, h) (((b) * 2 + (h)) * HTB)
#define PG8_SB(b, h) ((4 + (b) * 2 + (h)) * HTB)
#define PG8_STAGE(bufoff, gbase, voff) do { _Pragma("unroll") for (int _i = 0; _i < 2; ++_i) \
        __builtin_amdgcn_global_load_lds((const unsigned*)((const char*)(gbase) + (voff)[_i]), (PG8_LAS unsigned*)(lds + (bufoff) + ldsw + _i * 8192), 16, 0, 0); } while (0)
#define PG8_LDA(dst, b, h) do { _Pragma("unroll") for (int m = 0; m < 4; ++m) _Pragma("unroll") for (int k = 0; k < 2; ++k) dst[m][k] = *(const PG8_LAS bf16x8*)(lds + PG8_SA(b, h) + aoff + m * 2048 + k * 1024); } while (0)
#define PG8_LDB(dst, b, h) do { _Pragma("unroll") for (int n = 0; n < 2; ++n) _Pragma("unroll") for (int k = 0; k < 2; ++k) dst[n][k] = *(const PG8_LAS bf16x8*)(lds + PG8_SB(b, h) + boff + n * 2048 + k * 1024); } while (0)
#define PG8_MMA(ai, bj, At, Bt) do { __builtin_amdgcn_s_setprio(1); _Pragma("unroll") for (int m = 0; m < 4; ++m) _Pragma("unroll") for (int n = 0; n < 2; ++n) _Pragma("unroll") for (int k = 0; k < 2; ++k) \
        acc[ai][bj][m][n] = __builtin_amdgcn_mfma_f32_16x16x32_bf16(Bt[n][k], At[m][k], acc[ai][bj][m][n], 0, 0, 0); __builtin_amdgcn_s_setprio(0); } while (0)
#define PG8_WAIT_V(n) asm volatile("s_waitcnt vmcnt(" #n ")" ::: "memory")
#define PG8_WAIT_L(n) asm volatile("s_waitcnt lgkmcnt(" #n ")" ::: "memory")
#define PG8_BAR __builtin_amdgcn_s_barrier()
#define PG8_SCHED __builtin_amdgcn_sched_barrier(0)
    Unit cur, nxt; int ui = 0;
    if (!S.next(0, cur)) return;
    f32x4 acc[2][2][4][2];
#pragma unroll
    for (int a = 0; a < 2; ++a)
#pragma unroll
        for (int b = 0; b < 2; ++b)
#pragma unroll
            for (int m = 0; m < 4; ++m)
#pragma unroll
                for (int n = 0; n < 2; ++n) acc[a][b][m][n] = (f32x4){0.f, 0.f, 0.f, 0.f};
    bf16x8 At[4][2], B0[2][2], B1[2][2];
    const char* cA = (const char*)g.A + (size_t)cur.pm * tstepA; const char* cB = (const char*)g.Bt + (size_t)cur.pn * tstep;
    S.a_ready(cur);
    PG8_STAGE(PG8_SB(0, 0), cB, voffB); PG8_STAGE(PG8_SA(0, 0), cA, voffA); PG8_STAGE(PG8_SB(0, 1), cB + hstep, voffB); PG8_STAGE(PG8_SA(0, 1), cA + hstepA, voffA);
    if (wr == 1) PG8_BAR;
    PG8_WAIT_V(4); PG8_BAR;
    PG8_STAGE(PG8_SB(1, 0), cB + kstep, voffB); PG8_STAGE(PG8_SA(1, 0), cA + kstep, voffA); PG8_STAGE(PG8_SB(1, 1), cB + hstep + kstep, voffB);
    PG8_WAIT_V(6); PG8_BAR;
    PG8_STAMP();
    for (;;) {
        const bool has_next = S.next(ui + 1, nxt);
        const char* nA = has_next ? (const char*)g.A + (size_t)nxt.pm * tstepA : cA; const char* nB = has_next ? (const char*)g.Bt + (size_t)nxt.pn * tstep : cB;
        for (int t = 0; t < nt; t += 2) {
            const bool last = (t == nt - 2);
            const char* a1 = cA + (size_t)(t + 1) * kstep;
            const char* a2 = last ? nA : cA + (size_t)(t + 2) * kstep; const char* b2 = last ? nB : cB + (size_t)(t + 2) * kstep;
            const char* a3 = a2 + kstep; const char* b3 = b2 + kstep;
            if (last && has_next) S.a_ready(nxt);
            PG8_LDB(B0, 0, 0); PG8_SCHED; PG8_LDA(At, 0, 0); PG8_STAGE(PG8_SA(1, 1), a1 + hstepA, voffA);
            PG8_WAIT_L(8); PG8_BAR; PG8_WAIT_L(0); PG8_MMA(0, 0, At, B0); PG8_BAR; PG8_SCHED;
            PG8_LDB(B1, 0, 1); PG8_STAGE(PG8_SB(0, 0), b2, voffB);
            PG8_BAR; PG8_WAIT_L(0); PG8_MMA(0, 1, At, B1); PG8_BAR;
            PG8_LDA(At, 0, 1); PG8_STAGE(PG8_SA(0, 0), a2, voffA);
            PG8_BAR; PG8_WAIT_L(0); PG8_MMA(1, 0, At, B0); PG8_BAR; PG8_SCHED;
            PG8_STAGE(PG8_SB(0, 1), b2 + hstep, voffB);
            PG8_WAIT_V(6); PG8_BAR; PG8_MMA(1, 1, At, B1); PG8_BAR;
            PG8_LDB(B0, 1, 0); PG8_SCHED; PG8_LDA(At, 1, 0); PG8_STAGE(PG8_SA(0, 1), a2 + hstepA, voffA);
            PG8_WAIT_L(8); PG8_BAR; PG8_WAIT_L(0); PG8_MMA(0, 0, At, B0); PG8_BAR; PG8_SCHED;
            PG8_LDB(B1, 1, 1); PG8_STAGE(PG8_SB(1, 0), b3, voffB);
            PG8_BAR; PG8_WAIT_L(0); PG8_MMA(0, 1, At, B1); PG8_BAR;
            PG8_LDA(At, 1, 1); PG8_STAGE(PG8_SA(1, 0), a3, voffA);
            PG8_BAR; PG8_WAIT_L(0); PG8_MMA(1, 0, At, B0); PG8_BAR; PG8_SCHED;
            PG8_STAGE(PG8_SB(1, 1), b3 + hstep, voffB);
            PG8_WAIT_V(6); PG8_BAR; PG8_MMA(1, 1, At, B1); PG8_BAR;
        }
        PG8_STAMP();
        if constexpr (!Epi::AFTER_DRAIN) { E(acc, cur, wr, wc, fr, fq); S.done(cur); }
        PG8_STAMP();
        if (!has_next) break;
#pragma unroll
        for (int a = 0; a < 2; ++a)
#pragma unroll
            for (int b = 0; b < 2; ++b)
#pragma unroll
                for (int m = 0; m < 4; ++m)
#pragma unroll
                    for (int n = 0; n < 2; ++n) acc[a][b][m][n] = (f32x4){0.f, 0.f, 0.f, 0.f};
        cur = nxt; cA = nA; cB = nB; ++ui;
    }
    PG8_WAIT_V(0);
    if (wr == 0) PG8_BAR;
    PG8_BAR;
    if constexpr (Epi::AFTER_DRAIN) { E.fused(acc, cur, wr, wc, fr, fq, lds, wid, lane); S.done(cur); }
    PG8_STAMP();
    if (STAMP && wid == 0) { stamps[lane] = lane < nts ? (((unsigned long long)(unsigned)ts_hi << 32) | (unsigned)ts_lo) : 0ull;
        if (lane == 62) stamps[62] = rt_entry; if (lane == 63) stamps[63] = (unsigned long long)wall_clock64(); }
#undef PG8_STAMP
#undef PG8_SA
#undef PG8_SB
#undef PG8_STAGE
#undef PG8_LDA
#undef PG8_LDB
#undef PG8_MMA
#undef PG8_WAIT_V
#undef PG8_WAIT_L
#undef PG8_BAR
#undef PG8_SCHED
}
}

namespace cg = cooperative_groups;
#define LAS __attribute__((address_space(3)))
typedef unsigned short bf16_t;
typedef unsigned int u32;
typedef pg8::bf16x8 bf16x8;
typedef pg8::f32x4 f32x4;
typedef pg8::u32x4 u32x4;

constexpr int D = 1024, TP = 4096, BP = 8, MP = BP * TP, BS = 32, TS = 8, MS = BS * TS;
constexpr int MB = MP + MS;
constexpr int MA = 33280;
constexpr int MA_REAL = MP + BS * 9;
constexpr int DIN = 3328, RCOLS = 1792, FF = 2816, FF2 = 5632, NLORA = 1536, KLORA = 256;
constexpr int NTHREADS = 512;
constexpr int UP_TILES = 131, UP_STEP = 254, H2P_ROWS = (UP_TILES - 1) * UP_STEP + 256;
constexpr int LDS_BYTES = 144 * 1024;

constexpr size_t O_YP = 0;
constexpr size_t O_YS = O_YP + (size_t)MP * D;
constexpr size_t O_PSH = O_YS + (size_t)MS * D;
constexpr size_t O_PWKV = O_PSH + (size_t)BP * D;
constexpr size_t O_PK = O_PWKV + (size_t)BP * 8 * 64 * 64;
constexpr size_t O_PV = O_PK + (size_t)BP * 2048 * 512;
constexpr size_t O_PCONV = O_PV + (size_t)BP * 2048 * 512;
constexpr size_t O_SSH = O_PCONV + (size_t)BP * 2 * FF2;
constexpr size_t O_SWKV = O_SSH + (size_t)BS * D;
constexpr size_t O_SK = O_SWKV + (size_t)BS * 8 * 64 * 64;
constexpr size_t O_SV = O_SK + (size_t)BS * 2048 * 512;
constexpr size_t O_SCONV = O_SV + (size_t)BS * 2048 * 512;
constexpr size_t O_END = O_SCONV + (size_t)BS * 2 * FF2;

constexpr size_t al256(size_t x) { return (x + 255) & ~(size_t)255; }
constexpr size_t WS_WIN = 0;
constexpr size_t WS_WOUT = WS_WIN + al256((size_t)DIN * D * 2);
constexpr size_t WS_WUP = WS_WOUT + al256((size_t)D * D * 2);
constexpr size_t WS_WDN = WS_WUP + al256((size_t)FF2 * D * 2);
constexpr size_t WS_WLORA = WS_WDN + al256((size_t)D * FF * 2);
constexpr size_t WS_ROPE = WS_WLORA + al256((size_t)NLORA * KLORA * 2);
constexpr int NPOS = 4104;
constexpr size_t WS_SNEWK = WS_ROPE + al256((size_t)NPOS * 32 * 2 * 4);
constexpr size_t WS_SNEWV = WS_SNEWK + al256((size_t)MS * 512 * 4);
constexpr size_t WS_HALO = WS_SNEWV + al256((size_t)MS * 512 * 4);
constexpr size_t WS_A = WS_HALO + al256((size_t)1025 * 2 * FF2 * 2);
constexpr size_t WS_PROJRW = WS_A;
constexpr size_t WS_Q = WS_PROJRW + al256((size_t)MA * RCOLS * 2);
constexpr size_t WS_K = WS_Q + al256((size_t)MB * 512 * 2);
constexpr size_t WS_VT1 = WS_K + al256((size_t)MB * 512 * 2);
constexpr size_t WS_VT4 = WS_VT1 + al256((size_t)BP * 8 * 64 * TP * 2);
constexpr size_t WS_VT16 = WS_VT4 + al256((size_t)BP * 8 * 64 * TP * 2);
constexpr size_t WS_ALORA = WS_VT16 + al256((size_t)BP * 8 * 64 * TP * 2);
constexpr size_t WS_VROW = WS_ALORA + al256((size_t)MB * KLORA * 2);
constexpr size_t WS_A_EARLY_END = WS_VROW + al256((size_t)MP * 512 * 2);
constexpr size_t WS_U = WS_A;
constexpr size_t WS_F = WS_A + al256((size_t)MB * FF * 2);
static_assert(WS_F + (size_t)MB * D * 4 <= WS_A + al256((size_t)MB * FF2 * 2), "region A late overflow");
constexpr size_t WS_END = WS_A + al256((size_t)MB * FF2 * 2);
static_assert(WS_A_EARLY_END <= WS_END, "region A overflow");
constexpr size_t WS_BAR = WS_END;
constexpr size_t WS_TOTAL = WS_END + 256;
constexpr size_t WS_Y = WS_ALORA;
static_assert(WS_Y + (size_t)MB * 512 * 4 <= WS_END, "Y overflow");
constexpr size_t SC_B = O_SK * 4;
constexpr size_t SC_C = SC_B + al256((size_t)MB * D * 4);
static_assert(SC_C + (size_t)H2P_ROWS * D * 2 <= O_SCONV * 4, "scratch overflow");
static_assert((size_t)MA * D * 2 <= (size_t)MB * D * 4 && (size_t)MB * NLORA * 2 <= (size_t)MB * D * 4, "region B");

struct Params {
    const float* in[28];
    float* out;
    unsigned char* ws;
    int en, pad;
};

enum { I_XP = 0, I_XS, I_SSHIFT, I_SWKV, I_CK, I_CV, I_SCONV, I_NMPRE, I_NMPOST, I_NFPRE, I_NFPOST, I_WIN, I_MU, I_W0, I_WDEC, I_A0, I_WICLR, I_WGATE,
       I_KK, I_KA, I_RK, I_LNW, I_LNB, I_WOUT, I_WUP, I_CONVW, I_CONVB, I_WDN };

__device__ __forceinline__ float bflo(u32 p) { return __uint_as_float(p << 16); }
__device__ __forceinline__ float bfhi(u32 p) { return __uint_as_float(p & 0xffff0000u); }
__device__ __forceinline__ u32 pk2(float a, float b) { return pg8::cvt_pk_bf16(a, b); }
__device__ __forceinline__ float wave_sum(float v) {
#pragma unroll
    for (int o = 1; o < 64; o <<= 1) v += __shfl_xor(v, o);
    return v;
}
template <int N> __device__ __forceinline__ float dpp_ror(float x) {
    return __int_as_float(__builtin_amdgcn_update_dpp(0, __float_as_int(x), 0x120 + N, 0xF, 0xF, false));
}
__device__ __forceinline__ float row16_sum(float x) {
    x += dpp_ror<8>(x); x += dpp_ror<4>(x); x += dpp_ror<2>(x); x += dpp_ror<1>(x);
    return x;
}
__device__ __forceinline__ void row16_sum4(float& a, float& b, float& c, float& d) {
    asm volatile("s_nop 1\n\t"
                 "v_add_f32_dpp %0, %0, %0 row_ror:8 row_mask:0xf bank_mask:0xf\n\t" "v_add_f32_dpp %1, %1, %1 row_ror:8 row_mask:0xf bank_mask:0xf\n\t"
                 "v_add_f32_dpp %2, %2, %2 row_ror:8 row_mask:0xf bank_mask:0xf\n\t" "v_add_f32_dpp %3, %3, %3 row_ror:8 row_mask:0xf bank_mask:0xf\n\t"
                 "v_add_f32_dpp %0, %0, %0 row_ror:4 row_mask:0xf bank_mask:0xf\n\t" "v_add_f32_dpp %1, %1, %1 row_ror:4 row_mask:0xf bank_mask:0xf\n\t"
                 "v_add_f32_dpp %2, %2, %2 row_ror:4 row_mask:0xf bank_mask:0xf\n\t" "v_add_f32_dpp %3, %3, %3 row_ror:4 row_mask:0xf bank_mask:0xf\n\t"
                 "v_add_f32_dpp %0, %0, %0 row_ror:2 row_mask:0xf bank_mask:0xf\n\t" "v_add_f32_dpp %1, %1, %1 row_ror:2 row_mask:0xf bank_mask:0xf\n\t"
                 "v_add_f32_dpp %2, %2, %2 row_ror:2 row_mask:0xf bank_mask:0xf\n\t" "v_add_f32_dpp %3, %3, %3 row_ror:2 row_mask:0xf bank_mask:0xf\n\t"
                 "v_add_f32_dpp %0, %0, %0 row_ror:1 row_mask:0xf bank_mask:0xf\n\t" "v_add_f32_dpp %1, %1, %1 row_ror:1 row_mask:0xf bank_mask:0xf\n\t"
                 "v_add_f32_dpp %2, %2, %2 row_ror:1 row_mask:0xf bank_mask:0xf\n\t" "v_add_f32_dpp %3, %3, %3 row_ror:1 row_mask:0xf bank_mask:0xf\n\t"
                 "s_nop 1"
                 : "+v"(a), "+v"(b), "+v"(c), "+v"(d));
}
__device__ __forceinline__ float fma_(float a, float b, float c) { float d; asm("v_fma_f32 %0, %1, %2, %3" : "=v"(d) : "v"(a), "v"(b), "v"(c)); return d; }
__device__ __forceinline__ float mul_(float a, float b) { float d; asm("v_mul_f32 %0, %1, %2" : "=v"(d) : "v"(a), "v"(b)); return d; }
__device__ __forceinline__ void row16_sum2_mul4(float& a, float& b, float (&t)[4], float v, float k0, float k1, float k2, float k3) {
    asm volatile("v_mul_f32 %2, %6, %7\n\t" "v_mul_f32 %3, %6, %8\n\t"
                 "v_add_f32_dpp %0, %0, %0 row_ror:8 row_mask:0xf bank_mask:0xf\n\t" "v_add_f32_dpp %1, %1, %1 row_ror:8 row_mask:0xf bank_mask:0xf\n\t"
                 "v_mul_f32 %4, %6, %9\n\t"
                 "v_add_f32_dpp %0, %0, %0 row_ror:4 row_mask:0xf bank_mask:0xf\n\t" "v_add_f32_dpp %1, %1, %1 row_ror:4 row_mask:0xf bank_mask:0xf\n\t"
                 "v_mul_f32 %5, %6, %10\n\t"
                 "v_add_f32_dpp %0, %0, %0 row_ror:2 row_mask:0xf bank_mask:0xf\n\t" "v_add_f32_dpp %1, %1, %1 row_ror:2 row_mask:0xf bank_mask:0xf\n\t"
                 "s_nop 0\n\t"
                 "v_add_f32_dpp %0, %0, %0 row_ror:1 row_mask:0xf bank_mask:0xf\n\t" "v_add_f32_dpp %1, %1, %1 row_ror:1 row_mask:0xf bank_mask:0xf"
                 : "+v"(a), "+v"(b), "=&v"(t[0]), "=&v"(t[1]), "=&v"(t[2]), "=&v"(t[3])
                 : "v"(v), "v"(k0), "v"(k1), "v"(k2), "v"(k3));
}
__device__ __forceinline__ void row16_sum2(float& a, float& b) {
    asm volatile("s_nop 1\n\t"
                 "v_add_f32_dpp %0, %0, %0 row_ror:8 row_mask:0xf bank_mask:0xf\n\t" "v_add_f32_dpp %1, %1, %1 row_ror:8 row_mask:0xf bank_mask:0xf\n\t" "s_nop 0\n\t"
                 "v_add_f32_dpp %0, %0, %0 row_ror:4 row_mask:0xf bank_mask:0xf\n\t" "v_add_f32_dpp %1, %1, %1 row_ror:4 row_mask:0xf bank_mask:0xf\n\t" "s_nop 0\n\t"
                 "v_add_f32_dpp %0, %0, %0 row_ror:2 row_mask:0xf bank_mask:0xf\n\t" "v_add_f32_dpp %1, %1, %1 row_ror:2 row_mask:0xf bank_mask:0xf\n\t" "s_nop 0\n\t"
                 "v_add_f32_dpp %0, %0, %0 row_ror:1 row_mask:0xf bank_mask:0xf\n\t" "v_add_f32_dpp %1, %1, %1 row_ror:1 row_mask:0xf bank_mask:0xf\n\t"
                 "s_nop 1"
                 : "+v"(a), "+v"(b));
}
__device__ __forceinline__ float sigmoidf_(float x) { return __builtin_amdgcn_rcpf(1.f + __expf(-x)); }

__device__ __forceinline__ int win_rowmap(int n) {
    if (n < RCOLS || n >= RCOLS + 1024) return n;
    const int base = (n < RCOLS + 512) ? RCOLS : RCOLS + 512, c = n - base, unit = c >> 8, cu = c & 255, hu = cu >> 6, d = cu & 63, e = d & 31, s = d >> 5;
    const int idx = hu * 32 + e, bj = idx >> 6, wc = (idx & 63) >> 4, fq = (idx & 15) >> 2, j = idx & 3;
    return base + unit * 256 + 128 * bj + 32 * wc + 16 * s + 4 * fq + j;
}
__device__ __forceinline__ int wup_rowmap(int c) {
    const int isup = c >= FF ? 1 : 0, cc = c - FF * isup, pn = cc >> 7, e = cc & 127;
    return pn * 256 + 128 * (e >> 6) + 32 * ((e >> 4) & 3) + 16 * isup + 4 * ((e >> 2) & 3) + (e & 3);
}
__device__ __forceinline__ void transpose_item(const float* W, int K, int N, bf16_t* WT, int mode, LAS float* scr, int item, int lane) {
    const int nblk = N / 32, kb = item / nblk, nb = item % nblk, k0 = 64 * kb, n0 = 32 * nb;
#pragma unroll 8
    for (int i = 0; i < 32; ++i) { const int kk = 2 * i + (lane >> 5); scr[kk * 33 + (lane & 31)] = W[(size_t)(k0 + kk) * N + n0 + (lane & 31)]; }
    asm volatile("s_waitcnt lgkmcnt(0)" ::: "memory");
    const int c = lane & 7;
#pragma unroll
    for (int j = 0; j < 4; ++j) { const int n = (lane >> 3) + 8 * j; const LAS float* s = scr + (8 * c) * 33 + n;
        uint4 o; o.x = pk2(s[0 * 33], s[1 * 33]); o.y = pk2(s[2 * 33], s[3 * 33]); o.z = pk2(s[4 * 33], s[5 * 33]); o.w = pk2(s[6 * 33], s[7 * 33]);
        const int row = mode == 1 ? win_rowmap(n0 + n) : (mode == 2 ? wup_rowmap(n0 + n) : (n0 + n));
        *(uint4*)(WT + (size_t)row * K + k0 + 8 * c) = o; }
    asm volatile("s_waitcnt lgkmcnt(0)" ::: "memory");
}
__device__ __forceinline__ void rms_row(const float* xrow, const float* g, bf16_t* orow, float* frow, int lane) {
    const float4* xr = (const float4*)xrow + lane; const float4* gr = (const float4*)g + lane;
    float4 v[4]; float s = 0.f;
#pragma unroll
    for (int j = 0; j < 4; ++j) { v[j] = xr[64 * j]; s += (v[j].x * v[j].x + v[j].y * v[j].y) + (v[j].z * v[j].z + v[j].w * v[j].w); }
    const float rs = rsqrtf(wave_sum(s) * (1.f / D) + 1e-6f);
#pragma unroll
    for (int j = 0; j < 4; ++j) { const float4 gg = gr[64 * j];
        float4 y; y.x = v[j].x * rs * gg.x; y.y = v[j].y * rs * gg.y; y.z = v[j].z * rs * gg.z; y.w = v[j].w * rs * gg.w;
        uint2 o; o.x = pk2(y.x, y.y); o.y = pk2(y.z, y.w);
        *((uint2*)orow + lane + 64 * j) = o;
        if (frow) *((float4*)frow + lane + 64 * j) = y; }
}
__device__ __forceinline__ void phase0(const Params& p, LAS unsigned char* lds, int tid, int G, int bid) {
    const int wave = tid >> 6, lane = tid & 63, gw = bid * 8 + wave, NGW = G * 8;
    LAS float* scr = (LAS float*)(lds + wave * 16384);
    bf16_t* WinT = (bf16_t*)(p.ws + WS_WIN); bf16_t* WoutT = (bf16_t*)(p.ws + WS_WOUT); bf16_t* WupT = (bf16_t*)(p.ws + WS_WUP); bf16_t* WdnT = (bf16_t*)(p.ws + WS_WDN);
    constexpr int I1 = (D / 64) * (DIN / 32), I2 = (D / 64) * (D / 32), I3 = (D / 64) * (FF2 / 32), I4 = (FF / 64) * (D / 32);
    for (int it = gw; it < I1 + I2 + I3 + I4; it += NGW) {
        int r = it;
        if (r < I1) { transpose_item(p.in[I_WIN], D, DIN, WinT, 1, scr, r, lane); continue; } r -= I1;
        if (r < I2) { transpose_item(p.in[I_WOUT], D, D, WoutT, 0, scr, r, lane); continue; } r -= I2;
        if (r < I3) { transpose_item(p.in[I_WUP], D, FF2, WupT, 2, scr, r, lane); continue; } r -= I3;
        transpose_item(p.in[I_WDN], FF, D, WdnT, 0, scr, r, lane);
    }
    const int gt = bid * NTHREADS + tid, NT = G * NTHREADS;
    bf16_t* WL = (bf16_t*)(p.ws + WS_WLORA);
    for (int i = gt; i < NLORA * KLORA; i += NT) {
        const int row = i >> 8, k = i & 255; float v = 0.f;
        if (row < 512) { if (k < 64) v = p.in[I_WDEC][k * 512 + row]; }
        else if (row < 1024) { if (k >= 64 && k < 128) v = p.in[I_WICLR][(k - 64) * 512 + (row - 512)]; }
        else { if (k >= 128) v = p.in[I_WGATE][(k - 128) * 512 + (row - 1024)]; }
        WL[i] = (bf16_t)(pk2(v, 0.f) & 0xffffu);
    }
    float* rope = (float*)(p.ws + WS_ROPE);
    for (int i = gt; i < NPOS * 32; i += NT) {
        const int pi = i >> 5, e = i & 31; const int pos = pi < TP ? pi : 16384 + (pi - TP);
        double inv = 1.0; for (int q = 0; q < e; ++q) inv *= 0.7498942093324558273;
        const float ang = (float)pos * (float)inv;
        const double a = (double)ang; const double kq = rint(a * 0.15915494309189535); double r = a - kq * 6.283185307179586; r -= kq * 2.4492935982947064e-16;
        const double r2 = r * r;
        double sn = 1.0 / 51090942171709440000.0;
        sn = sn * r2 * (-1.0) + 1.0 / 121645100408832000.0;
        sn = -sn * r2 + 1.0 / 355687428096000.0;
        sn = -sn * r2 + 1.0 / 1307674368000.0;
        sn = -sn * r2 + 1.0 / 6227020800.0;
        sn = -sn * r2 + 1.0 / 39916800.0;
        sn = -sn * r2 + 1.0 / 362880.0;
        sn = -sn * r2 + 1.0 / 5040.0;
        sn = -sn * r2 + 1.0 / 120.0;
        sn = -sn * r2 + 1.0 / 6.0;
        sn = -sn * r2 + 1.0;
        sn *= r;
        double cs = 1.0 / 1124000727777607680000.0;
        cs = -cs * r2 + 1.0 / 2432902008176640000.0;
        cs = -cs * r2 + 1.0 / 6402373705728000.0;
        cs = -cs * r2 + 1.0 / 20922789888000.0;
        cs = -cs * r2 + 1.0 / 87178291200.0;
        cs = -cs * r2 + 1.0 / 479001600.0;
        cs = -cs * r2 + 1.0 / 3628800.0;
        cs = -cs * r2 + 1.0 / 40320.0;
        cs = -cs * r2 + 1.0 / 720.0;
        cs = -cs * r2 + 1.0 / 24.0;
        cs = -cs * r2 + 0.5;
        cs = -cs * r2 + 1.0;
        rope[i] = (float)cs; rope[NPOS * 32 + i] = (float)sn;
    }
    bf16_t* H = (bf16_t*)((unsigned char*)p.out + SC_B);
    for (int row = gw; row < MA; row += NGW) {
        bf16_t* orow = H + (size_t)row * D;
        if (row < MP) {
            const bool last = (row & (TP - 1)) == TP - 1;
            rms_row(p.in[I_XP] + (size_t)row * D, p.in[I_NMPRE], orow, last ? p.out + O_PSH + (size_t)(row >> 12) * D : nullptr, lane);
        } else {
            const int s = row - MP;
            if (s < BS * 9) {
                const int b = s / 9, j = s - b * 9;
                if (j == 0) {
                    const float4* sr = (const float4*)(p.in[I_SSHIFT] + (size_t)b * D) + lane;
#pragma unroll
                    for (int q = 0; q < 4; ++q) { const float4 v = sr[64 * q]; uint2 o; o.x = pk2(v.x, v.y); o.y = pk2(v.z, v.w); *((uint2*)orow + lane + 64 * q) = o; }
                } else {
                    rms_row(p.in[I_XS] + (size_t)(b * TS + j - 1) * D, p.in[I_NMPRE], orow, j == TS ? p.out + O_SSH + (size_t)b * D : nullptr, lane);
                }
            } else {
#pragma unroll
                for (int q = 0; q < 4; ++q) *((uint2*)orow + lane + 64 * q) = make_uint2(0u, 0u);
            }
        }
    }
}

struct EpiProj {
    static constexpr bool PERM = false, AFTER_DRAIN = false;
    bf16_t* projrw; bf16_t* Q; bf16_t* K; bf16_t* VT1; bf16_t* VT4; bf16_t* VT16; const float* rope; float* out; float* snewk; float* snewv;
    __device__ __forceinline__ void operator()(const f32x4 (&acc)[2][2][4][2], const pg8::Unit& u, int wr, int wc, int fr, int fq) const {
        const int pn = u.pn;
        if (pn < 7) {
#pragma unroll
            for (int ai = 0; ai < 2; ++ai)
#pragma unroll
                for (int m = 0; m < 4; ++m) { const int row = u.pm * 256 + ai * 128 + wr * 64 + m * 16 + fr;
                    bf16_t* rp = projrw + (size_t)row * RCOLS + pn * 256 + wc * 32 + 4 * fq;
#pragma unroll
                    for (int bj = 0; bj < 2; ++bj)
#pragma unroll
                        for (int n = 0; n < 2; ++n) { const f32x4 v = acc[ai][bj][m][n]; uint2 o; o.x = pk2(v[0], v[1]); o.y = pk2(v[2], v[3]); *(uint2*)(rp + bj * 128 + n * 16) = o; } }
            return;
        }
#pragma unroll
        for (int ai = 0; ai < 2; ++ai)
#pragma unroll
            for (int m = 0; m < 4; ++m) {
                const int row = u.pm * 256 + ai * 128 + wr * 64 + m * 16 + fr;
                bool prompt = row < MP; int b, t, rowB, pi; bool valid = true;
                if (prompt) { b = row >> 12; t = row & (TP - 1); rowB = row; pi = t; }
                else { const int s = row - MP; b = s / 9; const int j = s - b * 9; valid = (s < BS * 9) && (j > 0); t = j - 1; rowB = MP + b * TS + t; pi = TP + t; }
                if (!valid) continue;
                if (pn < 11) {
                    const bool isq = pn < 9; const int unit = isq ? pn - 7 : pn - 9;
#pragma unroll
                    for (int bj = 0; bj < 2; ++bj) {
                        const int idx = bj * 64 + wc * 16 + fq * 4, hu = idx >> 5, e = idx & 31;
                        const float4 cs = *(const float4*)(rope + (size_t)pi * 32 + e), sn = *(const float4*)(rope + (size_t)NPOS * 32 + (size_t)pi * 32 + e);
                        const f32x4 x1 = acc[ai][bj][m][0], x2 = acc[ai][bj][m][1];
                        float o1[4], o2[4];
                        o1[0] = x1[0] * cs.x - x2[0] * sn.x; o2[0] = x1[0] * sn.x + x2[0] * cs.x;
                        o1[1] = x1[1] * cs.y - x2[1] * sn.y; o2[1] = x1[1] * sn.y + x2[1] * cs.y;
                        o1[2] = x1[2] * cs.z - x2[2] * sn.z; o2[2] = x1[2] * sn.z + x2[2] * cs.z;
                        o1[3] = x1[3] * cs.w - x2[3] * sn.w; o2[3] = x1[3] * sn.w + x2[3] * cs.w;
                        const int col = unit * 256 + hu * 64 + e;
                        if (isq) {
                            uint2 a, c2; a.x = pk2(o1[0] * 0.125f, o1[1] * 0.125f); a.y = pk2(o1[2] * 0.125f, o1[3] * 0.125f); c2.x = pk2(o2[0] * 0.125f, o2[1] * 0.125f); c2.y = pk2(o2[2] * 0.125f, o2[3] * 0.125f);
                            *(uint2*)(Q + (size_t)rowB * 512 + col) = a; *(uint2*)(Q + (size_t)rowB * 512 + col + 32) = c2;
                        } else {
                            uint2 a, c2; a.x = pk2(o1[0], o1[1]); a.y = pk2(o1[2], o1[3]); c2.x = pk2(o2[0], o2[1]); c2.y = pk2(o2[2], o2[3]);
                            *(uint2*)(K + (size_t)rowB * 512 + col) = a; *(uint2*)(K + (size_t)rowB * 512 + col + 32) = c2;
                            float* dst = nullptr;
                            if (prompt) { if (t >= 2048) dst = out + O_PK + ((size_t)b * 2048 + (t - 2048)) * 512 + col; }
                            else dst = snewk + (size_t)(b * TS + t) * 512 + col;
                            if (dst) { *(float4*)dst = make_float4(o1[0], o1[1], o1[2], o1[3]); *(float4*)(dst + 32) = make_float4(o2[0], o2[1], o2[2], o2[3]); }
                        }
                    }
                } else {
#pragma unroll
                    for (int bj = 0; bj < 2; ++bj)
#pragma unroll
                        for (int n = 0; n < 2; ++n) {
                            const int col = (pn - 11) * 256 + bj * 128 + wc * 32 + n * 16 + 4 * fq; const f32x4 v = acc[ai][bj][m][n];
                            if (prompt) {
                                if (t >= 2048) *(float4*)(out + O_PV + ((size_t)b * 2048 + (t - 2048)) * 512 + col) = make_float4(v[0], v[1], v[2], v[3]);
                                uint2 o; o.x = pk2(v[0], v[1]); o.y = pk2(v[2], v[3]); *(uint2*)(VT1 + (size_t)rowB * 512 + col) = o;
                            } else {
                                *(float4*)(snewv + (size_t)(b * TS + t) * 512 + col) = make_float4(v[0], v[1], v[2], v[3]);
                            }
                        }
                }
            }
    }
};
struct EpiBf16S {
    static constexpr bool PERM = false, AFTER_DRAIN = false;
    bf16_t* O; int ldc;
    __device__ __forceinline__ void operator()(const f32x4 (&acc)[2][2][4][2], const pg8::Unit& u, int wr, int wc, int fr, int fq) const {
#pragma unroll
        for (int ai = 0; ai < 2; ++ai)
#pragma unroll
            for (int m = 0; m < 4; ++m) { bf16_t* rp = O + (size_t)(u.pm * 256 + ai * 128 + wr * 64 + m * 16 + fr) * ldc + u.pn * 256 + wc * 32 + 4 * fq;
#pragma unroll
                for (int bj = 0; bj < 2; ++bj)
#pragma unroll
                    for (int n = 0; n < 2; ++n) { const f32x4 v = acc[ai][bj][m][n]; uint2 o; o.x = pk2(v[0], v[1]); o.y = pk2(v[2], v[3]); *(uint2*)(rp + bj * 128 + n * 16) = o; } }
    }
};
struct EpiDag {
    static constexpr bool PERM = false, AFTER_DRAIN = false;
    bf16_t* dag; const float* w0; const float* a0;
    __device__ __forceinline__ void operator()(const f32x4 (&acc)[2][2][4][2], const pg8::Unit& u, int wr, int wc, int fr, int fq) const {
        const int kind = u.pn >> 1;
#pragma unroll
        for (int bj = 0; bj < 2; ++bj)
#pragma unroll
            for (int n = 0; n < 2; ++n) {
                const int col = u.pn * 256 + bj * 128 + wc * 32 + n * 16 + 4 * fq;
                float4 bias = make_float4(0.f, 0.f, 0.f, 0.f);
                if (kind == 0) bias = *(const float4*)(w0 + col); else if (kind == 1) bias = *(const float4*)(a0 + col - 512);
                const float bb[4] = {bias.x, bias.y, bias.z, bias.w};
#pragma unroll
                for (int ai = 0; ai < 2; ++ai)
#pragma unroll
                    for (int m = 0; m < 4; ++m) { const int row = u.pm * 256 + ai * 128 + wr * 64 + m * 16 + fr; const f32x4 v = acc[ai][bj][m][n]; float o[4];
#pragma unroll
                        for (int j = 0; j < 4; ++j) { const float x = v[j] + bb[j];
                            if (kind == 0) { const float z = -x; const float sp = fmaxf(z, 0.f) + __logf(1.f + __expf(-fabsf(z))); o[j] = -__expf(-sp - 0.5f); }
                            else if (kind == 1) o[j] = sigmoidf_(x);
                            else o[j] = x; }
                        uint2 q; q.x = pk2(o[0], o[1]); q.y = pk2(o[2], o[3]); *(uint2*)(dag + (size_t)row * NLORA + col) = q; }
            }
    }
};
struct EpiUp {
    static constexpr bool PERM = false, AFTER_DRAIN = false;
    bf16_t* U; bf16_t* halo; float* out;
    __device__ __forceinline__ void operator()(const f32x4 (&acc)[2][2][4][2], const pg8::Unit& u, int wr, int wc, int fr, int fq) const {
#pragma unroll
        for (int ai = 0; ai < 2; ++ai)
#pragma unroll
            for (int m = 0; m < 4; ++m) {
                const int row = u.pm * 256 + ai * 128 + wr * 64 + m * 16 + fr; const int col0 = u.pn * 256 + wc * 32 + 4 * fq;
                bf16_t* hrow = nullptr; float* frow = nullptr;
                if (row < MP) { const int t = row & (TP - 1);
                    if ((t & 31) >= 30) hrow = halo + ((size_t)((row >> 5) + 1) * 2 + ((t & 31) - 30)) * FF2;
                    if (t >= TP - 2) frow = out + O_PCONV + ((size_t)(row >> 12) * 2 + (t - (TP - 2))) * FF2;
                } else { const int s = row - MP, b = s >> 3, tt = s & 7; if (tt >= 6) frow = out + O_SCONV + ((size_t)b * 2 + (tt - 6)) * FF2; }
#pragma unroll
                for (int bj = 0; bj < 2; ++bj)
#pragma unroll
                    for (int n = 0; n < 2; ++n) { const f32x4 v = acc[ai][bj][m][n]; const int col = col0 + bj * 128 + n * 16;
                        uint2 o; o.x = pk2(v[0], v[1]); o.y = pk2(v[2], v[3]);
                        *(uint2*)(U + (size_t)row * FF2 + col) = o;
                        if (hrow) *(uint2*)(hrow + col) = o;
                        if (frow) *(float4*)(frow + col) = make_float4(v[0], v[1], v[2], v[3]); }
            }
    }
};

struct EpiUpAct {
    static constexpr bool PERM = false, AFTER_DRAIN = false;
    bf16_t* ACT; float* out; const float* cw; const float* cb; const float* sconv; LAS float* xch;
    __device__ __forceinline__ void operator()(const f32x4 (&acc)[2][2][4][2], const pg8::Unit& u, int wr, int wc, int fr, int fq) const {
        const int lane = fq * 16 + fr, wid = wr * 4 + wc;
        if (fr >= 14) {
#pragma unroll
            for (int ai = 0; ai < 2; ++ai)
#pragma unroll
                for (int bj = 0; bj < 2; ++bj)
#pragma unroll
                    for (int n = 0; n < 2; ++n) *(LAS f32x4*)(xch + ((wid * 2 + ai) * 2 + (fr - 14)) * 64 + (bj * 2 + n) * 16 + 4 * fq) = acc[ai][bj][3][n];
        }
        asm volatile("s_waitcnt lgkmcnt(0)" ::: "memory");
        __builtin_amdgcn_s_barrier(); __builtin_amdgcn_s_barrier();
        asm volatile("" ::: "memory");
#pragma unroll
        for (int bj = 0; bj < 2; ++bj) {
            const int e = 64 * bj + 16 * wc + 4 * fq, gcol = 128 * u.pn + e, ucol = FF + gcol;
            const float4 wg0 = *(const float4*)(cw + gcol), wg1 = *(const float4*)(cw + FF2 + gcol), wg2 = *(const float4*)(cw + 2 * FF2 + gcol), bg = *(const float4*)(cb + gcol);
            const float4 wu0 = *(const float4*)(cw + ucol), wu1 = *(const float4*)(cw + FF2 + ucol), wu2 = *(const float4*)(cw + 2 * FF2 + ucol), bu = *(const float4*)(cb + ucol);
            const float w0g[4] = {wg0.x, wg0.y, wg0.z, wg0.w}, w1g[4] = {wg1.x, wg1.y, wg1.z, wg1.w}, w2g[4] = {wg2.x, wg2.y, wg2.z, wg2.w}, bgg[4] = {bg.x, bg.y, bg.z, bg.w};
            const float w0u[4] = {wu0.x, wu0.y, wu0.z, wu0.w}, w1u[4] = {wu1.x, wu1.y, wu1.z, wu1.w}, w2u[4] = {wu2.x, wu2.y, wu2.z, wu2.w}, buu[4] = {bu.x, bu.y, bu.z, bu.w};
#pragma unroll
            for (int ai = 0; ai < 2; ++ai) {
                const int swr = wr ^ 1, sai = (wr == 1) ? ai : 0;
                const LAS float* xs = xch + (((swr * 4 + wc) * 2 + sai) * 2) * 64 + (bj * 2) * 16 + 4 * fq;
                f32x4 pg1 = *(const LAS f32x4*)(xs + 64), pg2 = *(const LAS f32x4*)(xs), pu1 = *(const LAS f32x4*)(xs + 64 + 16), pu2 = *(const LAS f32x4*)(xs + 16);
                f32x4 g1p = pg1, g2p = (fr == 1) ? pg1 : pg2, u1p = pu1, u2p = (fr == 1) ? pu1 : pu2;
#pragma unroll
                for (int m = 0; m < 4; ++m) {
                    const int r = 128 * ai + 64 * wr + 16 * m + fr; const int R = UP_STEP * u.pm - 2 + r;
                    const f32x4 gc = acc[ai][bj][m][0], uc = acc[ai][bj][m][1];
                    f32x4 g1r, g2r, u1r, u2r;
#pragma unroll
                    for (int j = 0; j < 4; ++j) { g1r[j] = dpp_ror<1>(gc[j]); g2r[j] = dpp_ror<2>(gc[j]); u1r[j] = dpp_ror<1>(uc[j]); u2r[j] = dpp_ror<2>(uc[j]); }
                    f32x4 g1 = (fr >= 1) ? g1r : g1p, g2 = (fr >= 2) ? g2r : g2p, u1 = (fr >= 1) ? u1r : u1p, u2 = (fr >= 2) ? u2r : u2p;
                    g1p = g1r; g2p = g2r; u1p = u1r; u2p = u2r;
                    const bool emit = (r >= 2) && (R < MB);
                    if (emit) {
                        float* frow = nullptr;
                        if (R < MP) { const int t = R & (TP - 1);
                            if (t == 0) { g1 = (f32x4){0.f, 0.f, 0.f, 0.f}; u1 = g1; }
                            if (t <= 1) { g2 = (f32x4){0.f, 0.f, 0.f, 0.f}; u2 = g2; }
                            if (t >= TP - 2) frow = out + O_PCONV + ((size_t)(R >> 12) * 2 + (t - (TP - 2))) * FF2;
                        } else { const int s = R - MP, b = s >> 3, tt = s & 7; const float* sp = sconv + (size_t)b * 2 * FF2;
                            if (tt == 0) { const float4 a = *(const float4*)(sp + FF2 + gcol), c = *(const float4*)(sp + FF2 + ucol); g1 = (f32x4){a.x, a.y, a.z, a.w}; u1 = (f32x4){c.x, c.y, c.z, c.w}; }
                            if (tt <= 1) { const float4 a = *(const float4*)(sp + (tt == 0 ? 0 : FF2) + gcol), c = *(const float4*)(sp + (tt == 0 ? 0 : FF2) + ucol); g2 = (f32x4){a.x, a.y, a.z, a.w}; u2 = (f32x4){c.x, c.y, c.z, c.w}; }
                            if (tt >= 6) frow = out + O_SCONV + ((size_t)b * 2 + (tt - 6)) * FF2;
                        }
                        float o[4];
#pragma unroll
                        for (int j = 0; j < 4; ++j) { const float cgv = w0g[j] * g2[j] + w1g[j] * g1[j] + w2g[j] * gc[j] + bgg[j], cuv = w0u[j] * u2[j] + w1u[j] * u1[j] + w2u[j] * uc[j] + buu[j];
                            o[j] = cgv * sigmoidf_(cgv) * cuv; }
                        uint2 w; w.x = pk2(o[0], o[1]); w.y = pk2(o[2], o[3]);
                        *(uint2*)(ACT + (size_t)R * FF + gcol) = w;
                        if (frow) { *(float4*)(frow + gcol) = make_float4(gc[0], gc[1], gc[2], gc[3]); *(float4*)(frow + ucol) = make_float4(uc[0], uc[1], uc[2], uc[3]); }
                    }
                }
            }
        }
    }
};

__device__ __forceinline__ int rowA_of(int rowB) { return rowB < MP ? rowB : MP + ((rowB - MP) >> 3) * 9 + 1 + ((rowB - MP) & 7); }
__device__ __forceinline__ void phase_alora(const Params& p, int tid, int G, int bid) {
    const bf16_t* PR = (const bf16_t*)(p.ws + WS_PROJRW); bf16_t* AL = (bf16_t*)(p.ws + WS_ALORA); const float* mu = p.in[I_MU];
    const int gt = bid * NTHREADS + tid, NT = G * NTHREADS;
    for (int i = gt; i < MB * 64; i += NT) {
        const int rowB = i >> 6, c = (i & 63) * 4, rowA = rowA_of(rowB);
        const uint2 cur = *(const uint2*)(PR + (size_t)rowA * RCOLS + 1536 + c);
        uint2 prv = make_uint2(0u, 0u);
        if (!(rowB < MP && (rowB & (TP - 1)) == 0)) prv = *(const uint2*)(PR + (size_t)(rowA - 1) * RCOLS + 1536 + c);
        const float4 m4 = *(const float4*)(mu + 1536 + c);
        float x[4] = {bflo(cur.x), bfhi(cur.x), bflo(cur.y), bfhi(cur.y)}; const float pv[4] = {bflo(prv.x), bfhi(prv.x), bflo(prv.y), bfhi(prv.y)}; const float mm[4] = {m4.x, m4.y, m4.z, m4.w};
#pragma unroll
        for (int j = 0; j < 4; ++j) { float v = x[j] + (pv[j] - x[j]) * mm[j];
            if (c < 64) v = tanhf(v); else if (c >= 128) v = sigmoidf_(v);
            x[j] = v; }
        uint2 o; o.x = pk2(x[0], x[1]); o.y = pk2(x[2], x[3]);
        *(uint2*)(AL + (size_t)rowB * KLORA + c) = o;
    }
}


__device__ __forceinline__ void phase_vtrans(const Params& p, LAS unsigned char* lds, int tid, int G, int bid) {
    const bf16_t* VR = (const bf16_t*)(p.ws + WS_VROW);
    constexpr int PITCH = 132;
    for (int item = bid; item < BP * 8 * 8; item += G) {
        const int b = item >> 6, h = (item >> 3) & 7, t0 = (item & 7) * 512;
        __syncthreads();
#pragma unroll
        for (int i = 0; i < 8; ++i) { const int piece = tid + 512 * i, row = piece >> 3, c8 = piece & 7;
            const uint4 v = *(const uint4*)(VR + (size_t)(b * TP + t0 + row) * 512 + h * 64 + c8 * 8);
            LAS u32* dst = (LAS u32*)(lds + row * PITCH + c8 * 16); dst[0] = v.x; dst[1] = v.y; dst[2] = v.z; dst[3] = v.w; }
        __syncthreads();
#pragma unroll 1
        for (int lay = 0; lay < 3; ++lay) {
            const int dd = lay == 0 ? 1 : (lay == 1 ? 4 : 16); const int Tdd = TP / dd;
            bf16_t* VT = (bf16_t*)(p.ws + (lay == 0 ? WS_VT1 : (lay == 1 ? WS_VT4 : WS_VT16))) + (size_t)(b * 8 + h) * 64 * TP;
            const int chunk0 = (t0 / dd) >> 5;
#pragma unroll
            for (int i = 0; i < 8; ++i) {
                const int sidx = tid + 512 * i, g = sidx & 3, d = (sidx >> 2) & 63, rc = sidx >> 8;
                int r, cl; if (lay == 0) { r = 0; cl = rc; } else if (lay == 1) { r = rc & 3; cl = rc >> 2; } else { r = rc; cl = 0; }
                u32 w[4];
#pragma unroll
                for (int hf = 0; hf < 2; ++hf)
#pragma unroll
                    for (int jp = 0; jp < 2; ++jp) {
                        const int u5a = 16 * hf + 4 * g + 2 * jp; const int ta = (32 * cl + u5a) * dd + r, tb = ta + dd;
                        const u32 lo = *(const LAS unsigned short*)(lds + ta * PITCH + d * 2), hi = *(const LAS unsigned short*)(lds + tb * PITCH + d * 2);
                        w[hf * 2 + jp] = lo | (hi << 16);
                    }
                *(uint4*)(VT + (size_t)r * Tdd * 64 + (size_t)(chunk0 + cl) * 2048 + d * 32 + 8 * g) = make_uint4(w[0], w[1], w[2], w[3]);
            }
        }
    }
    __syncthreads();
}

constexpr int CH = 32;
constexpr int SST = 452;
constexpr int SI_W = 0, SI_A = 64, SI_B = 128, SI_K = 192, SI_WR = 256, SI_V = 320, SI_G = 384, SI_SC = 448;
struct PrepRegs { uint2 cr, ck, cv, pr, pk, pv, dw, da, dg; };
__device__ __forceinline__ void scan_item(const Params& p, LAS unsigned char* lds, int tid, bool sample, int b, int h, int half) {
    const bf16_t* PR = (const bf16_t*)(p.ws + WS_PROJRW); const bf16_t* DAG = (const bf16_t*)((const unsigned char*)p.out + SC_B);
    float* YG = (float*)(p.ws + WS_Y);
    LAS float* buf0 = (LAS float*)lds; LAS float* buf1 = buf0 + CH * SST; LAS float* ybuf = buf1 + CH * SST;
    const int T = sample ? TS : TP;
    const int rowB0 = sample ? MP + b * TS : b * TP;
    const int rowA0 = sample ? MP + b * 9 + 1 : b * TP;
    const int nch = (T + CH - 1) / CH;
    const int ptl = tid >> 4, pj = (tid & 15) * 4, pc = h * 64 + pj;
    const int lane = tid & 63, wv = tid >> 6, rg = wv * 4 + (lane >> 4), cgi = lane & 15;
    const int row = 32 * half + rg;
    float st[4];
    if (sample) {
        const float4 a = *(const float4*)(p.in[I_SWKV] + ((size_t)(b * 8 + h) * 64 + row) * 64 + 4 * cgi);
        st[0] = a.x; st[1] = a.y; st[2] = a.z; st[3] = a.w;
    } else {
#pragma unroll
        for (int j = 0; j < 4; ++j) st[j] = 0.f;
    }
    const float4 mur = *(const float4*)(p.in[I_MU] + pc), muk = *(const float4*)(p.in[I_MU] + 512 + pc), muv = *(const float4*)(p.in[I_MU] + 1024 + pc);
    const float4 kk4 = *(const float4*)(p.in[I_KK] + pc), ka4 = *(const float4*)(p.in[I_KA] + pc), rk4 = *(const float4*)(p.in[I_RK] + pc);
    __builtin_amdgcn_s_waitcnt(0x0F70);
    PrepRegs R;
#define SCAN_LOAD(chunk) do { const int t_ = (chunk) * CH + ptl; if (t_ < T) { const size_t ra = (size_t)(rowA0 + t_) * RCOLS + pc; const size_t rb = (size_t)(rowB0 + t_) * NLORA + pc; \
        R.cr = *(const uint2*)(PR + ra); R.ck = *(const uint2*)(PR + ra + 512); R.cv = *(const uint2*)(PR + ra + 1024); \
        if (!sample && t_ == 0) { R.pr = make_uint2(0u, 0u); R.pk = R.pr; R.pv = R.pr; } \
        else { R.pr = *(const uint2*)(PR + ra - RCOLS); R.pk = *(const uint2*)(PR + ra - RCOLS + 512); R.pv = *(const uint2*)(PR + ra - RCOLS + 1024); } \
        R.dw = *(const uint2*)(DAG + rb); R.da = *(const uint2*)(DAG + rb + 512); R.dg = *(const uint2*)(DAG + rb + 1024); } } while (0)
#define SCAN_PREP(chunk, dstbuf) do { const int t_ = (chunk) * CH + ptl; if (t_ < T) { \
        const float mr[4] = {mur.x, mur.y, mur.z, mur.w}, mk[4] = {muk.x, muk.y, muk.z, muk.w}, mv[4] = {muv.x, muv.y, muv.z, muv.w}; \
        const float kkc[4] = {kk4.x, kk4.y, kk4.z, kk4.w}, kac[4] = {ka4.x, ka4.y, ka4.z, ka4.w}, rkc[4] = {rk4.x, rk4.y, rk4.z, rk4.w}; \
        const float crr[4] = {bflo(R.cr.x), bfhi(R.cr.x), bflo(R.cr.y), bfhi(R.cr.y)}, ckk[4] = {bflo(R.ck.x), bfhi(R.ck.x), bflo(R.ck.y), bfhi(R.ck.y)}, cvv[4] = {bflo(R.cv.x), bfhi(R.cv.x), bflo(R.cv.y), bfhi(R.cv.y)}; \
        const float prr[4] = {bflo(R.pr.x), bfhi(R.pr.x), bflo(R.pr.y), bfhi(R.pr.y)}, pkk[4] = {bflo(R.pk.x), bfhi(R.pk.x), bflo(R.pk.y), bfhi(R.pk.y)}, pvv[4] = {bflo(R.pv.x), bfhi(R.pv.x), bflo(R.pv.y), bfhi(R.pv.y)}; \
        const float lw[4] = {bflo(R.dw.x), bfhi(R.dw.x), bflo(R.dw.y), bfhi(R.dw.y)}, aa[4] = {bflo(R.da.x), bfhi(R.da.x), bflo(R.da.y), bfhi(R.da.y)}, gg[4] = {bflo(R.dg.x), bfhi(R.dg.x), bflo(R.dg.y), bfhi(R.dg.y)}; \
        float r_[4], k_[4], v_[4], w_[4], kn[4], k2[4]; float nrm = 0.f; \
        _Pragma("unroll") for (int j = 0; j < 4; ++j) { r_[j] = crr[j] + (prr[j] - crr[j]) * mr[j]; k_[j] = ckk[j] + (pkk[j] - ckk[j]) * mk[j]; v_[j] = cvv[j] + (pvv[j] - cvv[j]) * mv[j]; \
            w_[j] = __expf(lw[j]); kn[j] = k_[j] * kkc[j]; nrm += kn[j] * kn[j]; k2[j] = k_[j] * (1.f + (aa[j] - 1.f) * kac[j]); } \
        nrm = row16_sum(nrm); const float inv = __builtin_amdgcn_rsqf(fmaxf(nrm, 1e-24f)); \
        float br = 0.f, kr = 0.f, rk = 0.f; float an[4], bn[4], wrr[4]; \
        _Pragma("unroll") for (int j = 0; j < 4; ++j) { const float kkn = kn[j] * inv; an[j] = -kkn; bn[j] = kkn * aa[j]; wrr[j] = w_[j] * r_[j]; br += bn[j] * r_[j]; kr += k2[j] * r_[j]; rk += r_[j] * k2[j] * rkc[j]; } \
        br = row16_sum(br); kr = row16_sum(kr); rk = row16_sum(rk); \
        LAS float* rec = (dstbuf) + ptl * SST; \
        *(LAS f32x4*)(rec + SI_W + pj) = (f32x4){w_[0], w_[1], w_[2], w_[3]}; *(LAS f32x4*)(rec + SI_A + pj) = (f32x4){an[0], an[1], an[2], an[3]}; \
        *(LAS f32x4*)(rec + SI_B + pj) = (f32x4){bn[0], bn[1], bn[2], bn[3]}; *(LAS f32x4*)(rec + SI_K + pj) = (f32x4){k2[0], k2[1], k2[2], k2[3]}; \
        *(LAS f32x4*)(rec + SI_WR + pj) = (f32x4){wrr[0], wrr[1], wrr[2], wrr[3]}; *(LAS f32x4*)(rec + SI_V + pj) = (f32x4){v_[0], v_[1], v_[2], v_[3]}; \
        *(LAS f32x4*)(rec + SI_G + pj) = (f32x4){gg[0], gg[1], gg[2], gg[3]}; \
        if ((tid & 15) == 0) *(LAS f32x4*)(rec + SI_SC) = (f32x4){br, kr, rk, 0.f}; } } while (0)

    SCAN_LOAD(0);
    SCAN_PREP(0, buf0);
    __syncthreads();
    for (int c = 0; c < nch; ++c) {
        LAS float* cur = (c & 1) ? buf1 : buf0; LAS float* nxt = (c & 1) ? buf0 : buf1;
        if (c + 1 < nch) SCAN_LOAD(c + 1);
        const int ns = (T - c * CH) < CH ? (T - c * CH) : CH;
        {
            const LAS float* rec = cur;
            f32x4 wA = *(const LAS f32x4*)(rec + SI_W + 4 * cgi), aA = *(const LAS f32x4*)(rec + SI_A + 4 * cgi), bA = *(const LAS f32x4*)(rec + SI_B + 4 * cgi);
            f32x4 kA = *(const LAS f32x4*)(rec + SI_K + 4 * cgi), rA = *(const LAS f32x4*)(rec + SI_WR + 4 * cgi);
            float vA = rec[SI_V + row]; pg8::f32x2 cA = *(const LAS pg8::f32x2*)(rec + SI_SC);
            f32x4 wB, aB, bB, kB, rB; float vB; pg8::f32x2 cB;
#define SCAN_FETCH(W, A, B, K, R, V, C) do { rec += SST; W = *(const LAS f32x4*)(rec + SI_W + 4 * cgi); A = *(const LAS f32x4*)(rec + SI_A + 4 * cgi); B = *(const LAS f32x4*)(rec + SI_B + 4 * cgi); \
            K = *(const LAS f32x4*)(rec + SI_K + 4 * cgi); R = *(const LAS f32x4*)(rec + SI_WR + 4 * cgi); V = rec[SI_V + row]; C = *(const LAS pg8::f32x2*)(rec + SI_SC); } while (0)
#define SCAN_STEP(W, A, B, K, R, V, C, qq) do { \
            float da = mul_(st[0], A[0]); float dw = mul_(st[0], R[0]); \
            da = fma_(st[1], A[1], da); dw = fma_(st[1], R[1], dw); da = fma_(st[2], A[2], da); dw = fma_(st[2], R[2], dw); da = fma_(st[3], A[3], da); dw = fma_(st[3], R[3], dw); \
            float tt_[4]; row16_sum2_mul4(da, dw, tt_, V, K[0], K[1], K[2], K[3]); \
            const float y = fma_(V, C[1], fma_(da, C[0], dw)); \
            _Pragma("unroll") for (int j = 0; j < 4; ++j) st[j] = fma_(st[j], W[j], fma_(da, B[j], tt_[j])); \
            yk = ((qq) == cgi) ? y : yk; } while (0)
            for (int tb = 0; tb < ns; tb += 16) {
                const int nq = (ns - tb) < 16 ? (ns - tb) : 16;
                float yk = 0.f;
                for (int q = 0; q < nq; q += 2) {
                    SCAN_FETCH(wB, aB, bB, kB, rB, vB, cB);
                    SCAN_STEP(wA, aA, bA, kA, rA, vA, cA, q);
                    SCAN_FETCH(wA, aA, bA, kA, rA, vA, cA);
                    SCAN_STEP(wB, aB, bB, kB, rB, vB, cB, q + 1);
                }
                ybuf[(tb + cgi) * 32 + rg] = yk;
            }
#undef SCAN_FETCH
#undef SCAN_STEP
        }
        __syncthreads();
        if (ptl < ns) {
            const pg8::f32x2 y2 = *(const LAS pg8::f32x2*)(ybuf + ptl * 32 + 2 * (tid & 15));
            *(float2*)(YG + (size_t)(rowB0 + c * CH + ptl) * 512 + h * 64 + 32 * half + 2 * (tid & 15)) = make_float2(y2[0], y2[1]);
        }
        if (c + 1 < nch) SCAN_PREP(c + 1, nxt);
        __syncthreads();
    }
#undef SCAN_LOAD
#undef SCAN_PREP
    float* So = p.out + (sample ? O_SWKV : O_PWKV) + ((size_t)(b * 8 + h) * 64 + row) * 64 + 4 * cgi;
    *(float4*)So = make_float4(st[0], st[1], st[2], st[3]);
}

__device__ __forceinline__ void phase_wkvfin(const Params& p, int tid, int G, int bid) {
    const bf16_t* PR = (const bf16_t*)(p.ws + WS_PROJRW); const bf16_t* DAG = (const bf16_t*)((const unsigned char*)p.out + SC_B);
    const float* YG = (const float*)(p.ws + WS_Y); bf16_t* MIX = (bf16_t*)((unsigned char*)p.out + SC_C);
    const int gt = bid * NTHREADS + tid, NT = G * NTHREADS;
    for (int i = gt; i < MB * 128; i += NT) {
        const int jq = i & 15, h = (i >> 4) & 7, rowB = i >> 7, pc = h * 64 + jq * 4, rowA = rowA_of(rowB);
        const size_t ra = (size_t)rowA * RCOLS + pc;
        const uint2 cr = *(const uint2*)(PR + ra), ck = *(const uint2*)(PR + ra + 512), cv = *(const uint2*)(PR + ra + 1024);
        uint2 pr = make_uint2(0u, 0u), pk = pr, pv = pr;
        if (!(rowB < MP && (rowB & (TP - 1)) == 0)) { pr = *(const uint2*)(PR + ra - RCOLS); pk = *(const uint2*)(PR + ra - RCOLS + 512); pv = *(const uint2*)(PR + ra - RCOLS + 1024); }
        const uint2 da = *(const uint2*)(DAG + (size_t)rowB * NLORA + 512 + pc), dg = *(const uint2*)(DAG + (size_t)rowB * NLORA + 1024 + pc);
        const float4 y4 = *(const float4*)(YG + (size_t)rowB * 512 + pc);
        const float4 mur = *(const float4*)(p.in[I_MU] + pc), muk = *(const float4*)(p.in[I_MU] + 512 + pc), muv = *(const float4*)(p.in[I_MU] + 1024 + pc);
        const float4 ka4 = *(const float4*)(p.in[I_KA] + pc), rk4 = *(const float4*)(p.in[I_RK] + pc), lw4 = *(const float4*)(p.in[I_LNW] + pc), lb4 = *(const float4*)(p.in[I_LNB] + pc);
        const float mr[4] = {mur.x, mur.y, mur.z, mur.w}, mk[4] = {muk.x, muk.y, muk.z, muk.w}, mv[4] = {muv.x, muv.y, muv.z, muv.w};
        const float kac[4] = {ka4.x, ka4.y, ka4.z, ka4.w}, rkc[4] = {rk4.x, rk4.y, rk4.z, rk4.w}, lw[4] = {lw4.x, lw4.y, lw4.z, lw4.w}, lb[4] = {lb4.x, lb4.y, lb4.z, lb4.w};
        const float crr[4] = {bflo(cr.x), bfhi(cr.x), bflo(cr.y), bfhi(cr.y)}, ckk[4] = {bflo(ck.x), bfhi(ck.x), bflo(ck.y), bfhi(ck.y)}, cvv[4] = {bflo(cv.x), bfhi(cv.x), bflo(cv.y), bfhi(cv.y)};
        const float prr[4] = {bflo(pr.x), bfhi(pr.x), bflo(pr.y), bfhi(pr.y)}, pkk[4] = {bflo(pk.x), bfhi(pk.x), bflo(pk.y), bfhi(pk.y)}, pvv[4] = {bflo(pv.x), bfhi(pv.x), bflo(pv.y), bfhi(pv.y)};
        const float aa[4] = {bflo(da.x), bfhi(da.x), bflo(da.y), bfhi(da.y)}, gg[4] = {bflo(dg.x), bfhi(dg.x), bflo(dg.y), bfhi(dg.y)};
        const float yy[4] = {y4.x, y4.y, y4.z, y4.w};
        float v_[4]; float rk = 0.f;
#pragma unroll
        for (int j = 0; j < 4; ++j) { const float r_ = crr[j] + (prr[j] - crr[j]) * mr[j], k_ = ckk[j] + (pkk[j] - ckk[j]) * mk[j]; v_[j] = cvv[j] + (pvv[j] - cvv[j]) * mv[j];
            const float k2 = k_ * (1.f + (aa[j] - 1.f) * kac[j]); rk += r_ * k2 * rkc[j]; }
        rk = row16_sum(rk);
        const float mean = row16_sum((yy[0] + yy[1]) + (yy[2] + yy[3])) * (1.f / 64.f);
        float d[4]; float vs = 0.f;
#pragma unroll
        for (int j = 0; j < 4; ++j) { d[j] = yy[j] - mean; vs += d[j] * d[j]; }
        const float rs = rsqrtf(row16_sum(vs) * (1.f / 64.f) + 64e-5f);
        float o[4];
#pragma unroll
        for (int j = 0; j < 4; ++j) o[j] = (d[j] * rs * lw[j] + lb[j] + rk * v_[j]) * gg[j];
        uint2 w; w.x = pk2(o[0], o[1]); w.y = pk2(o[2], o[3]);
        *(uint2*)(MIX + (size_t)rowB * D + pc) = w;
    }
}

__device__ __forceinline__ void attn_task(const Params& p, int task, int lane) {
    const bf16_t* Q = (const bf16_t*)(p.ws + WS_Q); const bf16_t* K = (const bf16_t*)(p.ws + WS_K);
    bf16_t* MIX = (bf16_t*)((unsigned char*)p.out + SC_C);
    const int b = task >> 11, h = (task >> 8) & 7, r16 = (task >> 4) & 15, ig = task & 15;
    const int li = lane & 15, g = lane >> 4;
    const int tq = r16 + 16 * (16 * ig + li);
    const bf16_t* qp = Q + (size_t)(b * TP + tq) * 512 + h * 64 + 8 * g;
    const bf16x8 qf0 = *(const bf16x8*)qp, qf1 = *(const bf16x8*)(qp + 32);
    float m_run = -1e30f, l_run = 0.f;
    f32x4 o[4];
#pragma unroll
    for (int i = 0; i < 4; ++i) o[i] = (f32x4){0.f, 0.f, 0.f, 0.f};
#pragma unroll 1
    for (int br = 0; br < 3; ++br) {
        int dd, r, uq0, Tdd; const bf16_t* VT;
        if (br == 0) { dd = 16; r = r16; uq0 = 16 * ig; Tdd = TP / 16; VT = (const bf16_t*)(p.ws + WS_VT16); }
        else if (br == 1) { dd = 4; r = r16 & 3; uq0 = (r16 >> 2) + 64 * ig; Tdd = TP / 4; VT = (const bf16_t*)(p.ws + WS_VT4); }
        else { dd = 1; r = 0; uq0 = r16 + 256 * ig; Tdd = TP; VT = (const bf16_t*)(p.ws + WS_VT1); }
        const int s = 16 / dd, uq = uq0 + s * li;
        int ulo = uq0 - 128; if (ulo < 0) ulo = 0; ulo &= ~31;
        const int uhi = uq0 + 15 * s;
        const bf16_t* Kb = K + ((size_t)b * TP + r) * 512 + h * 64 + 8 * g;
        const bf16_t* Vb = VT + (size_t)(b * 8 + h) * 64 * TP + (size_t)r * Tdd * 64 + li * 32 + 8 * g;
        bf16x8 kx0, kx1, ky0, ky1, vf[4];
        { const bf16_t* kx = Kb + (size_t)(ulo + li) * dd * 512; const bf16_t* ky = kx + (size_t)16 * dd * 512;
          kx0 = *(const bf16x8*)kx; kx1 = *(const bf16x8*)(kx + 32); ky0 = *(const bf16x8*)ky; ky1 = *(const bf16x8*)(ky + 32);
#pragma unroll
          for (int dt = 0; dt < 4; ++dt) vf[dt] = *(const bf16x8*)(Vb + (size_t)(ulo >> 5) * 2048 + dt * 512); }
#pragma unroll 1
        for (int kt = ulo; kt <= uhi; kt += 32) {
            const int ktn = (kt + 32 <= uhi) ? kt + 32 : kt;
            const bf16_t* nkx = Kb + (size_t)(ktn + li) * dd * 512; const bf16_t* nky = nkx + (size_t)16 * dd * 512;
            const bf16x8 nkx0 = *(const bf16x8*)nkx, nkx1 = *(const bf16x8*)(nkx + 32), nky0 = *(const bf16x8*)nky, nky1 = *(const bf16x8*)(nky + 32);
            bf16x8 nvf[4];
#pragma unroll
            for (int dt = 0; dt < 4; ++dt) nvf[dt] = *(const bf16x8*)(Vb + (size_t)(ktn >> 5) * 2048 + dt * 512);
            f32x4 sx = (f32x4){0.f, 0.f, 0.f, 0.f}, sy = (f32x4){0.f, 0.f, 0.f, 0.f};
            sx = __builtin_amdgcn_mfma_f32_16x16x32_bf16(kx0, qf0, sx, 0, 0, 0); sx = __builtin_amdgcn_mfma_f32_16x16x32_bf16(kx1, qf1, sx, 0, 0, 0);
            sy = __builtin_amdgcn_mfma_f32_16x16x32_bf16(ky0, qf0, sy, 0, 0, 0); sy = __builtin_amdgcn_mfma_f32_16x16x32_bf16(ky1, qf1, sy, 0, 0, 0);
            float sv[8]; bool ok[8]; float tmax = -1e30f;
#pragma unroll
            for (int j = 0; j < 4; ++j) { const int dx = uq - (kt + 4 * g + j), dy = dx - 16;
                ok[j] = (unsigned)dx <= 128u; ok[4 + j] = (unsigned)dy <= 128u; sv[j] = ok[j] ? sx[j] : -1e30f; sv[4 + j] = ok[4 + j] ? sy[j] : -1e30f;
                tmax = fmaxf(tmax, fmaxf(sv[j], sv[4 + j])); }
            tmax = fmaxf(tmax, __shfl_xor(tmax, 16)); tmax = fmaxf(tmax, __shfl_xor(tmax, 32));
            const float m_new = fmaxf(m_run, tmax), alpha = __expf(m_run - m_new);
            float pe[8]; float ps = 0.f;
#pragma unroll
            for (int j = 0; j < 8; ++j) { pe[j] = ok[j] ? __expf(sv[j] - m_new) : 0.f; ps += pe[j]; }
            l_run = l_run * alpha + ps; m_run = m_new;
            u32x4 pw; pw[0] = pk2(pe[0], pe[1]); pw[1] = pk2(pe[2], pe[3]); pw[2] = pk2(pe[4], pe[5]); pw[3] = pk2(pe[6], pe[7]);
            const bf16x8 pf = __builtin_bit_cast(bf16x8, pw);
#pragma unroll
            for (int dt = 0; dt < 4; ++dt) { o[dt] *= alpha; o[dt] = __builtin_amdgcn_mfma_f32_16x16x32_bf16(vf[dt], pf, o[dt], 0, 0, 0); }
            kx0 = nkx0; kx1 = nkx1; ky0 = nky0; ky1 = nky1;
#pragma unroll
            for (int dt = 0; dt < 4; ++dt) vf[dt] = nvf[dt];
        }
    }
    float lt = l_run; lt += __shfl_xor(lt, 16); lt += __shfl_xor(lt, 32);
    const float il = 1.f / lt;
    bf16_t* op = MIX + (size_t)(b * TP + tq) * D + 512 + h * 64 + 4 * g;
#pragma unroll
    for (int dt = 0; dt < 4; ++dt) { uint2 w; w.x = pk2(o[dt][0] * il, o[dt][1] * il); w.y = pk2(o[dt][2] * il, o[dt][3] * il); *(uint2*)(op + 16 * dt) = w; }
}
__device__ __forceinline__ void attn_sample_task(const Params& p, int task, int lane, LAS float* wl) {
    const bf16_t* Q = (const bf16_t*)(p.ws + WS_Q); const float* snewk = (const float*)(p.ws + WS_SNEWK); const float* snewv = (const float*)(p.ws + WS_SNEWV);
    const float* CK = p.in[I_CK]; const float* CV = p.in[I_CV];
    bf16_t* MIX = (bf16_t*)((unsigned char*)p.out + SC_C);
    const int b = task >> 6, h = (task >> 3) & 7, tt = task & 7;
    const int rowB = MP + b * TS + tt;
    asm volatile("s_waitcnt lgkmcnt(0)" ::: "memory");
    wl[lane] = bflo((u32)Q[(size_t)rowB * 512 + h * 64 + lane]);
    asm volatile("s_waitcnt lgkmcnt(0)" ::: "memory");
    float mx = -1e30f;
#pragma unroll 1
    for (int c = 0; c < 9; ++c) {
        const int br = c / 3, it = c - br * 3; const int dd = br == 0 ? 1 : (br == 1 ? 4 : 16); const int j = lane + 64 * it;
        const int jc = j <= 128 ? j : 128;
        const int idx = 2048 + tt - jc * dd;
        const float* kr = idx < 2048 ? CK + ((size_t)(b * 2048 + idx) * 8 + h) * 64 : snewk + (size_t)(b * TS + idx - 2048) * 512 + h * 64;
        float s = 0.f;
#pragma unroll
        for (int d4 = 0; d4 < 16; ++d4) { const float4 kv = *(const float4*)(kr + 4 * d4); const f32x4 qv = *(const LAS f32x4*)(wl + 4 * d4);
            s += kv.x * qv[0] + kv.y * qv[1] + kv.z * qv[2] + kv.w * qv[3]; }
        if (j > 128) s = -1e30f;
        wl[64 + c * 64 + lane] = s; mx = fmaxf(mx, s);
    }
#pragma unroll
    for (int o = 1; o < 64; o <<= 1) mx = fmaxf(mx, __shfl_xor(mx, o));
    asm volatile("s_waitcnt lgkmcnt(0)" ::: "memory");
    float ls = 0.f;
#pragma unroll 1
    for (int c = 0; c < 9; ++c) { const float s = wl[64 + c * 64 + lane]; const float e = s > -1e29f ? __expf(s - mx) : 0.f; wl[64 + c * 64 + lane] = e; ls += e; }
    ls = wave_sum(ls);
    asm volatile("s_waitcnt lgkmcnt(0)" ::: "memory");
    float acc = 0.f;
#pragma unroll 1
    for (int c = 0; c < 9; ++c) {
        const int br = c / 3, it = c - br * 3; const int dd = br == 0 ? 1 : (br == 1 ? 4 : 16); const int nj = it < 2 ? 64 : 1;
#pragma unroll 8
        for (int l2 = 0; l2 < nj; ++l2) {
            const int j = l2 + 64 * it; const int idx = 2048 + tt - j * dd;
            const float* vr = idx < 2048 ? CV + ((size_t)(b * 2048 + idx) * 8 + h) * 64 : snewv + (size_t)(b * TS + idx - 2048) * 512 + h * 64;
            acc += wl[64 + c * 64 + l2] * vr[lane];
        }
    }
    const float res = acc / ls;
    const float other = __shfl_xor(res, 1);
    if ((lane & 1) == 0) *(u32*)(MIX + (size_t)rowB * D + 512 + h * 64 + lane) = pk2(res, other);
}

__device__ __forceinline__ void phase_norm1(const Params& p, int tid, int G, int bid) {
    const int wave = tid >> 6, lane = tid & 63, gw = bid * 8 + wave, NGW = G * 8;
    const bf16_t* mix = (const bf16_t*)((const unsigned char*)p.out + SC_B); bf16_t* H2 = (bf16_t*)((unsigned char*)p.out + SC_C);
    for (int row = gw; row < MB; row += NGW) {
        const float* xrow = row < MP ? p.in[I_XP] + (size_t)row * D : p.in[I_XS] + (size_t)(row - MP) * D;
        const uint2* mr = (const uint2*)(mix + (size_t)row * D) + lane; const float4* xr = (const float4*)xrow + lane;
        float4 v[4], x[4]; float s = 0.f;
#pragma unroll
        for (int j = 0; j < 4; ++j) { const uint2 mm = mr[64 * j]; v[j] = make_float4(bflo(mm.x), bfhi(mm.x), bflo(mm.y), bfhi(mm.y)); x[j] = xr[64 * j]; s += (v[j].x * v[j].x + v[j].y * v[j].y) + (v[j].z * v[j].z + v[j].w * v[j].w); }
        const float rs = rsqrtf(wave_sum(s) * (1.f / D) + 1e-6f);
        float s2 = 0.f;
#pragma unroll
        for (int j = 0; j < 4; ++j) { const float4 gg = *((const float4*)p.in[I_NMPOST] + lane + 64 * j);
            x[j].x += v[j].x * rs * gg.x; x[j].y += v[j].y * rs * gg.y; x[j].z += v[j].z * rs * gg.z; x[j].w += v[j].w * rs * gg.w;
            s2 += (x[j].x * x[j].x + x[j].y * x[j].y) + (x[j].z * x[j].z + x[j].w * x[j].w);
            *((float4*)(p.out + (size_t)row * D) + lane + 64 * j) = x[j]; }
        const float rs2 = rsqrtf(wave_sum(s2) * (1.f / D) + 1e-6f);
#pragma unroll
        for (int j = 0; j < 4; ++j) { const float4 gg = *((const float4*)p.in[I_NFPRE] + lane + 64 * j);
            uint2 o; o.x = pk2(x[j].x * rs2 * gg.x, x[j].y * rs2 * gg.y); o.y = pk2(x[j].z * rs2 * gg.z, x[j].w * rs2 * gg.w);
            *((uint2*)(H2 + (size_t)(row + 2) * D) + lane + 64 * j) = o; }
    }
    for (int row = gw; row < 2 + (H2P_ROWS - MB - 2); row += NGW) {
        const int rr = row < 2 ? row : MB + row;
#pragma unroll
        for (int j = 0; j < 4; ++j) *((uint2*)(H2 + (size_t)rr * D) + lane + 64 * j) = make_uint2(0u, 0u);
    }
}
__device__ __forceinline__ void phase_act(const Params& p, int tid, int G, int bid) {
    const int wave = tid >> 6, lane = tid & 63, gw = bid * 8 + wave, NGW = G * 8;
    bf16_t* U = (bf16_t*)(p.ws + WS_U); const bf16_t* halo = (const bf16_t*)(p.ws + WS_HALO);
    const float* cw = p.in[I_CONVW]; const float* cb = p.in[I_CONVB];
    constexpr int NPI = (MP / 32) * 11, NSI = BS * 11;
    for (int it = gw; it < NPI + NSI; it += NGW) {
        const bool sample = it >= NPI; const int q = sample ? it - NPI : it; const int chunk = q / 11, cgp = q - chunk * 11;
        const int col = cgp * 256 + 4 * lane;
        const float4 wg0 = *(const float4*)(cw + col), wg1 = *(const float4*)(cw + FF2 + col), wg2 = *(const float4*)(cw + 2 * FF2 + col), bg = *(const float4*)(cb + col);
        const float4 wu0 = *(const float4*)(cw + FF + col), wu1 = *(const float4*)(cw + FF2 + FF + col), wu2 = *(const float4*)(cw + 2 * FF2 + FF + col), bu = *(const float4*)(cb + FF + col);
        float g2[4], g1[4], u2[4], u1[4];
        int row0, nrows;
        if (!sample) {
            row0 = chunk * 32; nrows = 32;
            if ((row0 & (TP - 1)) == 0) {
#pragma unroll
                for (int j = 0; j < 4; ++j) { g2[j] = 0.f; g1[j] = 0.f; u2[j] = 0.f; u1[j] = 0.f; }
            } else {
                const bf16_t* hp = halo + (size_t)chunk * 2 * FF2;
                const uint2 a = *(const uint2*)(hp + col), c2 = *(const uint2*)(hp + FF2 + col), e = *(const uint2*)(hp + FF + col), f = *(const uint2*)(hp + FF2 + FF + col);
                g2[0] = bflo(a.x); g2[1] = bfhi(a.x); g2[2] = bflo(a.y); g2[3] = bfhi(a.y); g1[0] = bflo(c2.x); g1[1] = bfhi(c2.x); g1[2] = bflo(c2.y); g1[3] = bfhi(c2.y);
                u2[0] = bflo(e.x); u2[1] = bfhi(e.x); u2[2] = bflo(e.y); u2[3] = bfhi(e.y); u1[0] = bflo(f.x); u1[1] = bfhi(f.x); u1[2] = bflo(f.y); u1[3] = bfhi(f.y);
            }
        } else {
            row0 = MP + chunk * TS; nrows = TS;
            const float* sp = p.in[I_SCONV] + (size_t)chunk * 2 * FF2;
            const float4 a = *(const float4*)(sp + col), c2 = *(const float4*)(sp + FF2 + col), e = *(const float4*)(sp + FF + col), f = *(const float4*)(sp + FF2 + FF + col);
            g2[0] = a.x; g2[1] = a.y; g2[2] = a.z; g2[3] = a.w; g1[0] = c2.x; g1[1] = c2.y; g1[2] = c2.z; g1[3] = c2.w;
            u2[0] = e.x; u2[1] = e.y; u2[2] = e.z; u2[3] = e.w; u1[0] = f.x; u1[1] = f.y; u1[2] = f.z; u1[3] = f.w;
        }
        const float w0g[4] = {wg0.x, wg0.y, wg0.z, wg0.w}, w1g[4] = {wg1.x, wg1.y, wg1.z, wg1.w}, w2g[4] = {wg2.x, wg2.y, wg2.z, wg2.w}, bgg[4] = {bg.x, bg.y, bg.z, bg.w};
        const float w0u[4] = {wu0.x, wu0.y, wu0.z, wu0.w}, w1u[4] = {wu1.x, wu1.y, wu1.z, wu1.w}, w2u[4] = {wu2.x, wu2.y, wu2.z, wu2.w}, buu[4] = {bu.x, bu.y, bu.z, bu.w};
        for (int r0 = 0; r0 < nrows; r0 += 8) {
            uint2 gv[8], uv[8];
#pragma unroll
            for (int i = 0; i < 8; ++i) { const bf16_t* rp = U + (size_t)(row0 + r0 + i) * FF2 + col; gv[i] = *(const uint2*)rp; uv[i] = *(const uint2*)(rp + FF); }
#pragma unroll
            for (int i = 0; i < 8; ++i) {
                const float gc[4] = {bflo(gv[i].x), bfhi(gv[i].x), bflo(gv[i].y), bfhi(gv[i].y)}, uc[4] = {bflo(uv[i].x), bfhi(uv[i].x), bflo(uv[i].y), bfhi(uv[i].y)};
                float o[4];
#pragma unroll
                for (int j = 0; j < 4; ++j) {
                    const float cgv = w0g[j] * g2[j] + w1g[j] * g1[j] + w2g[j] * gc[j] + bgg[j];
                    const float cuv = w0u[j] * u2[j] + w1u[j] * u1[j] + w2u[j] * uc[j] + buu[j];
                    o[j] = cgv * sigmoidf_(cgv) * cuv;
                    g2[j] = g1[j]; g1[j] = gc[j]; u2[j] = u1[j]; u1[j] = uc[j];
                }
                uint2 w; w.x = pk2(o[0], o[1]); w.y = pk2(o[2], o[3]);
                *(uint2*)(U + (size_t)(row0 + r0 + i) * FF2 + col) = w;
            }
        }
    }
}
__device__ __forceinline__ void phase_final(const Params& p, int tid, int G, int bid) {
    const int wave = tid >> 6, lane = tid & 63, gw = bid * 8 + wave, NGW = G * 8;
    const float* F = (const float*)(p.ws + WS_F);
    for (int row = gw; row < MB; row += NGW) {
        const float4* fr = (const float4*)(F + (size_t)row * D) + lane; float4* yr = (float4*)(p.out + (size_t)row * D) + lane;
        float4 v[4]; float s = 0.f;
#pragma unroll
        for (int j = 0; j < 4; ++j) { v[j] = fr[64 * j]; s += (v[j].x * v[j].x + v[j].y * v[j].y) + (v[j].z * v[j].z + v[j].w * v[j].w); }
        const float rs = rsqrtf(wave_sum(s) * (1.f / D) + 1e-6f);
#pragma unroll
        for (int j = 0; j < 4; ++j) { const float4 gg = *((const float4*)p.in[I_NFPOST] + lane + 64 * j); float4 x = yr[64 * j];
            x.x += v[j].x * rs * gg.x; x.y += v[j].y * rs * gg.y; x.z += v[j].z * rs * gg.z; x.w += v[j].w * rs * gg.w; yr[64 * j] = x; }
    }
}
__device__ __forceinline__ void phase_cachecopy(const Params& p, int tid, int G, int bid) {
    if (bid < 4) return;
    const int gt = (bid - 4) * NTHREADS + tid, NT = (G - 4) * NTHREADS;
    constexpr int PER_B = 2048 * 512 / 4;
    const float4* snk = (const float4*)(p.ws + WS_SNEWK); const float4* snv = (const float4*)(p.ws + WS_SNEWV);
    for (int i = gt; i < 2 * BS * PER_B; i += NT) {
        const int which = i >= BS * PER_B; const int q = which ? i - BS * PER_B : i; const int b = q / PER_B, r = q - b * PER_B;
        const float4* src = (const float4*)p.in[which ? I_CV : I_CK] + (size_t)b * PER_B;
        float4 v;
        if (r < 2040 * 128) v = src[r + 8 * 128]; else v = (which ? snv : snk)[(size_t)b * TS * 128 + (r - 2040 * 128)];
        ((float4*)(p.out + (which ? O_SV : O_SK)))[(size_t)b * PER_B + r] = v;
    }
}

template <int PH>
__device__ __forceinline__ void run_phase(const Params& p, LAS unsigned char* lds, int tid, int G, int bid) {
    if constexpr (PH == 0) { phase0(p, lds, tid, G, bid); __syncthreads(); }
    else if constexpr (PH == 1) {
        pg8::Gemm g{(const bf16_t*)((const unsigned char*)p.out + SC_B), (const bf16_t*)(p.ws + WS_WIN), MA, DIN, D, D, 256}; pg8::StaticOrder S; S.init(MA, DIN, G, bid);
        EpiProj E{(bf16_t*)(p.ws + WS_PROJRW), (bf16_t*)(p.ws + WS_Q), (bf16_t*)(p.ws + WS_K), (bf16_t*)(p.ws + WS_VROW), (bf16_t*)(p.ws + WS_VT4), (bf16_t*)(p.ws + WS_VT16),
                  (const float*)(p.ws + WS_ROPE), p.out, (float*)(p.ws + WS_SNEWK), (float*)(p.ws + WS_SNEWV)};
        pg8::gemm_phase<EpiProj, pg8::StaticOrder, false>(lds, g, S, E, nullptr);
    } else if constexpr (PH == 2) { phase_alora(p, tid, G, bid); phase_vtrans(p, lds, tid, G, bid); }
    else if constexpr (PH == 3) {
        pg8::Gemm g{(const bf16_t*)(p.ws + WS_ALORA), (const bf16_t*)(p.ws + WS_WLORA), MB, NLORA, KLORA, KLORA, 256}; pg8::StaticOrder S; S.init(MB, NLORA, G, bid);
        EpiDag E{(bf16_t*)((unsigned char*)p.out + SC_B), p.in[I_W0], p.in[I_A0]};
        pg8::gemm_phase<EpiDag, pg8::StaticOrder, false>(lds, g, S, E, nullptr);
    } else if constexpr (PH == 4 || PH == 11 || PH == 12) {
        const int NSCAN = 128;
        if (bid < NSCAN) {
            if constexpr (PH != 12) {
                scan_item(p, lds, tid, false, bid >> 4, (bid >> 1) & 7, bid & 1);
            }
        } else {
            if constexpr (PH != 12) for (int it = bid - NSCAN; it < 512; it += G - NSCAN) scan_item(p, lds, tid, true, it >> 4, (it >> 1) & 7, it & 1);
        }
        if (PH == 4 || (PH == 12 && bid >= NSCAN)) {
            const int wave = tid >> 6, lane = tid & 63, x = bid & 7;
            unsigned* ctr = (unsigned*)(p.ws + WS_BAR) + (PH == 4 ? 16 : 32) + x;
            for (;;) {
                unsigned id = 0; if (lane == 0) id = __hip_atomic_fetch_add(ctr, 1u, __ATOMIC_RELAXED, __HIP_MEMORY_SCOPE_AGENT);
                id = (unsigned)__builtin_amdgcn_readfirstlane((int)id);
                if (id >= 2048u + 256u) break;
                if (id < 2048u) { const int ig = id >> 7, hh = (id >> 4) & 7, r16 = id & 15; attn_task(p, (x << 11) | (hh << 8) | (r16 << 4) | ig, lane); }
                else { const int s = id - 2048; attn_sample_task(p, ((4 * x + (s >> 6)) << 6) | (s & 63), lane, (LAS float*)(lds + wave * 4096)); }
            }
        }
    } else if constexpr (PH == 5) {
        pg8::Gemm g{(const bf16_t*)((const unsigned char*)p.out + SC_C), (const bf16_t*)(p.ws + WS_WOUT), MB, D, D, D, 256}; pg8::StaticOrder S; S.init(MB, D, G, bid);
        EpiBf16S E{(bf16_t*)((unsigned char*)p.out + SC_B), D};
        pg8::gemm_phase<EpiBf16S, pg8::StaticOrder, false>(lds, g, S, E, nullptr);
    } else if constexpr (PH == 6) phase_norm1(p, tid, G, bid);
    else if constexpr (PH == 7) {
        pg8::Gemm g{(const bf16_t*)((const unsigned char*)p.out + SC_C), (const bf16_t*)(p.ws + WS_WUP), UP_TILES * 256, FF2, D, D, UP_STEP}; pg8::StaticOrder S; S.init(UP_TILES * 256, FF2, G, bid);
        EpiUpAct E{(bf16_t*)(p.ws + WS_U), p.out, p.in[I_CONVW], p.in[I_CONVB], p.in[I_SCONV], (LAS float*)(lds + 131072)};
        pg8::gemm_phase<EpiUpAct, pg8::StaticOrder, false>(lds, g, S, E, nullptr);
    } else if constexpr (PH == 8) phase_act(p, tid, G, bid);
    else if constexpr (PH == 9) {
        pg8::Gemm g{(const bf16_t*)(p.ws + WS_U), (const bf16_t*)(p.ws + WS_WDN), MB, D, FF, FF, 256}; pg8::StaticOrder S; S.init(MB, D, G, bid);
        pg8::EpiF32 E{(float*)(p.ws + WS_F), D, nullptr};
        pg8::gemm_phase<pg8::EpiF32, pg8::StaticOrder, false>(lds, g, S, E, nullptr);
        phase_cachecopy(p, tid, G, bid);
    } else if constexpr (PH == 10) { phase_final(p, tid, G, bid); }
    else if constexpr (PH == 13) phase_wkvfin(p, tid, G, bid);
}
__device__ __forceinline__ void grid_bar(unsigned* ctr, unsigned target) {
    asm volatile("s_waitcnt vmcnt(0)" ::: "memory");
    __syncthreads();
    if (threadIdx.x == 0) {
        __builtin_amdgcn_fence(__ATOMIC_RELEASE, "agent");
        asm volatile("s_waitcnt vmcnt(0)" ::: "memory");
        __hip_atomic_fetch_add(ctr, 1u, __ATOMIC_RELAXED, __HIP_MEMORY_SCOPE_AGENT);
        while (__hip_atomic_load(ctr, __ATOMIC_RELAXED, __HIP_MEMORY_SCOPE_AGENT) < target) __builtin_amdgcn_s_sleep(2);
        __builtin_amdgcn_fence(__ATOMIC_ACQUIRE, "agent");
        asm volatile("s_waitcnt vmcnt(0)" ::: "memory");
    }
    __syncthreads();
}
template <int SEAM, int FIRST, int... REST>
__device__ __forceinline__ void run_program(const Params& p, LAS unsigned char* lds, cg::grid_group& grid, int tid, int G, int bid) {
    if (p.en > (int)sizeof...(REST) - 1000) run_phase<FIRST>(p, lds, tid, G, bid);
    if constexpr (sizeof...(REST) > 0) {
        if constexpr (SEAM == 0) grid.sync(); else grid_bar((unsigned*)(p.ws + WS_BAR), (unsigned)(SEAM * G));
        run_program<SEAM + 1, REST...>(p, lds, grid, tid, G, bid);
    }
}
#define PROGRAM 0, 1, 2, 3, 4, 13, 5, 6, 7, 9, 10
__global__ void __launch_bounds__(NTHREADS, 2) hymba_fwd(Params p) {
    extern __shared__ __attribute__((aligned(16))) unsigned char lds_raw[];
    LAS unsigned char* lds = (LAS unsigned char*)lds_raw;
    cg::grid_group grid = cg::this_grid();
    run_program<0, PROGRAM>(p, lds, grid, threadIdx.x, gridDim.x, blockIdx.x);
}

extern "C" void kernel_launch(void* const* d_in, const int* in_sizes, int n_in, void* d_out, int out_size, void* d_ws, size_t ws_size, hipStream_t stream) {
    static int grid = 0;
    if (grid == 0) {
        if (n_in != 28 || (size_t)out_size != O_END || ws_size < WS_TOTAL) { fprintf(stderr, "kernel_launch: unexpected sizes n_in %d out %d ws %zu (need %zu)\n", n_in, out_size, ws_size, (size_t)WS_TOTAL); grid = -1; return; }
        int dev = 0, cus = 0, per_cu = 0;
        hipGetDevice(&dev); hipDeviceGetAttribute(&cus, hipDeviceAttributeMultiprocessorCount, dev);
        if (hipFuncSetAttribute((const void*)hymba_fwd, hipFuncAttributeMaxDynamicSharedMemorySize, LDS_BYTES) != hipSuccess) { fprintf(stderr, "kernel_launch: hipFuncSetAttribute failed\n"); grid = -1; return; }
        hipOccupancyMaxActiveBlocksPerMultiprocessor(&per_cu, (const void*)hymba_fwd, NTHREADS, LDS_BYTES);
        (void)hipGetLastError();
        if (per_cu < 1) per_cu = 1;
        grid = cus;
    }
    if (grid < 0) return;
    Params p{};
    for (int i = 0; i < 28; ++i) p.in[i] = (const float*)d_in[i];
    p.out = (float*)d_out; p.ws = (unsigned char*)d_ws; p.en = 1;
    if (hipMemsetAsync((unsigned char*)d_ws + WS_BAR, 0, 256, stream) != hipSuccess) { fprintf(stderr, "kernel_launch: memset of the barrier word failed\n"); return; }
    void* args[] = {&p};
    hipError_t e = hipLaunchCooperativeKernel((const void*)hymba_fwd, dim3(grid), dim3(NTHREADS), args, LDS_BYTES, stream);
    if (e != hipSuccess) fprintf(stderr, "cooperative launch failed: %s (grid %d)\n", hipGetErrorString(e), grid);
}
```

```cpp
#include <hip/hip_runtime.h>
#include <hip/hip_cooperative_groups.h>
#include <cstdio>
#include <cstdint>
namespace pg8 {
#define PG8_LAS __attribute__((address_space(3)))
typedef unsigned short bf16_t;
typedef short bf16x8 __attribute__((ext_vector_type(8)));
typedef float f32x4 __attribute__((ext_vector_type(4)));
typedef unsigned u32x4 __attribute__((ext_vector_type(4)));
constexpr int BM = 256, BK = 64, HALF = 128, HTB = HALF * BK * 2  , STAGE_BYTES = 8 * HTB, NXCD = 8, WGM = 8;

__host__ __device__ __forceinline__ int lds_byte(int r, int c) { const int st = (r >> 4) * 2 + (c >> 5), rr = r & 15, cc = c & 31, ob = rr * 64 + cc * 2; return st * 1024 + (ob ^ (((ob >> 9) & 1) << 5)); }
__host__ __device__ __forceinline__ void stage_rc(int b, int& R, int& C) { const int st = b / 1024, sb = b % 1024, swz = sb ^ (((sb >> 9) & 1) << 5); R = (st >> 1) * 16 + swz / 64; C = (st & 1) * 32 + (swz % 64) / 2; }
__host__ __device__ __forceinline__ int perm32(int rho) { const int n = rho >> 4, i = rho & 15; return 8 * (i >> 2) + 4 * n + (i & 3); }

struct Unit { int pm, pn; };
struct Gemm { const bf16_t* A; const bf16_t* Bt; int M, N, K, lda, tile_rows; };

struct StaticOrder {
    int nM, nN, nwg, G, c;
    __host__ __device__ void init(int M, int N, int G_, int c_) { nM = M / BM; nN = N / BM; nwg = nM * nN; G = G_; c = c_; }
    __host__ __device__ bool next(int i, Unit& u) const {
        const long L = (long)i * G + c; if (L >= nwg) return false;
        int wgid = (int)L; { const int q = nwg / NXCD, r = nwg % NXCD, xcd = wgid % NXCD, off = wgid / NXCD; wgid = (xcd < r ? xcd * (q + 1) : r * (q + 1) + (xcd - r) * q) + off; }
        const int nig = WGM * nN, gid = wgid / nig, fm = gid * WGM, gsz = (nM - fm) < WGM ? (nM - fm) : WGM;
        u.pm = fm + ((wgid % nig) % gsz); u.pn = (wgid % nig) / gsz; return true;
    }
    __device__ __forceinline__ void a_ready(const Unit&) const {}
    __device__ __forceinline__ void done(const Unit&) const {}
};
__device__ __forceinline__ unsigned cvt_pk_bf16(float lo, float hi) { unsigned r; asm volatile("v_cvt_pk_bf16_f32 %0, %1, %2" : "=v"(r) : "v"(lo), "v"(hi)); return r; }
typedef float f32x2 __attribute__((ext_vector_type(2)));
struct EpiF32 {
    static constexpr bool PERM = false, AFTER_DRAIN = false;
    float* C; int ldc; const float* bias;
    __device__ __forceinline__ void operator()(const f32x4 (&acc)[2][2][4][2], const Unit& u, int wr, int wc, int fr, int fq) const {
        const int row0 = u.pm * BM + wr * 64 + fr, col0 = u.pn * BM + wc * 32 + 4 * fq;
        f32x4 bv[2][2];
#pragma unroll
        for (int bj = 0; bj < 2; ++bj)
#pragma unroll
            for (int n = 0; n < 2; ++n) bv[bj][n] = bias ? *(const f32x4*)(bias + col0 + bj * HALF + n * 16) : (f32x4){0.f, 0.f, 0.f, 0.f};
#pragma unroll
        for (int ai = 0; ai < 2; ++ai)
#pragma unroll
            for (int m = 0; m < 4; ++m) { float* rowp = C + (size_t)(row0 + ai * HALF + m * 16) * ldc + col0;
#pragma unroll
                for (int bj = 0; bj < 2; ++bj)
#pragma unroll
                    for (int n = 0; n < 2; ++n) *(f32x4*)(rowp + bj * HALF + n * 16) = acc[ai][bj][m][n] + bv[bj][n]; }
    }
};
template <class Epi, class Sched, bool STAMP = false>
__device__ __forceinline__ void gemm_phase(PG8_LAS unsigned char* lds, const Gemm g, const Sched& S, const Epi& E, unsigned long long* stamps) {
    const int tid = threadIdx.x, wid = __builtin_amdgcn_readfirstlane(tid >> 6), lane = tid & 63, wr = wid >> 2, wc = wid & 3, fr = lane & 15, fq = lane >> 4;
    const int K = g.K, nt = K / BK;
    int ts_lo = 0, ts_hi = 0, nts = 0; const unsigned long long rt_entry = STAMP ? (unsigned long long)wall_clock64() : 0ull;
#define PG8_STAMP() do { if (STAMP && wid == 0 && nts < 64) { const unsigned long long _c = (unsigned long long)clock64(); \
        ts_lo = (lane == nts) ? (int)(unsigned)_c : ts_lo; ts_hi = (lane == nts) ? (int)(unsigned)(_c >> 32) : ts_hi; ++nts; } } while (0)
    PG8_STAMP();
    unsigned voffA[2], voffB[2];
#pragma unroll
    for (int i = 0; i < 2; ++i) { int R, C; stage_rc(tid * 16 + i * 8192, R, C); const int Rb = Epi::PERM ? ((R & ~31) + perm32(R & 31)) : R;
        voffA[i] = (unsigned)(R * g.lda + C) * 2u; voffB[i] = (unsigned)(Rb * K + C) * 2u; }
    const size_t kstep = (size_t)(BK * 2);
    const size_t hstep = (size_t)HALF * K * 2, hstepA = (size_t)HALF * g.lda * 2;
    const size_t tstep = 2 * hstep, tstepA = (size_t)g.tile_rows * g.lda * 2;
    const unsigned ldsw = (unsigned)wid * 1024u;
    const int aoff = lds_byte(wr * 64 + fr, fq * 8), boff = lds_byte(wc * 32 + fr, fq * 8);
#define PG8_SA(b, h) (((b) * 2 + (h)) * HTB)
#define PG8_SB(b, h) ((4 + (b) * 2 + (h)) * HTB)
#define PG8_STAGE(bufoff, gbase, voff) do { _Pragma("unroll") for (int _i = 0; _i < 2; ++_i) \
        __builtin_amdgcn_global_load_lds((const unsigned*)((const char*)(gbase) + (voff)[_i]), (PG8_LAS unsigned*)(lds + (bufoff) + ldsw + _i * 8192), 16, 0, 0); } while (0)
#define PG8_LDA(dst, b, h) do { _Pragma("unroll") for (int m = 0; m < 4; ++m) _Pragma("unroll") for (int k = 0; k < 2; ++k) dst[m][k] = *(const PG8_LAS bf16x8*)(lds + PG8_SA(b, h) + aoff + m * 2048 + k * 1024); } while (0)
#define PG8_LDB(dst, b, h) do { _Pragma("unroll") for (int n = 0; n < 2; ++n) _Pragma("unroll") for (int k = 0; k < 2; ++k) dst[n][k] = *(const PG8_LAS bf16x8*)(lds + PG8_SB(b, h) + boff + n * 2048 + k * 1024); } while (0)
#define PG8_MMA(ai, bj, At, Bt) do { __builtin_amdgcn_s_setprio(1); _Pragma("unroll") for (int m = 0; m < 4; ++m) _Pragma("unroll") for (int n = 0; n < 2; ++n) _Pragma("unroll") for (int k = 0; k < 2; ++k) \
        acc[ai][bj][m][n] = __builtin_amdgcn_mfma_f32_16x16x32_bf16(Bt[n][k], At[m][k], acc[ai][bj][m][n], 0, 0, 0); __builtin_amdgcn_s_setprio(0); } while (0)
#define PG8_WAIT_V(n) asm volatile("s_waitcnt vmcnt(" #n ")" ::: "memory")
#define PG8_WAIT_L(n) asm volatile("s_waitcnt lgkmcnt(" #n ")" ::: "memory")
#define PG8_BAR __builtin_amdgcn_s_barrier()
#define PG8_SCHED __builtin_amdgcn_sched_barrier(0)
    Unit cur, nxt; int ui = 0;
    if (!S.next(0, cur)) return;
    f32x4 acc[2][2][4][2];
#pragma unroll
    for (int a = 0; a < 2; ++a)
#pragma unroll
        for (int b = 0; b < 2; ++b)
#pragma unroll
            for (int m = 0; m < 4; ++m)
#pragma unroll
                for (int n = 0; n < 2; ++n) acc[a][b][m][n] = (f32x4){0.f, 0.f, 0.f, 0.f};
    bf16x8 At[4][2], B0[2][2], B1[2][2];
    const char* cA = (const char*)g.A + (size_t)cur.pm * tstepA; const char* cB = (const char*)g.Bt + (size_t)cur.pn * tstep;
    S.a_ready(cur);
    PG8_STAGE(PG8_SB(0, 0), cB, voffB); PG8_STAGE(PG8_SA(0, 0), cA, voffA); PG8_STAGE(PG8_SB(0, 1), cB + hstep, voffB); PG8_STAGE(PG8_SA(0, 1), cA + hstepA, voffA);
    if (wr == 1) PG8_BAR;
    PG8_WAIT_V(4); PG8_BAR;
    PG8_STAGE(PG8_SB(1, 0), cB + kstep, voffB); PG8_STAGE(PG8_SA(1, 0), cA + kstep, voffA); PG8_STAGE(PG8_SB(1, 1), cB + hstep + kstep, voffB);
    PG8_WAIT_V(6); PG8_BAR;
    PG8_STAMP();
    for (;;) {
        const bool has_next = S.next(ui + 1, nxt);
        const char* nA = has_next ? (const char*)g.A + (size_t)nxt.pm * tstepA : cA; const char* nB = has_next ? (const char*)g.Bt + (size_t)nxt.pn * tstep : cB;
        for (int t = 0; t < nt; t += 2) {
            const bool last = (t == nt - 2);
            const char* a1 = cA + (size_t)(t + 1) * kstep;
            const char* a2 = last ? nA : cA + (size_t)(t + 2) * kstep; const char* b2 = last ? nB : cB + (size_t)(t + 2) * kstep;
            const char* a3 = a2 + kstep; const char* b3 = b2 + kstep;
            if (last && has_next) S.a_ready(nxt);
            PG8_LDB(B0, 0, 0); PG8_SCHED; PG8_LDA(At, 0, 0); PG8_STAGE(PG8_SA(1, 1), a1 + hstepA, voffA);
            PG8_WAIT_L(8); PG8_BAR; PG8_WAIT_L(0); PG8_MMA(0, 0, At, B0); PG8_BAR; PG8_SCHED;
            PG8_LDB(B1, 0, 1); PG8_STAGE(PG8_SB(0, 0), b2, voffB);
            PG8_BAR; PG8_WAIT_L(0); PG8_MMA(0, 1, At, B1); PG8_BAR;
            PG8_LDA(At, 0, 1); PG8_STAGE(PG8_SA(0, 0), a2, voffA);
            PG8_BAR; PG8_WAIT_L(0); PG8_MMA(1, 0, At, B0); PG8_BAR; PG8_SCHED;
            PG8_STAGE(PG8_SB(0, 1), b2 + hstep, voffB);
            PG8_WAIT_V(6); PG8_BAR; PG8_MMA(1, 1, At, B1); PG8_BAR;
            PG8_LDB(B0, 1, 0); PG8_SCHED; PG8_LDA(At, 1, 0); PG8_STAGE(PG8_SA(0, 1), a2 + hstepA, voffA);
            PG8_WAIT_L(8); PG8_BAR; PG8_WAIT_L(0); PG8_MMA(0, 0, At, B0); PG8_BAR; PG8_SCHED;
            PG8_LDB(B1, 1, 1); PG8_STAGE(PG8_SB(1, 0), b3, voffB);
            PG8_BAR; PG8_WAIT_L(0); PG8_MMA(0, 1, At, B1); PG8_BAR;
            PG8_LDA(At, 1, 1); PG8_STAGE(PG8_SA(1, 0), a3, voffA);
            PG8_BAR; PG8_WAIT_L(0); PG8_MMA(1, 0, At, B0); PG8_BAR; PG8_SCHED;
            PG8_STAGE(PG8_SB(1, 1), b3 + hstep, voffB);
            PG8_WAIT_V(6); PG8_BAR; PG8_MMA(1, 1, At, B1); PG8_BAR;
        }
        PG8_STAMP();
        if constexpr (!Epi::AFTER_DRAIN) { E(acc, cur, wr, wc, fr, fq); S.done(cur); }
        PG8_STAMP();
        if (!has_next) break;
#pragma unroll
        for (int a = 0; a < 2; ++a)
#pragma unroll
            for (int b = 0; b < 2; ++b)
#pragma unroll
                for (int m = 0; m < 4; ++m)
#pragma unroll
                    for (int n = 0; n < 2; ++n) acc[a][b][m][n] = (f32x4){0.f, 0.f, 0.f, 0.f};
        cur = nxt; cA = nA; cB = nB; ++ui;
    }
    PG8_WAIT_V(0);
    if (wr == 0) PG8_BAR;
    PG8_BAR;
    if constexpr (Epi::AFTER_DRAIN) { E.fused(acc, cur, wr, wc, fr, fq, lds, wid, lane); S.done(cur); }
    PG8_STAMP();
    if (STAMP && wid == 0) { stamps[lane] = lane < nts ? (((unsigned long long)(unsigned)ts_hi << 32) | (unsigned)ts_lo) : 0ull;
        if (lane == 62) stamps[62] = rt_entry; if (lane == 63) stamps[63] = (unsigned long long)wall_clock64(); }
#undef PG8_STAMP
#undef PG8_SA
#undef PG8_SB
#undef PG8_STAGE
#undef PG8_LDA
#undef PG8_LDB
#undef PG8_MMA
#undef PG8_WAIT_V
#undef PG8_WAIT_L
#undef PG8_BAR
#undef PG8_SCHED
}
}

namespace cg = cooperative_groups;
#define LAS __attribute__((address_space(3)))
typedef unsigned short bf16_t;
typedef unsigned int u32;
typedef pg8::bf16x8 bf16x8;
typedef pg8::f32x4 f32x4;
typedef pg8::u32x4 u32x4;

constexpr int D = 1024, TP = 4096, BP = 8, MP = BP * TP, BS = 32, TS = 8, MS = BS * TS;
constexpr int MB = MP + MS;
constexpr int MA = 33280;
constexpr int MA_REAL = MP + BS * 9;
constexpr int DIN = 3328, RCOLS = 1792, FF = 2816, FF2 = 5632, NLORA = 1536, KLORA = 256;
constexpr int NTHREADS = 512;
constexpr int UP_TILES = 131, UP_STEP = 254, H2P_ROWS = (UP_TILES - 1) * UP_STEP + 256;
constexpr int LDS_BYTES = 144 * 1024;

constexpr size_t O_YP = 0;
constexpr size_t O_YS = O_YP + (size_t)MP * D;
constexpr size_t O_PSH = O_YS + (size_t)MS * D;
constexpr size_t O_PWKV = O_PSH + (size_t)BP * D;
constexpr size_t O_PK = O_PWKV + (size_t)BP * 8 * 64 * 64;
constexpr size_t O_PV = O_PK + (size_t)BP * 2048 * 512;
constexpr size_t O_PCONV = O_PV + (size_t)BP * 2048 * 512;
constexpr size_t O_SSH = O_PCONV + (size_t)BP * 2 * FF2;
constexpr size_t O_SWKV = O_SSH + (size_t)BS * D;
constexpr size_t O_SK = O_SWKV + (size_t)BS * 8 * 64 * 64;
constexpr size_t O_SV = O_SK + (size_t)BS * 2048 * 512;
constexpr size_t O_SCONV = O_SV + (size_t)BS * 2048 * 512;
constexpr size_t O_END = O_SCONV + (size_t)BS * 2 * FF2;

constexpr size_t al256(size_t x) { return (x + 255) & ~(size_t)255; }
constexpr size_t WS_WIN = 0;
constexpr size_t WS_WOUT = WS_WIN + al256((size_t)DIN * D * 2);
constexpr size_t WS_WUP = WS_WOUT + al256((size_t)D * D * 2);
constexpr size_t WS_WDN = WS_WUP + al256((size_t)FF2 * D * 2);
constexpr size_t WS_WLORA = WS_WDN + al256((size_t)D * FF * 2);
constexpr size_t WS_ROPE = WS_WLORA + al256((size_t)NLORA * KLORA * 2);
constexpr int NPOS = 4104;
constexpr size_t WS_SNEWK = WS_ROPE + al256((size_t)NPOS * 32 * 2 * 4);
constexpr size_t WS_SNEWV = WS_SNEWK + al256((size_t)MS * 512 * 4);
constexpr size_t WS_HALO = WS_SNEWV + al256((size_t)MS * 512 * 4);
constexpr size_t WS_A = WS_HALO + al256((size_t)1025 * 2 * FF2 * 2);
constexpr size_t WS_PROJRW = WS_A;
constexpr size_t WS_Q = WS_PROJRW + al256((size_t)MA * RCOLS * 2);
constexpr size_t WS_K = WS_Q + al256((size_t)MB * 512 * 2);
constexpr size_t WS_VT1 = WS_K + al256((size_t)MB * 512 * 2);
constexpr size_t WS_VT4 = WS_VT1 + al256((size_t)BP * 8 * 64 * TP * 2);
constexpr size_t WS_VT16 = WS_VT4 + al256((size_t)BP * 8 * 64 * TP * 2);
constexpr size_t WS_ALORA = WS_VT16 + al256((size_t)BP * 8 * 64 * TP * 2);
constexpr size_t WS_VROW = WS_ALORA + al256((size_t)MB * KLORA * 2);
constexpr size_t WS_A_EARLY_END = WS_VROW + al256((size_t)MP * 512 * 2);
constexpr size_t WS_U = WS_A;
constexpr size_t WS_F = WS_A + al256((size_t)MB * FF * 2);
static_assert(WS_F + (size_t)MB * D * 4 <= WS_A + al256((size_t)MB * FF2 * 2), "region A late overflow");
constexpr size_t WS_END = WS_A + al256((size_t)MB * FF2 * 2);
static_assert(WS_A_EARLY_END <= WS_END, "region A overflow");
constexpr size_t WS_BAR = WS_END;
constexpr size_t WS_TOTAL = WS_END + 256;
constexpr size_t WS_Y = WS_ALORA;
static_assert(WS_Y + (size_t)MB * 512 * 4 <= WS_END, "Y overflow");
constexpr size_t SC_B = O_SK * 4;
constexpr size_t SC_C = SC_B + al256((size_t)MB * D * 4);
static_assert(SC_C + (size_t)H2P_ROWS * D * 2 <= O_SCONV * 4, "scratch overflow");
static_assert((size_t)MA * D * 2 <= (size_t)MB * D * 4 && (size_t)MB * NLORA * 2 <= (size_t)MB * D * 4, "region B");

struct Params {
    const float* in[28];
    float* out;
    unsigned char* ws;
    int en, pad;
};

enum { I_XP = 0, I_XS, I_SSHIFT, I_SWKV, I_CK, I_CV, I_SCONV, I_NMPRE, I_NMPOST, I_NFPRE, I_NFPOST, I_WIN, I_MU, I_W0, I_WDEC, I_A0, I_WICLR, I_WGATE,
       I_KK, I_KA, I_RK, I_LNW, I_LNB, I_WOUT, I_WUP, I_CONVW, I_CONVB, I_WDN };

__device__ __forceinline__ float bflo(u32 p) { return __uint_as_float(p << 16); }
__device__ __forceinline__ float bfhi(u32 p) { return __uint_as_float(p & 0xffff0000u); }
__device__ __forceinline__ u32 pk2(float a, float b) { return pg8::cvt_pk_bf16(a, b); }
__device__ __forceinline__ float wave_sum(float v) {
#pragma unroll
    for (int o = 1; o < 64; o <<= 1) v += __shfl_xor(v, o);
    return v;
}
template <int N> __device__ __forceinline__ float dpp_ror(float x) {
    return __int_as_float(__builtin_amdgcn_update_dpp(0, __float_as_int(x), 0x120 + N, 0xF, 0xF, false));
}
__device__ __forceinline__ float row16_sum(float x) {
    x += dpp_ror<8>(x); x += dpp_ror<4>(x); x += dpp_ror<2>(x); x += dpp_ror<1>(x);
    return x;
}
__device__ __forceinline__ void row16_sum4(float& a, float& b, float& c, float& d) {
    asm volatile("s_nop 1\n\t"
                 "v_add_f32_dpp %0, %0, %0 row_ror:8 row_mask:0xf bank_mask:0xf\n\t" "v_add_f32_dpp %1, %1, %1 row_ror:8 row_mask:0xf bank_mask:0xf\n\t"
                 "v_add_f32_dpp %2, %2, %2 row_ror:8 row_mask:0xf bank_mask:0xf\n\t" "v_add_f32_dpp %3, %3, %3 row_ror:8 row_mask:0xf bank_mask:0xf\n\t"
                 "v_add_f32_dpp %0, %0, %0 row_ror:4 row_mask:0xf bank_mask:0xf\n\t" "v_add_f32_dpp %1, %1, %1 row_ror:4 row_mask:0xf bank_mask:0xf\n\t"
                 "v_add_f32_dpp %2, %2, %2 row_ror:4 row_mask:0xf bank_mask:0xf\n\t" "v_add_f32_dpp %3, %3, %3 row_ror:4 row_mask:0xf bank_mask:0xf\n\t"
                 "v_add_f32_dpp %0, %0, %0 row_ror:2 row_mask:0xf bank_mask:0xf\n\t" "v_add_f32_dpp %1, %1, %1 row_ror:2 row_mask:0xf bank_mask:0xf\n\t"
                 "v_add_f32_dpp %2, %2, %2 row_ror:2 row_mask:0xf bank_mask:0xf\n\t" "v_add_f32_dpp %3, %3, %3 row_ror:2 row_mask:0xf bank_mask:0xf\n\t"
                 "v_add_f32_dpp %0, %0, %0 row_ror:1 row_mask:0xf bank_mask:0xf\n\t" "v_add_f32_dpp %1, %1, %1 row_ror:1 row_mask:0xf bank_mask:0xf\n\t"
                 "v_add_f32_dpp %2, %2, %2 row_ror:1 row_mask:0xf bank_mask:0xf\n\t" "v_add_f32_dpp %3, %3, %3 row_ror:1 row_mask:0xf bank_mask:0xf\n\t"
                 "s_nop 1"
                 : "+v"(a), "+v"(b), "+v"(c), "+v"(d));
}
__device__ __forceinline__ float fma_(float a, float b, float c) { float d; asm("v_fma_f32 %0, %1, %2, %3" : "=v"(d) : "v"(a), "v"(b), "v"(c)); return d; }
__device__ __forceinline__ float mul_(float a, float b) { float d; asm("v_mul_f32 %0, %1, %2" : "=v"(d) : "v"(a), "v"(b)); return d; }
__device__ __forceinline__ void row16_sum2_mul4(float& a, float& b, float (&t)[4], float v, float k0, float k1, float k2, float k3) {
    asm volatile("v_mul_f32 %2, %6, %7\n\t" "v_mul_f32 %3, %6, %8\n\t"
                 "v_add_f32_dpp %0, %0, %0 row_ror:8 row_mask:0xf bank_mask:0xf\n\t" "v_add_f32_dpp %1, %1, %1 row_ror:8 row_mask:0xf bank_mask:0xf\n\t"
                 "v_mul_f32 %4, %6, %9\n\t"
                 "v_add_f32_dpp %0, %0, %0 row_ror:4 row_mask:0xf bank_mask:0xf\n\t" "v_add_f32_dpp %1, %1, %1 row_ror:4 row_mask:0xf bank_mask:0xf\n\t"
                 "v_mul_f32 %5, %6, %10\n\t"
                 "v_add_f32_dpp %0, %0, %0 row_ror:2 row_mask:0xf bank_mask:0xf\n\t" "v_add_f32_dpp %1, %1, %1 row_ror:2 row_mask:0xf bank_mask:0xf\n\t"
                 "s_nop 0\n\t"
                 "v_add_f32_dpp %0, %0, %0 row_ror:1 row_mask:0xf bank_mask:0xf\n\t" "v_add_f32_dpp %1, %1, %1 row_ror:1 row_mask:0xf bank_mask:0xf"
                 : "+v"(a), "+v"(b), "=&v"(t[0]), "=&v"(t[1]), "=&v"(t[2]), "=&v"(t[3])
                 : "v"(v), "v"(k0), "v"(k1), "v"(k2), "v"(k3));
}
__device__ __forceinline__ void row16_sum2(float& a, float& b) {
    asm volatile("s_nop 1\n\t"
                 "v_add_f32_dpp %0, %0, %0 row_ror:8 row_mask:0xf bank_mask:0xf\n\t" "v_add_f32_dpp %1, %1, %1 row_ror:8 row_mask:0xf bank_mask:0xf\n\t" "s_nop 0\n\t"
                 "v_add_f32_dpp %0, %0, %0 row_ror:4 row_mask:0xf bank_mask:0xf\n\t" "v_add_f32_dpp %1, %1, %1 row_ror:4 row_mask:0xf bank_mask:0xf\n\t" "s_nop 0\n\t"
                 "v_add_f32_dpp %0, %0, %0 row_ror:2 row_mask:0xf bank_mask:0xf\n\t" "v_add_f32_dpp %1, %1, %1 row_ror:2 row_mask:0xf bank_mask:0xf\n\t" "s_nop 0\n\t"
                 "v_add_f32_dpp %0, %0, %0 row_ror:1 row_mask:0xf bank_mask:0xf\n\t" "v_add_f32_dpp %1, %1, %1 row_ror:1 row_mask:0xf bank_mask:0xf\n\t"
                 "s_nop 1"
                 : "+v"(a), "+v"(b));
}
__device__ __forceinline__ float sigmoidf_(float x) { return __builtin_amdgcn_rcpf(1.f + __expf(-x)); }

__device__ __forceinline__ int win_rowmap(int n) {
    if (n < RCOLS || n >= RCOLS + 1024) return n;
    const int base = (n < RCOLS + 512) ? RCOLS : RCOLS + 512, c = n - base, unit = c >> 8, cu = c & 255, hu = cu >> 6, d = cu & 63, e = d & 31, s = d >> 5;
    const int idx = hu * 32 + e, bj = idx >> 6, wc = (idx & 63) >> 4, fq = (idx & 15) >> 2, j = idx & 3;
    return base + unit * 256 + 128 * bj + 32 * wc + 16 * s + 4 * fq + j;
}
__device__ __forceinline__ int wup_rowmap(int c) {
    const int isup = c >= FF ? 1 : 0, cc = c - FF * isup, pn = cc >> 7, e = cc & 127;
    return pn * 256 + 128 * (e >> 6) + 32 * ((e >> 4) & 3) + 16 * isup + 4 * ((e >> 2) & 3) + (e & 3);
}
__device__ __forceinline__ void transpose_item(const float* W, int K, int N, bf16_t* WT, int mode, LAS float* scr, int item, int lane) {
    const int nblk = N / 32, kb = item / nblk, nb = item % nblk, k0 = 64 * kb, n0 = 32 * nb;
#pragma unroll 8
    for (int i = 0; i < 32; ++i) { const int kk = 2 * i + (lane >> 5); scr[kk * 33 + (lane & 31)] = W[(size_t)(k0 + kk) * N + n0 + (lane & 31)]; }
    asm volatile("s_waitcnt lgkmcnt(0)" ::: "memory");
    const int c = lane & 7;
#pragma unroll
    for (int j = 0; j < 4; ++j) { const int n = (lane >> 3) + 8 * j; const LAS float* s = scr + (8 * c) * 33 + n;
        uint4 o; o.x = pk2(s[0 * 33], s[1 * 33]); o.y = pk2(s[2 * 33], s[3 * 33]); o.z = pk2(s[4 * 33], s[5 * 33]); o.w = pk2(s[6 * 33], s[7 * 33]);
        const int row = mode == 1 ? win_rowmap(n0 + n) : (mode == 2 ? wup_rowmap(n0 + n) : (n0 + n));
        *(uint4*)(WT + (size_t)row * K + k0 + 8 * c) = o; }
    asm volatile("s_waitcnt lgkmcnt(0)" ::: "memory");
}
__device__ __forceinline__ void rms_row(const float* xrow, const float* g, bf16_t* orow, float* frow, int lane) {
    const float4* xr = (const float4*)xrow + lane; const float4* gr = (const float4*)g + lane;
    float4 v[4]; float s = 0.f;
#pragma unroll
    for (int j = 0; j < 4; ++j) { v[j] = xr[64 * j]; s += (v[j].x * v[j].x + v[j].y * v[j].y) + (v[j].z * v[j].z + v[j].w * v[j].w); }
    const float rs = rsqrtf(wave_sum(s) * (1.f / D) + 1e-6f);
#pragma unroll
    for (int j = 0; j < 4; ++j) { const float4 gg = gr[64 * j];
        float4 y; y.x = v[j].x * rs * gg.x; y.y = v[j].y * rs * gg.y; y.z = v[j].z * rs * gg.z; y.w = v[j].w * rs * gg.w;
        uint2 o; o.x = pk2(y.x, y.y); o.y = pk2(y.z, y.w);
        *((uint2*)orow + lane + 64 * j) = o;
        if (frow) *((float4*)frow + lane + 64 * j) = y; }
}
__device__ __forceinline__ void phase0(const Params& p, LAS unsigned char* lds, int tid, int G, int bid) {
    const int wave = tid >> 6, lane = tid & 63, gw = bid * 8 + wave, NGW = G * 8;
    LAS float* scr = (LAS float*)(lds + wave * 16384);
    bf16_t* WinT = (bf16_t*)(p.ws + WS_WIN); bf16_t* WoutT = (bf16_t*)(p.ws + WS_WOUT); bf16_t* WupT = (bf16_t*)(p.ws + WS_WUP); bf16_t* WdnT = (bf16_t*)(p.ws + WS_WDN);
    constexpr int I1 = (D / 64) * (DIN / 32), I2 = (D / 64) * (D / 32), I3 = (D / 64) * (FF2 / 32), I4 = (FF / 64) * (D / 32);
    for (int it = gw; it < I1 + I2 + I3 + I4; it += NGW) {
        int r = it;
        if (r < I1) { transpose_item(p.in[I_WIN], D, DIN, WinT, 1, scr, r, lane); continue; } r -= I1;
        if (r < I2) { transpose_item(p.in[I_WOUT], D, D, WoutT, 0, scr, r, lane); continue; } r -= I2;
        if (r < I3) { transpose_item(p.in[I_WUP], D, FF2, WupT, 2, scr, r, lane); continue; } r -= I3;
        transpose_item(p.in[I_WDN], FF, D, WdnT, 0, scr, r, lane);
    }
    const int gt = bid * NTHREADS + tid, NT = G * NTHREADS;
    bf16_t* WL = (bf16_t*)(p.ws + WS_WLORA);
    for (int i = gt; i < NLORA * KLORA; i += NT) {
        const int row = i >> 8, k = i & 255; float v = 0.f;
        if (row < 512) { if (k < 64) v = p.in[I_WDEC][k * 512 + row]; }
        else if (row < 1024) { if (k >= 64 && k < 128) v = p.in[I_WICLR][(k - 64) * 512 + (row - 512)]; }
        else { if (k >= 128) v = p.in[I_WGATE][(k - 128) * 512 + (row - 1024)]; }
        WL[i] = (bf16_t)(pk2(v, 0.f) & 0xffffu);
    }
    float* rope = (float*)(p.ws + WS_ROPE);
    for (int i = gt; i < NPOS * 32; i += NT) {
        const int pi = i >> 5, e = i & 31; const int pos = pi < TP ? pi : 16384 + (pi - TP);
        double inv = 1.0; for (int q = 0; q < e; ++q) inv *= 0.7498942093324558273;
        const float ang = (float)pos * (float)inv;
        const double a = (double)ang; const double kq = rint(a * 0.15915494309189535); double r = a - kq * 6.283185307179586; r -= kq * 2.4492935982947064e-16;
        const double r2 = r * r;
        double sn = 1.0 / 51090942171709440000.0;
        sn = sn * r2 * (-1.0) + 1.0 / 121645100408832000.0;
        sn = -sn * r2 + 1.0 / 355687428096000.0;
        sn = -sn * r2 + 1.0 / 1307674368000.0;
        sn = -sn * r2 + 1.0 / 6227020800.0;
        sn = -sn * r2 + 1.0 / 39916800.0;
        sn = -sn * r2 + 1.0 / 362880.0;
        sn = -sn * r2 + 1.0 / 5040.0;
        sn = -sn * r2 + 1.0 / 120.0;
        sn = -sn * r2 + 1.0 / 6.0;
        sn = -sn * r2 + 1.0;
        sn *= r;
        double cs = 1.0 / 1124000727777607680000.0;
        cs = -cs * r2 + 1.0 / 2432902008176640000.0;
        cs = -cs * r2 + 1.0 / 6402373705728000.0;
        cs = -cs * r2 + 1.0 / 20922789888000.0;
        cs = -cs * r2 + 1.0 / 87178291200.0;
        cs = -cs * r2 + 1.0 / 479001600.0;
        cs = -cs * r2 + 1.0 / 3628800.0;
        cs = -cs * r2 + 1.0 / 40320.0;
        cs = -cs * r2 + 1.0 / 720.0;
        cs = -cs * r2 + 1.0 / 24.0;
        cs = -cs * r2 + 0.5;
        cs = -cs * r2 + 1.0;
        rope[i] = (float)cs; rope[NPOS * 32 + i] = (float)sn;
    }
    bf16_t* H = (bf16_t*)((unsigned char*)p.out + SC_B);
    for (int row = gw; row < MA; row += NGW) {
        bf16_t* orow = H + (size_t)row * D;
        if (row < MP) {
            const bool last = (row & (TP - 1)) == TP - 1;
            rms_row(p.in[I_XP] + (size_t)row * D, p.in[I_NMPRE], orow, last ? p.out + O_PSH + (size_t)(row >> 12) * D : nullptr, lane);
        } else {
            const int s = row - MP;
            if (s < BS * 9) {
                const int b = s / 9, j = s - b * 9;
                if (j == 0) {
                    const float4* sr = (const float4*)(p.in[I_SSHIFT] + (size_t)b * D) + lane;
#pragma unroll
                    for (int q = 0; q < 4; ++q) { const float4 v = sr[64 * q]; uint2 o; o.x = pk2(v.x, v.y); o.y = pk2(v.z, v.w); *((uint2*)orow + lane + 64 * q) = o; }
                } else {
                    rms_row(p.in[I_XS] + (size_t)(b * TS + j - 1) * D, p.in[I_NMPRE], orow, j == TS ? p.out + O_SSH + (size_t)b * D : nullptr, lane);
                }
            } else {
#pragma unroll
                for (int q = 0; q < 4; ++q) *((uint2*)orow + lane + 64 * q) = make_uint2(0u, 0u);
            }
        }
    }
}

struct EpiProj {
    static constexpr bool PERM = false, AFTER_DRAIN = false;
    bf16_t* projrw; bf16_t* Q; bf16_t* K; bf16_t* VT1; bf16_t* VT4; bf16_t* VT16; const float* rope; float* out; float* snewk; float* snewv;
    __device__ __forceinline__ void operator()(const f32x4 (&acc)[2][2][4][2], const pg8::Unit& u, int wr, int wc, int fr, int fq) const {
        const int pn = u.pn;
        if (pn < 7) {
#pragma unroll
            for (int ai = 0; ai < 2; ++ai)
#pragma unroll
                for (int m = 0; m < 4; ++m) { const int row = u.pm * 256 + ai * 128 + wr * 64 + m * 16 + fr;
                    bf16_t* rp = projrw + (size_t)row * RCOLS + pn * 256 + wc * 32 + 4 * fq;
#pragma unroll
                    for (int bj = 0; bj < 2; ++bj)
#pragma unroll
                        for (int n = 0; n < 2; ++n) { const f32x4 v = acc[ai][bj][m][n]; uint2 o; o.x = pk2(v[0], v[1]); o.y = pk2(v[2], v[3]); *(uint2*)(rp + bj * 128 + n * 16) = o; } }
            return;
        }
#pragma unroll
        for (int ai = 0; ai < 2; ++ai)
#pragma unroll
            for (int m = 0; m < 4; ++m) {
                const int row = u.pm * 256 + ai * 128 + wr * 64 + m * 16 + fr;
                bool prompt = row < MP; int b, t, rowB, pi; bool valid = true;
                if (prompt) { b = row >> 12; t = row & (TP - 1); rowB = row; pi = t; }
                else { const int s = row - MP; b = s / 9; const int j = s - b * 9; valid = (s < BS * 9) && (j > 0); t = j - 1; rowB = MP + b * TS + t; pi = TP + t; }
                if (!valid) continue;
                if (pn < 11) {
                    const bool isq = pn < 9; const int unit = isq ? pn - 7 : pn - 9;
#pragma unroll
                    for (int bj = 0; bj < 2; ++bj) {
                        const int idx = bj * 64 + wc * 16 + fq * 4, hu = idx >> 5, e = idx & 31;
                        const float4 cs = *(const float4*)(rope + (size_t)pi * 32 + e), sn = *(const float4*)(rope + (size_t)NPOS * 32 + (size_t)pi * 32 + e);
                        const f32x4 x1 = acc[ai][bj][m][0], x2 = acc[ai][bj][m][1];
                        float o1[4], o2[4];
                        o1[0] = x1[0] * cs.x - x2[0] * sn.x; o2[0] = x1[0] * sn.x + x2[0] * cs.x;
                        o1[1] = x1[1] * cs.y - x2[1] * sn.y; o2[1] = x1[1] * sn.y + x2[1] * cs.y;
                        o1[2] = x1[2] * cs.z - x2[2] * sn.z; o2[2] = x1[2] * sn.z + x2[2] * cs.z;
                        o1[3] = x1[3] * cs.w - x2[3] * sn.w; o2[3] = x1[3] * sn.w + x2[3] * cs.w;
                        const int col = unit * 256 + hu * 64 + e;
                        if (isq) {
                            uint2 a, c2; a.x = pk2(o1[0] * 0.125f, o1[1] * 0.125f); a.y = pk2(o1[2] * 0.125f, o1[3] * 0.125f); c2.x = pk2(o2[0] * 0.125f, o2[1] * 0.125f); c2.y = pk2(o2[2] * 0.125f, o2[3] * 0.125f);
                            *(uint2*)(Q + (size_t)rowB * 512 + col) = a; *(uint2*)(Q + (size_t)rowB * 512 + col + 32) = c2;
                        } else {
                            uint2 a, c2; a.x = pk2(o1[0], o1[1]); a.y = pk2(o1[2], o1[3]); c2.x = pk2(o2[0], o2[1]); c2.y = pk2(o2[2], o2[3]);
                            *(uint2*)(K + (size_t)rowB * 512 + col) = a; *(uint2*)(K + (size_t)rowB * 512 + col + 32) = c2;
                            float* dst = nullptr;
                            if (prompt) { if (t >= 2048) dst = out + O_PK + ((size_t)b * 2048 + (t - 2048)) * 512 + col; }
                            else dst = snewk + (size_t)(b * TS + t) * 512 + col;
                            if (dst) { *(float4*)dst = make_float4(o1[0], o1[1], o1[2], o1[3]); *(float4*)(dst + 32) = make_float4(o2[0], o2[1], o2[2], o2[3]); }
                        }
                    }
                } else {
#pragma unroll
                    for (int bj = 0; bj < 2; ++bj)
#pragma unroll
                        for (int n = 0; n < 2; ++n) {
                            const int col = (pn - 11) * 256 + bj * 128 + wc * 32 + n * 16 + 4 * fq; const f32x4 v = acc[ai][bj][m][n];
                            if (prompt) {
                                if (t >= 2048) *(float4*)(out + O_PV + ((size_t)b * 2048 + (t - 2048)) * 512 + col) = make_float4(v[0], v[1], v[2], v[3]);
                                uint2 o; o.x = pk2(v[0], v[1]); o.y = pk2(v[2], v[3]); *(uint2*)(VT1 + (size_t)rowB * 512 + col) = o;
                            } else {
                                *(float4*)(snewv + (size_t)(b * TS + t) * 512 + col) = make_float4(v[0], v[1], v[2], v[3]);
                            }
                        }
                }
            }
    }
};
struct EpiBf16S {
    static constexpr bool PERM = false, AFTER_DRAIN = false;
    bf16_t* O; int ldc;
    __device__ __forceinline__ void operator()(const f32x4 (&acc)[2][2][4][2], const pg8::Unit& u, int wr, int wc, int fr, int fq) const {
#pragma unroll
        for (int ai = 0; ai < 2; ++ai)
#pragma unroll
            for (int m = 0; m < 4; ++m) { bf16_t* rp = O + (size_t)(u.pm * 256 + ai * 128 + wr * 64 + m * 16 + fr) * ldc + u.pn * 256 + wc * 32 + 4 * fq;
#pragma unroll
                for (int bj = 0; bj < 2; ++bj)
#pragma unroll
                    for (int n = 0; n < 2; ++n) { const f32x4 v = acc[ai][bj][m][n]; uint2 o; o.x = pk2(v[0], v[1]); o.y = pk2(v[2], v[3]); *(uint2*)(rp + bj * 128 + n * 16) = o; } }
    }
};
struct EpiDag {
    static constexpr bool PERM = false, AFTER_DRAIN = false;
    bf16_t* dag; const float* w0; const float* a0;
    __device__ __forceinline__ void operator()(const f32x4 (&acc)[2][2][4][2], const pg8::Unit& u, int wr, int wc, int fr, int fq) const {
        const int kind = u.pn >> 1;
#pragma unroll
        for (int bj = 0; bj < 2; ++bj)
#pragma unroll
            for (int n = 0; n < 2; ++n) {
                const int col = u.pn * 256 + bj * 128 + wc * 32 + n * 16 + 4 * fq;
                float4 bias = make_float4(0.f, 0.f, 0.f, 0.f);
                if (kind == 0) bias = *(const float4*)(w0 + col); else if (kind == 1) bias = *(const float4*)(a0 + col - 512);
                const float bb[4] = {bias.x, bias.y, bias.z, bias.w};
#pragma unroll
                for (int ai = 0; ai < 2; ++ai)
#pragma unroll
                    for (int m = 0; m < 4; ++m) { const int row = u.pm * 256 + ai * 128 + wr * 64 + m * 16 + fr; const f32x4 v = acc[ai][bj][m][n]; float o[4];
#pragma unroll
                        for (int j = 0; j < 4; ++j) { const float x = v[j] + bb[j];
                            if (kind == 0) { const float z = -x; const float sp = fmaxf(z, 0.f) + __logf(1.f + __expf(-fabsf(z))); o[j] = -__expf(-sp - 0.5f); }
                            else if (kind == 1) o[j] = sigmoidf_(x);
                            else o[j] = x; }
                        uint2 q; q.x = pk2(o[0], o[1]); q.y = pk2(o[2], o[3]); *(uint2*)(dag + (size_t)row * NLORA + col) = q; }
            }
    }
};
struct EpiUp {
    static constexpr bool PERM = false, AFTER_DRAIN = false;
    bf16_t* U; bf16_t* halo; float* out;
    __device__ __forceinline__ void operator()(const f32x4 (&acc)[2][2][4][2], const pg8::Unit& u, int wr, int wc, int fr, int fq) const {
#pragma unroll
        for (int ai = 0; ai < 2; ++ai)
#pragma unroll
            for (int m = 0; m < 4; ++m) {
                const int row = u.pm * 256 + ai * 128 + wr * 64 + m * 16 + fr; const int col0 = u.pn * 256 + wc * 32 + 4 * fq;
                bf16_t* hrow = nullptr; float* frow = nullptr;
                if (row < MP) { const int t = row & (TP - 1);
                    if ((t & 31) >= 30) hrow = halo + ((size_t)((row >> 5) + 1) * 2 + ((t & 31) - 30)) * FF2;
                    if (t >= TP - 2) frow = out + O_PCONV + ((size_t)(row >> 12) * 2 + (t - (TP - 2))) * FF2;
                } else { const int s = row - MP, b = s >> 3, tt = s & 7; if (tt >= 6) frow = out + O_SCONV + ((size_t)b * 2 + (tt - 6)) * FF2; }
#pragma unroll
                for (int bj = 0; bj < 2; ++bj)
#pragma unroll
                    for (int n = 0; n < 2; ++n) { const f32x4 v = acc[ai][bj][m][n]; const int col = col0 + bj * 128 + n * 16;
                        uint2 o; o.x = pk2(v[0], v[1]); o.y = pk2(v[2], v[3]);
                        *(uint2*)(U + (size_t)row * FF2 + col) = o;
                        if (hrow) *(uint2*)(hrow + col) = o;
                        if (frow) *(float4*)(frow + col) = make_float4(v[0], v[1], v[2], v[3]); }
            }
    }
};

struct EpiUpAct {
    static constexpr bool PERM = false, AFTER_DRAIN = false;
    bf16_t* ACT; float* out; const float* cw; const float* cb; const float* sconv; LAS float* xch;
    __device__ __forceinline__ void operator()(const f32x4 (&acc)[2][2][4][2], const pg8::Unit& u, int wr, int wc, int fr, int fq) const {
        const int lane = fq * 16 + fr, wid = wr * 4 + wc;
        if (fr >= 14) {
#pragma unroll
            for (int ai = 0; ai < 2; ++ai)
#pragma unroll
                for (int bj = 0; bj < 2; ++bj)
#pragma unroll
                    for (int n = 0; n < 2; ++n) *(LAS f32x4*)(xch + ((wid * 2 + ai) * 2 + (fr - 14)) * 64 + (bj * 2 + n) * 16 + 4 * fq) = acc[ai][bj][3][n];
        }
        asm volatile("s_waitcnt lgkmcnt(0)" ::: "memory");
        __builtin_amdgcn_s_barrier(); __builtin_amdgcn_s_barrier();
        asm volatile("" ::: "memory");
#pragma unroll
        for (int bj = 0; bj < 2; ++bj) {
            const int e = 64 * bj + 16 * wc + 4 * fq, gcol = 128 * u.pn + e, ucol = FF + gcol;
            const float4 wg0 = *(const float4*)(cw + gcol), wg1 = *(const float4*)(cw + FF2 + gcol), wg2 = *(const float4*)(cw + 2 * FF2 + gcol), bg = *(const float4*)(cb + gcol);
            const float4 wu0 = *(const float4*)(cw + ucol), wu1 = *(const float4*)(cw + FF2 + ucol), wu2 = *(const float4*)(cw + 2 * FF2 + ucol), bu = *(const float4*)(cb + ucol);
            const float w0g[4] = {wg0.x, wg0.y, wg0.z, wg0.w}, w1g[4] = {wg1.x, wg1.y, wg1.z, wg1.w}, w2g[4] = {wg2.x, wg2.y, wg2.z, wg2.w}, bgg[4] = {bg.x, bg.y, bg.z, bg.w};
            const float w0u[4] = {wu0.x, wu0.y, wu0.z, wu0.w}, w1u[4] = {wu1.x, wu1.y, wu1.z, wu1.w}, w2u[4] = {wu2.x, wu2.y, wu2.z, wu2.w}, buu[4] = {bu.x, bu.y, bu.z, bu.w};
#pragma unroll
            for (int ai = 0; ai < 2; ++ai) {
                const int swr = wr ^ 1, sai = (wr == 1) ? ai : 0;
                const LAS float* xs = xch + (((swr * 4 + wc) * 2 + sai) * 2) * 64 + (bj * 2) * 16 + 4 * fq;
                f32x4 pg1 = *(const LAS f32x4*)(xs + 64), pg2 = *(const LAS f32x4*)(xs), pu1 = *(const LAS f32x4*)(xs + 64 + 16), pu2 = *(const LAS f32x4*)(xs + 16);
                f32x4 g1p = pg1, g2p = (fr == 1) ? pg1 : pg2, u1p = pu1, u2p = (fr == 1) ? pu1 : pu2;
#pragma unroll
                for (int m = 0; m < 4; ++m) {
                    const int r = 128 * ai + 64 * wr + 16 * m + fr; const int R = UP_STEP * u.pm - 2 + r;
                    const f32x4 gc = acc[ai][bj][m][0], uc = acc[ai][bj][m][1];
                    f32x4 g1r, g2r, u1r, u2r;
#pragma unroll
                    for (int j = 0; j < 4; ++j) { g1r[j] = dpp_ror<1>(gc[j]); g2r[j] = dpp_ror<2>(gc[j]); u1r[j] = dpp_ror<1>(uc[j]); u2r[j] = dpp_ror<2>(uc[j]); }
                    f32x4 g1 = (fr >= 1) ? g1r : g1p, g2 = (fr >= 2) ? g2r : g2p, u1 = (fr >= 1) ? u1r : u1p, u2 = (fr >= 2) ? u2r : u2p;
                    g1p = g1r; g2p = g2r; u1p = u1r; u2p = u2r;
                    const bool emit = (r >= 2) && (R < MB);
                    if (emit) {
                        float* frow = nullptr;
                        if (R < MP) { const int t = R & (TP - 1);
                            if (t == 0) { g1 = (f32x4){0.f, 0.f, 0.f, 0.f}; u1 = g1; }
                            if (t <= 1) { g2 = (f32x4){0.f, 0.f, 0.f, 0.f}; u2 = g2; }
                            if (t >= TP - 2) frow = out + O_PCONV + ((size_t)(R >> 12) * 2 + (t - (TP - 2))) * FF2;
                        } else { const int s = R - MP, b = s >> 3, tt = s & 7; const float* sp = sconv + (size_t)b * 2 * FF2;
                            if (tt == 0) { const float4 a = *(const float4*)(sp + FF2 + gcol), c = *(const float4*)(sp + FF2 + ucol); g1 = (f32x4){a.x, a.y, a.z, a.w}; u1 = (f32x4){c.x, c.y, c.z, c.w}; }
                            if (tt <= 1) { const float4 a = *(const float4*)(sp + (tt == 0 ? 0 : FF2) + gcol), c = *(const float4*)(sp + (tt == 0 ? 0 : FF2) + ucol); g2 = (f32x4){a.x, a.y, a.z, a.w}; u2 = (f32x4){c.x, c.y, c.z, c.w}; }
                            if (tt >= 6) frow = out + O_SCONV + ((size_t)b * 2 + (tt - 6)) * FF2;
                        }
                        float o[4];
#pragma unroll
                        for (int j = 0; j < 4; ++j) { const float cgv = w0g[j] * g2[j] + w1g[j] * g1[j] + w2g[j] * gc[j] + bgg[j], cuv = w0u[j] * u2[j] + w1u[j] * u1[j] + w2u[j] * uc[j] + buu[j];
                            o[j] = cgv * sigmoidf_(cgv) * cuv; }
                        uint2 w; w.x = pk2(o[0], o[1]); w.y = pk2(o[2], o[3]);
                        *(uint2*)(ACT + (size_t)R * FF + gcol) = w;
                        if (frow) { *(float4*)(frow + gcol) = make_float4(gc[0], gc[1], gc[2], gc[3]); *(float4*)(frow + ucol) = make_float4(uc[0], uc[1], uc[2], uc[3]); }
                    }
                }
            }
        }
    }
};

__device__ __forceinline__ int rowA_of(int rowB) { return rowB < MP ? rowB : MP + ((rowB - MP) >> 3) * 9 + 1 + ((rowB - MP) & 7); }
__device__ __forceinline__ void phase_alora(const Params& p, int tid, int G, int bid) {
    const bf16_t* PR = (const bf16_t*)(p.ws + WS_PROJRW); bf16_t* AL = (bf16_t*)(p.ws + WS_ALORA); const float* mu = p.in[I_MU];
    const int gt = bid * NTHREADS + tid, NT = G * NTHREADS;
    for (int i = gt; i < MB * 64; i += NT) {
        const int rowB = i >> 6, c = (i & 63) * 4, rowA = rowA_of(rowB);
        const uint2 cur = *(const uint2*)(PR + (size_t)rowA * RCOLS + 1536 + c);
        uint2 prv = make_uint2(0u, 0u);
        if (!(rowB < MP && (rowB & (TP - 1)) == 0)) prv = *(const uint2*)(PR + (size_t)(rowA - 1) * RCOLS + 1536 + c);
        const float4 m4 = *(const float4*)(mu + 1536 + c);
        float x[4] = {bflo(cur.x), bfhi(cur.x), bflo(cur.y), bfhi(cur.y)}; const float pv[4] = {bflo(prv.x), bfhi(prv.x), bflo(prv.y), bfhi(prv.y)}; const float mm[4] = {m4.x, m4.y, m4.z, m4.w};
#pragma unroll
        for (int j = 0; j < 4; ++j) { float v = x[j] + (pv[j] - x[j]) * mm[j];
            if (c < 64) v = tanhf(v); else if (c >= 128) v = sigmoidf_(v);
            x[j] = v; }
        uint2 o; o.x = pk2(x[0], x[1]); o.y = pk2(x[2], x[3]);
        *(uint2*)(AL + (size_t)rowB * KLORA + c) = o;
    }
}


__device__ __forceinline__ void phase_vtrans(const Params& p, LAS unsigned char* lds, int tid, int G, int bid) {
    const bf16_t* VR = (const bf16_t*)(p.ws + WS_VROW);
    constexpr int PITCH = 132;
    for (int item = bid; item < BP * 8 * 8; item += G) {
        const int b = item >> 6, h = (item >> 3) & 7, t0 = (item & 7) * 512;
        __syncthreads();
#pragma unroll
        for (int i = 0; i < 8; ++i) { const int piece = tid + 512 * i, row = piece >> 3, c8 = piece & 7;
            const uint4 v = *(const uint4*)(VR + (size_t)(b * TP + t0 + row) * 512 + h * 64 + c8 * 8);
            LAS u32* dst = (LAS u32*)(lds + row * PITCH + c8 * 16); dst[0] = v.x; dst[1] = v.y; dst[2] = v.z; dst[3] = v.w; }
        __syncthreads();
#pragma unroll 1
        for (int lay = 0; lay < 3; ++lay) {
            const int dd = lay == 0 ? 1 : (lay == 1 ? 4 : 16); const int Tdd = TP / dd;
            bf16_t* VT = (bf16_t*)(p.ws + (lay == 0 ? WS_VT1 : (lay == 1 ? WS_VT4 : WS_VT16))) + (size_t)(b * 8 + h) * 64 * TP;
            const int chunk0 = (t0 / dd) >> 5;
#pragma unroll
            for (int i = 0; i < 4; ++i) {
                const int sidx = tid + 512 * i, g = sidx & 3, dp = (sidx >> 2) & 31, rc = sidx >> 7;
                int r, cl; if (lay == 0) { r = 0; cl = rc; } else if (lay == 1) { r = rc & 3; cl = rc >> 2; } else { r = rc; cl = 0; }
                u32 wlo[4], whi[4];
#pragma unroll
                for (int hf = 0; hf < 2; ++hf)
#pragma unroll
                    for (int jp = 0; jp < 2; ++jp) {
                        const int u5a = 16 * hf + 4 * g + 2 * jp; const int ta = (32 * cl + u5a) * dd + r, tb = ta + dd;
                        const u32 wa = *(const LAS u32*)(lds + ta * PITCH + dp * 4), wb = *(const LAS u32*)(lds + tb * PITCH + dp * 4);
                        wlo[hf * 2 + jp] = (wa & 0xffffu) | (wb << 16); whi[hf * 2 + jp] = (wa >> 16) | (wb & 0xffff0000u);
                    }
                bf16_t* dst = VT + (size_t)r * Tdd * 64 + (size_t)(chunk0 + cl) * 2048 + (2 * dp) * 32 + 8 * g;
                *(uint4*)dst = make_uint4(wlo[0], wlo[1], wlo[2], wlo[3]); *(uint4*)(dst + 32) = make_uint4(whi[0], whi[1], whi[2], whi[3]);
            }
        }
    }
    __syncthreads();
}

constexpr int CH = 32;
constexpr int SST = 452;
constexpr int SI_W = 0, SI_A = 64, SI_B = 128, SI_K = 192, SI_WR = 256, SI_V = 320, SI_G = 384, SI_SC = 448;
struct PrepRegs { uint2 cr, ck, cv, pr, pk, pv, dw, da, dg; };
__device__ __forceinline__ void scan_item(const Params& p, LAS unsigned char* lds, int tid, bool sample, int b, int h, int half) {
    const bf16_t* PR = (const bf16_t*)(p.ws + WS_PROJRW); const bf16_t* DAG = (const bf16_t*)((const unsigned char*)p.out + SC_B);
    float* YG = (float*)(p.ws + WS_Y);
    LAS float* buf0 = (LAS float*)lds; LAS float* buf1 = buf0 + CH * SST; LAS float* ybuf = buf1 + CH * SST;
    const int T = sample ? TS : TP;
    const int rowB0 = sample ? MP + b * TS : b * TP;
    const int rowA0 = sample ? MP + b * 9 + 1 : b * TP;
    const int nch = (T + CH - 1) / CH;
    const int ptl = tid >> 4, pj = (tid & 15) * 4, pc = h * 64 + pj;
    const int lane = tid & 63, wv = tid >> 6, rg = wv * 4 + (lane >> 4), cgi = lane & 15;
    const int row = 32 * half + rg;
    float st[4];
    if (sample) {
        const float4 a = *(const float4*)(p.in[I_SWKV] + ((size_t)(b * 8 + h) * 64 + row) * 64 + 4 * cgi);
        st[0] = a.x; st[1] = a.y; st[2] = a.z; st[3] = a.w;
    } else {
#pragma unroll
        for (int j = 0; j < 4; ++j) st[j] = 0.f;
    }
    const float4 mur = *(const float4*)(p.in[I_MU] + pc), muk = *(const float4*)(p.in[I_MU] + 512 + pc), muv = *(const float4*)(p.in[I_MU] + 1024 + pc);
    const float4 kk4 = *(const float4*)(p.in[I_KK] + pc), ka4 = *(const float4*)(p.in[I_KA] + pc), rk4 = *(const float4*)(p.in[I_RK] + pc);
    __builtin_amdgcn_s_waitcnt(0x0F70);
    PrepRegs R;
#define SCAN_LOAD(chunk) do { const int t_ = (chunk) * CH + ptl; if (t_ < T) { const size_t ra = (size_t)(rowA0 + t_) * RCOLS + pc; const size_t rb = (size_t)(rowB0 + t_) * NLORA + pc; \
        R.cr = *(const uint2*)(PR + ra); R.ck = *(const uint2*)(PR + ra + 512); R.cv = *(const uint2*)(PR + ra + 1024); \
        if (!sample && t_ == 0) { R.pr = make_uint2(0u, 0u); R.pk = R.pr; R.pv = R.pr; } \
        else { R.pr = *(const uint2*)(PR + ra - RCOLS); R.pk = *(const uint2*)(PR + ra - RCOLS + 512); R.pv = *(const uint2*)(PR + ra - RCOLS + 1024); } \
        R.dw = *(const uint2*)(DAG + rb); R.da = *(const uint2*)(DAG + rb + 512); R.dg = *(const uint2*)(DAG + rb + 1024); } } while (0)
#define SCAN_PREP(chunk, dstbuf) do { const int t_ = (chunk) * CH + ptl; if (t_ < T) { \
        const float mr[4] = {mur.x, mur.y, mur.z, mur.w}, mk[4] = {muk.x, muk.y, muk.z, muk.w}, mv[4] = {muv.x, muv.y, muv.z, muv.w}; \
        const float kkc[4] = {kk4.x, kk4.y, kk4.z, kk4.w}, kac[4] = {ka4.x, ka4.y, ka4.z, ka4.w}, rkc[4] = {rk4.x, rk4.y, rk4.z, rk4.w}; \
        const float crr[4] = {bflo(R.cr.x), bfhi(R.cr.x), bflo(R.cr.y), bfhi(R.cr.y)}, ckk[4] = {bflo(R.ck.x), bfhi(R.ck.x), bflo(R.ck.y), bfhi(R.ck.y)}, cvv[4] = {bflo(R.cv.x), bfhi(R.cv.x), bflo(R.cv.y), bfhi(R.cv.y)}; \
        const float prr[4] = {bflo(R.pr.x), bfhi(R.pr.x), bflo(R.pr.y), bfhi(R.pr.y)}, pkk[4] = {bflo(R.pk.x), bfhi(R.pk.x), bflo(R.pk.y), bfhi(R.pk.y)}, pvv[4] = {bflo(R.pv.x), bfhi(R.pv.x), bflo(R.pv.y), bfhi(R.pv.y)}; \
        const float lw[4] = {bflo(R.dw.x), bfhi(R.dw.x), bflo(R.dw.y), bfhi(R.dw.y)}, aa[4] = {bflo(R.da.x), bfhi(R.da.x), bflo(R.da.y), bfhi(R.da.y)}, gg[4] = {bflo(R.dg.x), bfhi(R.dg.x), bflo(R.dg.y), bfhi(R.dg.y)}; \
        float r_[4], k_[4], v_[4], w_[4], kn[4], k2[4]; float nrm = 0.f; \
        _Pragma("unroll") for (int j = 0; j < 4; ++j) { r_[j] = crr[j] + (prr[j] - crr[j]) * mr[j]; k_[j] = ckk[j] + (pkk[j] - ckk[j]) * mk[j]; v_[j] = cvv[j] + (pvv[j] - cvv[j]) * mv[j]; \
            w_[j] = __expf(lw[j]); kn[j] = k_[j] * kkc[j]; nrm += kn[j] * kn[j]; k2[j] = k_[j] * (1.f + (aa[j] - 1.f) * kac[j]); } \
        nrm = row16_sum(nrm); const float inv = __builtin_amdgcn_rsqf(fmaxf(nrm, 1e-24f)); \
        float br = 0.f, kr = 0.f, rk = 0.f; float an[4], bn[4], wrr[4]; \
        _Pragma("unroll") for (int j = 0; j < 4; ++j) { const float kkn = kn[j] * inv; an[j] = -kkn; bn[j] = kkn * aa[j]; wrr[j] = w_[j] * r_[j]; br += bn[j] * r_[j]; kr += k2[j] * r_[j]; rk += r_[j] * k2[j] * rkc[j]; } \
        br = row16_sum(br); kr = row16_sum(kr); rk = row16_sum(rk); \
        LAS float* rec = (dstbuf) + ptl * SST; \
        *(LAS f32x4*)(rec + SI_W + pj) = (f32x4){w_[0], w_[1], w_[2], w_[3]}; *(LAS f32x4*)(rec + SI_A + pj) = (f32x4){an[0], an[1], an[2], an[3]}; \
        *(LAS f32x4*)(rec + SI_B + pj) = (f32x4){bn[0], bn[1], bn[2], bn[3]}; *(LAS f32x4*)(rec + SI_K + pj) = (f32x4){k2[0], k2[1], k2[2], k2[3]}; \
        *(LAS f32x4*)(rec + SI_WR + pj) = (f32x4){wrr[0], wrr[1], wrr[2], wrr[3]}; *(LAS f32x4*)(rec + SI_V + pj) = (f32x4){v_[0], v_[1], v_[2], v_[3]}; \
        *(LAS f32x4*)(rec + SI_G + pj) = (f32x4){gg[0], gg[1], gg[2], gg[3]}; \
        if ((tid & 15) == 0) *(LAS f32x4*)(rec + SI_SC) = (f32x4){br, kr, rk, 0.f}; } } while (0)

    SCAN_LOAD(0);
    SCAN_PREP(0, buf0);
    __syncthreads();
    for (int c = 0; c < nch; ++c) {
        LAS float* cur = (c & 1) ? buf1 : buf0; LAS float* nxt = (c & 1) ? buf0 : buf1;
        if (c + 1 < nch) SCAN_LOAD(c + 1);
        const int ns = (T - c * CH) < CH ? (T - c * CH) : CH;
        {
            const LAS float* rec = cur;
            f32x4 wA = *(const LAS f32x4*)(rec + SI_W + 4 * cgi), aA = *(const LAS f32x4*)(rec + SI_A + 4 * cgi), bA = *(const LAS f32x4*)(rec + SI_B + 4 * cgi);
            f32x4 kA = *(const LAS f32x4*)(rec + SI_K + 4 * cgi), rA = *(const LAS f32x4*)(rec + SI_WR + 4 * cgi);
            float vA = rec[SI_V + row]; pg8::f32x2 cA = *(const LAS pg8::f32x2*)(rec + SI_SC);
            f32x4 wB, aB, bB, kB, rB; float vB; pg8::f32x2 cB;
#define SCAN_FETCH(W, A, B, K, R, V, C) do { rec += SST; W = *(const LAS f32x4*)(rec + SI_W + 4 * cgi); A = *(const LAS f32x4*)(rec + SI_A + 4 * cgi); B = *(const LAS f32x4*)(rec + SI_B + 4 * cgi); \
            K = *(const LAS f32x4*)(rec + SI_K + 4 * cgi); R = *(const LAS f32x4*)(rec + SI_WR + 4 * cgi); V = rec[SI_V + row]; C = *(const LAS pg8::f32x2*)(rec + SI_SC); } while (0)
#define SCAN_STEP(W, A, B, K, R, V, C, qq) do { \
            float da = mul_(st[0], A[0]); float dw = mul_(st[0], R[0]); \
            da = fma_(st[1], A[1], da); dw = fma_(st[1], R[1], dw); da = fma_(st[2], A[2], da); dw = fma_(st[2], R[2], dw); da = fma_(st[3], A[3], da); dw = fma_(st[3], R[3], dw); \
            float tt_[4]; row16_sum2_mul4(da, dw, tt_, V, K[0], K[1], K[2], K[3]); \
            const float y = fma_(V, C[1], fma_(da, C[0], dw)); \
            _Pragma("unroll") for (int j = 0; j < 4; ++j) st[j] = fma_(st[j], W[j], fma_(da, B[j], tt_[j])); \
            yk = ((qq) == cgi) ? y : yk; } while (0)
            for (int tb = 0; tb < ns; tb += 16) {
                const int nq = (ns - tb) < 16 ? (ns - tb) : 16;
                float yk = 0.f;
                for (int q = 0; q < nq; q += 2) {
                    SCAN_FETCH(wB, aB, bB, kB, rB, vB, cB);
                    SCAN_STEP(wA, aA, bA, kA, rA, vA, cA, q);
                    SCAN_FETCH(wA, aA, bA, kA, rA, vA, cA);
                    SCAN_STEP(wB, aB, bB, kB, rB, vB, cB, q + 1);
                }
                ybuf[(tb + cgi) * 32 + rg] = yk;
            }
#undef SCAN_FETCH
#undef SCAN_STEP
        }
        __syncthreads();
        if (ptl < ns) {
            const pg8::f32x2 y2 = *(const LAS pg8::f32x2*)(ybuf + ptl * 32 + 2 * (tid & 15));
            *(float2*)(YG + (size_t)(rowB0 + c * CH + ptl) * 512 + h * 64 + 32 * half + 2 * (tid & 15)) = make_float2(y2[0], y2[1]);
        }
        if (c + 1 < nch) SCAN_PREP(c + 1, nxt);
        __syncthreads();
    }
#undef SCAN_LOAD
#undef SCAN_PREP
    float* So = p.out + (sample ? O_SWKV : O_PWKV) + ((size_t)(b * 8 + h) * 64 + row) * 64 + 4 * cgi;
    *(float4*)So = make_float4(st[0], st[1], st[2], st[3]);
}

__device__ __forceinline__ void phase_wkvfin(const Params& p, int tid, int G, int bid) {
    const bf16_t* PR = (const bf16_t*)(p.ws + WS_PROJRW); const bf16_t* DAG = (const bf16_t*)((const unsigned char*)p.out + SC_B);
    const float* YG = (const float*)(p.ws + WS_Y); bf16_t* MIX = (bf16_t*)((unsigned char*)p.out + SC_C);
    const int gt = bid * NTHREADS + tid, NT = G * NTHREADS;
    for (int i = gt; i < MB * 128; i += NT) {
        const int jq = i & 15, h = (i >> 4) & 7, rowB = i >> 7, pc = h * 64 + jq * 4, rowA = rowA_of(rowB);
        const size_t ra = (size_t)rowA * RCOLS + pc;
        const uint2 cr = *(const uint2*)(PR + ra), ck = *(const uint2*)(PR + ra + 512), cv = *(const uint2*)(PR + ra + 1024);
        uint2 pr = make_uint2(0u, 0u), pk = pr, pv = pr;
        if (!(rowB < MP && (rowB & (TP - 1)) == 0)) { pr = *(const uint2*)(PR + ra - RCOLS); pk = *(const uint2*)(PR + ra - RCOLS + 512); pv = *(const uint2*)(PR + ra - RCOLS + 1024); }
        const uint2 da = *(const uint2*)(DAG + (size_t)rowB * NLORA + 512 + pc), dg = *(const uint2*)(DAG + (size_t)rowB * NLORA + 1024 + pc);
        const float4 y4 = *(const float4*)(YG + (size_t)rowB * 512 + pc);
        const float4 mur = *(const float4*)(p.in[I_MU] + pc), muk = *(const float4*)(p.in[I_MU] + 512 + pc), muv = *(const float4*)(p.in[I_MU] + 1024 + pc);
        const float4 ka4 = *(const float4*)(p.in[I_KA] + pc), rk4 = *(const float4*)(p.in[I_RK] + pc), lw4 = *(const float4*)(p.in[I_LNW] + pc), lb4 = *(const float4*)(p.in[I_LNB] + pc);
        const float mr[4] = {mur.x, mur.y, mur.z, mur.w}, mk[4] = {muk.x, muk.y, muk.z, muk.w}, mv[4] = {muv.x, muv.y, muv.z, muv.w};
        const float kac[4] = {ka4.x, ka4.y, ka4.z, ka4.w}, rkc[4] = {rk4.x, rk4.y, rk4.z, rk4.w}, lw[4] = {lw4.x, lw4.y, lw4.z, lw4.w}, lb[4] = {lb4.x, lb4.y, lb4.z, lb4.w};
        const float crr[4] = {bflo(cr.x), bfhi(cr.x), bflo(cr.y), bfhi(cr.y)}, ckk[4] = {bflo(ck.x), bfhi(ck.x), bflo(ck.y), bfhi(ck.y)}, cvv[4] = {bflo(cv.x), bfhi(cv.x), bflo(cv.y), bfhi(cv.y)};
        const float prr[4] = {bflo(pr.x), bfhi(pr.x), bflo(pr.y), bfhi(pr.y)}, pkk[4] = {bflo(pk.x), bfhi(pk.x), bflo(pk.y), bfhi(pk.y)}, pvv[4] = {bflo(pv.x), bfhi(pv.x), bflo(pv.y), bfhi(pv.y)};
        const float aa[4] = {bflo(da.x), bfhi(da.x), bflo(da.y), bfhi(da.y)}, gg[4] = {bflo(dg.x), bfhi(dg.x), bflo(dg.y), bfhi(dg.y)};
        const float yy[4] = {y4.x, y4.y, y4.z, y4.w};
        float v_[4]; float rk = 0.f;
#pragma unroll
        for (int j = 0; j < 4; ++j) { const float r_ = crr[j] + (prr[j] - crr[j]) * mr[j], k_ = ckk[j] + (pkk[j] - ckk[j]) * mk[j]; v_[j] = cvv[j] + (pvv[j] - cvv[j]) * mv[j];
            const float k2 = k_ * (1.f + (aa[j] - 1.f) * kac[j]); rk += r_ * k2 * rkc[j]; }
        rk = row16_sum(rk);
        const float mean = row16_sum((yy[0] + yy[1]) + (yy[2] + yy[3])) * (1.f / 64.f);
        float d[4]; float vs = 0.f;
#pragma unroll
        for (int j = 0; j < 4; ++j) { d[j] = yy[j] - mean; vs += d[j] * d[j]; }
        const float rs = rsqrtf(row16_sum(vs) * (1.f / 64.f) + 64e-5f);
        float o[4];
#pragma unroll
        for (int j = 0; j < 4; ++j) o[j] = (d[j] * rs * lw[j] + lb[j] + rk * v_[j]) * gg[j];
        uint2 w; w.x = pk2(o[0], o[1]); w.y = pk2(o[2], o[3]);
        *(uint2*)(MIX + (size_t)rowB * D + pc) = w;
    }
}

__device__ __forceinline__ void attn_task(const Params& p, int task, int lane) {
    const bf16_t* Q = (const bf16_t*)(p.ws + WS_Q); const bf16_t* K = (const bf16_t*)(p.ws + WS_K);
    bf16_t* MIX = (bf16_t*)((unsigned char*)p.out + SC_C);
    const int b = task >> 11, h = (task >> 8) & 7, r16 = (task >> 4) & 15, ig = task & 15;
    const int li = lane & 15, g = lane >> 4;
    const int tq = r16 + 16 * (16 * ig + li);
    const bf16_t* qp = Q + (size_t)(b * TP + tq) * 512 + h * 64 + 8 * g;
    const bf16x8 qf0 = *(const bf16x8*)qp, qf1 = *(const bf16x8*)(qp + 32);
    float m_run = -1e30f, l_run = 0.f;
    f32x4 o[4];
#pragma unroll
    for (int i = 0; i < 4; ++i) o[i] = (f32x4){0.f, 0.f, 0.f, 0.f};
#pragma unroll 1
    for (int br = 0; br < 3; ++br) {
        int dd, r, uq0, Tdd; const bf16_t* VT;
        if (br == 0) { dd = 16; r = r16; uq0 = 16 * ig; Tdd = TP / 16; VT = (const bf16_t*)(p.ws + WS_VT16); }
        else if (br == 1) { dd = 4; r = r16 & 3; uq0 = (r16 >> 2) + 64 * ig; Tdd = TP / 4; VT = (const bf16_t*)(p.ws + WS_VT4); }
        else { dd = 1; r = 0; uq0 = r16 + 256 * ig; Tdd = TP; VT = (const bf16_t*)(p.ws + WS_VT1); }
        const int s = 16 / dd, uq = uq0 + s * li;
        int ulo = uq0 - 128; if (ulo < 0) ulo = 0; ulo &= ~31;
        const int uhi = uq0 + 15 * s;
        const bf16_t* Kb = K + ((size_t)b * TP + r) * 512 + h * 64 + 8 * g;
        const bf16_t* Vb = VT + (size_t)(b * 8 + h) * 64 * TP + (size_t)r * Tdd * 64 + li * 32 + 8 * g;
        bf16x8 kx0, kx1, ky0, ky1, vf[4];
        { const bf16_t* kx = Kb + (size_t)(ulo + li) * dd * 512; const bf16_t* ky = kx + (size_t)16 * dd * 512;
          kx0 = *(const bf16x8*)kx; kx1 = *(const bf16x8*)(kx + 32); ky0 = *(const bf16x8*)ky; ky1 = *(const bf16x8*)(ky + 32);
#pragma unroll
          for (int dt = 0; dt < 4; ++dt) vf[dt] = *(const bf16x8*)(Vb + (size_t)(ulo >> 5) * 2048 + dt * 512); }
#pragma unroll 1
        for (int kt = ulo; kt <= uhi; kt += 32) {
            const int ktn = (kt + 32 <= uhi) ? kt + 32 : kt;
            const bf16_t* nkx = Kb + (size_t)(ktn + li) * dd * 512; const bf16_t* nky = nkx + (size_t)16 * dd * 512;
            const bf16x8 nkx0 = *(const bf16x8*)nkx, nkx1 = *(const bf16x8*)(nkx + 32), nky0 = *(const bf16x8*)nky, nky1 = *(const bf16x8*)(nky + 32);
            bf16x8 nvf[4];
#pragma unroll
            for (int dt = 0; dt < 4; ++dt) nvf[dt] = *(const bf16x8*)(Vb + (size_t)(ktn >> 5) * 2048 + dt * 512);
            f32x4 sx = (f32x4){0.f, 0.f, 0.f, 0.f}, sy = (f32x4){0.f, 0.f, 0.f, 0.f};
            sx = __builtin_amdgcn_mfma_f32_16x16x32_bf16(kx0, qf0, sx, 0, 0, 0); sx = __builtin_amdgcn_mfma_f32_16x16x32_bf16(kx1, qf1, sx, 0, 0, 0);
            sy = __builtin_amdgcn_mfma_f32_16x16x32_bf16(ky0, qf0, sy, 0, 0, 0); sy = __builtin_amdgcn_mfma_f32_16x16x32_bf16(ky1, qf1, sy, 0, 0, 0);
            float sv[8]; bool ok[8]; float tmax = -1e30f;
#pragma unroll
            for (int j = 0; j < 4; ++j) { const int dx = uq - (kt + 4 * g + j), dy = dx - 16;
                ok[j] = (unsigned)dx <= 128u; ok[4 + j] = (unsigned)dy <= 128u; sv[j] = ok[j] ? sx[j] : -1e30f; sv[4 + j] = ok[4 + j] ? sy[j] : -1e30f;
                tmax = fmaxf(tmax, fmaxf(sv[j], sv[4 + j])); }
            tmax = fmaxf(tmax, __shfl_xor(tmax, 16)); tmax = fmaxf(tmax, __shfl_xor(tmax, 32));
            const float m_new = fmaxf(m_run, tmax), alpha = __expf(m_run - m_new);
            float pe[8]; float ps = 0.f;
#pragma unroll
            for (int j = 0; j < 8; ++j) { pe[j] = ok[j] ? __expf(sv[j] - m_new) : 0.f; ps += pe[j]; }
            l_run = l_run * alpha + ps; m_run = m_new;
            u32x4 pw; pw[0] = pk2(pe[0], pe[1]); pw[1] = pk2(pe[2], pe[3]); pw[2] = pk2(pe[4], pe[5]); pw[3] = pk2(pe[6], pe[7]);
            const bf16x8 pf = __builtin_bit_cast(bf16x8, pw);
#pragma unroll
            for (int dt = 0; dt < 4; ++dt) { o[dt] *= alpha; o[dt] = __builtin_amdgcn_mfma_f32_16x16x32_bf16(vf[dt], pf, o[dt], 0, 0, 0); }
            kx0 = nkx0; kx1 = nkx1; ky0 = nky0; ky1 = nky1;
#pragma unroll
            for (int dt = 0; dt < 4; ++dt) vf[dt] = nvf[dt];
        }
    }
    float lt = l_run; lt += __shfl_xor(lt, 16); lt += __shfl_xor(lt, 32);
    const float il = 1.f / lt;
    bf16_t* op = MIX + (size_t)(b * TP + tq) * D + 512 + h * 64 + 4 * g;
#pragma unroll
    for (int dt = 0; dt < 4; ++dt) { uint2 w; w.x = pk2(o[dt][0] * il, o[dt][1] * il); w.y = pk2(o[dt][2] * il, o[dt][3] * il); *(uint2*)(op + 16 * dt) = w; }
}
__device__ __forceinline__ void attn_sample_task(const Params& p, int task, int lane, LAS float* wl) {
    const bf16_t* Q = (const bf16_t*)(p.ws + WS_Q); const float* snewk = (const float*)(p.ws + WS_SNEWK); const float* snewv = (const float*)(p.ws + WS_SNEWV);
    const float* CK = p.in[I_CK]; const float* CV = p.in[I_CV];
    bf16_t* MIX = (bf16_t*)((unsigned char*)p.out + SC_C);
    const int b = task >> 6, h = (task >> 3) & 7, tt = task & 7;
    const int rowB = MP + b * TS + tt;
    asm volatile("s_waitcnt lgkmcnt(0)" ::: "memory");
    wl[lane] = bflo((u32)Q[(size_t)rowB * 512 + h * 64 + lane]);
    asm volatile("s_waitcnt lgkmcnt(0)" ::: "memory");
    float mx = -1e30f;
#pragma unroll 1
    for (int c = 0; c < 9; ++c) {
        const int br = c / 3, it = c - br * 3; const int dd = br == 0 ? 1 : (br == 1 ? 4 : 16); const int j = lane + 64 * it;
        const int jc = j <= 128 ? j : 128;
        const int idx = 2048 + tt - jc * dd;
        const float* kr = idx < 2048 ? CK + ((size_t)(b * 2048 + idx) * 8 + h) * 64 : snewk + (size_t)(b * TS + idx - 2048) * 512 + h * 64;
        float s = 0.f;
#pragma unroll
        for (int d4 = 0; d4 < 16; ++d4) { const float4 kv = *(const float4*)(kr + 4 * d4); const f32x4 qv = *(const LAS f32x4*)(wl + 4 * d4);
            s += kv.x * qv[0] + kv.y * qv[1] + kv.z * qv[2] + kv.w * qv[3]; }
        if (j > 128) s = -1e30f;
        wl[64 + c * 64 + lane] = s; mx = fmaxf(mx, s);
    }
#pragma unroll
    for (int o = 1; o < 64; o <<= 1) mx = fmaxf(mx, __shfl_xor(mx, o));
    asm volatile("s_waitcnt lgkmcnt(0)" ::: "memory");
    float ls = 0.f;
#pragma unroll 1
    for (int c = 0; c < 9; ++c) { const float s = wl[64 + c * 64 + lane]; const float e = s > -1e29f ? __expf(s - mx) : 0.f; wl[64 + c * 64 + lane] = e; ls += e; }
    ls = wave_sum(ls);
    asm volatile("s_waitcnt lgkmcnt(0)" ::: "memory");
    float acc = 0.f;
#pragma unroll 1
    for (int c = 0; c < 9; ++c) {
        const int br = c / 3, it = c - br * 3; const int dd = br == 0 ? 1 : (br == 1 ? 4 : 16); const int nj = it < 2 ? 64 : 1;
#pragma unroll 8
        for (int l2 = 0; l2 < nj; ++l2) {
            const int j = l2 + 64 * it; const int idx = 2048 + tt - j * dd;
            const float* vr = idx < 2048 ? CV + ((size_t)(b * 2048 + idx) * 8 + h) * 64 : snewv + (size_t)(b * TS + idx - 2048) * 512 + h * 64;
            acc += wl[64 + c * 64 + l2] * vr[lane];
        }
    }
    const float res = acc / ls;
    const float other = __shfl_xor(res, 1);
    if ((lane & 1) == 0) *(u32*)(MIX + (size_t)rowB * D + 512 + h * 64 + lane) = pk2(res, other);
}

__device__ __forceinline__ void phase_norm1(const Params& p, int tid, int G, int bid) {
    const int wave = tid >> 6, lane = tid & 63, gw = bid * 8 + wave, NGW = G * 8;
    const bf16_t* mix = (const bf16_t*)((const unsigned char*)p.out + SC_B); bf16_t* H2 = (bf16_t*)((unsigned char*)p.out + SC_C);
    for (int row = gw; row < MB; row += NGW) {
        const float* xrow = row < MP ? p.in[I_XP] + (size_t)row * D : p.in[I_XS] + (size_t)(row - MP) * D;
        const uint2* mr = (const uint2*)(mix + (size_t)row * D) + lane; const float4* xr = (const float4*)xrow + lane;
        float4 v[4], x[4]; float s = 0.f;
#pragma unroll
        for (int j = 0; j < 4; ++j) { const uint2 mm = mr[64 * j]; v[j] = make_float4(bflo(mm.x), bfhi(mm.x), bflo(mm.y), bfhi(mm.y)); x[j] = xr[64 * j]; s += (v[j].x * v[j].x + v[j].y * v[j].y) + (v[j].z * v[j].z + v[j].w * v[j].w); }
        const float rs = rsqrtf(wave_sum(s) * (1.f / D) + 1e-6f);
        float s2 = 0.f;
#pragma unroll
        for (int j = 0; j < 4; ++j) { const float4 gg = *((const float4*)p.in[I_NMPOST] + lane + 64 * j);
            x[j].x += v[j].x * rs * gg.x; x[j].y += v[j].y * rs * gg.y; x[j].z += v[j].z * rs * gg.z; x[j].w += v[j].w * rs * gg.w;
            s2 += (x[j].x * x[j].x + x[j].y * x[j].y) + (x[j].z * x[j].z + x[j].w * x[j].w);
            *((float4*)(p.out + (size_t)row * D) + lane + 64 * j) = x[j]; }
        const float rs2 = rsqrtf(wave_sum(s2) * (1.f / D) + 1e-6f);
#pragma unroll
        for (int j = 0; j < 4; ++j) { const float4 gg = *((const float4*)p.in[I_NFPRE] + lane + 64 * j);
            uint2 o; o.x = pk2(x[j].x * rs2 * gg.x, x[j].y * rs2 * gg.y); o.y = pk2(x[j].z * rs2 * gg.z, x[j].w * rs2 * gg.w);
            *((uint2*)(H2 + (size_t)(row + 2) * D) + lane + 64 * j) = o; }
    }
    for (int row = gw; row < 2 + (H2P_ROWS - MB - 2); row += NGW) {
        const int rr = row < 2 ? row : MB + row;
#pragma unroll
        for (int j = 0; j < 4; ++j) *((uint2*)(H2 + (size_t)rr * D) + lane + 64 * j) = make_uint2(0u, 0u);
    }
}
__device__ __forceinline__ void phase_act(const Params& p, int tid, int G, int bid) {
    const int wave = tid >> 6, lane = tid & 63, gw = bid * 8 + wave, NGW = G * 8;
    bf16_t* U = (bf16_t*)(p.ws + WS_U); const bf16_t* halo = (const bf16_t*)(p.ws + WS_HALO);
    const float* cw = p.in[I_CONVW]; const float* cb = p.in[I_CONVB];
    constexpr int NPI = (MP / 32) * 11, NSI = BS * 11;
    for (int it = gw; it < NPI + NSI; it += NGW) {
        const bool sample = it >= NPI; const int q = sample ? it - NPI : it; const int chunk = q / 11, cgp = q - chunk * 11;
        const int col = cgp * 256 + 4 * lane;
        const float4 wg0 = *(const float4*)(cw + col), wg1 = *(const float4*)(cw + FF2 + col), wg2 = *(const float4*)(cw + 2 * FF2 + col), bg = *(const float4*)(cb + col);
        const float4 wu0 = *(const float4*)(cw + FF + col), wu1 = *(const float4*)(cw + FF2 + FF + col), wu2 = *(const float4*)(cw + 2 * FF2 + FF + col), bu = *(const float4*)(cb + FF + col);
        float g2[4], g1[4], u2[4], u1[4];
        int row0, nrows;
        if (!sample) {
            row0 = chunk * 32; nrows = 32;
            if ((row0 & (TP - 1)) == 0) {
#pragma unroll
                for (int j = 0; j < 4; ++j) { g2[j] = 0.f; g1[j] = 0.f; u2[j] = 0.f; u1[j] = 0.f; }
            } else {
                const bf16_t* hp = halo + (size_t)chunk * 2 * FF2;
                const uint2 a = *(const uint2*)(hp + col), c2 = *(const uint2*)(hp + FF2 + col), e = *(const uint2*)(hp + FF + col), f = *(const uint2*)(hp + FF2 + FF + col);
                g2[0] = bflo(a.x); g2[1] = bfhi(a.x); g2[2] = bflo(a.y); g2[3] = bfhi(a.y); g1[0] = bflo(c2.x); g1[1] = bfhi(c2.x); g1[2] = bflo(c2.y); g1[3] = bfhi(c2.y);
                u2[0] = bflo(e.x); u2[1] = bfhi(e.x); u2[2] = bflo(e.y); u2[3] = bfhi(e.y); u1[0] = bflo(f.x); u1[1] = bfhi(f.x); u1[2] = bflo(f.y); u1[3] = bfhi(f.y);
            }
        } else {
            row0 = MP + chunk * TS; nrows = TS;
            const float* sp = p.in[I_SCONV] + (size_t)chunk * 2 * FF2;
            const float4 a = *(const float4*)(sp + col), c2 = *(const float4*)(sp + FF2 + col), e = *(const float4*)(sp + FF + col), f = *(const float4*)(sp + FF2 + FF + col);
            g2[0] = a.x; g2[1] = a.y; g2[2] = a.z; g2[3] = a.w; g1[0] = c2.x; g1[1] = c2.y; g1[2] = c2.z; g1[3] = c2.w;
            u2[0] = e.x; u2[1] = e.y; u2[2] = e.z; u2[3] = e.w; u1[0] = f.x; u1[1] = f.y; u1[2] = f.z; u1[3] = f.w;
        }
        const float w0g[4] = {wg0.x, wg0.y, wg0.z, wg0.w}, w1g[4] = {wg1.x, wg1.y, wg1.z, wg1.w}, w2g[4] = {wg2.x, wg2.y, wg2.z, wg2.w}, bgg[4] = {bg.x, bg.y, bg.z, bg.w};
        const float w0u[4] = {wu0.x, wu0.y, wu0.z, wu0.w}, w1u[4] = {wu1.x, wu1.y, wu1.z, wu1.w}, w2u[4] = {wu2.x, wu2.y, wu2.z, wu2.w}, buu[4] = {bu.x, bu.y, bu.z, bu.w};
        for (int r0 = 0; r0 < nrows; r0 += 8) {
            uint2 gv[8], uv[8];
#pragma unroll
            for (int i = 0; i < 8; ++i) { const bf16_t* rp = U + (size_t)(row0 + r0 + i) * FF2 + col; gv[i] = *(const uint2*)rp; uv[i] = *(const uint2*)(rp + FF); }
#pragma unroll
            for (int i = 0; i < 8; ++i) {
                const float gc[4] = {bflo(gv[i].x), bfhi(gv[i].x), bflo(gv[i].y), bfhi(gv[i].y)}, uc[4] = {bflo(uv[i].x), bfhi(uv[i].x), bflo(uv[i].y), bfhi(uv[i].y)};
                float o[4];
#pragma unroll
                for (int j = 0; j < 4; ++j) {
                    const float cgv = w0g[j] * g2[j] + w1g[j] * g1[j] + w2g[j] * gc[j] + bgg[j];
                    const float cuv = w0u[j] * u2[j] + w1u[j] * u1[j] + w2u[j] * uc[j] + buu[j];
                    o[j] = cgv * sigmoidf_(cgv) * cuv;
                    g2[j] = g1[j]; g1[j] = gc[j]; u2[j] = u1[j]; u1[j] = uc[j];
                }
                uint2 w; w.x = pk2(o[0], o[1]); w.y = pk2(o[2], o[3]);
                *(uint2*)(U + (size_t)(row0 + r0 + i) * FF2 + col) = w;
            }
        }
    }
}
__device__ __forceinline__ void phase_final(const Params& p, int tid, int G, int bid) {
    const int wave = tid >> 6, lane = tid & 63, gw = bid * 8 + wave, NGW = G * 8;
    const float* F = (const float*)(p.ws + WS_F);
    for (int row = gw; row < MB; row += NGW) {
        const float4* fr = (const float4*)(F + (size_t)row * D) + lane; float4* yr = (float4*)(p.out + (size_t)row * D) + lane;
        float4 v[4]; float s = 0.f;
#pragma unroll
        for (int j = 0; j < 4; ++j) { v[j] = fr[64 * j]; s += (v[j].x * v[j].x + v[j].y * v[j].y) + (v[j].z * v[j].z + v[j].w * v[j].w); }
        const float rs = rsqrtf(wave_sum(s) * (1.f / D) + 1e-6f);
#pragma unroll
        for (int j = 0; j < 4; ++j) { const float4 gg = *((const float4*)p.in[I_NFPOST] + lane + 64 * j); float4 x = yr[64 * j];
            x.x += v[j].x * rs * gg.x; x.y += v[j].y * rs * gg.y; x.z += v[j].z * rs * gg.z; x.w += v[j].w * rs * gg.w; yr[64 * j] = x; }
    }
}
__device__ __forceinline__ void phase_cachecopy(const Params& p, int tid, int G, int bid) {
    if (bid < 4) return;
    const int gt = (bid - 4) * NTHREADS + tid, NT = (G - 4) * NTHREADS;
    constexpr int PER_B = 2048 * 512 / 4;
    const float4* snk = (const float4*)(p.ws + WS_SNEWK); const float4* snv = (const float4*)(p.ws + WS_SNEWV);
    for (int i = gt; i < 2 * BS * PER_B; i += NT) {
        const int which = i >= BS * PER_B; const int q = which ? i - BS * PER_B : i; const int b = q / PER_B, r = q - b * PER_B;
        const float4* src = (const float4*)p.in[which ? I_CV : I_CK] + (size_t)b * PER_B;
        float4 v;
        if (r < 2040 * 128) v = src[r + 8 * 128]; else v = (which ? snv : snk)[(size_t)b * TS * 128 + (r - 2040 * 128)];
        ((float4*)(p.out + (which ? O_SV : O_SK)))[(size_t)b * PER_B + r] = v;
    }
}

template <int PH>
__device__ __forceinline__ void run_phase(const Params& p, LAS unsigned char* lds, int tid, int G, int bid) {
    if constexpr (PH == 0) { phase0(p, lds, tid, G, bid); __syncthreads(); }
    else if constexpr (PH == 1) {
        pg8::Gemm g{(const bf16_t*)((const unsigned char*)p.out + SC_B), (const bf16_t*)(p.ws + WS_WIN), MA, DIN, D, D, 256}; pg8::StaticOrder S; S.init(MA, DIN, G, bid);
        EpiProj E{(bf16_t*)(p.ws + WS_PROJRW), (bf16_t*)(p.ws + WS_Q), (bf16_t*)(p.ws + WS_K), (bf16_t*)(p.ws + WS_VROW), (bf16_t*)(p.ws + WS_VT4), (bf16_t*)(p.ws + WS_VT16),
                  (const float*)(p.ws + WS_ROPE), p.out, (float*)(p.ws + WS_SNEWK), (float*)(p.ws + WS_SNEWV)};
        pg8::gemm_phase<EpiProj, pg8::StaticOrder, false>(lds, g, S, E, nullptr);
    } else if constexpr (PH == 2) { phase_alora(p, tid, G, bid); phase_vtrans(p, lds, tid, G, bid); }
    else if constexpr (PH == 3) {
        pg8::Gemm g{(const bf16_t*)(p.ws + WS_ALORA), (const bf16_t*)(p.ws + WS_WLORA), MB, NLORA, KLORA, KLORA, 256}; pg8::StaticOrder S; S.init(MB, NLORA, G, bid);
        EpiDag E{(bf16_t*)((unsigned char*)p.out + SC_B), p.in[I_W0], p.in[I_A0]};
        pg8::gemm_phase<EpiDag, pg8::StaticOrder, false>(lds, g, S, E, nullptr);
    } else if constexpr (PH == 4 || PH == 11 || PH == 12) {
        const int NSCAN = 128;
        if (bid < NSCAN) {
            if constexpr (PH != 12) {
                scan_item(p, lds, tid, false, bid >> 4, (bid >> 1) & 7, bid & 1);
            }
        } else {
            if constexpr (PH != 12) for (int it = bid - NSCAN; it < 512; it += G - NSCAN) scan_item(p, lds, tid, true, it >> 4, (it >> 1) & 7, it & 1);
        }
        if (PH == 4 || (PH == 12 && bid >= NSCAN)) {
            const int wave = tid >> 6, lane = tid & 63, x = bid & 7;
            unsigned* ctr = (unsigned*)(p.ws + WS_BAR) + (PH == 4 ? 16 : 32) + x;
            for (;;) {
                unsigned id = 0; if (lane == 0) id = __hip_atomic_fetch_add(ctr, 1u, __ATOMIC_RELAXED, __HIP_MEMORY_SCOPE_AGENT);
                id = (unsigned)__builtin_amdgcn_readfirstlane((int)id);
                if (id >= 2048u + 256u) break;
                if (id < 2048u) { const int ig = id >> 7, hh = (id >> 4) & 7, r16 = id & 15; attn_task(p, (x << 11) | (hh << 8) | (r16 << 4) | ig, lane); }
                else { const int s = id - 2048; attn_sample_task(p, ((4 * x + (s >> 6)) << 6) | (s & 63), lane, (LAS float*)(lds + wave * 4096)); }
            }
        }
    } else if constexpr (PH == 5) {
        pg8::Gemm g{(const bf16_t*)((const unsigned char*)p.out + SC_C), (const bf16_t*)(p.ws + WS_WOUT), MB, D, D, D, 256}; pg8::StaticOrder S; S.init(MB, D, G, bid);
        EpiBf16S E{(bf16_t*)((unsigned char*)p.out + SC_B), D};
        pg8::gemm_phase<EpiBf16S, pg8::StaticOrder, false>(lds, g, S, E, nullptr);
    } else if constexpr (PH == 6) phase_norm1(p, tid, G, bid);
    else if constexpr (PH == 7) {
        pg8::Gemm g{(const bf16_t*)((const unsigned char*)p.out + SC_C), (const bf16_t*)(p.ws + WS_WUP), UP_TILES * 256, FF2, D, D, UP_STEP}; pg8::StaticOrder S; S.init(UP_TILES * 256, FF2, G, bid);
        EpiUpAct E{(bf16_t*)(p.ws + WS_U), p.out, p.in[I_CONVW], p.in[I_CONVB], p.in[I_SCONV], (LAS float*)(lds + 131072)};
        pg8::gemm_phase<EpiUpAct, pg8::StaticOrder, false>(lds, g, S, E, nullptr);
    } else if constexpr (PH == 8) phase_act(p, tid, G, bid);
    else if constexpr (PH == 9) {
        pg8::Gemm g{(const bf16_t*)(p.ws + WS_U), (const bf16_t*)(p.ws + WS_WDN), MB, D, FF, FF, 256}; pg8::StaticOrder S; S.init(MB, D, G, bid);
        pg8::EpiF32 E{(float*)(p.ws + WS_F), D, nullptr};
        pg8::gemm_phase<pg8::EpiF32, pg8::StaticOrder, false>(lds, g, S, E, nullptr);
        phase_cachecopy(p, tid, G, bid);
    } else if constexpr (PH == 10) { phase_final(p, tid, G, bid); }
    else if constexpr (PH == 13) phase_wkvfin(p, tid, G, bid);
}
__device__ __forceinline__ void grid_bar(unsigned* ctr, unsigned target) {
    asm volatile("s_waitcnt vmcnt(0)" ::: "memory");
    __syncthreads();
    if (threadIdx.x == 0) {
        __builtin_amdgcn_fence(__ATOMIC_RELEASE, "agent");
        asm volatile("s_waitcnt vmcnt(0)" ::: "memory");
        __hip_atomic_fetch_add(ctr, 1u, __ATOMIC_RELAXED, __HIP_MEMORY_SCOPE_AGENT);
        while (__hip_atomic_load(ctr, __ATOMIC_RELAXED, __HIP_MEMORY_SCOPE_AGENT) < target) __builtin_amdgcn_s_sleep(2);
        __builtin_amdgcn_fence(__ATOMIC_ACQUIRE, "agent");
        asm volatile("s_waitcnt vmcnt(0)" ::: "memory");
    }
    __syncthreads();
}
template <int SEAM, int FIRST, int... REST>
__device__ __forceinline__ void run_program(const Params& p, LAS unsigned char* lds, cg::grid_group& grid, int tid, int G, int bid) {
    if (p.en > (int)sizeof...(REST) - 1000) run_phase<FIRST>(p, lds, tid, G, bid);
    if constexpr (sizeof...(REST) > 0) {
        if constexpr (SEAM == 0) grid.sync(); else grid_bar((unsigned*)(p.ws + WS_BAR), (unsigned)(SEAM * G));
        run_program<SEAM + 1, REST...>(p, lds, grid, tid, G, bid);
    }
}
#define PROGRAM 0, 1, 2, 3, 4, 13, 5, 6, 7, 9, 10
__global__ void __launch_bounds__(NTHREADS, 2) hymba_fwd(Params p) {
    extern __shared__ __attribute__((aligned(16))) unsigned char lds_raw[];
    LAS unsigned char* lds = (LAS unsigned char*)lds_raw;
    cg::grid_group grid = cg::this_grid();
    run_program<0, PROGRAM>(p, lds, grid, threadIdx.x, gridDim.x, blockIdx.x);
}

extern "C" void kernel_launch(void* const* d_in, const int* in_sizes, int n_in, void* d_out, int out_size, void* d_ws, size_t ws_size, hipStream_t stream) {
    static int grid = 0;
    if (grid == 0) {
        if (n_in != 28 || (size_t)out_size != O_END || ws_size < WS_TOTAL) { fprintf(stderr, "kernel_launch: unexpected sizes n_in %d out %d ws %zu (need %zu)\n", n_in, out_size, ws_size, (size_t)WS_TOTAL); grid = -1; return; }
        int dev = 0, cus = 0, per_cu = 0;
        hipGetDevice(&dev); hipDeviceGetAttribute(&cus, hipDeviceAttributeMultiprocessorCount, dev);
        if (hipFuncSetAttribute((const void*)hymba_fwd, hipFuncAttributeMaxDynamicSharedMemorySize, LDS_BYTES) != hipSuccess) { fprintf(stderr, "kernel_launch: hipFuncSetAttribute failed\n"); grid = -1; return; }
        hipOccupancyMaxActiveBlocksPerMultiprocessor(&per_cu, (const void*)hymba_fwd, NTHREADS, LDS_BYTES);
        (void)hipGetLastError();
        if (per_cu < 1) per_cu = 1;
        grid = cus;
    }
    if (grid < 0) return;
    Params p{};
    for (int i = 0; i < 28; ++i) p.in[i] = (const float*)d_in[i];
    p.out = (float*)d_out; p.ws = (unsigned char*)d_ws; p.en = 1;
    if (hipMemsetAsync((unsigned char*)d_ws + WS_BAR, 0, 256, stream) != hipSuccess) { fprintf(stderr, "kernel_launch: memset of the barrier word failed\n"); return; }
    void* args[] = {&p};
    hipError_t e = hipLaunchCooperativeKernel((const void*)hymba_fwd, dim3(grid), dim3(NTHREADS), args, LDS_BYTES, stream);
    if (e != hipSuccess) fprintf(stderr, "cooperative launch failed: %s (grid %d)\n", hipGetErrorString(e), grid);
}
```

```cpp
#include <hip/hip_runtime.h>
#include <hip/hip_cooperative_groups.h>
#include <cstdio>
#include <cstdint>
namespace pg8 {
#define PG8_LAS __attribute__((address_space(3)))
typedef unsigned short bf16_t;
typedef short bf16x8 __attribute__((ext_vector_type(8)));
typedef float f32x4 __attribute__((ext_vector_type(4)));
typedef unsigned u32x4 __attribute__((ext_vector_type(4)));
constexpr int BM = 256, BK = 64, HALF = 128, HTB = HALF * BK * 2  , STAGE_BYTES = 8 * HTB, NXCD = 8, WGM = 8;

__host__ __device__ __forceinline__ int lds_byte(int r, int c) { const int st = (r >> 4) * 2 + (c >> 5), rr = r & 15, cc = c & 31, ob = rr * 64 + cc * 2; return st * 1024 + (ob ^ (((ob >> 9) & 1) << 5)); }
__host__ __device__ __forceinline__ void stage_rc(int b, int& R, int& C) { const int st = b / 1024, sb = b % 1024, swz = sb ^ (((sb >> 9) & 1) << 5); R = (st >> 1) * 16 + swz / 64; C = (st & 1) * 32 + (swz % 64) / 2; }
__host__ __device__ __forceinline__ int perm32(int rho) { const int n = rho >> 4, i = rho & 15; return 8 * (i >> 2) + 4 * n + (i & 3); }

struct Unit { int pm, pn; };
struct Gemm { const bf16_t* A; const bf16_t* Bt; int M, N, K, lda, tile_rows; };

struct StaticOrder {
    int nM, nN, nwg, G, c;
    __host__ __device__ void init(int M, int N, int G_, int c_) { nM = M / BM; nN = N / BM; nwg = nM * nN; G = G_; c = c_; }
    __host__ __device__ bool next(int i, Unit& u) const {
        const long L = (long)i * G + c; if (L >= nwg) return false;
        int wgid = (int)L; { const int q = nwg / NXCD, r = nwg % NXCD, xcd = wgid % NXCD, off = wgid / NXCD; wgid = (xcd < r ? xcd * (q + 1) : r * (q + 1) + (xcd - r) * q) + off; }
        const int nig = WGM * nN, gid = wgid / nig, fm = gid * WGM, gsz = (nM - fm) < WGM ? (nM - fm) : WGM;
        u.pm = fm + ((wgid % nig) % gsz); u.pn = (wgid % nig) / gsz; return true;
    }
    __device__ __forceinline__ void a_ready(const Unit&) const {}
    __device__ __forceinline__ void done(const Unit&) const {}
};
__device__ __forceinline__ unsigned cvt_pk_bf16(float lo, float hi) { unsigned r; asm volatile("v_cvt_pk_bf16_f32 %0, %1, %2" : "=v"(r) : "v"(lo), "v"(hi)); return r; }
typedef float f32x2 __attribute__((ext_vector_type(2)));
struct EpiF32 {
    static constexpr bool PERM = false, AFTER_DRAIN = false;
    float* C; int ldc; const float* bias;
    __device__ __forceinline__ void operator()(const f32x4 (&acc)[2][2][4][2], const Unit& u, int wr, int wc, int fr, int fq) const {
        const int row0 = u.pm * BM + wr * 64 + fr, col0 = u.pn * BM + wc * 32 + 4 * fq;
        f32x4 bv[2][2];
#pragma unroll
        for (int bj = 0; bj < 2; ++bj)
#pragma unroll
            for (int n = 0; n < 2; ++n) bv[bj][n] = bias ? *(const f32x4*)(bias + col0 + bj * HALF + n * 16) : (f32x4){0.f, 0.f, 0.f, 0.f};
#pragma unroll
        for (int ai = 0; ai < 2; ++ai)
#pragma unroll
            for (int m = 0; m < 4; ++m) { float* rowp = C + (size_t)(row0 + ai * HALF + m * 16) * ldc + col0;
#pragma unroll
                for (int bj = 0; bj < 2; ++bj)
#pragma unroll
                    for (int n = 0; n < 2; ++n) *(f32x4*)(rowp + bj * HALF + n * 16) = acc[ai][bj][m][n] + bv[bj][n]; }
    }
};
template <class Epi, class Sched, bool STAMP = false>
__device__ __forceinline__ void gemm_phase(PG8_LAS unsigned char* lds, const Gemm g, const Sched& S, const Epi& E, unsigned long long* stamps) {
    const int tid = threadIdx.x, wid = __builtin_amdgcn_readfirstlane(tid >> 6), lane = tid & 63, wr = wid >> 2, wc = wid & 3, fr = lane & 15, fq = lane >> 4;
    const int K = g.K, nt = K / BK;
    int ts_lo = 0, ts_hi = 0, nts = 0; const unsigned long long rt_entry = STAMP ? (unsigned long long)wall_clock64() : 0ull;
#define PG8_STAMP() do { if (STAMP && wid == 0 && nts < 64) { const unsigned long long _c = (unsigned long long)clock64(); \
        ts_lo = (lane == nts) ? (int)(unsigned)_c : ts_lo; ts_hi = (lane == nts) ? (int)(unsigned)(_c >> 32) : ts_hi; ++nts; } } while (0)
    PG8_STAMP();
    unsigned voffA[2], voffB[2];
#pragma unroll
    for (int i = 0; i < 2; ++i) { int R, C; stage_rc(tid * 16 + i * 8192, R, C); const int Rb = Epi::PERM ? ((R & ~31) + perm32(R & 31)) : R;
        voffA[i] = (unsigned)(R * g.lda + C) * 2u; voffB[i] = (unsigned)(Rb * K + C) * 2u; }
    const size_t kstep = (size_t)(BK * 2);
    const size_t hstep = (size_t)HALF * K * 2, hstepA = (size_t)HALF * g.lda * 2;
    const size_t tstep = 2 * hstep, tstepA = (size_t)g.tile_rows * g.lda * 2;
    const unsigned ldsw = (unsigned)wid * 1024u;
    const int aoff = lds_byte(wr * 64 + fr, fq * 8), boff = lds_byte(wc * 32 + fr, fq * 8);
#define PG8_SA(b, h) (((b) * 2 + (h)) * HTB)
#define PG8_SB(b, h) ((4 + (b) * 2 + (h)) * HTB)
#define PG8_STAGE(bufoff, gbase, voff) do { _Pragma("unroll") for (int _i = 0; _i < 2; ++_i) \
        __builtin_amdgcn_global_load_lds((const unsigned*)((const char*)(gbase) + (voff)[_i]), (PG8_LAS unsigned*)(lds + (bufoff) + ldsw + _i * 8192), 16, 0, 0); } while (0)
#define PG8_LDA(dst, b, h) do { _Pragma("unroll") for (int m = 0; m < 4; ++m) _Pragma("unroll") for (int k = 0; k < 2; ++k) dst[m][k] = *(const PG8_LAS bf16x8*)(lds + PG8_SA(b, h) + aoff + m * 2048 + k * 1024); } while (0)
#define PG8_LDB(dst, b, h) do { _Pragma("unroll") for (int n = 0; n < 2; ++n) _Pragma("unroll") for (int k = 0; k < 2; ++k) dst[n][k] = *(const PG8_LAS bf16x8*)(lds + PG8_SB(b, h) + boff + n * 2048 + k * 1024); } while (0)
#define PG8_MMA(ai, bj, At, Bt) do { __builtin_amdgcn_s_setprio(1); _Pragma("unroll") for (int m = 0; m < 4; ++m) _Pragma("unroll") for (int n = 0; n < 2; ++n) _Pragma("unroll") for (int k = 0; k < 2; ++k) \
        acc[ai][bj][m][n] = __builtin_amdgcn_mfma_f32_16x16x32_bf16(Bt[n][k], At[m][k], acc[ai][bj][m][n], 0, 0, 0); __builtin_amdgcn_s_setprio(0); } while (0)
#define PG8_WAIT_V(n) asm volatile("s_waitcnt vmcnt(" #n ")" ::: "memory")
#define PG8_WAIT_L(n) asm volatile("s_waitcnt lgkmcnt(" #n ")" ::: "memory")
#define PG8_BAR __builtin_amdgcn_s_barrier()
#define PG8_SCHED __builtin_amdgcn_sched_barrier(0)
    Unit cur, nxt; int ui = 0;
    if (!S.next(0, cur)) return;
    f32x4 acc[2][2][4][2];
#pragma unroll
    for (int a = 0; a < 2; ++a)
#pragma unroll
        for (int b = 0; b < 2; ++b)
#pragma unroll
            for (int m = 0; m < 4; ++m)
#pragma unroll
                for (int n = 0; n < 2; ++n) acc[a][b][m][n] = (f32x4){0.f, 0.f, 0.f, 0.f};
    bf16x8 At[4][2], B0[2][2], B1[2][2];
    const char* cA = (const char*)g.A + (size_t)cur.pm * tstepA; const char* cB = (const char*)g.Bt + (size_t)cur.pn * tstep;
    S.a_ready(cur);
    PG8_STAGE(PG8_SB(0, 0), cB, voffB); PG8_STAGE(PG8_SA(0, 0), cA, voffA); PG8_STAGE(PG8_SB(0, 1), cB + hstep, voffB); PG8_STAGE(PG8_SA(0, 1), cA + hstepA, voffA);
    if (wr == 1) PG8_BAR;
    PG8_WAIT_V(4); PG8_BAR;
    PG8_STAGE(PG8_SB(1, 0), cB + kstep, voffB); PG8_STAGE(PG8_SA(1, 0), cA + kstep, voffA); PG8_STAGE(PG8_SB(1, 1), cB + hstep + kstep, voffB);
    PG8_WAIT_V(6); PG8_BAR;
    PG8_STAMP();
    for (;;) {
        const bool has_next = S.next(ui + 1, nxt);
        const char* nA = has_next ? (const char*)g.A + (size_t)nxt.pm * tstepA : cA; const char* nB = has_next ? (const char*)g.Bt + (size_t)nxt.pn * tstep : cB;
        for (int t = 0; t < nt; t += 2) {
            const bool last = (t == nt - 2);
            const char* a1 = cA + (size_t)(t + 1) * kstep;
            const char* a2 = last ? nA : cA + (size_t)(t + 2) * kstep; const char* b2 = last ? nB : cB + (size_t)(t + 2) * kstep;
            const char* a3 = a2 + kstep; const char* b3 = b2 + kstep;
            if (last && has_next) S.a_ready(nxt);
            PG8_LDB(B0, 0, 0); PG8_SCHED; PG8_LDA(At, 0, 0); PG8_STAGE(PG8_SA(1, 1), a1 + hstepA, voffA);
            PG8_WAIT_L(8); PG8_BAR; PG8_WAIT_L(0); PG8_MMA(0, 0, At, B0); PG8_BAR; PG8_SCHED;
            PG8_LDB(B1, 0, 1); PG8_STAGE(PG8_SB(0, 0), b2, voffB);
            PG8_BAR; PG8_WAIT_L(0); PG8_MMA(0, 1, At, B1); PG8_BAR;
            PG8_LDA(At, 0, 1); PG8_STAGE(PG8_SA(0, 0), a2, voffA);
            PG8_BAR; PG8_WAIT_L(0); PG8_MMA(1, 0, At, B0); PG8_BAR; PG8_SCHED;
            PG8_STAGE(PG8_SB(0, 1), b2 + hstep, voffB);
            PG8_WAIT_V(6); PG8_BAR; PG8_MMA(1, 1, At, B1); PG8_BAR;
            PG8_LDB(B0, 1, 0); PG8_SCHED; PG8_LDA(At, 1, 0); PG8_STAGE(PG8_SA(0, 1), a2 + hstepA, voffA);
            PG8_WAIT_L(8); PG8_BAR; PG8_WAIT_L(0); PG8_MMA(0, 0, At, B0); PG8_BAR; PG8_SCHED;
            PG8_LDB(B1, 1, 1); PG8_STAGE(PG8_SB(1, 0), b3, voffB);
            PG8_BAR; PG8_WAIT_L(0); PG8_MMA(0, 1, At, B1); PG8_BAR;
            PG8_LDA(At, 1, 1); PG8_STAGE(PG8_SA(1, 0), a3, voffA);
            PG8_BAR; PG8_WAIT_L(0); PG8_MMA(1, 0, At, B0); PG8_BAR; PG8_SCHED;
            PG8_STAGE(PG8_SB(1, 1), b3 + hstep, voffB);
            PG8_WAIT_V(6); PG8_BAR; PG8_MMA(1, 1, At, B1); PG8_BAR;
        }
        PG8_STAMP();
        if constexpr (!Epi::AFTER_DRAIN) { E(acc, cur, wr, wc, fr, fq); S.done(cur); }
        PG8_STAMP();
        if (!has_next) break;
#pragma unroll
        for (int a = 0; a < 2; ++a)
#pragma unroll
            for (int b = 0; b < 2; ++b)
#pragma unroll
                for (int m = 0; m < 4; ++m)
#pragma unroll
                    for (int n = 0; n < 2; ++n) acc[a][b][m][n] = (f32x4){0.f, 0.f, 0.f, 0.f};
        cur = nxt; cA = nA; cB = nB; ++ui;
    }
    PG8_WAIT_V(0);
    if (wr == 0) PG8_BAR;
    PG8_BAR;
    if constexpr (Epi::AFTER_DRAIN) { E.fused(acc, cur, wr, wc, fr, fq, lds, wid, lane); S.done(cur); }
    PG8_STAMP();
    if (STAMP && wid == 0) { stamps[lane] = lane < nts ? (((unsigned long long)(unsigned)ts_hi << 32) | (unsigned)ts_lo) : 0ull;
        if (lane == 62) stamps[62] = rt_entry; if (lane == 63) stamps[63] = (unsigned long long)wall_clock64(); }
#undef PG8_STAMP
#undef PG8_SA
#undef PG8_SB
#undef PG8_STAGE
#undef PG8_LDA
#undef PG8_LDB
#undef PG8_MMA
#undef PG8_WAIT_V
#undef PG8_WAIT_L
#undef PG8_BAR
#undef PG8_SCHED
}
}

namespace cg = cooperative_groups;
#define LAS __attribute__((address_space(3)))
typedef unsigned short bf16_t;
typedef unsigned int u32;
typedef pg8::bf16x8 bf16x8;
typedef pg8::f32x4 f32x4;
typedef pg8::u32x4 u32x4;

constexpr int D = 1024, TP = 4096, BP = 8, MP = BP * TP, BS = 32, TS = 8, MS = BS * TS;
constexpr int MB = MP + MS;
constexpr int MA = 33280;
constexpr int MA_REAL = MP + BS * 9;
constexpr int DIN = 3328, RCOLS = 1792, FF = 2816, FF2 = 5632, NLORA = 1536, KLORA = 256;
constexpr int NTHREADS = 512;
constexpr int UP_TILES = 131, UP_STEP = 254, H2P_ROWS = (UP_TILES - 1) * UP_STEP + 256;
constexpr int LDS_BYTES = 144 * 1024;

constexpr size_t O_YP = 0;
constexpr size_t O_YS = O_YP + (size_t)MP * D;
constexpr size_t O_PSH = O_YS + (size_t)MS * D;
constexpr size_t O_PWKV = O_PSH + (size_t)BP * D;
constexpr size_t O_PK = O_PWKV + (size_t)BP * 8 * 64 * 64;
constexpr size_t O_PV = O_PK + (size_t)BP * 2048 * 512;
constexpr size_t O_PCONV = O_PV + (size_t)BP * 2048 * 512;
constexpr size_t O_SSH = O_PCONV + (size_t)BP * 2 * FF2;
constexpr size_t O_SWKV = O_SSH + (size_t)BS * D;
constexpr size_t O_SK = O_SWKV + (size_t)BS * 8 * 64 * 64;
constexpr size_t O_SV = O_SK + (size_t)BS * 2048 * 512;
constexpr size_t O_SCONV = O_SV + (size_t)BS * 2048 * 512;
constexpr size_t O_END = O_SCONV + (size_t)BS * 2 * FF2;

constexpr size_t al256(size_t x) { return (x + 255) & ~(size_t)255; }
constexpr size_t WS_WIN = 0;
constexpr size_t WS_WOUT = WS_WIN + al256((size_t)DIN * D * 2);
constexpr size_t WS_WUP = WS_WOUT + al256((size_t)D * D * 2);
constexpr size_t WS_WDN = WS_WUP + al256((size_t)FF2 * D * 2);
constexpr size_t WS_WLORA = WS_WDN + al256((size_t)D * FF * 2);
constexpr size_t WS_ROPE = WS_WLORA + al256((size_t)NLORA * KLORA * 2);
constexpr int NPOS = 4104;
constexpr size_t WS_SNEWK = WS_ROPE + al256((size_t)NPOS * 32 * 2 * 4);
constexpr size_t WS_SNEWV = WS_SNEWK + al256((size_t)MS * 512 * 4);
constexpr size_t WS_HALO = WS_SNEWV + al256((size_t)MS * 512 * 4);
constexpr size_t WS_A = WS_HALO + al256((size_t)1025 * 2 * FF2 * 2);
constexpr size_t WS_PROJRW = WS_A;
constexpr size_t WS_Q = WS_PROJRW + al256((size_t)MA * RCOLS * 2);
constexpr size_t WS_K = WS_Q + al256((size_t)MB * 512 * 2);
constexpr size_t WS_VT1 = WS_K + al256((size_t)MB * 512 * 2);
constexpr size_t WS_VT4 = WS_VT1 + al256((size_t)BP * 8 * 64 * TP * 2);
constexpr size_t WS_VT16 = WS_VT4 + al256((size_t)BP * 8 * 64 * TP * 2);
constexpr size_t WS_ALORA = WS_VT16 + al256((size_t)BP * 8 * 64 * TP * 2);
constexpr size_t WS_VROW = WS_ALORA + al256((size_t)MB * KLORA * 2);
constexpr size_t WS_A_EARLY_END = WS_VROW + al256((size_t)MP * 512 * 2);
constexpr size_t WS_U = WS_A;
constexpr size_t WS_F = WS_A + al256((size_t)MB * FF * 2);
static_assert(WS_F + (size_t)MB * D * 4 <= WS_A + al256((size_t)MB * FF2 * 2), "region A late overflow");
constexpr size_t WS_END = WS_A + al256((size_t)MB * FF2 * 2);
static_assert(WS_A_EARLY_END <= WS_END, "region A overflow");
constexpr size_t WS_BAR = WS_END;
constexpr size_t WS_TOTAL = WS_END + 256;
constexpr size_t WS_Y = WS_ALORA;
static_assert(WS_Y + (size_t)MB * 512 * 4 <= WS_END, "Y overflow");
constexpr size_t SC_B = O_SK * 4;
constexpr size_t SC_C = SC_B + al256((size_t)MB * D * 4);
static_assert(SC_C + (size_t)H2P_ROWS * D * 2 <= O_SCONV * 4, "scratch overflow");
static_assert((size_t)MA * D * 2 <= (size_t)MB * D * 4 && (size_t)MB * NLORA * 2 <= (size_t)MB * D * 4, "region B");

struct Params {
    const float* in[28];
    float* out;
    unsigned char* ws;
    int en, pad;
};

enum { I_XP = 0, I_XS, I_SSHIFT, I_SWKV, I_CK, I_CV, I_SCONV, I_NMPRE, I_NMPOST, I_NFPRE, I_NFPOST, I_WIN, I_MU, I_W0, I_WDEC, I_A0, I_WICLR, I_WGATE,
       I_KK, I_KA, I_RK, I_LNW, I_LNB, I_WOUT, I_WUP, I_CONVW, I_CONVB, I_WDN };

__device__ __forceinline__ float bflo(u32 p) { return __uint_as_float(p << 16); }
__device__ __forceinline__ float bfhi(u32 p) { return __uint_as_float(p & 0xffff0000u); }
__device__ __forceinline__ u32 pk2(float a, float b) { return pg8::cvt_pk_bf16(a, b); }
__device__ __forceinline__ float wave_sum(float v) {
#pragma unroll
    for (int o = 1; o < 64; o <<= 1) v += __shfl_xor(v, o);
    return v;
}
template <int N> __device__ __forceinline__ float dpp_ror(float x) {
    return __int_as_float(__builtin_amdgcn_update_dpp(0, __float_as_int(x), 0x120 + N, 0xF, 0xF, false));
}
__device__ __forceinline__ float row16_sum(float x) {
    x += dpp_ror<8>(x); x += dpp_ror<4>(x); x += dpp_ror<2>(x); x += dpp_ror<1>(x);
    return x;
}
__device__ __forceinline__ void row16_sum4(float& a, float& b, float& c, float& d) {
    asm volatile("s_nop 1\n\t"
                 "v_add_f32_dpp %0, %0, %0 row_ror:8 row_mask:0xf bank_mask:0xf\n\t" "v_add_f32_dpp %1, %1, %1 row_ror:8 row_mask:0xf bank_mask:0xf\n\t"
                 "v_add_f32_dpp %2, %2, %2 row_ror:8 row_mask:0xf bank_mask:0xf\n\t" "v_add_f32_dpp %3, %3, %3 row_ror:8 row_mask:0xf bank_mask:0xf\n\t"
                 "v_add_f32_dpp %0, %0, %0 row_ror:4 row_mask:0xf bank_mask:0xf\n\t" "v_add_f32_dpp %1, %1, %1 row_ror:4 row_mask:0xf bank_mask:0xf\n\t"
                 "v_add_f32_dpp %2, %2, %2 row_ror:4 row_mask:0xf bank_mask:0xf\n\t" "v_add_f32_dpp %3, %3, %3 row_ror:4 row_mask:0xf bank_mask:0xf\n\t"
                 "v_add_f32_dpp %0, %0, %0 row_ror:2 row_mask:0xf bank_mask:0xf\n\t" "v_add_f32_dpp %1, %1, %1 row_ror:2 row_mask:0xf bank_mask:0xf\n\t"
                 "v_add_f32_dpp %2, %2, %2 row_ror:2 row_mask:0xf bank_mask:0xf\n\t" "v_add_f32_dpp %3, %3, %3 row_ror:2 row_mask:0xf bank_mask:0xf\n\t"
                 "v_add_f32_dpp %0, %0, %0 row_ror:1 row_mask:0xf bank_mask:0xf\n\t" "v_add_f32_dpp %1, %1, %1 row_ror:1 row_mask:0xf bank_mask:0xf\n\t"
                 "v_add_f32_dpp %2, %2, %2 row_ror:1 row_mask:0xf bank_mask:0xf\n\t" "v_add_f32_dpp %3, %3, %3 row_ror:1 row_mask:0xf bank_mask:0xf\n\t"
                 "s_nop 1"
                 : "+v"(a), "+v"(b), "+v"(c), "+v"(d));
}
__device__ __forceinline__ float fma_(float a, float b, float c) { float d; asm("v_fma_f32 %0, %1, %2, %3" : "=v"(d) : "v"(a), "v"(b), "v"(c)); return d; }
__device__ __forceinline__ float mul_(float a, float b) { float d; asm("v_mul_f32 %0, %1, %2" : "=v"(d) : "v"(a), "v"(b)); return d; }
__device__ __forceinline__ void row16_sum2_mul4(float& a, float& b, float (&t)[4], float v, float k0, float k1, float k2, float k3) {
    asm volatile("v_mul_f32 %2, %6, %7\n\t" "v_mul_f32 %3, %6, %8\n\t"
                 "v_add_f32_dpp %0, %0, %0 row_ror:8 row_mask:0xf bank_mask:0xf\n\t" "v_add_f32_dpp %1, %1, %1 row_ror:8 row_mask:0xf bank_mask:0xf\n\t"
                 "v_mul_f32 %4, %6, %9\n\t"
                 "v_add_f32_dpp %0, %0, %0 row_ror:4 row_mask:0xf bank_mask:0xf\n\t" "v_add_f32_dpp %1, %1, %1 row_ror:4 row_mask:0xf bank_mask:0xf\n\t"
                 "v_mul_f32 %5, %6, %10\n\t"
                 "v_add_f32_dpp %0, %0, %0 row_ror:2 row_mask:0xf bank_mask:0xf\n\t" "v_add_f32_dpp %1, %1, %1 row_ror:2 row_mask:0xf bank_mask:0xf\n\t"
                 "s_nop 0\n\t"
                 "v_add_f32_dpp %0, %0, %0 row_ror:1 row_mask:0xf bank_mask:0xf\n\t" "v_add_f32_dpp %1, %1, %1 row_ror:1 row_mask:0xf bank_mask:0xf"
                 : "+v"(a), "+v"(b), "=&v"(t[0]), "=&v"(t[1]), "=&v"(t[2]), "=&v"(t[3])
                 : "v"(v), "v"(k0), "v"(k1), "v"(k2), "v"(k3));
}
__device__ __forceinline__ void row16_sum2(float& a, float& b) {
    asm volatile("s_nop 1\n\t"
                 "v_add_f32_dpp %0, %0, %0 row_ror:8 row_mask:0xf bank_mask:0xf\n\t" "v_add_f32_dpp %1, %1, %1 row_ror:8 row_mask:0xf bank_mask:0xf\n\t" "s_nop 0\n\t"
                 "v_add_f32_dpp %0, %0, %0 row_ror:4 row_mask:0xf bank_mask:0xf\n\t" "v_add_f32_dpp %1, %1, %1 row_ror:4 row_mask:0xf bank_mask:0xf\n\t" "s_nop 0\n\t"
                 "v_add_f32_dpp %0, %0, %0 row_ror:2 row_mask:0xf bank_mask:0xf\n\t" "v_add_f32_dpp %1, %1, %1 row_ror:2 row_mask:0xf bank_mask:0xf\n\t" "s_nop 0\n\t"
                 "v_add_f32_dpp %0, %0, %0 row_ror:1 row_mask:0xf bank_mask:0xf\n\t" "v_add_f32_dpp %1, %1, %1 row_ror:1 row_mask:0xf bank_mask:0xf\n\t"
                 "s_nop 1"
                 : "+v"(a), "+v"(b));
}
__device__ __forceinline__ float sigmoidf_(float x) { return __builtin_amdgcn_rcpf(1.f + __expf(-x)); }

__device__ __forceinline__ int win_rowmap(int n) {
    if (n < RCOLS || n >= RCOLS + 1024) return n;
    const int base = (n < RCOLS + 512) ? RCOLS : RCOLS + 512, c = n - base, unit = c >> 8, cu = c & 255, hu = cu >> 6, d = cu & 63, e = d & 31, s = d >> 5;
    const int idx = hu * 32 + e, bj = idx >> 6, wc = (idx & 63) >> 4, fq = (idx & 15) >> 2, j = idx & 3;
    return base + unit * 256 + 128 * bj + 32 * wc + 16 * s + 4 * fq + j;
}
__device__ __forceinline__ int wup_rowmap(int c) {
    const int isup = c >= FF ? 1 : 0, cc = c - FF * isup, pn = cc >> 7, e = cc & 127;
    return pn * 256 + 128 * (e >> 6) + 32 * ((e >> 4) & 3) + 16 * isup + 4 * ((e >> 2) & 3) + (e & 3);
}
__device__ __forceinline__ void transpose_item(const float* W, int K, int N, bf16_t* WT, int mode, LAS float* scr, int item, int lane) {
    const int nblk = N / 32, kb = item / nblk, nb = item % nblk, k0 = 64 * kb, n0 = 32 * nb;
#pragma unroll 8
    for (int i = 0; i < 32; ++i) { const int kk = 2 * i + (lane >> 5); scr[kk * 33 + (lane & 31)] = W[(size_t)(k0 + kk) * N + n0 + (lane & 31)]; }
    asm volatile("s_waitcnt lgkmcnt(0)" ::: "memory");
    const int c = lane & 7;
#pragma unroll
    for (int j = 0; j < 4; ++j) { const int n = (lane >> 3) + 8 * j; const LAS float* s = scr + (8 * c) * 33 + n;
        uint4 o; o.x = pk2(s[0 * 33], s[1 * 33]); o.y = pk2(s[2 * 33], s[3 * 33]); o.z = pk2(s[4 * 33], s[5 * 33]); o.w = pk2(s[6 * 33], s[7 * 33]);
        const int row = mode == 1 ? win_rowmap(n0 + n) : (mode == 2 ? wup_rowmap(n0 + n) : (n0 + n));
        *(uint4*)(WT + (size_t)row * K + k0 + 8 * c) = o; }
    asm volatile("s_waitcnt lgkmcnt(0)" ::: "memory");
}
__device__ __forceinline__ void rms_row(const float* xrow, const float* g, bf16_t* orow, float* frow, int lane) {
    const float4* xr = (const float4*)xrow + lane; const float4* gr = (const float4*)g + lane;
    float4 v[4]; float s = 0.f;
#pragma unroll
    for (int j = 0; j < 4; ++j) { v[j] = xr[64 * j]; s += (v[j].x * v[j].x + v[j].y * v[j].y) + (v[j].z * v[j].z + v[j].w * v[j].w); }
    const float rs = rsqrtf(wave_sum(s) * (1.f / D) + 1e-6f);
#pragma unroll
    for (int j = 0; j < 4; ++j) { const float4 gg = gr[64 * j];
        float4 y; y.x = v[j].x * rs * gg.x; y.y = v[j].y * rs * gg.y; y.z = v[j].z * rs * gg.z; y.w = v[j].w * rs * gg.w;
        uint2 o; o.x = pk2(y.x, y.y); o.y = pk2(y.z, y.w);
        *((uint2*)orow + lane + 64 * j) = o;
        if (frow) *((float4*)frow + lane + 64 * j) = y; }
}
__device__ __forceinline__ void phase0(const Params& p, LAS unsigned char* lds, int tid, int G, int bid) {
    const int wave = tid >> 6, lane = tid & 63, gw = bid * 8 + wave, NGW = G * 8;
    LAS float* scr = (LAS float*)(lds + wave * 16384);
    bf16_t* WinT = (bf16_t*)(p.ws + WS_WIN); bf16_t* WoutT = (bf16_t*)(p.ws + WS_WOUT); bf16_t* WupT = (bf16_t*)(p.ws + WS_WUP); bf16_t* WdnT = (bf16_t*)(p.ws + WS_WDN);
    constexpr int I1 = (D / 64) * (DIN / 32), I2 = (D / 64) * (D / 32), I3 = (D / 64) * (FF2 / 32), I4 = (FF / 64) * (D / 32);
    for (int it = gw; it < I1 + I2 + I3 + I4; it += NGW) {
        int r = it;
        if (r < I1) { transpose_item(p.in[I_WIN], D, DIN, WinT, 1, scr, r, lane); continue; } r -= I1;
        if (r < I2) { transpose_item(p.in[I_WOUT], D, D, WoutT, 0, scr, r, lane); continue; } r -= I2;
        if (r < I3) { transpose_item(p.in[I_WUP], D, FF2, WupT, 2, scr, r, lane); continue; } r -= I3;
        transpose_item(p.in[I_WDN], FF, D, WdnT, 0, scr, r, lane);
    }
    const int gt = bid * NTHREADS + tid, NT = G * NTHREADS;
    bf16_t* WL = (bf16_t*)(p.ws + WS_WLORA);
    for (int i = gt; i < NLORA * KLORA; i += NT) {
        const int row = i >> 8, k = i & 255; float v = 0.f;
        if (row < 512) { if (k < 64) v = p.in[I_WDEC][k * 512 + row]; }
        else if (row < 1024) { if (k >= 64 && k < 128) v = p.in[I_WICLR][(k - 64) * 512 + (row - 512)]; }
        else { if (k >= 128) v = p.in[I_WGATE][(k - 128) * 512 + (row - 1024)]; }
        WL[i] = (bf16_t)(pk2(v, 0.f) & 0xffffu);
    }
    float* rope = (float*)(p.ws + WS_ROPE);
    for (int i = gt; i < NPOS * 32; i += NT) {
        const int pi = i >> 5, e = i & 31; const int pos = pi < TP ? pi : 16384 + (pi - TP);
        double inv = 1.0; for (int q = 0; q < e; ++q) inv *= 0.7498942093324558273;
        const float ang = (float)pos * (float)inv;
        const double a = (double)ang; const double kq = rint(a * 0.15915494309189535); double r = a - kq * 6.283185307179586; r -= kq * 2.4492935982947064e-16;
        const double r2 = r * r;
        double sn = 1.0 / 51090942171709440000.0;
        sn = sn * r2 * (-1.0) + 1.0 / 121645100408832000.0;
        sn = -sn * r2 + 1.0 / 355687428096000.0;
        sn = -sn * r2 + 1.0 / 1307674368000.0;
        sn = -sn * r2 + 1.0 / 6227020800.0;
        sn = -sn * r2 + 1.0 / 39916800.0;
        sn = -sn * r2 + 1.0 / 362880.0;
        sn = -sn * r2 + 1.0 / 5040.0;
        sn = -sn * r2 + 1.0 / 120.0;
        sn = -sn * r2 + 1.0 / 6.0;
        sn = -sn * r2 + 1.0;
        sn *= r;
        double cs = 1.0 / 1124000727777607680000.0;
        cs = -cs * r2 + 1.0 / 2432902008176640000.0;
        cs = -cs * r2 + 1.0 / 6402373705728000.0;
        cs = -cs * r2 + 1.0 / 20922789888000.0;
        cs = -cs * r2 + 1.0 / 87178291200.0;
        cs = -cs * r2 + 1.0 / 479001600.0;
        cs = -cs * r2 + 1.0 / 3628800.0;
        cs = -cs * r2 + 1.0 / 40320.0;
        cs = -cs * r2 + 1.0 / 720.0;
        cs = -cs * r2 + 1.0 / 24.0;
        cs = -cs * r2 + 0.5;
        cs = -cs * r2 + 1.0;
        rope[i] = (float)cs; rope[NPOS * 32 + i] = (float)sn;
    }
    bf16_t* H = (bf16_t*)((unsigned char*)p.out + SC_B);
    for (int row = gw; row < MA; row += NGW) {
        bf16_t* orow = H + (size_t)row * D;
        if (row < MP) {
            const bool last = (row & (TP - 1)) == TP - 1;
            rms_row(p.in[I_XP] + (size_t)row * D, p.in[I_NMPRE], orow, last ? p.out + O_PSH + (size_t)(row >> 12) * D : nullptr, lane);
        } else {
            const int s = row - MP;
            if (s < BS * 9) {
                const int b = s / 9, j = s - b * 9;
                if (j == 0) {
                    const float4* sr = (const float4*)(p.in[I_SSHIFT] + (size_t)b * D) + lane;
#pragma unroll
                    for (int q = 0; q < 4; ++q) { const float4 v = sr[64 * q]; uint2 o; o.x = pk2(v.x, v.y); o.y = pk2(v.z, v.w); *((uint2*)orow + lane + 64 * q) = o; }
                } else {
                    rms_row(p.in[I_XS] + (size_t)(b * TS + j - 1) * D, p.in[I_NMPRE], orow, j == TS ? p.out + O_SSH + (size_t)b * D : nullptr, lane);
                }
            } else {
#pragma unroll
                for (int q = 0; q < 4; ++q) *((uint2*)orow + lane + 64 * q) = make_uint2(0u, 0u);
            }
        }
    }
}

struct EpiProj {
    static constexpr bool PERM = false, AFTER_DRAIN = false;
    bf16_t* projrw; bf16_t* Q; bf16_t* K; bf16_t* VT1; bf16_t* VT4; bf16_t* VT16; const float* rope; float* out; float* snewk; float* snewv;
    __device__ __forceinline__ void operator()(const f32x4 (&acc)[2][2][4][2], const pg8::Unit& u, int wr, int wc, int fr, int fq) const {
        const int pn = u.pn;
        if (pn < 7) {
#pragma unroll
            for (int ai = 0; ai < 2; ++ai)
#pragma unroll
                for (int m = 0; m < 4; ++m) { const int row = u.pm * 256 + ai * 128 + wr * 64 + m * 16 + fr;
                    bf16_t* rp = projrw + (size_t)row * RCOLS + pn * 256 + wc * 32 + 4 * fq;
#pragma unroll
                    for (int bj = 0; bj < 2; ++bj)
#pragma unroll
                        for (int n = 0; n < 2; ++n) { const f32x4 v = acc[ai][bj][m][n]; uint2 o; o.x = pk2(v[0], v[1]); o.y = pk2(v[2], v[3]); *(uint2*)(rp + bj * 128 + n * 16) = o; } }
            return;
        }
#pragma unroll
        for (int ai = 0; ai < 2; ++ai)
#pragma unroll
            for (int m = 0; m < 4; ++m) {
                const int row = u.pm * 256 + ai * 128 + wr * 64 + m * 16 + fr;
                bool prompt = row < MP; int b, t, rowB, pi; bool valid = true;
                if (prompt) { b = row >> 12; t = row & (TP - 1); rowB = row; pi = t; }
                else { const int s = row - MP; b = s / 9; const int j = s - b * 9; valid = (s < BS * 9) && (j > 0); t = j - 1; rowB = MP + b * TS + t; pi = TP + t; }
                if (!valid) continue;
                if (pn < 11) {
                    const bool isq = pn < 9; const int unit = isq ? pn - 7 : pn - 9;
#pragma unroll
                    for (int bj = 0; bj < 2; ++bj) {
                        const int idx = bj * 64 + wc * 16 + fq * 4, hu = idx >> 5, e = idx & 31;
                        const float4 cs = *(const float4*)(rope + (size_t)pi * 32 + e), sn = *(const float4*)(rope + (size_t)NPOS * 32 + (size_t)pi * 32 + e);
                        const f32x4 x1 = acc[ai][bj][m][0], x2 = acc[ai][bj][m][1];
                        float o1[4], o2[4];
                        o1[0] = x1[0] * cs.x - x2[0] * sn.x; o2[0] = x1[0] * sn.x + x2[0] * cs.x;
                        o1[1] = x1[1] * cs.y - x2[1] * sn.y; o2[1] = x1[1] * sn.y + x2[1] * cs.y;
                        o1[2] = x1[2] * cs.z - x2[2] * sn.z; o2[2] = x1[2] * sn.z + x2[2] * cs.z;
                        o1[3] = x1[3] * cs.w - x2[3] * sn.w; o2[3] = x1[3] * sn.w + x2[3] * cs.w;
                        const int col = unit * 256 + hu * 64 + e;
                        if (isq) {
                            uint2 a, c2; a.x = pk2(o1[0] * 0.125f, o1[1] * 0.125f); a.y = pk2(o1[2] * 0.125f, o1[3] * 0.125f); c2.x = pk2(o2[0] * 0.125f, o2[1] * 0.125f); c2.y = pk2(o2[2] * 0.125f, o2[3] * 0.125f);
                            *(uint2*)(Q + (size_t)rowB * 512 + col) = a; *(uint2*)(Q + (size_t)rowB * 512 + col + 32) = c2;
                        } else {
                            uint2 a, c2; a.x = pk2(o1[0], o1[1]); a.y = pk2(o1[2], o1[3]); c2.x = pk2(o2[0], o2[1]); c2.y = pk2(o2[2], o2[3]);
                            *(uint2*)(K + (size_t)rowB * 512 + col) = a; *(uint2*)(K + (size_t)rowB * 512 + col + 32) = c2;
                            float* dst = nullptr;
                            if (prompt) { if (t >= 2048) dst = out + O_PK + ((size_t)b * 2048 + (t - 2048)) * 512 + col; }
                            else dst = snewk + (size_t)(b * TS + t) * 512 + col;
                            if (dst) { *(float4*)dst = make_float4(o1[0], o1[1], o1[2], o1[3]); *(float4*)(dst + 32) = make_float4(o2[0], o2[1], o2[2], o2[3]); }
                        }
                    }
                } else {
#pragma unroll
                    for (int bj = 0; bj < 2; ++bj)
#pragma unroll
                        for (int n = 0; n < 2; ++n) {
                            const int col = (pn - 11) * 256 + bj * 128 + wc * 32 + n * 16 + 4 * fq; const f32x4 v = acc[ai][bj][m][n];
                            if (prompt) {
                                if (t >= 2048) *(float4*)(out + O_PV + ((size_t)b * 2048 + (t - 2048)) * 512 + col) = make_float4(v[0], v[1], v[2], v[3]);
                                uint2 o; o.x = pk2(v[0], v[1]); o.y = pk2(v[2], v[3]); *(uint2*)(VT1 + (size_t)rowB * 512 + col) = o;
                            } else {
                                *(float4*)(snewv + (size_t)(b * TS + t) * 512 + col) = make_float4(v[0], v[1], v[2], v[3]);
                            }
                        }
                }
            }
    }
};
struct EpiBf16S {
    static constexpr bool PERM = false, AFTER_DRAIN = false;
    bf16_t* O; int ldc;
    __device__ __forceinline__ void operator()(const f32x4 (&acc)[2][2][4][2], const pg8::Unit& u, int wr, int wc, int fr, int fq) const {
#pragma unroll
        for (int ai = 0; ai < 2; ++ai)
#pragma unroll
            for (int m = 0; m < 4; ++m) { bf16_t* rp = O + (size_t)(u.pm * 256 + ai * 128 + wr * 64 + m * 16 + fr) * ldc + u.pn * 256 + wc * 32 + 4 * fq;
#pragma unroll
                for (int bj = 0; bj < 2; ++bj)
#pragma unroll
                    for (int n = 0; n < 2; ++n) { const f32x4 v = acc[ai][bj][m][n]; uint2 o; o.x = pk2(v[0], v[1]); o.y = pk2(v[2], v[3]); *(uint2*)(rp + bj * 128 + n * 16) = o; } }
    }
};
struct EpiDag {
    static constexpr bool PERM = false, AFTER_DRAIN = false;
    bf16_t* dag; const float* w0; const float* a0;
    __device__ __forceinline__ void operator()(const f32x4 (&acc)[2][2][4][2], const pg8::Unit& u, int wr, int wc, int fr, int fq) const {
        const int kind = u.pn >> 1;
#pragma unroll
        for (int bj = 0; bj < 2; ++bj)
#pragma unroll
            for (int n = 0; n < 2; ++n) {
                const int col = u.pn * 256 + bj * 128 + wc * 32 + n * 16 + 4 * fq;
                float4 bias = make_float4(0.f, 0.f, 0.f, 0.f);
                if (kind == 0) bias = *(const float4*)(w0 + col); else if (kind == 1) bias = *(const float4*)(a0 + col - 512);
                const float bb[4] = {bias.x, bias.y, bias.z, bias.w};
#pragma unroll
                for (int ai = 0; ai < 2; ++ai)
#pragma unroll
                    for (int m = 0; m < 4; ++m) { const int row = u.pm * 256 + ai * 128 + wr * 64 + m * 16 + fr; const f32x4 v = acc[ai][bj][m][n]; float o[4];
#pragma unroll
                        for (int j = 0; j < 4; ++j) { const float x = v[j] + bb[j];
                            if (kind == 0) o[j] = -0.60653065971263342f * sigmoidf_(x);
                            else if (kind == 1) o[j] = sigmoidf_(x);
                            else o[j] = x; }
                        uint2 q; q.x = pk2(o[0], o[1]); q.y = pk2(o[2], o[3]); *(uint2*)(dag + (size_t)row * NLORA + col) = q; }
            }
    }
};
struct EpiUp {
    static constexpr bool PERM = false, AFTER_DRAIN = false;
    bf16_t* U; bf16_t* halo; float* out;
    __device__ __forceinline__ void operator()(const f32x4 (&acc)[2][2][4][2], const pg8::Unit& u, int wr, int wc, int fr, int fq) const {
#pragma unroll
        for (int ai = 0; ai < 2; ++ai)
#pragma unroll
            for (int m = 0; m < 4; ++m) {
                const int row = u.pm * 256 + ai * 128 + wr * 64 + m * 16 + fr; const int col0 = u.pn * 256 + wc * 32 + 4 * fq;
                bf16_t* hrow = nullptr; float* frow = nullptr;
                if (row < MP) { const int t = row & (TP - 1);
                    if ((t & 31) >= 30) hrow = halo + ((size_t)((row >> 5) + 1) * 2 + ((t & 31) - 30)) * FF2;
                    if (t >= TP - 2) frow = out + O_PCONV + ((size_t)(row >> 12) * 2 + (t - (TP - 2))) * FF2;
                } else { const int s = row - MP, b = s >> 3, tt = s & 7; if (tt >= 6) frow = out + O_SCONV + ((size_t)b * 2 + (tt - 6)) * FF2; }
#pragma unroll
                for (int bj = 0; bj < 2; ++bj)
#pragma unroll
                    for (int n = 0; n < 2; ++n) { const f32x4 v = acc[ai][bj][m][n]; const int col = col0 + bj * 128 + n * 16;
                        uint2 o; o.x = pk2(v[0], v[1]); o.y = pk2(v[2], v[3]);
                        *(uint2*)(U + (size_t)row * FF2 + col) = o;
                        if (hrow) *(uint2*)(hrow + col) = o;
                        if (frow) *(float4*)(frow + col) = make_float4(v[0], v[1], v[2], v[3]); }
            }
    }
};

struct EpiUpAct {
    static constexpr bool PERM = false, AFTER_DRAIN = false;
    bf16_t* ACT; float* out; const float* cw; const float* cb; const float* sconv; LAS float* xch;
    __device__ __forceinline__ void operator()(const f32x4 (&acc)[2][2][4][2], const pg8::Unit& u, int wr, int wc, int fr, int fq) const {
        const int lane = fq * 16 + fr, wid = wr * 4 + wc;
        if (fr >= 14) {
#pragma unroll
            for (int ai = 0; ai < 2; ++ai)
#pragma unroll
                for (int bj = 0; bj < 2; ++bj)
#pragma unroll
                    for (int n = 0; n < 2; ++n) *(LAS f32x4*)(xch + ((wid * 2 + ai) * 2 + (fr - 14)) * 64 + (bj * 2 + n) * 16 + 4 * fq) = acc[ai][bj][3][n];
        }
        asm volatile("s_waitcnt lgkmcnt(0)" ::: "memory");
        __builtin_amdgcn_s_barrier(); __builtin_amdgcn_s_barrier();
        asm volatile("" ::: "memory");
#pragma unroll
        for (int bj = 0; bj < 2; ++bj) {
            const int e = 64 * bj + 16 * wc + 4 * fq, gcol = 128 * u.pn + e, ucol = FF + gcol;
            const float4 wg0 = *(const float4*)(cw + gcol), wg1 = *(const float4*)(cw + FF2 + gcol), wg2 = *(const float4*)(cw + 2 * FF2 + gcol), bg = *(const float4*)(cb + gcol);
            const float4 wu0 = *(const float4*)(cw + ucol), wu1 = *(const float4*)(cw + FF2 + ucol), wu2 = *(const float4*)(cw + 2 * FF2 + ucol), bu = *(const float4*)(cb + ucol);
            const float w0g[4] = {wg0.x, wg0.y, wg0.z, wg0.w}, w1g[4] = {wg1.x, wg1.y, wg1.z, wg1.w}, w2g[4] = {wg2.x, wg2.y, wg2.z, wg2.w}, bgg[4] = {bg.x, bg.y, bg.z, bg.w};
            const float w0u[4] = {wu0.x, wu0.y, wu0.z, wu0.w}, w1u[4] = {wu1.x, wu1.y, wu1.z, wu1.w}, w2u[4] = {wu2.x, wu2.y, wu2.z, wu2.w}, buu[4] = {bu.x, bu.y, bu.z, bu.w};
#pragma unroll
            for (int ai = 0; ai < 2; ++ai) {
                const int swr = wr ^ 1, sai = (wr == 1) ? ai : 0;
                const LAS float* xs = xch + (((swr * 4 + wc) * 2 + sai) * 2) * 64 + (bj * 2) * 16 + 4 * fq;
                f32x4 pg1 = *(const LAS f32x4*)(xs + 64), pg2 = *(const LAS f32x4*)(xs), pu1 = *(const LAS f32x4*)(xs + 64 + 16), pu2 = *(const LAS f32x4*)(xs + 16);
                f32x4 g1p = pg1, g2p = (fr == 1) ? pg1 : pg2, u1p = pu1, u2p = (fr == 1) ? pu1 : pu2;
#pragma unroll
                for (int m = 0; m < 4; ++m) {
                    const int r = 128 * ai + 64 * wr + 16 * m + fr; const int R = UP_STEP * u.pm - 2 + r;
                    const f32x4 gc = acc[ai][bj][m][0], uc = acc[ai][bj][m][1];
                    f32x4 g1r, g2r, u1r, u2r;
#pragma unroll
                    for (int j = 0; j < 4; ++j) { g1r[j] = dpp_ror<1>(gc[j]); g2r[j] = dpp_ror<2>(gc[j]); u1r[j] = dpp_ror<1>(uc[j]); u2r[j] = dpp_ror<2>(uc[j]); }
                    f32x4 g1 = (fr >= 1) ? g1r : g1p, g2 = (fr >= 2) ? g2r : g2p, u1 = (fr >= 1) ? u1r : u1p, u2 = (fr >= 2) ? u2r : u2p;
                    g1p = g1r; g2p = g2r; u1p = u1r; u2p = u2r;
                    const bool emit = (r >= 2) && (R < MB);
                    if (emit) {
                        float* frow = nullptr;
                        if (R < MP) { const int t = R & (TP - 1);
                            if (t == 0) { g1 = (f32x4){0.f, 0.f, 0.f, 0.f}; u1 = g1; }
                            if (t <= 1) { g2 = (f32x4){0.f, 0.f, 0.f, 0.f}; u2 = g2; }
                            if (t >= TP - 2) frow = out + O_PCONV + ((size_t)(R >> 12) * 2 + (t - (TP - 2))) * FF2;
                        } else { const int s = R - MP, b = s >> 3, tt = s & 7; const float* sp = sconv + (size_t)b * 2 * FF2;
                            if (tt == 0) { const float4 a = *(const float4*)(sp + FF2 + gcol), c = *(const float4*)(sp + FF2 + ucol); g1 = (f32x4){a.x, a.y, a.z, a.w}; u1 = (f32x4){c.x, c.y, c.z, c.w}; }
                            if (tt <= 1) { const float4 a = *(const float4*)(sp + (tt == 0 ? 0 : FF2) + gcol), c = *(const float4*)(sp + (tt == 0 ? 0 : FF2) + ucol); g2 = (f32x4){a.x, a.y, a.z, a.w}; u2 = (f32x4){c.x, c.y, c.z, c.w}; }
                            if (tt >= 6) frow = out + O_SCONV + ((size_t)b * 2 + (tt - 6)) * FF2;
                        }
                        float o[4];
#pragma unroll
                        for (int j = 0; j < 4; ++j) { const float cgv = w0g[j] * g2[j] + w1g[j] * g1[j] + w2g[j] * gc[j] + bgg[j], cuv = w0u[j] * u2[j] + w1u[j] * u1[j] + w2u[j] * uc[j] + buu[j];
                            o[j] = cgv * sigmoidf_(cgv) * cuv; }
                        uint2 w; w.x = pk2(o[0], o[1]); w.y = pk2(o[2], o[3]);
                        *(uint2*)(ACT + (size_t)R * FF + gcol) = w;
                        if (frow) { *(float4*)(frow + gcol) = make_float4(gc[0], gc[1], gc[2], gc[3]); *(float4*)(frow + ucol) = make_float4(uc[0], uc[1], uc[2], uc[3]); }
                    }
                }
            }
        }
    }
};

__device__ __forceinline__ int rowA_of(int rowB) { return rowB < MP ? rowB : MP + ((rowB - MP) >> 3) * 9 + 1 + ((rowB - MP) & 7); }
__device__ __forceinline__ void phase_alora(const Params& p, int tid, int G, int bid) {
    const bf16_t* PR = (const bf16_t*)(p.ws + WS_PROJRW); bf16_t* AL = (bf16_t*)(p.ws + WS_ALORA); const float* mu = p.in[I_MU];
    const int gt = bid * NTHREADS + tid, NT = G * NTHREADS;
    for (int i = gt; i < MB * 64; i += NT) {
        const int rowB = i >> 6, c = (i & 63) * 4, rowA = rowA_of(rowB);
        const uint2 cur = *(const uint2*)(PR + (size_t)rowA * RCOLS + 1536 + c);
        uint2 prv = make_uint2(0u, 0u);
        if (!(rowB < MP && (rowB & (TP - 1)) == 0)) prv = *(const uint2*)(PR + (size_t)(rowA - 1) * RCOLS + 1536 + c);
        const float4 m4 = *(const float4*)(mu + 1536 + c);
        float x[4] = {bflo(cur.x), bfhi(cur.x), bflo(cur.y), bfhi(cur.y)}; const float pv[4] = {bflo(prv.x), bfhi(prv.x), bflo(prv.y), bfhi(prv.y)}; const float mm[4] = {m4.x, m4.y, m4.z, m4.w};
#pragma unroll
        for (int j = 0; j < 4; ++j) { float v = x[j] + (pv[j] - x[j]) * mm[j];
            if (c < 64) v = 1.f - 2.f * __builtin_amdgcn_rcpf(1.f + __expf(2.f * v)); else if (c >= 128) v = sigmoidf_(v);
            x[j] = v; }
        uint2 o; o.x = pk2(x[0], x[1]); o.y = pk2(x[2], x[3]);
        *(uint2*)(AL + (size_t)rowB * KLORA + c) = o;
    }
}


__device__ __forceinline__ void phase_vtrans(const Params& p, LAS unsigned char* lds, int tid, int G, int bid) {
    const bf16_t* VR = (const bf16_t*)(p.ws + WS_VROW);
    constexpr int PITCH = 132;
    for (int item = bid; item < BP * 8 * 8; item += G) {
        const int b = item >> 6, h = (item >> 3) & 7, t0 = (item & 7) * 512;
        __syncthreads();
#pragma unroll
        for (int i = 0; i < 8; ++i) { const int piece = tid + 512 * i, row = piece >> 3, c8 = piece & 7;
            const uint4 v = *(const uint4*)(VR + (size_t)(b * TP + t0 + row) * 512 + h * 64 + c8 * 8);
            LAS u32* dst = (LAS u32*)(lds + row * PITCH + c8 * 16); dst[0] = v.x; dst[1] = v.y; dst[2] = v.z; dst[3] = v.w; }
        __syncthreads();
#pragma unroll 1
        for (int lay = 0; lay < 3; ++lay) {
            const int dd = lay == 0 ? 1 : (lay == 1 ? 4 : 16); const int Tdd = TP / dd;
            bf16_t* VT = (bf16_t*)(p.ws + (lay == 0 ? WS_VT1 : (lay == 1 ? WS_VT4 : WS_VT16))) + (size_t)(b * 8 + h) * 64 * TP;
            const int chunk0 = (t0 / dd) >> 5;
#pragma unroll
            for (int i = 0; i < 4; ++i) {
                const int sidx = tid + 512 * i, g = sidx & 3, dp = (sidx >> 2) & 31, rc = sidx >> 7;
                int r, cl; if (lay == 0) { r = 0; cl = rc; } else if (lay == 1) { r = rc & 3; cl = rc >> 2; } else { r = rc; cl = 0; }
                u32 wlo[4], whi[4];
#pragma unroll
                for (int hf = 0; hf < 2; ++hf)
#pragma unroll
                    for (int jp = 0; jp < 2; ++jp) {
                        const int u5a = 16 * hf + 4 * g + 2 * jp; const int ta = (32 * cl + u5a) * dd + r, tb = ta + dd;
                        const u32 wa = *(const LAS u32*)(lds + ta * PITCH + dp * 4), wb = *(const LAS u32*)(lds + tb * PITCH + dp * 4);
                        wlo[hf * 2 + jp] = (wa & 0xffffu) | (wb << 16); whi[hf * 2 + jp] = (wa >> 16) | (wb & 0xffff0000u);
                    }
                bf16_t* dst = VT + (size_t)r * Tdd * 64 + (size_t)(chunk0 + cl) * 2048 + (2 * dp) * 32 + 8 * g;
                *(uint4*)dst = make_uint4(wlo[0], wlo[1], wlo[2], wlo[3]); *(uint4*)(dst + 32) = make_uint4(whi[0], whi[1], whi[2], whi[3]);
            }
        }
    }
    __syncthreads();
}

constexpr int CH = 32;
constexpr int SST = 452;
constexpr int SI_W = 0, SI_A = 64, SI_B = 128, SI_K = 192, SI_WR = 256, SI_V = 320, SI_G = 384, SI_SC = 448;
struct PrepRegs { uint2 cr, ck, cv, pr, pk, pv, dw, da, dg; };
__device__ __forceinline__ void scan_item(const Params& p, LAS unsigned char* lds, int tid, bool sample, int b, int h, int half) {
    const bf16_t* PR = (const bf16_t*)(p.ws + WS_PROJRW); const bf16_t* DAG = (const bf16_t*)((const unsigned char*)p.out + SC_B);
    float* YG = (float*)(p.ws + WS_Y);
    LAS float* buf0 = (LAS float*)lds; LAS float* buf1 = buf0 + CH * SST; LAS float* ybuf = buf1 + CH * SST;
    const int T = sample ? TS : TP;
    const int rowB0 = sample ? MP + b * TS : b * TP;
    const int rowA0 = sample ? MP + b * 9 + 1 : b * TP;
    const int nch = (T + CH - 1) / CH;
    const int ptl = tid >> 4, pj = (tid & 15) * 4, pc = h * 64 + pj;
    const int lane = tid & 63, wv = tid >> 6, rg = wv * 4 + (lane >> 4), cgi = lane & 15;
    const int row = 32 * half + rg;
    float st[4];
    if (sample) {
        const float4 a = *(const float4*)(p.in[I_SWKV] + ((size_t)(b * 8 + h) * 64 + row) * 64 + 4 * cgi);
        st[0] = a.x; st[1] = a.y; st[2] = a.z; st[3] = a.w;
    } else {
#pragma unroll
        for (int j = 0; j < 4; ++j) st[j] = 0.f;
    }
    const float4 mur = *(const float4*)(p.in[I_MU] + pc), muk = *(const float4*)(p.in[I_MU] + 512 + pc), muv = *(const float4*)(p.in[I_MU] + 1024 + pc);
    const float4 kk4 = *(const float4*)(p.in[I_KK] + pc), ka4 = *(const float4*)(p.in[I_KA] + pc), rk4 = *(const float4*)(p.in[I_RK] + pc);
    __builtin_amdgcn_s_waitcnt(0x0F70);
    PrepRegs R;
#define SCAN_LOAD(chunk) do { const int t_ = (chunk) * CH + ptl; if (t_ < T) { const size_t ra = (size_t)(rowA0 + t_) * RCOLS + pc; const size_t rb = (size_t)(rowB0 + t_) * NLORA + pc; \
        R.cr = *(const uint2*)(PR + ra); R.ck = *(const uint2*)(PR + ra + 512); R.cv = *(const uint2*)(PR + ra + 1024); \
        if (!sample && t_ == 0) { R.pr = make_uint2(0u, 0u); R.pk = R.pr; R.pv = R.pr; } \
        else { R.pr = *(const uint2*)(PR + ra - RCOLS); R.pk = *(const uint2*)(PR + ra - RCOLS + 512); R.pv = *(const uint2*)(PR + ra - RCOLS + 1024); } \
        R.dw = *(const uint2*)(DAG + rb); R.da = *(const uint2*)(DAG + rb + 512); R.dg = *(const uint2*)(DAG + rb + 1024); } } while (0)
#define SCAN_PREP(chunk, dstbuf) do { const int t_ = (chunk) * CH + ptl; if (t_ < T) { \
        const float mr[4] = {mur.x, mur.y, mur.z, mur.w}, mk[4] = {muk.x, muk.y, muk.z, muk.w}, mv[4] = {muv.x, muv.y, muv.z, muv.w}; \
        const float kkc[4] = {kk4.x, kk4.y, kk4.z, kk4.w}, kac[4] = {ka4.x, ka4.y, ka4.z, ka4.w}, rkc[4] = {rk4.x, rk4.y, rk4.z, rk4.w}; \
        const float crr[4] = {bflo(R.cr.x), bfhi(R.cr.x), bflo(R.cr.y), bfhi(R.cr.y)}, ckk[4] = {bflo(R.ck.x), bfhi(R.ck.x), bflo(R.ck.y), bfhi(R.ck.y)}, cvv[4] = {bflo(R.cv.x), bfhi(R.cv.x), bflo(R.cv.y), bfhi(R.cv.y)}; \
        const float prr[4] = {bflo(R.pr.x), bfhi(R.pr.x), bflo(R.pr.y), bfhi(R.pr.y)}, pkk[4] = {bflo(R.pk.x), bfhi(R.pk.x), bflo(R.pk.y), bfhi(R.pk.y)}, pvv[4] = {bflo(R.pv.x), bfhi(R.pv.x), bflo(R.pv.y), bfhi(R.pv.y)}; \
        const float lw[4] = {bflo(R.dw.x), bfhi(R.dw.x), bflo(R.dw.y), bfhi(R.dw.y)}, aa[4] = {bflo(R.da.x), bfhi(R.da.x), bflo(R.da.y), bfhi(R.da.y)}, gg[4] = {bflo(R.dg.x), bfhi(R.dg.x), bflo(R.dg.y), bfhi(R.dg.y)}; \
        float r_[4], k_[4], v_[4], w_[4], kn[4], k2[4]; float nrm = 0.f; \
        _Pragma("unroll") for (int j = 0; j < 4; ++j) { r_[j] = crr[j] + (prr[j] - crr[j]) * mr[j]; k_[j] = ckk[j] + (pkk[j] - ckk[j]) * mk[j]; v_[j] = cvv[j] + (pvv[j] - cvv[j]) * mv[j]; \
            w_[j] = __expf(lw[j]); kn[j] = k_[j] * kkc[j]; nrm += kn[j] * kn[j]; k2[j] = k_[j] * (1.f + (aa[j] - 1.f) * kac[j]); } \
        nrm = row16_sum(nrm); const float inv = __builtin_amdgcn_rsqf(fmaxf(nrm, 1e-24f)); \
        float br = 0.f, kr = 0.f, rk = 0.f; float an[4], bn[4], wrr[4]; \
        _Pragma("unroll") for (int j = 0; j < 4; ++j) { const float kkn = kn[j] * inv; an[j] = -kkn; bn[j] = kkn * aa[j]; wrr[j] = w_[j] * r_[j]; br += bn[j] * r_[j]; kr += k2[j] * r_[j]; rk += r_[j] * k2[j] * rkc[j]; } \
        br = row16_sum(br); kr = row16_sum(kr); rk = row16_sum(rk); \
        LAS float* rec = (dstbuf) + ptl * SST; \
        *(LAS f32x4*)(rec + SI_W + pj) = (f32x4){w_[0], w_[1], w_[2], w_[3]}; *(LAS f32x4*)(rec + SI_A + pj) = (f32x4){an[0], an[1], an[2], an[3]}; \
        *(LAS f32x4*)(rec + SI_B + pj) = (f32x4){bn[0], bn[1], bn[2], bn[3]}; *(LAS f32x4*)(rec + SI_K + pj) = (f32x4){k2[0], k2[1], k2[2], k2[3]}; \
        *(LAS f32x4*)(rec + SI_WR + pj) = (f32x4){wrr[0], wrr[1], wrr[2], wrr[3]}; *(LAS f32x4*)(rec + SI_V + pj) = (f32x4){v_[0], v_[1], v_[2], v_[3]}; \
        *(LAS f32x4*)(rec + SI_G + pj) = (f32x4){gg[0], gg[1], gg[2], gg[3]}; \
        if ((tid & 15) == 0) *(LAS f32x4*)(rec + SI_SC) = (f32x4){br, kr, rk, 0.f}; } } while (0)

    SCAN_LOAD(0);
    SCAN_PREP(0, buf0);
    __syncthreads();
    for (int c = 0; c < nch; ++c) {
        LAS float* cur = (c & 1) ? buf1 : buf0; LAS float* nxt = (c & 1) ? buf0 : buf1;
        if (c + 1 < nch) SCAN_LOAD(c + 1);
        const int ns = (T - c * CH) < CH ? (T - c * CH) : CH;
        {
            const LAS float* rec = cur;
            f32x4 wA = *(const LAS f32x4*)(rec + SI_W + 4 * cgi), aA = *(const LAS f32x4*)(rec + SI_A + 4 * cgi), bA = *(const LAS f32x4*)(rec + SI_B + 4 * cgi);
            f32x4 kA = *(const LAS f32x4*)(rec + SI_K + 4 * cgi), rA = *(const LAS f32x4*)(rec + SI_WR + 4 * cgi);
            float vA = rec[SI_V + row]; pg8::f32x2 cA = *(const LAS pg8::f32x2*)(rec + SI_SC);
            f32x4 wB, aB, bB, kB, rB; float vB; pg8::f32x2 cB;
#define SCAN_FETCH(W, A, B, K, R, V, C) do { rec += SST; W = *(const LAS f32x4*)(rec + SI_W + 4 * cgi); A = *(const LAS f32x4*)(rec + SI_A + 4 * cgi); B = *(const LAS f32x4*)(rec + SI_B + 4 * cgi); \
            K = *(const LAS f32x4*)(rec + SI_K + 4 * cgi); R = *(const LAS f32x4*)(rec + SI_WR + 4 * cgi); V = rec[SI_V + row]; C = *(const LAS pg8::f32x2*)(rec + SI_SC); } while (0)
#define SCAN_STEP(W, A, B, K, R, V, C, qq) do { \
            float da = mul_(st[0], A[0]), da2 = mul_(st[2], A[2]); float dw = mul_(st[0], R[0]), dw2 = mul_(st[2], R[2]); \
            da = fma_(st[1], A[1], da); da2 = fma_(st[3], A[3], da2); dw = fma_(st[1], R[1], dw); dw2 = fma_(st[3], R[3], dw2); da += da2; dw += dw2; \
            float tt_[4]; row16_sum2_mul4(da, dw, tt_, V, K[0], K[1], K[2], K[3]); \
            const float y = fma_(V, C[1], fma_(da, C[0], dw)); \
            _Pragma("unroll") for (int j = 0; j < 4; ++j) st[j] = fma_(st[j], W[j], fma_(da, B[j], tt_[j])); \
            yk = ((qq) == cgi) ? y : yk; } while (0)
            for (int tb = 0; tb < ns; tb += 16) {
                const int nq = (ns - tb) < 16 ? (ns - tb) : 16;
                float yk = 0.f;
                for (int q = 0; q < nq; q += 2) {
                    SCAN_FETCH(wB, aB, bB, kB, rB, vB, cB);
                    SCAN_STEP(wA, aA, bA, kA, rA, vA, cA, q);
                    SCAN_FETCH(wA, aA, bA, kA, rA, vA, cA);
                    SCAN_STEP(wB, aB, bB, kB, rB, vB, cB, q + 1);
                }
                ybuf[(tb + cgi) * 32 + rg] = yk;
            }
#undef SCAN_FETCH
#undef SCAN_STEP
        }
        __syncthreads();
        if (ptl < ns) {
            const pg8::f32x2 y2 = *(const LAS pg8::f32x2*)(ybuf + ptl * 32 + 2 * (tid & 15));
            *(float2*)(YG + (size_t)(rowB0 + c * CH + ptl) * 512 + h * 64 + 32 * half + 2 * (tid & 15)) = make_float2(y2[0], y2[1]);
        }
        if (c + 1 < nch) SCAN_PREP(c + 1, nxt);
        __syncthreads();
    }
#undef SCAN_LOAD
#undef SCAN_PREP
    float* So = p.out + (sample ? O_SWKV : O_PWKV) + ((size_t)(b * 8 + h) * 64 + row) * 64 + 4 * cgi;
    *(float4*)So = make_float4(st[0], st[1], st[2], st[3]);
}

__device__ __forceinline__ void phase_wkvfin(const Params& p, int tid, int G, int bid) {
    const bf16_t* PR = (const bf16_t*)(p.ws + WS_PROJRW); const bf16_t* DAG = (const bf16_t*)((const unsigned char*)p.out + SC_B);
    const float* YG = (const float*)(p.ws + WS_Y); bf16_t* MIX = (bf16_t*)((unsigned char*)p.out + SC_C);
    const int gt = bid * NTHREADS + tid, NT = G * NTHREADS;
    for (int i = gt; i < MB * 128; i += NT) {
        const int jq = i & 15, h = (i >> 4) & 7, rowB = i >> 7, pc = h * 64 + jq * 4, rowA = rowA_of(rowB);
        const size_t ra = (size_t)rowA * RCOLS + pc;
        const uint2 cr = *(const uint2*)(PR + ra), ck = *(const uint2*)(PR + ra + 512), cv = *(const uint2*)(PR + ra + 1024);
        uint2 pr = make_uint2(0u, 0u), pk = pr, pv = pr;
        if (!(rowB < MP && (rowB & (TP - 1)) == 0)) { pr = *(const uint2*)(PR + ra - RCOLS); pk = *(const uint2*)(PR + ra - RCOLS + 512); pv = *(const uint2*)(PR + ra - RCOLS + 1024); }
        const uint2 da = *(const uint2*)(DAG + (size_t)rowB * NLORA + 512 + pc), dg = *(const uint2*)(DAG + (size_t)rowB * NLORA + 1024 + pc);
        const float4 y4 = *(const float4*)(YG + (size_t)rowB * 512 + pc);
        const float4 mur = *(const float4*)(p.in[I_MU] + pc), muk = *(const float4*)(p.in[I_MU] + 512 + pc), muv = *(const float4*)(p.in[I_MU] + 1024 + pc);
        const float4 ka4 = *(const float4*)(p.in[I_KA] + pc), rk4 = *(const float4*)(p.in[I_RK] + pc), lw4 = *(const float4*)(p.in[I_LNW] + pc), lb4 = *(const float4*)(p.in[I_LNB] + pc);
        const float mr[4] = {mur.x, mur.y, mur.z, mur.w}, mk[4] = {muk.x, muk.y, muk.z, muk.w}, mv[4] = {muv.x, muv.y, muv.z, muv.w};
        const float kac[4] = {ka4.x, ka4.y, ka4.z, ka4.w}, rkc[4] = {rk4.x, rk4.y, rk4.z, rk4.w}, lw[4] = {lw4.x, lw4.y, lw4.z, lw4.w}, lb[4] = {lb4.x, lb4.y, lb4.z, lb4.w};
        const float crr[4] = {bflo(cr.x), bfhi(cr.x), bflo(cr.y), bfhi(cr.y)}, ckk[4] = {bflo(ck.x), bfhi(ck.x), bflo(ck.y), bfhi(ck.y)}, cvv[4] = {bflo(cv.x), bfhi(cv.x), bflo(cv.y), bfhi(cv.y)};
        const float prr[4] = {bflo(pr.x), bfhi(pr.x), bflo(pr.y), bfhi(pr.y)}, pkk[4] = {bflo(pk.x), bfhi(pk.x), bflo(pk.y), bfhi(pk.y)}, pvv[4] = {bflo(pv.x), bfhi(pv.x), bflo(pv.y), bfhi(pv.y)};
        const float aa[4] = {bflo(da.x), bfhi(da.x), bflo(da.y), bfhi(da.y)}, gg[4] = {bflo(dg.x), bfhi(dg.x), bflo(dg.y), bfhi(dg.y)};
        const float yy[4] = {y4.x, y4.y, y4.z, y4.w};
        float v_[4]; float rk = 0.f;
#pragma unroll
        for (int j = 0; j < 4; ++j) { const float r_ = crr[j] + (prr[j] - crr[j]) * mr[j], k_ = ckk[j] + (pkk[j] - ckk[j]) * mk[j]; v_[j] = cvv[j] + (pvv[j] - cvv[j]) * mv[j];
            const float k2 = k_ * (1.f + (aa[j] - 1.f) * kac[j]); rk += r_ * k2 * rkc[j]; }
        rk = row16_sum(rk);
        const float mean = row16_sum((yy[0] + yy[1]) + (yy[2] + yy[3])) * (1.f / 64.f);
        float d[4]; float vs = 0.f;
#pragma unroll
        for (int j = 0; j < 4; ++j) { d[j] = yy[j] - mean; vs += d[j] * d[j]; }
        const float rs = rsqrtf(row16_sum(vs) * (1.f / 64.f) + 64e-5f);
        float o[4];
#pragma unroll
        for (int j = 0; j < 4; ++j) o[j] = (d[j] * rs * lw[j] + lb[j] + rk * v_[j]) * gg[j];
        uint2 w; w.x = pk2(o[0], o[1]); w.y = pk2(o[2], o[3]);
        *(uint2*)(MIX + (size_t)rowB * D + pc) = w;
    }
}

__device__ __forceinline__ void attn_task(const Params& p, int task, int lane) {
    const bf16_t* Q = (const bf16_t*)(p.ws + WS_Q); const bf16_t* K = (const bf16_t*)(p.ws + WS_K);
    bf16_t* MIX = (bf16_t*)((unsigned char*)p.out + SC_C);
    const int b = task >> 11, h = (task >> 8) & 7, r16 = (task >> 4) & 15, ig = task & 15;
    const int li = lane & 15, g = lane >> 4;
    const int tq = r16 + 16 * (16 * ig + li);
    const bf16_t* qp = Q + (size_t)(b * TP + tq) * 512 + h * 64 + 8 * g;
    const bf16x8 qf0 = *(const bf16x8*)qp, qf1 = *(const bf16x8*)(qp + 32);
    float m_run = -1e30f, l_run = 0.f;
    f32x4 o[4];
#pragma unroll
    for (int i = 0; i < 4; ++i) o[i] = (f32x4){0.f, 0.f, 0.f, 0.f};
#pragma unroll 1
    for (int br = 0; br < 3; ++br) {
        int dd, r, uq0, Tdd; const bf16_t* VT;
        if (br == 0) { dd = 16; r = r16; uq0 = 16 * ig; Tdd = TP / 16; VT = (const bf16_t*)(p.ws + WS_VT16); }
        else if (br == 1) { dd = 4; r = r16 & 3; uq0 = (r16 >> 2) + 64 * ig; Tdd = TP / 4; VT = (const bf16_t*)(p.ws + WS_VT4); }
        else { dd = 1; r = 0; uq0 = r16 + 256 * ig; Tdd = TP; VT = (const bf16_t*)(p.ws + WS_VT1); }
        const int s = 16 / dd, uq = uq0 + s * li;
        int ulo = uq0 - 128; if (ulo < 0) ulo = 0; ulo &= ~31;
        const int uhi = uq0 + 15 * s;
        const bf16_t* Kb = K + ((size_t)b * TP + r) * 512 + h * 64 + 8 * g;
        const bf16_t* Vb = VT + (size_t)(b * 8 + h) * 64 * TP + (size_t)r * Tdd * 64 + li * 32 + 8 * g;
        bf16x8 kx0, kx1, ky0, ky1, vf[4];
        { const bf16_t* kx = Kb + (size_t)(ulo + li) * dd * 512; const bf16_t* ky = kx + (size_t)16 * dd * 512;
          kx0 = *(const bf16x8*)kx; kx1 = *(const bf16x8*)(kx + 32); ky0 = *(const bf16x8*)ky; ky1 = *(const bf16x8*)(ky + 32);
#pragma unroll
          for (int dt = 0; dt < 4; ++dt) vf[dt] = *(const bf16x8*)(Vb + (size_t)(ulo >> 5) * 2048 + dt * 512); }
#pragma unroll 1
        for (int kt = ulo; kt <= uhi; kt += 32) {
            const int ktn = (kt + 32 <= uhi) ? kt + 32 : kt;
            const bf16_t* nkx = Kb + (size_t)(ktn + li) * dd * 512; const bf16_t* nky = nkx + (size_t)16 * dd * 512;
            const bf16x8 nkx0 = *(const bf16x8*)nkx, nkx1 = *(const bf16x8*)(nkx + 32), nky0 = *(const bf16x8*)nky, nky1 = *(const bf16x8*)(nky + 32);
            bf16x8 nvf[4];
#pragma unroll
            for (int dt = 0; dt < 4; ++dt) nvf[dt] = *(const bf16x8*)(Vb + (size_t)(ktn >> 5) * 2048 + dt * 512);
            f32x4 sx = (f32x4){0.f, 0.f, 0.f, 0.f}, sy = (f32x4){0.f, 0.f, 0.f, 0.f};
            sx = __builtin_amdgcn_mfma_f32_16x16x32_bf16(kx0, qf0, sx, 0, 0, 0); sx = __builtin_amdgcn_mfma_f32_16x16x32_bf16(kx1, qf1, sx, 0, 0, 0);
            sy = __builtin_amdgcn_mfma_f32_16x16x32_bf16(ky0, qf0, sy, 0, 0, 0); sy = __builtin_amdgcn_mfma_f32_16x16x32_bf16(ky1, qf1, sy, 0, 0, 0);
            float sv[8]; bool ok[8]; float tmax = -1e30f;
#pragma unroll
            for (int j = 0; j < 4; ++j) { const int dx = uq - (kt + 4 * g + j), dy = dx - 16;
                ok[j] = (unsigned)dx <= 128u; ok[4 + j] = (unsigned)dy <= 128u; sv[j] = ok[j] ? sx[j] : -1e30f; sv[4 + j] = ok[4 + j] ? sy[j] : -1e30f;
                tmax = fmaxf(tmax, fmaxf(sv[j], sv[4 + j])); }
            tmax = fmaxf(tmax, __shfl_xor(tmax, 16)); tmax = fmaxf(tmax, __shfl_xor(tmax, 32));
            const float m_new = fmaxf(m_run, tmax), alpha = __expf(m_run - m_new);
            float pe[8]; float ps = 0.f;
#pragma unroll
            for (int j = 0; j < 8; ++j) { pe[j] = ok[j] ? __expf(sv[j] - m_new) : 0.f; ps += pe[j]; }
            l_run = l_run * alpha + ps; m_run = m_new;
            u32x4 pw; pw[0] = pk2(pe[0], pe[1]); pw[1] = pk2(pe[2], pe[3]); pw[2] = pk2(pe[4], pe[5]); pw[3] = pk2(pe[6], pe[7]);
            const bf16x8 pf = __builtin_bit_cast(bf16x8, pw);
#pragma unroll
            for (int dt = 0; dt < 4; ++dt) { o[dt] *= alpha; o[dt] = __builtin_amdgcn_mfma_f32_16x16x32_bf16(vf[dt], pf, o[dt], 0, 0, 0); }
            kx0 = nkx0; kx1 = nkx1; ky0 = nky0; ky1 = nky1;
#pragma unroll
            for (int dt = 0; dt < 4; ++dt) vf[dt] = nvf[dt];
        }
    }
    float lt = l_run; lt += __shfl_xor(lt, 16); lt += __shfl_xor(lt, 32);
    const float il = 1.f / lt;
    bf16_t* op = MIX + (size_t)(b * TP + tq) * D + 512 + h * 64 + 4 * g;
#pragma unroll
    for (int dt = 0; dt < 4; ++dt) { uint2 w; w.x = pk2(o[dt][0] * il, o[dt][1] * il); w.y = pk2(o[dt][2] * il, o[dt][3] * il); *(uint2*)(op + 16 * dt) = w; }
}
__device__ __forceinline__ void attn_sample_task(const Params& p, int task, int lane, LAS float* wl) {
    const bf16_t* Q = (const bf16_t*)(p.ws + WS_Q); const float* snewk = (const float*)(p.ws + WS_SNEWK); const float* snewv = (const float*)(p.ws + WS_SNEWV);
    const float* CK = p.in[I_CK]; const float* CV = p.in[I_CV];
    bf16_t* MIX = (bf16_t*)((unsigned char*)p.out + SC_C);
    const int b = task >> 6, h = (task >> 3) & 7, tt = task & 7;
    const int rowB = MP + b * TS + tt;
    asm volatile("s_waitcnt lgkmcnt(0)" ::: "memory");
    wl[lane] = bflo((u32)Q[(size_t)rowB * 512 + h * 64 + lane]);
    asm volatile("s_waitcnt lgkmcnt(0)" ::: "memory");
    float mx = -1e30f;
#pragma unroll 1
    for (int c = 0; c < 9; ++c) {
        const int br = c / 3, it = c - br * 3; const int dd = br == 0 ? 1 : (br == 1 ? 4 : 16); const int j = lane + 64 * it;
        const int jc = j <= 128 ? j : 128;
        const int idx = 2048 + tt - jc * dd;
        const float* kr = idx < 2048 ? CK + ((size_t)(b * 2048 + idx) * 8 + h) * 64 : snewk + (size_t)(b * TS + idx - 2048) * 512 + h * 64;
        float s = 0.f;
#pragma unroll
        for (int d4 = 0; d4 < 16; ++d4) { const float4 kv = *(const float4*)(kr + 4 * d4); const f32x4 qv = *(const LAS f32x4*)(wl + 4 * d4);
            s += kv.x * qv[0] + kv.y * qv[1] + kv.z * qv[2] + kv.w * qv[3]; }
        if (j > 128) s = -1e30f;
        wl[64 + c * 64 + lane] = s; mx = fmaxf(mx, s);
    }
#pragma unroll
    for (int o = 1; o < 64; o <<= 1) mx = fmaxf(mx, __shfl_xor(mx, o));
    asm volatile("s_waitcnt lgkmcnt(0)" ::: "memory");
    float ls = 0.f;
#pragma unroll 1
    for (int c = 0; c < 9; ++c) { const float s = wl[64 + c * 64 + lane]; const float e = s > -1e29f ? __expf(s - mx) : 0.f; wl[64 + c * 64 + lane] = e; ls += e; }
    ls = wave_sum(ls);
    asm volatile("s_waitcnt lgkmcnt(0)" ::: "memory");
    float acc = 0.f;
#pragma unroll 1
    for (int c = 0; c < 9; ++c) {
        const int br = c / 3, it = c - br * 3; const int dd = br == 0 ? 1 : (br == 1 ? 4 : 16); const int nj = it < 2 ? 64 : 1;
#pragma unroll 8
        for (int l2 = 0; l2 < nj; ++l2) {
            const int j = l2 + 64 * it; const int idx = 2048 + tt - j * dd;
            const float* vr = idx < 2048 ? CV + ((size_t)(b * 2048 + idx) * 8 + h) * 64 : snewv + (size_t)(b * TS + idx - 2048) * 512 + h * 64;
            acc += wl[64 + c * 64 + l2] * vr[lane];
        }
    }
    const float res = acc / ls;
    const float other = __shfl_xor(res, 1);
    if ((lane & 1) == 0) *(u32*)(MIX + (size_t)rowB * D + 512 + h * 64 + lane) = pk2(res, other);
}

__device__ __forceinline__ void phase_norm1(const Params& p, int tid, int G, int bid) {
    const int wave = tid >> 6, lane = tid & 63, gw = bid * 8 + wave, NGW = G * 8;
    const bf16_t* mix = (const bf16_t*)((const unsigned char*)p.out + SC_B); bf16_t* H2 = (bf16_t*)((unsigned char*)p.out + SC_C);
    for (int row = gw; row < MB; row += NGW) {
        const float* xrow = row < MP ? p.in[I_XP] + (size_t)row * D : p.in[I_XS] + (size_t)(row - MP) * D;
        const uint2* mr = (const uint2*)(mix + (size_t)row * D) + lane; const float4* xr = (const float4*)xrow + lane;
        float4 v[4], x[4]; float s = 0.f;
#pragma unroll
        for (int j = 0; j < 4; ++j) { const uint2 mm = mr[64 * j]; v[j] = make_float4(bflo(mm.x), bfhi(mm.x), bflo(mm.y), bfhi(mm.y)); x[j] = xr[64 * j]; s += (v[j].x * v[j].x + v[j].y * v[j].y) + (v[j].z * v[j].z + v[j].w * v[j].w); }
        const float rs = rsqrtf(wave_sum(s) * (1.f / D) + 1e-6f);
        float s2 = 0.f;
#pragma unroll
        for (int j = 0; j < 4; ++j) { const float4 gg = *((const float4*)p.in[I_NMPOST] + lane + 64 * j);
            x[j].x += v[j].x * rs * gg.x; x[j].y += v[j].y * rs * gg.y; x[j].z += v[j].z * rs * gg.z; x[j].w += v[j].w * rs * gg.w;
            s2 += (x[j].x * x[j].x + x[j].y * x[j].y) + (x[j].z * x[j].z + x[j].w * x[j].w);
            *((float4*)(p.out + (size_t)row * D) + lane + 64 * j) = x[j]; }
        const float rs2 = rsqrtf(wave_sum(s2) * (1.f / D) + 1e-6f);
#pragma unroll
        for (int j = 0; j < 4; ++j) { const float4 gg = *((const float4*)p.in[I_NFPRE] + lane + 64 * j);
            uint2 o; o.x = pk2(x[j].x * rs2 * gg.x, x[j].y * rs2 * gg.y); o.y = pk2(x[j].z * rs2 * gg.z, x[j].w * rs2 * gg.w);
            *((uint2*)(H2 + (size_t)(row + 2) * D) + lane + 64 * j) = o; }
    }
    for (int row = gw; row < 2 + (H2P_ROWS - MB - 2); row += NGW) {
        const int rr = row < 2 ? row : MB + row;
#pragma unroll
        for (int j = 0; j < 4; ++j) *((uint2*)(H2 + (size_t)rr * D) + lane + 64 * j) = make_uint2(0u, 0u);
    }
}
__device__ __forceinline__ void phase_act(const Params& p, int tid, int G, int bid) {
    const int wave = tid >> 6, lane = tid & 63, gw = bid * 8 + wave, NGW = G * 8;
    bf16_t* U = (bf16_t*)(p.ws + WS_U); const bf16_t* halo = (const bf16_t*)(p.ws + WS_HALO);
    const float* cw = p.in[I_CONVW]; const float* cb = p.in[I_CONVB];
    constexpr int NPI = (MP / 32) * 11, NSI = BS * 11;
    for (int it = gw; it < NPI + NSI; it += NGW) {
        const bool sample = it >= NPI; const int q = sample ? it - NPI : it; const int chunk = q / 11, cgp = q - chunk * 11;
        const int col = cgp * 256 + 4 * lane;
        const float4 wg0 = *(const float4*)(cw + col), wg1 = *(const float4*)(cw + FF2 + col), wg2 = *(const float4*)(cw + 2 * FF2 + col), bg = *(const float4*)(cb + col);
        const float4 wu0 = *(const float4*)(cw + FF + col), wu1 = *(const float4*)(cw + FF2 + FF + col), wu2 = *(const float4*)(cw + 2 * FF2 + FF + col), bu = *(const float4*)(cb + FF + col);
        float g2[4], g1[4], u2[4], u1[4];
        int row0, nrows;
        if (!sample) {
            row0 = chunk * 32; nrows = 32;
            if ((row0 & (TP - 1)) == 0) {
#pragma unroll
                for (int j = 0; j < 4; ++j) { g2[j] = 0.f; g1[j] = 0.f; u2[j] = 0.f; u1[j] = 0.f; }
            } else {
                const bf16_t* hp = halo + (size_t)chunk * 2 * FF2;
                const uint2 a = *(const uint2*)(hp + col), c2 = *(const uint2*)(hp + FF2 + col), e = *(const uint2*)(hp + FF + col), f = *(const uint2*)(hp + FF2 + FF + col);
                g2[0] = bflo(a.x); g2[1] = bfhi(a.x); g2[2] = bflo(a.y); g2[3] = bfhi(a.y); g1[0] = bflo(c2.x); g1[1] = bfhi(c2.x); g1[2] = bflo(c2.y); g1[3] = bfhi(c2.y);
                u2[0] = bflo(e.x); u2[1] = bfhi(e.x); u2[2] = bflo(e.y); u2[3] = bfhi(e.y); u1[0] = bflo(f.x); u1[1] = bfhi(f.x); u1[2] = bflo(f.y); u1[3] = bfhi(f.y);
            }
        } else {
            row0 = MP + chunk * TS; nrows = TS;
            const float* sp = p.in[I_SCONV] + (size_t)chunk * 2 * FF2;
            const float4 a = *(const float4*)(sp + col), c2 = *(const float4*)(sp + FF2 + col), e = *(const float4*)(sp + FF + col), f = *(const float4*)(sp + FF2 + FF + col);
            g2[0] = a.x; g2[1] = a.y; g2[2] = a.z; g2[3] = a.w; g1[0] = c2.x; g1[1] = c2.y; g1[2] = c2.z; g1[3] = c2.w;
            u2[0] = e.x; u2[1] = e.y; u2[2] = e.z; u2[3] = e.w; u1[0] = f.x; u1[1] = f.y; u1[2] = f.z; u1[3] = f.w;
        }
        const float w0g[4] = {wg0.x, wg0.y, wg0.z, wg0.w}, w1g[4] = {wg1.x, wg1.y, wg1.z, wg1.w}, w2g[4] = {wg2.x, wg2.y, wg2.z, wg2.w}, bgg[4] = {bg.x, bg.y, bg.z, bg.w};
        const float w0u[4] = {wu0.x, wu0.y, wu0.z, wu0.w}, w1u[4] = {wu1.x, wu1.y, wu1.z, wu1.w}, w2u[4] = {wu2.x, wu2.y, wu2.z, wu2.w}, buu[4] = {bu.x, bu.y, bu.z, bu.w};
        for (int r0 = 0; r0 < nrows; r0 += 8) {
            uint2 gv[8], uv[8];
#pragma unroll
            for (int i = 0; i < 8; ++i) { const bf16_t* rp = U + (size_t)(row0 + r0 + i) * FF2 + col; gv[i] = *(const uint2*)rp; uv[i] = *(const uint2*)(rp + FF); }
#pragma unroll
            for (int i = 0; i < 8; ++i) {
                const float gc[4] = {bflo(gv[i].x), bfhi(gv[i].x), bflo(gv[i].y), bfhi(gv[i].y)}, uc[4] = {bflo(uv[i].x), bfhi(uv[i].x), bflo(uv[i].y), bfhi(uv[i].y)};
                float o[4];
#pragma unroll
                for (int j = 0; j < 4; ++j) {
                    const float cgv = w0g[j] * g2[j] + w1g[j] * g1[j] + w2g[j] * gc[j] + bgg[j];
                    const float cuv = w0u[j] * u2[j] + w1u[j] * u1[j] + w2u[j] * uc[j] + buu[j];
                    o[j] = cgv * sigmoidf_(cgv) * cuv;
                    g2[j] = g1[j]; g1[j] = gc[j]; u2[j] = u1[j]; u1[j] = uc[j];
                }
                uint2 w; w.x = pk2(o[0], o[1]); w.y = pk2(o[2], o[3]);
                *(uint2*)(U + (size_t)(row0 + r0 + i) * FF2 + col) = w;
            }
        }
    }
}
__device__ __forceinline__ void phase_final(const Params& p, int tid, int G, int bid) {
    const int wave = tid >> 6, lane = tid & 63, gw = bid * 8 + wave, NGW = G * 8;
    const float* F = (const float*)(p.ws + WS_F);
    for (int row = gw; row < MB; row += NGW) {
        const float4* fr = (const float4*)(F + (size_t)row * D) + lane; float4* yr = (float4*)(p.out + (size_t)row * D) + lane;
        float4 v[4]; float s = 0.f;
#pragma unroll
        for (int j = 0; j < 4; ++j) { v[j] = fr[64 * j]; s += (v[j].x * v[j].x + v[j].y * v[j].y) + (v[j].z * v[j].z + v[j].w * v[j].w); }
        const float rs = rsqrtf(wave_sum(s) * (1.f / D) + 1e-6f);
#pragma unroll
        for (int j = 0; j < 4; ++j) { const float4 gg = *((const float4*)p.in[I_NFPOST] + lane + 64 * j); float4 x = yr[64 * j];
            x.x += v[j].x * rs * gg.x; x.y += v[j].y * rs * gg.y; x.z += v[j].z * rs * gg.z; x.w += v[j].w * rs * gg.w; yr[64 * j] = x; }
    }
}
__device__ __forceinline__ void phase_cachecopy(const Params& p, int tid, int G, int bid) {
    if (bid < 4) return;
    const int gt = (bid - 4) * NTHREADS + tid, NT = (G - 4) * NTHREADS;
    constexpr int PER_B = 2048 * 512 / 4;
    const float4* snk = (const float4*)(p.ws + WS_SNEWK); const float4* snv = (const float4*)(p.ws + WS_SNEWV);
    for (int i = gt; i < 2 * BS * PER_B; i += NT) {
        const int which = i >= BS * PER_B; const int q = which ? i - BS * PER_B : i; const int b = q / PER_B, r = q - b * PER_B;
        const float4* src = (const float4*)p.in[which ? I_CV : I_CK] + (size_t)b * PER_B;
        float4 v;
        if (r < 2040 * 128) v = src[r + 8 * 128]; else v = (which ? snv : snk)[(size_t)b * TS * 128 + (r - 2040 * 128)];
        ((float4*)(p.out + (which ? O_SV : O_SK)))[(size_t)b * PER_B + r] = v;
    }
}

template <int PH>
__device__ __forceinline__ void run_phase(const Params& p, LAS unsigned char* lds, int tid, int G, int bid) {
    if constexpr (PH == 0) { phase0(p, lds, tid, G, bid); __syncthreads(); }
    else if constexpr (PH == 1) {
        pg8::Gemm g{(const bf16_t*)((const unsigned char*)p.out + SC_B), (const bf16_t*)(p.ws + WS_WIN), MA, DIN, D, D, 256}; pg8::StaticOrder S; S.init(MA, DIN, G, bid);
        EpiProj E{(bf16_t*)(p.ws + WS_PROJRW), (bf16_t*)(p.ws + WS_Q), (bf16_t*)(p.ws + WS_K), (bf16_t*)(p.ws + WS_VROW), (bf16_t*)(p.ws + WS_VT4), (bf16_t*)(p.ws + WS_VT16),
                  (const float*)(p.ws + WS_ROPE), p.out, (float*)(p.ws + WS_SNEWK), (float*)(p.ws + WS_SNEWV)};
        pg8::gemm_phase<EpiProj, pg8::StaticOrder, false>(lds, g, S, E, nullptr);
    } else if constexpr (PH == 2) { phase_alora(p, tid, G, bid); phase_vtrans(p, lds, tid, G, bid); }
    else if constexpr (PH == 3) {
        pg8::Gemm g{(const bf16_t*)(p.ws + WS_ALORA), (const bf16_t*)(p.ws + WS_WLORA), MB, NLORA, KLORA, KLORA, 256}; pg8::StaticOrder S; S.init(MB, NLORA, G, bid);
        EpiDag E{(bf16_t*)((unsigned char*)p.out + SC_B), p.in[I_W0], p.in[I_A0]};
        pg8::gemm_phase<EpiDag, pg8::StaticOrder, false>(lds, g, S, E, nullptr);
    } else if constexpr (PH == 4 || PH == 11 || PH == 12) {
        const int NSCAN = 128;
        if (bid < NSCAN) {
            if constexpr (PH != 12) {
                scan_item(p, lds, tid, false, bid >> 4, (bid >> 1) & 7, bid & 1);
            }
        } else {
            if constexpr (PH != 12) for (int it = bid - NSCAN; it < 512; it += G - NSCAN) scan_item(p, lds, tid, true, it >> 4, (it >> 1) & 7, it & 1);
        }
        if (PH == 4 || (PH == 12 && bid >= NSCAN)) {
            const int wave = tid >> 6, lane = tid & 63, x = bid & 7;
            unsigned* ctr = (unsigned*)(p.ws + WS_BAR) + (PH == 4 ? 16 : 32) + x;
            for (;;) {
                unsigned id = 0; if (lane == 0) id = __hip_atomic_fetch_add(ctr, 1u, __ATOMIC_RELAXED, __HIP_MEMORY_SCOPE_AGENT);
                id = (unsigned)__builtin_amdgcn_readfirstlane((int)id);
                if (id >= 2048u + 256u) break;
                if (id < 2048u) { const int ig = id >> 7, hh = (id >> 4) & 7, r16 = id & 15; attn_task(p, (x << 11) | (hh << 8) | (r16 << 4) | ig, lane); }
                else { const int s = id - 2048; attn_sample_task(p, ((4 * x + (s >> 6)) << 6) | (s & 63), lane, (LAS float*)(lds + wave * 4096)); }
            }
        }
    } else if constexpr (PH == 5) {
        pg8::Gemm g{(const bf16_t*)((const unsigned char*)p.out + SC_C), (const bf16_t*)(p.ws + WS_WOUT), MB, D, D, D, 256}; pg8::StaticOrder S; S.init(MB, D, G, bid);
        EpiBf16S E{(bf16_t*)((unsigned char*)p.out + SC_B), D};
        pg8::gemm_phase<EpiBf16S, pg8::StaticOrder, false>(lds, g, S, E, nullptr);
    } else if constexpr (PH == 6) phase_norm1(p, tid, G, bid);
    else if constexpr (PH == 7) {
        pg8::Gemm g{(const bf16_t*)((const unsigned char*)p.out + SC_C), (const bf16_t*)(p.ws + WS_WUP), UP_TILES * 256, FF2, D, D, UP_STEP}; pg8::StaticOrder S; S.init(UP_TILES * 256, FF2, G, bid);
        EpiUpAct E{(bf16_t*)(p.ws + WS_U), p.out, p.in[I_CONVW], p.in[I_CONVB], p.in[I_SCONV], (LAS float*)(lds + 131072)};
        pg8::gemm_phase<EpiUpAct, pg8::StaticOrder, false>(lds, g, S, E, nullptr);
    } else if constexpr (PH == 8) phase_act(p, tid, G, bid);
    else if constexpr (PH == 9) {
        pg8::Gemm g{(const bf16_t*)(p.ws + WS_U), (const bf16_t*)(p.ws + WS_WDN), MB, D, FF, FF, 256}; pg8::StaticOrder S; S.init(MB, D, G, bid);
        pg8::EpiF32 E{(float*)(p.ws + WS_F), D, nullptr};
        pg8::gemm_phase<pg8::EpiF32, pg8::StaticOrder, false>(lds, g, S, E, nullptr);
        phase_cachecopy(p, tid, G, bid);
    } else if constexpr (PH == 10) { phase_final(p, tid, G, bid); }
    else if constexpr (PH == 13) phase_wkvfin(p, tid, G, bid);
}
__device__ __forceinline__ void grid_bar(unsigned* ctr, unsigned target) {
    asm volatile("s_waitcnt vmcnt(0)" ::: "memory");
    __syncthreads();
    if (threadIdx.x == 0) {
        __builtin_amdgcn_fence(__ATOMIC_RELEASE, "agent");
        asm volatile("s_waitcnt vmcnt(0)" ::: "memory");
        __hip_atomic_fetch_add(ctr, 1u, __ATOMIC_RELAXED, __HIP_MEMORY_SCOPE_AGENT);
        while (__hip_atomic_load(ctr, __ATOMIC_RELAXED, __HIP_MEMORY_SCOPE_AGENT) < target) __builtin_amdgcn_s_sleep(2);
        __builtin_amdgcn_fence(__ATOMIC_ACQUIRE, "agent");
        asm volatile("s_waitcnt vmcnt(0)" ::: "memory");
    }
    __syncthreads();
}
template <int SEAM, int FIRST, int... REST>
__device__ __forceinline__ void run_program(const Params& p, LAS unsigned char* lds, cg::grid_group& grid, int tid, int G, int bid) {
    if (p.en > (int)sizeof...(REST) - 1000) run_phase<FIRST>(p, lds, tid, G, bid);
    if constexpr (sizeof...(REST) > 0) {
        if constexpr (SEAM == 0) grid.sync(); else grid_bar((unsigned*)(p.ws + WS_BAR), (unsigned)(SEAM * G));
        run_program<SEAM + 1, REST...>(p, lds, grid, tid, G, bid);
    }
}
#define PROGRAM 0, 1, 2, 3, 4, 13, 5, 6, 7, 9, 10
__global__ void __launch_bounds__(NTHREADS, 2) hymba_fwd(Params p) {
    extern __shared__ __attribute__((aligned(16))) unsigned char lds_raw[];
    LAS unsigned char* lds = (LAS unsigned char*)lds_raw;
    cg::grid_group grid = cg::this_grid();
    run_program<0, PROGRAM>(p, lds, grid, threadIdx.x, gridDim.x, blockIdx.x);
}

extern "C" void kernel_launch(void* const* d_in, const int* in_sizes, int n_in, void* d_out, int out_size, void* d_ws, size_t ws_size, hipStream_t stream) {
    static int grid = 0;
    if (grid == 0) {
        if (n_in != 28 || (size_t)out_size != O_END || ws_size < WS_TOTAL) { fprintf(stderr, "kernel_launch: unexpected sizes n_in %d out %d ws %zu (need %zu)\n", n_in, out_size, ws_size, (size_t)WS_TOTAL); grid = -1; return; }
        int dev = 0, cus = 0, per_cu = 0;
        hipGetDevice(&dev); hipDeviceGetAttribute(&cus, hipDeviceAttributeMultiprocessorCount, dev);
        if (hipFuncSetAttribute((const void*)hymba_fwd, hipFuncAttributeMaxDynamicSharedMemorySize, LDS_BYTES) != hipSuccess) { fprintf(stderr, "kernel_launch: hipFuncSetAttribute failed\n"); grid = -1; return; }
        hipOccupancyMaxActiveBlocksPerMultiprocessor(&per_cu, (const void*)hymba_fwd, NTHREADS, LDS_BYTES);
        (void)hipGetLastError();
        if (per_cu < 1) per_cu = 1;
        grid = cus;
    }
    if (grid < 0) return;
    Params p{};
    for (int i = 0; i < 28; ++i) p.in[i] = (const float*)d_in[i];
    p.out = (float*)d_out; p.ws = (unsigned char*)d_ws; p.en = 1;
    if (hipMemsetAsync((unsigned char*)d_ws + WS_BAR, 0, 256, stream) != hipSuccess) { fprintf(stderr, "kernel_launch: memset of the barrier word failed\n"); return; }
    void* args[] = {&p};
    hipError_t e = hipLaunchCooperativeKernel((const void*)hymba_fwd, dim3(grid), dim3(NTHREADS), args, LDS_BYTES, stream);
    if (e != hipSuccess) fprintf(stderr, "cooperative launch failed: %s (grid %d)\n", hipGetErrorString(e), grid);
}
```

```cpp
#include <hip/hip_runtime.h>
#include <hip/hip_cooperative_groups.h>
#include <cstdio>
#include <cstdint>
namespace pg8 {
#define PG8_LAS __attribute__((address_space(3)))
typedef unsigned short bf16_t;
typedef short bf16x8 __attribute__((ext_vector_type(8)));
typedef float f32x4 __attribute__((ext_vector_type(4)));
typedef unsigned u32x4 __attribute__((ext_vector_type(4)));
constexpr int BM = 256, BK = 64, HALF = 128, HTB = HALF * BK * 2  , STAGE_BYTES = 8 * HTB, NXCD = 8, WGM = 8;

__host__ __device__ __forceinline__ int lds_byte(int r, int c) { const int st = (r >> 4) * 2 + (c >> 5), rr = r & 15, cc = c & 31, ob = rr * 64 + cc * 2; return st * 1024 + (ob ^ (((ob >> 9) & 1) << 5)); }
__host__ __device__ __forceinline__ void stage_rc(int b, int& R, int& C) { const int st = b / 1024, sb = b % 1024, swz = sb ^ (((sb >> 9) & 1) << 5); R = (st >> 1) * 16 + swz / 64; C = (st & 1) * 32 + (swz % 64) / 2; }
__host__ __device__ __forceinline__ int perm32(int rho) { const int n = rho >> 4, i = rho & 15; return 8 * (i >> 2) + 4 * n + (i & 3); }

struct Unit { int pm, pn; };
struct Gemm { const bf16_t* A; const bf16_t* Bt; int M, N, K, lda, tile_rows; };

struct StaticOrder {
    int nM, nN, nwg, G, c;
    __host__ __device__ void init(int M, int N, int G_, int c_) { nM = M / BM; nN = N / BM; nwg = nM * nN; G = G_; c = c_; }
    __host__ __device__ bool next(int i, Unit& u) const {
        const long L = (long)i * G + c; if (L >= nwg) return false;
        int wgid = (int)L; { const int q = nwg / NXCD, r = nwg % NXCD, xcd = wgid % NXCD, off = wgid / NXCD; wgid = (xcd < r ? xcd * (q + 1) : r * (q + 1) + (xcd - r) * q) + off; }
        const int nig = WGM * nN, gid = wgid / nig, fm = gid * WGM, gsz = (nM - fm) < WGM ? (nM - fm) : WGM;
        u.pm = fm + ((wgid % nig) % gsz); u.pn = (wgid % nig) / gsz; return true;
    }
    __device__ __forceinline__ void a_ready(const Unit&) const {}
    __device__ __forceinline__ void done(const Unit&) const {}
};
__device__ __forceinline__ unsigned cvt_pk_bf16(float lo, float hi) { unsigned r; asm volatile("v_cvt_pk_bf16_f32 %0, %1, %2" : "=v"(r) : "v"(lo), "v"(hi)); return r; }
typedef float f32x2 __attribute__((ext_vector_type(2)));
struct EpiF32 {
    static constexpr bool PERM = false, AFTER_DRAIN = false;
    float* C; int ldc; const float* bias;
    __device__ __forceinline__ void operator()(const f32x4 (&acc)[2][2][4][2], const Unit& u, int wr, int wc, int fr, int fq) const {
        const int row0 = u.pm * BM + wr * 64 + fr, col0 = u.pn * BM + wc * 32 + 4 * fq;
        f32x4 bv[2][2];
#pragma unroll
        for (int bj = 0; bj < 2; ++bj)
#pragma unroll
            for (int n = 0; n < 2; ++n) bv[bj][n] = bias ? *(const f32x4*)(bias + col0 + bj * HALF + n * 16) : (f32x4){0.f, 0.f, 0.f, 0.f};
#pragma unroll
        for (int ai = 0; ai < 2; ++ai)
#pragma unroll
            for (int m = 0; m < 4; ++m) { float* rowp = C + (size_t)(row0 + ai * HALF + m * 16) * ldc + col0;
#pragma unroll
                for (int bj = 0; bj < 2; ++bj)
#pragma unroll
                    for (int n = 0; n < 2; ++n) *(f32x4*)(rowp + bj * HALF + n * 16) = acc[ai][bj][m][n] + bv[bj][n]; }
    }
};
template <class Epi, class Sched, bool STAMP = false>
__device__ __forceinline__ void gemm_phase(PG8_LAS unsigned char* lds, const Gemm g, const Sched& S, const Epi& E, unsigned long long* stamps) {
    const int tid = threadIdx.x, wid = __builtin_amdgcn_readfirstlane(tid >> 6), lane = tid & 63, wr = wid >> 2, wc = wid & 3, fr = lane & 15, fq = lane >> 4;
    const int K = g.K, nt = K / BK;
    int ts_lo = 0, ts_hi = 0, nts = 0; const unsigned long long rt_entry = STAMP ? (unsigned long long)wall_clock64() : 0ull;
#define PG8_STAMP() do { if (STAMP && wid == 0 && nts < 64) { const unsigned long long _c = (unsigned long long)clock64(); \
        ts_lo = (lane == nts) ? (int)(unsigned)_c : ts_lo; ts_hi = (lane == nts) ? (int)(unsigned)(_c >> 32) : ts_hi; ++nts; } } while (0)
    PG8_STAMP();
    unsigned voffA[2], voffB[2];
#pragma unroll
    for (int i = 0; i < 2; ++i) { int R, C; stage_rc(tid * 16 + i * 8192, R, C); const int Rb = Epi::PERM ? ((R & ~31) + perm32(R & 31)) : R;
        voffA[i] = (unsigned)(R * g.lda + C) * 2u; voffB[i] = (unsigned)(Rb * K + C) * 2u; }
    const size_t kstep = (size_t)(BK * 2);
    const size_t hstep = (size_t)HALF * K * 2, hstepA = (size_t)HALF * g.lda * 2;
    const size_t tstep = 2 * hstep, tstepA = (size_t)g.tile_rows * g.lda * 2;
    const unsigned ldsw = (unsigned)wid * 1024u;
    const int aoff = lds_byte(wr * 64 + fr, fq * 8), boff = lds_byte(wc * 32 + fr, fq * 8);
#define PG8_SA(b, h) (((b) * 2 + (h)) * HTB)
#define PG8_SB(b, h) ((4 + (b) * 2 + (h)) * HTB)
#define PG8_STAGE(bufoff, gbase, voff) do { _Pragma("unroll") for (int _i = 0; _i < 2; ++_i) \
        __builtin_amdgcn_global_load_lds((const unsigned*)((const char*)(gbase) + (voff)[_i]), (PG8_LAS unsigned*)(lds + (bufoff) + ldsw + _i * 8192), 16, 0, 0); } while (0)
#define PG8_LDA(dst, b, h) do { _Pragma("unroll") for (int m = 0; m < 4; ++m) _Pragma("unroll") for (int k = 0; k < 2; ++k) dst[m][k] = *(const PG8_LAS bf16x8*)(lds + PG8_SA(b, h) + aoff + m * 2048 + k * 1024); } while (0)
#define PG8_LDB(dst, b, h) do { _Pragma("unroll") for (int n = 0; n < 2; ++n) _Pragma("unroll") for (int k = 0; k < 2; ++k) dst[n][k] = *(const PG8_LAS bf16x8*)(lds + PG8_SB(b, h) + boff + n * 2048 + k * 1024); } while (0)
#define PG8_MMA(ai, bj, At, Bt) do { __builtin_amdgcn_s_setprio(1); _Pragma("unroll") for (int m = 0; m < 4; ++m) _Pragma("unroll") for (int n = 0; n < 2; ++n) _Pragma("unroll") for (int k = 0; k < 2; ++k) \
        acc[ai][bj][m][n] = __builtin_amdgcn_mfma_f32_16x16x32_bf16(Bt[n][k], At[m][k], acc[ai][bj][m][n], 0, 0, 0); __builtin_amdgcn_s_setprio(0); } while (0)
#define PG8_WAIT_V(n) asm volatile("s_waitcnt vmcnt(" #n ")" ::: "memory")
#define PG8_WAIT_L(n) asm volatile("s_waitcnt lgkmcnt(" #n ")" ::: "memory")
#define PG8_BAR __builtin_amdgcn_s_barrier()
#define PG8_SCHED __builtin_amdgcn_sched_barrier(0)
    Unit cur, nxt; int ui = 0;
    if (!S.next(0, cur)) return;
    f32x4 acc[2][2][4][2];
#pragma unroll
    for (int a = 0; a < 2; ++a)
#pragma unroll
        for (int b = 0; b < 2; ++b)
#pragma unroll
            for (int m = 0; m < 4; ++m)
#pragma unroll
                for (int n = 0; n < 2; ++n) acc[a][b][m][n] = (f32x4){0.f, 0.f, 0.f, 0.f};
    bf16x8 At[4][2], B0[2][2], B1[2][2];
    const char* cA = (const char*)g.A + (size_t)cur.pm * tstepA; const char* cB = (const char*)g.Bt + (size_t)cur.pn * tstep;
    S.a_ready(cur);
    PG8_STAGE(PG8_SB(0, 0), cB, voffB); PG8_STAGE(PG8_SA(0, 0), cA, voffA); PG8_STAGE(PG8_SB(0, 1), cB + hstep, voffB); PG8_STAGE(PG8_SA(0, 1), cA + hstepA, voffA);
    if (wr == 1) PG8_BAR;
    PG8_WAIT_V(4); PG8_BAR;
    PG8_STAGE(PG8_SB(1, 0), cB + kstep, voffB); PG8_STAGE(PG8_SA(1, 0), cA + kstep, voffA); PG8_STAGE(PG8_SB(1, 1), cB + hstep + kstep, voffB);
    PG8_WAIT_V(6); PG8_BAR;
    PG8_STAMP();
    for (;;) {
        const bool has_next = S.next(ui + 1, nxt);
        const char* nA = has_next ? (const char*)g.A + (size_t)nxt.pm * tstepA : cA; const char* nB = has_next ? (const char*)g.Bt + (size_t)nxt.pn * tstep : cB;
        for (int t = 0; t < nt; t += 2) {
            const bool last = (t == nt - 2);
            const char* a1 = cA + (size_t)(t + 1) * kstep;
            const char* a2 = last ? nA : cA + (size_t)(t + 2) * kstep; const char* b2 = last ? nB : cB + (size_t)(t + 2) * kstep;
            const char* a3 = a2 + kstep; const char* b3 = b2 + kstep;
            if (last && has_next) S.a_ready(nxt);
            PG8_LDB(B0, 0, 0); PG8_SCHED; PG8_LDA(At, 0, 0); PG8_STAGE(PG8_SA(1, 1), a1 + hstepA, voffA);
            PG8_WAIT_L(8); PG8_BAR; PG8_WAIT_L(0); PG8_MMA(0, 0, At, B0); PG8_BAR; PG8_SCHED;
            PG8_LDB(B1, 0, 1); PG8_STAGE(PG8_SB(0, 0), b2, voffB);
            PG8_BAR; PG8_WAIT_L(0); PG8_MMA(0, 1, At, B1); PG8_BAR;
            PG8_LDA(At, 0, 1); PG8_STAGE(PG8_SA(0, 0), a2, voffA);
            PG8_BAR; PG8_WAIT_L(0); PG8_MMA(1, 0, At, B0); PG8_BAR; PG8_SCHED;
            PG8_STAGE(PG8_SB(0, 1), b2 + hstep, voffB);
            PG8_WAIT_V(6); PG8_BAR; PG8_MMA(1, 1, At, B1); PG8_BAR;
            PG8_LDB(B0, 1, 0); PG8_SCHED; PG8_LDA(At, 1, 0); PG8_STAGE(PG8_SA(0, 1), a2 + hstepA, voffA);
            PG8_WAIT_L(8); PG8_BAR; PG8_WAIT_L(0); PG8_MMA(0, 0, At, B0); PG8_BAR; PG8_SCHED;
            PG8_LDB(B1, 1, 1); PG8_STAGE(PG8_SB(1, 0), b3, voffB);
            PG8_BAR; PG8_WAIT_L(0); PG8_MMA(0, 1, At, B1); PG8_BAR;
            PG8_LDA(At, 1, 1); PG8_STAGE(PG8_SA(1, 0), a3, voffA);
            PG8_BAR; PG8_WAIT_L(0); PG8_MMA(1, 0, At, B0); PG8_BAR; PG8_SCHED;
            PG8_STAGE(PG8_SB(1, 1), b3 + hstep, voffB);
            PG8_WAIT_V(6); PG8_BAR; PG8_MMA(1, 1, At, B1); PG8_BAR;
        }
        PG8_STAMP();
        if constexpr (!Epi::AFTER_DRAIN) { E(acc, cur, wr, wc, fr, fq); S.done(cur); }
        PG8_STAMP();
        if (!has_next) break;
#pragma unroll
        for (int a = 0; a < 2; ++a)
#pragma unroll
            for (int b = 0; b < 2; ++b)
#pragma unroll
                for (int m = 0; m < 4; ++m)
#pragma unroll
                    for (int n = 0; n < 2; ++n) acc[a][b][m][n] = (f32x4){0.f, 0.f, 0.f, 0.f};
        cur = nxt; cA = nA; cB = nB; ++ui;
    }
    PG8_WAIT_V(0);
    if (wr == 0) PG8_BAR;
    PG8_BAR;
    if constexpr (Epi::AFTER_DRAIN) { E.fused(acc, cur, wr, wc, fr, fq, lds, wid, lane); S.done(cur); }
    PG8_STAMP();
    if (STAMP && wid == 0) { stamps[lane] = lane < nts ? (((unsigned long long)(unsigned)ts_hi << 32) | (unsigned)ts_lo) : 0ull;
        if (lane == 62) stamps[62] = rt_entry; if (lane == 63) stamps[63] = (unsigned long long)wall_clock64(); }
#undef PG8_STAMP
#undef PG8_SA
#undef PG8_SB
#undef PG8_STAGE
#undef PG8_LDA
#undef PG8_LDB
#undef PG8_MMA
#undef PG8_WAIT_V
#undef PG8_WAIT_L
#undef PG8_BAR
#undef PG8_SCHED
}
}

namespace cg = cooperative_groups;
#define LAS __attribute__((address_space(3)))
typedef unsigned short bf16_t;
typedef unsigned int u32;
typedef pg8::bf16x8 bf16x8;
typedef pg8::f32x4 f32x4;
typedef pg8::u32x4 u32x4;

constexpr int D = 1024, TP = 4096, BP = 8, MP = BP * TP, BS = 32, TS = 8, MS = BS * TS;
constexpr int MB = MP + MS;
constexpr int MA = 33280;
constexpr int MA_REAL = MP + BS * 9;
constexpr int DIN = 3328, RCOLS = 1792, FF = 2816, FF2 = 5632, NLORA = 1536, KLORA = 256;
constexpr int NTHREADS = 512;
constexpr int UP_TILES = 131, UP_STEP = 254, H2P_ROWS = (UP_TILES - 1) * UP_STEP + 256;
constexpr int LDS_BYTES = 144 * 1024;

constexpr size_t O_YP = 0;
constexpr size_t O_YS = O_YP + (size_t)MP * D;
constexpr size_t O_PSH = O_YS + (size_t)MS * D;
constexpr size_t O_PWKV = O_PSH + (size_t)BP * D;
constexpr size_t O_PK = O_PWKV + (size_t)BP * 8 * 64 * 64;
constexpr size_t O_PV = O_PK + (size_t)BP * 2048 * 512;
constexpr size_t O_PCONV = O_PV + (size_t)BP * 2048 * 512;
constexpr size_t O_SSH = O_PCONV + (size_t)BP * 2 * FF2;
constexpr size_t O_SWKV = O_SSH + (size_t)BS * D;
constexpr size_t O_SK = O_SWKV + (size_t)BS * 8 * 64 * 64;
constexpr size_t O_SV = O_SK + (size_t)BS * 2048 * 512;
constexpr size_t O_SCONV = O_SV + (size_t)BS * 2048 * 512;
constexpr size_t O_END = O_SCONV + (size_t)BS * 2 * FF2;

constexpr size_t al256(size_t x) { return (x + 255) & ~(size_t)255; }
constexpr size_t WS_WIN = 0;
constexpr size_t WS_WOUT = WS_WIN + al256((size_t)DIN * D * 2);
constexpr size_t WS_WUP = WS_WOUT + al256((size_t)D * D * 2);
constexpr size_t WS_WDN = WS_WUP + al256((size_t)FF2 * D * 2);
constexpr size_t WS_WLORA = WS_WDN + al256((size_t)D * FF * 2);
constexpr size_t WS_ROPE = WS_WLORA + al256((size_t)NLORA * KLORA * 2);
constexpr int NPOS = 4104;
constexpr size_t WS_SNEWK = WS_ROPE + al256((size_t)NPOS * 32 * 2 * 4);
constexpr size_t WS_SNEWV = WS_SNEWK + al256((size_t)MS * 512 * 4);
constexpr size_t WS_HALO = WS_SNEWV + al256((size_t)MS * 512 * 4);
constexpr size_t WS_A = WS_HALO + al256((size_t)1025 * 2 * FF2 * 2);
constexpr size_t WS_PROJRW = WS_A;
constexpr size_t WS_Q = WS_PROJRW + al256((size_t)MA * RCOLS * 2);
constexpr size_t WS_K = WS_Q + al256((size_t)MB * 512 * 2);
constexpr size_t WS_VT1 = WS_K + al256((size_t)MB * 512 * 2);
constexpr size_t WS_VT4 = WS_VT1 + al256((size_t)BP * 8 * 64 * TP * 2);
constexpr size_t WS_VT16 = WS_VT4 + al256((size_t)BP * 8 * 64 * TP * 2);
constexpr size_t WS_ALORA = WS_VT16 + al256((size_t)BP * 8 * 64 * TP * 2);
constexpr size_t WS_VROW = WS_ALORA + al256((size_t)MB * KLORA * 2);
constexpr size_t WS_A_EARLY_END = WS_VROW + al256((size_t)MP * 512 * 2);
constexpr size_t WS_U = WS_A;
constexpr size_t WS_F = WS_A + al256((size_t)MB * FF * 2);
static_assert(WS_F + (size_t)MB * D * 4 <= WS_A + al256((size_t)MB * FF2 * 2), "region A late overflow");
constexpr size_t WS_END = WS_A + al256((size_t)MB * FF2 * 2);
static_assert(WS_A_EARLY_END <= WS_END, "region A overflow");
constexpr size_t WS_BAR = WS_END;
constexpr size_t WS_TOTAL = WS_END + 256;
constexpr size_t WS_Y = WS_ALORA;
static_assert(WS_Y + (size_t)MB * 512 * 4 <= WS_END, "Y overflow");
constexpr size_t SC_B = O_SK * 4;
constexpr size_t SC_C = SC_B + al256((size_t)MB * D * 4);
static_assert(SC_C + (size_t)H2P_ROWS * D * 2 <= O_SCONV * 4, "scratch overflow");
static_assert((size_t)MA * D * 2 <= (size_t)MB * D * 4 && (size_t)MB * NLORA * 2 <= (size_t)MB * D * 4, "region B");

struct Params {
    const float* in[28];
    float* out;
    unsigned char* ws;
    int en, pad;
};

enum { I_XP = 0, I_XS, I_SSHIFT, I_SWKV, I_CK, I_CV, I_SCONV, I_NMPRE, I_NMPOST, I_NFPRE, I_NFPOST, I_WIN, I_MU, I_W0, I_WDEC, I_A0, I_WICLR, I_WGATE,
       I_KK, I_KA, I_RK, I_LNW, I_LNB, I_WOUT, I_WUP, I_CONVW, I_CONVB, I_WDN };

__device__ __forceinline__ float bflo(u32 p) { return __uint_as_float(p << 16); }
__device__ __forceinline__ float bfhi(u32 p) { return __uint_as_float(p & 0xffff0000u); }
__device__ __forceinline__ u32 pk2(float a, float b) { return pg8::cvt_pk_bf16(a, b); }
__device__ __forceinline__ float wave_sum(float v) {
#pragma unroll
    for (int o = 1; o < 64; o <<= 1) v += __shfl_xor(v, o);
    return v;
}
template <int N> __device__ __forceinline__ float dpp_ror(float x) {
    return __int_as_float(__builtin_amdgcn_update_dpp(0, __float_as_int(x), 0x120 + N, 0xF, 0xF, false));
}
__device__ __forceinline__ float row16_sum(float x) {
    x += dpp_ror<8>(x); x += dpp_ror<4>(x); x += dpp_ror<2>(x); x += dpp_ror<1>(x);
    return x;
}
__device__ __forceinline__ void row16_sum4(float& a, float& b, float& c, float& d) {
    asm volatile("s_nop 1\n\t"
                 "v_add_f32_dpp %0, %0, %0 row_ror:8 row_mask:0xf bank_mask:0xf\n\t" "v_add_f32_dpp %1, %1, %1 row_ror:8 row_mask:0xf bank_mask:0xf\n\t"
                 "v_add_f32_dpp %2, %2, %2 row_ror:8 row_mask:0xf bank_mask:0xf\n\t" "v_add_f32_dpp %3, %3, %3 row_ror:8 row_mask:0xf bank_mask:0xf\n\t"
                 "v_add_f32_dpp %0, %0, %0 row_ror:4 row_mask:0xf bank_mask:0xf\n\t" "v_add_f32_dpp %1, %1, %1 row_ror:4 row_mask:0xf bank_mask:0xf\n\t"
                 "v_add_f32_dpp %2, %2, %2 row_ror:4 row_mask:0xf bank_mask:0xf\n\t" "v_add_f32_dpp %3, %3, %3 row_ror:4 row_mask:0xf bank_mask:0xf\n\t"
                 "v_add_f32_dpp %0, %0, %0 row_ror:2 row_mask:0xf bank_mask:0xf\n\t" "v_add_f32_dpp %1, %1, %1 row_ror:2 row_mask:0xf bank_mask:0xf\n\t"
                 "v_add_f32_dpp %2, %2, %2 row_ror:2 row_mask:0xf bank_mask:0xf\n\t" "v_add_f32_dpp %3, %3, %3 row_ror:2 row_mask:0xf bank_mask:0xf\n\t"
                 "v_add_f32_dpp %0, %0, %0 row_ror:1 row_mask:0xf bank_mask:0xf\n\t" "v_add_f32_dpp %1, %1, %1 row_ror:1 row_mask:0xf bank_mask:0xf\n\t"
                 "v_add_f32_dpp %2, %2, %2 row_ror:1 row_mask:0xf bank_mask:0xf\n\t" "v_add_f32_dpp %3, %3, %3 row_ror:1 row_mask:0xf bank_mask:0xf\n\t"
                 "s_nop 1"
                 : "+v"(a), "+v"(b), "+v"(c), "+v"(d));
}
__device__ __forceinline__ float fma_(float a, float b, float c) { float d; asm("v_fma_f32 %0, %1, %2, %3" : "=v"(d) : "v"(a), "v"(b), "v"(c)); return d; }
__device__ __forceinline__ float mul_(float a, float b) { float d; asm("v_mul_f32 %0, %1, %2" : "=v"(d) : "v"(a), "v"(b)); return d; }
__device__ __forceinline__ void row16_sum2_mul4(float& a, float& b, float (&t)[4], float v, float k0, float k1, float k2, float k3) {
    asm volatile("v_mul_f32 %2, %6, %7\n\t" "v_mul_f32 %3, %6, %8\n\t"
                 "v_add_f32_dpp %0, %0, %0 row_ror:8 row_mask:0xf bank_mask:0xf\n\t" "v_add_f32_dpp %1, %1, %1 row_ror:8 row_mask:0xf bank_mask:0xf\n\t"
                 "v_mul_f32 %4, %6, %9\n\t"
                 "v_add_f32_dpp %0, %0, %0 row_ror:4 row_mask:0xf bank_mask:0xf\n\t" "v_add_f32_dpp %1, %1, %1 row_ror:4 row_mask:0xf bank_mask:0xf\n\t"
                 "v_mul_f32 %5, %6, %10\n\t"
                 "v_add_f32_dpp %0, %0, %0 row_ror:2 row_mask:0xf bank_mask:0xf\n\t" "v_add_f32_dpp %1, %1, %1 row_ror:2 row_mask:0xf bank_mask:0xf\n\t"
                 "s_nop 0\n\t"
                 "v_add_f32_dpp %0, %0, %0 row_ror:1 row_mask:0xf bank_mask:0xf\n\t" "v_add_f32_dpp %1, %1, %1 row_ror:1 row_mask:0xf bank_mask:0xf"
                 : "+v"(a), "+v"(b), "=&v"(t[0]), "=&v"(t[1]), "=&v"(t[2]), "=&v"(t[3])
                 : "v"(v), "v"(k0), "v"(k1), "v"(k2), "v"(k3));
}
__device__ __forceinline__ void row16_sum2(float& a, float& b) {
    asm volatile("s_nop 1\n\t"
                 "v_add_f32_dpp %0, %0, %0 row_ror:8 row_mask:0xf bank_mask:0xf\n\t" "v_add_f32_dpp %1, %1, %1 row_ror:8 row_mask:0xf bank_mask:0xf\n\t" "s_nop 0\n\t"
                 "v_add_f32_dpp %0, %0, %0 row_ror:4 row_mask:0xf bank_mask:0xf\n\t" "v_add_f32_dpp %1, %1, %1 row_ror:4 row_mask:0xf bank_mask:0xf\n\t" "s_nop 0\n\t"
                 "v_add_f32_dpp %0, %0, %0 row_ror:2 row_mask:0xf bank_mask:0xf\n\t" "v_add_f32_dpp %1, %1, %1 row_ror:2 row_mask:0xf bank_mask:0xf\n\t" "s_nop 0\n\t"
                 "v_add_f32_dpp %0, %0, %0 row_ror:1 row_mask:0xf bank_mask:0xf\n\t" "v_add_f32_dpp %1, %1, %1 row_ror:1 row_mask:0xf bank_mask:0xf\n\t"
                 "s_nop 1"
                 : "+v"(a), "+v"(b));
}
__device__ __forceinline__ float sigmoidf_(float x) { return __builtin_amdgcn_rcpf(1.f + __expf(-x)); }

__device__ __forceinline__ int win_rowmap(int n) {
    if (n < RCOLS || n >= RCOLS + 1024) return n;
    const int base = (n < RCOLS + 512) ? RCOLS : RCOLS + 512, c = n - base, unit = c >> 8, cu = c & 255, hu = cu >> 6, d = cu & 63, e = d & 31, s = d >> 5;
    const int idx = hu * 32 + e, bj = idx >> 6, wc = (idx & 63) >> 4, fq = (idx & 15) >> 2, j = idx & 3;
    return base + unit * 256 + 128 * bj + 32 * wc + 16 * s + 4 * fq + j;
}
__device__ __forceinline__ int wup_rowmap(int c) {
    const int isup = c >= FF ? 1 : 0, cc = c - FF * isup, pn = cc >> 7, e = cc & 127;
    return pn * 256 + 128 * (e >> 6) + 32 * ((e >> 4) & 3) + 16 * isup + 4 * ((e >> 2) & 3) + (e & 3);
}
__device__ __forceinline__ void transpose_item(const float* W, int K, int N, bf16_t* WT, int mode, LAS float* scr, int item, int lane) {
    const int nblk = N / 32, kb = item / nblk, nb = item % nblk, k0 = 64 * kb, n0 = 32 * nb;
#pragma unroll 8
    for (int i = 0; i < 32; ++i) { const int kk = 2 * i + (lane >> 5); scr[kk * 33 + (lane & 31)] = W[(size_t)(k0 + kk) * N + n0 + (lane & 31)]; }
    asm volatile("s_waitcnt lgkmcnt(0)" ::: "memory");
    const int c = lane & 7;
#pragma unroll
    for (int j = 0; j < 4; ++j) { const int n = (lane >> 3) + 8 * j; const LAS float* s = scr + (8 * c) * 33 + n;
        uint4 o; o.x = pk2(s[0 * 33], s[1 * 33]); o.y = pk2(s[2 * 33], s[3 * 33]); o.z = pk2(s[4 * 33], s[5 * 33]); o.w = pk2(s[6 * 33], s[7 * 33]);
        const int row = mode == 1 ? win_rowmap(n0 + n) : (mode == 2 ? wup_rowmap(n0 + n) : (n0 + n));
        *(uint4*)(WT + (size_t)row * K + k0 + 8 * c) = o; }
    asm volatile("s_waitcnt lgkmcnt(0)" ::: "memory");
}
__device__ __forceinline__ void rms_row(const float* xrow, const float* g, bf16_t* orow, float* frow, int lane) {
    const float4* xr = (const float4*)xrow + lane; const float4* gr = (const float4*)g + lane;
    float4 v[4]; float s = 0.f;
#pragma unroll
    for (int j = 0; j < 4; ++j) { v[j] = xr[64 * j]; s += (v[j].x * v[j].x + v[j].y * v[j].y) + (v[j].z * v[j].z + v[j].w * v[j].w); }
    const float rs = rsqrtf(wave_sum(s) * (1.f / D) + 1e-6f);
#pragma unroll
    for (int j = 0; j < 4; ++j) { const float4 gg = gr[64 * j];
        float4 y; y.x = v[j].x * rs * gg.x; y.y = v[j].y * rs * gg.y; y.z = v[j].z * rs * gg.z; y.w = v[j].w * rs * gg.w;
        uint2 o; o.x = pk2(y.x, y.y); o.y = pk2(y.z, y.w);
        *((uint2*)orow + lane + 64 * j) = o;
        if (frow) *((float4*)frow + lane + 64 * j) = y; }
}
__device__ __forceinline__ void phase0(const Params& p, LAS unsigned char* lds, int tid, int G, int bid) {
    const int wave = tid >> 6, lane = tid & 63, gw = bid * 8 + wave, NGW = G * 8;
    LAS float* scr = (LAS float*)(lds + wave * 16384);
    bf16_t* WinT = (bf16_t*)(p.ws + WS_WIN); bf16_t* WoutT = (bf16_t*)(p.ws + WS_WOUT); bf16_t* WupT = (bf16_t*)(p.ws + WS_WUP); bf16_t* WdnT = (bf16_t*)(p.ws + WS_WDN);
    constexpr int I1 = (D / 64) * (DIN / 32), I2 = (D / 64) * (D / 32), I3 = (D / 64) * (FF2 / 32), I4 = (FF / 64) * (D / 32);
    for (int it = gw; it < I1 + I2 + I3 + I4; it += NGW) {
        int r = it;
        if (r < I1) { transpose_item(p.in[I_WIN], D, DIN, WinT, 1, scr, r, lane); continue; } r -= I1;
        if (r < I2) { transpose_item(p.in[I_WOUT], D, D, WoutT, 0, scr, r, lane); continue; } r -= I2;
        if (r < I3) { transpose_item(p.in[I_WUP], D, FF2, WupT, 2, scr, r, lane); continue; } r -= I3;
        transpose_item(p.in[I_WDN], FF, D, WdnT, 0, scr, r, lane);
    }
    const int gt = bid * NTHREADS + tid, NT = G * NTHREADS;
    bf16_t* WL = (bf16_t*)(p.ws + WS_WLORA);
    for (int i = gt; i < NLORA * KLORA; i += NT) {
        const int row = i >> 8, k = i & 255; float v = 0.f;
        if (row < 512) { if (k < 64) v = p.in[I_WDEC][k * 512 + row]; }
        else if (row < 1024) { if (k >= 64 && k < 128) v = p.in[I_WICLR][(k - 64) * 512 + (row - 512)]; }
        else { if (k >= 128) v = p.in[I_WGATE][(k - 128) * 512 + (row - 1024)]; }
        WL[i] = (bf16_t)(pk2(v, 0.f) & 0xffffu);
    }
    float* rope = (float*)(p.ws + WS_ROPE);
    for (int i = gt; i < NPOS * 32; i += NT) {
        const int pi = i >> 5, e = i & 31; const int pos = pi < TP ? pi : 16384 + (pi - TP);
        double inv = 1.0; for (int q = 0; q < e; ++q) inv *= 0.7498942093324558273;
        const float ang = (float)pos * (float)inv;
        const double a = (double)ang; const double kq = rint(a * 0.15915494309189535); double r = a - kq * 6.283185307179586; r -= kq * 2.4492935982947064e-16;
        const double r2 = r * r;
        double sn = 1.0 / 51090942171709440000.0;
        sn = sn * r2 * (-1.0) + 1.0 / 121645100408832000.0;
        sn = -sn * r2 + 1.0 / 355687428096000.0;
        sn = -sn * r2 + 1.0 / 1307674368000.0;
        sn = -sn * r2 + 1.0 / 6227020800.0;
        sn = -sn * r2 + 1.0 / 39916800.0;
        sn = -sn * r2 + 1.0 / 362880.0;
        sn = -sn * r2 + 1.0 / 5040.0;
        sn = -sn * r2 + 1.0 / 120.0;
        sn = -sn * r2 + 1.0 / 6.0;
        sn = -sn * r2 + 1.0;
        sn *= r;
        double cs = 1.0 / 1124000727777607680000.0;
        cs = -cs * r2 + 1.0 / 2432902008176640000.0;
        cs = -cs * r2 + 1.0 / 6402373705728000.0;
        cs = -cs * r2 + 1.0 / 20922789888000.0;
        cs = -cs * r2 + 1.0 / 87178291200.0;
        cs = -cs * r2 + 1.0 / 479001600.0;
        cs = -cs * r2 + 1.0 / 3628800.0;
        cs = -cs * r2 + 1.0 / 40320.0;
        cs = -cs * r2 + 1.0 / 720.0;
        cs = -cs * r2 + 1.0 / 24.0;
        cs = -cs * r2 + 0.5;
        cs = -cs * r2 + 1.0;
        rope[i] = (float)cs; rope[NPOS * 32 + i] = (float)sn;
    }
    bf16_t* H = (bf16_t*)((unsigned char*)p.out + SC_B);
    for (int row = gw; row < MA; row += NGW) {
        bf16_t* orow = H + (size_t)row * D;
        if (row < MP) {
            const bool last = (row & (TP - 1)) == TP - 1;
            rms_row(p.in[I_XP] + (size_t)row * D, p.in[I_NMPRE], orow, last ? p.out + O_PSH + (size_t)(row >> 12) * D : nullptr, lane);
        } else {
            const int s = row - MP;
            if (s < BS * 9) {
                const int b = s / 9, j = s - b * 9;
                if (j == 0) {
                    const float4* sr = (const float4*)(p.in[I_SSHIFT] + (size_t)b * D) + lane;
#pragma unroll
                    for (int q = 0; q < 4; ++q) { const float4 v = sr[64 * q]; uint2 o; o.x = pk2(v.x, v.y); o.y = pk2(v.z, v.w); *((uint2*)orow + lane + 64 * q) = o; }
                } else {
                    rms_row(p.in[I_XS] + (size_t)(b * TS + j - 1) * D, p.in[I_NMPRE], orow, j == TS ? p.out + O_SSH + (size_t)b * D : nullptr, lane);
                }
            } else {
#pragma unroll
                for (int q = 0; q < 4; ++q) *((uint2*)orow + lane + 64 * q) = make_uint2(0u, 0u);
            }
        }
    }
}

struct EpiProj {
    static constexpr bool PERM = false, AFTER_DRAIN = false;
    bf16_t* projrw; bf16_t* Q; bf16_t* K; bf16_t* VT1; bf16_t* VT4; bf16_t* VT16; const float* rope; float* out; float* snewk; float* snewv;
    __device__ __forceinline__ void operator()(const f32x4 (&acc)[2][2][4][2], const pg8::Unit& u, int wr, int wc, int fr, int fq) const {
        const int pn = u.pn;
        if (pn < 7) {
#pragma unroll
            for (int ai = 0; ai < 2; ++ai)
#pragma unroll
                for (int m = 0; m < 4; ++m) { const int row = u.pm * 256 + ai * 128 + wr * 64 + m * 16 + fr;
                    bf16_t* rp = projrw + (size_t)row * RCOLS + pn * 256 + wc * 32 + 4 * fq;
#pragma unroll
                    for (int bj = 0; bj < 2; ++bj)
#pragma unroll
                        for (int n = 0; n < 2; ++n) { const f32x4 v = acc[ai][bj][m][n]; uint2 o; o.x = pk2(v[0], v[1]); o.y = pk2(v[2], v[3]); *(uint2*)(rp + bj * 128 + n * 16) = o; } }
            return;
        }
        if (pn < 11 && u.pm < MP / 256) {
            const bool isq = pn < 9; const int unit = isq ? pn - 7 : pn - 9;
            const int rowbase = u.pm * 256 + wr * 64 + fr; const int b = rowbase >> 12, t0 = rowbase & (TP - 1);
#pragma unroll
            for (int bj = 0; bj < 2; ++bj) {
                const int idx = bj * 64 + wc * 16 + fq * 4, hu = idx >> 5, e = idx & 31; const int col = unit * 256 + hu * 64 + e;
                const float4 c16 = *(const float4*)(rope + 16 * 32 + e), s16 = *(const float4*)(rope + (size_t)NPOS * 32 + 16 * 32 + e);
                const float c16a[4] = {c16.x, c16.y, c16.z, c16.w}, s16a[4] = {s16.x, s16.y, s16.z, s16.w};
#pragma unroll
                for (int ai = 0; ai < 2; ++ai) {
                    const int tb = t0 + 128 * ai;
                    const float4 cs4 = *(const float4*)(rope + (size_t)tb * 32 + e), sn4 = *(const float4*)(rope + (size_t)NPOS * 32 + (size_t)tb * 32 + e);
                    float cs[4] = {cs4.x, cs4.y, cs4.z, cs4.w}, sn[4] = {sn4.x, sn4.y, sn4.z, sn4.w};
#pragma unroll
                    for (int m = 0; m < 4; ++m) {
                        const int t = tb + 16 * m; const size_t rowB = (size_t)b * TP + t;
                        const f32x4 x1 = acc[ai][bj][m][0], x2 = acc[ai][bj][m][1];
                        float o1[4], o2[4];
#pragma unroll
                        for (int j = 0; j < 4; ++j) { o1[j] = x1[j] * cs[j] - x2[j] * sn[j]; o2[j] = x1[j] * sn[j] + x2[j] * cs[j]; }
                        if (isq) {
                            uint2 a, c2; a.x = pk2(o1[0] * 0.125f, o1[1] * 0.125f); a.y = pk2(o1[2] * 0.125f, o1[3] * 0.125f); c2.x = pk2(o2[0] * 0.125f, o2[1] * 0.125f); c2.y = pk2(o2[2] * 0.125f, o2[3] * 0.125f);
                            *(uint2*)(Q + rowB * 512 + col) = a; *(uint2*)(Q + rowB * 512 + col + 32) = c2;
                        } else {
                            uint2 a, c2; a.x = pk2(o1[0], o1[1]); a.y = pk2(o1[2], o1[3]); c2.x = pk2(o2[0], o2[1]); c2.y = pk2(o2[2], o2[3]);
                            *(uint2*)(K + rowB * 512 + col) = a; *(uint2*)(K + rowB * 512 + col + 32) = c2;
                            if (t >= 2048) { float* dst = out + O_PK + ((size_t)b * 2048 + (t - 2048)) * 512 + col;
                                *(float4*)dst = make_float4(o1[0], o1[1], o1[2], o1[3]); *(float4*)(dst + 32) = make_float4(o2[0], o2[1], o2[2], o2[3]); }
                        }
#pragma unroll
                        for (int j = 0; j < 4; ++j) { const float nc = cs[j] * c16a[j] - sn[j] * s16a[j], ns = sn[j] * c16a[j] + cs[j] * s16a[j]; cs[j] = nc; sn[j] = ns; }
                    }
                }
            }
            return;
        }
#pragma unroll
        for (int ai = 0; ai < 2; ++ai)
#pragma unroll
            for (int m = 0; m < 4; ++m) {
                const int row = u.pm * 256 + ai * 128 + wr * 64 + m * 16 + fr;
                bool prompt = row < MP; int b, t, rowB, pi; bool valid = true;
                if (prompt) { b = row >> 12; t = row & (TP - 1); rowB = row; pi = t; }
                else { const int s = row - MP; b = s / 9; const int j = s - b * 9; valid = (s < BS * 9) && (j > 0); t = j - 1; rowB = MP + b * TS + t; pi = TP + t; }
                if (!valid) continue;
                if (pn < 11) {
                    const bool isq = pn < 9; const int unit = isq ? pn - 7 : pn - 9;
#pragma unroll
                    for (int bj = 0; bj < 2; ++bj) {
                        const int idx = bj * 64 + wc * 16 + fq * 4, hu = idx >> 5, e = idx & 31;
                        const float4 cs = *(const float4*)(rope + (size_t)pi * 32 + e), sn = *(const float4*)(rope + (size_t)NPOS * 32 + (size_t)pi * 32 + e);
                        const f32x4 x1 = acc[ai][bj][m][0], x2 = acc[ai][bj][m][1];
                        float o1[4], o2[4];
                        o1[0] = x1[0] * cs.x - x2[0] * sn.x; o2[0] = x1[0] * sn.x + x2[0] * cs.x;
                        o1[1] = x1[1] * cs.y - x2[1] * sn.y; o2[1] = x1[1] * sn.y + x2[1] * cs.y;
                        o1[2] = x1[2] * cs.z - x2[2] * sn.z; o2[2] = x1[2] * sn.z + x2[2] * cs.z;
                        o1[3] = x1[3] * cs.w - x2[3] * sn.w; o2[3] = x1[3] * sn.w + x2[3] * cs.w;
                        const int col = unit * 256 + hu * 64 + e;
                        if (isq) {
                            uint2 a, c2; a.x = pk2(o1[0] * 0.125f, o1[1] * 0.125f); a.y = pk2(o1[2] * 0.125f, o1[3] * 0.125f); c2.x = pk2(o2[0] * 0.125f, o2[1] * 0.125f); c2.y = pk2(o2[2] * 0.125f, o2[3] * 0.125f);
                            *(uint2*)(Q + (size_t)rowB * 512 + col) = a; *(uint2*)(Q + (size_t)rowB * 512 + col + 32) = c2;
                        } else {
                            uint2 a, c2; a.x = pk2(o1[0], o1[1]); a.y = pk2(o1[2], o1[3]); c2.x = pk2(o2[0], o2[1]); c2.y = pk2(o2[2], o2[3]);
                            *(uint2*)(K + (size_t)rowB * 512 + col) = a; *(uint2*)(K + (size_t)rowB * 512 + col + 32) = c2;
                            float* dst = nullptr;
                            if (prompt) { if (t >= 2048) dst = out + O_PK + ((size_t)b * 2048 + (t - 2048)) * 512 + col; }
                            else dst = snewk + (size_t)(b * TS + t) * 512 + col;
                            if (dst) { *(float4*)dst = make_float4(o1[0], o1[1], o1[2], o1[3]); *(float4*)(dst + 32) = make_float4(o2[0], o2[1], o2[2], o2[3]); }
                        }
                    }
                } else {
#pragma unroll
                    for (int bj = 0; bj < 2; ++bj)
#pragma unroll
                        for (int n = 0; n < 2; ++n) {
                            const int col = (pn - 11) * 256 + bj * 128 + wc * 32 + n * 16 + 4 * fq; const f32x4 v = acc[ai][bj][m][n];
                            if (prompt) {
                                if (t >= 2048) *(float4*)(out + O_PV + ((size_t)b * 2048 + (t - 2048)) * 512 + col) = make_float4(v[0], v[1], v[2], v[3]);
                                uint2 o; o.x = pk2(v[0], v[1]); o.y = pk2(v[2], v[3]); *(uint2*)(VT1 + (size_t)rowB * 512 + col) = o;
                            } else {
                                *(float4*)(snewv + (size_t)(b * TS + t) * 512 + col) = make_float4(v[0], v[1], v[2], v[3]);
                            }
                        }
                }
            }
    }
};
struct EpiBf16S {
    static constexpr bool PERM = false, AFTER_DRAIN = false;
    bf16_t* O; int ldc;
    __device__ __forceinline__ void operator()(const f32x4 (&acc)[2][2][4][2], const pg8::Unit& u, int wr, int wc, int fr, int fq) const {
#pragma unroll
        for (int ai = 0; ai < 2; ++ai)
#pragma unroll
            for (int m = 0; m < 4; ++m) { bf16_t* rp = O + (size_t)(u.pm * 256 + ai * 128 + wr * 64 + m * 16 + fr) * ldc + u.pn * 256 + wc * 32 + 4 * fq;
#pragma unroll
                for (int bj = 0; bj < 2; ++bj)
#pragma unroll
                    for (int n = 0; n < 2; ++n) { const f32x4 v = acc[ai][bj][m][n]; uint2 o; o.x = pk2(v[0], v[1]); o.y = pk2(v[2], v[3]); *(uint2*)(rp + bj * 128 + n * 16) = o; } }
    }
};
struct EpiDag {
    static constexpr bool PERM = false, AFTER_DRAIN = false;
    bf16_t* dag; const float* w0; const float* a0;
    __device__ __forceinline__ void operator()(const f32x4 (&acc)[2][2][4][2], const pg8::Unit& u, int wr, int wc, int fr, int fq) const {
        const int kind = u.pn >> 1;
#pragma unroll
        for (int bj = 0; bj < 2; ++bj)
#pragma unroll
            for (int n = 0; n < 2; ++n) {
                const int col = u.pn * 256 + bj * 128 + wc * 32 + n * 16 + 4 * fq;
                float4 bias = make_float4(0.f, 0.f, 0.f, 0.f);
                if (kind == 0) bias = *(const float4*)(w0 + col); else if (kind == 1) bias = *(const float4*)(a0 + col - 512);
                const float bb[4] = {bias.x, bias.y, bias.z, bias.w};
#pragma unroll
                for (int ai = 0; ai < 2; ++ai)
#pragma unroll
                    for (int m = 0; m < 4; ++m) { const int row = u.pm * 256 + ai * 128 + wr * 64 + m * 16 + fr; const f32x4 v = acc[ai][bj][m][n]; float o[4];
#pragma unroll
                        for (int j = 0; j < 4; ++j) { const float x = v[j] + bb[j];
                            if (kind == 0) o[j] = -0.60653065971263342f * sigmoidf_(x);
                            else if (kind == 1) o[j] = sigmoidf_(x);
                            else o[j] = x; }
                        uint2 q; q.x = pk2(o[0], o[1]); q.y = pk2(o[2], o[3]); *(uint2*)(dag + (size_t)row * NLORA + col) = q; }
            }
    }
};
struct EpiUp {
    static constexpr bool PERM = false, AFTER_DRAIN = false;
    bf16_t* U; bf16_t* halo; float* out;
    __device__ __forceinline__ void operator()(const f32x4 (&acc)[2][2][4][2], const pg8::Unit& u, int wr, int wc, int fr, int fq) const {
#pragma unroll
        for (int ai = 0; ai < 2; ++ai)
#pragma unroll
            for (int m = 0; m < 4; ++m) {
                const int row = u.pm * 256 + ai * 128 + wr * 64 + m * 16 + fr; const int col0 = u.pn * 256 + wc * 32 + 4 * fq;
                bf16_t* hrow = nullptr; float* frow = nullptr;
                if (row < MP) { const int t = row & (TP - 1);
                    if ((t & 31) >= 30) hrow = halo + ((size_t)((row >> 5) + 1) * 2 + ((t & 31) - 30)) * FF2;
                    if (t >= TP - 2) frow = out + O_PCONV + ((size_t)(row >> 12) * 2 + (t - (TP - 2))) * FF2;
                } else { const int s = row - MP, b = s >> 3, tt = s & 7; if (tt >= 6) frow = out + O_SCONV + ((size_t)b * 2 + (tt - 6)) * FF2; }
#pragma unroll
                for (int bj = 0; bj < 2; ++bj)
#pragma unroll
                    for (int n = 0; n < 2; ++n) { const f32x4 v = acc[ai][bj][m][n]; const int col = col0 + bj * 128 + n * 16;
                        uint2 o; o.x = pk2(v[0], v[1]); o.y = pk2(v[2], v[3]);
                        *(uint2*)(U + (size_t)row * FF2 + col) = o;
                        if (hrow) *(uint2*)(hrow + col) = o;
                        if (frow) *(float4*)(frow + col) = make_float4(v[0], v[1], v[2], v[3]); }
            }
    }
};

struct EpiUpAct {
    static constexpr bool PERM = false, AFTER_DRAIN = false;
    bf16_t* ACT; float* out; const float* cw; const float* cb; const float* sconv; LAS float* xch;
    __device__ __forceinline__ void operator()(const f32x4 (&acc)[2][2][4][2], const pg8::Unit& u, int wr, int wc, int fr, int fq) const {
        const int lane = fq * 16 + fr, wid = wr * 4 + wc;
        if (fr >= 14) {
#pragma unroll
            for (int ai = 0; ai < 2; ++ai)
#pragma unroll
                for (int bj = 0; bj < 2; ++bj)
#pragma unroll
                    for (int n = 0; n < 2; ++n) *(LAS f32x4*)(xch + ((wid * 2 + ai) * 2 + (fr - 14)) * 64 + (bj * 2 + n) * 16 + 4 * fq) = acc[ai][bj][3][n];
        }
        asm volatile("s_waitcnt lgkmcnt(0)" ::: "memory");
        __builtin_amdgcn_s_barrier(); __builtin_amdgcn_s_barrier();
        asm volatile("" ::: "memory");
#pragma unroll
        for (int bj = 0; bj < 2; ++bj) {
            const int e = 64 * bj + 16 * wc + 4 * fq, gcol = 128 * u.pn + e, ucol = FF + gcol;
            const float4 wg0 = *(const float4*)(cw + gcol), wg1 = *(const float4*)(cw + FF2 + gcol), wg2 = *(const float4*)(cw + 2 * FF2 + gcol), bg = *(const float4*)(cb + gcol);
            const float4 wu0 = *(const float4*)(cw + ucol), wu1 = *(const float4*)(cw + FF2 + ucol), wu2 = *(const float4*)(cw + 2 * FF2 + ucol), bu = *(const float4*)(cb + ucol);
            const float w0g[4] = {wg0.x, wg0.y, wg0.z, wg0.w}, w1g[4] = {wg1.x, wg1.y, wg1.z, wg1.w}, w2g[4] = {wg2.x, wg2.y, wg2.z, wg2.w}, bgg[4] = {bg.x, bg.y, bg.z, bg.w};
            const float w0u[4] = {wu0.x, wu0.y, wu0.z, wu0.w}, w1u[4] = {wu1.x, wu1.y, wu1.z, wu1.w}, w2u[4] = {wu2.x, wu2.y, wu2.z, wu2.w}, buu[4] = {bu.x, bu.y, bu.z, bu.w};
#pragma unroll
            for (int ai = 0; ai < 2; ++ai) {
                const int swr = wr ^ 1, sai = (wr == 1) ? ai : 0;
                const LAS float* xs = xch + (((swr * 4 + wc) * 2 + sai) * 2) * 64 + (bj * 2) * 16 + 4 * fq;
                f32x4 pg1 = *(const LAS f32x4*)(xs + 64), pg2 = *(const LAS f32x4*)(xs), pu1 = *(const LAS f32x4*)(xs + 64 + 16), pu2 = *(const LAS f32x4*)(xs + 16);
                f32x4 g1p = pg1, g2p = (fr == 1) ? pg1 : pg2, u1p = pu1, u2p = (fr == 1) ? pu1 : pu2;
#pragma unroll
                for (int m = 0; m < 4; ++m) {
                    const int r = 128 * ai + 64 * wr + 16 * m + fr; const int R = UP_STEP * u.pm - 2 + r;
                    const f32x4 gc = acc[ai][bj][m][0], uc = acc[ai][bj][m][1];
                    f32x4 g1r, g2r, u1r, u2r;
#pragma unroll
                    for (int j = 0; j < 4; ++j) { g1r[j] = dpp_ror<1>(gc[j]); g2r[j] = dpp_ror<2>(gc[j]); u1r[j] = dpp_ror<1>(uc[j]); u2r[j] = dpp_ror<2>(uc[j]); }
                    f32x4 g1 = (fr >= 1) ? g1r : g1p, g2 = (fr >= 2) ? g2r : g2p, u1 = (fr >= 1) ? u1r : u1p, u2 = (fr >= 2) ? u2r : u2p;
                    g1p = g1r; g2p = g2r; u1p = u1r; u2p = u2r;
                    const bool emit = (r >= 2) && (R < MB);
                    if (emit) {
                        float* frow = nullptr;
                        if (R < MP) { const int t = R & (TP - 1);
                            if (t == 0) { g1 = (f32x4){0.f, 0.f, 0.f, 0.f}; u1 = g1; }
                            if (t <= 1) { g2 = (f32x4){0.f, 0.f, 0.f, 0.f}; u2 = g2; }
                            if (t >= TP - 2) frow = out + O_PCONV + ((size_t)(R >> 12) * 2 + (t - (TP - 2))) * FF2;
                        } else { const int s = R - MP, b = s >> 3, tt = s & 7; const float* sp = sconv + (size_t)b * 2 * FF2;
                            if (tt == 0) { const float4 a = *(const float4*)(sp + FF2 + gcol), c = *(const float4*)(sp + FF2 + ucol); g1 = (f32x4){a.x, a.y, a.z, a.w}; u1 = (f32x4){c.x, c.y, c.z, c.w}; }
                            if (tt <= 1) { const float4 a = *(const float4*)(sp + (tt == 0 ? 0 : FF2) + gcol), c = *(const float4*)(sp + (tt == 0 ? 0 : FF2) + ucol); g2 = (f32x4){a.x, a.y, a.z, a.w}; u2 = (f32x4){c.x, c.y, c.z, c.w}; }
                            if (tt >= 6) frow = out + O_SCONV + ((size_t)b * 2 + (tt - 6)) * FF2;
                        }
                        float o[4];
#pragma unroll
                        for (int j = 0; j < 4; ++j) { const float cgv = w0g[j] * g2[j] + w1g[j] * g1[j] + w2g[j] * gc[j] + bgg[j], cuv = w0u[j] * u2[j] + w1u[j] * u1[j] + w2u[j] * uc[j] + buu[j];
                            o[j] = cgv * sigmoidf_(cgv) * cuv; }
                        uint2 w; w.x = pk2(o[0], o[1]); w.y = pk2(o[2], o[3]);
                        *(uint2*)(ACT + (size_t)R * FF + gcol) = w;
                        if (frow) { *(float4*)(frow + gcol) = make_float4(gc[0], gc[1], gc[2], gc[3]); *(float4*)(frow + ucol) = make_float4(uc[0], uc[1], uc[2], uc[3]); }
                    }
                }
            }
        }
    }
};

__device__ __forceinline__ int rowA_of(int rowB) { return rowB < MP ? rowB : MP + ((rowB - MP) >> 3) * 9 + 1 + ((rowB - MP) & 7); }
__device__ __forceinline__ void phase_alora(const Params& p, int tid, int G, int bid) {
    const bf16_t* PR = (const bf16_t*)(p.ws + WS_PROJRW); bf16_t* AL = (bf16_t*)(p.ws + WS_ALORA); const float* mu = p.in[I_MU];
    const int gt = bid * NTHREADS + tid, NT = G * NTHREADS;
    for (int i = gt; i < MB * 64; i += NT) {
        const int rowB = i >> 6, c = (i & 63) * 4, rowA = rowA_of(rowB);
        const uint2 cur = *(const uint2*)(PR + (size_t)rowA * RCOLS + 1536 + c);
        uint2 prv = make_uint2(0u, 0u);
        if (!(rowB < MP && (rowB & (TP - 1)) == 0)) prv = *(const uint2*)(PR + (size_t)(rowA - 1) * RCOLS + 1536 + c);
        const float4 m4 = *(const float4*)(mu + 1536 + c);
        float x[4] = {bflo(cur.x), bfhi(cur.x), bflo(cur.y), bfhi(cur.y)}; const float pv[4] = {bflo(prv.x), bfhi(prv.x), bflo(prv.y), bfhi(prv.y)}; const float mm[4] = {m4.x, m4.y, m4.z, m4.w};
#pragma unroll
        for (int j = 0; j < 4; ++j) { float v = x[j] + (pv[j] - x[j]) * mm[j];
            if (c < 64) v = 1.f - 2.f * __builtin_amdgcn_rcpf(1.f + __expf(2.f * v)); else if (c >= 128) v = sigmoidf_(v);
            x[j] = v; }
        uint2 o; o.x = pk2(x[0], x[1]); o.y = pk2(x[2], x[3]);
        *(uint2*)(AL + (size_t)rowB * KLORA + c) = o;
    }
}


__device__ __forceinline__ void phase_vtrans(const Params& p, LAS unsigned char* lds, int tid, int G, int bid) {
    const bf16_t* VR = (const bf16_t*)(p.ws + WS_VROW);
    constexpr int PITCH = 132;
    for (int item = bid; item < BP * 8 * 8; item += G) {
        const int b = item >> 6, h = (item >> 3) & 7, t0 = (item & 7) * 512;
        __syncthreads();
#pragma unroll
        for (int i = 0; i < 8; ++i) { const int piece = tid + 512 * i, row = piece >> 3, c8 = piece & 7;
            const uint4 v = *(const uint4*)(VR + (size_t)(b * TP + t0 + row) * 512 + h * 64 + c8 * 8);
            LAS u32* dst = (LAS u32*)(lds + row * PITCH + c8 * 16); dst[0] = v.x; dst[1] = v.y; dst[2] = v.z; dst[3] = v.w; }
        __syncthreads();
#pragma unroll 1
        for (int lay = 0; lay < 3; ++lay) {
            const int dd = lay == 0 ? 1 : (lay == 1 ? 4 : 16); const int Tdd = TP / dd;
            bf16_t* VT = (bf16_t*)(p.ws + (lay == 0 ? WS_VT1 : (lay == 1 ? WS_VT4 : WS_VT16))) + (size_t)(b * 8 + h) * 64 * TP;
            const int chunk0 = (t0 / dd) >> 5;
#pragma unroll
            for (int i = 0; i < 4; ++i) {
                const int sidx = tid + 512 * i, g = sidx & 3, dp = (sidx >> 2) & 31, rc = sidx >> 7;
                int r, cl; if (lay == 0) { r = 0; cl = rc; } else if (lay == 1) { r = rc & 3; cl = rc >> 2; } else { r = rc; cl = 0; }
                u32 wlo[4], whi[4];
#pragma unroll
                for (int hf = 0; hf < 2; ++hf)
#pragma unroll
                    for (int jp = 0; jp < 2; ++jp) {
                        const int u5a = 16 * hf + 4 * g + 2 * jp; const int ta = (32 * cl + u5a) * dd + r, tb = ta + dd;
                        const u32 wa = *(const LAS u32*)(lds + ta * PITCH + dp * 4), wb = *(const LAS u32*)(lds + tb * PITCH + dp * 4);
                        wlo[hf * 2 + jp] = (wa & 0xffffu) | (wb << 16); whi[hf * 2 + jp] = (wa >> 16) | (wb & 0xffff0000u);
                    }
                bf16_t* dst = VT + (size_t)r * Tdd * 64 + (size_t)(chunk0 + cl) * 2048 + (2 * dp) * 32 + 8 * g;
                *(uint4*)dst = make_uint4(wlo[0], wlo[1], wlo[2], wlo[3]); *(uint4*)(dst + 32) = make_uint4(whi[0], whi[1], whi[2], whi[3]);
            }
        }
    }
    __syncthreads();
}

constexpr int CH = 32;
constexpr int SST = 452;
constexpr int SI_W = 0, SI_A = 64, SI_B = 128, SI_K = 192, SI_WR = 256, SI_V = 320, SI_G = 384, SI_SC = 448;
struct PrepRegs { uint2 cr, ck, cv, pr, pk, pv, dw, da, dg; };
__device__ __forceinline__ void scan_item(const Params& p, LAS unsigned char* lds, int tid, bool sample, int b, int h, int half) {
    const bf16_t* PR = (const bf16_t*)(p.ws + WS_PROJRW); const bf16_t* DAG = (const bf16_t*)((const unsigned char*)p.out + SC_B);
    float* YG = (float*)(p.ws + WS_Y);
    LAS float* buf0 = (LAS float*)lds; LAS float* buf1 = buf0 + CH * SST; LAS float* ybuf = buf1 + CH * SST;
    const int T = sample ? TS : TP;
    const int rowB0 = sample ? MP + b * TS : b * TP;
    const int rowA0 = sample ? MP + b * 9 + 1 : b * TP;
    const int nch = (T + CH - 1) / CH;
    const int ptl = tid >> 4, pj = (tid & 15) * 4, pc = h * 64 + pj;
    const int lane = tid & 63, wv = tid >> 6, rg = wv * 4 + (lane >> 4), cgi = lane & 15;
    const int row = 32 * half + rg;
    float st[4];
    if (sample) {
        const float4 a = *(const float4*)(p.in[I_SWKV] + ((size_t)(b * 8 + h) * 64 + row) * 64 + 4 * cgi);
        st[0] = a.x; st[1] = a.y; st[2] = a.z; st[3] = a.w;
    } else {
#pragma unroll
        for (int j = 0; j < 4; ++j) st[j] = 0.f;
    }
    const float4 mur = *(const float4*)(p.in[I_MU] + pc), muk = *(const float4*)(p.in[I_MU] + 512 + pc), muv = *(const float4*)(p.in[I_MU] + 1024 + pc);
    const float4 kk4 = *(const float4*)(p.in[I_KK] + pc), ka4 = *(const float4*)(p.in[I_KA] + pc), rk4 = *(const float4*)(p.in[I_RK] + pc);
    __builtin_amdgcn_s_waitcnt(0x0F70);
    PrepRegs R;
#define SCAN_LOAD(chunk) do { const int t_ = (chunk) * CH + ptl; if (t_ < T) { const size_t ra = (size_t)(rowA0 + t_) * RCOLS + pc; const size_t rb = (size_t)(rowB0 + t_) * NLORA + pc; \
        R.cr = *(const uint2*)(PR + ra); R.ck = *(const uint2*)(PR + ra + 512); R.cv = *(const uint2*)(PR + ra + 1024); \
        if (!sample && t_ == 0) { R.pr = make_uint2(0u, 0u); R.pk = R.pr; R.pv = R.pr; } \
        else { R.pr = *(const uint2*)(PR + ra - RCOLS); R.pk = *(const uint2*)(PR + ra - RCOLS + 512); R.pv = *(const uint2*)(PR + ra - RCOLS + 1024); } \
        R.dw = *(const uint2*)(DAG + rb); R.da = *(const uint2*)(DAG + rb + 512); R.dg = *(const uint2*)(DAG + rb + 1024); } } while (0)
#define SCAN_PREP(chunk, dstbuf) do { const int t_ = (chunk) * CH + ptl; if (t_ < T) { \
        const float mr[4] = {mur.x, mur.y, mur.z, mur.w}, mk[4] = {muk.x, muk.y, muk.z, muk.w}, mv[4] = {muv.x, muv.y, muv.z, muv.w}; \
        const float kkc[4] = {kk4.x, kk4.y, kk4.z, kk4.w}, kac[4] = {ka4.x, ka4.y, ka4.z, ka4.w}, rkc[4] = {rk4.x, rk4.y, rk4.z, rk4.w}; \
        const float crr[4] = {bflo(R.cr.x), bfhi(R.cr.x), bflo(R.cr.y), bfhi(R.cr.y)}, ckk[4] = {bflo(R.ck.x), bfhi(R.ck.x), bflo(R.ck.y), bfhi(R.ck.y)}, cvv[4] = {bflo(R.cv.x), bfhi(R.cv.x), bflo(R.cv.y), bfhi(R.cv.y)}; \
        const float prr[4] = {bflo(R.pr.x), bfhi(R.pr.x), bflo(R.pr.y), bfhi(R.pr.y)}, pkk[4] = {bflo(R.pk.x), bfhi(R.pk.x), bflo(R.pk.y), bfhi(R.pk.y)}, pvv[4] = {bflo(R.pv.x), bfhi(R.pv.x), bflo(R.pv.y), bfhi(R.pv.y)}; \
        const float lw[4] = {bflo(R.dw.x), bfhi(R.dw.x), bflo(R.dw.y), bfhi(R.dw.y)}, aa[4] = {bflo(R.da.x), bfhi(R.da.x), bflo(R.da.y), bfhi(R.da.y)}, gg[4] = {bflo(R.dg.x), bfhi(R.dg.x), bflo(R.dg.y), bfhi(R.dg.y)}; \
        float r_[4], k_[4], v_[4], w_[4], kn[4], k2[4]; float nrm = 0.f; \
        _Pragma("unroll") for (int j = 0; j < 4; ++j) { r_[j] = crr[j] + (prr[j] - crr[j]) * mr[j]; k_[j] = ckk[j] + (pkk[j] - ckk[j]) * mk[j]; v_[j] = cvv[j] + (pvv[j] - cvv[j]) * mv[j]; \
            w_[j] = __expf(lw[j]); kn[j] = k_[j] * kkc[j]; nrm += kn[j] * kn[j]; k2[j] = k_[j] * (1.f + (aa[j] - 1.f) * kac[j]); } \
        nrm = row16_sum(nrm); const float inv = __builtin_amdgcn_rsqf(fmaxf(nrm, 1e-24f)); \
        float br = 0.f, kr = 0.f, rk = 0.f; float an[4], bn[4], wrr[4]; \
        _Pragma("unroll") for (int j = 0; j < 4; ++j) { const float kkn = kn[j] * inv; an[j] = -kkn; bn[j] = kkn * aa[j]; wrr[j] = w_[j] * r_[j]; br += bn[j] * r_[j]; kr += k2[j] * r_[j]; rk += r_[j] * k2[j] * rkc[j]; } \
        br = row16_sum(br); kr = row16_sum(kr); rk = row16_sum(rk); \
        LAS float* rec = (dstbuf) + ptl * SST; \
        *(LAS f32x4*)(rec + SI_W + pj) = (f32x4){w_[0], w_[1], w_[2], w_[3]}; *(LAS f32x4*)(rec + SI_A + pj) = (f32x4){an[0], an[1], an[2], an[3]}; \
        *(LAS f32x4*)(rec + SI_B + pj) = (f32x4){bn[0], bn[1], bn[2], bn[3]}; *(LAS f32x4*)(rec + SI_K + pj) = (f32x4){k2[0], k2[1], k2[2], k2[3]}; \
        *(LAS f32x4*)(rec + SI_WR + pj) = (f32x4){wrr[0], wrr[1], wrr[2], wrr[3]}; *(LAS f32x4*)(rec + SI_V + pj) = (f32x4){v_[0], v_[1], v_[2], v_[3]}; \
        *(LAS f32x4*)(rec + SI_G + pj) = (f32x4){gg[0], gg[1], gg[2], gg[3]}; \
        if ((tid & 15) == 0) *(LAS f32x4*)(rec + SI_SC) = (f32x4){br, kr, rk, 0.f}; } } while (0)

    SCAN_LOAD(0);
    SCAN_PREP(0, buf0);
    __syncthreads();
    for (int c = 0; c < nch; ++c) {
        LAS float* cur = (c & 1) ? buf1 : buf0; LAS float* nxt = (c & 1) ? buf0 : buf1;
        if (c + 1 < nch) SCAN_LOAD(c + 1);
        const int ns = (T - c * CH) < CH ? (T - c * CH) : CH;
        {
            const LAS float* rec = cur;
            f32x4 wA = *(const LAS f32x4*)(rec + SI_W + 4 * cgi), aA = *(const LAS f32x4*)(rec + SI_A + 4 * cgi), bA = *(const LAS f32x4*)(rec + SI_B + 4 * cgi);
            f32x4 kA = *(const LAS f32x4*)(rec + SI_K + 4 * cgi), rA = *(const LAS f32x4*)(rec + SI_WR + 4 * cgi);
            float vA = rec[SI_V + row]; pg8::f32x2 cA = *(const LAS pg8::f32x2*)(rec + SI_SC);
            f32x4 wB, aB, bB, kB, rB; float vB; pg8::f32x2 cB;
#define SCAN_FETCH(W, A, B, K, R, V, C) do { rec += SST; W = *(const LAS f32x4*)(rec + SI_W + 4 * cgi); A = *(const LAS f32x4*)(rec + SI_A + 4 * cgi); B = *(const LAS f32x4*)(rec + SI_B + 4 * cgi); \
            K = *(const LAS f32x4*)(rec + SI_K + 4 * cgi); R = *(const LAS f32x4*)(rec + SI_WR + 4 * cgi); V = rec[SI_V + row]; C = *(const LAS pg8::f32x2*)(rec + SI_SC); } while (0)
#define SCAN_STEP(W, A, B, K, R, V, C, qq) do { \
            float da = mul_(st[0], A[0]), da2 = mul_(st[2], A[2]); float dw = mul_(st[0], R[0]), dw2 = mul_(st[2], R[2]); \
            da = fma_(st[1], A[1], da); da2 = fma_(st[3], A[3], da2); dw = fma_(st[1], R[1], dw); dw2 = fma_(st[3], R[3], dw2); da += da2; dw += dw2; \
            float tt_[4]; row16_sum2_mul4(da, dw, tt_, V, K[0], K[1], K[2], K[3]); \
            const float y = fma_(V, C[1], fma_(da, C[0], dw)); \
            _Pragma("unroll") for (int j = 0; j < 4; ++j) st[j] = fma_(st[j], W[j], fma_(da, B[j], tt_[j])); \
            yk = ((qq) == cgi) ? y : yk; } while (0)
            for (int tb = 0; tb < ns; tb += 16) {
                const int nq = (ns - tb) < 16 ? (ns - tb) : 16;
                float yk = 0.f;
                for (int q = 0; q < nq; q += 2) {
                    SCAN_FETCH(wB, aB, bB, kB, rB, vB, cB);
                    SCAN_STEP(wA, aA, bA, kA, rA, vA, cA, q);
                    SCAN_FETCH(wA, aA, bA, kA, rA, vA, cA);
                    SCAN_STEP(wB, aB, bB, kB, rB, vB, cB, q + 1);
                }
                ybuf[(tb + cgi) * 32 + rg] = yk;
            }
#undef SCAN_FETCH
#undef SCAN_STEP
        }
        __syncthreads();
        if (ptl < ns) {
            const pg8::f32x2 y2 = *(const LAS pg8::f32x2*)(ybuf + ptl * 32 + 2 * (tid & 15));
            *(float2*)(YG + (size_t)(rowB0 + c * CH + ptl) * 512 + h * 64 + 32 * half + 2 * (tid & 15)) = make_float2(y2[0], y2[1]);
        }
        if (c + 1 < nch) SCAN_PREP(c + 1, nxt);
        __syncthreads();
    }
#undef SCAN_LOAD
#undef SCAN_PREP
    float* So = p.out + (sample ? O_SWKV : O_PWKV) + ((size_t)(b * 8 + h) * 64 + row) * 64 + 4 * cgi;
    *(float4*)So = make_float4(st[0], st[1], st[2], st[3]);
}

__device__ __forceinline__ void phase_wkvfin(const Params& p, int tid, int G, int bid) {
    const bf16_t* PR = (const bf16_t*)(p.ws + WS_PROJRW); const bf16_t* DAG = (const bf16_t*)((const unsigned char*)p.out + SC_B);
    const float* YG = (const float*)(p.ws + WS_Y); bf16_t* MIX = (bf16_t*)((unsigned char*)p.out + SC_C);
    const int gt = bid * NTHREADS + tid, NT = G * NTHREADS;
    for (int i = gt; i < MB * 128; i += NT) {
        const int jq = i & 15, h = (i >> 4) & 7, rowB = i >> 7, pc = h * 64 + jq * 4, rowA = rowA_of(rowB);
        const size_t ra = (size_t)rowA * RCOLS + pc;
        const uint2 cr = *(const uint2*)(PR + ra), ck = *(const uint2*)(PR + ra + 512), cv = *(const uint2*)(PR + ra + 1024);
        uint2 pr = make_uint2(0u, 0u), pk = pr, pv = pr;
        if (!(rowB < MP && (rowB & (TP - 1)) == 0)) { pr = *(const uint2*)(PR + ra - RCOLS); pk = *(const uint2*)(PR + ra - RCOLS + 512); pv = *(const uint2*)(PR + ra - RCOLS + 1024); }
        const uint2 da = *(const uint2*)(DAG + (size_t)rowB * NLORA + 512 + pc), dg = *(const uint2*)(DAG + (size_t)rowB * NLORA + 1024 + pc);
        const float4 y4 = *(const float4*)(YG + (size_t)rowB * 512 + pc);
        const float4 mur = *(const float4*)(p.in[I_MU] + pc), muk = *(const float4*)(p.in[I_MU] + 512 + pc), muv = *(const float4*)(p.in[I_MU] + 1024 + pc);
        const float4 ka4 = *(const float4*)(p.in[I_KA] + pc), rk4 = *(const float4*)(p.in[I_RK] + pc), lw4 = *(const float4*)(p.in[I_LNW] + pc), lb4 = *(const float4*)(p.in[I_LNB] + pc);
        const float mr[4] = {mur.x, mur.y, mur.z, mur.w}, mk[4] = {muk.x, muk.y, muk.z, muk.w}, mv[4] = {muv.x, muv.y, muv.z, muv.w};
        const float kac[4] = {ka4.x, ka4.y, ka4.z, ka4.w}, rkc[4] = {rk4.x, rk4.y, rk4.z, rk4.w}, lw[4] = {lw4.x, lw4.y, lw4.z, lw4.w}, lb[4] = {lb4.x, lb4.y, lb4.z, lb4.w};
        const float crr[4] = {bflo(cr.x), bfhi(cr.x), bflo(cr.y), bfhi(cr.y)}, ckk[4] = {bflo(ck.x), bfhi(ck.x), bflo(ck.y), bfhi(ck.y)}, cvv[4] = {bflo(cv.x), bfhi(cv.x), bflo(cv.y), bfhi(cv.y)};
        const float prr[4] = {bflo(pr.x), bfhi(pr.x), bflo(pr.y), bfhi(pr.y)}, pkk[4] = {bflo(pk.x), bfhi(pk.x), bflo(pk.y), bfhi(pk.y)}, pvv[4] = {bflo(pv.x), bfhi(pv.x), bflo(pv.y), bfhi(pv.y)};
        const float aa[4] = {bflo(da.x), bfhi(da.x), bflo(da.y), bfhi(da.y)}, gg[4] = {bflo(dg.x), bfhi(dg.x), bflo(dg.y), bfhi(dg.y)};
        const float yy[4] = {y4.x, y4.y, y4.z, y4.w};
        float v_[4]; float rk = 0.f;
#pragma unroll
        for (int j = 0; j < 4; ++j) { const float r_ = crr[j] + (prr[j] - crr[j]) * mr[j], k_ = ckk[j] + (pkk[j] - ckk[j]) * mk[j]; v_[j] = cvv[j] + (pvv[j] - cvv[j]) * mv[j];
            const float k2 = k_ * (1.f + (aa[j] - 1.f) * kac[j]); rk += r_ * k2 * rkc[j]; }
        rk = row16_sum(rk);
        const float mean = row16_sum((yy[0] + yy[1]) + (yy[2] + yy[3])) * (1.f / 64.f);
        float d[4]; float vs = 0.f;
#pragma unroll
        for (int j = 0; j < 4; ++j) { d[j] = yy[j] - mean; vs += d[j] * d[j]; }
        const float rs = rsqrtf(row16_sum(vs) * (1.f / 64.f) + 64e-5f);
        float o[4];
#pragma unroll
        for (int j = 0; j < 4; ++j) o[j] = (d[j] * rs * lw[j] + lb[j] + rk * v_[j]) * gg[j];
        uint2 w; w.x = pk2(o[0], o[1]); w.y = pk2(o[2], o[3]);
        *(uint2*)(MIX + (size_t)rowB * D + pc) = w;
    }
}

__device__ __forceinline__ void attn_task(const Params& p, int task, int lane) {
    const bf16_t* Q = (const bf16_t*)(p.ws + WS_Q); const bf16_t* K = (const bf16_t*)(p.ws + WS_K);
    bf16_t* MIX = (bf16_t*)((unsigned char*)p.out + SC_C);
    const int b = task >> 11, h = (task >> 8) & 7, r16 = (task >> 4) & 15, ig = task & 15;
    const int li = lane & 15, g = lane >> 4;
    const int tq = r16 + 16 * (16 * ig + li);
    const bf16_t* qp = Q + (size_t)(b * TP + tq) * 512 + h * 64 + 8 * g;
    const bf16x8 qf0 = *(const bf16x8*)qp, qf1 = *(const bf16x8*)(qp + 32);
    float m_run = -1e30f, l_run = 0.f;
    f32x4 o[4];
#pragma unroll
    for (int i = 0; i < 4; ++i) o[i] = (f32x4){0.f, 0.f, 0.f, 0.f};
#pragma unroll 1
    for (int br = 0; br < 3; ++br) {
        int dd, r, uq0, Tdd; const bf16_t* VT;
        if (br == 0) { dd = 16; r = r16; uq0 = 16 * ig; Tdd = TP / 16; VT = (const bf16_t*)(p.ws + WS_VT16); }
        else if (br == 1) { dd = 4; r = r16 & 3; uq0 = (r16 >> 2) + 64 * ig; Tdd = TP / 4; VT = (const bf16_t*)(p.ws + WS_VT4); }
        else { dd = 1; r = 0; uq0 = r16 + 256 * ig; Tdd = TP; VT = (const bf16_t*)(p.ws + WS_VT1); }
        const int s = 16 / dd, uq = uq0 + s * li;
        int ulo = uq0 - 128; if (ulo < 0) ulo = 0; ulo &= ~31;
        const int uhi = uq0 + 15 * s;
        const bf16_t* Kb = K + ((size_t)b * TP + r) * 512 + h * 64 + 8 * g;
        const bf16_t* Vb = VT + (size_t)(b * 8 + h) * 64 * TP + (size_t)r * Tdd * 64 + li * 32 + 8 * g;
        bf16x8 kx0, kx1, ky0, ky1, vf[4];
        { const bf16_t* kx = Kb + (size_t)(ulo + li) * dd * 512; const bf16_t* ky = kx + (size_t)16 * dd * 512;
          kx0 = *(const bf16x8*)kx; kx1 = *(const bf16x8*)(kx + 32); ky0 = *(const bf16x8*)ky; ky1 = *(const bf16x8*)(ky + 32);
#pragma unroll
          for (int dt = 0; dt < 4; ++dt) vf[dt] = *(const bf16x8*)(Vb + (size_t)(ulo >> 5) * 2048 + dt * 512); }
#pragma unroll 1
        for (int kt = ulo; kt <= uhi; kt += 32) {
            const int ktn = (kt + 32 <= uhi) ? kt + 32 : kt;
            const bf16_t* nkx = Kb + (size_t)(ktn + li) * dd * 512; const bf16_t* nky = nkx + (size_t)16 * dd * 512;
            const bf16x8 nkx0 = *(const bf16x8*)nkx, nkx1 = *(const bf16x8*)(nkx + 32), nky0 = *(const bf16x8*)nky, nky1 = *(const bf16x8*)(nky + 32);
            bf16x8 nvf[4];
#pragma unroll
            for (int dt = 0; dt < 4; ++dt) nvf[dt] = *(const bf16x8*)(Vb + (size_t)(ktn >> 5) * 2048 + dt * 512);
            f32x4 sx = (f32x4){0.f, 0.f, 0.f, 0.f}, sy = (f32x4){0.f, 0.f, 0.f, 0.f};
            sx = __builtin_amdgcn_mfma_f32_16x16x32_bf16(kx0, qf0, sx, 0, 0, 0); sx = __builtin_amdgcn_mfma_f32_16x16x32_bf16(kx1, qf1, sx, 0, 0, 0);
            sy = __builtin_amdgcn_mfma_f32_16x16x32_bf16(ky0, qf0, sy, 0, 0, 0); sy = __builtin_amdgcn_mfma_f32_16x16x32_bf16(ky1, qf1, sy, 0, 0, 0);
            float sv[8]; bool ok[8]; float tmax = -1e30f;
#pragma unroll
            for (int j = 0; j < 4; ++j) { const int dx = uq - (kt + 4 * g + j), dy = dx - 16;
                ok[j] = (unsigned)dx <= 128u; ok[4 + j] = (unsigned)dy <= 128u; sv[j] = ok[j] ? sx[j] : -1e30f; sv[4 + j] = ok[4 + j] ? sy[j] : -1e30f;
                tmax = fmaxf(tmax, fmaxf(sv[j], sv[4 + j])); }
            tmax = fmaxf(tmax, __shfl_xor(tmax, 16)); tmax = fmaxf(tmax, __shfl_xor(tmax, 32));
            const float m_new = fmaxf(m_run, tmax), alpha = __expf(m_run - m_new);
            float pe[8]; float ps = 0.f;
#pragma unroll
            for (int j = 0; j < 8; ++j) { pe[j] = ok[j] ? __expf(sv[j] - m_new) : 0.f; ps += pe[j]; }
            l_run = l_run * alpha + ps; m_run = m_new;
            u32x4 pw; pw[0] = pk2(pe[0], pe[1]); pw[1] = pk2(pe[2], pe[3]); pw[2] = pk2(pe[4], pe[5]); pw[3] = pk2(pe[6], pe[7]);
            const bf16x8 pf = __builtin_bit_cast(bf16x8, pw);
#pragma unroll
            for (int dt = 0; dt < 4; ++dt) { o[dt] *= alpha; o[dt] = __builtin_amdgcn_mfma_f32_16x16x32_bf16(vf[dt], pf, o[dt], 0, 0, 0); }
            kx0 = nkx0; kx1 = nkx1; ky0 = nky0; ky1 = nky1;
#pragma unroll
            for (int dt = 0; dt < 4; ++dt) vf[dt] = nvf[dt];
        }
    }
    float lt = l_run; lt += __shfl_xor(lt, 16); lt += __shfl_xor(lt, 32);
    const float il = 1.f / lt;
    bf16_t* op = MIX + (size_t)(b * TP + tq) * D + 512 + h * 64 + 4 * g;
#pragma unroll
    for (int dt = 0; dt < 4; ++dt) { uint2 w; w.x = pk2(o[dt][0] * il, o[dt][1] * il); w.y = pk2(o[dt][2] * il, o[dt][3] * il); *(uint2*)(op + 16 * dt) = w; }
}
__device__ __forceinline__ void attn_sample_task(const Params& p, int task, int lane, LAS float* wl) {
    const bf16_t* Q = (const bf16_t*)(p.ws + WS_Q); const float* snewk = (const float*)(p.ws + WS_SNEWK); const float* snewv = (const float*)(p.ws + WS_SNEWV);
    const float* CK = p.in[I_CK]; const float* CV = p.in[I_CV];
    bf16_t* MIX = (bf16_t*)((unsigned char*)p.out + SC_C);
    const int b = task >> 6, h = (task >> 3) & 7, tt = task & 7;
    const int rowB = MP + b * TS + tt;
    asm volatile("s_waitcnt lgkmcnt(0)" ::: "memory");
    wl[lane] = bflo((u32)Q[(size_t)rowB * 512 + h * 64 + lane]);
    asm volatile("s_waitcnt lgkmcnt(0)" ::: "memory");
    float mx = -1e30f;
#pragma unroll 1
    for (int c = 0; c < 9; ++c) {
        const int br = c / 3, it = c - br * 3; const int dd = br == 0 ? 1 : (br == 1 ? 4 : 16); const int j = lane + 64 * it;
        const int jc = j <= 128 ? j : 128;
        const int idx = 2048 + tt - jc * dd;
        const float* kr = idx < 2048 ? CK + ((size_t)(b * 2048 + idx) * 8 + h) * 64 : snewk + (size_t)(b * TS + idx - 2048) * 512 + h * 64;
        float s = 0.f;
#pragma unroll
        for (int d4 = 0; d4 < 16; ++d4) { const float4 kv = *(const float4*)(kr + 4 * d4); const f32x4 qv = *(const LAS f32x4*)(wl + 4 * d4);
            s += kv.x * qv[0] + kv.y * qv[1] + kv.z * qv[2] + kv.w * qv[3]; }
        if (j > 128) s = -1e30f;
        wl[64 + c * 64 + lane] = s; mx = fmaxf(mx, s);
    }
#pragma unroll
    for (int o = 1; o < 64; o <<= 1) mx = fmaxf(mx, __shfl_xor(mx, o));
    asm volatile("s_waitcnt lgkmcnt(0)" ::: "memory");
    float ls = 0.f;
#pragma unroll 1
    for (int c = 0; c < 9; ++c) { const float s = wl[64 + c * 64 + lane]; const float e = s > -1e29f ? __expf(s - mx) : 0.f; wl[64 + c * 64 + lane] = e; ls += e; }
    ls = wave_sum(ls);
    asm volatile("s_waitcnt lgkmcnt(0)" ::: "memory");
    float acc = 0.f;
#pragma unroll 1
    for (int c = 0; c < 9; ++c) {
        const int br = c / 3, it = c - br * 3; const int dd = br == 0 ? 1 : (br == 1 ? 4 : 16); const int nj = it < 2 ? 64 : 1;
#pragma unroll 8
        for (int l2 = 0; l2 < nj; ++l2) {
            const int j = l2 + 64 * it; const int idx = 2048 + tt - j * dd;
            const float* vr = idx < 2048 ? CV + ((size_t)(b * 2048 + idx) * 8 + h) * 64 : snewv + (size_t)(b * TS + idx - 2048) * 512 + h * 64;
            acc += wl[64 + c * 64 + l2] * vr[lane];
        }
    }
    const float res = acc / ls;
    const float other = __shfl_xor(res, 1);
    if ((lane & 1) == 0) *(u32*)(MIX + (size_t)rowB * D + 512 + h * 64 + lane) = pk2(res, other);
}

__device__ __forceinline__ void phase_norm1(const Params& p, int tid, int G, int bid) {
    const int wave = tid >> 6, lane = tid & 63, gw = bid * 8 + wave, NGW = G * 8;
    const bf16_t* mix = (const bf16_t*)((const unsigned char*)p.out + SC_B); bf16_t* H2 = (bf16_t*)((unsigned char*)p.out + SC_C);
    for (int row = gw; row < MB; row += NGW) {
        const float* xrow = row < MP ? p.in[I_XP] + (size_t)row * D : p.in[I_XS] + (size_t)(row - MP) * D;
        const uint2* mr = (const uint2*)(mix + (size_t)row * D) + lane; const float4* xr = (const float4*)xrow + lane;
        float4 v[4], x[4]; float s = 0.f;
#pragma unroll
        for (int j = 0; j < 4; ++j) { const uint2 mm = mr[64 * j]; v[j] = make_float4(bflo(mm.x), bfhi(mm.x), bflo(mm.y), bfhi(mm.y)); x[j] = xr[64 * j]; s += (v[j].x * v[j].x + v[j].y * v[j].y) + (v[j].z * v[j].z + v[j].w * v[j].w); }
        const float rs = rsqrtf(wave_sum(s) * (1.f / D) + 1e-6f);
        float s2 = 0.f;
#pragma unroll
        for (int j = 0; j < 4; ++j) { const float4 gg = *((const float4*)p.in[I_NMPOST] + lane + 64 * j);
            x[j].x += v[j].x * rs * gg.x; x[j].y += v[j].y * rs * gg.y; x[j].z += v[j].z * rs * gg.z; x[j].w += v[j].w * rs * gg.w;
            s2 += (x[j].x * x[j].x + x[j].y * x[j].y) + (x[j].z * x[j].z + x[j].w * x[j].w);
            *((float4*)(p.out + (size_t)row * D) + lane + 64 * j) = x[j]; }
        const float rs2 = rsqrtf(wave_sum(s2) * (1.f / D) + 1e-6f);
#pragma unroll
        for (int j = 0; j < 4; ++j) { const float4 gg = *((const float4*)p.in[I_NFPRE] + lane + 64 * j);
            uint2 o; o.x = pk2(x[j].x * rs2 * gg.x, x[j].y * rs2 * gg.y); o.y = pk2(x[j].z * rs2 * gg.z, x[j].w * rs2 * gg.w);
            *((uint2*)(H2 + (size_t)(row + 2) * D) + lane + 64 * j) = o; }
    }
    for (int row = gw; row < 2 + (H2P_ROWS - MB - 2); row += NGW) {
        const int rr = row < 2 ? row : MB + row;
#pragma unroll
        for (int j = 0; j < 4; ++j) *((uint2*)(H2 + (size_t)rr * D) + lane + 64 * j) = make_uint2(0u, 0u);
    }
}
__device__ __forceinline__ void phase_act(const Params& p, int tid, int G, int bid) {
    const int wave = tid >> 6, lane = tid & 63, gw = bid * 8 + wave, NGW = G * 8;
    bf16_t* U = (bf16_t*)(p.ws + WS_U); const bf16_t* halo = (const bf16_t*)(p.ws + WS_HALO);
    const float* cw = p.in[I_CONVW]; const float* cb = p.in[I_CONVB];
    constexpr int NPI = (MP / 32) * 11, NSI = BS * 11;
    for (int it = gw; it < NPI + NSI; it += NGW) {
        const bool sample = it >= NPI; const int q = sample ? it - NPI : it; const int chunk = q / 11, cgp = q - chunk * 11;
        const int col = cgp * 256 + 4 * lane;
        const float4 wg0 = *(const float4*)(cw + col), wg1 = *(const float4*)(cw + FF2 + col), wg2 = *(const float4*)(cw + 2 * FF2 + col), bg = *(const float4*)(cb + col);
        const float4 wu0 = *(const float4*)(cw + FF + col), wu1 = *(const float4*)(cw + FF2 + FF + col), wu2 = *(const float4*)(cw + 2 * FF2 + FF + col), bu = *(const float4*)(cb + FF + col);
        float g2[4], g1[4], u2[4], u1[4];
        int row0, nrows;
        if (!sample) {
            row0 = chunk * 32; nrows = 32;
            if ((row0 & (TP - 1)) == 0) {
#pragma unroll
                for (int j = 0; j < 4; ++j) { g2[j] = 0.f; g1[j] = 0.f; u2[j] = 0.f; u1[j] = 0.f; }
            } else {
                const bf16_t* hp = halo + (size_t)chunk * 2 * FF2;
                const uint2 a = *(const uint2*)(hp + col), c2 = *(const uint2*)(hp + FF2 + col), e = *(const uint2*)(hp + FF + col), f = *(const uint2*)(hp + FF2 + FF + col);
                g2[0] = bflo(a.x); g2[1] = bfhi(a.x); g2[2] = bflo(a.y); g2[3] = bfhi(a.y); g1[0] = bflo(c2.x); g1[1] = bfhi(c2.x); g1[2] = bflo(c2.y); g1[3] = bfhi(c2.y);
                u2[0] = bflo(e.x); u2[1] = bfhi(e.x); u2[2] = bflo(e.y); u2[3] = bfhi(e.y); u1[0] = bflo(f.x); u1[1] = bfhi(f.x); u1[2] = bflo(f.y); u1[3] = bfhi(f.y);
            }
        } else {
            row0 = MP + chunk * TS; nrows = TS;
            const float* sp = p.in[I_SCONV] + (size_t)chunk * 2 * FF2;
            const float4 a = *(const float4*)(sp + col), c2 = *(const float4*)(sp + FF2 + col), e = *(const float4*)(sp + FF + col), f = *(const float4*)(sp + FF2 + FF + col);
            g2[0] = a.x; g2[1] = a.y; g2[2] = a.z; g2[3] = a.w; g1[0] = c2.x; g1[1] = c2.y; g1[2] = c2.z; g1[3] = c2.w;
            u2[0] = e.x; u2[1] = e.y; u2[2] = e.z; u2[3] = e.w; u1[0] = f.x; u1[1] = f.y; u1[2] = f.z; u1[3] = f.w;
        }
        const float w0g[4] = {wg0.x, wg0.y, wg0.z, wg0.w}, w1g[4] = {wg1.x, wg1.y, wg1.z, wg1.w}, w2g[4] = {wg2.x, wg2.y, wg2.z, wg2.w}, bgg[4] = {bg.x, bg.y, bg.z, bg.w};
        const float w0u[4] = {wu0.x, wu0.y, wu0.z, wu0.w}, w1u[4] = {wu1.x, wu1.y, wu1.z, wu1.w}, w2u[4] = {wu2.x, wu2.y, wu2.z, wu2.w}, buu[4] = {bu.x, bu.y, bu.z, bu.w};
        for (int r0 = 0; r0 < nrows; r0 += 8) {
            uint2 gv[8], uv[8];
#pragma unroll
            for (int i = 0; i < 8; ++i) { const bf16_t* rp = U + (size_t)(row0 + r0 + i) * FF2 + col; gv[i] = *(const uint2*)rp; uv[i] = *(const uint2*)(rp + FF); }
#pragma unroll
            for (int i = 0; i < 8; ++i) {
                const float gc[4] = {bflo(gv[i].x), bfhi(gv[i].x), bflo(gv[i].y), bfhi(gv[i].y)}, uc[4] = {bflo(uv[i].x), bfhi(uv[i].x), bflo(uv[i].y), bfhi(uv[i].y)};
                float o[4];
#pragma unroll
                for (int j = 0; j < 4; ++j) {
                    const float cgv = w0g[j] * g2[j] + w1g[j] * g1[j] + w2g[j] * gc[j] + bgg[j];
                    const float cuv = w0u[j] * u2[j] + w1u[j] * u1[j] + w2u[j] * uc[j] + buu[j];
                    o[j] = cgv * sigmoidf_(cgv) * cuv;
                    g2[j] = g1[j]; g1[j] = gc[j]; u2[j] = u1[j]; u1[j] = uc[j];
                }
                uint2 w; w.x = pk2(o[0], o[1]); w.y = pk2(o[2], o[3]);
                *(uint2*)(U + (size_t)(row0 + r0 + i) * FF2 + col) = w;
            }
        }
    }
}
__device__ __forceinline__ void phase_final(const Params& p, int tid, int G, int bid) {
    const int wave = tid >> 6, lane = tid & 63, gw = bid * 8 + wave, NGW = G * 8;
    const float* F = (const float*)(p.ws + WS_F);
    for (int row = gw; row < MB; row += NGW) {
        const float4* fr = (const float4*)(F + (size_t)row * D) + lane; float4* yr = (float4*)(p.out + (size_t)row * D) + lane;
        float4 v[4]; float s = 0.f;
#pragma unroll
        for (int j = 0; j < 4; ++j) { v[j] = fr[64 * j]; s += (v[j].x * v[j].x + v[j].y * v[j].y) + (v[j].z * v[j].z + v[j].w * v[j].w); }
        const float rs = rsqrtf(wave_sum(s) * (1.f / D) + 1e-6f);
#pragma unroll
        for (int j = 0; j < 4; ++j) { const float4 gg = *((const float4*)p.in[I_NFPOST] + lane + 64 * j); float4 x = yr[64 * j];
            x.x += v[j].x * rs * gg.x; x.y += v[j].y * rs * gg.y; x.z += v[j].z * rs * gg.z; x.w += v[j].w * rs * gg.w; yr[64 * j] = x; }
    }
}
__device__ __forceinline__ void phase_cachecopy(const Params& p, int tid, int G, int bid) {
    if (bid < 4) return;
    const int gt = (bid - 4) * NTHREADS + tid, NT = (G - 4) * NTHREADS;
    constexpr int PER_B = 2048 * 512 / 4;
    const float4* snk = (const float4*)(p.ws + WS_SNEWK); const float4* snv = (const float4*)(p.ws + WS_SNEWV);
    for (int i = gt; i < 2 * BS * PER_B; i += NT) {
        const int which = i >= BS * PER_B; const int q = which ? i - BS * PER_B : i; const int b = q / PER_B, r = q - b * PER_B;
        const float4* src = (const float4*)p.in[which ? I_CV : I_CK] + (size_t)b * PER_B;
        float4 v;
        if (r < 2040 * 128) v = src[r + 8 * 128]; else v = (which ? snv : snk)[(size_t)b * TS * 128 + (r - 2040 * 128)];
        ((float4*)(p.out + (which ? O_SV : O_SK)))[(size_t)b * PER_B + r] = v;
    }
}

template <int PH>
__device__ __forceinline__ void run_phase(const Params& p, LAS unsigned char* lds, int tid, int G, int bid) {
    if constexpr (PH == 0) { phase0(p, lds, tid, G, bid); __syncthreads(); }
    else if constexpr (PH == 1) {
        pg8::Gemm g{(const bf16_t*)((const unsigned char*)p.out + SC_B), (const bf16_t*)(p.ws + WS_WIN), MA, DIN, D, D, 256}; pg8::StaticOrder S; S.init(MA, DIN, G, bid);
        EpiProj E{(bf16_t*)(p.ws + WS_PROJRW), (bf16_t*)(p.ws + WS_Q), (bf16_t*)(p.ws + WS_K), (bf16_t*)(p.ws + WS_VROW), (bf16_t*)(p.ws + WS_VT4), (bf16_t*)(p.ws + WS_VT16),
                  (const float*)(p.ws + WS_ROPE), p.out, (float*)(p.ws + WS_SNEWK), (float*)(p.ws + WS_SNEWV)};
        pg8::gemm_phase<EpiProj, pg8::StaticOrder, false>(lds, g, S, E, nullptr);
    } else if constexpr (PH == 2) { phase_alora(p, tid, G, bid); phase_vtrans(p, lds, tid, G, bid); }
    else if constexpr (PH == 3) {
        pg8::Gemm g{(const bf16_t*)(p.ws + WS_ALORA), (const bf16_t*)(p.ws + WS_WLORA), MB, NLORA, KLORA, KLORA, 256}; pg8::StaticOrder S; S.init(MB, NLORA, G, bid);
        EpiDag E{(bf16_t*)((unsigned char*)p.out + SC_B), p.in[I_W0], p.in[I_A0]};
        pg8::gemm_phase<EpiDag, pg8::StaticOrder, false>(lds, g, S, E, nullptr);
    } else if constexpr (PH == 4 || PH == 11 || PH == 12) {
        const int NSCAN = 128;
        if (bid < NSCAN) {
            if constexpr (PH != 12) {
                scan_item(p, lds, tid, false, bid >> 4, (bid >> 1) & 7, bid & 1);
            }
        } else {
            if constexpr (PH != 12) for (int it = bid - NSCAN; it < 512; it += G - NSCAN) scan_item(p, lds, tid, true, it >> 4, (it >> 1) & 7, it & 1);
        }
        if (PH == 4 || (PH == 12 && bid >= NSCAN)) {
            const int wave = tid >> 6, lane = tid & 63, x = bid & 7;
            unsigned* ctr = (unsigned*)(p.ws + WS_BAR) + (PH == 4 ? 16 : 32) + x;
            for (;;) {
                unsigned id = 0; if (lane == 0) id = __hip_atomic_fetch_add(ctr, 1u, __ATOMIC_RELAXED, __HIP_MEMORY_SCOPE_AGENT);
                id = (unsigned)__builtin_amdgcn_readfirstlane((int)id);
                if (id >= 2048u + 256u) break;
                if (id < 2048u) { const int ig = id >> 7, hh = (id >> 4) & 7, r16 = id & 15; attn_task(p, (x << 11) | (hh << 8) | (r16 << 4) | ig, lane); }
                else { const int s = id - 2048; attn_sample_task(p, ((4 * x + (s >> 6)) << 6) | (s & 63), lane, (LAS float*)(lds + wave * 4096)); }
            }
        }
    } else if constexpr (PH == 5) {
        pg8::Gemm g{(const bf16_t*)((const unsigned char*)p.out + SC_C), (const bf16_t*)(p.ws + WS_WOUT), MB, D, D, D, 256}; pg8::StaticOrder S; S.init(MB, D, G, bid);
        EpiBf16S E{(bf16_t*)((unsigned char*)p.out + SC_B), D};
        pg8::gemm_phase<EpiBf16S, pg8::StaticOrder, false>(lds, g, S, E, nullptr);
    } else if constexpr (PH == 6) phase_norm1(p, tid, G, bid);
    else if constexpr (PH == 7) {
        pg8::Gemm g{(const bf16_t*)((const unsigned char*)p.out + SC_C), (const bf16_t*)(p.ws + WS_WUP), UP_TILES * 256, FF2, D, D, UP_STEP}; pg8::StaticOrder S; S.init(UP_TILES * 256, FF2, G, bid);
        EpiUpAct E{(bf16_t*)(p.ws + WS_U), p.out, p.in[I_CONVW], p.in[I_CONVB], p.in[I_SCONV], (LAS float*)(lds + 131072)};
        pg8::gemm_phase<EpiUpAct, pg8::StaticOrder, false>(lds, g, S, E, nullptr);
    } else if constexpr (PH == 8) phase_act(p, tid, G, bid);
    else if constexpr (PH == 9) {
        pg8::Gemm g{(const bf16_t*)(p.ws + WS_U), (const bf16_t*)(p.ws + WS_WDN), MB, D, FF, FF, 256}; pg8::StaticOrder S; S.init(MB, D, G, bid);
        pg8::EpiF32 E{(float*)(p.ws + WS_F), D, nullptr};
        pg8::gemm_phase<pg8::EpiF32, pg8::StaticOrder, false>(lds, g, S, E, nullptr);
        phase_cachecopy(p, tid, G, bid);
    } else if constexpr (PH == 10) { phase_final(p, tid, G, bid); }
    else if constexpr (PH == 13) phase_wkvfin(p, tid, G, bid);
}
__device__ __forceinline__ void grid_bar(unsigned* ctr, unsigned target) {
    asm volatile("s_waitcnt vmcnt(0)" ::: "memory");
    __syncthreads();
    if (threadIdx.x == 0) {
        __builtin_amdgcn_fence(__ATOMIC_RELEASE, "agent");
        asm volatile("s_waitcnt vmcnt(0)" ::: "memory");
        __hip_atomic_fetch_add(ctr, 1u, __ATOMIC_RELAXED, __HIP_MEMORY_SCOPE_AGENT);
        while (__hip_atomic_load(ctr, __ATOMIC_RELAXED, __HIP_MEMORY_SCOPE_AGENT) < target) __builtin_amdgcn_s_sleep(2);
        __builtin_amdgcn_fence(__ATOMIC_ACQUIRE, "agent");
        asm volatile("s_waitcnt vmcnt(0)" ::: "memory");
    }
    __syncthreads();
}
template <int SEAM, int FIRST, int... REST>
__device__ __forceinline__ void run_program(const Params& p, LAS unsigned char* lds, cg::grid_group& grid, int tid, int G, int bid) {
    if (p.en > (int)sizeof...(REST) - 1000) run_phase<FIRST>(p, lds, tid, G, bid);
    if constexpr (sizeof...(REST) > 0) {
        if constexpr (SEAM == 0) grid.sync(); else grid_bar((unsigned*)(p.ws + WS_BAR), (unsigned)(SEAM * G));
        run_program<SEAM + 1, REST...>(p, lds, grid, tid, G, bid);
    }
}
#define PROGRAM 0, 1, 2, 3, 4, 13, 5, 6, 7, 9, 10
__global__ void __launch_bounds__(NTHREADS, 2) hymba_fwd(Params p) {
    extern __shared__ __attribute__((aligned(16))) unsigned char lds_raw[];
    LAS unsigned char* lds = (LAS unsigned char*)lds_raw;
    cg::grid_group grid = cg::this_grid();
    run_program<0, PROGRAM>(p, lds, grid, threadIdx.x, gridDim.x, blockIdx.x);
}

extern "C" void kernel_launch(void* const* d_in, const int* in_sizes, int n_in, void* d_out, int out_size, void* d_ws, size_t ws_size, hipStream_t stream) {
    static int grid = 0;
    if (grid == 0) {
        if (n_in != 28 || (size_t)out_size != O_END || ws_size < WS_TOTAL) { fprintf(stderr, "kernel_launch: unexpected sizes n_in %d out %d ws %zu (need %zu)\n", n_in, out_size, ws_size, (size_t)WS_TOTAL); grid = -1; return; }
        int dev = 0, cus = 0, per_cu = 0;
        hipGetDevice(&dev); hipDeviceGetAttribute(&cus, hipDeviceAttributeMultiprocessorCount, dev);
        if (hipFuncSetAttribute((const void*)hymba_fwd, hipFuncAttributeMaxDynamicSharedMemorySize, LDS_BYTES) != hipSuccess) { fprintf(stderr, "kernel_launch: hipFuncSetAttribute failed\n"); grid = -1; return; }
        hipOccupancyMaxActiveBlocksPerMultiprocessor(&per_cu, (const void*)hymba_fwd, NTHREADS, LDS_BYTES);
        (void)hipGetLastError();
        if (per_cu < 1) per_cu = 1;
        grid = cus;
    }
    if (grid < 0) return;
    Params p{};
    for (int i = 0; i < 28; ++i) p.in[i] = (const float*)d_in[i];
    p.out = (float*)d_out; p.ws = (unsigned char*)d_ws; p.en = 1;
    if (hipMemsetAsync((unsigned char*)d_ws + WS_BAR, 0, 256, stream) != hipSuccess) { fprintf(stderr, "kernel_launch: memset of the barrier word failed\n"); return; }
    void* args[] = {&p};
    hipError_t e = hipLaunchCooperativeKernel((const void*)hymba_fwd, dim3(grid), dim3(NTHREADS), args, LDS_BYTES, stream);
    if (e != hipSuccess) fprintf(stderr, "cooperative launch failed: %s (grid %d)\n", hipGetErrorString(e), grid);
}
```

```cpp
#include <hip/hip_runtime.h>
#include <hip/hip_cooperative_groups.h>
#include <cstdio>
#include <cstdint>
namespace pg8 {
#define PG8_LAS __attribute__((address_space(3)))
typedef unsigned short bf16_t;
typedef short bf16x8 __attribute__((ext_vector_type(8)));
typedef float f32x4 __attribute__((ext_vector_type(4)));
typedef unsigned u32x4 __attribute__((ext_vector_type(4)));
constexpr int BM = 256, BK = 64, HALF = 128, HTB = HALF * BK * 2  , STAGE_BYTES = 8 * HTB, NXCD = 8, WGM = 8;

__host__ __device__ __forceinline__ int lds_byte(int r, int c) { const int st = (r >> 4) * 2 + (c >> 5), rr = r & 15, cc = c & 31, ob = rr * 64 + cc * 2; return st * 1024 + (ob ^ (((ob >> 9) & 1) << 5)); }
__host__ __device__ __forceinline__ void stage_rc(int b, int& R, int& C) { const int st = b / 1024, sb = b % 1024, swz = sb ^ (((sb >> 9) & 1) << 5); R = (st >> 1) * 16 + swz / 64; C = (st & 1) * 32 + (swz % 64) / 2; }
__host__ __device__ __forceinline__ int perm32(int rho) { const int n = rho >> 4, i = rho & 15; return 8 * (i >> 2) + 4 * n + (i & 3); }

struct Unit { int pm, pn; };
struct Gemm { const bf16_t* A; const bf16_t* Bt; int M, N, K, lda, tile_rows; };

struct StaticOrder {
    int nM, nN, nwg, G, c;
    __host__ __device__ void init(int M, int N, int G_, int c_) { nM = M / BM; nN = N / BM; nwg = nM * nN; G = G_; c = c_; }
    __host__ __device__ bool next(int i, Unit& u) const {
        const long L = (long)i * G + c; if (L >= nwg) return false;
        int wgid = (int)L; { const int q = nwg / NXCD, r = nwg % NXCD, xcd = wgid % NXCD, off = wgid / NXCD; wgid = (xcd < r ? xcd * (q + 1) : r * (q + 1) + (xcd - r) * q) + off; }
        const int nig = WGM * nN, gid = wgid / nig, fm = gid * WGM, gsz = (nM - fm) < WGM ? (nM - fm) : WGM;
        u.pm = fm + ((wgid % nig) % gsz); u.pn = (wgid % nig) / gsz; return true;
    }
    __device__ __forceinline__ void a_ready(const Unit&) const {}
    __device__ __forceinline__ void done(const Unit&) const {}
};
__device__ __forceinline__ unsigned cvt_pk_bf16(float lo, float hi) { unsigned r; asm volatile("v_cvt_pk_bf16_f32 %0, %1, %2" : "=v"(r) : "v"(lo), "v"(hi)); return r; }
typedef float f32x2 __attribute__((ext_vector_type(2)));
struct EpiF32 {
    static constexpr bool PERM = false, AFTER_DRAIN = false;
    float* C; int ldc; const float* bias;
    __device__ __forceinline__ void operator()(const f32x4 (&acc)[2][2][4][2], const Unit& u, int wr, int wc, int fr, int fq) const {
        const int row0 = u.pm * BM + wr * 64 + fr, col0 = u.pn * BM + wc * 32 + 4 * fq;
        f32x4 bv[2][2];
#pragma unroll
        for (int bj = 0; bj < 2; ++bj)
#pragma unroll
            for (int n = 0; n < 2; ++n) bv[bj][n] = bias ? *(const f32x4*)(bias + col0 + bj * HALF + n * 16) : (f32x4){0.f, 0.f, 0.f, 0.f};
#pragma unroll
        for (int ai = 0; ai < 2; ++ai)
#pragma unroll
            for (int m = 0; m < 4; ++m) { float* rowp = C + (size_t)(row0 + ai * HALF + m * 16) * ldc + col0;
#pragma unroll
                for (int bj = 0; bj < 2; ++bj)
#pragma unroll
                    for (int n = 0; n < 2; ++n) *(f32x4*)(rowp + bj * HALF + n * 16) = acc[ai][bj][m][n] + bv[bj][n]; }
    }
};
template <class Epi, class Sched, bool STAMP = false>
__device__ __forceinline__ void gemm_phase(PG8_LAS unsigned char* lds, const Gemm g, const Sched& S, const Epi& E, unsigned long long* stamps) {
    const int tid = threadIdx.x, wid = __builtin_amdgcn_readfirstlane(tid >> 6), lane = tid & 63, wr = wid >> 2, wc = wid & 3, fr = lane & 15, fq = lane >> 4;
    const int K = g.K, nt = K / BK;
    int ts_lo = 0, ts_hi = 0, nts = 0; const unsigned long long rt_entry = STAMP ? (unsigned long long)wall_clock64() : 0ull;
#define PG8_STAMP() do { if (STAMP && wid == 0 && nts < 64) { const unsigned long long _c = (unsigned long long)clock64(); \
        ts_lo = (lane == nts) ? (int)(unsigned)_c : ts_lo; ts_hi = (lane == nts) ? (int)(unsigned)(_c >> 32) : ts_hi; ++nts; } } while (0)
    PG8_STAMP();
    unsigned voffA[2], voffB[2];
#pragma unroll
    for (int i = 0; i < 2; ++i) { int R, C; stage_rc(tid * 16 + i * 8192, R, C); const int Rb = Epi::PERM ? ((R & ~31) + perm32(R & 31)) : R;
        voffA[i] = (unsigned)(R * g.lda + C) * 2u; voffB[i] = (unsigned)(Rb * K + C) * 2u; }
    const size_t kstep = (size_t)(BK * 2);
    const size_t hstep = (size_t)HALF * K * 2, hstepA = (size_t)HALF * g.lda * 2;
    const size_t tstep = 2 * hstep, tstepA = (size_t)g.tile_rows * g.lda * 2;
    const unsigned ldsw = (unsigned)wid * 1024u;
    const int aoff = lds_byte(wr * 64 + fr, fq * 8), boff = lds_byte(wc * 32 + fr, fq * 8);
#define PG8_SA(b, h) (((b) * 2 + (h)) * HTB)
#define PG8_SB(b, h) ((4 + (b) * 2 + (h)) * HTB)
#define PG8_STAGE(bufoff, gbase, voff) do { _Pragma("unroll") for (int _i = 0; _i < 2; ++_i) \
        __builtin_amdgcn_global_load_lds((const unsigned*)((const char*)(gbase) + (voff)[_i]), (PG8_LAS unsigned*)(lds + (bufoff) + ldsw + _i * 8192), 16, 0, 0); } while (0)
#define PG8_LDA(dst, b, h) do { _Pragma("unroll") for (int m = 0; m < 4; ++m) _Pragma("unroll") for (int k = 0; k < 2; ++k) dst[m][k] = *(const PG8_LAS bf16x8*)(lds + PG8_SA(b, h) + aoff + m * 2048 + k * 1024); } while (0)
#define PG8_LDB(dst, b, h) do { _Pragma("unroll") for (int n = 0; n < 2; ++n) _Pragma("unroll") for (int k = 0; k < 2; ++k) dst[n][k] = *(const PG8_LAS bf16x8*)(lds + PG8_SB(b, h) + boff + n * 2048 + k * 1024); } while (0)
#define PG8_MMA(ai, bj, At, Bt) do { __builtin_amdgcn_s_setprio(1); _Pragma("unroll") for (int m = 0; m < 4; ++m) _Pragma("unroll") for (int n = 0; n < 2; ++n) _Pragma("unroll") for (int k = 0; k < 2; ++k) \
        acc[ai][bj][m][n] = __builtin_amdgcn_mfma_f32_16x16x32_bf16(Bt[n][k], At[m][k], acc[ai][bj][m][n], 0, 0, 0); __builtin_amdgcn_s_setprio(0); } while (0)
#define PG8_WAIT_V(n) asm volatile("s_waitcnt vmcnt(" #n ")" ::: "memory")
#define PG8_WAIT_L(n) asm volatile("s_waitcnt lgkmcnt(" #n ")" ::: "memory")
#define PG8_BAR __builtin_amdgcn_s_barrier()
#define PG8_SCHED __builtin_amdgcn_sched_barrier(0)
    Unit cur, nxt; int ui = 0;
    if (!S.next(0, cur)) return;
    f32x4 acc[2][2][4][2];
#pragma unroll
    for (int a = 0; a < 2; ++a)
#pragma unroll
        for (int b = 0; b < 2; ++b)
#pragma unroll
            for (int m = 0; m < 4; ++m)
#pragma unroll
                for (int n = 0; n < 2; ++n) acc[a][b][m][n] = (f32x4){0.f, 0.f, 0.f, 0.f};
    bf16x8 At[4][2], B0[2][2], B1[2][2];
    const char* cA = (const char*)g.A + (size_t)cur.pm * tstepA; const char* cB = (const char*)g.Bt + (size_t)cur.pn * tstep;
    S.a_ready(cur);
    PG8_STAGE(PG8_SB(0, 0), cB, voffB); PG8_STAGE(PG8_SA(0, 0), cA, voffA); PG8_STAGE(PG8_SB(0, 1), cB + hstep, voffB); PG8_STAGE(PG8_SA(0, 1), cA + hstepA, voffA);
    if (wr == 1) PG8_BAR;
    PG8_WAIT_V(4); PG8_BAR;
    PG8_STAGE(PG8_SB(1, 0), cB + kstep, voffB); PG8_STAGE(PG8_SA(1, 0), cA + kstep, voffA); PG8_STAGE(PG8_SB(1, 1), cB + hstep + kstep, voffB);
    PG8_WAIT_V(6); PG8_BAR;
    PG8_STAMP();
    for (;;) {
        const bool has_next = S.next(ui + 1, nxt);
        const char* nA = has_next ? (const char*)g.A + (size_t)nxt.pm * tstepA : cA; const char* nB = has_next ? (const char*)g.Bt + (size_t)nxt.pn * tstep : cB;
        for (int t = 0; t < nt; t += 2) {
            const bool last = (t == nt - 2);
            const char* a1 = cA + (size_t)(t + 1) * kstep;
            const char* a2 = last ? nA : cA + (size_t)(t + 2) * kstep; const char* b2 = last ? nB : cB + (size_t)(t + 2) * kstep;
            const char* a3 = a2 + kstep; const char* b3 = b2 + kstep;
            if (last && has_next) S.a_ready(nxt);
            PG8_LDB(B0, 0, 0); PG8_SCHED; PG8_LDA(At, 0, 0); PG8_STAGE(PG8_SA(1, 1), a1 + hstepA, voffA);
            PG8_WAIT_L(8); PG8_BAR; PG8_WAIT_L(0); PG8_MMA(0, 0, At, B0); PG8_BAR; PG8_SCHED;
            PG8_LDB(B1, 0, 1); PG8_STAGE(PG8_SB(0, 0), b2, voffB);
            PG8_BAR; PG8_WAIT_L(0); PG8_MMA(0, 1, At, B1); PG8_BAR;
            PG8_LDA(At, 0, 1); PG8_STAGE(PG8_SA(0, 0), a2, voffA);
            PG8_BAR; PG8_WAIT_L(0); PG8_MMA(1, 0, At, B0); PG8_BAR; PG8_SCHED;
            PG8_STAGE(PG8_SB(0, 1), b2 + hstep, voffB);
            PG8_WAIT_V(6); PG8_BAR; PG8_MMA(1, 1, At, B1); PG8_BAR;
            PG8_LDB(B0, 1, 0); PG8_SCHED; PG8_LDA(At, 1, 0); PG8_STAGE(PG8_SA(0, 1), a2 + hstepA, voffA);
            PG8_WAIT_L(8); PG8_BAR; PG8_WAIT_L(0); PG8_MMA(0, 0, At, B0); PG8_BAR; PG8_SCHED;
            PG8_LDB(B1, 1, 1); PG8_STAGE(PG8_SB(1, 0), b3, voffB);
            PG8_BAR; PG8_WAIT_L(0); PG8_MMA(0, 1, At, B1); PG8_BAR;
            PG8_LDA(At, 1, 1); PG8_STAGE(PG8_SA(1, 0), a3, voffA);
            PG8_BAR; PG8_WAIT_L(0); PG8_MMA(1, 0, At, B0); PG8_BAR; PG8_SCHED;
            PG8_STAGE(PG8_SB(1, 1), b3 + hstep, voffB);
            PG8_WAIT_V(6); PG8_BAR; PG8_MMA(1, 1, At, B1); PG8_BAR;
        }
        PG8_STAMP();
        if constexpr (!Epi::AFTER_DRAIN) { E(acc, cur, wr, wc, fr, fq); S.done(cur); }
        PG8_STAMP();
        if (!has_next) break;
#pragma unroll
        for (int a = 0; a < 2; ++a)
#pragma unroll
            for (int b = 0; b < 2; ++b)
#pragma unroll
                for (int m = 0; m < 4; ++m)
#pragma unroll
                    for (int n = 0; n < 2; ++n) acc[a][b][m][n] = (f32x4){0.f, 0.f, 0.f, 0.f};
        cur = nxt; cA = nA; cB = nB; ++ui;
    }
    PG8_WAIT_V(0);
    if (wr == 0) PG8_BAR;
    PG8_BAR;
    if constexpr (Epi::AFTER_DRAIN) { E.fused(acc, cur, wr, wc, fr, fq, lds, wid, lane); S.done(cur); }
    PG8_STAMP();
    if (STAMP && wid == 0) { stamps[lane] = lane < nts ? (((unsigned long long)(unsigned)ts_hi << 32) | (unsigned)ts_lo) : 0ull;
        if (lane == 62) stamps[62] = rt_entry; if (lane == 63) stamps[63] = (unsigned long long)wall_clock64(); }
#undef PG8_STAMP
#undef PG8_SA
#undef PG8_SB
#undef PG8_STAGE
#undef PG8_LDA
#undef PG8_LDB
#undef PG8_MMA
#undef PG8_WAIT_V
#undef PG8_WAIT_L
#undef PG8_BAR
#undef PG8_SCHED
}
}

namespace cg = cooperative_groups;
#define LAS __attribute__((address_space(3)))
typedef unsigned short bf16_t;
typedef unsigned int u32;
typedef pg8::bf16x8 bf16x8;
typedef pg8::f32x4 f32x4;
typedef pg8::u32x4 u32x4;

constexpr int D = 1024, TP = 4096, BP = 8, MP = BP * TP, BS = 32, TS = 8, MS = BS * TS;
constexpr int MB = MP + MS;
constexpr int MA = 33280;
constexpr int MA_REAL = MP + BS * 9;
constexpr int DIN = 3328, RCOLS = 1792, FF = 2816, FF2 = 5632, NLORA = 1536, KLORA = 256;
constexpr int NTHREADS = 512;
constexpr int UP_TILES = 131, UP_STEP = 254, H2P_ROWS = (UP_TILES - 1) * UP_STEP + 256;
constexpr int LDS_BYTES = 144 * 1024;

constexpr size_t O_YP = 0;
constexpr size_t O_YS = O_YP + (size_t)MP * D;
constexpr size_t O_PSH = O_YS + (size_t)MS * D;
constexpr size_t O_PWKV = O_PSH + (size_t)BP * D;
constexpr size_t O_PK = O_PWKV + (size_t)BP * 8 * 64 * 64;
constexpr size_t O_PV = O_PK + (size_t)BP * 2048 * 512;
constexpr size_t O_PCONV = O_PV + (size_t)BP * 2048 * 512;
constexpr size_t O_SSH = O_PCONV + (size_t)BP * 2 * FF2;
constexpr size_t O_SWKV = O_SSH + (size_t)BS * D;
constexpr size_t O_SK = O_SWKV + (size_t)BS * 8 * 64 * 64;
constexpr size_t O_SV = O_SK + (size_t)BS * 2048 * 512;
constexpr size_t O_SCONV = O_SV + (size_t)BS * 2048 * 512;
constexpr size_t O_END = O_SCONV + (size_t)BS * 2 * FF2;

constexpr size_t al256(size_t x) { return (x + 255) & ~(size_t)255; }
constexpr size_t WS_WIN = 0;
constexpr size_t WS_WOUT = WS_WIN + al256((size_t)DIN * D * 2);
constexpr size_t WS_WUP = WS_WOUT + al256((size_t)D * D * 2);
constexpr size_t WS_WDN = WS_WUP + al256((size_t)FF2 * D * 2);
constexpr size_t WS_WLORA = WS_WDN + al256((size_t)D * FF * 2);
constexpr size_t WS_ROPE = WS_WLORA + al256((size_t)NLORA * KLORA * 2);
constexpr int NPOS = 4104;
constexpr size_t WS_SNEWK = WS_ROPE + al256((size_t)NPOS * 32 * 2 * 4);
constexpr size_t WS_SNEWV = WS_SNEWK + al256((size_t)MS * 512 * 4);
constexpr size_t WS_HALO = WS_SNEWV + al256((size_t)MS * 512 * 4);
constexpr size_t WS_A = WS_HALO + al256((size_t)1025 * 2 * FF2 * 2);
constexpr size_t WS_PROJRW = WS_A;
constexpr size_t WS_Q = WS_PROJRW + al256((size_t)MA * RCOLS * 2);
constexpr size_t WS_K = WS_Q + al256((size_t)MB * 512 * 2);
constexpr size_t WS_VT1 = WS_K + al256((size_t)MB * 512 * 2);
constexpr size_t WS_VT4 = WS_VT1 + al256((size_t)BP * 8 * 64 * TP * 2);
constexpr size_t WS_VT16 = WS_VT4 + al256((size_t)BP * 8 * 64 * TP * 2);
constexpr size_t WS_ALORA = WS_VT16 + al256((size_t)BP * 8 * 64 * TP * 2);
constexpr size_t WS_VROW = WS_ALORA + al256((size_t)MB * KLORA * 2);
constexpr size_t WS_A_EARLY_END = WS_VROW + al256((size_t)MP * 512 * 2);
constexpr size_t WS_U = WS_A;
constexpr size_t WS_F = WS_A + al256((size_t)MB * FF * 2);
static_assert(WS_F + (size_t)MB * D * 4 <= WS_A + al256((size_t)MB * FF2 * 2), "region A late overflow");
constexpr size_t WS_END = WS_A + al256((size_t)MB * FF2 * 2);
static_assert(WS_A_EARLY_END <= WS_END, "region A overflow");
constexpr size_t WS_BAR = WS_END;
constexpr size_t WS_TOTAL = WS_END + 256;
constexpr size_t WS_Y = WS_ALORA;
static_assert(WS_Y + (size_t)MB * 512 * 4 <= WS_END, "Y overflow");
constexpr size_t SC_B = O_SK * 4;
constexpr size_t SC_C = SC_B + al256((size_t)MB * D * 4);
static_assert(SC_C + (size_t)H2P_ROWS * D * 2 <= O_SCONV * 4, "scratch overflow");
static_assert((size_t)MA * D * 2 <= (size_t)MB * D * 4 && (size_t)MB * NLORA * 2 <= (size_t)MB * D * 4, "region B");

struct Params {
    const float* in[28];
    float* out;
    unsigned char* ws;
    int en, pad;
};

enum { I_XP = 0, I_XS, I_SSHIFT, I_SWKV, I_CK, I_CV, I_SCONV, I_NMPRE, I_NMPOST, I_NFPRE, I_NFPOST, I_WIN, I_MU, I_W0, I_WDEC, I_A0, I_WICLR, I_WGATE,
       I_KK, I_KA, I_RK, I_LNW, I_LNB, I_WOUT, I_WUP, I_CONVW, I_CONVB, I_WDN };

__device__ __forceinline__ float bflo(u32 p) { return __uint_as_float(p << 16); }
__device__ __forceinline__ float bfhi(u32 p) { return __uint_as_float(p & 0xffff0000u); }
__device__ __forceinline__ u32 pk2(float a, float b) { return pg8::cvt_pk_bf16(a, b); }
__device__ __forceinline__ float wave_sum(float v) {
#pragma unroll
    for (int o = 1; o < 64; o <<= 1) v += __shfl_xor(v, o);
    return v;
}
template <int N> __device__ __forceinline__ float dpp_ror(float x) {
    return __int_as_float(__builtin_amdgcn_update_dpp(0, __float_as_int(x), 0x120 + N, 0xF, 0xF, false));
}
__device__ __forceinline__ float row16_sum(float x) {
    x += dpp_ror<8>(x); x += dpp_ror<4>(x); x += dpp_ror<2>(x); x += dpp_ror<1>(x);
    return x;
}
__device__ __forceinline__ void row16_sum4(float& a, float& b, float& c, float& d) {
    asm volatile("s_nop 1\n\t"
                 "v_add_f32_dpp %0, %0, %0 row_ror:8 row_mask:0xf bank_mask:0xf\n\t" "v_add_f32_dpp %1, %1, %1 row_ror:8 row_mask:0xf bank_mask:0xf\n\t"
                 "v_add_f32_dpp %2, %2, %2 row_ror:8 row_mask:0xf bank_mask:0xf\n\t" "v_add_f32_dpp %3, %3, %3 row_ror:8 row_mask:0xf bank_mask:0xf\n\t"
                 "v_add_f32_dpp %0, %0, %0 row_ror:4 row_mask:0xf bank_mask:0xf\n\t" "v_add_f32_dpp %1, %1, %1 row_ror:4 row_mask:0xf bank_mask:0xf\n\t"
                 "v_add_f32_dpp %2, %2, %2 row_ror:4 row_mask:0xf bank_mask:0xf\n\t" "v_add_f32_dpp %3, %3, %3 row_ror:4 row_mask:0xf bank_mask:0xf\n\t"
                 "v_add_f32_dpp %0, %0, %0 row_ror:2 row_mask:0xf bank_mask:0xf\n\t" "v_add_f32_dpp %1, %1, %1 row_ror:2 row_mask:0xf bank_mask:0xf\n\t"
                 "v_add_f32_dpp %2, %2, %2 row_ror:2 row_mask:0xf bank_mask:0xf\n\t" "v_add_f32_dpp %3, %3, %3 row_ror:2 row_mask:0xf bank_mask:0xf\n\t"
                 "v_add_f32_dpp %0, %0, %0 row_ror:1 row_mask:0xf bank_mask:0xf\n\t" "v_add_f32_dpp %1, %1, %1 row_ror:1 row_mask:0xf bank_mask:0xf\n\t"
                 "v_add_f32_dpp %2, %2, %2 row_ror:1 row_mask:0xf bank_mask:0xf\n\t" "v_add_f32_dpp %3, %3, %3 row_ror:1 row_mask:0xf bank_mask:0xf\n\t"
                 "s_nop 1"
                 : "+v"(a), "+v"(b), "+v"(c), "+v"(d));
}
__device__ __forceinline__ float fma_(float a, float b, float c) { float d; asm("v_fma_f32 %0, %1, %2, %3" : "=v"(d) : "v"(a), "v"(b), "v"(c)); return d; }
__device__ __forceinline__ float mul_(float a, float b) { float d; asm("v_mul_f32 %0, %1, %2" : "=v"(d) : "v"(a), "v"(b)); return d; }
__device__ __forceinline__ void row16_sum2_mul4(float& a, float& b, float (&t)[4], float v, float k0, float k1, float k2, float k3) {
    asm volatile("v_mul_f32 %2, %6, %7\n\t" "v_mul_f32 %3, %6, %8\n\t"
                 "v_add_f32_dpp %0, %0, %0 row_ror:8 row_mask:0xf bank_mask:0xf\n\t" "v_add_f32_dpp %1, %1, %1 row_ror:8 row_mask:0xf bank_mask:0xf\n\t"
                 "v_mul_f32 %4, %6, %9\n\t"
                 "v_add_f32_dpp %0, %0, %0 row_ror:4 row_mask:0xf bank_mask:0xf\n\t" "v_add_f32_dpp %1, %1, %1 row_ror:4 row_mask:0xf bank_mask:0xf\n\t"
                 "v_mul_f32 %5, %6, %10\n\t"
                 "v_add_f32_dpp %0, %0, %0 row_ror:2 row_mask:0xf bank_mask:0xf\n\t" "v_add_f32_dpp %1, %1, %1 row_ror:2 row_mask:0xf bank_mask:0xf\n\t"
                 "s_nop 0\n\t"
                 "v_add_f32_dpp %0, %0, %0 row_ror:1 row_mask:0xf bank_mask:0xf\n\t" "v_add_f32_dpp %1, %1, %1 row_ror:1 row_mask:0xf bank_mask:0xf"
                 : "+v"(a), "+v"(b), "=&v"(t[0]), "=&v"(t[1]), "=&v"(t[2]), "=&v"(t[3])
                 : "v"(v), "v"(k0), "v"(k1), "v"(k2), "v"(k3));
}
__device__ __forceinline__ void row16_sum2(float& a, float& b) {
    asm volatile("s_nop 1\n\t"
                 "v_add_f32_dpp %0, %0, %0 row_ror:8 row_mask:0xf bank_mask:0xf\n\t" "v_add_f32_dpp %1, %1, %1 row_ror:8 row_mask:0xf bank_mask:0xf\n\t" "s_nop 0\n\t"
                 "v_add_f32_dpp %0, %0, %0 row_ror:4 row_mask:0xf bank_mask:0xf\n\t" "v_add_f32_dpp %1, %1, %1 row_ror:4 row_mask:0xf bank_mask:0xf\n\t" "s_nop 0\n\t"
                 "v_add_f32_dpp %0, %0, %0 row_ror:2 row_mask:0xf bank_mask:0xf\n\t" "v_add_f32_dpp %1, %1, %1 row_ror:2 row_mask:0xf bank_mask:0xf\n\t" "s_nop 0\n\t"
                 "v_add_f32_dpp %0, %0, %0 row_ror:1 row_mask:0xf bank_mask:0xf\n\t" "v_add_f32_dpp %1, %1, %1 row_ror:1 row_mask:0xf bank_mask:0xf\n\t"
                 "s_nop 1"
                 : "+v"(a), "+v"(b));
}
__device__ __forceinline__ float sigmoidf_(float x) { return __builtin_amdgcn_rcpf(1.f + __expf(-x)); }

__device__ __forceinline__ int win_rowmap(int n) {
    if (n < RCOLS || n >= RCOLS + 1024) return n;
    const int base = (n < RCOLS + 512) ? RCOLS : RCOLS + 512, c = n - base, unit = c >> 8, cu = c & 255, hu = cu >> 6, d = cu & 63, e = d & 31, s = d >> 5;
    const int idx = hu * 32 + e, bj = idx >> 6, wc = (idx & 63) >> 4, fq = (idx & 15) >> 2, j = idx & 3;
    return base + unit * 256 + 128 * bj + 32 * wc + 16 * s + 4 * fq + j;
}
__device__ __forceinline__ int wup_rowmap(int c) {
    const int isup = c >= FF ? 1 : 0, cc = c - FF * isup, pn = cc >> 7, e = cc & 127;
    return pn * 256 + 128 * (e >> 6) + 32 * ((e >> 4) & 3) + 16 * isup + 4 * ((e >> 2) & 3) + (e & 3);
}
__device__ __forceinline__ void transpose_item(const float* W, int K, int N, bf16_t* WT, int mode, LAS float* scr, int item, int lane) {
    const int nblk = N / 32, kb = item / nblk, nb = item % nblk, k0 = 64 * kb, n0 = 32 * nb;
#pragma unroll 8
    for (int i = 0; i < 32; ++i) { const int kk = 2 * i + (lane >> 5); scr[kk * 33 + (lane & 31)] = W[(size_t)(k0 + kk) * N + n0 + (lane & 31)]; }
    asm volatile("s_waitcnt lgkmcnt(0)" ::: "memory");
    const int c = lane & 7;
#pragma unroll
    for (int j = 0; j < 4; ++j) { const int n = (lane >> 3) + 8 * j; const LAS float* s = scr + (8 * c) * 33 + n;
        uint4 o; o.x = pk2(s[0 * 33], s[1 * 33]); o.y = pk2(s[2 * 33], s[3 * 33]); o.z = pk2(s[4 * 33], s[5 * 33]); o.w = pk2(s[6 * 33], s[7 * 33]);
        const int row = mode == 1 ? win_rowmap(n0 + n) : (mode == 2 ? wup_rowmap(n0 + n) : (n0 + n));
        *(uint4*)(WT + (size_t)row * K + k0 + 8 * c) = o; }
    asm volatile("s_waitcnt lgkmcnt(0)" ::: "memory");
}
__device__ __forceinline__ void rms_row(const float* xrow, const float* g, bf16_t* orow, float* frow, int lane) {
    const float4* xr = (const float4*)xrow + lane; const float4* gr = (const float4*)g + lane;
    float4 v[4]; float s = 0.f;
#pragma unroll
    for (int j = 0; j < 4; ++j) { v[j] = xr[64 * j]; s += (v[j].x * v[j].x + v[j].y * v[j].y) + (v[j].z * v[j].z + v[j].w * v[j].w); }
    const float rs = rsqrtf(wave_sum(s) * (1.f / D) + 1e-6f);
#pragma unroll
    for (int j = 0; j < 4; ++j) { const float4 gg = gr[64 * j];
        float4 y; y.x = v[j].x * rs * gg.x; y.y = v[j].y * rs * gg.y; y.z = v[j].z * rs * gg.z; y.w = v[j].w * rs * gg.w;
        uint2 o; o.x = pk2(y.x, y.y); o.y = pk2(y.z, y.w);
        *((uint2*)orow + lane + 64 * j) = o;
        if (frow) *((float4*)frow + lane + 64 * j) = y; }
}
__device__ __forceinline__ void phase0(const Params& p, LAS unsigned char* lds, int tid, int G, int bid) {
    const int wave = tid >> 6, lane = tid & 63, gw = bid * 8 + wave, NGW = G * 8;
    LAS float* scr = (LAS float*)(lds + wave * 16384);
    bf16_t* WinT = (bf16_t*)(p.ws + WS_WIN); bf16_t* WoutT = (bf16_t*)(p.ws + WS_WOUT); bf16_t* WupT = (bf16_t*)(p.ws + WS_WUP); bf16_t* WdnT = (bf16_t*)(p.ws + WS_WDN);
    constexpr int I1 = (D / 64) * (DIN / 32), I2 = (D / 64) * (D / 32), I3 = (D / 64) * (FF2 / 32), I4 = (FF / 64) * (D / 32);
    for (int it = gw; it < I1 + I2 + I3 + I4; it += NGW) {
        int r = it;
        if (r < I1) { transpose_item(p.in[I_WIN], D, DIN, WinT, 1, scr, r, lane); continue; } r -= I1;
        if (r < I2) { transpose_item(p.in[I_WOUT], D, D, WoutT, 0, scr, r, lane); continue; } r -= I2;
        if (r < I3) { transpose_item(p.in[I_WUP], D, FF2, WupT, 2, scr, r, lane); continue; } r -= I3;
        transpose_item(p.in[I_WDN], FF, D, WdnT, 0, scr, r, lane);
    }
    const int gt = bid * NTHREADS + tid, NT = G * NTHREADS;
    bf16_t* WL = (bf16_t*)(p.ws + WS_WLORA);
    for (int i = gt; i < NLORA * KLORA; i += NT) {
        const int row = i >> 8, k = i & 255; float v = 0.f;
        if (row < 512) { if (k < 64) v = p.in[I_WDEC][k * 512 + row]; }
        else if (row < 1024) { if (k >= 64 && k < 128) v = p.in[I_WICLR][(k - 64) * 512 + (row - 512)]; }
        else { if (k >= 128) v = p.in[I_WGATE][(k - 128) * 512 + (row - 1024)]; }
        WL[i] = (bf16_t)(pk2(v, 0.f) & 0xffffu);
    }
    float* rope = (float*)(p.ws + WS_ROPE);
    for (int i = gt; i < NPOS * 32; i += NT) {
        const int pi = i >> 5, e = i & 31; const int pos = pi < TP ? pi : 16384 + (pi - TP);
        double inv = 1.0; for (int q = 0; q < e; ++q) inv *= 0.7498942093324558273;
        const float ang = (float)pos * (float)inv;
        const double a = (double)ang; const double kq = rint(a * 0.15915494309189535); double r = a - kq * 6.283185307179586; r -= kq * 2.4492935982947064e-16;
        const double r2 = r * r;
        double sn = 1.0 / 51090942171709440000.0;
        sn = sn * r2 * (-1.0) + 1.0 / 121645100408832000.0;
        sn = -sn * r2 + 1.0 / 355687428096000.0;
        sn = -sn * r2 + 1.0 / 1307674368000.0;
        sn = -sn * r2 + 1.0 / 6227020800.0;
        sn = -sn * r2 + 1.0 / 39916800.0;
        sn = -sn * r2 + 1.0 / 362880.0;
        sn = -sn * r2 + 1.0 / 5040.0;
        sn = -sn * r2 + 1.0 / 120.0;
        sn = -sn * r2 + 1.0 / 6.0;
        sn = -sn * r2 + 1.0;
        sn *= r;
        double cs = 1.0 / 1124000727777607680000.0;
        cs = -cs * r2 + 1.0 / 2432902008176640000.0;
        cs = -cs * r2 + 1.0 / 6402373705728000.0;
        cs = -cs * r2 + 1.0 / 20922789888000.0;
        cs = -cs * r2 + 1.0 / 87178291200.0;
        cs = -cs * r2 + 1.0 / 479001600.0;
        cs = -cs * r2 + 1.0 / 3628800.0;
        cs = -cs * r2 + 1.0 / 40320.0;
        cs = -cs * r2 + 1.0 / 720.0;
        cs = -cs * r2 + 1.0 / 24.0;
        cs = -cs * r2 + 0.5;
        cs = -cs * r2 + 1.0;
        rope[i] = (float)cs; rope[NPOS * 32 + i] = (float)sn;
    }
    bf16_t* H = (bf16_t*)((unsigned char*)p.out + SC_B);
    for (int row = gw; row < MA; row += NGW) {
        bf16_t* orow = H + (size_t)row * D;
        if (row < MP) {
            const bool last = (row & (TP - 1)) == TP - 1;
            rms_row(p.in[I_XP] + (size_t)row * D, p.in[I_NMPRE], orow, last ? p.out + O_PSH + (size_t)(row >> 12) * D : nullptr, lane);
        } else {
            const int s = row - MP;
            if (s < BS * 9) {
                const int b = s / 9, j = s - b * 9;
                if (j == 0) {
                    const float4* sr = (const float4*)(p.in[I_SSHIFT] + (size_t)b * D) + lane;
#pragma unroll
                    for (int q = 0; q < 4; ++q) { const float4 v = sr[64 * q]; uint2 o; o.x = pk2(v.x, v.y); o.y = pk2(v.z, v.w); *((uint2*)orow + lane + 64 * q) = o; }
                } else {
                    rms_row(p.in[I_XS] + (size_t)(b * TS + j - 1) * D, p.in[I_NMPRE], orow, j == TS ? p.out + O_SSH + (size_t)b * D : nullptr, lane);
                }
            } else {
#pragma unroll
                for (int q = 0; q < 4; ++q) *((uint2*)orow + lane + 64 * q) = make_uint2(0u, 0u);
            }
        }
    }
}

struct EpiProj {
    static constexpr bool PERM = false, AFTER_DRAIN = false;
    bf16_t* projrw; bf16_t* Q; bf16_t* K; bf16_t* VT1; bf16_t* VT4; bf16_t* VT16; const float* rope; float* out; float* snewk; float* snewv;
    __device__ __forceinline__ void operator()(const f32x4 (&acc)[2][2][4][2], const pg8::Unit& u, int wr, int wc, int fr, int fq) const {
        const int pn = u.pn;
        if (pn < 7) {
#pragma unroll
            for (int ai = 0; ai < 2; ++ai)
#pragma unroll
                for (int m = 0; m < 4; ++m) { const int row = u.pm * 256 + ai * 128 + wr * 64 + m * 16 + fr;
                    bf16_t* rp = projrw + (size_t)row * RCOLS + pn * 256 + wc * 32 + 4 * fq;
#pragma unroll
                    for (int bj = 0; bj < 2; ++bj)
#pragma unroll
                        for (int n = 0; n < 2; ++n) { const f32x4 v = acc[ai][bj][m][n]; uint2 o; o.x = pk2(v[0], v[1]); o.y = pk2(v[2], v[3]); *(uint2*)(rp + bj * 128 + n * 16) = o; } }
            return;
        }
        if (pn < 11 && u.pm < MP / 256) {
            const bool isq = pn < 9; const int unit = isq ? pn - 7 : pn - 9;
            const int rowbase = u.pm * 256 + wr * 64 + fr; const int b = rowbase >> 12, t0 = rowbase & (TP - 1);
#pragma unroll
            for (int bj = 0; bj < 2; ++bj) {
                const int idx = bj * 64 + wc * 16 + fq * 4, hu = idx >> 5, e = idx & 31; const int col = unit * 256 + hu * 64 + e;
                const float4 c16 = *(const float4*)(rope + 16 * 32 + e), s16 = *(const float4*)(rope + (size_t)NPOS * 32 + 16 * 32 + e);
                const float c16a[4] = {c16.x, c16.y, c16.z, c16.w}, s16a[4] = {s16.x, s16.y, s16.z, s16.w};
#pragma unroll
                for (int ai = 0; ai < 2; ++ai) {
                    const int tb = t0 + 128 * ai;
                    const float4 cs4 = *(const float4*)(rope + (size_t)tb * 32 + e), sn4 = *(const float4*)(rope + (size_t)NPOS * 32 + (size_t)tb * 32 + e);
                    float cs[4] = {cs4.x, cs4.y, cs4.z, cs4.w}, sn[4] = {sn4.x, sn4.y, sn4.z, sn4.w};
#pragma unroll
                    for (int m = 0; m < 4; ++m) {
                        const int t = tb + 16 * m; const size_t rowB = (size_t)b * TP + t;
                        const f32x4 x1 = acc[ai][bj][m][0], x2 = acc[ai][bj][m][1];
                        float o1[4], o2[4];
#pragma unroll
                        for (int j = 0; j < 4; ++j) { o1[j] = x1[j] * cs[j] - x2[j] * sn[j]; o2[j] = x1[j] * sn[j] + x2[j] * cs[j]; }
                        if (isq) {
                            uint2 a, c2; a.x = pk2(o1[0] * 0.125f, o1[1] * 0.125f); a.y = pk2(o1[2] * 0.125f, o1[3] * 0.125f); c2.x = pk2(o2[0] * 0.125f, o2[1] * 0.125f); c2.y = pk2(o2[2] * 0.125f, o2[3] * 0.125f);
                            *(uint2*)(Q + rowB * 512 + col) = a; *(uint2*)(Q + rowB * 512 + col + 32) = c2;
                        } else {
                            uint2 a, c2; a.x = pk2(o1[0], o1[1]); a.y = pk2(o1[2], o1[3]); c2.x = pk2(o2[0], o2[1]); c2.y = pk2(o2[2], o2[3]);
                            *(uint2*)(K + rowB * 512 + col) = a; *(uint2*)(K + rowB * 512 + col + 32) = c2;
                            if (t >= 2048) { float* dst = out + O_PK + ((size_t)b * 2048 + (t - 2048)) * 512 + col;
                                *(float4*)dst = make_float4(o1[0], o1[1], o1[2], o1[3]); *(float4*)(dst + 32) = make_float4(o2[0], o2[1], o2[2], o2[3]); }
                        }
#pragma unroll
                        for (int j = 0; j < 4; ++j) { const float nc = cs[j] * c16a[j] - sn[j] * s16a[j], ns = sn[j] * c16a[j] + cs[j] * s16a[j]; cs[j] = nc; sn[j] = ns; }
                    }
                }
            }
            return;
        }
#pragma unroll
        for (int ai = 0; ai < 2; ++ai)
#pragma unroll
            for (int m = 0; m < 4; ++m) {
                const int row = u.pm * 256 + ai * 128 + wr * 64 + m * 16 + fr;
                bool prompt = row < MP; int b, t, rowB, pi; bool valid = true;
                if (prompt) { b = row >> 12; t = row & (TP - 1); rowB = row; pi = t; }
                else { const int s = row - MP; b = s / 9; const int j = s - b * 9; valid = (s < BS * 9) && (j > 0); t = j - 1; rowB = MP + b * TS + t; pi = TP + t; }
                if (!valid) continue;
                if (pn < 11) {
                    const bool isq = pn < 9; const int unit = isq ? pn - 7 : pn - 9;
#pragma unroll
                    for (int bj = 0; bj < 2; ++bj) {
                        const int idx = bj * 64 + wc * 16 + fq * 4, hu = idx >> 5, e = idx & 31;
                        const float4 cs = *(const float4*)(rope + (size_t)pi * 32 + e), sn = *(const float4*)(rope + (size_t)NPOS * 32 + (size_t)pi * 32 + e);
                        const f32x4 x1 = acc[ai][bj][m][0], x2 = acc[ai][bj][m][1];
                        float o1[4], o2[4];
                        o1[0] = x1[0] * cs.x - x2[0] * sn.x; o2[0] = x1[0] * sn.x + x2[0] * cs.x;
                        o1[1] = x1[1] * cs.y - x2[1] * sn.y; o2[1] = x1[1] * sn.y + x2[1] * cs.y;
                        o1[2] = x1[2] * cs.z - x2[2] * sn.z; o2[2] = x1[2] * sn.z + x2[2] * cs.z;
                        o1[3] = x1[3] * cs.w - x2[3] * sn.w; o2[3] = x1[3] * sn.w + x2[3] * cs.w;
                        const int col = unit * 256 + hu * 64 + e;
                        if (isq) {
                            uint2 a, c2; a.x = pk2(o1[0] * 0.125f, o1[1] * 0.125f); a.y = pk2(o1[2] * 0.125f, o1[3] * 0.125f); c2.x = pk2(o2[0] * 0.125f, o2[1] * 0.125f); c2.y = pk2(o2[2] * 0.125f, o2[3] * 0.125f);
                            *(uint2*)(Q + (size_t)rowB * 512 + col) = a; *(uint2*)(Q + (size_t)rowB * 512 + col + 32) = c2;
                        } else {
                            uint2 a, c2; a.x = pk2(o1[0], o1[1]); a.y = pk2(o1[2], o1[3]); c2.x = pk2(o2[0], o2[1]); c2.y = pk2(o2[2], o2[3]);
                            *(uint2*)(K + (size_t)rowB * 512 + col) = a; *(uint2*)(K + (size_t)rowB * 512 + col + 32) = c2;
                            float* dst = nullptr;
                            if (prompt) { if (t >= 2048) dst = out + O_PK + ((size_t)b * 2048 + (t - 2048)) * 512 + col; }
                            else dst = snewk + (size_t)(b * TS + t) * 512 + col;
                            if (dst) { *(float4*)dst = make_float4(o1[0], o1[1], o1[2], o1[3]); *(float4*)(dst + 32) = make_float4(o2[0], o2[1], o2[2], o2[3]); }
                        }
                    }
                } else {
#pragma unroll
                    for (int bj = 0; bj < 2; ++bj)
#pragma unroll
                        for (int n = 0; n < 2; ++n) {
                            const int col = (pn - 11) * 256 + bj * 128 + wc * 32 + n * 16 + 4 * fq; const f32x4 v = acc[ai][bj][m][n];
                            if (prompt) {
                                if (t >= 2048) *(float4*)(out + O_PV + ((size_t)b * 2048 + (t - 2048)) * 512 + col) = make_float4(v[0], v[1], v[2], v[3]);
                                uint2 o; o.x = pk2(v[0], v[1]); o.y = pk2(v[2], v[3]); *(uint2*)(VT1 + (size_t)rowB * 512 + col) = o;
                            } else {
                                *(float4*)(snewv + (size_t)(b * TS + t) * 512 + col) = make_float4(v[0], v[1], v[2], v[3]);
                            }
                        }
                }
            }
    }
};
struct EpiBf16S {
    static constexpr bool PERM = false, AFTER_DRAIN = false;
    bf16_t* O; int ldc;
    __device__ __forceinline__ void operator()(const f32x4 (&acc)[2][2][4][2], const pg8::Unit& u, int wr, int wc, int fr, int fq) const {
#pragma unroll
        for (int ai = 0; ai < 2; ++ai)
#pragma unroll
            for (int m = 0; m < 4; ++m) { bf16_t* rp = O + (size_t)(u.pm * 256 + ai * 128 + wr * 64 + m * 16 + fr) * ldc + u.pn * 256 + wc * 32 + 4 * fq;
#pragma unroll
                for (int bj = 0; bj < 2; ++bj)
#pragma unroll
                    for (int n = 0; n < 2; ++n) { const f32x4 v = acc[ai][bj][m][n]; uint2 o; o.x = pk2(v[0], v[1]); o.y = pk2(v[2], v[3]); *(uint2*)(rp + bj * 128 + n * 16) = o; } }
    }
};
struct EpiDag {
    static constexpr bool PERM = false, AFTER_DRAIN = false;
    bf16_t* dag; const float* w0; const float* a0;
    __device__ __forceinline__ void operator()(const f32x4 (&acc)[2][2][4][2], const pg8::Unit& u, int wr, int wc, int fr, int fq) const {
        const int kind = u.pn >> 1;
#pragma unroll
        for (int bj = 0; bj < 2; ++bj)
#pragma unroll
            for (int n = 0; n < 2; ++n) {
                const int col = u.pn * 256 + bj * 128 + wc * 32 + n * 16 + 4 * fq;
                float4 bias = make_float4(0.f, 0.f, 0.f, 0.f);
                if (kind == 0) bias = *(const float4*)(w0 + col); else if (kind == 1) bias = *(const float4*)(a0 + col - 512);
                const float bb[4] = {bias.x, bias.y, bias.z, bias.w};
#pragma unroll
                for (int ai = 0; ai < 2; ++ai)
#pragma unroll
                    for (int m = 0; m < 4; ++m) { const int row = u.pm * 256 + ai * 128 + wr * 64 + m * 16 + fr; const f32x4 v = acc[ai][bj][m][n]; float o[4];
#pragma unroll
                        for (int j = 0; j < 4; ++j) { const float x = v[j] + bb[j];
                            if (kind == 0) o[j] = -0.60653065971263342f * sigmoidf_(x);
                            else if (kind == 1) o[j] = sigmoidf_(x);
                            else o[j] = x; }
                        uint2 q; q.x = pk2(o[0], o[1]); q.y = pk2(o[2], o[3]); *(uint2*)(dag + (size_t)row * NLORA + col) = q; }
            }
    }
};
struct EpiUp {
    static constexpr bool PERM = false, AFTER_DRAIN = false;
    bf16_t* U; bf16_t* halo; float* out;
    __device__ __forceinline__ void operator()(const f32x4 (&acc)[2][2][4][2], const pg8::Unit& u, int wr, int wc, int fr, int fq) const {
#pragma unroll
        for (int ai = 0; ai < 2; ++ai)
#pragma unroll
            for (int m = 0; m < 4; ++m) {
                const int row = u.pm * 256 + ai * 128 + wr * 64 + m * 16 + fr; const int col0 = u.pn * 256 + wc * 32 + 4 * fq;
                bf16_t* hrow = nullptr; float* frow = nullptr;
                if (row < MP) { const int t = row & (TP - 1);
                    if ((t & 31) >= 30) hrow = halo + ((size_t)((row >> 5) + 1) * 2 + ((t & 31) - 30)) * FF2;
                    if (t >= TP - 2) frow = out + O_PCONV + ((size_t)(row >> 12) * 2 + (t - (TP - 2))) * FF2;
                } else { const int s = row - MP, b = s >> 3, tt = s & 7; if (tt >= 6) frow = out + O_SCONV + ((size_t)b * 2 + (tt - 6)) * FF2; }
#pragma unroll
                for (int bj = 0; bj < 2; ++bj)
#pragma unroll
                    for (int n = 0; n < 2; ++n) { const f32x4 v = acc[ai][bj][m][n]; const int col = col0 + bj * 128 + n * 16;
                        uint2 o; o.x = pk2(v[0], v[1]); o.y = pk2(v[2], v[3]);
                        *(uint2*)(U + (size_t)row * FF2 + col) = o;
                        if (hrow) *(uint2*)(hrow + col) = o;
                        if (frow) *(float4*)(frow + col) = make_float4(v[0], v[1], v[2], v[3]); }
            }
    }
};

struct EpiUpAct {
    static constexpr bool PERM = false, AFTER_DRAIN = false;
    bf16_t* ACT; float* out; const float* cw; const float* cb; const float* sconv; LAS float* xch;
    __device__ __forceinline__ void operator()(const f32x4 (&acc)[2][2][4][2], const pg8::Unit& u, int wr, int wc, int fr, int fq) const {
        const int lane = fq * 16 + fr, wid = wr * 4 + wc;
        if (fr >= 14) {
#pragma unroll
            for (int ai = 0; ai < 2; ++ai)
#pragma unroll
                for (int bj = 0; bj < 2; ++bj)
#pragma unroll
                    for (int n = 0; n < 2; ++n) *(LAS f32x4*)(xch + ((wid * 2 + ai) * 2 + (fr - 14)) * 64 + (bj * 2 + n) * 16 + 4 * fq) = acc[ai][bj][3][n];
        }
        asm volatile("s_waitcnt lgkmcnt(0)" ::: "memory");
        __builtin_amdgcn_s_barrier(); __builtin_amdgcn_s_barrier();
        asm volatile("" ::: "memory");
#pragma unroll
        for (int bj = 0; bj < 2; ++bj) {
            const int e = 64 * bj + 16 * wc + 4 * fq, gcol = 128 * u.pn + e, ucol = FF + gcol;
            const float4 wg0 = *(const float4*)(cw + gcol), wg1 = *(const float4*)(cw + FF2 + gcol), wg2 = *(const float4*)(cw + 2 * FF2 + gcol), bg = *(const float4*)(cb + gcol);
            const float4 wu0 = *(const float4*)(cw + ucol), wu1 = *(const float4*)(cw + FF2 + ucol), wu2 = *(const float4*)(cw + 2 * FF2 + ucol), bu = *(const float4*)(cb + ucol);
            const float w0g[4] = {wg0.x, wg0.y, wg0.z, wg0.w}, w1g[4] = {wg1.x, wg1.y, wg1.z, wg1.w}, w2g[4] = {wg2.x, wg2.y, wg2.z, wg2.w}, bgg[4] = {bg.x, bg.y, bg.z, bg.w};
            const float w0u[4] = {wu0.x, wu0.y, wu0.z, wu0.w}, w1u[4] = {wu1.x, wu1.y, wu1.z, wu1.w}, w2u[4] = {wu2.x, wu2.y, wu2.z, wu2.w}, buu[4] = {bu.x, bu.y, bu.z, bu.w};
#pragma unroll
            for (int ai = 0; ai < 2; ++ai) {
                const int swr = wr ^ 1, sai = (wr == 1) ? ai : 0;
                const LAS float* xs = xch + (((swr * 4 + wc) * 2 + sai) * 2) * 64 + (bj * 2) * 16 + 4 * fq;
                f32x4 pg1 = *(const LAS f32x4*)(xs + 64), pg2 = *(const LAS f32x4*)(xs), pu1 = *(const LAS f32x4*)(xs + 64 + 16), pu2 = *(const LAS f32x4*)(xs + 16);
                f32x4 g1p = pg1, g2p = (fr == 1) ? pg1 : pg2, u1p = pu1, u2p = (fr == 1) ? pu1 : pu2;
#pragma unroll
                for (int m = 0; m < 4; ++m) {
                    const int r = 128 * ai + 64 * wr + 16 * m + fr; const int R = UP_STEP * u.pm - 2 + r;
                    const f32x4 gc = acc[ai][bj][m][0], uc = acc[ai][bj][m][1];
                    f32x4 g1r, g2r, u1r, u2r;
#pragma unroll
                    for (int j = 0; j < 4; ++j) { g1r[j] = dpp_ror<1>(gc[j]); g2r[j] = dpp_ror<2>(gc[j]); u1r[j] = dpp_ror<1>(uc[j]); u2r[j] = dpp_ror<2>(uc[j]); }
                    f32x4 g1 = (fr >= 1) ? g1r : g1p, g2 = (fr >= 2) ? g2r : g2p, u1 = (fr >= 1) ? u1r : u1p, u2 = (fr >= 2) ? u2r : u2p;
                    g1p = g1r; g2p = g2r; u1p = u1r; u2p = u2r;
                    const bool emit = (r >= 2) && (R < MB);
                    if (emit) {
                        float* frow = nullptr;
                        if (R < MP) { const int t = R & (TP - 1);
                            if (t == 0) { g1 = (f32x4){0.f, 0.f, 0.f, 0.f}; u1 = g1; }
                            if (t <= 1) { g2 = (f32x4){0.f, 0.f, 0.f, 0.f}; u2 = g2; }
                            if (t >= TP - 2) frow = out + O_PCONV + ((size_t)(R >> 12) * 2 + (t - (TP - 2))) * FF2;
                        } else { const int s = R - MP, b = s >> 3, tt = s & 7; const float* sp = sconv + (size_t)b * 2 * FF2;
                            if (tt == 0) { const float4 a = *(const float4*)(sp + FF2 + gcol), c = *(const float4*)(sp + FF2 + ucol); g1 = (f32x4){a.x, a.y, a.z, a.w}; u1 = (f32x4){c.x, c.y, c.z, c.w}; }
                            if (tt <= 1) { const float4 a = *(const float4*)(sp + (tt == 0 ? 0 : FF2) + gcol), c = *(const float4*)(sp + (tt == 0 ? 0 : FF2) + ucol); g2 = (f32x4){a.x, a.y, a.z, a.w}; u2 = (f32x4){c.x, c.y, c.z, c.w}; }
                            if (tt >= 6) frow = out + O_SCONV + ((size_t)b * 2 + (tt - 6)) * FF2;
                        }
                        float o[4];
#pragma unroll
                        for (int j = 0; j < 4; ++j) { const float cgv = w0g[j] * g2[j] + w1g[j] * g1[j] + w2g[j] * gc[j] + bgg[j], cuv = w0u[j] * u2[j] + w1u[j] * u1[j] + w2u[j] * uc[j] + buu[j];
                            o[j] = cgv * sigmoidf_(cgv) * cuv; }
                        uint2 w; w.x = pk2(o[0], o[1]); w.y = pk2(o[2], o[3]);
                        *(uint2*)(ACT + (size_t)R * FF + gcol) = w;
                        if (frow) { *(float4*)(frow + gcol) = make_float4(gc[0], gc[1], gc[2], gc[3]); *(float4*)(frow + ucol) = make_float4(uc[0], uc[1], uc[2], uc[3]); }
                    }
                }
            }
        }
    }
};

__device__ __forceinline__ int rowA_of(int rowB) { return rowB < MP ? rowB : MP + ((rowB - MP) >> 3) * 9 + 1 + ((rowB - MP) & 7); }
__device__ __forceinline__ void phase_alora(const Params& p, int tid, int G, int bid) {
    const bf16_t* PR = (const bf16_t*)(p.ws + WS_PROJRW); bf16_t* AL = (bf16_t*)(p.ws + WS_ALORA); const float* mu = p.in[I_MU];
    const int gt = bid * NTHREADS + tid, NT = G * NTHREADS;
    for (int i = gt; i < MB * 64; i += NT) {
        const int rowB = i >> 6, c = (i & 63) * 4, rowA = rowA_of(rowB);
        const uint2 cur = *(const uint2*)(PR + (size_t)rowA * RCOLS + 1536 + c);
        uint2 prv = make_uint2(0u, 0u);
        if (!(rowB < MP && (rowB & (TP - 1)) == 0)) prv = *(const uint2*)(PR + (size_t)(rowA - 1) * RCOLS + 1536 + c);
        const float4 m4 = *(const float4*)(mu + 1536 + c);
        float x[4] = {bflo(cur.x), bfhi(cur.x), bflo(cur.y), bfhi(cur.y)}; const float pv[4] = {bflo(prv.x), bfhi(prv.x), bflo(prv.y), bfhi(prv.y)}; const float mm[4] = {m4.x, m4.y, m4.z, m4.w};
#pragma unroll
        for (int j = 0; j < 4; ++j) { float v = x[j] + (pv[j] - x[j]) * mm[j];
            if (c < 64) v = 1.f - 2.f * __builtin_amdgcn_rcpf(1.f + __expf(2.f * v)); else if (c >= 128) v = sigmoidf_(v);
            x[j] = v; }
        uint2 o; o.x = pk2(x[0], x[1]); o.y = pk2(x[2], x[3]);
        *(uint2*)(AL + (size_t)rowB * KLORA + c) = o;
    }
}


__device__ __forceinline__ void phase_vtrans(const Params& p, LAS unsigned char* lds, int tid, int G, int bid) {
    const bf16_t* VR = (const bf16_t*)(p.ws + WS_VROW);
    constexpr int PITCH = 132;
    for (int item = bid; item < BP * 8 * 8; item += G) {
        const int b = item >> 6, h = (item >> 3) & 7, t0 = (item & 7) * 512;
        __syncthreads();
#pragma unroll
        for (int i = 0; i < 8; ++i) { const int piece = tid + 512 * i, row = piece >> 3, c8 = piece & 7;
            const uint4 v = *(const uint4*)(VR + (size_t)(b * TP + t0 + row) * 512 + h * 64 + c8 * 8);
            LAS u32* dst = (LAS u32*)(lds + row * PITCH + c8 * 16); dst[0] = v.x; dst[1] = v.y; dst[2] = v.z; dst[3] = v.w; }
        __syncthreads();
#pragma unroll 1
        for (int lay = 0; lay < 3; ++lay) {
            const int dd = lay == 0 ? 1 : (lay == 1 ? 4 : 16); const int Tdd = TP / dd;
            bf16_t* VT = (bf16_t*)(p.ws + (lay == 0 ? WS_VT1 : (lay == 1 ? WS_VT4 : WS_VT16))) + (size_t)(b * 8 + h) * 64 * TP;
            const int chunk0 = (t0 / dd) >> 5;
#pragma unroll
            for (int i = 0; i < 4; ++i) {
                const int sidx = tid + 512 * i, g = sidx & 3, dp = (sidx >> 2) & 31, rc = sidx >> 7;
                int r, cl; if (lay == 0) { r = 0; cl = rc; } else if (lay == 1) { r = rc & 3; cl = rc >> 2; } else { r = rc; cl = 0; }
                u32 wlo[4], whi[4];
#pragma unroll
                for (int hf = 0; hf < 2; ++hf)
#pragma unroll
                    for (int jp = 0; jp < 2; ++jp) {
                        const int u5a = 16 * hf + 4 * g + 2 * jp; const int ta = (32 * cl + u5a) * dd + r, tb = ta + dd;
                        const u32 wa = *(const LAS u32*)(lds + ta * PITCH + dp * 4), wb = *(const LAS u32*)(lds + tb * PITCH + dp * 4);
                        wlo[hf * 2 + jp] = (wa & 0xffffu) | (wb << 16); whi[hf * 2 + jp] = (wa >> 16) | (wb & 0xffff0000u);
                    }
                bf16_t* dst = VT + (size_t)r * Tdd * 64 + (size_t)(chunk0 + cl) * 2048 + (2 * dp) * 32 + 8 * g;
                *(uint4*)dst = make_uint4(wlo[0], wlo[1], wlo[2], wlo[3]); *(uint4*)(dst + 32) = make_uint4(whi[0], whi[1], whi[2], whi[3]);
            }
        }
    }
    __syncthreads();
}

constexpr int CH = 32;
constexpr int SST = 452;
constexpr int SI_W = 0, SI_A = 64, SI_B = 128, SI_K = 192, SI_WR = 256, SI_V = 320, SI_G = 384, SI_SC = 448;
struct PrepRegs { uint2 cr, ck, cv, pr, pk, pv, dw, da, dg; };
__device__ __forceinline__ void scan_item(const Params& p, LAS unsigned char* lds, int tid, bool sample, int b, int h, int half) {
    const bf16_t* PR = (const bf16_t*)(p.ws + WS_PROJRW); const bf16_t* DAG = (const bf16_t*)((const unsigned char*)p.out + SC_B);
    float* YG = (float*)(p.ws + WS_Y);
    LAS float* buf0 = (LAS float*)lds; LAS float* buf1 = buf0 + CH * SST; LAS float* ybuf = buf1 + CH * SST;
    const int T = sample ? TS : TP;
    const int rowB0 = sample ? MP + b * TS : b * TP;
    const int rowA0 = sample ? MP + b * 9 + 1 : b * TP;
    const int nch = (T + CH - 1) / CH;
    const int ptl = tid >> 4, pj = (tid & 15) * 4, pc = h * 64 + pj;
    const int lane = tid & 63, wv = tid >> 6, rg = wv * 4 + (lane >> 4), cgi = lane & 15;
    const int row = 32 * half + rg;
    float st[4];
    if (sample) {
        const float4 a = *(const float4*)(p.in[I_SWKV] + ((size_t)(b * 8 + h) * 64 + row) * 64 + 4 * cgi);
        st[0] = a.x; st[1] = a.y; st[2] = a.z; st[3] = a.w;
    } else {
#pragma unroll
        for (int j = 0; j < 4; ++j) st[j] = 0.f;
    }
    const float4 mur = *(const float4*)(p.in[I_MU] + pc), muk = *(const float4*)(p.in[I_MU] + 512 + pc), muv = *(const float4*)(p.in[I_MU] + 1024 + pc);
    const float4 kk4 = *(const float4*)(p.in[I_KK] + pc), ka4 = *(const float4*)(p.in[I_KA] + pc), rk4 = *(const float4*)(p.in[I_RK] + pc);
    __builtin_amdgcn_s_waitcnt(0x0F70);
    PrepRegs R;
#define SCAN_LOAD(chunk) do { const int t_ = (chunk) * CH + ptl; if (t_ < T) { const size_t ra = (size_t)(rowA0 + t_) * RCOLS + pc; const size_t rb = (size_t)(rowB0 + t_) * NLORA + pc; \
        R.cr = *(const uint2*)(PR + ra); R.ck = *(const uint2*)(PR + ra + 512); R.cv = *(const uint2*)(PR + ra + 1024); \
        if (!sample && t_ == 0) { R.pr = make_uint2(0u, 0u); R.pk = R.pr; R.pv = R.pr; } \
        else { R.pr = *(const uint2*)(PR + ra - RCOLS); R.pk = *(const uint2*)(PR + ra - RCOLS + 512); R.pv = *(const uint2*)(PR + ra - RCOLS + 1024); } \
        R.dw = *(const uint2*)(DAG + rb); R.da = *(const uint2*)(DAG + rb + 512); R.dg = *(const uint2*)(DAG + rb + 1024); } } while (0)
#define SCAN_PREP(chunk, dstbuf) do { const int t_ = (chunk) * CH + ptl; if (t_ < T) { \
        const float mr[4] = {mur.x, mur.y, mur.z, mur.w}, mk[4] = {muk.x, muk.y, muk.z, muk.w}, mv[4] = {muv.x, muv.y, muv.z, muv.w}; \
        const float kkc[4] = {kk4.x, kk4.y, kk4.z, kk4.w}, kac[4] = {ka4.x, ka4.y, ka4.z, ka4.w}, rkc[4] = {rk4.x, rk4.y, rk4.z, rk4.w}; \
        const float crr[4] = {bflo(R.cr.x), bfhi(R.cr.x), bflo(R.cr.y), bfhi(R.cr.y)}, ckk[4] = {bflo(R.ck.x), bfhi(R.ck.x), bflo(R.ck.y), bfhi(R.ck.y)}, cvv[4] = {bflo(R.cv.x), bfhi(R.cv.x), bflo(R.cv.y), bfhi(R.cv.y)}; \
        const float prr[4] = {bflo(R.pr.x), bfhi(R.pr.x), bflo(R.pr.y), bfhi(R.pr.y)}, pkk[4] = {bflo(R.pk.x), bfhi(R.pk.x), bflo(R.pk.y), bfhi(R.pk.y)}, pvv[4] = {bflo(R.pv.x), bfhi(R.pv.x), bflo(R.pv.y), bfhi(R.pv.y)}; \
        const float lw[4] = {bflo(R.dw.x), bfhi(R.dw.x), bflo(R.dw.y), bfhi(R.dw.y)}, aa[4] = {bflo(R.da.x), bfhi(R.da.x), bflo(R.da.y), bfhi(R.da.y)}, gg[4] = {bflo(R.dg.x), bfhi(R.dg.x), bflo(R.dg.y), bfhi(R.dg.y)}; \
        float r_[4], k_[4], v_[4], w_[4], kn[4], k2[4]; float nrm = 0.f; \
        _Pragma("unroll") for (int j = 0; j < 4; ++j) { r_[j] = crr[j] + (prr[j] - crr[j]) * mr[j]; k_[j] = ckk[j] + (pkk[j] - ckk[j]) * mk[j]; v_[j] = cvv[j] + (pvv[j] - cvv[j]) * mv[j]; \
            w_[j] = __expf(lw[j]); kn[j] = k_[j] * kkc[j]; nrm += kn[j] * kn[j]; k2[j] = k_[j] * (1.f + (aa[j] - 1.f) * kac[j]); } \
        nrm = row16_sum(nrm); const float inv = __builtin_amdgcn_rsqf(fmaxf(nrm, 1e-24f)); \
        float br = 0.f, kr = 0.f, rk = 0.f; float an[4], bn[4], wrr[4]; \
        _Pragma("unroll") for (int j = 0; j < 4; ++j) { const float kkn = kn[j] * inv; an[j] = -kkn; bn[j] = kkn * aa[j]; wrr[j] = w_[j] * r_[j]; br += bn[j] * r_[j]; kr += k2[j] * r_[j]; rk += r_[j] * k2[j] * rkc[j]; } \
        br = row16_sum(br); kr = row16_sum(kr); rk = row16_sum(rk); \
        LAS float* rec = (dstbuf) + ptl * SST; \
        *(LAS f32x4*)(rec + SI_W + pj) = (f32x4){w_[0], w_[1], w_[2], w_[3]}; *(LAS f32x4*)(rec + SI_A + pj) = (f32x4){an[0], an[1], an[2], an[3]}; \
        *(LAS f32x4*)(rec + SI_B + pj) = (f32x4){bn[0], bn[1], bn[2], bn[3]}; *(LAS f32x4*)(rec + SI_K + pj) = (f32x4){k2[0], k2[1], k2[2], k2[3]}; \
        *(LAS f32x4*)(rec + SI_WR + pj) = (f32x4){wrr[0], wrr[1], wrr[2], wrr[3]}; *(LAS f32x4*)(rec + SI_V + pj) = (f32x4){v_[0], v_[1], v_[2], v_[3]}; \
        *(LAS f32x4*)(rec + SI_G + pj) = (f32x4){gg[0], gg[1], gg[2], gg[3]}; \
        if ((tid & 15) == 0) *(LAS f32x4*)(rec + SI_SC) = (f32x4){br, kr, rk, 0.f}; } } while (0)

    SCAN_LOAD(0);
    SCAN_PREP(0, buf0);
    __syncthreads();
    for (int c = 0; c < nch; ++c) {
        LAS float* cur = (c & 1) ? buf1 : buf0; LAS float* nxt = (c & 1) ? buf0 : buf1;
        if (c + 1 < nch) SCAN_LOAD(c + 1);
        const int ns = (T - c * CH) < CH ? (T - c * CH) : CH;
        LAS float* yb = ybuf + (c & 1) * (CH * 32);
        {
            const LAS float* rec = cur;
            f32x4 wA = *(const LAS f32x4*)(rec + SI_W + 4 * cgi), aA = *(const LAS f32x4*)(rec + SI_A + 4 * cgi), bA = *(const LAS f32x4*)(rec + SI_B + 4 * cgi);
            f32x4 kA = *(const LAS f32x4*)(rec + SI_K + 4 * cgi), rA = *(const LAS f32x4*)(rec + SI_WR + 4 * cgi);
            float vA = rec[SI_V + row]; pg8::f32x2 cA = *(const LAS pg8::f32x2*)(rec + SI_SC);
            f32x4 wB, aB, bB, kB, rB; float vB; pg8::f32x2 cB;
#define SCAN_FETCH(W, A, B, K, R, V, C) do { rec += SST; W = *(const LAS f32x4*)(rec + SI_W + 4 * cgi); A = *(const LAS f32x4*)(rec + SI_A + 4 * cgi); B = *(const LAS f32x4*)(rec + SI_B + 4 * cgi); \
            K = *(const LAS f32x4*)(rec + SI_K + 4 * cgi); R = *(const LAS f32x4*)(rec + SI_WR + 4 * cgi); V = rec[SI_V + row]; C = *(const LAS pg8::f32x2*)(rec + SI_SC); } while (0)
#define SCAN_STEP(W, A, B, K, R, V, C, qq) do { \
            float da = mul_(st[0], A[0]), da2 = mul_(st[2], A[2]); float dw = mul_(st[0], R[0]), dw2 = mul_(st[2], R[2]); \
            da = fma_(st[1], A[1], da); da2 = fma_(st[3], A[3], da2); dw = fma_(st[1], R[1], dw); dw2 = fma_(st[3], R[3], dw2); da += da2; dw += dw2; \
            float tt_[4]; row16_sum2_mul4(da, dw, tt_, V, K[0], K[1], K[2], K[3]); \
            const float y = fma_(V, C[1], fma_(da, C[0], dw)); \
            _Pragma("unroll") for (int j = 0; j < 4; ++j) st[j] = fma_(st[j], W[j], fma_(da, B[j], tt_[j])); \
            yk = ((qq) == cgi) ? y : yk; } while (0)
            for (int tb = 0; tb < ns; tb += 16) {
                const int nq = (ns - tb) < 16 ? (ns - tb) : 16;
                float yk = 0.f;
                for (int q = 0; q < nq; q += 2) {
                    SCAN_FETCH(wB, aB, bB, kB, rB, vB, cB);
                    SCAN_STEP(wA, aA, bA, kA, rA, vA, cA, q);
                    SCAN_FETCH(wA, aA, bA, kA, rA, vA, cA);
                    SCAN_STEP(wB, aB, bB, kB, rB, vB, cB, q + 1);
                }
                yb[(tb + cgi) * 32 + rg] = yk;
            }
#undef SCAN_FETCH
#undef SCAN_STEP
        }
        if (c + 1 < nch) SCAN_PREP(c + 1, nxt);
        __syncthreads();
        if (ptl < ns) {
            const pg8::f32x2 y2 = *(const LAS pg8::f32x2*)(yb + ptl * 32 + 2 * (tid & 15));
            *(float2*)(YG + (size_t)(rowB0 + c * CH + ptl) * 512 + h * 64 + 32 * half + 2 * (tid & 15)) = make_float2(y2[0], y2[1]);
        }
    }
#undef SCAN_LOAD
#undef SCAN_PREP
    float* So = p.out + (sample ? O_SWKV : O_PWKV) + ((size_t)(b * 8 + h) * 64 + row) * 64 + 4 * cgi;
    *(float4*)So = make_float4(st[0], st[1], st[2], st[3]);
}

__device__ __forceinline__ void phase_wkvfin(const Params& p, int tid, int G, int bid) {
    const bf16_t* PR = (const bf16_t*)(p.ws + WS_PROJRW); const bf16_t* DAG = (const bf16_t*)((const unsigned char*)p.out + SC_B);
    const float* YG = (const float*)(p.ws + WS_Y); bf16_t* MIX = (bf16_t*)((unsigned char*)p.out + SC_C);
    const int gt = bid * NTHREADS + tid, NT = G * NTHREADS;
    for (int i = gt; i < MB * 128; i += NT) {
        const int jq = i & 15, h = (i >> 4) & 7, rowB = i >> 7, pc = h * 64 + jq * 4, rowA = rowA_of(rowB);
        const size_t ra = (size_t)rowA * RCOLS + pc;
        const uint2 cr = *(const uint2*)(PR + ra), ck = *(const uint2*)(PR + ra + 512), cv = *(const uint2*)(PR + ra + 1024);
        uint2 pr = make_uint2(0u, 0u), pk = pr, pv = pr;
        if (!(rowB < MP && (rowB & (TP - 1)) == 0)) { pr = *(const uint2*)(PR + ra - RCOLS); pk = *(const uint2*)(PR + ra - RCOLS + 512); pv = *(const uint2*)(PR + ra - RCOLS + 1024); }
        const uint2 da = *(const uint2*)(DAG + (size_t)rowB * NLORA + 512 + pc), dg = *(const uint2*)(DAG + (size_t)rowB * NLORA + 1024 + pc);
        const float4 y4 = *(const float4*)(YG + (size_t)rowB * 512 + pc);
        const float4 mur = *(const float4*)(p.in[I_MU] + pc), muk = *(const float4*)(p.in[I_MU] + 512 + pc), muv = *(const float4*)(p.in[I_MU] + 1024 + pc);
        const float4 ka4 = *(const float4*)(p.in[I_KA] + pc), rk4 = *(const float4*)(p.in[I_RK] + pc), lw4 = *(const float4*)(p.in[I_LNW] + pc), lb4 = *(const float4*)(p.in[I_LNB] + pc);
        const float mr[4] = {mur.x, mur.y, mur.z, mur.w}, mk[4] = {muk.x, muk.y, muk.z, muk.w}, mv[4] = {muv.x, muv.y, muv.z, muv.w};
        const float kac[4] = {ka4.x, ka4.y, ka4.z, ka4.w}, rkc[4] = {rk4.x, rk4.y, rk4.z, rk4.w}, lw[4] = {lw4.x, lw4.y, lw4.z, lw4.w}, lb[4] = {lb4.x, lb4.y, lb4.z, lb4.w};
        const float crr[4] = {bflo(cr.x), bfhi(cr.x), bflo(cr.y), bfhi(cr.y)}, ckk[4] = {bflo(ck.x), bfhi(ck.x), bflo(ck.y), bfhi(ck.y)}, cvv[4] = {bflo(cv.x), bfhi(cv.x), bflo(cv.y), bfhi(cv.y)};
        const float prr[4] = {bflo(pr.x), bfhi(pr.x), bflo(pr.y), bfhi(pr.y)}, pkk[4] = {bflo(pk.x), bfhi(pk.x), bflo(pk.y), bfhi(pk.y)}, pvv[4] = {bflo(pv.x), bfhi(pv.x), bflo(pv.y), bfhi(pv.y)};
        const float aa[4] = {bflo(da.x), bfhi(da.x), bflo(da.y), bfhi(da.y)}, gg[4] = {bflo(dg.x), bfhi(dg.x), bflo(dg.y), bfhi(dg.y)};
        const float yy[4] = {y4.x, y4.y, y4.z, y4.w};
        float v_[4]; float rk = 0.f;
#pragma unroll
        for (int j = 0; j < 4; ++j) { const float r_ = crr[j] + (prr[j] - crr[j]) * mr[j], k_ = ckk[j] + (pkk[j] - ckk[j]) * mk[j]; v_[j] = cvv[j] + (pvv[j] - cvv[j]) * mv[j];
            const float k2 = k_ * (1.f + (aa[j] - 1.f) * kac[j]); rk += r_ * k2 * rkc[j]; }
        rk = row16_sum(rk);
        const float mean = row16_sum((yy[0] + yy[1]) + (yy[2] + yy[3])) * (1.f / 64.f);
        float d[4]; float vs = 0.f;
#pragma unroll
        for (int j = 0; j < 4; ++j) { d[j] = yy[j] - mean; vs += d[j] * d[j]; }
        const float rs = rsqrtf(row16_sum(vs) * (1.f / 64.f) + 64e-5f);
        float o[4];
#pragma unroll
        for (int j = 0; j < 4; ++j) o[j] = (d[j] * rs * lw[j] + lb[j] + rk * v_[j]) * gg[j];
        uint2 w; w.x = pk2(o[0], o[1]); w.y = pk2(o[2], o[3]);
        *(uint2*)(MIX + (size_t)rowB * D + pc) = w;
    }
}

__device__ __forceinline__ void attn_task(const Params& p, int task, int lane) {
    const bf16_t* Q = (const bf16_t*)(p.ws + WS_Q); const bf16_t* K = (const bf16_t*)(p.ws + WS_K);
    bf16_t* MIX = (bf16_t*)((unsigned char*)p.out + SC_C);
    const int b = task >> 11, h = (task >> 8) & 7, r16 = (task >> 4) & 15, ig = task & 15;
    const int li = lane & 15, g = lane >> 4;
    const int tq = r16 + 16 * (16 * ig + li);
    const bf16_t* qp = Q + (size_t)(b * TP + tq) * 512 + h * 64 + 8 * g;
    const bf16x8 qf0 = *(const bf16x8*)qp, qf1 = *(const bf16x8*)(qp + 32);
    float m_run = -1e30f, l_run = 0.f;
    f32x4 o[4];
#pragma unroll
    for (int i = 0; i < 4; ++i) o[i] = (f32x4){0.f, 0.f, 0.f, 0.f};
#pragma unroll 1
    for (int br = 0; br < 3; ++br) {
        int dd, r, uq0, Tdd; const bf16_t* VT;
        if (br == 0) { dd = 16; r = r16; uq0 = 16 * ig; Tdd = TP / 16; VT = (const bf16_t*)(p.ws + WS_VT16); }
        else if (br == 1) { dd = 4; r = r16 & 3; uq0 = (r16 >> 2) + 64 * ig; Tdd = TP / 4; VT = (const bf16_t*)(p.ws + WS_VT4); }
        else { dd = 1; r = 0; uq0 = r16 + 256 * ig; Tdd = TP; VT = (const bf16_t*)(p.ws + WS_VT1); }
        const int s = 16 / dd, uq = uq0 + s * li;
        int ulo = uq0 - 128; if (ulo < 0) ulo = 0; ulo &= ~31;
        const int uhi = uq0 + 15 * s;
        const bf16_t* Kb = K + ((size_t)b * TP + r) * 512 + h * 64 + 8 * g;
        const bf16_t* Vb = VT + (size_t)(b * 8 + h) * 64 * TP + (size_t)r * Tdd * 64 + li * 32 + 8 * g;
        bf16x8 kx0, kx1, ky0, ky1, vf[4];
        { const bf16_t* kx = Kb + (size_t)(ulo + li) * dd * 512; const bf16_t* ky = kx + (size_t)16 * dd * 512;
          kx0 = *(const bf16x8*)kx; kx1 = *(const bf16x8*)(kx + 32); ky0 = *(const bf16x8*)ky; ky1 = *(const bf16x8*)(ky + 32);
#pragma unroll
          for (int dt = 0; dt < 4; ++dt) vf[dt] = *(const bf16x8*)(Vb + (size_t)(ulo >> 5) * 2048 + dt * 512); }
#pragma unroll 1
        for (int kt = ulo; kt <= uhi; kt += 32) {
            const int ktn = (kt + 32 <= uhi) ? kt + 32 : kt;
            const bf16_t* nkx = Kb + (size_t)(ktn + li) * dd * 512; const bf16_t* nky = nkx + (size_t)16 * dd * 512;
            const bf16x8 nkx0 = *(const bf16x8*)nkx, nkx1 = *(const bf16x8*)(nkx + 32), nky0 = *(const bf16x8*)nky, nky1 = *(const bf16x8*)(nky + 32);
            bf16x8 nvf[4];
#pragma unroll
            for (int dt = 0; dt < 4; ++dt) nvf[dt] = *(const bf16x8*)(Vb + (size_t)(ktn >> 5) * 2048 + dt * 512);
            f32x4 sx = (f32x4){0.f, 0.f, 0.f, 0.f}, sy = (f32x4){0.f, 0.f, 0.f, 0.f};
            sx = __builtin_amdgcn_mfma_f32_16x16x32_bf16(kx0, qf0, sx, 0, 0, 0); sx = __builtin_amdgcn_mfma_f32_16x16x32_bf16(kx1, qf1, sx, 0, 0, 0);
            sy = __builtin_amdgcn_mfma_f32_16x16x32_bf16(ky0, qf0, sy, 0, 0, 0); sy = __builtin_amdgcn_mfma_f32_16x16x32_bf16(ky1, qf1, sy, 0, 0, 0);
            float sv[8]; bool ok[8]; float tmax = -1e30f;
#pragma unroll
            for (int j = 0; j < 4; ++j) { const int dx = uq - (kt + 4 * g + j), dy = dx - 16;
                ok[j] = (unsigned)dx <= 128u; ok[4 + j] = (unsigned)dy <= 128u; sv[j] = ok[j] ? sx[j] : -1e30f; sv[4 + j] = ok[4 + j] ? sy[j] : -1e30f;
                tmax = fmaxf(tmax, fmaxf(sv[j], sv[4 + j])); }
            tmax = fmaxf(tmax, __shfl_xor(tmax, 16)); tmax = fmaxf(tmax, __shfl_xor(tmax, 32));
            const float m_new = fmaxf(m_run, tmax), alpha = __expf(m_run - m_new);
            float pe[8]; float ps = 0.f;
#pragma unroll
            for (int j = 0; j < 8; ++j) { pe[j] = ok[j] ? __expf(sv[j] - m_new) : 0.f; ps += pe[j]; }
            l_run = l_run * alpha + ps; m_run = m_new;
            u32x4 pw; pw[0] = pk2(pe[0], pe[1]); pw[1] = pk2(pe[2], pe[3]); pw[2] = pk2(pe[4], pe[5]); pw[3] = pk2(pe[6], pe[7]);
            const bf16x8 pf = __builtin_bit_cast(bf16x8, pw);
#pragma unroll
            for (int dt = 0; dt < 4; ++dt) { o[dt] *= alpha; o[dt] = __builtin_amdgcn_mfma_f32_16x16x32_bf16(vf[dt], pf, o[dt], 0, 0, 0); }
            kx0 = nkx0; kx1 = nkx1; ky0 = nky0; ky1 = nky1;
#pragma unroll
            for (int dt = 0; dt < 4; ++dt) vf[dt] = nvf[dt];
        }
    }
    float lt = l_run; lt += __shfl_xor(lt, 16); lt += __shfl_xor(lt, 32);
    const float il = 1.f / lt;
    bf16_t* op = MIX + (size_t)(b * TP + tq) * D + 512 + h * 64 + 4 * g;
#pragma unroll
    for (int dt = 0; dt < 4; ++dt) { uint2 w; w.x = pk2(o[dt][0] * il, o[dt][1] * il); w.y = pk2(o[dt][2] * il, o[dt][3] * il); *(uint2*)(op + 16 * dt) = w; }
}
__device__ __forceinline__ void attn_sample_task(const Params& p, int task, int lane, LAS float* wl) {
    const bf16_t* Q = (const bf16_t*)(p.ws + WS_Q); const float* snewk = (const float*)(p.ws + WS_SNEWK); const float* snewv = (const float*)(p.ws + WS_SNEWV);
    const float* CK = p.in[I_CK]; const float* CV = p.in[I_CV];
    bf16_t* MIX = (bf16_t*)((unsigned char*)p.out + SC_C);
    const int b = task >> 6, h = (task >> 3) & 7, tt = task & 7;
    const int rowB = MP + b * TS + tt;
    asm volatile("s_waitcnt lgkmcnt(0)" ::: "memory");
    wl[lane] = bflo((u32)Q[(size_t)rowB * 512 + h * 64 + lane]);
    asm volatile("s_waitcnt lgkmcnt(0)" ::: "memory");
    float mx = -1e30f;
#pragma unroll 1
    for (int c = 0; c < 9; ++c) {
        const int br = c / 3, it = c - br * 3; const int dd = br == 0 ? 1 : (br == 1 ? 4 : 16); const int j = lane + 64 * it;
        const int jc = j <= 128 ? j : 128;
        const int idx = 2048 + tt - jc * dd;
        const float* kr = idx < 2048 ? CK + ((size_t)(b * 2048 + idx) * 8 + h) * 64 : snewk + (size_t)(b * TS + idx - 2048) * 512 + h * 64;
        float s = 0.f;
#pragma unroll
        for (int d4 = 0; d4 < 16; ++d4) { const float4 kv = *(const float4*)(kr + 4 * d4); const f32x4 qv = *(const LAS f32x4*)(wl + 4 * d4);
            s += kv.x * qv[0] + kv.y * qv[1] + kv.z * qv[2] + kv.w * qv[3]; }
        if (j > 128) s = -1e30f;
        wl[64 + c * 64 + lane] = s; mx = fmaxf(mx, s);
    }
#pragma unroll
    for (int o = 1; o < 64; o <<= 1) mx = fmaxf(mx, __shfl_xor(mx, o));
    asm volatile("s_waitcnt lgkmcnt(0)" ::: "memory");
    float ls = 0.f;
#pragma unroll 1
    for (int c = 0; c < 9; ++c) { const float s = wl[64 + c * 64 + lane]; const float e = s > -1e29f ? __expf(s - mx) : 0.f; wl[64 + c * 64 + lane] = e; ls += e; }
    ls = wave_sum(ls);
    asm volatile("s_waitcnt lgkmcnt(0)" ::: "memory");
    float acc = 0.f;
#pragma unroll 1
    for (int c = 0; c < 9; ++c) {
        const int br = c / 3, it = c - br * 3; const int dd = br == 0 ? 1 : (br == 1 ? 4 : 16); const int nj = it < 2 ? 64 : 1;
#pragma unroll 8
        for (int l2 = 0; l2 < nj; ++l2) {
            const int j = l2 + 64 * it; const int idx = 2048 + tt - j * dd;
            const float* vr = idx < 2048 ? CV + ((size_t)(b * 2048 + idx) * 8 + h) * 64 : snewv + (size_t)(b * TS + idx - 2048) * 512 + h * 64;
            acc += wl[64 + c * 64 + l2] * vr[lane];
        }
    }
    const float res = acc / ls;
    const float other = __shfl_xor(res, 1);
    if ((lane & 1) == 0) *(u32*)(MIX + (size_t)rowB * D + 512 + h * 64 + lane) = pk2(res, other);
}

__device__ __forceinline__ void phase_norm1(const Params& p, int tid, int G, int bid) {
    const int wave = tid >> 6, lane = tid & 63, gw = bid * 8 + wave, NGW = G * 8;
    const bf16_t* mix = (const bf16_t*)((const unsigned char*)p.out + SC_B); bf16_t* H2 = (bf16_t*)((unsigned char*)p.out + SC_C);
    for (int row = gw; row < MB; row += NGW) {
        const float* xrow = row < MP ? p.in[I_XP] + (size_t)row * D : p.in[I_XS] + (size_t)(row - MP) * D;
        const uint2* mr = (const uint2*)(mix + (size_t)row * D) + lane; const float4* xr = (const float4*)xrow + lane;
        float4 v[4], x[4]; float s = 0.f;
#pragma unroll
        for (int j = 0; j < 4; ++j) { const uint2 mm = mr[64 * j]; v[j] = make_float4(bflo(mm.x), bfhi(mm.x), bflo(mm.y), bfhi(mm.y)); x[j] = xr[64 * j]; s += (v[j].x * v[j].x + v[j].y * v[j].y) + (v[j].z * v[j].z + v[j].w * v[j].w); }
        const float rs = rsqrtf(wave_sum(s) * (1.f / D) + 1e-6f);
        float s2 = 0.f;
#pragma unroll
        for (int j = 0; j < 4; ++j) { const float4 gg = *((const float4*)p.in[I_NMPOST] + lane + 64 * j);
            x[j].x += v[j].x * rs * gg.x; x[j].y += v[j].y * rs * gg.y; x[j].z += v[j].z * rs * gg.z; x[j].w += v[j].w * rs * gg.w;
            s2 += (x[j].x * x[j].x + x[j].y * x[j].y) + (x[j].z * x[j].z + x[j].w * x[j].w);
            *((float4*)(p.out + (size_t)row * D) + lane + 64 * j) = x[j]; }
        const float rs2 = rsqrtf(wave_sum(s2) * (1.f / D) + 1e-6f);
#pragma unroll
        for (int j = 0; j < 4; ++j) { const float4 gg = *((const float4*)p.in[I_NFPRE] + lane + 64 * j);
            uint2 o; o.x = pk2(x[j].x * rs2 * gg.x, x[j].y * rs2 * gg.y); o.y = pk2(x[j].z * rs2 * gg.z, x[j].w * rs2 * gg.w);
            *((uint2*)(H2 + (size_t)(row + 2) * D) + lane + 64 * j) = o; }
    }
    for (int row = gw; row < 2 + (H2P_ROWS - MB - 2); row += NGW) {
        const int rr = row < 2 ? row : MB + row;
#pragma unroll
        for (int j = 0; j < 4; ++j) *((uint2*)(H2 + (size_t)rr * D) + lane + 64 * j) = make_uint2(0u, 0u);
    }
}
__device__ __forceinline__ void phase_act(const Params& p, int tid, int G, int bid) {
    const int wave = tid >> 6, lane = tid & 63, gw = bid * 8 + wave, NGW = G * 8;
    bf16_t* U = (bf16_t*)(p.ws + WS_U); const bf16_t* halo = (const bf16_t*)(p.ws + WS_HALO);
    const float* cw = p.in[I_CONVW]; const float* cb = p.in[I_CONVB];
    constexpr int NPI = (MP / 32) * 11, NSI = BS * 11;
    for (int it = gw; it < NPI + NSI; it += NGW) {
        const bool sample = it >= NPI; const int q = sample ? it - NPI : it; const int chunk = q / 11, cgp = q - chunk * 11;
        const int col = cgp * 256 + 4 * lane;
        const float4 wg0 = *(const float4*)(cw + col), wg1 = *(const float4*)(cw + FF2 + col), wg2 = *(const float4*)(cw + 2 * FF2 + col), bg = *(const float4*)(cb + col);
        const float4 wu0 = *(const float4*)(cw + FF + col), wu1 = *(const float4*)(cw + FF2 + FF + col), wu2 = *(const float4*)(cw + 2 * FF2 + FF + col), bu = *(const float4*)(cb + FF + col);
        float g2[4], g1[4], u2[4], u1[4];
        int row0, nrows;
        if (!sample) {
            row0 = chunk * 32; nrows = 32;
            if ((row0 & (TP - 1)) == 0) {
#pragma unroll
                for (int j = 0; j < 4; ++j) { g2[j] = 0.f; g1[j] = 0.f; u2[j] = 0.f; u1[j] = 0.f; }
            } else {
                const bf16_t* hp = halo + (size_t)chunk * 2 * FF2;
                const uint2 a = *(const uint2*)(hp + col), c2 = *(const uint2*)(hp + FF2 + col), e = *(const uint2*)(hp + FF + col), f = *(const uint2*)(hp + FF2 + FF + col);
                g2[0] = bflo(a.x); g2[1] = bfhi(a.x); g2[2] = bflo(a.y); g2[3] = bfhi(a.y); g1[0] = bflo(c2.x); g1[1] = bfhi(c2.x); g1[2] = bflo(c2.y); g1[3] = bfhi(c2.y);
                u2[0] = bflo(e.x); u2[1] = bfhi(e.x); u2[2] = bflo(e.y); u2[3] = bfhi(e.y); u1[0] = bflo(f.x); u1[1] = bfhi(f.x); u1[2] = bflo(f.y); u1[3] = bfhi(f.y);
            }
        } else {
            row0 = MP + chunk * TS; nrows = TS;
            const float* sp = p.in[I_SCONV] + (size_t)chunk * 2 * FF2;
            const float4 a = *(const float4*)(sp + col), c2 = *(const float4*)(sp + FF2 + col), e = *(const float4*)(sp + FF + col), f = *(const float4*)(sp + FF2 + FF + col);
            g2[0] = a.x; g2[1] = a.y; g2[2] = a.z; g2[3] = a.w; g1[0] = c2.x; g1[1] = c2.y; g1[2] = c2.z; g1[3] = c2.w;
            u2[0] = e.x; u2[1] = e.y; u2[2] = e.z; u2[3] = e.w; u1[0] = f.x; u1[1] = f.y; u1[2] = f.z; u1[3] = f.w;
        }
        const float w0g[4] = {wg0.x, wg0.y, wg0.z, wg0.w}, w1g[4] = {wg1.x, wg1.y, wg1.z, wg1.w}, w2g[4] = {wg2.x, wg2.y, wg2.z, wg2.w}, bgg[4] = {bg.x, bg.y, bg.z, bg.w};
        const float w0u[4] = {wu0.x, wu0.y, wu0.z, wu0.w}, w1u[4] = {wu1.x, wu1.y, wu1.z, wu1.w}, w2u[4] = {wu2.x, wu2.y, wu2.z, wu2.w}, buu[4] = {bu.x, bu.y, bu.z, bu.w};
        for (int r0 = 0; r0 < nrows; r0 += 8) {
            uint2 gv[8], uv[8];
#pragma unroll
            for (int i = 0; i < 8; ++i) { const bf16_t* rp = U + (size_t)(row0 + r0 + i) * FF2 + col; gv[i] = *(const uint2*)rp; uv[i] = *(const uint2*)(rp + FF); }
#pragma unroll
            for (int i = 0; i < 8; ++i) {
                const float gc[4] = {bflo(gv[i].x), bfhi(gv[i].x), bflo(gv[i].y), bfhi(gv[i].y)}, uc[4] = {bflo(uv[i].x), bfhi(uv[i].x), bflo(uv[i].y), bfhi(uv[i].y)};
                float o[4];
#pragma unroll
                for (int j = 0; j < 4; ++j) {
                    const float cgv = w0g[j] * g2[j] + w1g[j] * g1[j] + w2g[j] * gc[j] + bgg[j];
                    const float cuv = w0u[j] * u2[j] + w1u[j] * u1[j] + w2u[j] * uc[j] + buu[j];
                    o[j] = cgv * sigmoidf_(cgv) * cuv;
                    g2[j] = g1[j]; g1[j] = gc[j]; u2[j] = u1[j]; u1[j] = uc[j];
                }
                uint2 w; w.x = pk2(o[0], o[1]); w.y = pk2(o[2], o[3]);
                *(uint2*)(U + (size_t)(row0 + r0 + i) * FF2 + col) = w;
            }
        }
    }
}
__device__ __forceinline__ void phase_final(const Params& p, int tid, int G, int bid) {
    const int wave = tid >> 6, lane = tid & 63, gw = bid * 8 + wave, NGW = G * 8;
    const float* F = (const float*)(p.ws + WS_F);
    for (int row = gw; row < MB; row += NGW) {
        const float4* fr = (const float4*)(F + (size_t)row * D) + lane; float4* yr = (float4*)(p.out + (size_t)row * D) + lane;
        float4 v[4]; float s = 0.f;
#pragma unroll
        for (int j = 0; j < 4; ++j) { v[j] = fr[64 * j]; s += (v[j].x * v[j].x + v[j].y * v[j].y) + (v[j].z * v[j].z + v[j].w * v[j].w); }
        const float rs = rsqrtf(wave_sum(s) * (1.f / D) + 1e-6f);
#pragma unroll
        for (int j = 0; j < 4; ++j) { const float4 gg = *((const float4*)p.in[I_NFPOST] + lane + 64 * j); float4 x = yr[64 * j];
            x.x += v[j].x * rs * gg.x; x.y += v[j].y * rs * gg.y; x.z += v[j].z * rs * gg.z; x.w += v[j].w * rs * gg.w; yr[64 * j] = x; }
    }
}
__device__ __forceinline__ void phase_cachecopy(const Params& p, int tid, int G, int bid) {
    if (bid < 4) return;
    const int gt = (bid - 4) * NTHREADS + tid, NT = (G - 4) * NTHREADS;
    constexpr int PER_B = 2048 * 512 / 4;
    const float4* snk = (const float4*)(p.ws + WS_SNEWK); const float4* snv = (const float4*)(p.ws + WS_SNEWV);
    for (int i = gt; i < 2 * BS * PER_B; i += NT) {
        const int which = i >= BS * PER_B; const int q = which ? i - BS * PER_B : i; const int b = q / PER_B, r = q - b * PER_B;
        const float4* src = (const float4*)p.in[which ? I_CV : I_CK] + (size_t)b * PER_B;
        float4 v;
        if (r < 2040 * 128) v = src[r + 8 * 128]; else v = (which ? snv : snk)[(size_t)b * TS * 128 + (r - 2040 * 128)];
        ((float4*)(p.out + (which ? O_SV : O_SK)))[(size_t)b * PER_B + r] = v;
    }
}

template <int PH>
__device__ __forceinline__ void run_phase(const Params& p, LAS unsigned char* lds, int tid, int G, int bid) {
    if constexpr (PH == 0) { phase0(p, lds, tid, G, bid); __syncthreads(); }
    else if constexpr (PH == 1) {
        pg8::Gemm g{(const bf16_t*)((const unsigned char*)p.out + SC_B), (const bf16_t*)(p.ws + WS_WIN), MA, DIN, D, D, 256}; pg8::StaticOrder S; S.init(MA, DIN, G, bid);
        EpiProj E{(bf16_t*)(p.ws + WS_PROJRW), (bf16_t*)(p.ws + WS_Q), (bf16_t*)(p.ws + WS_K), (bf16_t*)(p.ws + WS_VROW), (bf16_t*)(p.ws + WS_VT4), (bf16_t*)(p.ws + WS_VT16),
                  (const float*)(p.ws + WS_ROPE), p.out, (float*)(p.ws + WS_SNEWK), (float*)(p.ws + WS_SNEWV)};
        pg8::gemm_phase<EpiProj, pg8::StaticOrder, false>(lds, g, S, E, nullptr);
    } else if constexpr (PH == 2) { phase_alora(p, tid, G, bid); phase_vtrans(p, lds, tid, G, bid); }
    else if constexpr (PH == 3) {
        pg8::Gemm g{(const bf16_t*)(p.ws + WS_ALORA), (const bf16_t*)(p.ws + WS_WLORA), MB, NLORA, KLORA, KLORA, 256}; pg8::StaticOrder S; S.init(MB, NLORA, G, bid);
        EpiDag E{(bf16_t*)((unsigned char*)p.out + SC_B), p.in[I_W0], p.in[I_A0]};
        pg8::gemm_phase<EpiDag, pg8::StaticOrder, false>(lds, g, S, E, nullptr);
    } else if constexpr (PH == 4 || PH == 11 || PH == 12) {
        const int NSCAN = 128;
        if (bid < NSCAN) {
            if constexpr (PH != 12) {
                scan_item(p, lds, tid, false, bid >> 4, (bid >> 1) & 7, bid & 1);
            }
        } else {
            if constexpr (PH != 12) for (int it = bid - NSCAN; it < 512; it += G - NSCAN) scan_item(p, lds, tid, true, it >> 4, (it >> 1) & 7, it & 1);
        }
        if (PH == 4 || (PH == 12 && bid >= NSCAN)) {
            const int wave = tid >> 6, lane = tid & 63, x = bid & 7;
            unsigned* ctr = (unsigned*)(p.ws + WS_BAR) + (PH == 4 ? 16 : 32) + x;
            for (;;) {
                unsigned id = 0; if (lane == 0) id = __hip_atomic_fetch_add(ctr, 1u, __ATOMIC_RELAXED, __HIP_MEMORY_SCOPE_AGENT);
                id = (unsigned)__builtin_amdgcn_readfirstlane((int)id);
                if (id >= 2048u + 256u) break;
                if (id < 2048u) { const int ig = id >> 7, hh = (id >> 4) & 7, r16 = id & 15; attn_task(p, (x << 11) | (hh << 8) | (r16 << 4) | ig, lane); }
                else { const int s = id - 2048; attn_sample_task(p, ((4 * x + (s >> 6)) << 6) | (s & 63), lane, (LAS float*)(lds + wave * 4096)); }
            }
        }
    } else if constexpr (PH == 5) {
        pg8::Gemm g{(const bf16_t*)((const unsigned char*)p.out + SC_C), (const bf16_t*)(p.ws + WS_WOUT), MB, D, D, D, 256}; pg8::StaticOrder S; S.init(MB, D, G, bid);
        EpiBf16S E{(bf16_t*)((unsigned char*)p.out + SC_B), D};
        pg8::gemm_phase<EpiBf16S, pg8::StaticOrder, false>(lds, g, S, E, nullptr);
    } else if constexpr (PH == 6) phase_norm1(p, tid, G, bid);
    else if constexpr (PH == 7) {
        pg8::Gemm g{(const bf16_t*)((const unsigned char*)p.out + SC_C), (const bf16_t*)(p.ws + WS_WUP), UP_TILES * 256, FF2, D, D, UP_STEP}; pg8::StaticOrder S; S.init(UP_TILES * 256, FF2, G, bid);
        EpiUpAct E{(bf16_t*)(p.ws + WS_U), p.out, p.in[I_CONVW], p.in[I_CONVB], p.in[I_SCONV], (LAS float*)(lds + 131072)};
        pg8::gemm_phase<EpiUpAct, pg8::StaticOrder, false>(lds, g, S, E, nullptr);
    } else if constexpr (PH == 8) phase_act(p, tid, G, bid);
    else if constexpr (PH == 9) {
        pg8::Gemm g{(const bf16_t*)(p.ws + WS_U), (const bf16_t*)(p.ws + WS_WDN), MB, D, FF, FF, 256}; pg8::StaticOrder S; S.init(MB, D, G, bid);
        pg8::EpiF32 E{(float*)(p.ws + WS_F), D, nullptr};
        pg8::gemm_phase<pg8::EpiF32, pg8::StaticOrder, false>(lds, g, S, E, nullptr);
        phase_cachecopy(p, tid, G, bid);
    } else if constexpr (PH == 10) { phase_final(p, tid, G, bid); }
    else if constexpr (PH == 13) phase_wkvfin(p, tid, G, bid);
}
__device__ __forceinline__ void grid_bar(unsigned* ctr, unsigned target) {
    asm volatile("s_waitcnt vmcnt(0)" ::: "memory");
    __syncthreads();
    if (threadIdx.x == 0) {
        __builtin_amdgcn_fence(__ATOMIC_RELEASE, "agent");
        asm volatile("s_waitcnt vmcnt(0)" ::: "memory");
        __hip_atomic_fetch_add(ctr, 1u, __ATOMIC_RELAXED, __HIP_MEMORY_SCOPE_AGENT);
        while (__hip_atomic_load(ctr, __ATOMIC_RELAXED, __HIP_MEMORY_SCOPE_AGENT) < target) __builtin_amdgcn_s_sleep(2);
        __builtin_amdgcn_fence(__ATOMIC_ACQUIRE, "agent");
        asm volatile("s_waitcnt vmcnt(0)" ::: "memory");
    }
    __syncthreads();
}
template <int SEAM, int FIRST, int... REST>
__device__ __forceinline__ void run_program(const Params& p, LAS unsigned char* lds, cg::grid_group& grid, int tid, int G, int bid) {
    if (p.en > (int)sizeof...(REST) - 1000) run_phase<FIRST>(p, lds, tid, G, bid);
    if constexpr (sizeof...(REST) > 0) {
        if constexpr (SEAM == 0) grid.sync(); else grid_bar((unsigned*)(p.ws + WS_BAR), (unsigned)(SEAM * G));
        run_program<SEAM + 1, REST...>(p, lds, grid, tid, G, bid);
    }
}
#define PROGRAM 0, 1, 2, 3, 4, 13, 5, 6, 7, 9, 10
__global__ void __launch_bounds__(NTHREADS, 2) hymba_fwd(Params p) {
    extern __shared__ __attribute__((aligned(16))) unsigned char lds_raw[];
    LAS unsigned char* lds = (LAS unsigned char*)lds_raw;
    cg::grid_group grid = cg::this_grid();
    run_program<0, PROGRAM>(p, lds, grid, threadIdx.x, gridDim.x, blockIdx.x);
}

extern "C" void kernel_launch(void* const* d_in, const int* in_sizes, int n_in, void* d_out, int out_size, void* d_ws, size_t ws_size, hipStream_t stream) {
    static int grid = 0;
    if (grid == 0) {
        if (n_in != 28 || (size_t)out_size != O_END || ws_size < WS_TOTAL) { fprintf(stderr, "kernel_launch: unexpected sizes n_in %d out %d ws %zu (need %zu)\n", n_in, out_size, ws_size, (size_t)WS_TOTAL); grid = -1; return; }
        int dev = 0, cus = 0, per_cu = 0;
        hipGetDevice(&dev); hipDeviceGetAttribute(&cus, hipDeviceAttributeMultiprocessorCount, dev);
        if (hipFuncSetAttribute((const void*)hymba_fwd, hipFuncAttributeMaxDynamicSharedMemorySize, LDS_BYTES) != hipSuccess) { fprintf(stderr, "kernel_launch: hipFuncSetAttribute failed\n"); grid = -1; return; }
        hipOccupancyMaxActiveBlocksPerMultiprocessor(&per_cu, (const void*)hymba_fwd, NTHREADS, LDS_BYTES);
        (void)hipGetLastError();
        if (per_cu < 1) per_cu = 1;
        grid = cus;
    }
    if (grid < 0) return;
    Params p{};
    for (int i = 0; i < 28; ++i) p.in[i] = (const float*)d_in[i];
    p.out = (float*)d_out; p.ws = (unsigned char*)d_ws; p.en = 1;
    if (hipMemsetAsync((unsigned char*)d_ws + WS_BAR, 0, 256, stream) != hipSuccess) { fprintf(stderr, "kernel_launch: memset of the barrier word failed\n"); return; }
    void* args[] = {&p};
    hipError_t e = hipLaunchCooperativeKernel((const void*)hymba_fwd, dim3(grid), dim3(NTHREADS), args, LDS_BYTES, stream);
    if (e != hipSuccess) fprintf(stderr, "cooperative launch failed: %s (grid %d)\n", hipGetErrorString(e), grid);
}
```

```cpp
#include <hip/hip_runtime.h>
#include <hip/hip_cooperative_groups.h>
#include <cstdio>
#include <cstdint>
namespace pg8 {
#define PG8_LAS __attribute__((address_space(3)))
typedef unsigned short bf16_t;
typedef short bf16x8 __attribute__((ext_vector_type(8)));
typedef float f32x4 __attribute__((ext_vector_type(4)));
typedef unsigned u32x4 __attribute__((ext_vector_type(4)));
constexpr int BM = 256, BK = 64, HALF = 128, HTB = HALF * BK * 2  , STAGE_BYTES = 8 * HTB, NXCD = 8, WGM = 8;

__host__ __device__ __forceinline__ int lds_byte(int r, int c) { const int st = (r >> 4) * 2 + (c >> 5), rr = r & 15, cc = c & 31, ob = rr * 64 + cc * 2; return st * 1024 + (ob ^ (((ob >> 9) & 1) << 5)); }
__host__ __device__ __forceinline__ void stage_rc(int b, int& R, int& C) { const int st = b / 1024, sb = b % 1024, swz = sb ^ (((sb >> 9) & 1) << 5); R = (st >> 1) * 16 + swz / 64; C = (st & 1) * 32 + (swz % 64) / 2; }
__host__ __device__ __forceinline__ int perm32(int rho) { const int n = rho >> 4, i = rho & 15; return 8 * (i >> 2) + 4 * n + (i & 3); }

struct Unit { int pm, pn; };
struct Gemm { const bf16_t* A; const bf16_t* Bt; int M, N, K, lda, tile_rows; };

struct StaticOrder {
    int nM, nN, nwg, G, c;
    __host__ __device__ void init(int M, int N, int G_, int c_) { nM = M / BM; nN = N / BM; nwg = nM * nN; G = G_; c = c_; }
    __host__ __device__ bool next(int i, Unit& u) const {
        const long L = (long)i * G + c; if (L >= nwg) return false;
        int wgid = (int)L; { const int q = nwg / NXCD, r = nwg % NXCD, xcd = wgid % NXCD, off = wgid / NXCD; wgid = (xcd < r ? xcd * (q + 1) : r * (q + 1) + (xcd - r) * q) + off; }
        const int nig = WGM * nN, gid = wgid / nig, fm = gid * WGM, gsz = (nM - fm) < WGM ? (nM - fm) : WGM;
        u.pm = fm + ((wgid % nig) % gsz); u.pn = (wgid % nig) / gsz; return true;
    }
    __device__ __forceinline__ void a_ready(const Unit&) const {}
    __device__ __forceinline__ void done(const Unit&) const {}
};
__device__ __forceinline__ unsigned cvt_pk_bf16(float lo, float hi) { unsigned r; asm volatile("v_cvt_pk_bf16_f32 %0, %1, %2" : "=v"(r) : "v"(lo), "v"(hi)); return r; }
typedef float f32x2 __attribute__((ext_vector_type(2)));
struct EpiF32 {
    static constexpr bool PERM = false, AFTER_DRAIN = false;
    float* C; int ldc; const float* bias;
    __device__ __forceinline__ void operator()(const f32x4 (&acc)[2][2][4][2], const Unit& u, int wr, int wc, int fr, int fq) const {
        const int row0 = u.pm * BM + wr * 64 + fr, col0 = u.pn * BM + wc * 32 + 4 * fq;
        f32x4 bv[2][2];
#pragma unroll
        for (int bj = 0; bj < 2; ++bj)
#pragma unroll
            for (int n = 0; n < 2; ++n) bv[bj][n] = bias ? *(const f32x4*)(bias + col0 + bj * HALF + n * 16) : (f32x4){0.f, 0.f, 0.f, 0.f};
#pragma unroll
        for (int ai = 0; ai < 2; ++ai)
#pragma unroll
            for (int m = 0; m < 4; ++m) { float* rowp = C + (size_t)(row0 + ai * HALF + m * 16) * ldc + col0;
#pragma unroll
                for (int bj = 0; bj < 2; ++bj)
#pragma unroll
                    for (int n = 0; n < 2; ++n) *(f32x4*)(rowp + bj * HALF + n * 16) = acc[ai][bj][m][n] + bv[bj][n]; }
    }
};
template <class Epi, class Sched, bool STAMP = false>
__device__ __forceinline__ void gemm_phase(PG8_LAS unsigned char* lds, const Gemm g, const Sched& S, const Epi& E, unsigned long long* stamps) {
    const int tid = threadIdx.x, wid = __builtin_amdgcn_readfirstlane(tid >> 6), lane = tid & 63, wr = wid >> 2, wc = wid & 3, fr = lane & 15, fq = lane >> 4;
    const int K = g.K, nt = K / BK;
    int ts_lo = 0, ts_hi = 0, nts = 0; const unsigned long long rt_entry = STAMP ? (unsigned long long)wall_clock64() : 0ull;
#define PG8_STAMP() do { if (STAMP && wid == 0 && nts < 64) { const unsigned long long _c = (unsigned long long)clock64(); \
        ts_lo = (lane == nts) ? (int)(unsigned)_c : ts_lo; ts_hi = (lane == nts) ? (int)(unsigned)(_c >> 32) : ts_hi; ++nts; } } while (0)
    PG8_STAMP();
    unsigned voffA[2], voffB[2];
#pragma unroll
    for (int i = 0; i < 2; ++i) { int R, C; stage_rc(tid * 16 + i * 8192, R, C); const int Rb = Epi::PERM ? ((R & ~31) + perm32(R & 31)) : R;
        voffA[i] = (unsigned)(R * g.lda + C) * 2u; voffB[i] = (unsigned)(Rb * K + C) * 2u; }
    const size_t kstep = (size_t)(BK * 2);
    const size_t hstep = (size_t)HALF * K * 2, hstepA = (size_t)HALF * g.lda * 2;
    const size_t tstep = 2 * hstep, tstepA = (size_t)g.tile_rows * g.lda * 2;
    const unsigned ldsw = (unsigned)wid * 1024u;
    const int aoff = lds_byte(wr * 64 + fr, fq * 8), boff = lds_byte(wc * 32 + fr, fq * 8);
#define PG8_SA(b, h) (((b) * 2 + (h)) * HTB)
#define PG8_SB(b, h) ((4 + (b) * 2 + (h)) * HTB)
#define PG8_STAGE(bufoff, gbase, voff) do { _Pragma("unroll") for (int _i = 0; _i < 2; ++_i) \
        __builtin_amdgcn_global_load_lds((const unsigned*)((const char*)(gbase) + (voff)[_i]), (PG8_LAS unsigned*)(lds + (bufoff) + ldsw + _i * 8192), 16, 0, 0); } while (0)
#define PG8_LDA(dst, b, h) do { _Pragma("unroll") for (int m = 0; m < 4; ++m) _Pragma("unroll") for (int k = 0; k < 2; ++k) dst[m][k] = *(const PG8_LAS bf16x8*)(lds + PG8_SA(b, h) + aoff + m * 2048 + k * 1024); } while (0)
#define PG8_LDB(dst, b, h) do { _Pragma("unroll") for (int n = 0; n < 2; ++n) _Pragma("unroll") for (int k = 0; k < 2; ++k) dst[n][k] = *(const PG8_LAS bf16x8*)(lds + PG8_SB(b, h) + boff + n * 2048 + k * 1024); } while (0)
#define PG8_MMA(ai, bj, At, Bt) do { __builtin_amdgcn_s_setprio(1); _Pragma("unroll") for (int m = 0; m < 4; ++m) _Pragma("unroll") for (int n = 0; n < 2; ++n) _Pragma("unroll") for (int k = 0; k < 2; ++k) \
        acc[ai][bj][m][n] = __builtin_amdgcn_mfma_f32_16x16x32_bf16(Bt[n][k], At[m][k], acc[ai][bj][m][n], 0, 0, 0); __builtin_amdgcn_s_setprio(0); } while (0)
#define PG8_WAIT_V(n) asm volatile("s_waitcnt vmcnt(" #n ")" ::: "memory")
#define PG8_WAIT_L(n) asm volatile("s_waitcnt lgkmcnt(" #n ")" ::: "memory")
#define PG8_BAR __builtin_amdgcn_s_barrier()
#define PG8_SCHED __builtin_amdgcn_sched_barrier(0)
    Unit cur, nxt; int ui = 0;
    if (!S.next(0, cur)) return;
    f32x4 acc[2][2][4][2];
#pragma unroll
    for (int a = 0; a < 2; ++a)
#pragma unroll
        for (int b = 0; b < 2; ++b)
#pragma unroll
            for (int m = 0; m < 4; ++m)
#pragma unroll
                for (int n = 0; n < 2; ++n) acc[a][b][m][n] = (f32x4){0.f, 0.f, 0.f, 0.f};
    bf16x8 At[4][2], B0[2][2], B1[2][2];
    const char* cA = (const char*)g.A + (size_t)cur.pm * tstepA; const char* cB = (const char*)g.Bt + (size_t)cur.pn * tstep;
    S.a_ready(cur);
    PG8_STAGE(PG8_SB(0, 0), cB, voffB); PG8_STAGE(PG8_SA(0, 0), cA, voffA); PG8_STAGE(PG8_SB(0, 1), cB + hstep, voffB); PG8_STAGE(PG8_SA(0, 1), cA + hstepA, voffA);
    if (wr == 1) PG8_BAR;
    PG8_WAIT_V(4); PG8_BAR;
    PG8_STAGE(PG8_SB(1, 0), cB + kstep, voffB); PG8_STAGE(PG8_SA(1, 0), cA + kstep, voffA); PG8_STAGE(PG8_SB(1, 1), cB + hstep + kstep, voffB);
    PG8_WAIT_V(6); PG8_BAR;
    PG8_STAMP();
    for (;;) {
        const bool has_next = S.next(ui + 1, nxt);
        const char* nA = has_next ? (const char*)g.A + (size_t)nxt.pm * tstepA : cA; const char* nB = has_next ? (const char*)g.Bt + (size_t)nxt.pn * tstep : cB;
        for (int t = 0; t < nt; t += 2) {
            const bool last = (t == nt - 2);
            const char* a1 = cA + (size_t)(t + 1) * kstep;
            const char* a2 = last ? nA : cA + (size_t)(t + 2) * kstep; const char* b2 = last ? nB : cB + (size_t)(t + 2) * kstep;
            const char* a3 = a2 + kstep; const char* b3 = b2 + kstep;
            if (last && has_next) S.a_ready(nxt);
            PG8_LDB(B0, 0, 0); PG8_SCHED; PG8_LDA(At, 0, 0); PG8_STAGE(PG8_SA(1, 1), a1 + hstepA, voffA);
            PG8_WAIT_L(8); PG8_BAR; PG8_WAIT_L(0); PG8_MMA(0, 0, At, B0); PG8_BAR; PG8_SCHED;
            PG8_LDB(B1, 0, 1); PG8_STAGE(PG8_SB(0, 0), b2, voffB);
            PG8_BAR; PG8_WAIT_L(0); PG8_MMA(0, 1, At, B1); PG8_BAR;
            PG8_LDA(At, 0, 1); PG8_STAGE(PG8_SA(0, 0), a2, voffA);
            PG8_BAR; PG8_WAIT_L(0); PG8_MMA(1, 0, At, B0); PG8_BAR; PG8_SCHED;
            PG8_STAGE(PG8_SB(0, 1), b2 + hstep, voffB);
            PG8_WAIT_V(6); PG8_BAR; PG8_MMA(1, 1, At, B1); PG8_BAR;
            PG8_LDB(B0, 1, 0); PG8_SCHED; PG8_LDA(At, 1, 0); PG8_STAGE(PG8_SA(0, 1), a2 + hstepA, voffA);
            PG8_WAIT_L(8); PG8_BAR; PG8_WAIT_L(0); PG8_MMA(0, 0, At, B0); PG8_BAR; PG8_SCHED;
            PG8_LDB(B1, 1, 1); PG8_STAGE(PG8_SB(1, 0), b3, voffB);
            PG8_BAR; PG8_WAIT_L(0); PG8_MMA(0, 1, At, B1); PG8_BAR;
            PG8_LDA(At, 1, 1); PG8_STAGE(PG8_SA(1, 0), a3, voffA);
            PG8_BAR; PG8_WAIT_L(0); PG8_MMA(1, 0, At, B0); PG8_BAR; PG8_SCHED;
            PG8_STAGE(PG8_SB(1, 1), b3 + hstep, voffB);
            PG8_WAIT_V(6); PG8_BAR; PG8_MMA(1, 1, At, B1); PG8_BAR;
        }
        PG8_STAMP();
        if constexpr (!Epi::AFTER_DRAIN) { E(acc, cur, wr, wc, fr, fq); S.done(cur); }
        PG8_STAMP();
        if (!has_next) break;
#pragma unroll
        for (int a = 0; a < 2; ++a)
#pragma unroll
            for (int b = 0; b < 2; ++b)
#pragma unroll
                for (int m = 0; m < 4; ++m)
#pragma unroll
                    for (int n = 0; n < 2; ++n) acc[a][b][m][n] = (f32x4){0.f, 0.f, 0.f, 0.f};
        cur = nxt; cA = nA; cB = nB; ++ui;
    }
    PG8_WAIT_V(0);
    if (wr == 0) PG8_BAR;
    PG8_BAR;
    if constexpr (Epi::AFTER_DRAIN) { E.fused(acc, cur, wr, wc, fr, fq, lds, wid, lane); S.done(cur); }
    PG8_STAMP();
    if (STAMP && wid == 0) { stamps[lane] = lane < nts ? (((unsigned long long)(unsigned)ts_hi << 32) | (unsigned)ts_lo) : 0ull;
        if (lane == 62) stamps[62] = rt_entry; if (lane == 63) stamps[63] = (unsigned long long)wall_clock64(); }
#undef PG8_STAMP
#undef PG8_SA
#undef PG8_SB
#undef PG8_STAGE
#undef PG8_LDA
#undef PG8_LDB
#undef PG8_MMA
#undef PG8_WAIT_V
#undef PG8_WAIT_L
#undef PG8_BAR
#undef PG8_SCHED
}
}

namespace cg = cooperative_groups;
#define LAS __attribute__((address_space(3)))
typedef unsigned short bf16_t;
typedef unsigned int u32;
typedef pg8::bf16x8 bf16x8;
typedef pg8::f32x4 f32x4;
typedef pg8::u32x4 u32x4;

constexpr int D = 1024, TP = 4096, BP = 8, MP = BP * TP, BS = 32, TS = 8, MS = BS * TS;
constexpr int MB = MP + MS;
constexpr int MA = 33280;
constexpr int MA_REAL = MP + BS * 9;
constexpr int DIN = 3328, RCOLS = 1792, FF = 2816, FF2 = 5632, NLORA = 1536, KLORA = 256;
constexpr int NTHREADS = 512;
constexpr int UP_TILES = 131, UP_STEP = 254, H2P_ROWS = (UP_TILES - 1) * UP_STEP + 256;
constexpr int LDS_BYTES = 144 * 1024;

constexpr size_t O_YP = 0;
constexpr size_t O_YS = O_YP + (size_t)MP * D;
constexpr size_t O_PSH = O_YS + (size_t)MS * D;
constexpr size_t O_PWKV = O_PSH + (size_t)BP * D;
constexpr size_t O_PK = O_PWKV + (size_t)BP * 8 * 64 * 64;
constexpr size_t O_PV = O_PK + (size_t)BP * 2048 * 512;
constexpr size_t O_PCONV = O_PV + (size_t)BP * 2048 * 512;
constexpr size_t O_SSH = O_PCONV + (size_t)BP * 2 * FF2;
constexpr size_t O_SWKV = O_SSH + (size_t)BS * D;
constexpr size_t O_SK = O_SWKV + (size_t)BS * 8 * 64 * 64;
constexpr size_t O_SV = O_SK + (size_t)BS * 2048 * 512;
constexpr size_t O_SCONV = O_SV + (size_t)BS * 2048 * 512;
constexpr size_t O_END = O_SCONV + (size_t)BS * 2 * FF2;

constexpr size_t al256(size_t x) { return (x + 255) & ~(size_t)255; }
constexpr size_t WS_WIN = 0;
constexpr size_t WS_WOUT = WS_WIN + al256((size_t)DIN * D * 2);
constexpr size_t WS_WUP = WS_WOUT + al256((size_t)D * D * 2);
constexpr size_t WS_WDN = WS_WUP + al256((size_t)FF2 * D * 2);
constexpr size_t WS_WLORA = WS_WDN + al256((size_t)D * FF * 2);
constexpr size_t WS_ROPE = WS_WLORA + al256((size_t)NLORA * KLORA * 2);
constexpr int NPOS = 4104;
constexpr size_t WS_SNEWK = WS_ROPE + al256((size_t)NPOS * 32 * 2 * 4);
constexpr size_t WS_SNEWV = WS_SNEWK + al256((size_t)MS * 512 * 4);
constexpr size_t WS_HALO = WS_SNEWV + al256((size_t)MS * 512 * 4);
constexpr size_t WS_A = WS_HALO + al256((size_t)1025 * 2 * FF2 * 2);
constexpr size_t WS_PROJRW = WS_A;
constexpr size_t WS_Q = WS_PROJRW + al256((size_t)MA * RCOLS * 2);
constexpr size_t WS_K = WS_Q + al256((size_t)MB * 512 * 2);
constexpr size_t WS_VT1 = WS_K + al256((size_t)MB * 512 * 2);
constexpr size_t WS_VT4 = WS_VT1 + al256((size_t)BP * 8 * 64 * TP * 2);
constexpr size_t WS_VT16 = WS_VT4 + al256((size_t)BP * 8 * 64 * TP * 2);
constexpr size_t WS_ALORA = WS_VT16 + al256((size_t)BP * 8 * 64 * TP * 2);
constexpr size_t WS_VROW = WS_ALORA + al256((size_t)MB * KLORA * 2);
constexpr size_t WS_A_EARLY_END = WS_VROW + al256((size_t)MP * 512 * 2);
constexpr size_t WS_U = WS_A;
constexpr size_t WS_F = WS_A + al256((size_t)MB * FF * 2);
static_assert(WS_F + (size_t)MB * D * 4 <= WS_A + al256((size_t)MB * FF2 * 2), "region A late overflow");
constexpr size_t WS_END = WS_A + al256((size_t)MB * FF2 * 2);
static_assert(WS_A_EARLY_END <= WS_END, "region A overflow");
constexpr size_t WS_BAR = WS_END;
constexpr size_t WS_TOTAL = WS_END + 256;
constexpr size_t WS_Y = WS_ALORA;
static_assert(WS_Y + (size_t)MB * 512 * 4 <= WS_END, "Y overflow");
constexpr size_t SC_B = O_SK * 4;
constexpr size_t SC_C = SC_B + al256((size_t)MB * D * 4);
static_assert(SC_C + (size_t)H2P_ROWS * D * 2 <= O_SCONV * 4, "scratch overflow");
static_assert((size_t)MA * D * 2 <= (size_t)MB * D * 4 && (size_t)MB * NLORA * 2 <= (size_t)MB * D * 4, "region B");

struct Params {
    const float* in[28];
    float* out;
    unsigned char* ws;
    int en, pad;
};

enum { I_XP = 0, I_XS, I_SSHIFT, I_SWKV, I_CK, I_CV, I_SCONV, I_NMPRE, I_NMPOST, I_NFPRE, I_NFPOST, I_WIN, I_MU, I_W0, I_WDEC, I_A0, I_WICLR, I_WGATE,
       I_KK, I_KA, I_RK, I_LNW, I_LNB, I_WOUT, I_WUP, I_CONVW, I_CONVB, I_WDN };

__device__ __forceinline__ float bflo(u32 p) { return __uint_as_float(p << 16); }
__device__ __forceinline__ float bfhi(u32 p) { return __uint_as_float(p & 0xffff0000u); }
__device__ __forceinline__ u32 pk2(float a, float b) { return pg8::cvt_pk_bf16(a, b); }
__device__ __forceinline__ float wave_sum(float v) {
#pragma unroll
    for (int o = 1; o < 64; o <<= 1) v += __shfl_xor(v, o);
    return v;
}
template <int N> __device__ __forceinline__ float dpp_ror(float x) {
    return __int_as_float(__builtin_amdgcn_update_dpp(0, __float_as_int(x), 0x120 + N, 0xF, 0xF, false));
}
__device__ __forceinline__ float row16_sum(float x) {
    x += dpp_ror<8>(x); x += dpp_ror<4>(x); x += dpp_ror<2>(x); x += dpp_ror<1>(x);
    return x;
}
__device__ __forceinline__ void row16_sum4(float& a, float& b, float& c, float& d) {
    asm volatile("s_nop 1\n\t"
                 "v_add_f32_dpp %0, %0, %0 row_ror:8 row_mask:0xf bank_mask:0xf\n\t" "v_add_f32_dpp %1, %1, %1 row_ror:8 row_mask:0xf bank_mask:0xf\n\t"
                 "v_add_f32_dpp %2, %2, %2 row_ror:8 row_mask:0xf bank_mask:0xf\n\t" "v_add_f32_dpp %3, %3, %3 row_ror:8 row_mask:0xf bank_mask:0xf\n\t"
                 "v_add_f32_dpp %0, %0, %0 row_ror:4 row_mask:0xf bank_mask:0xf\n\t" "v_add_f32_dpp %1, %1, %1 row_ror:4 row_mask:0xf bank_mask:0xf\n\t"
                 "v_add_f32_dpp %2, %2, %2 row_ror:4 row_mask:0xf bank_mask:0xf\n\t" "v_add_f32_dpp %3, %3, %3 row_ror:4 row_mask:0xf bank_mask:0xf\n\t"
                 "v_add_f32_dpp %0, %0, %0 row_ror:2 row_mask:0xf bank_mask:0xf\n\t" "v_add_f32_dpp %1, %1, %1 row_ror:2 row_mask:0xf bank_mask:0xf\n\t"
                 "v_add_f32_dpp %2, %2, %2 row_ror:2 row_mask:0xf bank_mask:0xf\n\t" "v_add_f32_dpp %3, %3, %3 row_ror:2 row_mask:0xf bank_mask:0xf\n\t"
                 "v_add_f32_dpp %0, %0, %0 row_ror:1 row_mask:0xf bank_mask:0xf\n\t" "v_add_f32_dpp %1, %1, %1 row_ror:1 row_mask:0xf bank_mask:0xf\n\t"
                 "v_add_f32_dpp %2, %2, %2 row_ror:1 row_mask:0xf bank_mask:0xf\n\t" "v_add_f32_dpp %3, %3, %3 row_ror:1 row_mask:0xf bank_mask:0xf\n\t"
                 "s_nop 1"
                 : "+v"(a), "+v"(b), "+v"(c), "+v"(d));
}
__device__ __forceinline__ float fma_(float a, float b, float c) { float d; asm("v_fma_f32 %0, %1, %2, %3" : "=v"(d) : "v"(a), "v"(b), "v"(c)); return d; }
__device__ __forceinline__ float mul_(float a, float b) { float d; asm("v_mul_f32 %0, %1, %2" : "=v"(d) : "v"(a), "v"(b)); return d; }
__device__ __forceinline__ void row16_sum2_mul4(float& a, float& b, float (&t)[4], float v, float k0, float k1, float k2, float k3) {
    asm volatile("v_mul_f32 %2, %6, %7\n\t" "v_mul_f32 %3, %6, %8\n\t"
                 "v_add_f32_dpp %0, %0, %0 row_ror:8 row_mask:0xf bank_mask:0xf\n\t" "v_add_f32_dpp %1, %1, %1 row_ror:8 row_mask:0xf bank_mask:0xf\n\t"
                 "v_mul_f32 %4, %6, %9\n\t"
                 "v_add_f32_dpp %0, %0, %0 row_ror:4 row_mask:0xf bank_mask:0xf\n\t" "v_add_f32_dpp %1, %1, %1 row_ror:4 row_mask:0xf bank_mask:0xf\n\t"
                 "v_mul_f32 %5, %6, %10\n\t"
                 "v_add_f32_dpp %0, %0, %0 row_ror:2 row_mask:0xf bank_mask:0xf\n\t" "v_add_f32_dpp %1, %1, %1 row_ror:2 row_mask:0xf bank_mask:0xf\n\t"
                 "s_nop 0\n\t"
                 "v_add_f32_dpp %0, %0, %0 row_ror:1 row_mask:0xf bank_mask:0xf\n\t" "v_add_f32_dpp %1, %1, %1 row_ror:1 row_mask:0xf bank_mask:0xf"
                 : "+v"(a), "+v"(b), "=&v"(t[0]), "=&v"(t[1]), "=&v"(t[2]), "=&v"(t[3])
                 : "v"(v), "v"(k0), "v"(k1), "v"(k2), "v"(k3));
}
__device__ __forceinline__ void row16_sum2(float& a, float& b) {
    asm volatile("s_nop 1\n\t"
                 "v_add_f32_dpp %0, %0, %0 row_ror:8 row_mask:0xf bank_mask:0xf\n\t" "v_add_f32_dpp %1, %1, %1 row_ror:8 row_mask:0xf bank_mask:0xf\n\t" "s_nop 0\n\t"
                 "v_add_f32_dpp %0, %0, %0 row_ror:4 row_mask:0xf bank_mask:0xf\n\t" "v_add_f32_dpp %1, %1, %1 row_ror:4 row_mask:0xf bank_mask:0xf\n\t" "s_nop 0\n\t"
                 "v_add_f32_dpp %0, %0, %0 row_ror:2 row_mask:0xf bank_mask:0xf\n\t" "v_add_f32_dpp %1, %1, %1 row_ror:2 row_mask:0xf bank_mask:0xf\n\t" "s_nop 0\n\t"
                 "v_add_f32_dpp %0, %0, %0 row_ror:1 row_mask:0xf bank_mask:0xf\n\t" "v_add_f32_dpp %1, %1, %1 row_ror:1 row_mask:0xf bank_mask:0xf\n\t"
                 "s_nop 1"
                 : "+v"(a), "+v"(b));
}
__device__ __forceinline__ float sigmoidf_(float x) { return __builtin_amdgcn_rcpf(1.f + __expf(-x)); }

__device__ __forceinline__ int win_rowmap(int n) {
    if (n < RCOLS || n >= RCOLS + 1024) return n;
    const int base = (n < RCOLS + 512) ? RCOLS : RCOLS + 512, c = n - base, unit = c >> 8, cu = c & 255, hu = cu >> 6, d = cu & 63, e = d & 31, s = d >> 5;
    const int idx = hu * 32 + e, bj = idx >> 6, wc = (idx & 63) >> 4, fq = (idx & 15) >> 2, j = idx & 3;
    return base + unit * 256 + 128 * bj + 32 * wc + 16 * s + 4 * fq + j;
}
__device__ __forceinline__ int wup_rowmap(int c) {
    const int isup = c >= FF ? 1 : 0, cc = c - FF * isup, pn = cc >> 7, e = cc & 127;
    return pn * 256 + 128 * (e >> 6) + 32 * ((e >> 4) & 3) + 16 * isup + 4 * ((e >> 2) & 3) + (e & 3);
}
__device__ __forceinline__ void transpose_item(const float* W, int K, int N, bf16_t* WT, int mode, LAS float* scr, int item, int lane) {
    const int nblk = N / 32, kb = item / nblk, nb = item % nblk, k0 = 64 * kb, n0 = 32 * nb;
#pragma unroll 8
    for (int i = 0; i < 32; ++i) { const int kk = 2 * i + (lane >> 5); scr[kk * 33 + (lane & 31)] = W[(size_t)(k0 + kk) * N + n0 + (lane & 31)]; }
    asm volatile("s_waitcnt lgkmcnt(0)" ::: "memory");
    const int c = lane & 7;
#pragma unroll
    for (int j = 0; j < 4; ++j) { const int n = (lane >> 3) + 8 * j; const LAS float* s = scr + (8 * c) * 33 + n;
        uint4 o; o.x = pk2(s[0 * 33], s[1 * 33]); o.y = pk2(s[2 * 33], s[3 * 33]); o.z = pk2(s[4 * 33], s[5 * 33]); o.w = pk2(s[6 * 33], s[7 * 33]);
        const int row = mode == 1 ? win_rowmap(n0 + n) : (mode == 2 ? wup_rowmap(n0 + n) : (n0 + n));
        *(uint4*)(WT + (size_t)row * K + k0 + 8 * c) = o; }
    asm volatile("s_waitcnt lgkmcnt(0)" ::: "memory");
}
__device__ __forceinline__ void rms_row(const float* xrow, const float* g, bf16_t* orow, float* frow, int lane) {
    const float4* xr = (const float4*)xrow + lane; const float4* gr = (const float4*)g + lane;
    float4 v[4]; float s = 0.f;
#pragma unroll
    for (int j = 0; j < 4; ++j) { v[j] = xr[64 * j]; s += (v[j].x * v[j].x + v[j].y * v[j].y) + (v[j].z * v[j].z + v[j].w * v[j].w); }
    const float rs = rsqrtf(wave_sum(s) * (1.f / D) + 1e-6f);
#pragma unroll
    for (int j = 0; j < 4; ++j) { const float4 gg = gr[64 * j];
        float4 y; y.x = v[j].x * rs * gg.x; y.y = v[j].y * rs * gg.y; y.z = v[j].z * rs * gg.z; y.w = v[j].w * rs * gg.w;
        uint2 o; o.x = pk2(y.x, y.y); o.y = pk2(y.z, y.w);
        *((uint2*)orow + lane + 64 * j) = o;
        if (frow) *((float4*)frow + lane + 64 * j) = y; }
}
__device__ __forceinline__ void phase0(const Params& p, LAS unsigned char* lds, int tid, int G, int bid) {
    const int wave = tid >> 6, lane = tid & 63, gw = bid * 8 + wave, NGW = G * 8;
    LAS float* scr = (LAS float*)(lds + wave * 16384);
    bf16_t* WinT = (bf16_t*)(p.ws + WS_WIN); bf16_t* WoutT = (bf16_t*)(p.ws + WS_WOUT); bf16_t* WupT = (bf16_t*)(p.ws + WS_WUP); bf16_t* WdnT = (bf16_t*)(p.ws + WS_WDN);
    constexpr int I1 = (D / 64) * (DIN / 32), I2 = (D / 64) * (D / 32), I3 = (D / 64) * (FF2 / 32), I4 = (FF / 64) * (D / 32);
    for (int it = gw; it < I1 + I2 + I3 + I4; it += NGW) {
        int r = it;
        if (r < I1) { transpose_item(p.in[I_WIN], D, DIN, WinT, 1, scr, r, lane); continue; } r -= I1;
        if (r < I2) { transpose_item(p.in[I_WOUT], D, D, WoutT, 0, scr, r, lane); continue; } r -= I2;
        if (r < I3) { transpose_item(p.in[I_WUP], D, FF2, WupT, 2, scr, r, lane); continue; } r -= I3;
        transpose_item(p.in[I_WDN], FF, D, WdnT, 0, scr, r, lane);
    }
    const int gt = bid * NTHREADS + tid, NT = G * NTHREADS;
    bf16_t* WL = (bf16_t*)(p.ws + WS_WLORA);
    for (int i = gt; i < NLORA * KLORA; i += NT) {
        const int row = i >> 8, k = i & 255; float v = 0.f;
        if (row < 512) { if (k < 64) v = p.in[I_WDEC][k * 512 + row]; }
        else if (row < 1024) { if (k >= 64 && k < 128) v = p.in[I_WICLR][(k - 64) * 512 + (row - 512)]; }
        else { if (k >= 128) v = p.in[I_WGATE][(k - 128) * 512 + (row - 1024)]; }
        WL[i] = (bf16_t)(pk2(v, 0.f) & 0xffffu);
    }
    float* rope = (float*)(p.ws + WS_ROPE);
    for (int i = gt; i < NPOS * 32; i += NT) {
        const int pi = i >> 5, e = i & 31; const int pos = pi < TP ? pi : 16384 + (pi - TP);
        double inv = 1.0; for (int q = 0; q < e; ++q) inv *= 0.7498942093324558273;
        const float ang = (float)pos * (float)inv;
        const double a = (double)ang; const double kq = rint(a * 0.15915494309189535); double r = a - kq * 6.283185307179586; r -= kq * 2.4492935982947064e-16;
        const double r2 = r * r;
        double sn = 1.0 / 51090942171709440000.0;
        sn = sn * r2 * (-1.0) + 1.0 / 121645100408832000.0;
        sn = -sn * r2 + 1.0 / 355687428096000.0;
        sn = -sn * r2 + 1.0 / 1307674368000.0;
        sn = -sn * r2 + 1.0 / 6227020800.0;
        sn = -sn * r2 + 1.0 / 39916800.0;
        sn = -sn * r2 + 1.0 / 362880.0;
        sn = -sn * r2 + 1.0 / 5040.0;
        sn = -sn * r2 + 1.0 / 120.0;
        sn = -sn * r2 + 1.0 / 6.0;
        sn = -sn * r2 + 1.0;
        sn *= r;
        double cs = 1.0 / 1124000727777607680000.0;
        cs = -cs * r2 + 1.0 / 2432902008176640000.0;
        cs = -cs * r2 + 1.0 / 6402373705728000.0;
        cs = -cs * r2 + 1.0 / 20922789888000.0;
        cs = -cs * r2 + 1.0 / 87178291200.0;
        cs = -cs * r2 + 1.0 / 479001600.0;
        cs = -cs * r2 + 1.0 / 3628800.0;
        cs = -cs * r2 + 1.0 / 40320.0;
        cs = -cs * r2 + 1.0 / 720.0;
        cs = -cs * r2 + 1.0 / 24.0;
        cs = -cs * r2 + 0.5;
        cs = -cs * r2 + 1.0;
        rope[i] = (float)cs; rope[NPOS * 32 + i] = (float)sn;
    }
    bf16_t* H = (bf16_t*)((unsigned char*)p.out + SC_B);
    for (int row = gw; row < MA; row += NGW) {
        bf16_t* orow = H + (size_t)row * D;
        if (row < MP) {
            const bool last = (row & (TP - 1)) == TP - 1;
            rms_row(p.in[I_XP] + (size_t)row * D, p.in[I_NMPRE], orow, last ? p.out + O_PSH + (size_t)(row >> 12) * D : nullptr, lane);
        } else {
            const int s = row - MP;
            if (s < BS * 9) {
                const int b = s / 9, j = s - b * 9;
                if (j == 0) {
                    const float4* sr = (const float4*)(p.in[I_SSHIFT] + (size_t)b * D) + lane;
#pragma unroll
                    for (int q = 0; q < 4; ++q) { const float4 v = sr[64 * q]; uint2 o; o.x = pk2(v.x, v.y); o.y = pk2(v.z, v.w); *((uint2*)orow + lane + 64 * q) = o; }
                } else {
                    rms_row(p.in[I_XS] + (size_t)(b * TS + j - 1) * D, p.in[I_NMPRE], orow, j == TS ? p.out + O_SSH + (size_t)b * D : nullptr, lane);
                }
            } else {
#pragma unroll
                for (int q = 0; q < 4; ++q) *((uint2*)orow + lane + 64 * q) = make_uint2(0u, 0u);
            }
        }
    }
}

struct EpiProj {
    static constexpr bool PERM = false, AFTER_DRAIN = false;
    bf16_t* projrw; bf16_t* Q; bf16_t* K; bf16_t* VT1; bf16_t* VT4; bf16_t* VT16; const float* rope; float* out; float* snewk; float* snewv;
    __device__ __forceinline__ void operator()(const f32x4 (&acc)[2][2][4][2], const pg8::Unit& u, int wr, int wc, int fr, int fq) const {
        const int pn = u.pn;
        if (pn < 7) {
#pragma unroll
            for (int ai = 0; ai < 2; ++ai)
#pragma unroll
                for (int m = 0; m < 4; ++m) { const int row = u.pm * 256 + ai * 128 + wr * 64 + m * 16 + fr;
                    bf16_t* rp = projrw + (size_t)row * RCOLS + pn * 256 + wc * 32 + 4 * fq;
#pragma unroll
                    for (int bj = 0; bj < 2; ++bj)
#pragma unroll
                        for (int n = 0; n < 2; ++n) { const f32x4 v = acc[ai][bj][m][n]; uint2 o; o.x = pk2(v[0], v[1]); o.y = pk2(v[2], v[3]); *(uint2*)(rp + bj * 128 + n * 16) = o; } }
            return;
        }
        if (pn < 11 && u.pm < MP / 256) {
            const bool isq = pn < 9; const int unit = isq ? pn - 7 : pn - 9;
            const int rowbase = u.pm * 256 + wr * 64 + fr; const int b = rowbase >> 12, t0 = rowbase & (TP - 1);
#pragma unroll
            for (int bj = 0; bj < 2; ++bj) {
                const int idx = bj * 64 + wc * 16 + fq * 4, hu = idx >> 5, e = idx & 31; const int col = unit * 256 + hu * 64 + e;
                const float4 c16 = *(const float4*)(rope + 16 * 32 + e), s16 = *(const float4*)(rope + (size_t)NPOS * 32 + 16 * 32 + e);
                const float c16a[4] = {c16.x, c16.y, c16.z, c16.w}, s16a[4] = {s16.x, s16.y, s16.z, s16.w};
#pragma unroll
                for (int ai = 0; ai < 2; ++ai) {
                    const int tb = t0 + 128 * ai;
                    const float4 cs4 = *(const float4*)(rope + (size_t)tb * 32 + e), sn4 = *(const float4*)(rope + (size_t)NPOS * 32 + (size_t)tb * 32 + e);
                    float cs[4] = {cs4.x, cs4.y, cs4.z, cs4.w}, sn[4] = {sn4.x, sn4.y, sn4.z, sn4.w};
#pragma unroll
                    for (int m = 0; m < 4; ++m) {
                        const int t = tb + 16 * m; const size_t rowB = (size_t)b * TP + t;
                        const f32x4 x1 = acc[ai][bj][m][0], x2 = acc[ai][bj][m][1];
                        float o1[4], o2[4];
#pragma unroll
                        for (int j = 0; j < 4; ++j) { o1[j] = x1[j] * cs[j] - x2[j] * sn[j]; o2[j] = x1[j] * sn[j] + x2[j] * cs[j]; }
                        if (isq) {
                            uint2 a, c2; a.x = pk2(o1[0] * 0.125f, o1[1] * 0.125f); a.y = pk2(o1[2] * 0.125f, o1[3] * 0.125f); c2.x = pk2(o2[0] * 0.125f, o2[1] * 0.125f); c2.y = pk2(o2[2] * 0.125f, o2[3] * 0.125f);
                            *(uint2*)(Q + rowB * 512 + col) = a; *(uint2*)(Q + rowB * 512 + col + 32) = c2;
                        } else {
                            uint2 a, c2; a.x = pk2(o1[0], o1[1]); a.y = pk2(o1[2], o1[3]); c2.x = pk2(o2[0], o2[1]); c2.y = pk2(o2[2], o2[3]);
                            *(uint2*)(K + rowB * 512 + col) = a; *(uint2*)(K + rowB * 512 + col + 32) = c2;
                            if (t >= 2048) { float* dst = out + O_PK + ((size_t)b * 2048 + (t - 2048)) * 512 + col;
                                *(float4*)dst = make_float4(o1[0], o1[1], o1[2], o1[3]); *(float4*)(dst + 32) = make_float4(o2[0], o2[1], o2[2], o2[3]); }
                        }
#pragma unroll
                        for (int j = 0; j < 4; ++j) { const float nc = cs[j] * c16a[j] - sn[j] * s16a[j], ns = sn[j] * c16a[j] + cs[j] * s16a[j]; cs[j] = nc; sn[j] = ns; }
                    }
                }
            }
            return;
        }
#pragma unroll
        for (int ai = 0; ai < 2; ++ai)
#pragma unroll
            for (int m = 0; m < 4; ++m) {
                const int row = u.pm * 256 + ai * 128 + wr * 64 + m * 16 + fr;
                bool prompt = row < MP; int b, t, rowB, pi; bool valid = true;
                if (prompt) { b = row >> 12; t = row & (TP - 1); rowB = row; pi = t; }
                else { const int s = row - MP; b = s / 9; const int j = s - b * 9; valid = (s < BS * 9) && (j > 0); t = j - 1; rowB = MP + b * TS + t; pi = TP + t; }
                if (!valid) continue;
                if (pn < 11) {
                    const bool isq = pn < 9; const int unit = isq ? pn - 7 : pn - 9;
#pragma unroll
                    for (int bj = 0; bj < 2; ++bj) {
                        const int idx = bj * 64 + wc * 16 + fq * 4, hu = idx >> 5, e = idx & 31;
                        const float4 cs = *(const float4*)(rope + (size_t)pi * 32 + e), sn = *(const float4*)(rope + (size_t)NPOS * 32 + (size_t)pi * 32 + e);
                        const f32x4 x1 = acc[ai][bj][m][0], x2 = acc[ai][bj][m][1];
                        float o1[4], o2[4];
                        o1[0] = x1[0] * cs.x - x2[0] * sn.x; o2[0] = x1[0] * sn.x + x2[0] * cs.x;
                        o1[1] = x1[1] * cs.y - x2[1] * sn.y; o2[1] = x1[1] * sn.y + x2[1] * cs.y;
                        o1[2] = x1[2] * cs.z - x2[2] * sn.z; o2[2] = x1[2] * sn.z + x2[2] * cs.z;
                        o1[3] = x1[3] * cs.w - x2[3] * sn.w; o2[3] = x1[3] * sn.w + x2[3] * cs.w;
                        const int col = unit * 256 + hu * 64 + e;
                        if (isq) {
                            uint2 a, c2; a.x = pk2(o1[0] * 0.125f, o1[1] * 0.125f); a.y = pk2(o1[2] * 0.125f, o1[3] * 0.125f); c2.x = pk2(o2[0] * 0.125f, o2[1] * 0.125f); c2.y = pk2(o2[2] * 0.125f, o2[3] * 0.125f);
                            *(uint2*)(Q + (size_t)rowB * 512 + col) = a; *(uint2*)(Q + (size_t)rowB * 512 + col + 32) = c2;
                        } else {
                            uint2 a, c2; a.x = pk2(o1[0], o1[1]); a.y = pk2(o1[2], o1[3]); c2.x = pk2(o2[0], o2[1]); c2.y = pk2(o2[2], o2[3]);
                            *(uint2*)(K + (size_t)rowB * 512 + col) = a; *(uint2*)(K + (size_t)rowB * 512 + col + 32) = c2;
                            float* dst = nullptr;
                            if (prompt) { if (t >= 2048) dst = out + O_PK + ((size_t)b * 2048 + (t - 2048)) * 512 + col; }
                            else dst = snewk + (size_t)(b * TS + t) * 512 + col;
                            if (dst) { *(float4*)dst = make_float4(o1[0], o1[1], o1[2], o1[3]); *(float4*)(dst + 32) = make_float4(o2[0], o2[1], o2[2], o2[3]); }
                        }
                    }
                } else {
#pragma unroll
                    for (int bj = 0; bj < 2; ++bj)
#pragma unroll
                        for (int n = 0; n < 2; ++n) {
                            const int col = (pn - 11) * 256 + bj * 128 + wc * 32 + n * 16 + 4 * fq; const f32x4 v = acc[ai][bj][m][n];
                            if (prompt) {
                                if (t >= 2048) *(float4*)(out + O_PV + ((size_t)b * 2048 + (t - 2048)) * 512 + col) = make_float4(v[0], v[1], v[2], v[3]);
                                uint2 o; o.x = pk2(v[0], v[1]); o.y = pk2(v[2], v[3]); *(uint2*)(VT1 + (size_t)rowB * 512 + col) = o;
                            } else {
                                *(float4*)(snewv + (size_t)(b * TS + t) * 512 + col) = make_float4(v[0], v[1], v[2], v[3]);
                            }
                        }
                }
            }
    }
};
struct EpiBf16S {
    static constexpr bool PERM = false, AFTER_DRAIN = false;
    bf16_t* O; int ldc;
    __device__ __forceinline__ void operator()(const f32x4 (&acc)[2][2][4][2], const pg8::Unit& u, int wr, int wc, int fr, int fq) const {
#pragma unroll
        for (int ai = 0; ai < 2; ++ai)
#pragma unroll
            for (int m = 0; m < 4; ++m) { bf16_t* rp = O + (size_t)(u.pm * 256 + ai * 128 + wr * 64 + m * 16 + fr) * ldc + u.pn * 256 + wc * 32 + 4 * fq;
#pragma unroll
                for (int bj = 0; bj < 2; ++bj)
#pragma unroll
                    for (int n = 0; n < 2; ++n) { const f32x4 v = acc[ai][bj][m][n]; uint2 o; o.x = pk2(v[0], v[1]); o.y = pk2(v[2], v[3]); *(uint2*)(rp + bj * 128 + n * 16) = o; } }
    }
};
struct EpiDag {
    static constexpr bool PERM = false, AFTER_DRAIN = false;
    bf16_t* dag; const float* w0; const float* a0;
    __device__ __forceinline__ void operator()(const f32x4 (&acc)[2][2][4][2], const pg8::Unit& u, int wr, int wc, int fr, int fq) const {
        const int kind = u.pn >> 1;
#pragma unroll
        for (int bj = 0; bj < 2; ++bj)
#pragma unroll
            for (int n = 0; n < 2; ++n) {
                const int col = u.pn * 256 + bj * 128 + wc * 32 + n * 16 + 4 * fq;
                float4 bias = make_float4(0.f, 0.f, 0.f, 0.f);
                if (kind == 0) bias = *(const float4*)(w0 + col); else if (kind == 1) bias = *(const float4*)(a0 + col - 512);
                const float bb[4] = {bias.x, bias.y, bias.z, bias.w};
#pragma unroll
                for (int ai = 0; ai < 2; ++ai)
#pragma unroll
                    for (int m = 0; m < 4; ++m) { const int row = u.pm * 256 + ai * 128 + wr * 64 + m * 16 + fr; const f32x4 v = acc[ai][bj][m][n]; float o[4];
#pragma unroll
                        for (int j = 0; j < 4; ++j) { const float x = v[j] + bb[j];
                            if (kind == 0) o[j] = -0.60653065971263342f * sigmoidf_(x);
                            else if (kind == 1) o[j] = sigmoidf_(x);
                            else o[j] = x; }
                        uint2 q; q.x = pk2(o[0], o[1]); q.y = pk2(o[2], o[3]); *(uint2*)(dag + (size_t)row * NLORA + col) = q; }
            }
    }
};
struct EpiUp {
    static constexpr bool PERM = false, AFTER_DRAIN = false;
    bf16_t* U; bf16_t* halo; float* out;
    __device__ __forceinline__ void operator()(const f32x4 (&acc)[2][2][4][2], const pg8::Unit& u, int wr, int wc, int fr, int fq) const {
#pragma unroll
        for (int ai = 0; ai < 2; ++ai)
#pragma unroll
            for (int m = 0; m < 4; ++m) {
                const int row = u.pm * 256 + ai * 128 + wr * 64 + m * 16 + fr; const int col0 = u.pn * 256 + wc * 32 + 4 * fq;
                bf16_t* hrow = nullptr; float* frow = nullptr;
                if (row < MP) { const int t = row & (TP - 1);
                    if ((t & 31) >= 30) hrow = halo + ((size_t)((row >> 5) + 1) * 2 + ((t & 31) - 30)) * FF2;
                    if (t >= TP - 2) frow = out + O_PCONV + ((size_t)(row >> 12) * 2 + (t - (TP - 2))) * FF2;
                } else { const int s = row - MP, b = s >> 3, tt = s & 7; if (tt >= 6) frow = out + O_SCONV + ((size_t)b * 2 + (tt - 6)) * FF2; }
#pragma unroll
                for (int bj = 0; bj < 2; ++bj)
#pragma unroll
                    for (int n = 0; n < 2; ++n) { const f32x4 v = acc[ai][bj][m][n]; const int col = col0 + bj * 128 + n * 16;
                        uint2 o; o.x = pk2(v[0], v[1]); o.y = pk2(v[2], v[3]);
                        *(uint2*)(U + (size_t)row * FF2 + col) = o;
                        if (hrow) *(uint2*)(hrow + col) = o;
                        if (frow) *(float4*)(frow + col) = make_float4(v[0], v[1], v[2], v[3]); }
            }
    }
};

struct EpiUpAct {
    static constexpr bool PERM = false, AFTER_DRAIN = false;
    bf16_t* ACT; float* out; const float* cw; const float* cb; const float* sconv; LAS float* xch;
    __device__ __forceinline__ void operator()(const f32x4 (&acc)[2][2][4][2], const pg8::Unit& u, int wr, int wc, int fr, int fq) const {
        const int lane = fq * 16 + fr, wid = wr * 4 + wc;
        if (fr >= 14) {
#pragma unroll
            for (int ai = 0; ai < 2; ++ai)
#pragma unroll
                for (int bj = 0; bj < 2; ++bj)
#pragma unroll
                    for (int n = 0; n < 2; ++n) *(LAS f32x4*)(xch + ((wid * 2 + ai) * 2 + (fr - 14)) * 64 + (bj * 2 + n) * 16 + 4 * fq) = acc[ai][bj][3][n];
        }
        asm volatile("s_waitcnt lgkmcnt(0)" ::: "memory");
        __builtin_amdgcn_s_barrier(); __builtin_amdgcn_s_barrier();
        asm volatile("" ::: "memory");
#pragma unroll
        for (int bj = 0; bj < 2; ++bj) {
            const int e = 64 * bj + 16 * wc + 4 * fq, gcol = 128 * u.pn + e, ucol = FF + gcol;
            const float4 wg0 = *(const float4*)(cw + gcol), wg1 = *(const float4*)(cw + FF2 + gcol), wg2 = *(const float4*)(cw + 2 * FF2 + gcol), bg = *(const float4*)(cb + gcol);
            const float4 wu0 = *(const float4*)(cw + ucol), wu1 = *(const float4*)(cw + FF2 + ucol), wu2 = *(const float4*)(cw + 2 * FF2 + ucol), bu = *(const float4*)(cb + ucol);
            const float w0g[4] = {wg0.x, wg0.y, wg0.z, wg0.w}, w1g[4] = {wg1.x, wg1.y, wg1.z, wg1.w}, w2g[4] = {wg2.x, wg2.y, wg2.z, wg2.w}, bgg[4] = {bg.x, bg.y, bg.z, bg.w};
            const float w0u[4] = {wu0.x, wu0.y, wu0.z, wu0.w}, w1u[4] = {wu1.x, wu1.y, wu1.z, wu1.w}, w2u[4] = {wu2.x, wu2.y, wu2.z, wu2.w}, buu[4] = {bu.x, bu.y, bu.z, bu.w};
#pragma unroll
            for (int ai = 0; ai < 2; ++ai) {
                const int swr = wr ^ 1, sai = (wr == 1) ? ai : 0;
                const LAS float* xs = xch + (((swr * 4 + wc) * 2 + sai) * 2) * 64 + (bj * 2) * 16 + 4 * fq;
                f32x4 pg1 = *(const LAS f32x4*)(xs + 64), pg2 = *(const LAS f32x4*)(xs), pu1 = *(const LAS f32x4*)(xs + 64 + 16), pu2 = *(const LAS f32x4*)(xs + 16);
                f32x4 g1p = pg1, g2p = (fr == 1) ? pg1 : pg2, u1p = pu1, u2p = (fr == 1) ? pu1 : pu2;
#pragma unroll
                for (int m = 0; m < 4; ++m) {
                    const int r = 128 * ai + 64 * wr + 16 * m + fr; const int R = UP_STEP * u.pm - 2 + r;
                    const f32x4 gc = acc[ai][bj][m][0], uc = acc[ai][bj][m][1];
                    f32x4 g1r, g2r, u1r, u2r;
#pragma unroll
                    for (int j = 0; j < 4; ++j) { g1r[j] = dpp_ror<1>(gc[j]); g2r[j] = dpp_ror<2>(gc[j]); u1r[j] = dpp_ror<1>(uc[j]); u2r[j] = dpp_ror<2>(uc[j]); }
                    f32x4 g1 = (fr >= 1) ? g1r : g1p, g2 = (fr >= 2) ? g2r : g2p, u1 = (fr >= 1) ? u1r : u1p, u2 = (fr >= 2) ? u2r : u2p;
                    g1p = g1r; g2p = g2r; u1p = u1r; u2p = u2r;
                    const bool emit = (r >= 2) && (R < MB);
                    if (emit) {
                        float* frow = nullptr;
                        if (R < MP) { const int t = R & (TP - 1);
                            if (t == 0) { g1 = (f32x4){0.f, 0.f, 0.f, 0.f}; u1 = g1; }
                            if (t <= 1) { g2 = (f32x4){0.f, 0.f, 0.f, 0.f}; u2 = g2; }
                            if (t >= TP - 2) frow = out + O_PCONV + ((size_t)(R >> 12) * 2 + (t - (TP - 2))) * FF2;
                        } else { const int s = R - MP, b = s >> 3, tt = s & 7; const float* sp = sconv + (size_t)b * 2 * FF2;
                            if (tt == 0) { const float4 a = *(const float4*)(sp + FF2 + gcol), c = *(const float4*)(sp + FF2 + ucol); g1 = (f32x4){a.x, a.y, a.z, a.w}; u1 = (f32x4){c.x, c.y, c.z, c.w}; }
                            if (tt <= 1) { const float4 a = *(const float4*)(sp + (tt == 0 ? 0 : FF2) + gcol), c = *(const float4*)(sp + (tt == 0 ? 0 : FF2) + ucol); g2 = (f32x4){a.x, a.y, a.z, a.w}; u2 = (f32x4){c.x, c.y, c.z, c.w}; }
                            if (tt >= 6) frow = out + O_SCONV + ((size_t)b * 2 + (tt - 6)) * FF2;
                        }
                        float o[4];
#pragma unroll
                        for (int j = 0; j < 4; ++j) { const float cgv = w0g[j] * g2[j] + w1g[j] * g1[j] + w2g[j] * gc[j] + bgg[j], cuv = w0u[j] * u2[j] + w1u[j] * u1[j] + w2u[j] * uc[j] + buu[j];
                            o[j] = cgv * sigmoidf_(cgv) * cuv; }
                        uint2 w; w.x = pk2(o[0], o[1]); w.y = pk2(o[2], o[3]);
                        *(uint2*)(ACT + (size_t)R * FF + gcol) = w;
                        if (frow) { *(float4*)(frow + gcol) = make_float4(gc[0], gc[1], gc[2], gc[3]); *(float4*)(frow + ucol) = make_float4(uc[0], uc[1], uc[2], uc[3]); }
                    }
                }
            }
        }
    }
};

__device__ __forceinline__ int rowA_of(int rowB) { return rowB < MP ? rowB : MP + ((rowB - MP) >> 3) * 9 + 1 + ((rowB - MP) & 7); }
__device__ __forceinline__ void phase_alora(const Params& p, int tid, int G, int bid) {
    const bf16_t* PR = (const bf16_t*)(p.ws + WS_PROJRW); bf16_t* AL = (bf16_t*)(p.ws + WS_ALORA); const float* mu = p.in[I_MU];
    const int gt = bid * NTHREADS + tid, NT = G * NTHREADS;
    for (int i = gt; i < MB * 64; i += NT) {
        const int rowB = i >> 6, c = (i & 63) * 4, rowA = rowA_of(rowB);
        const uint2 cur = *(const uint2*)(PR + (size_t)rowA * RCOLS + 1536 + c);
        uint2 prv = make_uint2(0u, 0u);
        if (!(rowB < MP && (rowB & (TP - 1)) == 0)) prv = *(const uint2*)(PR + (size_t)(rowA - 1) * RCOLS + 1536 + c);
        const float4 m4 = *(const float4*)(mu + 1536 + c);
        float x[4] = {bflo(cur.x), bfhi(cur.x), bflo(cur.y), bfhi(cur.y)}; const float pv[4] = {bflo(prv.x), bfhi(prv.x), bflo(prv.y), bfhi(prv.y)}; const float mm[4] = {m4.x, m4.y, m4.z, m4.w};
#pragma unroll
        for (int j = 0; j < 4; ++j) { float v = x[j] + (pv[j] - x[j]) * mm[j];
            if (c < 64) v = 1.f - 2.f * __builtin_amdgcn_rcpf(1.f + __expf(2.f * v)); else if (c >= 128) v = sigmoidf_(v);
            x[j] = v; }
        uint2 o; o.x = pk2(x[0], x[1]); o.y = pk2(x[2], x[3]);
        *(uint2*)(AL + (size_t)rowB * KLORA + c) = o;
    }
}


__device__ __forceinline__ void phase_vtrans(const Params& p, LAS unsigned char* lds, int tid, int G, int bid) {
    const bf16_t* VR = (const bf16_t*)(p.ws + WS_VROW);
    constexpr int PITCH = 132;
    for (int item = bid; item < BP * 8 * 8; item += G) {
        const int b = item >> 6, h = (item >> 3) & 7, t0 = (item & 7) * 512;
        __syncthreads();
#pragma unroll
        for (int i = 0; i < 8; ++i) { const int piece = tid + 512 * i, row = piece >> 3, c8 = piece & 7;
            const uint4 v = *(const uint4*)(VR + (size_t)(b * TP + t0 + row) * 512 + h * 64 + c8 * 8);
            LAS u32* dst = (LAS u32*)(lds + row * PITCH + c8 * 16); dst[0] = v.x; dst[1] = v.y; dst[2] = v.z; dst[3] = v.w; }
        __syncthreads();
#pragma unroll 1
        for (int lay = 0; lay < 3; ++lay) {
            const int dd = lay == 0 ? 1 : (lay == 1 ? 4 : 16); const int Tdd = TP / dd;
            bf16_t* VT = (bf16_t*)(p.ws + (lay == 0 ? WS_VT1 : (lay == 1 ? WS_VT4 : WS_VT16))) + (size_t)(b * 8 + h) * 64 * TP;
            const int chunk0 = (t0 / dd) >> 5;
#pragma unroll
            for (int i = 0; i < 4; ++i) {
                const int sidx = tid + 512 * i, g = sidx & 3, dp = (sidx >> 2) & 31, rc = sidx >> 7;
                int r, cl; if (lay == 0) { r = 0; cl = rc; } else if (lay == 1) { r = rc & 3; cl = rc >> 2; } else { r = rc; cl = 0; }
                u32 wlo[4], whi[4];
#pragma unroll
                for (int hf = 0; hf < 2; ++hf)
#pragma unroll
                    for (int jp = 0; jp < 2; ++jp) {
                        const int u5a = 16 * hf + 4 * g + 2 * jp; const int ta = (32 * cl + u5a) * dd + r, tb = ta + dd;
                        const u32 wa = *(const LAS u32*)(lds + ta * PITCH + dp * 4), wb = *(const LAS u32*)(lds + tb * PITCH + dp * 4);
                        wlo[hf * 2 + jp] = (wa & 0xffffu) | (wb << 16); whi[hf * 2 + jp] = (wa >> 16) | (wb & 0xffff0000u);
                    }
                bf16_t* dst = VT + (size_t)r * Tdd * 64 + (size_t)(chunk0 + cl) * 2048 + (2 * dp) * 32 + 8 * g;
                *(uint4*)dst = make_uint4(wlo[0], wlo[1], wlo[2], wlo[3]); *(uint4*)(dst + 32) = make_uint4(whi[0], whi[1], whi[2], whi[3]);
            }
        }
    }
    __syncthreads();
}

constexpr int CH = 32;
constexpr int SST = 452;
constexpr int SI_W = 0, SI_A = 64, SI_B = 128, SI_K = 192, SI_WR = 256, SI_V = 320, SI_G = 384, SI_SC = 448;
struct PrepRegs { uint2 cr, ck, cv, pr, pk, pv, dw, da, dg; };
__device__ __forceinline__ void scan_item(const Params& p, LAS unsigned char* lds, int tid, bool sample, int b, int h, int half) {
    const bf16_t* PR = (const bf16_t*)(p.ws + WS_PROJRW); const bf16_t* DAG = (const bf16_t*)((const unsigned char*)p.out + SC_B);
    float* YG = (float*)(p.ws + WS_Y); float* RKG = (float*)(p.ws + WS_HALO);
    LAS float* buf0 = (LAS float*)lds; LAS float* buf1 = buf0 + CH * SST; LAS float* ybuf = buf1 + CH * SST;
    const int T = sample ? TS : TP;
    const int rowB0 = sample ? MP + b * TS : b * TP;
    const int rowA0 = sample ? MP + b * 9 + 1 : b * TP;
    const int nch = (T + CH - 1) / CH;
    const int ptl = tid >> 4, pj = (tid & 15) * 4, pc = h * 64 + pj;
    const int lane = tid & 63, wv = tid >> 6, rg = wv * 4 + (lane >> 4), cgi = lane & 15;
    const int row = 32 * half + rg;
    float st[4];
    if (sample) {
        const float4 a = *(const float4*)(p.in[I_SWKV] + ((size_t)(b * 8 + h) * 64 + row) * 64 + 4 * cgi);
        st[0] = a.x; st[1] = a.y; st[2] = a.z; st[3] = a.w;
    } else {
#pragma unroll
        for (int j = 0; j < 4; ++j) st[j] = 0.f;
    }
    const float4 mur = *(const float4*)(p.in[I_MU] + pc), muk = *(const float4*)(p.in[I_MU] + 512 + pc), muv = *(const float4*)(p.in[I_MU] + 1024 + pc);
    const float4 kk4 = *(const float4*)(p.in[I_KK] + pc), ka4 = *(const float4*)(p.in[I_KA] + pc), rk4 = *(const float4*)(p.in[I_RK] + pc);
    __builtin_amdgcn_s_waitcnt(0x0F70);
    PrepRegs R;
#define SCAN_LOAD(chunk) do { const int t_ = (chunk) * CH + ptl; if (t_ < T) { const size_t ra = (size_t)(rowA0 + t_) * RCOLS + pc; const size_t rb = (size_t)(rowB0 + t_) * NLORA + pc; \
        R.cr = *(const uint2*)(PR + ra); R.ck = *(const uint2*)(PR + ra + 512); R.cv = *(const uint2*)(PR + ra + 1024); \
        if (!sample && t_ == 0) { R.pr = make_uint2(0u, 0u); R.pk = R.pr; R.pv = R.pr; } \
        else { R.pr = *(const uint2*)(PR + ra - RCOLS); R.pk = *(const uint2*)(PR + ra - RCOLS + 512); R.pv = *(const uint2*)(PR + ra - RCOLS + 1024); } \
        R.dw = *(const uint2*)(DAG + rb); R.da = *(const uint2*)(DAG + rb + 512); R.dg = *(const uint2*)(DAG + rb + 1024); } } while (0)
#define SCAN_PREP(chunk, dstbuf) do { const int t_ = (chunk) * CH + ptl; if (t_ < T) { \
        const float mr[4] = {mur.x, mur.y, mur.z, mur.w}, mk[4] = {muk.x, muk.y, muk.z, muk.w}, mv[4] = {muv.x, muv.y, muv.z, muv.w}; \
        const float kkc[4] = {kk4.x, kk4.y, kk4.z, kk4.w}, kac[4] = {ka4.x, ka4.y, ka4.z, ka4.w}, rkc[4] = {rk4.x, rk4.y, rk4.z, rk4.w}; \
        const float crr[4] = {bflo(R.cr.x), bfhi(R.cr.x), bflo(R.cr.y), bfhi(R.cr.y)}, ckk[4] = {bflo(R.ck.x), bfhi(R.ck.x), bflo(R.ck.y), bfhi(R.ck.y)}, cvv[4] = {bflo(R.cv.x), bfhi(R.cv.x), bflo(R.cv.y), bfhi(R.cv.y)}; \
        const float prr[4] = {bflo(R.pr.x), bfhi(R.pr.x), bflo(R.pr.y), bfhi(R.pr.y)}, pkk[4] = {bflo(R.pk.x), bfhi(R.pk.x), bflo(R.pk.y), bfhi(R.pk.y)}, pvv[4] = {bflo(R.pv.x), bfhi(R.pv.x), bflo(R.pv.y), bfhi(R.pv.y)}; \
        const float lw[4] = {bflo(R.dw.x), bfhi(R.dw.x), bflo(R.dw.y), bfhi(R.dw.y)}, aa[4] = {bflo(R.da.x), bfhi(R.da.x), bflo(R.da.y), bfhi(R.da.y)}, gg[4] = {bflo(R.dg.x), bfhi(R.dg.x), bflo(R.dg.y), bfhi(R.dg.y)}; \
        float r_[4], k_[4], v_[4], w_[4], kn[4], k2[4]; float nrm = 0.f; \
        _Pragma("unroll") for (int j = 0; j < 4; ++j) { r_[j] = crr[j] + (prr[j] - crr[j]) * mr[j]; k_[j] = ckk[j] + (pkk[j] - ckk[j]) * mk[j]; v_[j] = cvv[j] + (pvv[j] - cvv[j]) * mv[j]; \
            w_[j] = __expf(lw[j]); kn[j] = k_[j] * kkc[j]; nrm += kn[j] * kn[j]; k2[j] = k_[j] * (1.f + (aa[j] - 1.f) * kac[j]); } \
        nrm = row16_sum(nrm); const float inv = __builtin_amdgcn_rsqf(fmaxf(nrm, 1e-24f)); \
        float br = 0.f, kr = 0.f, rk = 0.f; float an[4], bn[4], wrr[4]; \
        _Pragma("unroll") for (int j = 0; j < 4; ++j) { const float kkn = kn[j] * inv; an[j] = -kkn; bn[j] = kkn * aa[j]; wrr[j] = w_[j] * r_[j]; br += bn[j] * r_[j]; kr += k2[j] * r_[j]; rk += r_[j] * k2[j] * rkc[j]; } \
        br = row16_sum(br); kr = row16_sum(kr); rk = row16_sum(rk); \
        LAS float* rec = (dstbuf) + ptl * SST; \
        *(LAS f32x4*)(rec + SI_W + pj) = (f32x4){w_[0], w_[1], w_[2], w_[3]}; *(LAS f32x4*)(rec + SI_A + pj) = (f32x4){an[0], an[1], an[2], an[3]}; \
        *(LAS f32x4*)(rec + SI_B + pj) = (f32x4){bn[0], bn[1], bn[2], bn[3]}; *(LAS f32x4*)(rec + SI_K + pj) = (f32x4){k2[0], k2[1], k2[2], k2[3]}; \
        *(LAS f32x4*)(rec + SI_WR + pj) = (f32x4){wrr[0], wrr[1], wrr[2], wrr[3]}; *(LAS f32x4*)(rec + SI_V + pj) = (f32x4){v_[0], v_[1], v_[2], v_[3]}; \
        *(LAS f32x4*)(rec + SI_G + pj) = (f32x4){gg[0], gg[1], gg[2], gg[3]}; \
        if ((tid & 15) == 0) { *(LAS f32x4*)(rec + SI_SC) = (f32x4){br, kr, rk, 0.f}; if (half == 0) RKG[(size_t)(rowB0 + t_) * 8 + h] = rk; } } } while (0)

    SCAN_LOAD(0);
    SCAN_PREP(0, buf0);
    __syncthreads();
    for (int c = 0; c < nch; ++c) {
        LAS float* cur = (c & 1) ? buf1 : buf0; LAS float* nxt = (c & 1) ? buf0 : buf1;
        if (c + 1 < nch) SCAN_LOAD(c + 1);
        const int ns = (T - c * CH) < CH ? (T - c * CH) : CH;
        LAS float* yb = ybuf + (c & 1) * (CH * 32);
        {
            const LAS float* rec = cur;
            f32x4 wA = *(const LAS f32x4*)(rec + SI_W + 4 * cgi), aA = *(const LAS f32x4*)(rec + SI_A + 4 * cgi), bA = *(const LAS f32x4*)(rec + SI_B + 4 * cgi);
            f32x4 kA = *(const LAS f32x4*)(rec + SI_K + 4 * cgi), rA = *(const LAS f32x4*)(rec + SI_WR + 4 * cgi);
            float vA = rec[SI_V + row]; pg8::f32x2 cA = *(const LAS pg8::f32x2*)(rec + SI_SC);
            f32x4 wB, aB, bB, kB, rB; float vB; pg8::f32x2 cB;
#define SCAN_FETCH(W, A, B, K, R, V, C) do { rec += SST; W = *(const LAS f32x4*)(rec + SI_W + 4 * cgi); A = *(const LAS f32x4*)(rec + SI_A + 4 * cgi); B = *(const LAS f32x4*)(rec + SI_B + 4 * cgi); \
            K = *(const LAS f32x4*)(rec + SI_K + 4 * cgi); R = *(const LAS f32x4*)(rec + SI_WR + 4 * cgi); V = rec[SI_V + row]; C = *(const LAS pg8::f32x2*)(rec + SI_SC); } while (0)
#define SCAN_STEP(W, A, B, K, R, V, C, qq) do { \
            float da = mul_(st[0], A[0]), da2 = mul_(st[2], A[2]); float dw = mul_(st[0], R[0]), dw2 = mul_(st[2], R[2]); \
            da = fma_(st[1], A[1], da); da2 = fma_(st[3], A[3], da2); dw = fma_(st[1], R[1], dw); dw2 = fma_(st[3], R[3], dw2); da += da2; dw += dw2; \
            float tt_[4]; row16_sum2_mul4(da, dw, tt_, V, K[0], K[1], K[2], K[3]); \
            const float y = fma_(V, C[1], fma_(da, C[0], dw)); \
            _Pragma("unroll") for (int j = 0; j < 4; ++j) st[j] = fma_(st[j], W[j], fma_(da, B[j], tt_[j])); \
            yk = ((qq) == cgi) ? y : yk; } while (0)
            for (int tb = 0; tb < ns; tb += 16) {
                const int nq = (ns - tb) < 16 ? (ns - tb) : 16;
                float yk = 0.f;
                for (int q = 0; q < nq; q += 2) {
                    SCAN_FETCH(wB, aB, bB, kB, rB, vB, cB);
                    SCAN_STEP(wA, aA, bA, kA, rA, vA, cA, q);
                    SCAN_FETCH(wA, aA, bA, kA, rA, vA, cA);
                    SCAN_STEP(wB, aB, bB, kB, rB, vB, cB, q + 1);
                }
                yb[(tb + cgi) * 32 + rg] = yk;
            }
#undef SCAN_FETCH
#undef SCAN_STEP
        }
        if (c + 1 < nch) SCAN_PREP(c + 1, nxt);
        __syncthreads();
        if (ptl < ns) {
            const pg8::f32x2 y2 = *(const LAS pg8::f32x2*)(yb + ptl * 32 + 2 * (tid & 15));
            *(float2*)(YG + (size_t)(rowB0 + c * CH + ptl) * 512 + h * 64 + 32 * half + 2 * (tid & 15)) = make_float2(y2[0], y2[1]);
        }
    }
#undef SCAN_LOAD
#undef SCAN_PREP
    float* So = p.out + (sample ? O_SWKV : O_PWKV) + ((size_t)(b * 8 + h) * 64 + row) * 64 + 4 * cgi;
    *(float4*)So = make_float4(st[0], st[1], st[2], st[3]);
}

__device__ __forceinline__ void phase_wkvfin(const Params& p, int tid, int G, int bid) {
    const bf16_t* PR = (const bf16_t*)(p.ws + WS_PROJRW); const bf16_t* DAG = (const bf16_t*)((const unsigned char*)p.out + SC_B);
    const float* YG = (const float*)(p.ws + WS_Y); const float* RKG = (const float*)(p.ws + WS_HALO); bf16_t* MIX = (bf16_t*)((unsigned char*)p.out + SC_C);
    const int gt = bid * NTHREADS + tid, NT = G * NTHREADS;
    for (int i = gt; i < MB * 128; i += NT) {
        const int jq = i & 15, h = (i >> 4) & 7, rowB = i >> 7, pc = h * 64 + jq * 4, rowA = rowA_of(rowB);
        const size_t ra = (size_t)rowA * RCOLS + pc;
        const uint2 cv = *(const uint2*)(PR + ra + 1024);
        uint2 pv = make_uint2(0u, 0u);
        if (!(rowB < MP && (rowB & (TP - 1)) == 0)) pv = *(const uint2*)(PR + ra - RCOLS + 1024);
        const uint2 dg = *(const uint2*)(DAG + (size_t)rowB * NLORA + 1024 + pc);
        const float4 y4 = *(const float4*)(YG + (size_t)rowB * 512 + pc);
        const float rk = RKG[(size_t)rowB * 8 + h];
        const float4 muv = *(const float4*)(p.in[I_MU] + 1024 + pc), lw4 = *(const float4*)(p.in[I_LNW] + pc), lb4 = *(const float4*)(p.in[I_LNB] + pc);
        const float mv[4] = {muv.x, muv.y, muv.z, muv.w}, lw[4] = {lw4.x, lw4.y, lw4.z, lw4.w}, lb[4] = {lb4.x, lb4.y, lb4.z, lb4.w};
        const float cvv[4] = {bflo(cv.x), bfhi(cv.x), bflo(cv.y), bfhi(cv.y)}, pvv[4] = {bflo(pv.x), bfhi(pv.x), bflo(pv.y), bfhi(pv.y)};
        const float gg[4] = {bflo(dg.x), bfhi(dg.x), bflo(dg.y), bfhi(dg.y)}, yy[4] = {y4.x, y4.y, y4.z, y4.w};
        const float mean = row16_sum((yy[0] + yy[1]) + (yy[2] + yy[3])) * (1.f / 64.f);
        float d[4]; float vs = 0.f;
#pragma unroll
        for (int j = 0; j < 4; ++j) { d[j] = yy[j] - mean; vs += d[j] * d[j]; }
        const float rs = rsqrtf(row16_sum(vs) * (1.f / 64.f) + 64e-5f);
        float o[4];
#pragma unroll
        for (int j = 0; j < 4; ++j) { const float v_ = cvv[j] + (pvv[j] - cvv[j]) * mv[j]; o[j] = (d[j] * rs * lw[j] + lb[j] + rk * v_) * gg[j]; }
        uint2 w; w.x = pk2(o[0], o[1]); w.y = pk2(o[2], o[3]);
        *(uint2*)(MIX + (size_t)rowB * D + pc) = w;
    }
}

__device__ __forceinline__ void attn_task(const Params& p, int task, int lane) {
    const bf16_t* Q = (const bf16_t*)(p.ws + WS_Q); const bf16_t* K = (const bf16_t*)(p.ws + WS_K);
    bf16_t* MIX = (bf16_t*)((unsigned char*)p.out + SC_C);
    const int b = task >> 11, h = (task >> 8) & 7, r16 = (task >> 4) & 15, ig = task & 15;
    const int li = lane & 15, g = lane >> 4;
    const int tq = r16 + 16 * (16 * ig + li);
    const bf16_t* qp = Q + (size_t)(b * TP + tq) * 512 + h * 64 + 8 * g;
    const bf16x8 qf0 = *(const bf16x8*)qp, qf1 = *(const bf16x8*)(qp + 32);
    float m_run = -1e30f, l_run = 0.f;
    f32x4 o[4];
#pragma unroll
    for (int i = 0; i < 4; ++i) o[i] = (f32x4){0.f, 0.f, 0.f, 0.f};
#pragma unroll 1
    for (int br = 0; br < 3; ++br) {
        int dd, r, uq0, Tdd; const bf16_t* VT;
        if (br == 0) { dd = 16; r = r16; uq0 = 16 * ig; Tdd = TP / 16; VT = (const bf16_t*)(p.ws + WS_VT16); }
        else if (br == 1) { dd = 4; r = r16 & 3; uq0 = (r16 >> 2) + 64 * ig; Tdd = TP / 4; VT = (const bf16_t*)(p.ws + WS_VT4); }
        else { dd = 1; r = 0; uq0 = r16 + 256 * ig; Tdd = TP; VT = (const bf16_t*)(p.ws + WS_VT1); }
        const int s = 16 / dd, uq = uq0 + s * li;
        int ulo = uq0 - 128; if (ulo < 0) ulo = 0; ulo &= ~31;
        const int uhi = uq0 + 15 * s;
        const bf16_t* Kb = K + ((size_t)b * TP + r) * 512 + h * 64 + 8 * g;
        const bf16_t* Vb = VT + (size_t)(b * 8 + h) * 64 * TP + (size_t)r * Tdd * 64 + li * 32 + 8 * g;
        bf16x8 kx0, kx1, ky0, ky1, vf[4];
        { const bf16_t* kx = Kb + (size_t)(ulo + li) * dd * 512; const bf16_t* ky = kx + (size_t)16 * dd * 512;
          kx0 = *(const bf16x8*)kx; kx1 = *(const bf16x8*)(kx + 32); ky0 = *(const bf16x8*)ky; ky1 = *(const bf16x8*)(ky + 32);
#pragma unroll
          for (int dt = 0; dt < 4; ++dt) vf[dt] = *(const bf16x8*)(Vb + (size_t)(ulo >> 5) * 2048 + dt * 512); }
#pragma unroll 1
        for (int kt = ulo; kt <= uhi; kt += 32) {
            const int ktn = (kt + 32 <= uhi) ? kt + 32 : kt;
            const bf16_t* nkx = Kb + (size_t)(ktn + li) * dd * 512; const bf16_t* nky = nkx + (size_t)16 * dd * 512;
            const bf16x8 nkx0 = *(const bf16x8*)nkx, nkx1 = *(const bf16x8*)(nkx + 32), nky0 = *(const bf16x8*)nky, nky1 = *(const bf16x8*)(nky + 32);
            bf16x8 nvf[4];
#pragma unroll
            for (int dt = 0; dt < 4; ++dt) nvf[dt] = *(const bf16x8*)(Vb + (size_t)(ktn >> 5) * 2048 + dt * 512);
            f32x4 sx = (f32x4){0.f, 0.f, 0.f, 0.f}, sy = (f32x4){0.f, 0.f, 0.f, 0.f};
            sx = __builtin_amdgcn_mfma_f32_16x16x32_bf16(kx0, qf0, sx, 0, 0, 0); sx = __builtin_amdgcn_mfma_f32_16x16x32_bf16(kx1, qf1, sx, 0, 0, 0);
            sy = __builtin_amdgcn_mfma_f32_16x16x32_bf16(ky0, qf0, sy, 0, 0, 0); sy = __builtin_amdgcn_mfma_f32_16x16x32_bf16(ky1, qf1, sy, 0, 0, 0);
            float sv[8]; bool ok[8]; float tmax = -1e30f;
#pragma unroll
            for (int j = 0; j < 4; ++j) { const int dx = uq - (kt + 4 * g + j), dy = dx - 16;
                ok[j] = (unsigned)dx <= 128u; ok[4 + j] = (unsigned)dy <= 128u; sv[j] = ok[j] ? sx[j] : -1e30f; sv[4 + j] = ok[4 + j] ? sy[j] : -1e30f;
                tmax = fmaxf(tmax, fmaxf(sv[j], sv[4 + j])); }
            tmax = fmaxf(tmax, __shfl_xor(tmax, 16)); tmax = fmaxf(tmax, __shfl_xor(tmax, 32));
            const float m_new = fmaxf(m_run, tmax), alpha = __expf(m_run - m_new);
            float pe[8]; float ps = 0.f;
#pragma unroll
            for (int j = 0; j < 8; ++j) { pe[j] = ok[j] ? __expf(sv[j] - m_new) : 0.f; ps += pe[j]; }
            l_run = l_run * alpha + ps; m_run = m_new;
            u32x4 pw; pw[0] = pk2(pe[0], pe[1]); pw[1] = pk2(pe[2], pe[3]); pw[2] = pk2(pe[4], pe[5]); pw[3] = pk2(pe[6], pe[7]);
            const bf16x8 pf = __builtin_bit_cast(bf16x8, pw);
#pragma unroll
            for (int dt = 0; dt < 4; ++dt) { o[dt] *= alpha; o[dt] = __builtin_amdgcn_mfma_f32_16x16x32_bf16(vf[dt], pf, o[dt], 0, 0, 0); }
            kx0 = nkx0; kx1 = nkx1; ky0 = nky0; ky1 = nky1;
#pragma unroll
            for (int dt = 0; dt < 4; ++dt) vf[dt] = nvf[dt];
        }
    }
    float lt = l_run; lt += __shfl_xor(lt, 16); lt += __shfl_xor(lt, 32);
    const float il = 1.f / lt;
    bf16_t* op = MIX + (size_t)(b * TP + tq) * D + 512 + h * 64 + 4 * g;
#pragma unroll
    for (int dt = 0; dt < 4; ++dt) { uint2 w; w.x = pk2(o[dt][0] * il, o[dt][1] * il); w.y = pk2(o[dt][2] * il, o[dt][3] * il); *(uint2*)(op + 16 * dt) = w; }
}
__device__ __forceinline__ void attn_sample_task(const Params& p, int task, int lane, LAS float* wl) {
    const bf16_t* Q = (const bf16_t*)(p.ws + WS_Q); const float* snewk = (const float*)(p.ws + WS_SNEWK); const float* snewv = (const float*)(p.ws + WS_SNEWV);
    const float* CK = p.in[I_CK]; const float* CV = p.in[I_CV];
    bf16_t* MIX = (bf16_t*)((unsigned char*)p.out + SC_C);
    const int b = task >> 6, h = (task >> 3) & 7, tt = task & 7;
    const int rowB = MP + b * TS + tt;
    asm volatile("s_waitcnt lgkmcnt(0)" ::: "memory");
    wl[lane] = bflo((u32)Q[(size_t)rowB * 512 + h * 64 + lane]);
    asm volatile("s_waitcnt lgkmcnt(0)" ::: "memory");
    float mx = -1e30f;
#pragma unroll 1
    for (int c = 0; c < 9; ++c) {
        const int br = c / 3, it = c - br * 3; const int dd = br == 0 ? 1 : (br == 1 ? 4 : 16); const int j = lane + 64 * it;
        const int jc = j <= 128 ? j : 128;
        const int idx = 2048 + tt - jc * dd;
        const float* kr = idx < 2048 ? CK + ((size_t)(b * 2048 + idx) * 8 + h) * 64 : snewk + (size_t)(b * TS + idx - 2048) * 512 + h * 64;
        float s = 0.f;
#pragma unroll
        for (int d4 = 0; d4 < 16; ++d4) { const float4 kv = *(const float4*)(kr + 4 * d4); const f32x4 qv = *(const LAS f32x4*)(wl + 4 * d4);
            s += kv.x * qv[0] + kv.y * qv[1] + kv.z * qv[2] + kv.w * qv[3]; }
        if (j > 128) s = -1e30f;
        wl[64 + c * 64 + lane] = s; mx = fmaxf(mx, s);
    }
#pragma unroll
    for (int o = 1; o < 64; o <<= 1) mx = fmaxf(mx, __shfl_xor(mx, o));
    asm volatile("s_waitcnt lgkmcnt(0)" ::: "memory");
    float ls = 0.f;
#pragma unroll 1
    for (int c = 0; c < 9; ++c) { const float s = wl[64 + c * 64 + lane]; const float e = s > -1e29f ? __expf(s - mx) : 0.f; wl[64 + c * 64 + lane] = e; ls += e; }
    ls = wave_sum(ls);
    asm volatile("s_waitcnt lgkmcnt(0)" ::: "memory");
    float acc = 0.f;
#pragma unroll 1
    for (int c = 0; c < 9; ++c) {
        const int br = c / 3, it = c - br * 3; const int dd = br == 0 ? 1 : (br == 1 ? 4 : 16); const int nj = it < 2 ? 64 : 1;
#pragma unroll 8
        for (int l2 = 0; l2 < nj; ++l2) {
            const int j = l2 + 64 * it; const int idx = 2048 + tt - j * dd;
            const float* vr = idx < 2048 ? CV + ((size_t)(b * 2048 + idx) * 8 + h) * 64 : snewv + (size_t)(b * TS + idx - 2048) * 512 + h * 64;
            acc += wl[64 + c * 64 + l2] * vr[lane];
        }
    }
    const float res = acc / ls;
    const float other = __shfl_xor(res, 1);
    if ((lane & 1) == 0) *(u32*)(MIX + (size_t)rowB * D + 512 + h * 64 + lane) = pk2(res, other);
}

__device__ __forceinline__ void phase_norm1(const Params& p, int tid, int G, int bid) {
    const int wave = tid >> 6, lane = tid & 63, gw = bid * 8 + wave, NGW = G * 8;
    const bf16_t* mix = (const bf16_t*)((const unsigned char*)p.out + SC_B); bf16_t* H2 = (bf16_t*)((unsigned char*)p.out + SC_C);
    for (int row = gw; row < MB; row += NGW) {
        const float* xrow = row < MP ? p.in[I_XP] + (size_t)row * D : p.in[I_XS] + (size_t)(row - MP) * D;
        const uint2* mr = (const uint2*)(mix + (size_t)row * D) + lane; const float4* xr = (const float4*)xrow + lane;
        float4 v[4], x[4]; float s = 0.f;
#pragma unroll
        for (int j = 0; j < 4; ++j) { const uint2 mm = mr[64 * j]; v[j] = make_float4(bflo(mm.x), bfhi(mm.x), bflo(mm.y), bfhi(mm.y)); x[j] = xr[64 * j]; s += (v[j].x * v[j].x + v[j].y * v[j].y) + (v[j].z * v[j].z + v[j].w * v[j].w); }
        const float rs = rsqrtf(wave_sum(s) * (1.f / D) + 1e-6f);
        float s2 = 0.f;
#pragma unroll
        for (int j = 0; j < 4; ++j) { const float4 gg = *((const float4*)p.in[I_NMPOST] + lane + 64 * j);
            x[j].x += v[j].x * rs * gg.x; x[j].y += v[j].y * rs * gg.y; x[j].z += v[j].z * rs * gg.z; x[j].w += v[j].w * rs * gg.w;
            s2 += (x[j].x * x[j].x + x[j].y * x[j].y) + (x[j].z * x[j].z + x[j].w * x[j].w);
            *((float4*)(p.out + (size_t)row * D) + lane + 64 * j) = x[j]; }
        const float rs2 = rsqrtf(wave_sum(s2) * (1.f / D) + 1e-6f);
#pragma unroll
        for (int j = 0; j < 4; ++j) { const float4 gg = *((const float4*)p.in[I_NFPRE] + lane + 64 * j);
            uint2 o; o.x = pk2(x[j].x * rs2 * gg.x, x[j].y * rs2 * gg.y); o.y = pk2(x[j].z * rs2 * gg.z, x[j].w * rs2 * gg.w);
            *((uint2*)(H2 + (size_t)(row + 2) * D) + lane + 64 * j) = o; }
    }
    for (int row = gw; row < 2 + (H2P_ROWS - MB - 2); row += NGW) {
        const int rr = row < 2 ? row : MB + row;
#pragma unroll
        for (int j = 0; j < 4; ++j) *((uint2*)(H2 + (size_t)rr * D) + lane + 64 * j) = make_uint2(0u, 0u);
    }
}
__device__ __forceinline__ void phase_act(const Params& p, int tid, int G, int bid) {
    const int wave = tid >> 6, lane = tid & 63, gw = bid * 8 + wave, NGW = G * 8;
    bf16_t* U = (bf16_t*)(p.ws + WS_U); const bf16_t* halo = (const bf16_t*)(p.ws + WS_HALO);
    const float* cw = p.in[I_CONVW]; const float* cb = p.in[I_CONVB];
    constexpr int NPI = (MP / 32) * 11, NSI = BS * 11;
    for (int it = gw; it < NPI + NSI; it += NGW) {
        const bool sample = it >= NPI; const int q = sample ? it - NPI : it; const int chunk = q / 11, cgp = q - chunk * 11;
        const int col = cgp * 256 + 4 * lane;
        const float4 wg0 = *(const float4*)(cw + col), wg1 = *(const float4*)(cw + FF2 + col), wg2 = *(const float4*)(cw + 2 * FF2 + col), bg = *(const float4*)(cb + col);
        const float4 wu0 = *(const float4*)(cw + FF + col), wu1 = *(const float4*)(cw + FF2 + FF + col), wu2 = *(const float4*)(cw + 2 * FF2 + FF + col), bu = *(const float4*)(cb + FF + col);
        float g2[4], g1[4], u2[4], u1[4];
        int row0, nrows;
        if (!sample) {
            row0 = chunk * 32; nrows = 32;
            if ((row0 & (TP - 1)) == 0) {
#pragma unroll
                for (int j = 0; j < 4; ++j) { g2[j] = 0.f; g1[j] = 0.f; u2[j] = 0.f; u1[j] = 0.f; }
            } else {
                const bf16_t* hp = halo + (size_t)chunk * 2 * FF2;
                const uint2 a = *(const uint2*)(hp + col), c2 = *(const uint2*)(hp + FF2 + col), e = *(const uint2*)(hp + FF + col), f = *(const uint2*)(hp + FF2 + FF + col);
                g2[0] = bflo(a.x); g2[1] = bfhi(a.x); g2[2] = bflo(a.y); g2[3] = bfhi(a.y); g1[0] = bflo(c2.x); g1[1] = bfhi(c2.x); g1[2] = bflo(c2.y); g1[3] = bfhi(c2.y);
                u2[0] = bflo(e.x); u2[1] = bfhi(e.x); u2[2] = bflo(e.y); u2[3] = bfhi(e.y); u1[0] = bflo(f.x); u1[1] = bfhi(f.x); u1[2] = bflo(f.y); u1[3] = bfhi(f.y);
            }
        } else {
            row0 = MP + chunk * TS; nrows = TS;
            const float* sp = p.in[I_SCONV] + (size_t)chunk * 2 * FF2;
            const float4 a = *(const float4*)(sp + col), c2 = *(const float4*)(sp + FF2 + col), e = *(const float4*)(sp + FF + col), f = *(const float4*)(sp + FF2 + FF + col);
            g2[0] = a.x; g2[1] = a.y; g2[2] = a.z; g2[3] = a.w; g1[0] = c2.x; g1[1] = c2.y; g1[2] = c2.z; g1[3] = c2.w;
            u2[0] = e.x; u2[1] = e.y; u2[2] = e.z; u2[3] = e.w; u1[0] = f.x; u1[1] = f.y; u1[2] = f.z; u1[3] = f.w;
        }
        const float w0g[4] = {wg0.x, wg0.y, wg0.z, wg0.w}, w1g[4] = {wg1.x, wg1.y, wg1.z, wg1.w}, w2g[4] = {wg2.x, wg2.y, wg2.z, wg2.w}, bgg[4] = {bg.x, bg.y, bg.z, bg.w};
        const float w0u[4] = {wu0.x, wu0.y, wu0.z, wu0.w}, w1u[4] = {wu1.x, wu1.y, wu1.z, wu1.w}, w2u[4] = {wu2.x, wu2.y, wu2.z, wu2.w}, buu[4] = {bu.x, bu.y, bu.z, bu.w};
        for (int r0 = 0; r0 < nrows; r0 += 8) {
            uint2 gv[8], uv[8];
#pragma unroll
            for (int i = 0; i < 8; ++i) { const bf16_t* rp = U + (size_t)(row0 + r0 + i) * FF2 + col; gv[i] = *(const uint2*)rp; uv[i] = *(const uint2*)(rp + FF); }
#pragma unroll
            for (int i = 0; i < 8; ++i) {
                const float gc[4] = {bflo(gv[i].x), bfhi(gv[i].x), bflo(gv[i].y), bfhi(gv[i].y)}, uc[4] = {bflo(uv[i].x), bfhi(uv[i].x), bflo(uv[i].y), bfhi(uv[i].y)};
                float o[4];
#pragma unroll
                for (int j = 0; j < 4; ++j) {
                    const float cgv = w0g[j] * g2[j] + w1g[j] * g1[j] + w2g[j] * gc[j] + bgg[j];
                    const float cuv = w0u[j] * u2[j] + w1u[j] * u1[j] + w2u[j] * uc[j] + buu[j];
                    o[j] = cgv * sigmoidf_(cgv) * cuv;
                    g2[j] = g1[j]; g1[j] = gc[j]; u2[j] = u1[j]; u1[j] = uc[j];
                }
                uint2 w; w.x = pk2(o[0], o[1]); w.y = pk2(o[2], o[3]);
                *(uint2*)(U + (size_t)(row0 + r0 + i) * FF2 + col) = w;
            }
        }
    }
}
__device__ __forceinline__ void phase_final(const Params& p, int tid, int G, int bid) {
    const int wave = tid >> 6, lane = tid & 63, gw = bid * 8 + wave, NGW = G * 8;
    const float* F = (const float*)(p.ws + WS_F);
    for (int row = gw; row < MB; row += NGW) {
        const float4* fr = (const float4*)(F + (size_t)row * D) + lane; float4* yr = (float4*)(p.out + (size_t)row * D) + lane;
        float4 v[4]; float s = 0.f;
#pragma unroll
        for (int j = 0; j < 4; ++j) { v[j] = fr[64 * j]; s += (v[j].x * v[j].x + v[j].y * v[j].y) + (v[j].z * v[j].z + v[j].w * v[j].w); }
        const float rs = rsqrtf(wave_sum(s) * (1.f / D) + 1e-6f);
#pragma unroll
        for (int j = 0; j < 4; ++j) { const float4 gg = *((const float4*)p.in[I_NFPOST] + lane + 64 * j); float4 x = yr[64 * j];
            x.x += v[j].x * rs * gg.x; x.y += v[j].y * rs * gg.y; x.z += v[j].z * rs * gg.z; x.w += v[j].w * rs * gg.w; yr[64 * j] = x; }
    }
}
__device__ __forceinline__ void phase_cachecopy(const Params& p, int tid, int G, int bid) {
    if (bid < 4) return;
    const int gt = (bid - 4) * NTHREADS + tid, NT = (G - 4) * NTHREADS;
    constexpr int PER_B = 2048 * 512 / 4;
    const float4* snk = (const float4*)(p.ws + WS_SNEWK); const float4* snv = (const float4*)(p.ws + WS_SNEWV);
    for (int i = gt; i < 2 * BS * PER_B; i += NT) {
        const int which = i >= BS * PER_B; const int q = which ? i - BS * PER_B : i; const int b = q / PER_B, r = q - b * PER_B;
        const float4* src = (const float4*)p.in[which ? I_CV : I_CK] + (size_t)b * PER_B;
        float4 v;
        if (r < 2040 * 128) v = src[r + 8 * 128]; else v = (which ? snv : snk)[(size_t)b * TS * 128 + (r - 2040 * 128)];
        ((float4*)(p.out + (which ? O_SV : O_SK)))[(size_t)b * PER_B + r] = v;
    }
}

template <int PH>
__device__ __forceinline__ void run_phase(const Params& p, LAS unsigned char* lds, int tid, int G, int bid) {
    if constexpr (PH == 0) { phase0(p, lds, tid, G, bid); __syncthreads(); }
    else if constexpr (PH == 1) {
        pg8::Gemm g{(const bf16_t*)((const unsigned char*)p.out + SC_B), (const bf16_t*)(p.ws + WS_WIN), MA, DIN, D, D, 256}; pg8::StaticOrder S; S.init(MA, DIN, G, bid);
        EpiProj E{(bf16_t*)(p.ws + WS_PROJRW), (bf16_t*)(p.ws + WS_Q), (bf16_t*)(p.ws + WS_K), (bf16_t*)(p.ws + WS_VROW), (bf16_t*)(p.ws + WS_VT4), (bf16_t*)(p.ws + WS_VT16),
                  (const float*)(p.ws + WS_ROPE), p.out, (float*)(p.ws + WS_SNEWK), (float*)(p.ws + WS_SNEWV)};
        pg8::gemm_phase<EpiProj, pg8::StaticOrder, false>(lds, g, S, E, nullptr);
    } else if constexpr (PH == 2) { phase_alora(p, tid, G, bid); phase_vtrans(p, lds, tid, G, bid); }
    else if constexpr (PH == 3) {
        pg8::Gemm g{(const bf16_t*)(p.ws + WS_ALORA), (const bf16_t*)(p.ws + WS_WLORA), MB, NLORA, KLORA, KLORA, 256}; pg8::StaticOrder S; S.init(MB, NLORA, G, bid);
        EpiDag E{(bf16_t*)((unsigned char*)p.out + SC_B), p.in[I_W0], p.in[I_A0]};
        pg8::gemm_phase<EpiDag, pg8::StaticOrder, false>(lds, g, S, E, nullptr);
    } else if constexpr (PH == 4 || PH == 11 || PH == 12) {
        const int NSCAN = 128;
        if (bid < NSCAN) {
            if constexpr (PH != 12) {
                scan_item(p, lds, tid, false, bid >> 4, (bid >> 1) & 7, bid & 1);
            }
        } else {
            if constexpr (PH != 12) for (int it = bid - NSCAN; it < 512; it += G - NSCAN) scan_item(p, lds, tid, true, it >> 4, (it >> 1) & 7, it & 1);
        }
        if (PH == 4 || (PH == 12 && bid >= NSCAN)) {
            const int wave = tid >> 6, lane = tid & 63, x = bid & 7;
            unsigned* ctr = (unsigned*)(p.ws + WS_BAR) + (PH == 4 ? 16 : 32) + x;
            for (;;) {
                unsigned id = 0; if (lane == 0) id = __hip_atomic_fetch_add(ctr, 1u, __ATOMIC_RELAXED, __HIP_MEMORY_SCOPE_AGENT);
                id = (unsigned)__builtin_amdgcn_readfirstlane((int)id);
                if (id >= 2048u + 256u) break;
                if (id < 2048u) { const int ig = id >> 7, hh = (id >> 4) & 7, r16 = id & 15; attn_task(p, (x << 11) | (hh << 8) | (r16 << 4) | ig, lane); }
                else { const int s = id - 2048; attn_sample_task(p, ((4 * x + (s >> 6)) << 6) | (s & 63), lane, (LAS float*)(lds + wave * 4096)); }
            }
        }
    } else if constexpr (PH == 5) {
        pg8::Gemm g{(const bf16_t*)((const unsigned char*)p.out + SC_C), (const bf16_t*)(p.ws + WS_WOUT), MB, D, D, D, 256}; pg8::StaticOrder S; S.init(MB, D, G, bid);
        EpiBf16S E{(bf16_t*)((unsigned char*)p.out + SC_B), D};
        pg8::gemm_phase<EpiBf16S, pg8::StaticOrder, false>(lds, g, S, E, nullptr);
    } else if constexpr (PH == 6) phase_norm1(p, tid, G, bid);
    else if constexpr (PH == 7) {
        pg8::Gemm g{(const bf16_t*)((const unsigned char*)p.out + SC_C), (const bf16_t*)(p.ws + WS_WUP), UP_TILES * 256, FF2, D, D, UP_STEP}; pg8::StaticOrder S; S.init(UP_TILES * 256, FF2, G, bid);
        EpiUpAct E{(bf16_t*)(p.ws + WS_U), p.out, p.in[I_CONVW], p.in[I_CONVB], p.in[I_SCONV], (LAS float*)(lds + 131072)};
        pg8::gemm_phase<EpiUpAct, pg8::StaticOrder, false>(lds, g, S, E, nullptr);
    } else if constexpr (PH == 8) phase_act(p, tid, G, bid);
    else if constexpr (PH == 9) {
        pg8::Gemm g{(const bf16_t*)(p.ws + WS_U), (const bf16_t*)(p.ws + WS_WDN), MB, D, FF, FF, 256}; pg8::StaticOrder S; S.init(MB, D, G, bid);
        pg8::EpiF32 E{(float*)(p.ws + WS_F), D, nullptr};
        pg8::gemm_phase<pg8::EpiF32, pg8::StaticOrder, false>(lds, g, S, E, nullptr);
        phase_cachecopy(p, tid, G, bid);
    } else if constexpr (PH == 10) { phase_final(p, tid, G, bid); }
    else if constexpr (PH == 13) phase_wkvfin(p, tid, G, bid);
}
__device__ __forceinline__ void grid_bar(unsigned* ctr, unsigned target) {
    asm volatile("s_waitcnt vmcnt(0)" ::: "memory");
    __syncthreads();
    if (threadIdx.x == 0) {
        __builtin_amdgcn_fence(__ATOMIC_RELEASE, "agent");
        asm volatile("s_waitcnt vmcnt(0)" ::: "memory");
        __hip_atomic_fetch_add(ctr, 1u, __ATOMIC_RELAXED, __HIP_MEMORY_SCOPE_AGENT);
        while (__hip_atomic_load(ctr, __ATOMIC_RELAXED, __HIP_MEMORY_SCOPE_AGENT) < target) __builtin_amdgcn_s_sleep(2);
        __builtin_amdgcn_fence(__ATOMIC_ACQUIRE, "agent");
        asm volatile("s_waitcnt vmcnt(0)" ::: "memory");
    }
    __syncthreads();
}
template <int SEAM, int FIRST, int... REST>
__device__ __forceinline__ void run_program(const Params& p, LAS unsigned char* lds, cg::grid_group& grid, int tid, int G, int bid) {
    if (p.en > (int)sizeof...(REST) - 1000) run_phase<FIRST>(p, lds, tid, G, bid);
    if constexpr (sizeof...(REST) > 0) {
        if constexpr (SEAM == 0) grid.sync(); else grid_bar((unsigned*)(p.ws + WS_BAR), (unsigned)(SEAM * G));
        run_program<SEAM + 1, REST...>(p, lds, grid, tid, G, bid);
    }
}
#define PROGRAM 0, 1, 2, 3, 4, 13, 5, 6, 7, 9, 10
__global__ void __launch_bounds__(NTHREADS, 2) hymba_fwd(Params p) {
    extern __shared__ __attribute__((aligned(16))) unsigned char lds_raw[];
    LAS unsigned char* lds = (LAS unsigned char*)lds_raw;
    cg::grid_group grid = cg::this_grid();
    run_program<0, PROGRAM>(p, lds, grid, threadIdx.x, gridDim.x, blockIdx.x);
}

extern "C" void kernel_launch(void* const* d_in, const int* in_sizes, int n_in, void* d_out, int out_size, void* d_ws, size_t ws_size, hipStream_t stream) {
    static int grid = 0;
    if (grid == 0) {
        if (n_in != 28 || (size_t)out_size != O_END || ws_size < WS_TOTAL) { fprintf(stderr, "kernel_launch: unexpected sizes n_in %d out %d ws %zu (need %zu)\n", n_in, out_size, ws_size, (size_t)WS_TOTAL); grid = -1; return; }
        int dev = 0, cus = 0, per_cu = 0;
        hipGetDevice(&dev); hipDeviceGetAttribute(&cus, hipDeviceAttributeMultiprocessorCount, dev);
        if (hipFuncSetAttribute((const void*)hymba_fwd, hipFuncAttributeMaxDynamicSharedMemorySize, LDS_BYTES) != hipSuccess) { fprintf(stderr, "kernel_launch: hipFuncSetAttribute failed\n"); grid = -1; return; }
        hipOccupancyMaxActiveBlocksPerMultiprocessor(&per_cu, (const void*)hymba_fwd, NTHREADS, LDS_BYTES);
        (void)hipGetLastError();
        if (per_cu < 1) per_cu = 1;
        grid = cus;
    }
    if (grid < 0) return;
    Params p{};
    for (int i = 0; i < 28; ++i) p.in[i] = (const float*)d_in[i];
    p.out = (float*)d_out; p.ws = (unsigned char*)d_ws; p.en = 1;
    if (hipMemsetAsync((unsigned char*)d_ws + WS_BAR, 0, 256, stream) != hipSuccess) { fprintf(stderr, "kernel_launch: memset of the barrier word failed\n"); return; }
    void* args[] = {&p};
    hipError_t e = hipLaunchCooperativeKernel((const void*)hymba_fwd, dim3(grid), dim3(NTHREADS), args, LDS_BYTES, stream);
    if (e != hipSuccess) fprintf(stderr, "cooperative launch failed: %s (grid %d)\n", hipGetErrorString(e), grid);
}
```
